# Optimizing an MI355X kernel written in HIP

```python
import jax
import jax.numpy as jnp
from jax import lax
import numpy as np

D_MODEL = 1024
BATCH = 8
SEQ = 4096
DEPTH = 2

GRID_W = 64
CTX_LEN = 256
EPS = 1e-6

MLA_HEADS = 6
Q_LORA = 384
KV_LORA = 256
NOPE_DIM = 128
ROPE_DIM = 64
V_DIM = 128
QK_DIM = NOPE_DIM + ROPE_DIM
ROPE_BASE = 10000.0
Q_BLOCK = 128
FOURIER_GROUPS = 4
FOURIER_GROUP_DIM = 64
FOURIER_WIDTH = FOURIER_GROUPS * FOURIER_GROUP_DIM
MLA_IN = Q_LORA + KV_LORA + ROPE_DIM
EVEN_IN = MLA_IN + FOURIER_WIDTH
EVEN_MIX = MLA_HEADS * V_DIM + FOURIER_WIDTH
GLA_HEADS = 4
GLA_DK = 128
GLA_DV = 256
GATE_RANK = 16
GATE_NORMALIZER = 16.0
GLA_CHUNK = 64
GLA_KW = GLA_HEADS * GLA_DK
GLA_VW = GLA_HEADS * GLA_DV
ODD_IN = 2 * GLA_KW + 2 * GLA_VW + 2 * GATE_RANK
ODD_MIX = GLA_VW
N_EXPERTS = 32
TOP_K = 4
D_FF = 1024
SWIGLU_ALPHA = 1.702
SWIGLU_LIMIT = 7.0
EXPERT_BLOCK = 128

kernel_name = "hybrid_mla_fnet_gla_moe_dit"


def rmsnorm(x, g):
    xf = x.astype(jnp.float32)
    y = xf * lax.rsqrt(jnp.mean(xf * xf, axis=-1, keepdims=True) + EPS)
    return (y * g.astype(jnp.float32)).astype(x.dtype)


def modulate(x, g, shift, scale):
    return rmsnorm(x, g) * (1 + scale) + shift


def adaln(cvec, mod_w, mod_b):
    m = jax.nn.silu(cvec) @ mod_w + mod_b
    return jnp.split(m[..., None, :], 6, axis=-1)


def _flip(a):
    return a[:, ::-1]


def axial_rope_tables(n_tokens):
    rows = n_tokens // GRID_W
    row, col = jnp.meshgrid(jnp.arange(rows, dtype=jnp.float32),
                            jnp.arange(GRID_W, dtype=jnp.float32), indexing="ij")
    axis_dim = ROPE_DIM // 2
    inv_freq = ROPE_BASE ** (-jnp.arange(0, axis_dim, 2, dtype=jnp.float32) / axis_dim)
    ang_r = row.reshape(-1, 1) * inv_freq
    ang_c = col.reshape(-1, 1) * inv_freq
    ang = jnp.concatenate([ang_r, ang_r, ang_c, ang_c], axis=-1)
    return jnp.cos(ang), jnp.sin(ang)


def apply_rope(x, cos, sin):
    r1, r2, c1, c2 = jnp.split(x, 4, axis=-1)
    rot = jnp.concatenate([-r2, r1, -c2, c1], axis=-1)
    return (x * cos + rot * sin).astype(x.dtype)


def mla_queries(c_q, q_norm_g, w_q_up, cos, sin):
    b, n, _ = c_q.shape
    q = (rmsnorm(c_q, q_norm_g) @ w_q_up).reshape(b, n, MLA_HEADS, QK_DIM)
    q_nope, q_rope = q[..., :NOPE_DIM], q[..., NOPE_DIM:]
    if cos is not None:
        q_rope = apply_rope(q_rope, cos[:, None, :], sin[:, None, :])
    return jnp.concatenate([q_nope, q_rope], axis=-1)


def mla_keys_values(u_kv, kv_norm_g, w_kv_up, cos, sin):
    b, n, _ = u_kv.shape
    c_kv, k_rope = u_kv[..., :KV_LORA], u_kv[..., KV_LORA:]
    kv = (rmsnorm(c_kv, kv_norm_g) @ w_kv_up).reshape(b, n, MLA_HEADS, NOPE_DIM + V_DIM)
    k_nope, v = kv[..., :NOPE_DIM], kv[..., NOPE_DIM:]
    if cos is not None:
        k_rope = apply_rope(k_rope, cos, sin)
    k = jnp.concatenate([k_nope, jnp.broadcast_to(k_rope[:, :, None, :], (b, n, MLA_HEADS, ROPE_DIM))], axis=-1)
    return k, v


def attend(q, k, v):
    s = jnp.einsum("bqhd,bkhd->bhqk", q.astype(jnp.float32), k.astype(jnp.float32)) * (QK_DIM ** -0.5)
    p = jax.nn.softmax(s, axis=-1).astype(v.dtype)
    return jnp.einsum("bhqk,bkhd->bqhd", p, v)


def blocked_attend(q, k, v):
    b, n, h, dk = q.shape
    nb = n // Q_BLOCK
    qb = q.reshape(b, nb, Q_BLOCK, h, dk).transpose(1, 0, 2, 3, 4)
    ob = lax.map(lambda qi: attend(qi, k, v), qb)
    return ob.transpose(1, 0, 2, 3, 4).reshape(b, n, h, -1)


def fourier_mix(u):
    b, n, _ = u.shape
    ug = u.reshape(b, n, FOURIER_GROUPS, FOURIER_GROUP_DIM).astype(jnp.float32)
    f = jnp.fft.fft2(ug, axes=(1, 3), norm="ortho").real
    return f.reshape(b, n, FOURIER_WIDTH).astype(u.dtype)


def even_mixer(h_lat, h_ctx, w_in, q_norm_g, w_q_up, kv_norm_g, w_kv_up, w_out, ctx_out):
    b, n, _ = h_lat.shape
    cos, sin = axial_rope_tables(n)
    u_lat = h_lat @ w_in
    u_ctx = h_ctx @ w_in
    q_lat = mla_queries(u_lat[..., :Q_LORA], q_norm_g, w_q_up, cos, sin)
    k_lat, v_lat = mla_keys_values(u_lat[..., Q_LORA:MLA_IN], kv_norm_g, w_kv_up, cos, sin)
    k_ctx, v_ctx = mla_keys_values(u_ctx[..., Q_LORA:MLA_IN], kv_norm_g, w_kv_up, None, None)
    a_lat = blocked_attend(q_lat, jnp.concatenate([k_ctx, k_lat], axis=1),
                           jnp.concatenate([v_ctx, v_lat], axis=1))
    y_lat = jnp.concatenate([a_lat.reshape(b, n, -1), fourier_mix(u_lat[..., MLA_IN:])], axis=-1) @ w_out
    y_ctx = None
    if ctx_out:
        q_ctx = mla_queries(u_ctx[..., :Q_LORA], q_norm_g, w_q_up, None, None)
        a_ctx = attend(q_ctx, k_ctx, v_ctx)
        y_ctx = jnp.concatenate([a_ctx.reshape(b, h_ctx.shape[1], -1), fourier_mix(u_ctx[..., MLA_IN:])], axis=-1) @ w_out
    return y_lat, y_ctx


def gla_project(u, w_gk_fwd, b_gk_fwd, w_gk_bwd, b_gk_bwd):
    b, n, _ = u.shape
    q, k, v, g_out, gd_fwd, gd_bwd = jnp.split(
        u, [GLA_KW, 2 * GLA_KW, 2 * GLA_KW + GLA_VW, 2 * GLA_KW + 2 * GLA_VW,
            2 * GLA_KW + 2 * GLA_VW + GATE_RANK], axis=-1)

    def heads(a, d):
        return a.reshape(b, n, GLA_HEADS, d).astype(jnp.float32)

    def decay(gd, w_up, b_up):
        z = (gd @ w_up + b_up).astype(jnp.float32)
        return heads(jax.nn.log_sigmoid(z) / GATE_NORMALIZER, GLA_DK)

    return (heads(q, GLA_DK) * (GLA_DK ** -0.5), heads(k, GLA_DK), heads(v, GLA_DV), g_out,
            decay(gd_fwd, w_gk_fwd, b_gk_fwd), decay(gd_bwd, w_gk_bwd, b_gk_bwd))


def gla_chunked(q, k, v, g, s0):
    b, n, h, _ = q.shape
    nc = n // GLA_CHUNK

    def to_chunks(a):
        return a.reshape(b, nc, GLA_CHUNK, h, a.shape[-1]).transpose(1, 0, 3, 2, 4)

    tril = jnp.tril(jnp.ones((GLA_CHUNK, GLA_CHUNK), dtype=bool))

    def step(state, inp):
        qc, kc, vc, gc = inp
        cum = jnp.cumsum(gc, axis=2)
        last = cum[:, :, -1:, :]
        q_dec = qc * jnp.exp(cum)
        k_dec = kc * jnp.exp(-cum)
        scores = jnp.where(tril, jnp.einsum("bhid,bhjd->bhij", q_dec, k_dec), 0.0)
        out = jnp.einsum("bhid,bhde->bhie", q_dec, state) + jnp.einsum("bhij,bhje->bhie", scores, vc)
        state = (jnp.exp(last)[:, :, 0, :, None] * state
                 + jnp.einsum("bhjd,bhje->bhde", kc * jnp.exp(last - cum), vc))
        return state, out

    s_fin, o = lax.scan(step, s0, (to_chunks(q), to_chunks(k), to_chunks(v), to_chunks(g)))
    return o.transpose(1, 0, 3, 2, 4).reshape(b, n, h, -1), s_fin


def gla_final_state(k, v, g):
    cum = jnp.cumsum(g, axis=1)
    return jnp.einsum("bnhd,bnhe->bhde", k * jnp.exp(cum[:, -1:] - cum), v)


def gla_output(o, g_out, gnorm_g, w_out):
    b, n = o.shape[:2]
    o = rmsnorm(o, gnorm_g).reshape(b, n, GLA_VW) * jax.nn.silu(g_out.astype(jnp.float32))
    return o.astype(w_out.dtype) @ w_out


def odd_mixer(h_lat, h_ctx, w_in, w_gk_fwd, b_gk_fwd, w_gk_bwd, b_gk_bwd, gnorm_g, w_out, ctx_out):
    gates = (w_gk_fwd, b_gk_fwd, w_gk_bwd, b_gk_bwd)
    q_c, k_c, v_c, go_c, gf_c, gb_c = gla_project(h_ctx @ w_in, *gates)
    y_ctx = None
    if ctx_out:
        zero = jnp.zeros((h_ctx.shape[0], GLA_HEADS, GLA_DK, GLA_DV), jnp.float32)
        o_f, s_fwd = gla_chunked(q_c, k_c, v_c, gf_c, zero)
        o_b, s_bwd = gla_chunked(_flip(q_c), _flip(k_c), _flip(v_c), _flip(gb_c), zero)
        y_ctx = gla_output(o_f + _flip(o_b), go_c, gnorm_g, w_out)
    else:
        s_fwd = gla_final_state(k_c, v_c, gf_c)
        s_bwd = gla_final_state(_flip(k_c), _flip(v_c), _flip(gb_c))
    q, k, v, go, gf, gb = gla_project(h_lat @ w_in, *gates)
    o_f, _ = gla_chunked(q, k, v, gf, s_fwd)
    o_b, _ = gla_chunked(_flip(q), _flip(k), _flip(v), _flip(gb), s_bwd)
    return gla_output(o_f + _flip(o_b), go, gnorm_g, w_out), y_ctx


def clamped_swiglu(gu):
    x_glu, x_lin = gu[..., ::2], gu[..., 1::2]
    x_glu = jnp.minimum(x_glu, SWIGLU_LIMIT)
    x_lin = jnp.clip(x_lin, -SWIGLU_LIMIT, SWIGLU_LIMIT)
    return x_glu * jax.nn.sigmoid(SWIGLU_ALPHA * x_glu) * (x_lin + 1)


def moe_ffn(h, router_w, router_b, w_gu, b_gu, w_down, b_down):
    n_tok, d = h.shape
    logits = (h @ router_w + router_b).astype(jnp.float32)
    top_val, top_idx = lax.top_k(logits, TOP_K)
    gates = jax.nn.softmax(top_val, axis=-1)
    n_rows = n_tok * TOP_K
    e_flat = top_idx.reshape(-1)
    tok_flat = jnp.repeat(jnp.arange(n_tok, dtype=jnp.int32), TOP_K)
    order = jnp.argsort(e_flat)
    e_sorted = e_flat[order]
    counts = jnp.bincount(e_flat, length=N_EXPERTS)
    starts = jnp.cumsum(counts) - counts
    padded = (counts + EXPERT_BLOCK - 1) // EXPERT_BLOCK * EXPERT_BLOCK
    pad_ends = jnp.cumsum(padded)
    pad_starts = pad_ends - padded
    dest = pad_starts[e_sorted] + jnp.arange(n_rows, dtype=jnp.int32) - starts[e_sorted]
    n_blocks = -(-(n_rows + N_EXPERTS * (EXPERT_BLOCK - 1)) // EXPERT_BLOCK)
    n_pad = n_blocks * EXPERT_BLOCK
    row_tok = jnp.full((n_pad,), n_tok, jnp.int32).at[dest].set(tok_flat[order])
    row_gate = jnp.zeros((n_pad,), jnp.float32).at[dest].set(gates.reshape(-1)[order])
    block_e = jnp.minimum(
        jnp.searchsorted(pad_ends, jnp.arange(n_blocks, dtype=jnp.int32) * EXPERT_BLOCK, side="right"),
        N_EXPERTS - 1)
    h_pad = jnp.concatenate([h, jnp.zeros((1, d), h.dtype)], axis=0)
    xb = h_pad[row_tok].reshape(n_blocks, EXPERT_BLOCK, d)

    def expert_block(args):
        xe, e = args
        gu = xe @ w_gu[e] + b_gu[e]
        return clamped_swiglu(gu) @ w_down[e] + b_down[e]

    yb = lax.map(expert_block, (xb, block_e)).reshape(n_pad, d)
    y = jax.ops.segment_sum(yb * row_gate[:, None].astype(yb.dtype), row_tok, num_segments=n_tok + 1)
    return y[:n_tok]


def setup_inputs(seed: int = 0) -> dict:
    key = jax.random.key(seed)
    keys = list(jax.random.split(key, 48))

    def normal(shape, scale=1.0):
        return scale * jax.random.normal(keys.pop(), shape, jnp.float32)

    def dense(shape, fan_in, scale=1.0):
        return normal(shape, scale * fan_in ** -0.5)

    def gain(n):
        return 1.0 + normal((n,), 0.05)

    D, F, E = D_MODEL, D_FF, N_EXPERTS
    inp = {}
    inp["x"] = normal((BATCH, SEQ, D))
    inp["c"] = normal((BATCH, D))
    inp["ctx"] = normal((BATCH, CTX_LEN, D))
    inp["c_ctx"] = normal((D,))
    inp["final_norm_g"] = gain(D)
    inp["l0_mod_w"] = dense((D, 6 * D), D, 0.5)
    inp["l0_mod_b"] = normal((6 * D,), 0.1)
    inp["l0_norm1_g"] = gain(D)
    inp["l0_w_in"] = dense((D, EVEN_IN), D)
    inp["l0_q_norm_g"] = gain(Q_LORA)
    inp["l0_w_q_up"] = dense((Q_LORA, MLA_HEADS * QK_DIM), Q_LORA)
    inp["l0_kv_norm_g"] = gain(KV_LORA)
    inp["l0_w_kv_up"] = dense((KV_LORA, MLA_HEADS * (NOPE_DIM + V_DIM)), KV_LORA)
    inp["l0_w_out"] = dense((EVEN_MIX, D), EVEN_MIX)
    inp["l0_norm2_g"] = gain(D)
    inp["l0_router_w"] = dense((D, E), D)
    inp["l0_router_b"] = normal((E,), 0.01)
    inp["l0_w_gu"] = dense((E, D, 2 * F), D)
    inp["l0_b_gu"] = normal((E, 2 * F), 0.02)
    inp["l0_w_down"] = dense((E, F, D), F)
    inp["l0_b_down"] = normal((E, D), 0.02)
    inp["l1_mod_w"] = dense((D, 6 * D), D, 0.5)
    inp["l1_mod_b"] = normal((6 * D,), 0.1)
    inp["l1_norm1_g"] = gain(D)
    inp["l1_w_in"] = dense((D, ODD_IN), D)
    inp["l1_w_gk_fwd"] = dense((GATE_RANK, GLA_KW), GATE_RANK)
    inp["l1_b_gk_fwd"] = normal((GLA_KW,), 0.1)
    inp["l1_w_gk_bwd"] = dense((GATE_RANK, GLA_KW), GATE_RANK)
    inp["l1_b_gk_bwd"] = normal((GLA_KW,), 0.1)
    inp["l1_gnorm_g"] = gain(GLA_DV)
    inp["l1_w_out"] = dense((ODD_MIX, D), ODD_MIX)
    inp["l1_norm2_g"] = gain(D)
    inp["l1_router_w"] = dense((D, E), D)
    inp["l1_router_b"] = normal((E,), 0.01)
    inp["l1_w_gu"] = dense((E, D, 2 * F), D)
    inp["l1_b_gu"] = normal((E, 2 * F), 0.02)
    inp["l1_w_down"] = dense((E, F, D), F)
    inp["l1_b_down"] = normal((E, D), 0.02)
    return inp


def reference(x, c, ctx, c_ctx, final_norm_g,
              l0_mod_w, l0_mod_b, l0_norm1_g, l0_w_in, l0_q_norm_g, l0_w_q_up, l0_kv_norm_g, l0_w_kv_up,
              l0_w_out, l0_norm2_g, l0_router_w, l0_router_b, l0_w_gu, l0_b_gu, l0_w_down, l0_b_down,
              l1_mod_w, l1_mod_b, l1_norm1_g, l1_w_in, l1_w_gk_fwd, l1_b_gk_fwd, l1_w_gk_bwd, l1_b_gk_bwd,
              l1_gnorm_g, l1_w_out, l1_norm2_g, l1_router_w, l1_router_b, l1_w_gu, l1_b_gu, l1_w_down,
              l1_b_down):
    common = [(l0_mod_w, l0_mod_b, l0_norm1_g, l0_norm2_g),
              (l1_mod_w, l1_mod_b, l1_norm1_g, l1_norm2_g)]
    mixers = [(even_mixer, (l0_w_in, l0_q_norm_g, l0_w_q_up, l0_kv_norm_g, l0_w_kv_up, l0_w_out)),
              (odd_mixer, (l1_w_in, l1_w_gk_fwd, l1_b_gk_fwd, l1_w_gk_bwd, l1_b_gk_bwd, l1_gnorm_g, l1_w_out))]
    experts = [(l0_router_w, l0_router_b, l0_w_gu, l0_b_gu, l0_w_down, l0_b_down),
               (l1_router_w, l1_router_b, l1_w_gu, l1_b_gu, l1_w_down, l1_b_down)]
    x_lat, x_ctx = x, ctx
    for i in range(DEPTH):
        last = i == DEPTH - 1
        mod_w, mod_b, norm1_g, norm2_g = common[i]
        mixer, mixer_params = mixers[i]
        sh1, sc1, g1, sh2, sc2, g2 = adaln(c, mod_w, mod_b)
        csh1, csc1, cg1, csh2, csc2, cg2 = adaln(c_ctx, mod_w, mod_b)
        y_lat, y_ctx = mixer(modulate(x_lat, norm1_g, sh1, sc1), modulate(x_ctx, norm1_g, csh1, csc1),
                             *mixer_params, ctx_out=not last)
        x_lat = x_lat + g1 * y_lat
        h_lat = modulate(x_lat, norm2_g, sh2, sc2)
        b, n, d = h_lat.shape
        if last:
            x_lat = x_lat + g2 * moe_ffn(h_lat.reshape(b * n, d), *experts[i]).reshape(b, n, d)
        else:
            x_ctx = x_ctx + cg1 * y_ctx
            h_ctx = modulate(x_ctx, norm2_g, csh2, csc2)
            m = h_ctx.shape[1]
            y = moe_ffn(jnp.concatenate([h_ctx.reshape(b * m, d), h_lat.reshape(b * n, d)], axis=0), *experts[i])
            x_ctx = x_ctx + cg2 * y[: b * m].reshape(b, m, d)
            x_lat = x_lat + g2 * y[b * m:].reshape(b, n, d)
    return rmsnorm(x_lat, final_norm_g)
```

```cpp
#include <hip/hip_runtime.h>
#include <stdint.h>
#include <stdio.h>

#define LAS __attribute__((address_space(3)))
typedef unsigned short bf16_t;
typedef short bf16x8 __attribute__((ext_vector_type(8)));
typedef float f32x4 __attribute__((ext_vector_type(4)));
typedef float f32x2 __attribute__((ext_vector_type(2)));
typedef unsigned u32x4 __attribute__((ext_vector_type(4)));
typedef unsigned u32x2 __attribute__((ext_vector_type(2)));

#ifndef NAIVE_ATTN
#define NAIVE_ATTN 0
#endif
#ifndef NAIVE_GLA
#define NAIVE_GLA 0
#endif
constexpr int D = 1024, NB = 8, SEQ = 4096, CTXL = 256;
constexpr int TC = NB * CTXL, TL = NB * SEQ, T = TC + TL;
constexpr int QL = 384, KVL = 256, ROPE = 64, NH = 6, QKD = 192, VD = 128;
constexpr int U0W = 768;
constexpr int QW = NH * QKD  , QWP = 1280, KVW = NH * 256  ;
constexpr int NE = 32, TOPK = 4, FF = 1024;
constexpr int U1W = 3072;
constexpr int NPAD = 147456;
constexpr float EPS = 1e-6f;
constexpr int NTHR = 512, NWAVE = 8;

constexpr size_t al256(size_t x) { return (x + 255) / 256 * 256; }
constexpr size_t XCD_BAR_WORDS_C = 3456;
constexpr size_t CW_BAR = 0;
constexpr size_t CW_Q5 = 15360;
constexpr size_t CW_CNT = 16384;
constexpr size_t CTL_BYTES = 32768;
constexpr size_t WS_CTL = 0;
constexpr size_t WS_MODV = WS_CTL + CTL_BYTES;
constexpr size_t WS_ROPE = WS_MODV + al256(2 * 9 * 6144 * 4);
constexpr size_t WS_RS = WS_ROPE + al256(2 * 64 * 16 * 4);
constexpr size_t WS_XCTX = WS_RS + al256((size_t)2 * T * 4);
constexpr size_t WS_H = WS_XCTX + al256((size_t)TC * D * 4);
constexpr size_t WS_WIN0 = WS_H + al256((size_t)T * D * 2);
constexpr size_t WS_WF = WS_WIN0 + al256((size_t)U0W * D * 2);
constexpr size_t WS_WQ = WS_WF + al256((size_t)512 * D * 2);
constexpr size_t WS_WKV = WS_WQ + al256((size_t)QWP * QL * 2);
constexpr size_t WS_WOUT0 = WS_WKV + al256((size_t)KVW * KVL * 2);
constexpr size_t WS_WIN1 = WS_WOUT0 + al256((size_t)D * D * 2);
constexpr size_t WS_WOUT1 = WS_WIN1 + al256((size_t)U1W * D * 2);
constexpr size_t WS_WGU = WS_WOUT1 + al256((size_t)D * D * 2);
constexpr size_t WS_WDN = WS_WGU + al256((size_t)NE * 2048 * D * 2);
constexpr size_t WS_ACT = WS_WDN + al256((size_t)NE * D * FF * 2);
constexpr size_t WS_LIST = WS_ACT + al256((size_t)NPAD * FF * 2);
constexpr size_t WS_TOKE = WS_LIST + al256((size_t)NE * T * 4);
constexpr size_t WS_TOKP = WS_TOKE + al256((size_t)T * 4 * 4);
constexpr size_t WS_TOKG = WS_TOKP + al256((size_t)T * 4 * 4);
constexpr size_t WS_GD = WS_TOKG + al256((size_t)T * 4 * 4);
constexpr size_t WS_REG = WS_GD + al256((size_t)T * 32 * 4);
constexpr size_t R0_U0 = WS_REG;
constexpr size_t R0_TT = R0_U0 + al256((size_t)T * U0W * 2);
constexpr size_t R0_TTC = R0_TT + al256((size_t)NB * 256 * 8192 * 2);
constexpr size_t R0_Q = R0_TTC + al256((size_t)NB * 256 * 512 * 2);
constexpr size_t R0_KV = R0_Q + al256((size_t)T * QW * 2);
constexpr size_t R0_KR = R0_KV + al256((size_t)T * KVW * 2);
constexpr size_t R0_MIX = R0_KR + al256((size_t)T * ROPE * 2);
constexpr size_t R0_DFT = R0_MIX + al256((size_t)T * D * 2);
constexpr size_t R0_DFTC = R0_DFT + al256((size_t)4096 * 4096 * 2);
constexpr size_t R0_TT2 = R0_DFTC + al256((size_t)256 * 256 * 2);
constexpr size_t R0_TTC2 = R0_TT2 + al256((size_t)NB * 256 * 4096 * 2);
constexpr size_t R0_END = R0_TTC2 + al256((size_t)NB * 256 * 256 * 2);
constexpr size_t R1_U1 = WS_REG;
constexpr size_t R1_OF = R1_U1 + al256((size_t)T * U1W * 2);
constexpr size_t R1_OB = R1_OF + al256((size_t)TL * D * 2);
constexpr size_t R1_MIX = R1_OB + al256((size_t)TL * D * 2);
constexpr size_t R1_END = R1_MIX + al256((size_t)TL * D * 2);
constexpr size_t RM_YB = WS_REG;
constexpr size_t RM_END = RM_YB + al256((size_t)NPAD * D * 2);
constexpr size_t cmax(size_t a, size_t b) { return a > b ? a : b; }
constexpr size_t WS_END = cmax(cmax(R0_END, R1_END), RM_END);

constexpr int LDS_BYTES = 160 * 1024;
constexpr int LDS_MISC = 1024;
constexpr int RING_OFF = LDS_MISC;

__device__ __forceinline__ float bf2f(bf16_t b) { return __uint_as_float(((unsigned)b) << 16); }
__device__ __forceinline__ bf16_t f2bf(float f) { unsigned u = __float_as_uint(f); u += 0x7FFFu + ((u >> 16) & 1u); return (bf16_t)(u >> 16); }
__device__ __forceinline__ unsigned pk2(float lo, float hi) { return (unsigned)f2bf(lo) | ((unsigned)f2bf(hi) << 16); }
typedef __bf16 bf16v2_t __attribute__((ext_vector_type(2)));
__device__ __forceinline__ unsigned cvt_pk_bf16(float lo, float hi) { const f32x2 v = {lo, hi}; bf16v2_t b = __builtin_convertvector(v, bf16v2_t); return *reinterpret_cast<unsigned*>(&b); }
__device__ __forceinline__ float wsum(float v) { for (int o = 32; o >= 1; o >>= 1) v += __shfl_xor(v, o); return v; }
__device__ __forceinline__ float siluf(float x) { return x / (1.0f + __expf(-x)); }
__device__ __forceinline__ float silu_fast(float x) { return x * __builtin_amdgcn_rcpf(1.0f + __builtin_amdgcn_exp2f(x * -1.4426950408889634f)); }

#define XB_TMO      128
#define XB_XCNT(j)  (256  + 64 * (j))
#define XB_XSUB(j)  (1280 + 64 * (j))
#define XB_XGEN(j)  (2304 + 64 * (j))
#define XB_TOP      3328
#define XB_TOPGEN   3392
#define XCD_BAR_WORDS 3456
#define XB_SPIN_CAP (1u << 20)
__device__ __forceinline__ unsigned xb_ld(unsigned* p)              { return __hip_atomic_load(p, __ATOMIC_RELAXED, __HIP_MEMORY_SCOPE_AGENT); }
__device__ __forceinline__ unsigned xb_add(unsigned* p, unsigned v) { return __hip_atomic_fetch_add(p, v, __ATOMIC_RELAXED, __HIP_MEMORY_SCOPE_AGENT); }
__device__ __forceinline__ unsigned xb_xcc_id() { return (unsigned)__builtin_amdgcn_s_getreg((3 << 11) | 20) & 0xFu; }
#define XB_SPIN(cond, bar) do { unsigned _sp = 0; while (cond) { __builtin_amdgcn_s_sleep(1); \
    if ((++_sp & 255u) == 0u) { if (xb_ld(&(bar)[XB_TMO])) break; if (_sp > XB_SPIN_CAP) { atomicAdd(&(bar)[XB_TMO], 1u); break; } } } } while (0)
struct XcdBarrier { unsigned* bar; unsigned x; volatile LAS unsigned* st; };
__device__ __forceinline__ XcdBarrier xcd_barrier_post(unsigned* bar, volatile LAS unsigned* st) {
    XcdBarrier b; b.bar = bar; b.x = xb_xcc_id(); b.st = st;
    if (threadIdx.x == 0) (void)xb_add(&bar[XB_XCNT(b.x)], 1u);
    return b;
}
__device__ __forceinline__ void xcd_barrier_complete(unsigned* bar, unsigned x, unsigned& nloc, unsigned& nx) {
    const unsigned G = gridDim.x * gridDim.y * gridDim.z;
    unsigned sum, cnt, mine, sp = 0u;
    for (;;) {
        sum = 0u; cnt = 0u; mine = 0u;
#pragma unroll
        for (unsigned j = 0; j < 16; ++j) { const unsigned c = xb_ld(&bar[XB_XCNT(j)]); sum += c; cnt += (c > 0u) ? 1u : 0u; mine = (j == x) ? c : mine; }
        if (sum == G) break;
        __builtin_amdgcn_s_sleep(1);
        if ((++sp & 255u) == 0u) { if (xb_ld(&bar[XB_TMO])) break; if (sp > XB_SPIN_CAP) { atomicAdd(&bar[XB_TMO], 1u); break; } }
    }
    nloc = mine > 0u ? mine : 1u; nx = cnt > 0u ? cnt : 1u;
}
__device__ __forceinline__ void xcd_barrier(const XcdBarrier& b) {
    asm volatile("s_waitcnt vmcnt(0)" ::: "memory");
    __syncthreads();
    if (threadIdx.x == 0) {
        unsigned* bar = b.bar;
        __builtin_amdgcn_s_waitcnt(0);
        unsigned nloc = b.st[0], nx = b.st[1];
        if (nloc == 0u) { xcd_barrier_complete(bar, b.x, nloc, nx); b.st[0] = nloc; b.st[1] = nx; }
        const unsigned old = xb_add(&bar[XB_XSUB(b.x)], 1u);
        const unsigned gen = old / nloc;
        if (old + 1u == (gen + 1u) * nloc) {
            __builtin_amdgcn_fence(__ATOMIC_RELEASE, "agent");
            asm volatile("s_waitcnt vmcnt(0)" ::: "memory");
            const unsigned og = xb_add(&bar[XB_TOP], 1u);
            const unsigned tg = og / nx;
            if (og + 1u == (tg + 1u) * nx) xb_add(&bar[XB_TOPGEN], 1u);
            else XB_SPIN(xb_ld(&bar[XB_TOPGEN]) == tg, bar);
            __builtin_amdgcn_fence(__ATOMIC_ACQUIRE, "agent");
            xb_add(&bar[XB_XGEN(b.x)], 1u);
            asm volatile("s_waitcnt vmcnt(0)" ::: "memory");
        } else {
            XB_SPIN(xb_ld(&bar[XB_XGEN(b.x)]) == gen, bar);
            __builtin_amdgcn_fence(__ATOMIC_ACQUIRE, "agent");
            asm volatile("s_waitcnt vmcnt(0)" ::: "memory");
        }
    }
    __syncthreads();
}

namespace pg8 {
constexpr int BM = 256, BK = 64, HALF = 128, HTB = HALF * BK * 2, STAGE_BYTES = 8 * HTB, NXCD = 8, WGM = 8;
__host__ __device__ __forceinline__ int lds_byte(int r, int c) { const int st = (r >> 4) * 2 + (c >> 5), rr = r & 15, cc = c & 31, ob = rr * 64 + cc * 2; return st * 1024 + (ob ^ (((ob >> 9) & 1) << 5)); }
__host__ __device__ __forceinline__ void stage_rc(int b, int& R, int& C) { const int st = b / 1024, sb = b % 1024, swz = sb ^ (((sb >> 9) & 1) << 5); R = (st >> 1) * 16 + swz / 64; C = (st & 1) * 32 + (swz % 64) / 2; }
__host__ __device__ __forceinline__ int perm32(int rho) { const int n = rho >> 4, i = rho & 15; return 8 * (i >> 2) + 4 * n + (i & 3); }

struct Unit { int pm, pn, e, cnt; const char* A; const char* B; };
struct Gemm { int K, lda, ldb; };

struct DenseOrder {
    const char* A; const char* B; int lda, ldb; int nM, nN, nwg, G, c;
    static constexpr bool GATHER = false;
    __device__ void init(const void* A_, const void* B_, int lda_, int ldb_, int M, int N, int G_, int c_) { A = (const char*)A_; B = (const char*)B_; lda = lda_; ldb = ldb_; nM = M / BM; nN = N / BM; nwg = nM * nN; G = G_; c = c_; }
    __device__ bool next(int i, Unit& u) const {
        const long L = (long)i * G + c; if (L >= nwg) return false;
        int wgid = (int)L; { const int q = nwg / NXCD, r = nwg % NXCD, xcd = wgid % NXCD, off = wgid / NXCD; wgid = (xcd < r ? xcd * (q + 1) : r * (q + 1) + (xcd - r) * q) + off; }
        const int nig = WGM * nN, gid = wgid / nig, fm = gid * WGM, gsz = (nM - fm) < WGM ? (nM - fm) : WGM;
        u.pm = fm + ((wgid % nig) % gsz); u.pn = (wgid % nig) / gsz; u.e = 0; u.cnt = 0;
        u.A = A + (size_t)u.pm * BM * lda * 2; u.B = B + (size_t)u.pn * BM * ldb * 2; return true;
    }
    __device__ __forceinline__ void aoff(const Unit&, const int (&R)[2], const int (&C)[2], unsigned (&off)[2][2]) const {
#pragma unroll
        for (int h = 0; h < 2; ++h)
#pragma unroll
            for (int i = 0; i < 2; ++i) off[h][i] = (unsigned)((h * HALF + R[i]) * lda + C[i]) * 2u;
    }
};
struct BatchOrder {
    const char* A; const char* B; size_t sA, sB; int lda, ldb; int nM, nN, per, nwg, G, c;
    static constexpr bool GATHER = false;
    __device__ void init(const void* A_, const void* B_, size_t sA_, size_t sB_, int lda_, int ldb_, int nb, int M, int N, int G_, int c_) { A = (const char*)A_; B = (const char*)B_; sA = sA_; sB = sB_; lda = lda_; ldb = ldb_; nM = M / BM; nN = N / BM; per = nM * nN; nwg = per * nb; G = G_; c = c_; }
    __device__ bool next(int i, Unit& u) const {
        const long L = (long)i * G + c; if (L >= nwg) return false;
        const int b = (int)L / per, r = (int)L % per; u.pm = r / nN; u.pn = r % nN; u.e = b; u.cnt = 0;
        u.A = A + (size_t)b * sA + (size_t)u.pm * BM * lda * 2; u.B = B + (size_t)b * sB + (size_t)u.pn * BM * ldb * 2; return true;
    }
    __device__ __forceinline__ void aoff(const Unit&, const int (&R)[2], const int (&C)[2], unsigned (&off)[2][2]) const {
#pragma unroll
        for (int h = 0; h < 2; ++h)
#pragma unroll
            for (int i = 0; i < 2; ++i) off[h][i] = (unsigned)((h * HALF + R[i]) * lda + C[i]) * 2u;
    }
};
struct DualOrder {
    DenseOrder a, b;
    static constexpr bool GATHER = false;
    __device__ __forceinline__ void aoff_issue(const Unit&, const int (&)[2], unsigned (&)[2][2]) const {}
    __device__ __forceinline__ void aoff_finish(const int (&)[2], unsigned (&)[2][2], unsigned (&)[2][2]) const {}
    __device__ bool next(int i, Unit& u) const {
        const long L = (long)i * a.G + a.c;
        if (L < a.nwg) { return a.next(i, u); }
        const long Lb = L - a.nwg; if (Lb >= b.nwg) return false;
        DenseOrder t = b; t.c = (int)(Lb % b.G); const bool ok = t.next((int)(Lb / b.G), u); u.e = 1; return ok;
    }
    __device__ __forceinline__ void aoff(const Unit& u, const int (&R)[2], const int (&C)[2], unsigned (&off)[2][2]) const { a.aoff(u, R, C, off); }
};
struct OneUnit {
    Unit u0; int lda;
    static constexpr bool GATHER = false;
    __device__ bool next(int i, Unit& u) const { if (i != 0) return false; u = u0; return true; }
    __device__ __forceinline__ void aoff(const Unit&, const int (&R)[2], const int (&C)[2], unsigned (&off)[2][2]) const {
#pragma unroll
        for (int h = 0; h < 2; ++h)
#pragma unroll
            for (int i = 0; i < 2; ++i) off[h][i] = (unsigned)((h * HALF + R[i]) * lda + C[i]) * 2u;
    }
};
template <bool GATHER_> struct MoeOrder {
    const char* A; const char* B; size_t sB; int lda, ldb; int npn, nwg, G, c;
    const LAS int* tstart; const LAS int* cnt; const int* list;
    const LAS int* t2e;
    __device__ __forceinline__ int ts(int j) const { return __builtin_amdgcn_readfirstlane(tstart[j]); }
    static constexpr bool GATHER = GATHER_;
    __device__ bool next(int i, Unit& u) const {
        const long L = (long)i * G + c; if (L >= nwg) return false;
        int wgid = (int)L; { const int q = nwg / NXCD, r = nwg % NXCD, xcd = wgid % NXCD, off = wgid / NXCD; wgid = (xcd < r ? xcd * (q + 1) : r * (q + 1) + (xcd - r) * q) + off; }
        const int e = __builtin_amdgcn_readfirstlane(t2e[wgid / npn]);
        const int t0 = ts(e), nt = ts(e + 1) - t0, l = wgid - t0 * npn, pn = l / nt, ti = l % nt;
        u.pm = t0 + ti; u.pn = pn; u.e = e; u.cnt = __builtin_amdgcn_readfirstlane(cnt[e]) - ti * BM;
        u.A = GATHER ? A : A + (size_t)u.pm * BM * lda * 2;
        u.B = B + (size_t)e * sB + (size_t)pn * BM * ldb * 2; return true;
    }
    __device__ __forceinline__ void aoff(const Unit& u, const int (&R)[2], const int (&C)[2], unsigned (&off)[2][2]) const {
        if (GATHER) {
            const int ti = u.pm - ts(u.e);
#pragma unroll
            for (int h = 0; h < 2; ++h)
#pragma unroll
                for (int i = 0; i < 2; ++i) { const int r = h * HALF + R[i]; const int tok = (r < u.cnt) ? list[(size_t)u.e * T + ti * BM + r] : 0; off[h][i] = (unsigned)(tok * lda + C[i]) * 2u; }
        } else {
#pragma unroll
            for (int h = 0; h < 2; ++h)
#pragma unroll
                for (int i = 0; i < 2; ++i) off[h][i] = (unsigned)((h * HALF + R[i]) * lda + C[i]) * 2u;
        }
    }
};

template <class Epi, class Sched>
__device__ __forceinline__ void gemm_phase(LAS unsigned char* lds, const Gemm g, const Sched& S, const Epi& E) {
    const int tid = threadIdx.x, wid = __builtin_amdgcn_readfirstlane(tid >> 6), lane = tid & 63, wr = wid >> 2, wc = wid & 3, fr = lane & 15, fq = lane >> 4;
    const int K = g.K, nt = K / BK;
    int Rr[2], Cc[2]; unsigned voffB[2];
#pragma unroll
    for (int i = 0; i < 2; ++i) { int R, C; stage_rc(tid * 16 + i * 8192, R, C); const int Rb = Epi::PERM ? ((R & ~31) + perm32(R & 31)) : R; Rr[i] = R; Cc[i] = C; voffB[i] = (unsigned)(Rb * g.ldb + C) * 2u; }
    const size_t kstep = (size_t)(BK * 2);
    const size_t hstepB = (size_t)HALF * g.ldb * 2;
    const unsigned ldsw = (unsigned)wid * 1024u;
    const int aoff = lds_byte(wr * 64 + fr, fq * 8), boff = lds_byte(wc * 32 + fr, fq * 8);
#define PG8_SA(b, h) (((b) * 2 + (h)) * HTB)
#define PG8_SB(b, h) ((4 + (b) * 2 + (h)) * HTB)
#define PG8_STAGE2(bufoff, gbase, o0, o1) do { \
        __builtin_amdgcn_global_load_lds((const unsigned*)((const char*)(gbase) + (o0)), (LAS unsigned*)(lds + (bufoff) + ldsw), 16, 0, 0); \
        __builtin_amdgcn_global_load_lds((const unsigned*)((const char*)(gbase) + (o1)), (LAS unsigned*)(lds + (bufoff) + ldsw + 8192), 16, 0, 0); } while (0)
#define PG8_STAGEB(bufoff, gbase) PG8_STAGE2(bufoff, gbase, voffB[0], voffB[1])
#define PG8_LDA(dst, b, h) do { _Pragma("unroll") for (int m = 0; m < 4; ++m) _Pragma("unroll") for (int k = 0; k < 2; ++k) dst[m][k] = *(const LAS bf16x8*)(lds + PG8_SA(b, h) + aoff + m * 2048 + k * 1024); } while (0)
#define PG8_LDB(dst, b, h) do { _Pragma("unroll") for (int n = 0; n < 2; ++n) _Pragma("unroll") for (int k = 0; k < 2; ++k) dst[n][k] = *(const LAS bf16x8*)(lds + PG8_SB(b, h) + boff + n * 2048 + k * 1024); } while (0)
#define PG8_MMA(ai, bj, At, Bt) do { __builtin_amdgcn_s_setprio(1); _Pragma("unroll") for (int m = 0; m < 4; ++m) _Pragma("unroll") for (int n = 0; n < 2; ++n) _Pragma("unroll") for (int k = 0; k < 2; ++k) \
        acc[ai][bj][m][n] = __builtin_amdgcn_mfma_f32_16x16x32_bf16(Bt[n][k], At[m][k], acc[ai][bj][m][n], 0, 0, 0); __builtin_amdgcn_s_setprio(0); } while (0)
#define PG8_WAIT_V(n) asm volatile("s_waitcnt vmcnt(" #n ")" ::: "memory")
#define PG8_WAIT_L(n) asm volatile("s_waitcnt lgkmcnt(" #n ")" ::: "memory")
#define PG8_BAR __builtin_amdgcn_s_barrier()
#define PG8_SCHED __builtin_amdgcn_sched_barrier(0)
    Unit cur, nxt; int ui = 0;
    if (!S.next(0, cur)) return;
    f32x4 acc[2][2][4][2];
#pragma unroll
    for (int a = 0; a < 2; ++a)
#pragma unroll
        for (int b = 0; b < 2; ++b)
#pragma unroll
            for (int m = 0; m < 4; ++m)
#pragma unroll
                for (int n = 0; n < 2; ++n) acc[a][b][m][n] = (f32x4){0.f, 0.f, 0.f, 0.f};
    bf16x8 At[4][2], B0[2][2], B1[2][2];
    unsigned oA[2][2], nOA[2][2];
    S.aoff(cur, Rr, Cc, oA);
    const char* cA = cur.A; const char* cB = cur.B;
    PG8_STAGEB(PG8_SB(0, 0), cB); PG8_STAGEB(PG8_SB(0, 1), cB + hstepB); PG8_STAGE2(PG8_SA(0, 0), cA, oA[0][0], oA[0][1]); PG8_STAGE2(PG8_SA(0, 1), cA, oA[1][0], oA[1][1]);
    if (wr == 1) PG8_BAR;
    PG8_WAIT_V(2); PG8_BAR;
    PG8_STAGEB(PG8_SB(1, 0), cB + kstep); PG8_STAGE2(PG8_SA(1, 0), cA + kstep, oA[0][0], oA[0][1]); PG8_STAGEB(PG8_SB(1, 1), cB + hstepB + kstep);
    PG8_WAIT_V(6); PG8_BAR;
    for (;;) {
        const bool has_next = S.next(ui + 1, nxt);
        const char* nA = has_next ? nxt.A : cA; const char* nB = has_next ? nxt.B : cB;
        if (Sched::GATHER) { if (has_next) S.aoff(nxt, Rr, Cc, nOA); else {
#pragma unroll
            for (int h = 0; h < 2; ++h)
#pragma unroll
                for (int i = 0; i < 2; ++i) nOA[h][i] = oA[h][i]; }
            asm volatile("" : "+v"(nOA[0][0]), "+v"(nOA[0][1]), "+v"(nOA[1][0]), "+v"(nOA[1][1])); }
        for (int t = 0; t < nt; t += 2) {
            const bool last = (t == nt - 2);
            const char* a1 = cA + (size_t)(t + 1) * kstep;
            const char* a2 = last ? nA : cA + (size_t)(t + 2) * kstep; const char* b2 = last ? nB : cB + (size_t)(t + 2) * kstep;
            const char* a3 = a2 + kstep; const char* b3 = b2 + kstep;
            unsigned q00 = oA[0][0], q01 = oA[0][1], q10 = oA[1][0], q11 = oA[1][1];
            if (Sched::GATHER) { q00 = last ? nOA[0][0] : q00; q01 = last ? nOA[0][1] : q01; q10 = last ? nOA[1][0] : q10; q11 = last ? nOA[1][1] : q11; }
            PG8_LDB(B0, 0, 0); PG8_LDB(B1, 0, 1); PG8_SCHED; PG8_LDA(At, 0, 0); PG8_STAGE2(PG8_SA(1, 1), a1, oA[1][0], oA[1][1]);
            PG8_WAIT_V(8); PG8_WAIT_L(0); PG8_BAR; PG8_MMA(0, 0, At, B0); PG8_MMA(0, 1, At, B1); PG8_BAR; PG8_SCHED;
            PG8_LDA(At, 0, 1); PG8_STAGEB(PG8_SB(0, 0), b2); PG8_STAGEB(PG8_SB(0, 1), b2 + hstepB); PG8_STAGE2(PG8_SA(0, 0), a2, q00, q01);
            PG8_WAIT_V(8); PG8_WAIT_L(0); PG8_BAR; PG8_MMA(1, 0, At, B0); PG8_MMA(1, 1, At, B1); PG8_BAR; PG8_SCHED;
            PG8_LDB(B0, 1, 0); PG8_LDB(B1, 1, 1); PG8_SCHED; PG8_LDA(At, 1, 0); PG8_STAGE2(PG8_SA(0, 1), a2, q10, q11);
            PG8_WAIT_V(8); PG8_WAIT_L(0); PG8_BAR; PG8_MMA(0, 0, At, B0); PG8_MMA(0, 1, At, B1); PG8_BAR; PG8_SCHED;
            PG8_LDA(At, 1, 1); PG8_STAGEB(PG8_SB(1, 0), b3); PG8_STAGEB(PG8_SB(1, 1), b3 + hstepB); PG8_STAGE2(PG8_SA(1, 0), a3, q00, q01);
            PG8_WAIT_V(8); PG8_WAIT_L(0); PG8_BAR; PG8_MMA(1, 0, At, B0); PG8_MMA(1, 1, At, B1); PG8_BAR; PG8_SCHED;
        }
        if (wr == 0) PG8_BAR;
        E(acc, cur, wr, wc, fr, fq);
        if (!has_next) break;
#pragma unroll
        for (int a = 0; a < 2; ++a)
#pragma unroll
            for (int b = 0; b < 2; ++b)
#pragma unroll
                for (int m = 0; m < 4; ++m)
#pragma unroll
                    for (int n = 0; n < 2; ++n) acc[a][b][m][n] = (f32x4){0.f, 0.f, 0.f, 0.f};
        cur = nxt; cA = nA; cB = nB; ++ui;
        if (Sched::GATHER) {
#pragma unroll
            for (int h = 0; h < 2; ++h)
#pragma unroll
                for (int i = 0; i < 2; ++i) oA[h][i] = nOA[h][i]; }
        if (wr == 1) PG8_BAR;
    }
    PG8_WAIT_V(0);
    PG8_BAR;
#undef PG8_SA
#undef PG8_SB
#undef PG8_STAGE2
#undef PG8_STAGEB
#undef PG8_LDA
#undef PG8_LDB
#undef PG8_MMA
#undef PG8_WAIT_V
#undef PG8_WAIT_L
#undef PG8_BAR
#undef PG8_SCHED
}

typedef f32x4 Acc[2][2][4][2];

struct EpiBf16 {
    static constexpr bool PERM = true;
    bf16_t* O; int ldc; int ncols;
    __device__ __forceinline__ void operator()(const Acc& acc, const Unit& u, int wr, int wc, int fr, int fq) const {
        const int row0 = u.pm * BM + wr * 64 + fr, col0 = u.pn * BM + wc * 32 + 8 * fq;
#pragma unroll
        for (int ai = 0; ai < 2; ++ai)
#pragma unroll
            for (int m = 0; m < 4; ++m) { bf16_t* rowp = O + (size_t)(row0 + ai * HALF + m * 16) * ldc + col0;
#pragma unroll
                for (int bj = 0; bj < 2; ++bj) { if (col0 + bj * HALF < ncols) { const f32x4 v0 = acc[ai][bj][m][0], v1 = acc[ai][bj][m][1];
                    u32x4 w; w.x = cvt_pk_bf16(v0[0], v0[1]); w.y = cvt_pk_bf16(v0[2], v0[3]); w.z = cvt_pk_bf16(v1[0], v1[1]); w.w = cvt_pk_bf16(v1[2], v1[3]);
                    *(u32x4*)(rowp + bj * HALF) = w; } } }
    }
};
struct EpiFourT {
    static constexpr bool PERM = true;
    bf16_t* TT; bf16_t* TTC;
    __device__ __forceinline__ void operator()(const Acc& acc, const Unit& u, int wr, int wc, int fr, int fq) const {
        const int part = u.pm; const int ch0 = wr * 64 + fr; const int tok0 = u.pn * BM + wc * 32 + 8 * fq;
#pragma unroll
        for (int bj = 0; bj < 2; ++bj) { const int tok = tok0 + bj * HALF; bf16_t* base; int ldt;
            if (tok < TC) { const int b = tok >> 8, n = tok & 255; base = TTC + (size_t)b * 256 * 512 + part * 256 + n; ldt = 512; }
            else { const int tl = tok - TC, b = tl >> 12, n = tl & 4095; base = TT + (size_t)b * 256 * 8192 + part * 4096 + n; ldt = 8192; }
#pragma unroll
            for (int ai = 0; ai < 2; ++ai)
#pragma unroll
                for (int m = 0; m < 4; ++m) { const int ch = ch0 + ai * HALF + m * 16; const f32x4 v0 = acc[ai][bj][m][0], v1 = acc[ai][bj][m][1];
                    u32x4 w; w.x = cvt_pk_bf16(v0[0], v0[1]); w.y = cvt_pk_bf16(v0[2], v0[3]); w.z = cvt_pk_bf16(v1[0], v1[1]); w.w = cvt_pk_bf16(v1[2], v1[3]);
                    *(u32x4*)(base + (size_t)ch * ldt) = w; } }
    }
};
struct EpiRS {
    static constexpr bool PERM = true;
    bf16_t* O; const float* rs; int ldc, ncols;
    __device__ __forceinline__ void operator()(const Acc& acc, const Unit& u, int wr, int wc, int fr, int fq) const {
        const int row0 = u.pm * BM + wr * 64 + fr, col0 = u.pn * BM + wc * 32 + 8 * fq;
#pragma unroll
        for (int ai = 0; ai < 2; ++ai)
#pragma unroll
            for (int m = 0; m < 4; ++m) { const int row = row0 + ai * HALF + m * 16; const float s = rs[row]; bf16_t* rowp = O + (size_t)row * ldc + col0;
#pragma unroll
                for (int bj = 0; bj < 2; ++bj) { if (col0 + bj * HALF >= ncols) continue; const f32x4 v0 = acc[ai][bj][m][0] * s, v1 = acc[ai][bj][m][1] * s;
                    u32x4 w; w.x = cvt_pk_bf16(v0[0], v0[1]); w.y = cvt_pk_bf16(v0[2], v0[3]); w.z = cvt_pk_bf16(v1[0], v1[1]); w.w = cvt_pk_bf16(v1[2], v1[3]);
                    *(u32x4*)(rowp + bj * HALF) = w; } }
    }
};
struct EpiFourOut {
    static constexpr bool PERM = true;
    bf16_t* MIX; int rowbase, rows_per_b;
    __device__ __forceinline__ void operator()(const Acc& acc, const Unit& u, int wr, int wc, int fr, int fq) const {
        const int row0 = rowbase + u.e * rows_per_b + u.pm * BM + wr * 64 + fr, col0 = 768 + wc * 32 + 8 * fq;
#pragma unroll
        for (int ai = 0; ai < 2; ++ai)
#pragma unroll
            for (int m = 0; m < 4; ++m) { bf16_t* rowp = MIX + (size_t)(row0 + ai * HALF + m * 16) * D + col0;
#pragma unroll
                for (int bj = 0; bj < 2; ++bj) { const f32x4 v0 = acc[ai][bj][m][0], v1 = acc[ai][bj][m][1];
                    u32x4 w; w.x = cvt_pk_bf16(v0[0], v0[1]); w.y = cvt_pk_bf16(v0[2], v0[3]); w.z = cvt_pk_bf16(v1[0], v1[1]); w.w = cvt_pk_bf16(v1[2], v1[3]);
                    *(u32x4*)(rowp + bj * HALF) = w; } }
    }
};
struct EpiDual0 {
    static constexpr bool PERM = true;
    EpiBf16 e0; EpiFourT e1;
    __device__ __forceinline__ void operator()(const Acc& acc, const Unit& u, int wr, int wc, int fr, int fq) const { if (u.e == 0) e0(acc, u, wr, wc, fr, fq); else e1(acc, u, wr, wc, fr, fq); }
};
struct EpiResid {
    static constexpr bool PERM = false;
    const float* base_ctx; const float* base_lat; float* out_ctx; float* out_lat; const float* modv; int goff; int rowoff;
    __device__ __forceinline__ void operator()(const Acc& acc, const Unit& u, int wr, int wc, int fr, int fq) const {
        const int rt = rowoff + u.pm * BM;
        const bool isctx = rt < TC; const int mr = isctx ? 8 : ((rt - TC) >> 12);
        const float* base = isctx ? base_ctx + (size_t)rt * D : base_lat + (size_t)(rt - TC) * D;
        float* out = isctx ? out_ctx + (size_t)rt * D : out_lat + (size_t)(rt - TC) * D;
        const float* gv = modv + mr * 6144 + goff;
        const int r0 = wr * 64 + fr, col0 = u.pn * BM + wc * 32 + 4 * fq;
        f32x4 g[2][2];
#pragma unroll
        for (int bj = 0; bj < 2; ++bj)
#pragma unroll
            for (int n = 0; n < 2; ++n) g[bj][n] = *(const f32x4*)(gv + col0 + bj * HALF + n * 16);
#pragma unroll
        for (int ai = 0; ai < 2; ++ai) {
            f32x4 bs[4][2][2];
#pragma unroll
            for (int m = 0; m < 4; ++m) { const size_t off = (size_t)(r0 + ai * HALF + m * 16) * D + col0;
#pragma unroll
                for (int bj = 0; bj < 2; ++bj)
#pragma unroll
                    for (int n = 0; n < 2; ++n) bs[m][bj][n] = *(const f32x4*)(base + off + bj * HALF + n * 16); }
#pragma unroll
            for (int m = 0; m < 4; ++m) { const size_t off = (size_t)(r0 + ai * HALF + m * 16) * D + col0;
#pragma unroll
                for (int bj = 0; bj < 2; ++bj)
#pragma unroll
                    for (int n = 0; n < 2; ++n) *(f32x4*)(out + off + bj * HALF + n * 16) = bs[m][bj][n] + g[bj][n] * acc[ai][bj][m][n]; }
            asm volatile("" ::: "memory"); }
    }
};
struct EpiGateBf16 {
    static constexpr bool PERM = true; static constexpr int NSTORE = 16;
    bf16_t* Y; const float* modv; int goff, rowoff, ybase;
    __device__ __forceinline__ void operator()(const Acc& acc, const Unit& u, int wr, int wc, int fr, int fq) const {
        const int rt = rowoff + u.pm * BM; const int mr = rt < TC ? 8 : ((rt - TC) >> 12);
        const float* gv = modv + mr * 6144 + goff; const int col0 = u.pn * BM + wc * 32 + 8 * fq;
        f32x4 g[2][2];
#pragma unroll
        for (int bj = 0; bj < 2; ++bj)
#pragma unroll
            for (int n = 0; n < 2; ++n) g[bj][n] = *(const f32x4*)(gv + col0 + bj * HALF + 4 * n);
        bf16_t* yb = Y + (size_t)(rt - ybase + wr * 64 + fr) * D + col0;
#pragma unroll
        for (int ai = 0; ai < 2; ++ai)
#pragma unroll
            for (int m = 0; m < 4; ++m) { bf16_t* rowp = yb + (size_t)(ai * HALF + m * 16) * D;
#pragma unroll
                for (int bj = 0; bj < 2; ++bj) { const f32x4 v0 = acc[ai][bj][m][0] * g[bj][0], v1 = acc[ai][bj][m][1] * g[bj][1];
                    u32x4 w; w.x = cvt_pk_bf16(v0[0], v0[1]); w.y = cvt_pk_bf16(v0[2], v0[3]); w.z = cvt_pk_bf16(v1[0], v1[1]); w.w = cvt_pk_bf16(v1[2], v1[3]);
                    *(u32x4*)(rowp + bj * HALF) = w; } }
    }
};
struct EpiSwiglu {
    static constexpr bool PERM = true;
    bf16_t* ACT; const float* bgu;
    __device__ __forceinline__ void operator()(const Acc& acc, const Unit& u, int wr, int wc, int fr, int fq) const {
        const int row0 = u.pm * BM + wr * 64 + fr, a0 = u.pn * HALF + wc * 32 + 8 * fq;
        const float* bp = bgu + (size_t)u.e * 2048 + 2 * a0;
        float bg[8], bl[8];
#pragma unroll
        for (int q = 0; q < 4; ++q) { const f32x4 t = *(const f32x4*)(bp + 4 * q); bg[2 * q] = t[0]; bl[2 * q] = t[1]; bg[2 * q + 1] = t[2]; bl[2 * q + 1] = t[3]; }
#pragma unroll
        for (int ai = 0; ai < 2; ++ai)
#pragma unroll
            for (int m = 0; m < 4; ++m) { float o[8];
#pragma unroll
                for (int j = 0; j < 8; ++j) { float xg = acc[ai][0][m][j >> 2][j & 3] + bg[j], xl = acc[ai][1][m][j >> 2][j & 3] + bl[j];
                    xg = fminf(xg, 7.0f); xl = fminf(fmaxf(xl, -7.0f), 7.0f);
                    o[j] = xg * __builtin_amdgcn_rcpf(1.0f + __builtin_amdgcn_exp2f(xg * (-1.702f * 1.4426950408889634f))) * (xl + 1.0f); }
                u32x4 w; w.x = cvt_pk_bf16(o[0], o[1]); w.y = cvt_pk_bf16(o[2], o[3]); w.z = cvt_pk_bf16(o[4], o[5]); w.w = cvt_pk_bf16(o[6], o[7]);
                *(u32x4*)(ACT + (size_t)(row0 + ai * HALF + m * 16) * FF + a0) = w; }
    }
};
struct EpiDown {
    static constexpr bool PERM = true;
    bf16_t* YB; const float* bdn;
    __device__ __forceinline__ void operator()(const Acc& acc, const Unit& u, int wr, int wc, int fr, int fq) const {
        const int row0 = u.pm * BM + wr * 64 + fr, col0 = u.pn * BM + wc * 32 + 8 * fq;
        f32x4 bv[2][2];
#pragma unroll
        for (int bj = 0; bj < 2; ++bj)
#pragma unroll
            for (int n = 0; n < 2; ++n) bv[bj][n] = *(const f32x4*)(bdn + (size_t)u.e * D + col0 + bj * HALF + 4 * n);
#pragma unroll
        for (int ai = 0; ai < 2; ++ai)
#pragma unroll
            for (int m = 0; m < 4; ++m) { bf16_t* rowp = YB + (size_t)(row0 + ai * HALF + m * 16) * D + col0;
#pragma unroll
                for (int bj = 0; bj < 2; ++bj) { const f32x4 v0 = acc[ai][bj][m][0] + bv[bj][0], v1 = acc[ai][bj][m][1] + bv[bj][1];
                    u32x4 w; w.x = cvt_pk_bf16(v0[0], v0[1]); w.y = cvt_pk_bf16(v0[2], v0[3]); w.z = cvt_pk_bf16(v1[0], v1[1]); w.w = cvt_pk_bf16(v1[2], v1[3]);
                    *(u32x4*)(rowp + bj * HALF) = w; } }
    }
};
}

struct Args { const float* in[38]; float* out; unsigned char* ws; int ph_lo, ph_hi; };
enum { I_X = 0, I_C, I_CTX, I_CCTX, I_FNG,
       I0_MODW, I0_MODB, I0_N1G, I0_WIN, I0_QNG, I0_WQUP, I0_KVNG, I0_WKVUP, I0_WOUT, I0_N2G, I0_RW, I0_RB, I0_WGU, I0_BGU, I0_WDN, I0_BDN,
       I1_MODW, I1_MODB, I1_N1G, I1_WIN, I1_WGKF, I1_BGKF, I1_WGKB, I1_BGKB, I1_GNG, I1_WOUT, I1_N2G, I1_RW, I1_RB, I1_WGU, I1_BGU, I1_WDN, I1_BDN };

struct Frame {
    const float* const* in; float* out; unsigned char* ws; LAS unsigned char* lds; LAS unsigned char* ring;
    int tid, lane, wave, G, bid;
};
#define WSP(T_, off) ((T_*)(F.ws + (off)))

__device__ __forceinline__ int gu_row(int n) { const int a = n >> 1, half = n & 1; return 256 * (a >> 7) + 128 * half + (a & 127); }
template <int MODE>
__device__ __forceinline__ void cvt_tile(const Frame& F, LAS bf16_t* tile  , const float* src, int ldsrc, int k0, int n0, bf16_t* dst, int ldd, const float* sk, float mul) {
    const int t = F.tid;
    { const int kl = t >> 3, nc = (t & 7) * 8; const float* p = src + (size_t)(k0 + kl) * ldsrc + n0 + nc;
      const f32x4 a = *(const f32x4*)p, b = *(const f32x4*)(p + 4); const float s = (sk ? sk[k0 + kl] : 1.0f) * mul;
      tile[(nc + 0) * 72 + kl] = f2bf(a[0] * s); tile[(nc + 1) * 72 + kl] = f2bf(a[1] * s); tile[(nc + 2) * 72 + kl] = f2bf(a[2] * s); tile[(nc + 3) * 72 + kl] = f2bf(a[3] * s);
      tile[(nc + 4) * 72 + kl] = f2bf(b[0] * s); tile[(nc + 5) * 72 + kl] = f2bf(b[1] * s); tile[(nc + 6) * 72 + kl] = f2bf(b[2] * s); tile[(nc + 7) * 72 + kl] = f2bf(b[3] * s); }
    __syncthreads();
    { const int nl = t >> 3, kc = (t & 7) * 8; const int n = n0 + nl; const int row = MODE == 1 ? gu_row(n) : n;
      const u32x4 v = *(const LAS u32x4*)(tile + nl * 72 + kc); *(u32x4*)(dst + (size_t)row * ldd + k0 + kc) = v; }
    __syncthreads();
}
template <int MODE>
__device__ __forceinline__ void cvt_blk(const Frame& F, LAS float* tl, const float* src, int ldsrc, int k0, int n0, bf16_t* dst, int ldd) {
    const int t = F.tid, w = t >> 6, l = t & 63;
    f32x4 v[8];
#pragma unroll
    for (int i = 0; i < 8; ++i) v[i] = *(const f32x4*)(src + (size_t)(k0 + w + 8 * i) * ldsrc + n0 + 4 * l);
#pragma unroll
    for (int i = 0; i < 8; ++i) *(LAS f32x4*)(tl + (w + 8 * i) * 260 + 4 * l) = v[i];
    __syncthreads();
    { const int n = t & 255, kh = t >> 8; const int row = MODE == 1 ? gu_row(n0 + n) : n0 + n; bf16_t* dp = dst + (size_t)row * ldd + k0 + kh * 32;
#pragma unroll
      for (int q = 0; q < 4; ++q) { float x[8];
#pragma unroll
          for (int j = 0; j < 8; ++j) x[j] = tl[(kh * 32 + 8 * q + j) * 260 + n];
          u32x4 o; o.x = cvt_pk_bf16(x[0], x[1]); o.y = cvt_pk_bf16(x[2], x[3]); o.z = cvt_pk_bf16(x[4], x[5]); o.w = cvt_pk_bf16(x[6], x[7]);
          *(u32x4*)(dp + 8 * q) = o; } }
    __syncthreads();
}
constexpr int CVT_NGU = NE * 16 * 8, CVT_NDN = NE * 16 * 4, CVT_JOBS = CVT_NGU + CVT_NDN;
__device__ __forceinline__ void cvt_moe_job(const Frame& F, LAS float* tl, const float* wgu, const float* wdn, int j) {
    bf16_t* WGU = WSP(bf16_t, WS_WGU); bf16_t* WDN = WSP(bf16_t, WS_WDN);
    if (j < CVT_NGU) { const int e = j >> 7, r = j & 127, kt = r >> 3, ntl = r & 7; cvt_blk<1>(F, tl, wgu + (size_t)e * 1024 * 2048, 2048, kt * 64, ntl * 256, WGU + (size_t)e * 2048 * 1024, 1024); }
    else { const int jj = j - CVT_NGU, e = jj >> 6, r = jj & 63, kt = r >> 2, ntl = r & 3; cvt_blk<0>(F, tl, wdn + (size_t)e * 1024 * 1024, 1024, kt * 64, ntl * 256, WDN + (size_t)e * 1024 * 1024, 1024); }
}
__device__ __forceinline__ void cvt_moe_weights(const Frame& F, LAS float* tl, const float* wgu, const float* wdn) {
    for (int j = F.bid; j < CVT_JOBS; j += F.G) cvt_moe_job(F, tl, wgu, wdn, j);
}
__device__ __forceinline__ void ph_prologue(const Frame& F) {
    LAS float* sc = (LAS float*)(F.ring);
    LAS float* red = (LAS float*)(F.ring + 36864);
    LAS float* ctab = (LAS float*)(F.ring + 55296);
    LAS float* stab = ctab + 4096;
    LAS bf16_t* tile = (LAS bf16_t*)(F.ring + 88064);
    LAS float* wt = (LAS float*)(F.ring + 97280);
    const int t = F.tid;
    for (int i = t; i < 9 * 1024; i += NTHR) { const int r = i >> 10, k = i & 1023; const float v = (r < 8) ? F.in[I_C][r * 1024 + k] : F.in[I_CCTX][k]; sc[i] = siluf(v); }
    for (int i = t; i < 4096; i += NTHR) { const float x = (float)i * (1.0f / 2048.0f); ctab[i] = cospif(x); stab[i] = sinpif(x); }
    __syncthreads();
    for (int u = F.bid; u < 2 * 96; u += F.G) {
        const int l = u / 96, j0 = (u % 96) * 64; const float* W = l ? F.in[I1_MODW] : F.in[I0_MODW]; const float* Bv = l ? F.in[I1_MODB] : F.in[I0_MODB];
        const int c4 = t & 15, kb = F.wave * 128 + ((t >> 4) & 3) * 32; f32x4 a[9];
#pragma unroll
        for (int r = 0; r < 9; ++r) a[r] = (f32x4){0.f, 0.f, 0.f, 0.f};
#pragma unroll 8
        for (int q = 0; q < 32; ++q) { const f32x4 w = *(const f32x4*)(W + (size_t)(kb + q) * 6144 + j0 + 4 * c4);
#pragma unroll
            for (int r = 0; r < 9; ++r) a[r] += w * sc[r * 1024 + kb + q]; }
#pragma unroll
        for (int r = 0; r < 9; ++r) {
#pragma unroll
            for (int j = 0; j < 4; ++j) { float v = a[r][j]; v += __shfl_xor(v, 16); v += __shfl_xor(v, 32); a[r][j] = v; }
            if ((t & 48) == 0) *(LAS f32x4*)(red + (F.wave * 9 + r) * 64 + 4 * c4) = a[r]; }
        __syncthreads();
        for (int i = t; i < 576; i += NTHR) { const int r = i >> 6, c = i & 63; float s = 0.f;
#pragma unroll
            for (int q = 0; q < 8; ++q) s += red[(q * 9 + r) * 64 + c];
            WSP(float, WS_MODV)[(size_t)(l * 9 + r) * 6144 + j0 + c] = s + Bv[j0 + c]; }
        __syncthreads();
    }
    if (F.bid == (1 % F.G)) { for (int i = t; i < 1024; i += NTHR) { const int pos = i >> 4, j = i & 15; const float inv = powf(10000.0f, -(float)j / 16.0f); const float ang = (float)pos * inv;
        WSP(float, WS_ROPE)[i] = cosf(ang); WSP(float, WS_ROPE)[1024 + i] = sinf(ang); } }
    { bf16_t* DFT = WSP(bf16_t, R0_DFT); bf16_t* DFTC = WSP(bf16_t, R0_DFTC);
      for (int k = F.bid; k < 4096 + 256; k += F.G) {
          if (k < 4096) { for (int jc = t; jc < 512; jc += NTHR) { const int j0 = jc * 8; float v[8];
#pragma unroll
                  for (int q = 0; q < 8; ++q) { const int j = j0 + q; const bool isS = j > 2048; const int idx = (k * (isS ? j - 2048 : j)) & 4095; v[q] = (isS ? stab[idx] : ctab[idx]) * (1.0f / 512.0f); }
                  u32x4 w; w.x = pk2(v[0], v[1]); w.y = pk2(v[2], v[3]); w.z = pk2(v[4], v[5]); w.w = pk2(v[6], v[7]); *(u32x4*)(DFT + (size_t)k * 4096 + j0) = w; } }
          else { const int kk = k - 4096; for (int jc = t; jc < 32; jc += NTHR) { const int j0 = jc * 8; float v[8];
#pragma unroll
                  for (int q = 0; q < 8; ++q) { const int j = j0 + q; const bool isS = j > 128; const int idx = ((kk * (isS ? j - 128 : j)) & 255) * 16; v[q] = (isS ? stab[idx] : ctab[idx]) * (1.0f / 128.0f); }
                  u32x4 w; w.x = pk2(v[0], v[1]); w.y = pk2(v[2], v[3]); w.z = pk2(v[4], v[5]); w.w = pk2(v[6], v[7]); *(u32x4*)(DFTC + (size_t)kk * 256 + j0) = w; } }
      } }
    { bf16_t* WF = WSP(bf16_t, WS_WF); const float* Win = F.in[I0_WIN];
      for (int j = (F.bid + 64) % F.G; j < 64; j += F.G) { const int k0 = (j >> 2) * 64, g = j & 3;
          for (int i = t; i < 4096; i += NTHR) { const int kl = i >> 6, c = i & 63; wt[kl * 65 + c] = Win[(size_t)(k0 + kl) * 960 + 704 + g * 64 + c]; }
          __syncthreads();
          { const int kl = t & 63, mg = t >> 6;
#pragma unroll 1
            for (int mm = 0; mm < 8; ++mm) { const int m = mg * 8 + mm; float ac = 0.f, as = 0.f;
                for (int c = 0; c < 64; ++c) { const int idx = ((m * c) & 63) * 64; const float w = wt[kl * 65 + c]; ac = fmaf(w, ctab[idx], ac); as = fmaf(w, stab[idx], as); }
                WF[(size_t)(g * 64 + m) * 1024 + k0 + kl] = f2bf(ac); WF[(size_t)(256 + g * 64 + m) * 1024 + k0 + kl] = f2bf(-as); } }
          __syncthreads(); } }
    {
      constexpr int J_WIN0 = 16 * 11, J_WQ = 6 * 18, J_WKV = 4 * 24, J_WO = 16 * 16, J_WIN1 = 16 * 48;
      constexpr int JT = J_WIN0 + J_WQ + J_WKV + 2 * J_WO + J_WIN1;
      for (int j = F.bid; j < JT; j += F.G) { int r = j;
          if (r < J_WIN0) { cvt_tile<0>(F, tile, F.in[I0_WIN], 960, (r / 11) * 64, (r % 11) * 64, WSP(bf16_t, WS_WIN0), 1024, nullptr, 1.0f); continue; } r -= J_WIN0;
          if (r < J_WQ) { cvt_tile<0>(F, tile, F.in[I0_WQUP], 1152, (r / 18) * 64, (r % 18) * 64, WSP(bf16_t, WS_WQ), QL, F.in[I0_QNG], 1.0f); continue; } r -= J_WQ;
          if (r < J_WKV) { cvt_tile<0>(F, tile, F.in[I0_WKVUP], 1536, (r / 24) * 64, (r % 24) * 64, WSP(bf16_t, WS_WKV), KVL, F.in[I0_KVNG], 1.0f); continue; } r -= J_WKV;
          if (r < J_WO) { cvt_tile<0>(F, tile, F.in[I0_WOUT], 1024, (r / 16) * 64, (r % 16) * 64, WSP(bf16_t, WS_WOUT0), 1024, nullptr, 1.0f); continue; } r -= J_WO;
          if (r < J_WO) { cvt_tile<0>(F, tile, F.in[I1_WOUT], 1024, (r / 16) * 64, (r % 16) * 64, WSP(bf16_t, WS_WOUT1), 1024, nullptr, 1.0f); continue; } r -= J_WO;
          { const int n0 = (r % 48) * 64; cvt_tile<0>(F, tile, F.in[I1_WIN], 3104, (r / 48) * 64, n0, WSP(bf16_t, WS_WIN1), 1024, nullptr, n0 < 512 ? 0.08838834764831845f : 1.0f); }
      }
      for (int i = F.bid * NTHR + t; i < (64 * 1024 + 128 * QL) / 8; i += F.G * NTHR) { const u32x4 z = {0u, 0u, 0u, 0u};
          if (i < 64 * 1024 / 8) *(u32x4*)(WSP(bf16_t, WS_WIN0) + (size_t)704 * 1024 + (size_t)i * 8) = z; else *(u32x4*)(WSP(bf16_t, WS_WQ) + (size_t)1152 * QL + (size_t)(i - 64 * 1024 / 8) * 8) = z; }
    }
}

__device__ __forceinline__ const float* xrow_in(const Frame& F, int r) { return r < TC ? F.in[I_CTX] + (size_t)r * D : F.in[I_X] + (size_t)(r - TC) * D; }
__device__ __forceinline__ float* xrow_res(const Frame& F, int r) { return r < TC ? WSP(float, WS_XCTX) + (size_t)r * D : F.out + (size_t)(r - TC) * D; }
__device__ __forceinline__ int modrow(int r) { return r < TC ? 8 : ((r - TC) >> 12); }
__device__ __forceinline__ void ld16f(const float* p, int lane, float (&v)[16]) {
#pragma unroll
    for (int h = 0; h < 2; ++h) { const f32x4 a = *(const f32x4*)(p + 8 * lane + 512 * h), b = *(const f32x4*)(p + 8 * lane + 512 * h + 4);
        v[8 * h] = a[0]; v[8 * h + 1] = a[1]; v[8 * h + 2] = a[2]; v[8 * h + 3] = a[3]; v[8 * h + 4] = b[0]; v[8 * h + 5] = b[1]; v[8 * h + 6] = b[2]; v[8 * h + 7] = b[3]; }
}
__device__ __forceinline__ void st16f(float* p, int lane, const float (&v)[16]) {
#pragma unroll
    for (int h = 0; h < 2; ++h) { *(f32x4*)(p + 8 * lane + 512 * h) = (f32x4){v[8 * h], v[8 * h + 1], v[8 * h + 2], v[8 * h + 3]}; *(f32x4*)(p + 8 * lane + 512 * h + 4) = (f32x4){v[8 * h + 4], v[8 * h + 5], v[8 * h + 6], v[8 * h + 7]}; }
}
__device__ __forceinline__ void ld16b(const bf16_t* p, int lane, float (&v)[16]) {
#pragma unroll
    for (int h = 0; h < 2; ++h) { const u32x4 w = *(const u32x4*)(p + 8 * lane + 512 * h);
#pragma unroll
        for (int q = 0; q < 4; ++q) { v[8 * h + 2 * q] = __uint_as_float(w[q] << 16); v[8 * h + 2 * q + 1] = __uint_as_float(w[q] & 0xffff0000u); } }
}
__device__ __forceinline__ void st16b(bf16_t* p, int lane, const float (&v)[16]) {
#pragma unroll
    for (int h = 0; h < 2; ++h) { u32x4 w; w.x = cvt_pk_bf16(v[8 * h], v[8 * h + 1]); w.y = cvt_pk_bf16(v[8 * h + 2], v[8 * h + 3]); w.z = cvt_pk_bf16(v[8 * h + 4], v[8 * h + 5]); w.w = cvt_pk_bf16(v[8 * h + 6], v[8 * h + 7]);
        *(u32x4*)(p + 8 * lane + 512 * h) = w; }
}
__device__ __forceinline__ void modulate16(float (&v)[16], const float* g, const float* scale, const float* shift, int lane) {
    float ss = 0.f;
#pragma unroll
    for (int i = 0; i < 16; ++i) ss = fmaf(v[i], v[i], ss);
    const float rs = rsqrtf(wsum(ss) * (1.0f / D) + EPS);
    float gg[16], sc[16], sh[16]; ld16f(g, lane, gg); ld16f(scale, lane, sc); ld16f(shift, lane, sh);
#pragma unroll
    for (int i = 0; i < 16; ++i) v[i] = v[i] * rs * gg[i] * (1.0f + sc[i]) + sh[i];
}

__device__ __forceinline__ void ph_mod0(const Frame& F) {
    const float* g = F.in[I0_N1G]; bf16_t* H = WSP(bf16_t, WS_H);
    for (int r = F.bid * NWAVE + F.wave; r < T; r += F.G * NWAVE) {
        const float* mv = WSP(float, WS_MODV) + (size_t)modrow(r) * 6144;
        float v[16]; ld16f(xrow_in(F, r), F.lane, v);
        modulate16(v, g, mv + 1024, mv, F.lane);
        st16b(H + (size_t)r * D, F.lane, v);
    }
}
__device__ __forceinline__ void ph_rowstats(const Frame& F) {
    const bf16_t* U0 = WSP(bf16_t, R0_U0); float* rsq = WSP(float, WS_RS); float* rskv = rsq + T; bf16_t* KR = WSP(bf16_t, R0_KR);
    const float* rc = WSP(float, WS_ROPE); const float* rsn = rc + 1024;
    for (int r = F.bid * NWAVE + F.wave; r < T; r += F.G * NWAVE) {
        const bf16_t* u = U0 + (size_t)r * U0W; const int lane = F.lane;
        float a[8], b[8];
        { const u32x4 w = *(const u32x4*)(u + 8 * lane);
#pragma unroll
          for (int q = 0; q < 4; ++q) { a[2 * q] = __uint_as_float(w[q] << 16); a[2 * q + 1] = __uint_as_float(w[q] & 0xffff0000u); } }
        { u32x4 w = {0u, 0u, 0u, 0u}; if (lane < 32) w = *(const u32x4*)(u + 512 + 8 * lane);
#pragma unroll
          for (int q = 0; q < 4; ++q) { b[2 * q] = __uint_as_float(w[q] << 16); b[2 * q + 1] = __uint_as_float(w[q] & 0xffff0000u); } }
        float sa = 0.f, sb = 0.f;
#pragma unroll
        for (int j = 0; j < 8; ++j) { sa = fmaf(a[j], a[j], sa); sb = fmaf(b[j], b[j], sb); }
        const float sq = wsum(lane < 48 ? sa : 0.f), skv = wsum((lane >= 48 ? sa : 0.f) + (lane < 16 ? sb : 0.f));
        float pr[8];
#pragma unroll
        for (int j = 0; j < 8; ++j) pr[j] = __shfl_xor(b[j], 2);
        if (lane >= 16 && lane < 24) { const int jq = lane - 16, quarter = jq >> 1;
            if (r >= TC) { const int n = (r - TC) & 4095; const int pos = (quarter >= 2) ? (n & 63) : (n >> 6); const float* cp = rc + pos * 16 + (jq & 1) * 8; const float* sp = rsn + pos * 16 + (jq & 1) * 8;
#pragma unroll
                for (int j = 0; j < 8; ++j) b[j] = (quarter & 1) ? (b[j] * cp[j] + pr[j] * sp[j]) : (b[j] * cp[j] - pr[j] * sp[j]); }
            u32x4 w; w.x = cvt_pk_bf16(b[0], b[1]); w.y = cvt_pk_bf16(b[2], b[3]); w.z = cvt_pk_bf16(b[4], b[5]); w.w = cvt_pk_bf16(b[6], b[7]);
            *(u32x4*)(KR + (size_t)r * ROPE + 8 * jq) = w; }
        if (lane == 0) { rsq[r] = rsqrtf(sq * (1.0f / QL) + EPS); rskv[r] = rsqrtf(skv * (1.0f / KVL) + EPS); }
    }
    { const bf16_t* TT = WSP(bf16_t, R0_TT); const bf16_t* TTC = WSP(bf16_t, R0_TTC); bf16_t* TT2 = WSP(bf16_t, R0_TT2); bf16_t* TTC2 = WSP(bf16_t, R0_TTC2);
      const int nch_l = NB * 256 * 512, nch_c = NB * 256 * 32;
      for (int i = F.bid * NTHR + F.tid; i < nch_l + nch_c; i += F.G * NTHR) {
          const bool lat = i < nch_l; const int ii = lat ? i : i - nch_l; const int N = lat ? 4096 : 256; const int cpr = N >> 3; const int row = ii / cpr, p0 = (ii % cpr) * 8;
          const bf16_t* src = (lat ? TT : TTC) + (size_t)row * 2 * N; bf16_t* dst = (lat ? TT2 : TTC2) + (size_t)row * N + p0; float v[8];
#pragma unroll
          for (int q = 0; q < 8; ++q) { const int pp = p0 + q; const bool cs = pp <= (N >> 1); const int j = cs ? pp : pp - (N >> 1); const bf16_t* X = cs ? src : src + N;
              const float a = bf2f(X[j]); const float bmir = (j == 0 || j == (N >> 1)) ? 0.f : bf2f(X[N - j]); v[q] = cs ? a + bmir : a - bmir; }
          u32x4 w; w.x = pk2(v[0], v[1]); w.y = pk2(v[2], v[3]); w.z = pk2(v[4], v[5]); w.w = pk2(v[6], v[7]); *(u32x4*)dst = w; }
    }
}

namespace att {
typedef float f32x16 __attribute__((ext_vector_type(16)));
typedef short s16x4 __attribute__((ext_vector_type(4)));
constexpr float SCALE = 0.07216878364870322f, THR = 8.f;
constexpr int SHM_V = 16384, SHM_KN = 64 * 272, SHM_KR = 64 * 144, SHM_QW = 32 * 272;
constexpr int OFF_V = 0, OFF_KN = 2 * SHM_V, OFF_KR = OFF_KN + 2 * SHM_KN, OFF_WS = OFF_KR + 2 * SHM_KR, OFF_QR = OFF_WS + 2048;
#define KNSWZ(row, cb) ((row) * 272 + (cb))
#define KRSWZ(row, cb) ((row) * 144 + (cb))
#define SBAR() __builtin_amdgcn_sched_barrier(0)
__device__ __forceinline__ int crow(int r, int hi) { return (r & 3) + 8 * (r >> 2) + 4 * hi; }
__device__ __forceinline__ void partialSM(f32x16& p0, f32x16& p1, float& m_reg, float& mn, float& alpha) {
  constexpr float C = SCALE * 1.4426950408889634f;
  float pmax = p0[0];
#pragma unroll
  for (int r = 1; r < 16; ++r) pmax = fmaxf(pmax, p0[r]);
#pragma unroll
  for (int r = 0; r < 16; ++r) pmax = fmaxf(pmax, p1[r]);
  { auto rr = __builtin_amdgcn_permlane32_swap(__float_as_uint(pmax), __float_as_uint(pmax), false, false);
    pmax = fmaxf(__uint_as_float(rr[0]), __uint_as_float(rr[1])); }
  if (__builtin_expect(__all(pmax - m_reg <= THR / SCALE), 1)) { mn = m_reg; alpha = 1.f; }
  else { mn = fmaxf(m_reg, pmax); alpha = __builtin_amdgcn_exp2f((m_reg - mn) * C); m_reg = mn; }
  const float mnC = -mn * C;
#pragma unroll
  for (int r = 0; r < 16; ++r) p0[r] = fmaf(p0[r], C, mnC);
#pragma unroll
  for (int r = 0; r < 16; ++r) p1[r] = fmaf(p1[r], C, mnC);
#pragma unroll
  for (int r = 0; r < 16; ++r) p0[r] = __builtin_amdgcn_exp2f(p0[r]);
}
__device__ __forceinline__ void finishSM(f32x16& p0, f32x16& p1, float alpha, float& l_reg, bf16x8& pa0, bf16x8& pa1, bf16x8& pa2, bf16x8& pa3) {
#pragma unroll
  for (int r = 0; r < 16; ++r) p1[r] = __builtin_amdgcn_exp2f(p1[r]);
  float ps = 0;
#pragma unroll
  for (int r = 0; r < 16; ++r) ps += p0[r];
#pragma unroll
  for (int r = 0; r < 16; ++r) ps += p1[r];
  { auto rr = __builtin_amdgcn_permlane32_swap(__float_as_uint(ps), __float_as_uint(ps), false, false);
    ps = __uint_as_float(rr[0]) + __uint_as_float(rr[1]); }
  l_reg = l_reg * alpha + ps;
#define PK4(P, BASE, OUT) do { unsigned a0 = cvt_pk_bf16(P[BASE + 0], P[BASE + 1]), a1 = cvt_pk_bf16(P[BASE + 2], P[BASE + 3]);   \
    unsigned b0 = cvt_pk_bf16(P[BASE + 4], P[BASE + 5]), b1 = cvt_pk_bf16(P[BASE + 6], P[BASE + 7]);                              \
    auto r0 = __builtin_amdgcn_permlane32_swap(a0, b0, false, false); auto r1 = __builtin_amdgcn_permlane32_swap(a1, b1, false, false); \
    u32x4 w = {r0[0], r1[0], r0[1], r1[1]}; OUT = *reinterpret_cast<bf16x8*>(&w); } while (0)
  PK4(p0, 0, pa0); PK4(p0, 8, pa1); PK4(p1, 0, pa2); PK4(p1, 8, pa3);
#undef PK4
}
__device__ __forceinline__ void qkt(f32x16& p0, f32x16& p1, const LAS char* Kn, const LAS char* Kr, const bf16x8 (&qr)[4], const LAS char* Qr, int r32, int hi) {
  p0 = f32x16{}; p1 = f32x16{};
#pragma unroll
  for (int d0 = 0; d0 < 8; ++d0) { const int cb = (d0 * 16 + hi * 8) * 2;
    const bf16x8 b0 = *(const LAS bf16x8*)(Kn + KNSWZ(r32, cb));
    const bf16x8 b1 = *(const LAS bf16x8*)(Kn + KNSWZ(32 + r32, cb));
    bf16x8 qq; if (d0 < 4) qq = qr[d0]; else qq = *(const LAS bf16x8*)(Qr + KNSWZ(r32, ((d0 - 4) * 16 + hi * 8) * 2));
    p0 = __builtin_amdgcn_mfma_f32_32x32x16_bf16(b0, qq, p0, 0, 0, 0);
    p1 = __builtin_amdgcn_mfma_f32_32x32x16_bf16(b1, qq, p1, 0, 0, 0); }
#pragma unroll
  for (int d0 = 0; d0 < 4; ++d0) { const int cb = (d0 * 16 + hi * 8) * 2;
    const bf16x8 b0 = *(const LAS bf16x8*)(Kr + KRSWZ(r32, cb));
    const bf16x8 b1 = *(const LAS bf16x8*)(Kr + KRSWZ(32 + r32, cb));
    const bf16x8 qq = *(const LAS bf16x8*)(Qr + KNSWZ(r32, ((4 + d0) * 16 + hi * 8) * 2));
    p0 = __builtin_amdgcn_mfma_f32_32x32x16_bf16(b0, qq, p0, 0, 0, 0);
    p1 = __builtin_amdgcn_mfma_f32_32x32x16_bf16(b1, qq, p1, 0, 0, 0); }
}
__device__ __forceinline__ int v_st(int k, int c) { const int kk = (k & ~0xC) | ((k & 4) << 1) | ((k & 8) >> 1); return ((kk >> 3) * 4 + (c >> 5)) * 512 + ((kk & 7) * 32 + (c & 31)) * 2; }
__device__ __forceinline__ int v_rd_base(int lane) { return ((lane & 3) << 3) | (((lane >> 2) & 3) << 6) | (((lane >> 4) & 1) << 5) | (((lane >> 5) & 1) << 8); }
constexpr int v_rd_off(int d0, int ks, int half) { return d0 * 512 + ks * 4096 + half * 2048; }
template <int OFF> __device__ __forceinline__ s16x4 tr_read(int vb) {
  s16x4 r; asm volatile("ds_read_b64_tr_b16 %0, %1 offset:%2" : "=&v"(r) : "v"(vb), "i"(OFF) : "memory"); return r;
}
template <int D0> __device__ __forceinline__ void pv_one(f32x16& od, int vb, bf16x8 pa0, bf16x8 pa1, bf16x8 pa2, bf16x8 pa3) {
  const s16x4 l0 = tr_read<v_rd_off(D0, 0, 0)>(vb), h0 = tr_read<v_rd_off(D0, 0, 1)>(vb), l1 = tr_read<v_rd_off(D0, 1, 0)>(vb), h1 = tr_read<v_rd_off(D0, 1, 1)>(vb);
  const s16x4 l2 = tr_read<v_rd_off(D0, 2, 0)>(vb), h2 = tr_read<v_rd_off(D0, 2, 1)>(vb), l3 = tr_read<v_rd_off(D0, 3, 0)>(vb), h3 = tr_read<v_rd_off(D0, 3, 1)>(vb);
  asm volatile("s_waitcnt lgkmcnt(0)" ::: "memory"); SBAR();
#define PK(L, H) (bf16x8){L[0], L[1], L[2], L[3], H[0], H[1], H[2], H[3]}
  od = __builtin_amdgcn_mfma_f32_32x32x16_bf16(pa0, PK(l0, h0), od, 0, 0, 0);
  od = __builtin_amdgcn_mfma_f32_32x32x16_bf16(pa1, PK(l1, h1), od, 0, 0, 0);
  od = __builtin_amdgcn_mfma_f32_32x32x16_bf16(pa2, PK(l2, h2), od, 0, 0, 0);
  od = __builtin_amdgcn_mfma_f32_32x32x16_bf16(pa3, PK(l3, h3), od, 0, 0, 0);
#undef PK
}
__device__ __forceinline__ void pv_d0(f32x16 (&o)[4], int vb, bf16x8 pa0, bf16x8 pa1, bf16x8 pa2, bf16x8 pa3) {
  pv_one<0>(o[0], vb, pa0, pa1, pa2, pa3); pv_one<1>(o[1], vb, pa0, pa1, pa2, pa3); pv_one<2>(o[2], vb, pa0, pa1, pa2, pa3); pv_one<3>(o[3], vb, pa0, pa1, pa2, pa3);
}
__device__ __forceinline__ void attn_unit(const bf16_t* __restrict__ Q, const bf16_t* __restrict__ KV, const bf16_t* __restrict__ KR, bf16_t* __restrict__ MIX,
                                          const float* __restrict__ ropec, const float* __restrict__ ropes, int h, int qrow0, bool lat, int crow0, int lrow0, int NT, LAS char* lds) {
  int tid = threadIdx.x; asm volatile("" : "+v"(tid));
  const int wid = __builtin_amdgcn_readfirstlane(tid >> 6), lane = tid & 63, r32 = lane & 31, hi = lane >> 5;
  LAS char* V_lds = lds + OFF_V; LAS char* KN_lds = lds + OFF_KN; LAS char* KR_lds = lds + OFF_KR;
  LAS float* ws = (LAS float*)(lds + OFF_WS) + wid * 64; LAS float* li_l = ws; LAS float* al_l = ws + 32;
  float m_reg = -1e30f, l_reg = 0; f32x16 o[4] = {}; bf16x8 qr[4];
  LAS char* Qr = lds + OFF_QR + wid * SHM_QW;
  { const int qrow = qrow0 + wid * 32 + r32; const bf16_t* Qw = Q + (size_t)qrow * QW + h * QKD + hi * 8;
#pragma unroll
    for (int d0 = 0; d0 < 4; ++d0) qr[d0] = *(const bf16x8*)(Qw + d0 * 16);
#pragma unroll
    for (int d0 = 4; d0 < 8; ++d0) *(LAS bf16x8*)(Qr + KNSWZ(r32, ((d0 - 4) * 16 + hi * 8) * 2)) = *(const bf16x8*)(Qw + d0 * 16);
    const int n = (qrow - TC) & 4095;
#pragma unroll
    for (int ax = 0; ax < 2; ++ax) {
      const bf16x8 q1 = *(const bf16x8*)(Qw + (8 + 2 * ax) * 16), q2 = *(const bf16x8*)(Qw + (9 + 2 * ax) * 16);
      u32x4 w1 = *reinterpret_cast<const u32x4*>(&q1), w2 = *reinterpret_cast<const u32x4*>(&q2);
      if (lat) { const int pos = ax ? (n & 63) : (n >> 6); const float* cp = ropec + pos * 16 + hi * 8; const float* sp = ropes + pos * 16 + hi * 8;
#pragma unroll
        for (int j = 0; j < 4; ++j) { const float c0 = cp[2 * j], s0 = sp[2 * j], c1 = cp[2 * j + 1], s1 = sp[2 * j + 1];
          const float a0 = bf2f((bf16_t)q1[2 * j]), a1 = bf2f((bf16_t)q1[2 * j + 1]), b0 = bf2f((bf16_t)q2[2 * j]), b1 = bf2f((bf16_t)q2[2 * j + 1]);
          w1[j] = cvt_pk_bf16(a0 * c0 - b0 * s0, a1 * c1 - b1 * s1);
          w2[j] = cvt_pk_bf16(b0 * c0 + a0 * s0, b1 * c1 + a1 * s1); } }
      *(LAS u32x4*)(Qr + KNSWZ(r32, ((4 + 2 * ax) * 16 + hi * 8) * 2)) = w1; *(LAS u32x4*)(Qr + KNSWZ(r32, ((5 + 2 * ax) * 16 + hi * 8) * 2)) = w2; }
  }
  const int sr = tid >> 4, sc = (tid & 15) * 8, vst0 = v_st(sr, sc), vst1 = v_st(32 + sr, sc);
  const int rr = tid >> 3, rc = (tid & 7) * 8;
  const int vb0 = (int)(uintptr_t)V_lds + v_rd_base(lane);
  const bf16_t* KVh = KV + h * 256;
  const int nctx_t = lat ? 4 : NT;
  bf16x8 vs0, vs1, ks0, ks1, krs;
#define TROW(kt) ((kt) < nctx_t ? crow0 + (kt) * 64 : lrow0 + ((kt) - nctx_t) * 64)
#define SLOAD(kt) do { const int _r0 = TROW(kt); const bf16_t* _p0 = KVh + (size_t)(_r0 + sr) * KVW + sc; const bf16_t* _p1 = KVh + (size_t)(_r0 + 32 + sr) * KVW + sc; \
    vs0 = *(const bf16x8*)(_p0 + 128); vs1 = *(const bf16x8*)(_p1 + 128); ks0 = *(const bf16x8*)_p0; ks1 = *(const bf16x8*)_p1; krs = *(const bf16x8*)(KR + (size_t)(_r0 + rr) * ROPE + rc); } while (0)
#define SWRITE(b) do { *(LAS bf16x8*)(V_lds + (b) * SHM_V + vst0) = vs0; *(LAS bf16x8*)(V_lds + (b) * SHM_V + vst1) = vs1; \
    *(LAS bf16x8*)(KN_lds + (b) * SHM_KN + KNSWZ(sr, sc * 2)) = ks0; *(LAS bf16x8*)(KN_lds + (b) * SHM_KN + KNSWZ(32 + sr, sc * 2)) = ks1; \
    *(LAS bf16x8*)(KR_lds + (b) * SHM_KR + KRSWZ(rr, rc * 2)) = krs; } while (0)
#define SWAIT() asm volatile("s_waitcnt vmcnt(0)" ::: "memory")
#define RESC(a) do { if (__any((a) < 1.f)) { if (hi == 0) al_l[r32] = (a); asm volatile("s_waitcnt lgkmcnt(0)" ::: "memory"); \
    _Pragma("unroll") for (int d = 0; d < 4; ++d) _Pragma("unroll") for (int r = 0; r < 16; ++r) o[d][r] *= al_l[crow(r, hi)]; } } while (0)
  f32x16 pA0, pA1, pB0, pB1; float mnA, mnB, alA, alB; bf16x8 pa0, pa1, pa2, pa3;
  SLOAD(0); SWAIT(); SWRITE(0); __syncthreads();
  qkt(pA0, pA1, KN_lds, KR_lds, qr, Qr, r32, hi); partialSM(pA0, pA1, m_reg, mnA, alA);
  SLOAD(1); SWAIT(); SWRITE(1); __syncthreads();
  for (int j = 1; j + 1 < NT; j += 2) {
    SBAR(); qkt(pB0, pB1, KN_lds + SHM_KN, KR_lds + SHM_KR, qr, Qr, r32, hi);
    finishSM(pA0, pA1, alA, l_reg, pa0, pa1, pa2, pa3); SBAR();
    SLOAD(j + 1); SBAR();
    pv_d0(o, vb0, pa0, pa1, pa2, pa3); partialSM(pB0, pB1, m_reg, mnB, alB);
    __syncthreads(); SWAIT(); SWRITE(0);
    RESC(alB); __syncthreads();
    SBAR(); qkt(pA0, pA1, KN_lds, KR_lds, qr, Qr, r32, hi);
    finishSM(pB0, pB1, alB, l_reg, pa0, pa1, pa2, pa3); SBAR();
    SLOAD(j + 2); SBAR();
    pv_d0(o, vb0 + SHM_V, pa0, pa1, pa2, pa3); partialSM(pA0, pA1, m_reg, mnA, alA);
    __syncthreads(); SWAIT(); SWRITE(1);
    RESC(alA); __syncthreads();
  }
  SBAR(); qkt(pB0, pB1, KN_lds + SHM_KN, KR_lds + SHM_KR, qr, Qr, r32, hi);
  finishSM(pA0, pA1, alA, l_reg, pa0, pa1, pa2, pa3); SBAR();
  pv_d0(o, vb0, pa0, pa1, pa2, pa3); partialSM(pB0, pB1, m_reg, mnB, alB);
  __syncthreads(); RESC(alB);
  finishSM(pB0, pB1, alB, l_reg, pa0, pa1, pa2, pa3); SBAR();
  pv_d0(o, vb0 + SHM_V, pa0, pa1, pa2, pa3);
  if (hi == 0) li_l[r32] = l_reg; asm volatile("s_waitcnt lgkmcnt(0)" ::: "memory");
  float rli[16];
#pragma unroll
  for (int r = 0; r < 16; ++r) rli[r] = __builtin_amdgcn_rcpf(li_l[crow(r, hi)]);
  int tid2 = threadIdx.x; asm volatile("" : "+v"(tid2));
  const int r32e = tid2 & 31, hie = (tid2 >> 5) & 1;
  bf16_t* Ow = MIX + (size_t)(qrow0 + wid * 32) * D + h * VD + r32e;
#pragma unroll
  for (int r = 0; r < 16; ++r) { const int orow = crow(r, hie);
#pragma unroll
    for (int d0 = 0; d0 < 4; ++d0) Ow[(size_t)orow * D + d0 * 32] = f2bf(o[d0][r] * rli[r]); }
  __syncthreads();
#undef TROW
#undef SLOAD
#undef SWRITE
#undef SWAIT
#undef RESC
}
}
constexpr int Q5_ATT = 768, Q5_DFT = Q5_ATT + 128, Q5_ATTC = Q5_DFT + 48, Q5_DFTC = Q5_ATTC + 8, Q5_END = Q5_DFTC + CVT_JOBS;
__device__ __forceinline__ void ph_queue5(const Frame& F) {
    unsigned* qhead = (unsigned*)(F.ws + WS_CTL + CW_Q5);
    LAS int* qslot = (LAS int*)(F.lds + 640);
    const bf16_t* Q = WSP(bf16_t, R0_Q); const bf16_t* KV = WSP(bf16_t, R0_KV); const bf16_t* KR = WSP(bf16_t, R0_KR); bf16_t* MIX = WSP(bf16_t, R0_MIX);
    const float* rc = WSP(float, WS_ROPE); const float* rs = rc + 1024;
    for (;;) {
        __syncthreads();
        if (F.tid == 0) qslot[0] = (int)__hip_atomic_fetch_add(qhead, 1u, __ATOMIC_RELAXED, __HIP_MEMORY_SCOPE_AGENT);
        __syncthreads();
        const int it = __builtin_amdgcn_readfirstlane(qslot[0]);
        if (it >= Q5_END) break;
        if (it < Q5_ATT) { const int b = it / 96, rem = it % 96, h = rem / 16, qb = rem % 16;
            att::attn_unit(Q, KV, KR, MIX, rc, rs, h, TC + b * 4096 + qb * 256, true, b * 256, TC + b * 4096, 68, (LAS char*)F.ring); }
        else if (it < Q5_DFT || (it >= Q5_ATTC && it < Q5_DFTC)) {
            const bool lat = it < Q5_DFT; const int i = lat ? it - Q5_ATT : it - Q5_ATTC; const int b = lat ? i >> 4 : i, pm = lat ? i & 15 : 0; const int K = lat ? 4096 : 256;
            pg8::OneUnit S; S.lda = K; S.u0.pm = pm; S.u0.pn = 0; S.u0.e = b; S.u0.cnt = 0;
            S.u0.A = (const char*)(lat ? WSP(bf16_t, R0_DFT) : WSP(bf16_t, R0_DFTC)) + (size_t)pm * 256 * K * 2;
            S.u0.B = (const char*)(lat ? WSP(bf16_t, R0_TT2) : WSP(bf16_t, R0_TTC2)) + (size_t)b * 256 * K * 2;
            pg8::EpiFourOut E{MIX, lat ? TC : 0, lat ? 4096 : 256};
            pg8::gemm_phase<pg8::EpiFourOut, pg8::OneUnit>(F.ring, pg8::Gemm{K, K, K}, S, E); }
        else if (it < Q5_ATTC) { const int uu = it - Q5_DFT, b = uu / 6, h = uu % 6;
            att::attn_unit(Q, KV, KR, MIX, rc, rs, h, b * 256, false, b * 256, 0, 4, (LAS char*)F.ring); }
        else cvt_moe_job(F, (LAS float*)F.ring, F.in[I0_WGU], F.in[I0_WDN], it - Q5_DFTC);
    }
}

__device__ __forceinline__ void load_w32(const Frame& F, LAS float* wl, const float* W, int ldw) {
    for (int i = F.tid; i < 1024 * 8; i += NTHR) { const int r = i >> 3, q = i & 7; const int c = 8 * (r & 63) + 512 * (r >> 9) + ((r >> 6) & 7); const f32x4 v = *(const f32x4*)(W + (size_t)c * ldw + q * 4); *(LAS f32x4*)(wl + r * 36 + q * 4) = v; }
}
__device__ __forceinline__ float row_gemv32(const float (&v)[16], const LAS float* wl, int lane) {
    float p[32];
#pragma unroll
    for (int e = 0; e < 32; ++e) p[e] = 0.f;
#pragma unroll
    for (int i = 0; i < 16; ++i) { const LAS float* wr_ = wl + (lane + 64 * i) * 36;
#pragma unroll
        for (int q = 0; q < 8; ++q) { const f32x4 w = *(const LAS f32x4*)(wr_ + q * 4); p[4 * q] = fmaf(v[i], w[0], p[4 * q]); p[4 * q + 1] = fmaf(v[i], w[1], p[4 * q + 1]); p[4 * q + 2] = fmaf(v[i], w[2], p[4 * q + 2]); p[4 * q + 3] = fmaf(v[i], w[3], p[4 * q + 3]); }
        asm volatile("" ::: "memory"); }
    float a16[16], a8[8], a4[4], a2[2];
    { const bool up = (lane & 32) != 0;
#pragma unroll
      for (int i = 0; i < 16; ++i) { const float send = up ? p[i] : p[i + 16], keep = up ? p[i + 16] : p[i]; a16[i] = keep + __shfl_xor(send, 32); } }
    { const bool up = (lane & 16) != 0;
#pragma unroll
      for (int i = 0; i < 8; ++i) { const float send = up ? a16[i] : a16[i + 8], keep = up ? a16[i + 8] : a16[i]; a8[i] = keep + __shfl_xor(send, 16); } }
    { const bool up = (lane & 8) != 0;
#pragma unroll
      for (int i = 0; i < 4; ++i) { const float send = up ? a8[i] : a8[i + 4], keep = up ? a8[i + 4] : a8[i]; a4[i] = keep + __shfl_xor(send, 8); } }
    { const bool up = (lane & 4) != 0;
#pragma unroll
      for (int i = 0; i < 2; ++i) { const float send = up ? a4[i] : a4[i + 2], keep = up ? a4[i + 2] : a4[i]; a2[i] = keep + __shfl_xor(send, 4); } }
    float a1; { const bool up = (lane & 2) != 0; const float send = up ? a2[0] : a2[1], keep = up ? a2[1] : a2[0]; a1 = keep + __shfl_xor(send, 2); }
    a1 += __shfl_xor(a1, 1);
    return a1;
}
__device__ __forceinline__ void row_gemv32x2(const float (&va)[16], const float (&vb)[16], const LAS float* wl, int lane, float& ya, float& yb) {
    float p[32], q[32];
#pragma unroll
    for (int e = 0; e < 32; ++e) { p[e] = 0.f; q[e] = 0.f; }
#pragma unroll
    for (int i = 0; i < 16; ++i) { const LAS float* wr_ = wl + (lane + 64 * i) * 36;
#pragma unroll
        for (int k = 0; k < 8; ++k) { const f32x4 w = *(const LAS f32x4*)(wr_ + k * 4);
            p[4 * k] = fmaf(va[i], w[0], p[4 * k]); p[4 * k + 1] = fmaf(va[i], w[1], p[4 * k + 1]); p[4 * k + 2] = fmaf(va[i], w[2], p[4 * k + 2]); p[4 * k + 3] = fmaf(va[i], w[3], p[4 * k + 3]);
            q[4 * k] = fmaf(vb[i], w[0], q[4 * k]); q[4 * k + 1] = fmaf(vb[i], w[1], q[4 * k + 1]); q[4 * k + 2] = fmaf(vb[i], w[2], q[4 * k + 2]); q[4 * k + 3] = fmaf(vb[i], w[3], q[4 * k + 3]); }
        asm volatile("" ::: "memory"); }
    float a16[16], b16[16], a8[8], b8[8], a4[4], b4[4], a2[2], b2[2];
    { const bool up = (lane & 32) != 0;
#pragma unroll
      for (int i = 0; i < 16; ++i) { a16[i] = (up ? p[i + 16] : p[i]) + __shfl_xor(up ? p[i] : p[i + 16], 32); b16[i] = (up ? q[i + 16] : q[i]) + __shfl_xor(up ? q[i] : q[i + 16], 32); } }
    { const bool up = (lane & 16) != 0;
#pragma unroll
      for (int i = 0; i < 8; ++i) { a8[i] = (up ? a16[i + 8] : a16[i]) + __shfl_xor(up ? a16[i] : a16[i + 8], 16); b8[i] = (up ? b16[i + 8] : b16[i]) + __shfl_xor(up ? b16[i] : b16[i + 8], 16); } }
    { const bool up = (lane & 8) != 0;
#pragma unroll
      for (int i = 0; i < 4; ++i) { a4[i] = (up ? a8[i + 4] : a8[i]) + __shfl_xor(up ? a8[i] : a8[i + 4], 8); b4[i] = (up ? b8[i + 4] : b8[i]) + __shfl_xor(up ? b8[i] : b8[i + 4], 8); } }
    { const bool up = (lane & 4) != 0;
#pragma unroll
      for (int i = 0; i < 2; ++i) { a2[i] = (up ? a4[i + 2] : a4[i]) + __shfl_xor(up ? a4[i] : a4[i + 2], 4); b2[i] = (up ? b4[i + 2] : b4[i]) + __shfl_xor(up ? b4[i] : b4[i + 2], 4); } }
    { const bool up = (lane & 2) != 0; ya = (up ? a2[1] : a2[0]) + __shfl_xor(up ? a2[0] : a2[1], 2); yb = (up ? b2[1] : b2[0]) + __shfl_xor(up ? b2[0] : b2[1], 2); }
    ya += __shfl_xor(ya, 1); yb += __shfl_xor(yb, 1);
}
__device__ __forceinline__ void ph_router(const Frame& F, int layer, int r0) {
    LAS float* wl = (LAS float*)F.ring;
    LAS unsigned* lcnt = (LAS unsigned*)(F.lds + 512);
    LAS float* scr = (LAS float*)(F.ring + 147456) + F.wave * 128;
    const float* g = F.in[layer ? I1_N2G : I0_N2G]; const float* rb_ = F.in[layer ? I1_RB : I0_RB];
    load_w32(F, wl, F.in[layer ? I1_RW : I0_RW], 32);
    if (F.tid < 64) lcnt[F.tid] = 0u;
    __syncthreads();
    bf16_t* H = WSP(bf16_t, WS_H); unsigned* cnt = (unsigned*)(F.ws + WS_CTL + CW_CNT) + layer * 64;
    int* list = WSP(int, WS_LIST); int* toke = WSP(int, WS_TOKE); int* tokp = WSP(int, WS_TOKP); float* tokg = WSP(float, WS_TOKG);
    const float* modv = WSP(float, WS_MODV) + (size_t)layer * 9 * 6144;
    const int per = (T - r0 + F.G * NWAVE - 1) / (F.G * NWAVE); const int rbeg = r0 + (F.bid * NWAVE + F.wave) * per; const int rend = (rbeg + per < T) ? rbeg + per : T;
    float gg[16]; ld16f(g, F.lane, gg);
    float scv[16], shv[16]; int curm = -1;
    const bf16_t* Yb = layer == 0 ? WSP(bf16_t, R0_U0) : WSP(bf16_t, R1_OF) - (size_t)TC * D;
    for (int r = rbeg; r < rend; ++r) {
        float v[16];
        { float y[16]; ld16f(layer == 0 ? xrow_in(F, r) : xrow_res(F, r), F.lane, v); ld16b(Yb + (size_t)r * D, F.lane, y);
#pragma unroll
          for (int i = 0; i < 16; ++i) v[i] += y[i];
          st16f(xrow_res(F, r), F.lane, v); }
        { float ss = 0.f;
#pragma unroll
          for (int i = 0; i < 16; ++i) ss = fmaf(v[i], v[i], ss);
          const float rs = rsqrtf(wsum(ss) * (1.0f / D) + EPS);
          const int m = modrow(r);
          if (m != curm) { const float* mv = modv + (size_t)m * 6144; ld16f(mv + 4096, F.lane, scv); ld16f(mv + 3072, F.lane, shv); curm = m; }
#pragma unroll
          for (int i = 0; i < 16; ++i) v[i] = v[i] * rs * gg[i] * (1.0f + scv[i]) + shv[i]; }
        st16b(H + (size_t)r * D, F.lane, v);
        const int e = F.lane >> 1;
        const float lg = row_gemv32(v, wl, F.lane) + rb_[e];
        { LAS float* sc_ = scr;
            if ((F.lane & 1) == 0) sc_[e] = lg;
            asm volatile("s_waitcnt lgkmcnt(0)" ::: "memory");
            int rank = 0;
#pragma unroll
            for (int q = 0; q < 8; ++q) { const f32x4 v4 = *(const LAS f32x4*)(sc_ + 4 * q);
#pragma unroll
                for (int j = 0; j < 4; ++j) rank += (int)((v4[j] > lg) | ((v4[j] == lg) & ((4 * q + j) < e))); }
            if (rank < 4 && (F.lane & 1) == 0) { sc_[32 + rank] = lg; ((LAS int*)sc_)[36 + rank] = e; }
            asm volatile("s_waitcnt lgkmcnt(0)" ::: "memory");
            const f32x4 tvv = *(const LAS f32x4*)(sc_ + 32); const u32x4 tev = *(const LAS u32x4*)(sc_ + 36);
            asm volatile("s_waitcnt lgkmcnt(0)" ::: "memory");
            const float e1 = __expf(tvv[1] - tvv[0]), e2 = __expf(tvv[2] - tvv[0]), e3 = __expf(tvv[3] - tvv[0]); const float inv = 1.0f / (1.0f + e1 + e2 + e3);
            if (F.lane < 4) { const int k = F.lane; const int ek = (int)(k == 0 ? tev[0] : k == 1 ? tev[1] : k == 2 ? tev[2] : tev[3]); const float gk = (k == 0 ? 1.0f : k == 1 ? e1 : k == 2 ? e2 : e3) * inv;
                const unsigned lp = __hip_atomic_fetch_add(lcnt + ek, 1u, __ATOMIC_RELAXED, __HIP_MEMORY_SCOPE_WORKGROUP);
                toke[r * 4 + k] = ek; tokp[r * 4 + k] = (int)lp; tokg[r * 4 + k] = gk; }
        }
    }
    __syncthreads();
    if (F.tid < 32) { const unsigned c = lcnt[F.tid]; lcnt[32 + F.tid] = c ? __hip_atomic_fetch_add(cnt + F.tid, c, __ATOMIC_RELAXED, __HIP_MEMORY_SCOPE_AGENT) : 0u; }
    __syncthreads();
    int ln = threadIdx.x & 63; asm volatile("" : "+v"(ln));
    for (int r = rbeg; r < rend; ++r) {
        if (ln < 4) { const int ek = toke[r * 4 + ln]; const int pos = tokp[r * 4 + ln] + (int)lcnt[32 + ek]; tokp[r * 4 + ln] = pos; list[(size_t)ek * T + pos] = r; }
    }
}
__device__ __forceinline__ int moe_tstart(const Frame& F, int layer, LAS int* tstart) {
    unsigned* cnt = (unsigned*)(F.ws + WS_CTL + CW_CNT) + layer * 64;
    __syncthreads();
    if (F.tid == 0) { int s = 0; for (int e = 0; e < NE; ++e) { const int c = (int)__hip_atomic_load(cnt + e, __ATOMIC_RELAXED, __HIP_MEMORY_SCOPE_AGENT); tstart[e] = s; tstart[40 + e] = c; s += (c + 255) >> 8; } tstart[NE] = s; }
    __syncthreads();
    { LAS int* t2e = (LAS int*)(F.ring + 140000); const int nt = tstart[NE];
      for (int t = F.tid; t < nt; t += NTHR) { int e = 0; for (int j = 1; j < NE; ++j) e += (t >= tstart[j]) ? 1 : 0; t2e[t] = e; } }
    __syncthreads();
    return __builtin_amdgcn_readfirstlane(tstart[NE]);
}
__device__ __forceinline__ void ph_moe1(const Frame& F, int layer) {
    LAS int* tstart = (LAS int*)(F.lds + 64); const int ntile = moe_tstart(F, layer, tstart);
    pg8::MoeOrder<true> S; S.A = (const char*)WSP(bf16_t, WS_H); S.B = (const char*)WSP(bf16_t, WS_WGU); S.sB = (size_t)2048 * 1024 * 2; S.lda = D; S.ldb = D; S.npn = 8; S.nwg = ntile * 8; S.G = F.G; S.c = F.bid;
    S.tstart = tstart; S.cnt = tstart + 40; S.list = WSP(int, WS_LIST); S.t2e = (const LAS int*)(F.ring + 140000);
    pg8::EpiSwiglu E{WSP(bf16_t, WS_ACT), F.in[layer ? I1_BGU : I0_BGU]};
    pg8::gemm_phase<pg8::EpiSwiglu, pg8::MoeOrder<true>>(F.ring, pg8::Gemm{D, D, D}, S, E);
}
__device__ __forceinline__ void ph_moe2(const Frame& F, int layer) {
    LAS int* tstart = (LAS int*)(F.lds + 64); const int ntile = moe_tstart(F, layer, tstart);
    pg8::MoeOrder<false> S; S.A = (const char*)WSP(bf16_t, WS_ACT); S.B = (const char*)WSP(bf16_t, WS_WDN); S.sB = (size_t)1024 * 1024 * 2; S.lda = FF; S.ldb = FF; S.npn = 4; S.nwg = ntile * 4; S.G = F.G; S.c = F.bid;
    S.tstart = tstart; S.cnt = tstart + 40; S.list = nullptr; S.t2e = (const LAS int*)(F.ring + 140000);
    pg8::EpiDown E{WSP(bf16_t, RM_YB), F.in[layer ? I1_BDN : I0_BDN]};
    pg8::gemm_phase<pg8::EpiDown, pg8::MoeOrder<false>>(F.ring, pg8::Gemm{FF, FF, FF}, S, E);
}
__device__ __forceinline__ void moe_combine_row(const Frame& F, int layer, int r, const LAS int* tstart, float (&v)[16]) {
    const int* toke = WSP(int, WS_TOKE); const int* tokp = WSP(int, WS_TOKP); const float* tokg = WSP(float, WS_TOKG); const bf16_t* YB = WSP(bf16_t, RM_YB);
    const float* g2 = WSP(float, WS_MODV) + (size_t)(layer * 9 + modrow(r)) * 6144 + 5120;
    float y[16];
#pragma unroll
    for (int i = 0; i < 16; ++i) y[i] = 0.f;
#pragma unroll
    for (int k = 0; k < 4; ++k) { const int e = toke[r * 4 + k]; const size_t prow = (size_t)tstart[e] * 256 + tokp[r * 4 + k]; const float gk = tokg[r * 4 + k]; float yy[16]; ld16b(YB + prow * D, F.lane, yy);
#pragma unroll
        for (int i = 0; i < 16; ++i) y[i] = fmaf(gk, yy[i], y[i]); }
    float gg[16]; ld16f(g2, F.lane, gg); ld16f(xrow_res(F, r), F.lane, v);
#pragma unroll
    for (int i = 0; i < 16; ++i) v[i] = fmaf(gg[i], y[i], v[i]);
}
__device__ __forceinline__ void ph_combine_mod1(const Frame& F) {
    LAS int* tstart = (LAS int*)(F.lds + 64); moe_tstart(F, 0, tstart);
    LAS float* wl = (LAS float*)F.ring;
    load_w32(F, wl, F.in[I1_WIN] + 3072, 3104);
    __syncthreads();
    const float* g = F.in[I1_N1G]; bf16_t* H = WSP(bf16_t, WS_H); float* GD = WSP(float, WS_GD);
    const float* modv = WSP(float, WS_MODV) + (size_t)9 * 6144;
    for (int r = F.bid * NWAVE + F.wave; r < T; r += F.G * NWAVE) {
        float v[16]; moe_combine_row(F, 0, r, tstart, v);
        const float* mv = modv + (size_t)modrow(r) * 6144;
        st16f(xrow_res(F, r), F.lane, v);
        modulate16(v, g, mv + 1024, mv, F.lane);
        st16b(H + (size_t)r * D, F.lane, v);
        const float gd = row_gemv32(v, wl, F.lane);
        if ((F.lane & 1) == 0) GD[(size_t)r * 32 + (F.lane >> 1)] = gd;
    }
    __syncthreads();
    cvt_moe_weights(F, (LAS float*)F.ring, F.in[I1_WGU], F.in[I1_WDN]);
}
__device__ __forceinline__ void ph_final(const Frame& F) {
    LAS int* tstart = (LAS int*)(F.lds + 64); moe_tstart(F, 1, tstart);
    const float* g = F.in[I_FNG];
    for (int r = TC + F.bid * NWAVE + F.wave; r < T; r += F.G * NWAVE) {
        float v[16]; moe_combine_row(F, 1, r, tstart, v); float ss = 0.f;
#pragma unroll
        for (int i = 0; i < 16; ++i) ss = fmaf(v[i], v[i], ss);
        const float rs = rsqrtf(wsum(ss) * (1.0f / D) + EPS); float gg[16]; ld16f(g, F.lane, gg);
#pragma unroll
        for (int i = 0; i < 16; ++i) v[i] = v[i] * rs * gg[i];
        st16f(F.out + (size_t)(r - TC) * D, F.lane, v);
    }
}

namespace gla3 {
using att::f32x16; using att::s16x4; using att::crow; using att::v_st; using att::v_rd_base; using att::v_rd_off; using att::tr_read;
constexpr int ROWB = 272;
constexpr int P_GD = 0, P_TOT = 4096, P_WG = 8192;
constexpr int O_QD = 0, O_KD = 17408, O_KS = 34816, O_VV = 51200, O_ST = 67584, O_DEC = 102400;
constexpr size_t TILE_B = 64 * 128 * 2, ITEM_B = 2 * TILE_B;
#define GPK(L, H) (bf16x8){L[0], L[1], L[2], L[3], H[0], H[1], H[2], H[3]}
#define CH_ROW0(b, dir, cc) ((cc) < 4 ? ((b) * 256 + ((dir) ? 3 - (cc) : (cc)) * 64) : (TC + (b) * 4096 + ((dir) ? 67 - (cc) : (cc) - 4) * 64))
#define TOK(dir, jj) ((dir) ? 63 - (jj) : (jj))
__device__ __forceinline__ void pre_phase(const Frame& F) {
  LAS char* lds = (LAS char*)F.ring;
  int tid = threadIdx.x; asm volatile("" : "+v"(tid));
  const int wid = __builtin_amdgcn_readfirstlane(tid >> 6), lane = tid & 63;
  LAS float* gds = (LAS float*)(lds + P_GD); LAS float* tot = (LAS float*)(lds + P_TOT); LAS float* wgall = (LAS float*)(lds + P_WG);
  const bf16_t* U1 = WSP(bf16_t, R1_U1); const float* GD = WSP(float, WS_GD);
  char* tiles = (char*)(F.ws + WS_ACT); float* decbuf = (float*)(F.ws + WS_ACT + (size_t)4352 * ITEM_B);
  for (int i = tid; i < 8 * 17 * 128; i += NTHR) { const int tb = i / (17 * 128), rem = i % (17 * 128), r = rem >> 7, d = rem & 127, hd = tb >> 1, dir = tb & 1;
    const float* Wg = dir ? F.in[I1_WGKB] : F.in[I1_WGKF]; const float* Bg = dir ? F.in[I1_BGKB] : F.in[I1_BGKF]; wgall[i] = (r < 16) ? Wg[r * 512 + hd * 128 + d] : Bg[hd * 128 + d]; }
  const int d0 = 2 * lane, tg = wid, gj = tid >> 3, gr = (tid & 7) * 2;
  unsigned qreg[8], kreg[8]; f32x2 gdreg;
#define PLOAD(u) do { const int _cc = (u) % 68, _s = (u) / 68, _dir = _s & 1, _hd = (_s >> 1) & 3, _b = _s >> 3; const int _r0 = CH_ROW0(_b, _dir, _cc); \
    const bf16_t* _uq = U1 + _hd * 128 + d0; \
    _Pragma("unroll") for (int i = 0; i < 8; ++i) { const bf16_t* _p = _uq + (size_t)(_r0 + TOK(_dir, 8 * tg + i)) * U1W; qreg[i] = *(const unsigned*)_p; kreg[i] = *(const unsigned*)(_p + 512); } \
    gdreg = *(const f32x2*)(GD + (size_t)(_r0 + TOK(_dir, gj)) * 32 + _dir * 16 + gr); } while (0)
  int u = F.bid;
  if (u < 4352) PLOAD(u);
  __syncthreads();
  for (; u < 4352; u += F.G) {
    const int sc = u / 68, dir = sc & 1, hd = (sc >> 1) & 3;
    const LAS float* wg = wgall + (hd * 2 + dir) * 17 * 128;
    *(LAS f32x2*)(gds + gj * 16 + gr) = gdreg;
    __syncthreads();
    float cl0[8], cl1[8];
    { float z0[8], z1[8]; const f32x2 bb = *(const LAS f32x2*)(wg + 16 * 128 + d0);
#pragma unroll
      for (int i = 0; i < 8; ++i) { z0[i] = bb[0]; z1[i] = bb[1]; }
#pragma unroll
      for (int r4 = 0; r4 < 4; ++r4) { f32x2 w[4];
#pragma unroll
        for (int q = 0; q < 4; ++q) w[q] = *(const LAS f32x2*)(wg + (4 * r4 + q) * 128 + d0);
#pragma unroll
        for (int i = 0; i < 8; ++i) { const f32x4 g4 = *(const LAS f32x4*)(gds + (8 * tg + i) * 16 + 4 * r4);
#pragma unroll
          for (int q = 0; q < 4; ++q) { z0[i] = fmaf(g4[q], w[q][0], z0[i]); z1[i] = fmaf(g4[q], w[q][1], z1[i]); } } }
      float a0 = 0.f, a1 = 0.f;
#pragma unroll
      for (int i = 0; i < 8; ++i) { const float l0 = fminf(z0[i], 0.f) - __logf(1.0f + __expf(-fabsf(z0[i]))), l1 = fminf(z1[i], 0.f) - __logf(1.0f + __expf(-fabsf(z1[i])));
        a0 += l0 * (1.0f / 16.0f); a1 += l1 * (1.0f / 16.0f); cl0[i] = a0; cl1[i] = a1; }
      *(LAS f32x2*)(tot + tg * 128 + d0) = (f32x2){a0, a1}; }
    __syncthreads();
    { float off0 = 0.f, off1 = 0.f, last0 = 0.f, last1 = 0.f;
#pragma unroll
      for (int g = 0; g < 8; ++g) { const f32x2 tv = *(const LAS f32x2*)(tot + g * 128 + d0); if (g < tg) { off0 += tv[0]; off1 += tv[1]; } last0 += tv[0]; last1 += tv[1]; }
      const float el0 = __expf(last0), el1 = __expf(last1);
      if (tg == 0) *(f32x2*)(decbuf + (size_t)u * 128 + d0) = (f32x2){el0, el1};
      char* it = tiles + (size_t)u * ITEM_B + d0 * 2;
#pragma unroll
      for (int i = 0; i < 8; ++i) { const int jj = 8 * tg + i; const float e0 = __expf(off0 + cl0[i]), e1 = __expf(off1 + cl1[i]); const float r0 = __builtin_amdgcn_rcpf(e0), r1 = __builtin_amdgcn_rcpf(e1);
        const float q0 = __uint_as_float(qreg[i] << 16), q1 = __uint_as_float(qreg[i] & 0xffff0000u), k0 = __uint_as_float(kreg[i] << 16), k1 = __uint_as_float(kreg[i] & 0xffff0000u);
        *(unsigned*)(it + jj * 256) = cvt_pk_bf16(q0 * e0, q1 * e1);
        *(unsigned*)(it + TILE_B + jj * 256) = cvt_pk_bf16(k0 * r0, k1 * r1); } }
    if (u + F.G < 4352) PLOAD(u + F.G);
    __syncthreads();
  }
#undef PLOAD
}
constexpr int SB_QD = 0, SB_KD = 16384, SB_VV = 32768, SB_DEC = 40960, SB_BYTES = 41984, O_ST2 = 3 * SB_BYTES;
constexpr int vc_off(int d0, int ks, int half) { return d0 * 512 + ks * 2048 + half * 1024; }
struct SeqCtx { LAS char* lds; const char* tiles; const char* decb; const bf16_t* Uv; bf16_t* OUT; unsigned sQ[2], sK[2], ldsw; int vk, b, dir, hd, dvs, wid, lane, r32, hi, trb, xq, eb, db, kdo; };
#define DMA16(gptr, ldsoff) __builtin_amdgcn_global_load_lds((const unsigned*)(gptr), (LAS unsigned*)(C.lds + (ldsoff)), 16, 0, 0)
__device__ __forceinline__ void seq_issue(const SeqCtx& C, int cc) {
    const int bo = (cc % 3) * SB_BYTES; const char* t = C.tiles + (size_t)cc * ITEM_B;
    DMA16(t + C.sQ[0], bo + SB_QD + C.ldsw); DMA16(t + C.sQ[1], bo + SB_QD + 8192 + C.ldsw);
    DMA16(t + TILE_B + C.sK[0], bo + SB_KD + C.ldsw); DMA16(t + TILE_B + C.sK[1], bo + SB_KD + 8192 + C.ldsw);
    DMA16(C.Uv + (size_t)(CH_ROW0(C.b, C.dir, cc) + TOK(C.dir, C.vk)) * U1W, bo + SB_VV + C.ldsw);
    if (C.wid == 7) DMA16(C.decb + (size_t)cc * 512 + C.lane * 16, bo + SB_DEC);
}
#undef DMA16
template <int IB> __device__ __forceinline__ void seq_out_loop(const SeqCtx& C) {
  const int r32 = C.r32, hi = C.hi, xq = C.xq;
  for (int cc = 0; cc < 68; ++cc) {
    if (cc >= 6 && cc < 67) asm volatile("s_waitcnt vmcnt(37)" ::: "memory"); else if (cc >= 1 && cc < 67) asm volatile("s_waitcnt vmcnt(5)" ::: "memory"); else asm volatile("s_waitcnt vmcnt(0)" ::: "memory");
    asm volatile("s_waitcnt lgkmcnt(0)" ::: "memory");
    __builtin_amdgcn_s_barrier();
    asm volatile("" ::: "memory");
    if (cc + 2 < 68) seq_issue(C, cc + 2);
    if (cc < 4) continue;
    const LAS char* sb = C.lds + (cc % 3) * SB_BYTES;
    const LAS char* STp = C.lds + O_ST2 + ((cc + 1) & 1) * 17408;
    f32x16 p0 = {}, p1 = {}, o = {};
    const LAS char* QDr = sb + SB_QD + (32 * IB + r32) * 256; const LAS char* KDr = sb + SB_KD + C.kdo;
#pragma unroll
    for (int k = 0; k < 8; ++k) { const int po = (k << 5) ^ xq; const bf16x8 qf = *(const LAS bf16x8*)(QDr + po); const bf16x8 k0f = *(const LAS bf16x8*)(KDr + (k >> 1) * 512 + (k & 1) * 32);
      p0 = __builtin_amdgcn_mfma_f32_32x32x16_bf16(k0f, qf, p0, 0, 0, 0);
      if (IB) { const bf16x8 k1f = *(const LAS bf16x8*)(KDr + 8192 + (k >> 1) * 512 + (k & 1) * 32); p1 = __builtin_amdgcn_mfma_f32_32x32x16_bf16(k1f, qf, p1, 0, 0, 0); } }
#pragma unroll
    for (int r = 0; r < 16; ++r) { const bool kill = crow(r, hi) > r32; if (IB == 0) p0[r] = kill ? 0.f : p0[r]; else p1[r] = kill ? 0.f : p1[r]; }
    bf16x8 pa0, pa1, pa2, pa3;
#define PK4(P, BASE, OUT_) do { unsigned a0 = cvt_pk_bf16(P[BASE + 0], P[BASE + 1]), a1 = cvt_pk_bf16(P[BASE + 2], P[BASE + 3]);   \
    unsigned b0 = cvt_pk_bf16(P[BASE + 4], P[BASE + 5]), b1 = cvt_pk_bf16(P[BASE + 6], P[BASE + 7]);                              \
    auto r0 = __builtin_amdgcn_permlane32_swap(a0, b0, false, false); auto r1 = __builtin_amdgcn_permlane32_swap(a1, b1, false, false); \
    u32x4 w = {r0[0], r1[0], r0[1], r1[1]}; OUT_ = *reinterpret_cast<bf16x8*>(&w); } while (0)
    PK4(p0, 0, pa0); PK4(p0, 8, pa1); if (IB) { PK4(p1, 0, pa2); PK4(p1, 8, pa3); }
#undef PK4
    { const int vb = (int)(uintptr_t)(sb + SB_VV) + C.trb + C.eb * 512;
      const s16x4 l0 = tr_read<vc_off(0, 0, 0)>(vb), h0 = tr_read<vc_off(0, 0, 1)>(vb), l1 = tr_read<vc_off(0, 1, 0)>(vb), h1 = tr_read<vc_off(0, 1, 1)>(vb);
      s16x4 l2, h2, l3, h3;
      if (IB) { l2 = tr_read<vc_off(0, 2, 0)>(vb); h2 = tr_read<vc_off(0, 2, 1)>(vb); l3 = tr_read<vc_off(0, 3, 0)>(vb); h3 = tr_read<vc_off(0, 3, 1)>(vb); }
      asm volatile("s_waitcnt lgkmcnt(0)" ::: "memory"); __builtin_amdgcn_sched_barrier(0);
      o = __builtin_amdgcn_mfma_f32_32x32x16_bf16(pa0, GPK(l0, h0), o, 0, 0, 0);
      o = __builtin_amdgcn_mfma_f32_32x32x16_bf16(pa1, GPK(l1, h1), o, 0, 0, 0);
      if (IB) { o = __builtin_amdgcn_mfma_f32_32x32x16_bf16(pa2, GPK(l2, h2), o, 0, 0, 0);
                o = __builtin_amdgcn_mfma_f32_32x32x16_bf16(pa3, GPK(l3, h3), o, 0, 0, 0); } }
    { const LAS char* STr = STp + (32 * C.eb + r32) * ROWB + hi * 16;
#pragma unroll
      for (int k = 0; k < 8; ++k) { const bf16x8 qf = *(const LAS bf16x8*)(QDr + ((k << 5) ^ xq)); const bf16x8 sf = *(const LAS bf16x8*)(STr + k * 32);
        o = __builtin_amdgcn_mfma_f32_32x32x16_bf16(qf, sf, o, 0, 0, 0); } }
    bf16_t* op = C.OUT + (size_t)(CH_ROW0(C.b, C.dir, cc) - TC) * D + C.hd * 256 + C.dvs * 64 + 32 * C.eb + r32;
#pragma unroll
    for (int r = 0; r < 16; ++r) { const int i = 32 * IB + crow(r, hi); op[(size_t)TOK(C.dir, i) * D] = f2bf(o[r]); }
  }
}
__device__ __forceinline__ void seq_state_loop(const SeqCtx& C) {
  const int r32 = C.r32, hi = C.hi, db = C.db;
  f32x16 S0 = {}, S1 = {};
  for (int cc = 0; cc < 68; ++cc) {
    if (cc >= 1 && cc < 67) { if (C.wid == 7) asm volatile("s_waitcnt vmcnt(6)" ::: "memory"); else asm volatile("s_waitcnt vmcnt(5)" ::: "memory"); } else asm volatile("s_waitcnt vmcnt(0)" ::: "memory");
    asm volatile("s_waitcnt lgkmcnt(0)" ::: "memory");
    __builtin_amdgcn_s_barrier();
    asm volatile("" ::: "memory");
    if (cc + 2 < 68) seq_issue(C, cc + 2);
    const LAS char* sb = C.lds + (cc % 3) * SB_BYTES;
    LAS char* STn = C.lds + O_ST2 + (cc & 1) * 17408;
    const int kb = (int)(uintptr_t)(sb + SB_KD) + C.trb + db * 512, vb = (int)(uintptr_t)(sb + SB_VV) + C.trb;
    { const s16x4 al0 = tr_read<v_rd_off(0, 0, 0)>(kb), ah0 = tr_read<v_rd_off(0, 0, 1)>(kb), al1 = tr_read<v_rd_off(0, 1, 0)>(kb), ah1 = tr_read<v_rd_off(0, 1, 1)>(kb);
      const s16x4 al2 = tr_read<v_rd_off(0, 2, 0)>(kb), ah2 = tr_read<v_rd_off(0, 2, 1)>(kb), al3 = tr_read<v_rd_off(0, 3, 0)>(kb), ah3 = tr_read<v_rd_off(0, 3, 1)>(kb);
      const s16x4 bl0 = tr_read<vc_off(0, 0, 0)>(vb), bh0 = tr_read<vc_off(0, 0, 1)>(vb), bl1 = tr_read<vc_off(0, 1, 0)>(vb), bh1 = tr_read<vc_off(0, 1, 1)>(vb);
      const s16x4 bl2 = tr_read<vc_off(0, 2, 0)>(vb), bh2 = tr_read<vc_off(0, 2, 1)>(vb), bl3 = tr_read<vc_off(0, 3, 0)>(vb), bh3 = tr_read<vc_off(0, 3, 1)>(vb);
      const s16x4 cl0_ = tr_read<vc_off(1, 0, 0)>(vb), ch0 = tr_read<vc_off(1, 0, 1)>(vb), cl1_ = tr_read<vc_off(1, 1, 0)>(vb), ch1 = tr_read<vc_off(1, 1, 1)>(vb);
      const s16x4 cl2 = tr_read<vc_off(1, 2, 0)>(vb), ch2 = tr_read<vc_off(1, 2, 1)>(vb), cl3 = tr_read<vc_off(1, 3, 0)>(vb), ch3 = tr_read<vc_off(1, 3, 1)>(vb);
      asm volatile("s_waitcnt lgkmcnt(0)" ::: "memory"); __builtin_amdgcn_sched_barrier(0);
      S0 = __builtin_amdgcn_mfma_f32_32x32x16_bf16(GPK(al0, ah0), GPK(bl0, bh0), S0, 0, 0, 0); S1 = __builtin_amdgcn_mfma_f32_32x32x16_bf16(GPK(al0, ah0), GPK(cl0_, ch0), S1, 0, 0, 0);
      S0 = __builtin_amdgcn_mfma_f32_32x32x16_bf16(GPK(al1, ah1), GPK(bl1, bh1), S0, 0, 0, 0); S1 = __builtin_amdgcn_mfma_f32_32x32x16_bf16(GPK(al1, ah1), GPK(cl1_, ch1), S1, 0, 0, 0);
      S0 = __builtin_amdgcn_mfma_f32_32x32x16_bf16(GPK(al2, ah2), GPK(bl2, bh2), S0, 0, 0, 0); S1 = __builtin_amdgcn_mfma_f32_32x32x16_bf16(GPK(al2, ah2), GPK(cl2, ch2), S1, 0, 0, 0);
      S0 = __builtin_amdgcn_mfma_f32_32x32x16_bf16(GPK(al3, ah3), GPK(bl3, bh3), S0, 0, 0, 0); S1 = __builtin_amdgcn_mfma_f32_32x32x16_bf16(GPK(al3, ah3), GPK(cl3, ch3), S1, 0, 0, 0); }
#pragma unroll
    for (int g = 0; g < 4; ++g) { const f32x4 dc = *(const LAS f32x4*)(sb + SB_DEC + (32 * db + 8 * g + 4 * hi) * 4);
                                  S0[4 * g] *= dc[0]; S0[4 * g + 1] *= dc[1]; S0[4 * g + 2] *= dc[2]; S0[4 * g + 3] *= dc[3];
                                  S1[4 * g] *= dc[0]; S1[4 * g + 1] *= dc[1]; S1[4 * g + 2] *= dc[2]; S1[4 * g + 3] *= dc[3]; }
#pragma unroll
    for (int g = 0; g < 4; ++g) { u32x2 w0, w1; w0.x = cvt_pk_bf16(S0[4 * g], S0[4 * g + 1]); w0.y = cvt_pk_bf16(S0[4 * g + 2], S0[4 * g + 3]); w1.x = cvt_pk_bf16(S1[4 * g], S1[4 * g + 1]); w1.y = cvt_pk_bf16(S1[4 * g + 2], S1[4 * g + 3]);
      *(LAS u32x2*)(STn + r32 * ROWB + (32 * db + 8 * g + 4 * hi) * 2) = w0; *(LAS u32x2*)(STn + (32 + r32) * ROWB + (32 * db + 8 * g + 4 * hi) * 2) = w1; }
  }
}
__device__ __forceinline__ void seq_unit(const Frame& F, int b, int hd, int dir, int dvs, LAS char* lds) {
  int tid = threadIdx.x; asm volatile("" : "+v"(tid));
  SeqCtx C; C.lds = lds; C.wid = __builtin_amdgcn_readfirstlane(tid >> 6); C.lane = tid & 63; C.r32 = C.lane & 31; C.hi = C.lane >> 5; C.b = b; C.dir = dir; C.hd = hd; C.dvs = dvs;
  const int sc = (b * 4 + hd) * 2 + dir;
  C.OUT = WSP(bf16_t, dir ? R1_OB : R1_OF);
  C.tiles = (const char*)(F.ws + WS_ACT) + (size_t)sc * 68 * ITEM_B; C.decb = (const char*)(F.ws + WS_ACT + (size_t)4352 * ITEM_B) + (size_t)sc * 68 * 512;
  for (int i = tid; i < 2 * 17408 / 4; i += NTHR) ((LAS unsigned*)(lds + O_ST2))[i] = 0u;
  int vcol;
#pragma unroll
  for (int rd = 0; rd < 2; ++rd) { const int o = rd * 8192 + C.wid * 1024 + C.lane * 16;
    { const int row = o >> 8, slot = (o >> 4) & 15; C.sQ[rd] = (unsigned)(row * 256 + ((slot ^ (row & 15)) << 4)); }
    { const int sub = o >> 9, kkhi = sub >> 2, cblk = sub & 3, w = (o & 511) >> 1, kklo = w >> 5, cin = w & 31; const int kk = kkhi * 8 + kklo; const int k = (kk & ~0xC) | ((kk & 4) << 1) | ((kk & 8) >> 1);
      C.sK[rd] = (unsigned)(k * 256 + (cblk * 32 + cin) * 2); } }
  { const int o = C.wid * 1024 + C.lane * 16; const int sub = o >> 9, kkhi = sub >> 1, cblk = sub & 1, w = (o & 511) >> 1, kklo = w >> 5, cin = w & 31; const int kk = kkhi * 8 + kklo;
    C.vk = (kk & ~0xC) | ((kk & 4) << 1) | ((kk & 8) >> 1); vcol = cblk * 32 + cin; }
  C.Uv = WSP(bf16_t, R1_U1) + 1024 + hd * 256 + dvs * 64 + vcol;
  C.ldsw = (unsigned)C.wid * 1024u;
  C.eb = C.wid & 1; C.db = C.wid & 3; C.trb = v_rd_base(C.lane); C.xq = ((C.r32 & 15) ^ C.hi) << 4;
  { const int j = C.r32, kk = (j & ~0xC) | ((j & 4) << 1) | ((j & 8) >> 1); C.kdo = (kk >> 3) * 2048 + (kk & 7) * 64 + C.hi * 16; }
  seq_issue(C, 0); seq_issue(C, 1);
  if (C.wid < 4) { if (C.wid & 2) seq_out_loop<1>(C); else seq_out_loop<0>(C); }
  else seq_state_loop(C);
  asm volatile("s_waitcnt vmcnt(0) lgkmcnt(0)" ::: "memory");
  __builtin_amdgcn_s_barrier();
}
__device__ __forceinline__ void seq_phase(const Frame& F) {
  for (int un = F.bid; un < 256; un += F.G) {
    const int dvs = un & 3, sc = un >> 2, dir = sc & 1, hd = (sc >> 1) & 3, b = sc >> 3;
    __syncthreads();
    seq_unit(F, b, hd, dir, dvs, (LAS char*)F.ring);
  }
}
#undef GPK
#undef CH_ROW0
#undef TOK
}

__device__ __forceinline__ void ph_gla_out(const Frame& F) {
    const bf16_t* OF = WSP(bf16_t, R1_OF); const bf16_t* OB = WSP(bf16_t, R1_OB); const bf16_t* U1 = WSP(bf16_t, R1_U1); bf16_t* MIX = WSP(bf16_t, R1_MIX); const float* gn = F.in[I1_GNG];
    for (int rl = F.bid * NWAVE + F.wave; rl < TL; rl += F.G * NWAVE) {
        float o[16], ob[16], go[16]; ld16b(OF + (size_t)rl * D, F.lane, o); ld16b(OB + (size_t)rl * D, F.lane, ob); ld16b(U1 + (size_t)(TC + rl) * U1W + 2048, F.lane, go);
        float s0 = 0.f, s1 = 0.f;
#pragma unroll
        for (int i = 0; i < 8; ++i) { o[i] += ob[i]; o[8 + i] += ob[8 + i]; s0 = fmaf(o[i], o[i], s0); s1 = fmaf(o[8 + i], o[8 + i], s1); }
        for (int k = 16; k >= 1; k >>= 1) { s0 += __shfl_xor(s0, k); s1 += __shfl_xor(s1, k); }
        const float r0 = rsqrtf(s0 * (1.0f / 256.0f) + EPS), r1 = rsqrtf(s1 * (1.0f / 256.0f) + EPS);
        const float* gp = gn + ((8 * F.lane) & 255);
#pragma unroll
        for (int i = 0; i < 8; ++i) { const float gw = gp[i]; o[i] = o[i] * r0 * gw * silu_fast(go[i]); o[8 + i] = o[8 + i] * r1 * gw * silu_fast(go[8 + i]); }
        st16b(MIX + (size_t)rl * D, F.lane, o);
    }
}

constexpr int NPHASE = 20;
__global__ void __launch_bounds__(NTHR, 2) fwd_kernel(Args args) {
    extern __shared__ __attribute__((aligned(16))) unsigned char lds_raw[];
    Frame F; F.in = args.in; F.out = args.out; F.ws = args.ws; F.lds = (LAS unsigned char*)lds_raw; F.ring = F.lds + RING_OFF;
    F.tid = threadIdx.x; F.lane = F.tid & 63; F.wave = __builtin_amdgcn_readfirstlane(F.tid >> 6); F.G = gridDim.x; F.bid = blockIdx.x;
    if (F.tid < 4) ((LAS unsigned*)F.lds)[F.tid] = 0u;
    __syncthreads();
    const int lo = args.ph_lo, hi = args.ph_hi;
    const bool multi = (hi - lo) > 1;
    XcdBarrier bar; bar.bar = (unsigned*)(F.ws + WS_CTL + CW_BAR); bar.x = 0; bar.st = (volatile LAS unsigned*)F.lds;
    if (multi) bar = xcd_barrier_post((unsigned*)(F.ws + WS_CTL + CW_BAR), (volatile LAS unsigned*)F.lds);
#define IN(k) (lo <= (k) && (k) < hi)
#define SEAM(k) do { if (IN((k) + 1)) xcd_barrier(bar); } while (0)
#define REFRESH() do { int t_ = threadIdx.x; asm volatile("" : "+v"(t_)); F.tid = t_; F.lane = t_ & 63; F.wave = __builtin_amdgcn_readfirstlane(t_ >> 6); } while (0)

    if (IN(0)) { REFRESH(); ph_prologue(F); SEAM(0); }
    if (IN(1)) { REFRESH(); ph_mod0(F); SEAM(1); }
    if (IN(2)) { REFRESH();
        pg8::DualOrder S; S.a.init(WSP(bf16_t, WS_H), WSP(bf16_t, WS_WIN0), D, D, T, U0W, F.G, F.bid); S.b.init(WSP(bf16_t, WS_WF), WSP(bf16_t, WS_H), D, D, 512, T, F.G, F.bid);
        pg8::EpiDual0 E{pg8::EpiBf16{WSP(bf16_t, R0_U0), U0W, U0W}, pg8::EpiFourT{WSP(bf16_t, R0_TT), WSP(bf16_t, R0_TTC)}};
        pg8::gemm_phase<pg8::EpiDual0, pg8::DualOrder>(F.ring, pg8::Gemm{D, D, D}, S, E);
        SEAM(2); }
    if (IN(3)) { REFRESH(); ph_rowstats(F); SEAM(3); }
    if (IN(4)) { REFRESH();
        { pg8::DenseOrder S; S.init(WSP(bf16_t, R0_U0), WSP(bf16_t, WS_WQ), U0W, QL, T, QWP, F.G, F.bid);
          pg8::EpiRS E{WSP(bf16_t, R0_Q), WSP(float, WS_RS), QW, QW}; pg8::gemm_phase<pg8::EpiRS, pg8::DenseOrder>(F.ring, pg8::Gemm{QL, U0W, QL}, S, E); }
        { pg8::DenseOrder S; S.init(WSP(bf16_t, R0_U0) + QL, WSP(bf16_t, WS_WKV), U0W, KVL, T, KVW, F.G, F.bid);
          pg8::EpiRS E{WSP(bf16_t, R0_KV), WSP(float, WS_RS) + T, KVW, KVW}; pg8::gemm_phase<pg8::EpiRS, pg8::DenseOrder>(F.ring, pg8::Gemm{KVL, U0W, KVL}, S, E); }
        SEAM(4); }
    if (IN(5)) { REFRESH();
        ph_queue5(F); SEAM(5); }
    if (IN(6)) { REFRESH();
        pg8::DenseOrder S; S.init(WSP(bf16_t, R0_MIX), WSP(bf16_t, WS_WOUT0), D, D, T, D, F.G, F.bid);
        pg8::EpiGateBf16 E{WSP(bf16_t, R0_U0), WSP(float, WS_MODV), 2048, 0, 0};
        pg8::gemm_phase<pg8::EpiGateBf16, pg8::DenseOrder>(F.ring, pg8::Gemm{D, D, D}, S, E); SEAM(6); }
    if (IN(7)) { REFRESH(); ph_router(F, 0, 0); SEAM(7); }
    if (IN(8)) { REFRESH(); ph_moe1(F, 0); SEAM(8); }
    if (IN(9)) { REFRESH(); ph_moe2(F, 0); SEAM(9); }
    if (IN(10)) { REFRESH(); ph_combine_mod1(F); SEAM(10); }
    if (IN(11)) { REFRESH();
        pg8::DenseOrder S; S.init(WSP(bf16_t, WS_H), WSP(bf16_t, WS_WIN1), D, D, T, U1W, F.G, F.bid);
        pg8::EpiBf16 E{WSP(bf16_t, R1_U1), U1W, U1W}; pg8::gemm_phase<pg8::EpiBf16, pg8::DenseOrder>(F.ring, pg8::Gemm{D, D, D}, S, E); SEAM(11); }
    if (IN(12)) { REFRESH(); gla3::pre_phase(F); SEAM(12); }
    if (IN(13)) { REFRESH(); gla3::seq_phase(F); SEAM(13); }
    if (IN(14)) { REFRESH(); ph_gla_out(F); SEAM(14); }
    if (IN(15)) { REFRESH();
        pg8::DenseOrder S; S.init(WSP(bf16_t, R1_MIX), WSP(bf16_t, WS_WOUT1), D, D, TL, D, F.G, F.bid);
        pg8::EpiGateBf16 E{WSP(bf16_t, R1_OF), WSP(float, WS_MODV) + 9 * 6144, 2048, TC, TC};
        pg8::gemm_phase<pg8::EpiGateBf16, pg8::DenseOrder>(F.ring, pg8::Gemm{D, D, D}, S, E); SEAM(15); }
    if (IN(16)) { REFRESH(); ph_router(F, 1, TC); SEAM(16); }
    if (IN(17)) { REFRESH(); ph_moe1(F, 1); SEAM(17); }
    if (IN(18)) { REFRESH(); ph_moe2(F, 1); SEAM(18); }
    if (IN(19)) { REFRESH(); ph_final(F); }
#undef IN
#undef SEAM
}

#ifndef ONE_LAUNCH
#define ONE_LAUNCH 1
#endif
extern "C" void kernel_launch(void* const* d_in, const int* in_sizes, int n_in, void* d_out, int out_size, void* d_ws, size_t ws_size, hipStream_t stream) {
    static int grid = 0;
    if (grid == 0) {
        if (n_in != 38 || out_size != TL * D || ws_size < WS_END) { fprintf(stderr, "kernel_launch: unexpected shapes: n_in %d out %d ws %zu (need %zu)\n", n_in, out_size, ws_size, (size_t)WS_END); grid = -1; return; }
        int dev = 0, cus = 0, per_cu = 0;
        if (hipGetDevice(&dev) != hipSuccess || hipDeviceGetAttribute(&cus, hipDeviceAttributeMultiprocessorCount, dev) != hipSuccess) { grid = -1; return; }
        if (hipFuncSetAttribute((const void*)fwd_kernel, hipFuncAttributeMaxDynamicSharedMemorySize, LDS_BYTES) != hipSuccess) { fprintf(stderr, "kernel_launch: hipFuncSetAttribute failed\n"); grid = -1; return; }
        if (hipOccupancyMaxActiveBlocksPerMultiprocessor(&per_cu, (const void*)fwd_kernel, NTHR, LDS_BYTES) != hipSuccess || per_cu < 1) { fprintf(stderr, "kernel_launch: occupancy query says %d\n", per_cu); }
        (void)hipGetLastError();
        grid = cus;
    }
    if (grid < 0) return;
    (void)hipMemsetAsync((char*)d_ws + WS_CTL, 0, CTL_BYTES, stream);
    Args a{};
    for (int i = 0; i < 38; ++i) a.in[i] = (const float*)d_in[i];
    a.out = (float*)d_out; a.ws = (unsigned char*)d_ws;
#if ONE_LAUNCH
    a.ph_lo = 0; a.ph_hi = NPHASE;
    hipLaunchKernelGGL(fwd_kernel, dim3(grid), dim3(NTHR), LDS_BYTES, stream, a);
#else
    for (int p = 0; p < NPHASE; ++p) { a.ph_lo = p; a.ph_hi = p + 1; hipLaunchKernelGGL(fwd_kernel, dim3(grid), dim3(NTHR), LDS_BYTES, stream, a); }
#endif
}
```

```cpp
#include <hip/hip_runtime.h>
#include <stdint.h>
#include <stdio.h>

#define LAS __attribute__((address_space(3)))
typedef unsigned short bf16_t;
typedef short bf16x8 __attribute__((ext_vector_type(8)));
typedef float f32x4 __attribute__((ext_vector_type(4)));
typedef float f32x2 __attribute__((ext_vector_type(2)));
typedef unsigned u32x4 __attribute__((ext_vector_type(4)));
typedef unsigned u32x2 __attribute__((ext_vector_type(2)));

#ifndef NAIVE_ATTN
#define NAIVE_ATTN 0
#endif
#ifndef NAIVE_GLA
#define NAIVE_GLA 0
#endif
constexpr int D = 1024, NB = 8, SEQ = 4096, CTXL = 256;
constexpr int TC = NB * CTXL, TL = NB * SEQ, T = TC + TL;
constexpr int QL = 384, KVL = 256, ROPE = 64, NH = 6, QKD = 192, VD = 128;
constexpr int U0W = 768;
constexpr int QW = NH * QKD  , QWP = 1280, KVW = NH * 256  ;
constexpr int NE = 32, TOPK = 4, FF = 1024;
constexpr int U1W = 3072;
constexpr int NPAD = 147456;
constexpr float EPS = 1e-6f;
constexpr int NTHR = 512, NWAVE = 8;

constexpr size_t al256(size_t x) { return (x + 255) / 256 * 256; }
constexpr size_t XCD_BAR_WORDS_C = 3456;
constexpr size_t CW_BAR = 0;
constexpr size_t CW_Q5 = 15360;
constexpr size_t CW_CNT = 16384;
constexpr size_t CTL_BYTES = 32768;
constexpr size_t WS_CTL = 0;
constexpr size_t WS_MODV = WS_CTL + CTL_BYTES;
constexpr size_t WS_ROPE = WS_MODV + al256(2 * 9 * 6144 * 4);
constexpr size_t WS_RS = WS_ROPE + al256(2 * 64 * 16 * 4);
constexpr size_t WS_XCTX = WS_RS + al256((size_t)2 * T * 4);
constexpr size_t WS_H = WS_XCTX + al256((size_t)TC * D * 4);
constexpr size_t WS_WIN0 = WS_H + al256((size_t)T * D * 2);
constexpr size_t WS_WF = WS_WIN0 + al256((size_t)U0W * D * 2);
constexpr size_t WS_WQ = WS_WF + al256((size_t)512 * D * 2);
constexpr size_t WS_WKV = WS_WQ + al256((size_t)QWP * QL * 2);
constexpr size_t WS_WOUT0 = WS_WKV + al256((size_t)KVW * KVL * 2);
constexpr size_t WS_WIN1 = WS_WOUT0 + al256((size_t)D * D * 2);
constexpr size_t WS_WOUT1 = WS_WIN1 + al256((size_t)U1W * D * 2);
constexpr size_t WS_WGU = WS_WOUT1 + al256((size_t)D * D * 2);
constexpr size_t WS_WDN = WS_WGU + al256((size_t)NE * 2048 * D * 2);
constexpr size_t WS_ACT = WS_WDN + al256((size_t)NE * D * FF * 2);
constexpr size_t WS_LIST = WS_ACT + al256((size_t)NPAD * FF * 2);
constexpr size_t WS_TOKE = WS_LIST + al256((size_t)NE * T * 4);
constexpr size_t WS_TOKP = WS_TOKE + al256((size_t)T * 4 * 4);
constexpr size_t WS_TOKG = WS_TOKP + al256((size_t)T * 4 * 4);
constexpr size_t WS_RWT = WS_TOKG + al256((size_t)T * 4 * 4);
constexpr size_t WS_GD = WS_RWT + al256((size_t)2 * 2 * 32 * 1024 * 2);
constexpr size_t WS_REG = WS_GD + al256((size_t)T * 32 * 4);
constexpr size_t R0_U0 = WS_REG;
constexpr size_t R0_TT = R0_U0 + al256((size_t)T * U0W * 2);
constexpr size_t R0_TTC = R0_TT + al256((size_t)NB * 256 * 8192 * 2);
constexpr size_t R0_Q = R0_TTC + al256((size_t)NB * 256 * 512 * 2);
constexpr size_t R0_KV = R0_Q + al256((size_t)T * QW * 2);
constexpr size_t R0_KR = R0_KV + al256((size_t)T * KVW * 2);
constexpr size_t R0_MIX = R0_KR + al256((size_t)T * ROPE * 2);
constexpr size_t R0_DFT = R0_MIX + al256((size_t)T * D * 2);
constexpr size_t R0_DFTC = R0_DFT + al256((size_t)4096 * 4096 * 2);
constexpr size_t R0_TT2 = R0_DFTC + al256((size_t)256 * 256 * 2);
constexpr size_t R0_TTC2 = R0_TT2 + al256((size_t)NB * 256 * 4096 * 2);
constexpr size_t R0_END = R0_TTC2 + al256((size_t)NB * 256 * 256 * 2);
constexpr size_t R1_U1 = WS_REG;
constexpr size_t R1_OF = R1_U1 + al256((size_t)T * U1W * 2);
constexpr size_t R1_OB = R1_OF + al256((size_t)TL * D * 2);
constexpr size_t R1_MIX = R1_OB + al256((size_t)TL * D * 2);
constexpr size_t R1_END = R1_MIX + al256((size_t)TL * D * 2);
constexpr size_t RM_YB = WS_REG;
constexpr size_t RM_END = RM_YB + al256((size_t)NPAD * D * 2);
constexpr size_t cmax(size_t a, size_t b) { return a > b ? a : b; }
constexpr size_t WS_END = cmax(cmax(R0_END, R1_END), RM_END);

constexpr int LDS_BYTES = 160 * 1024;
constexpr int LDS_MISC = 1024;
constexpr int RING_OFF = LDS_MISC;

__device__ __forceinline__ float bf2f(bf16_t b) { return __uint_as_float(((unsigned)b) << 16); }
__device__ __forceinline__ bf16_t f2bf(float f) { unsigned u = __float_as_uint(f); u += 0x7FFFu + ((u >> 16) & 1u); return (bf16_t)(u >> 16); }
__device__ __forceinline__ unsigned pk2(float lo, float hi) { return (unsigned)f2bf(lo) | ((unsigned)f2bf(hi) << 16); }
typedef __bf16 bf16v2_t __attribute__((ext_vector_type(2)));
__device__ __forceinline__ unsigned cvt_pk_bf16(float lo, float hi) { const f32x2 v = {lo, hi}; bf16v2_t b = __builtin_convertvector(v, bf16v2_t); return *reinterpret_cast<unsigned*>(&b); }
__device__ __forceinline__ float wsum(float v) { for (int o = 32; o >= 1; o >>= 1) v += __shfl_xor(v, o); return v; }
__device__ __forceinline__ float siluf(float x) { return x / (1.0f + __expf(-x)); }
__device__ __forceinline__ float silu_fast(float x) { return x * __builtin_amdgcn_rcpf(1.0f + __builtin_amdgcn_exp2f(x * -1.4426950408889634f)); }

#define XB_TMO      128
#define XB_XCNT(j)  (256  + 64 * (j))
#define XB_XSUB(j)  (1280 + 64 * (j))
#define XB_XGEN(j)  (2304 + 64 * (j))
#define XB_TOP      3328
#define XB_TOPGEN   3392
#define XCD_BAR_WORDS 3456
#define XB_SPIN_CAP (1u << 20)
__device__ __forceinline__ unsigned xb_ld(unsigned* p)              { return __hip_atomic_load(p, __ATOMIC_RELAXED, __HIP_MEMORY_SCOPE_AGENT); }
__device__ __forceinline__ unsigned xb_add(unsigned* p, unsigned v) { return __hip_atomic_fetch_add(p, v, __ATOMIC_RELAXED, __HIP_MEMORY_SCOPE_AGENT); }
__device__ __forceinline__ unsigned xb_xcc_id() { return (unsigned)__builtin_amdgcn_s_getreg((3 << 11) | 20) & 0xFu; }
#define XB_SPIN(cond, bar) do { unsigned _sp = 0; while (cond) { __builtin_amdgcn_s_sleep(1); \
    if ((++_sp & 255u) == 0u) { if (xb_ld(&(bar)[XB_TMO])) break; if (_sp > XB_SPIN_CAP) { atomicAdd(&(bar)[XB_TMO], 1u); break; } } } } while (0)
struct XcdBarrier { unsigned* bar; unsigned x; volatile LAS unsigned* st; };
__device__ __forceinline__ XcdBarrier xcd_barrier_post(unsigned* bar, volatile LAS unsigned* st) {
    XcdBarrier b; b.bar = bar; b.x = xb_xcc_id(); b.st = st;
    if (threadIdx.x == 0) (void)xb_add(&bar[XB_XCNT(b.x)], 1u);
    return b;
}
__device__ __forceinline__ void xcd_barrier_complete(unsigned* bar, unsigned x, unsigned& nloc, unsigned& nx) {
    const unsigned G = gridDim.x * gridDim.y * gridDim.z;
    unsigned sum, cnt, mine, sp = 0u;
    for (;;) {
        sum = 0u; cnt = 0u; mine = 0u;
#pragma unroll
        for (unsigned j = 0; j < 16; ++j) { const unsigned c = xb_ld(&bar[XB_XCNT(j)]); sum += c; cnt += (c > 0u) ? 1u : 0u; mine = (j == x) ? c : mine; }
        if (sum == G) break;
        __builtin_amdgcn_s_sleep(1);
        if ((++sp & 255u) == 0u) { if (xb_ld(&bar[XB_TMO])) break; if (sp > XB_SPIN_CAP) { atomicAdd(&bar[XB_TMO], 1u); break; } }
    }
    nloc = mine > 0u ? mine : 1u; nx = cnt > 0u ? cnt : 1u;
}
__device__ __forceinline__ void xcd_barrier(const XcdBarrier& b) {
    asm volatile("s_waitcnt vmcnt(0)" ::: "memory");
    __syncthreads();
    if (threadIdx.x == 0) {
        unsigned* bar = b.bar;
        __builtin_amdgcn_s_waitcnt(0);
        unsigned nloc = b.st[0], nx = b.st[1];
        if (nloc == 0u) { xcd_barrier_complete(bar, b.x, nloc, nx); b.st[0] = nloc; b.st[1] = nx; }
        const unsigned old = xb_add(&bar[XB_XSUB(b.x)], 1u);
        const unsigned gen = old / nloc;
        if (old + 1u == (gen + 1u) * nloc) {
            __builtin_amdgcn_fence(__ATOMIC_RELEASE, "agent");
            asm volatile("s_waitcnt vmcnt(0)" ::: "memory");
            const unsigned og = xb_add(&bar[XB_TOP], 1u);
            const unsigned tg = og / nx;
            if (og + 1u == (tg + 1u) * nx) xb_add(&bar[XB_TOPGEN], 1u);
            else XB_SPIN(xb_ld(&bar[XB_TOPGEN]) == tg, bar);
            __builtin_amdgcn_fence(__ATOMIC_ACQUIRE, "agent");
            xb_add(&bar[XB_XGEN(b.x)], 1u);
            asm volatile("s_waitcnt vmcnt(0)" ::: "memory");
        } else {
            XB_SPIN(xb_ld(&bar[XB_XGEN(b.x)]) == gen, bar);
            __builtin_amdgcn_fence(__ATOMIC_ACQUIRE, "agent");
            asm volatile("s_waitcnt vmcnt(0)" ::: "memory");
        }
    }
    __syncthreads();
}

namespace pg8 {
constexpr int BM = 256, BK = 64, HALF = 128, HTB = HALF * BK * 2, STAGE_BYTES = 8 * HTB, NXCD = 8, WGM = 8;
__host__ __device__ __forceinline__ int lds_byte(int r, int c) { const int st = (r >> 4) * 2 + (c >> 5), rr = r & 15, cc = c & 31, ob = rr * 64 + cc * 2; return st * 1024 + (ob ^ (((ob >> 9) & 1) << 5)); }
__host__ __device__ __forceinline__ void stage_rc(int b, int& R, int& C) { const int st = b / 1024, sb = b % 1024, swz = sb ^ (((sb >> 9) & 1) << 5); R = (st >> 1) * 16 + swz / 64; C = (st & 1) * 32 + (swz % 64) / 2; }
__host__ __device__ __forceinline__ int perm32(int rho) { const int n = rho >> 4, i = rho & 15; return 8 * (i >> 2) + 4 * n + (i & 3); }

struct Unit { int pm, pn, e, cnt; const char* A; const char* B; };
struct Gemm { int K, lda, ldb; };

struct DenseOrder {
    const char* A; const char* B; int lda, ldb; int nM, nN, nwg, G, c;
    static constexpr bool GATHER = false;
    __device__ void init(const void* A_, const void* B_, int lda_, int ldb_, int M, int N, int G_, int c_) { A = (const char*)A_; B = (const char*)B_; lda = lda_; ldb = ldb_; nM = M / BM; nN = N / BM; nwg = nM * nN; G = G_; c = c_; }
    __device__ bool next(int i, Unit& u) const {
        const long L = (long)i * G + c; if (L >= nwg) return false;
        int wgid = (int)L; { const int q = nwg / NXCD, r = nwg % NXCD, xcd = wgid % NXCD, off = wgid / NXCD; wgid = (xcd < r ? xcd * (q + 1) : r * (q + 1) + (xcd - r) * q) + off; }
        const int nig = WGM * nN, gid = wgid / nig, fm = gid * WGM, gsz = (nM - fm) < WGM ? (nM - fm) : WGM;
        u.pm = fm + ((wgid % nig) % gsz); u.pn = (wgid % nig) / gsz; u.e = 0; u.cnt = 0;
        u.A = A + (size_t)u.pm * BM * lda * 2; u.B = B + (size_t)u.pn * BM * ldb * 2; return true;
    }
    __device__ __forceinline__ void aoff(const Unit&, const int (&R)[2], const int (&C)[2], unsigned (&off)[2][2]) const {
#pragma unroll
        for (int h = 0; h < 2; ++h)
#pragma unroll
            for (int i = 0; i < 2; ++i) off[h][i] = (unsigned)((h * HALF + R[i]) * lda + C[i]) * 2u;
    }
};
struct BatchOrder {
    const char* A; const char* B; size_t sA, sB; int lda, ldb; int nM, nN, per, nwg, G, c;
    static constexpr bool GATHER = false;
    __device__ void init(const void* A_, const void* B_, size_t sA_, size_t sB_, int lda_, int ldb_, int nb, int M, int N, int G_, int c_) { A = (const char*)A_; B = (const char*)B_; sA = sA_; sB = sB_; lda = lda_; ldb = ldb_; nM = M / BM; nN = N / BM; per = nM * nN; nwg = per * nb; G = G_; c = c_; }
    __device__ bool next(int i, Unit& u) const {
        const long L = (long)i * G + c; if (L >= nwg) return false;
        const int b = (int)L / per, r = (int)L % per; u.pm = r / nN; u.pn = r % nN; u.e = b; u.cnt = 0;
        u.A = A + (size_t)b * sA + (size_t)u.pm * BM * lda * 2; u.B = B + (size_t)b * sB + (size_t)u.pn * BM * ldb * 2; return true;
    }
    __device__ __forceinline__ void aoff(const Unit&, const int (&R)[2], const int (&C)[2], unsigned (&off)[2][2]) const {
#pragma unroll
        for (int h = 0; h < 2; ++h)
#pragma unroll
            for (int i = 0; i < 2; ++i) off[h][i] = (unsigned)((h * HALF + R[i]) * lda + C[i]) * 2u;
    }
};
struct DualOrder {
    DenseOrder a, b;
    static constexpr bool GATHER = false;
    __device__ __forceinline__ void aoff_issue(const Unit&, const int (&)[2], unsigned (&)[2][2]) const {}
    __device__ __forceinline__ void aoff_finish(const int (&)[2], unsigned (&)[2][2], unsigned (&)[2][2]) const {}
    __device__ bool next(int i, Unit& u) const {
        const long L = (long)i * a.G + a.c;
        if (L < a.nwg) { return a.next(i, u); }
        const long Lb = L - a.nwg; if (Lb >= b.nwg) return false;
        DenseOrder t = b; t.c = (int)(Lb % b.G); const bool ok = t.next((int)(Lb / b.G), u); u.e = 1; return ok;
    }
    __device__ __forceinline__ void aoff(const Unit& u, const int (&R)[2], const int (&C)[2], unsigned (&off)[2][2]) const { a.aoff(u, R, C, off); }
};
struct OneUnit {
    Unit u0; int lda;
    static constexpr bool GATHER = false;
    __device__ bool next(int i, Unit& u) const { if (i != 0) return false; u = u0; return true; }
    __device__ __forceinline__ void aoff(const Unit&, const int (&R)[2], const int (&C)[2], unsigned (&off)[2][2]) const {
#pragma unroll
        for (int h = 0; h < 2; ++h)
#pragma unroll
            for (int i = 0; i < 2; ++i) off[h][i] = (unsigned)((h * HALF + R[i]) * lda + C[i]) * 2u;
    }
};
template <bool GATHER_> struct MoeOrder {
    const char* A; const char* B; size_t sB; int lda, ldb; int npn, nwg, G, c;
    const LAS int* tstart; const LAS int* cnt; const int* list;
    const LAS int* t2e;
    __device__ __forceinline__ int ts(int j) const { return __builtin_amdgcn_readfirstlane(tstart[j]); }
    static constexpr bool GATHER = GATHER_;
    __device__ bool next(int i, Unit& u) const {
        const long L = (long)i * G + c; if (L >= nwg) return false;
        int wgid = (int)L; { const int q = nwg / NXCD, r = nwg % NXCD, xcd = wgid % NXCD, off = wgid / NXCD; wgid = (xcd < r ? xcd * (q + 1) : r * (q + 1) + (xcd - r) * q) + off; }
        const int e = __builtin_amdgcn_readfirstlane(t2e[wgid / npn]);
        const int t0 = ts(e), nt = ts(e + 1) - t0, l = wgid - t0 * npn, pn = l / nt, ti = l % nt;
        u.pm = t0 + ti; u.pn = pn; u.e = e; u.cnt = __builtin_amdgcn_readfirstlane(cnt[e]) - ti * BM;
        u.A = GATHER ? A : A + (size_t)u.pm * BM * lda * 2;
        u.B = B + (size_t)e * sB + (size_t)pn * BM * ldb * 2; return true;
    }
    __device__ __forceinline__ void aoff(const Unit& u, const int (&R)[2], const int (&C)[2], unsigned (&off)[2][2]) const {
        if (GATHER) {
            const int ti = u.pm - ts(u.e);
#pragma unroll
            for (int h = 0; h < 2; ++h)
#pragma unroll
                for (int i = 0; i < 2; ++i) { const int r = h * HALF + R[i]; const int tok = (r < u.cnt) ? list[(size_t)u.e * T + ti * BM + r] : 0; off[h][i] = (unsigned)(tok * lda + C[i]) * 2u; }
        } else {
#pragma unroll
            for (int h = 0; h < 2; ++h)
#pragma unroll
                for (int i = 0; i < 2; ++i) off[h][i] = (unsigned)((h * HALF + R[i]) * lda + C[i]) * 2u;
        }
    }
};

template <class Epi, class Sched>
__device__ __forceinline__ void gemm_phase(LAS unsigned char* lds, const Gemm g, const Sched& S, const Epi& E) {
    const int tid = threadIdx.x, wid = __builtin_amdgcn_readfirstlane(tid >> 6), lane = tid & 63, wr = wid >> 2, wc = wid & 3, fr = lane & 15, fq = lane >> 4;
    const int K = g.K, nt = K / BK;
    int Rr[2], Cc[2]; unsigned voffB[2];
#pragma unroll
    for (int i = 0; i < 2; ++i) { int R, C; stage_rc(tid * 16 + i * 8192, R, C); const int Rb = Epi::PERM ? ((R & ~31) + perm32(R & 31)) : R; Rr[i] = R; Cc[i] = C; voffB[i] = (unsigned)(Rb * g.ldb + C) * 2u; }
    const size_t kstep = (size_t)(BK * 2);
    const size_t hstepB = (size_t)HALF * g.ldb * 2;
    const unsigned ldsw = (unsigned)wid * 1024u;
    const int aoff = lds_byte(wr * 64 + fr, fq * 8), boff = lds_byte(wc * 32 + fr, fq * 8);
#define PG8_SA(b, h) (((b) * 2 + (h)) * HTB)
#define PG8_SB(b, h) ((4 + (b) * 2 + (h)) * HTB)
#define PG8_STAGE2(bufoff, gbase, o0, o1) do { \
        __builtin_amdgcn_global_load_lds((const unsigned*)((const char*)(gbase) + (o0)), (LAS unsigned*)(lds + (bufoff) + ldsw), 16, 0, 0); \
        __builtin_amdgcn_global_load_lds((const unsigned*)((const char*)(gbase) + (o1)), (LAS unsigned*)(lds + (bufoff) + ldsw + 8192), 16, 0, 0); } while (0)
#define PG8_STAGEB(bufoff, gbase) PG8_STAGE2(bufoff, gbase, voffB[0], voffB[1])
#define PG8_LDA(dst, b, h) do { _Pragma("unroll") for (int m = 0; m < 4; ++m) _Pragma("unroll") for (int k = 0; k < 2; ++k) dst[m][k] = *(const LAS bf16x8*)(lds + PG8_SA(b, h) + aoff + m * 2048 + k * 1024); } while (0)
#define PG8_LDB(dst, b, h) do { _Pragma("unroll") for (int n = 0; n < 2; ++n) _Pragma("unroll") for (int k = 0; k < 2; ++k) dst[n][k] = *(const LAS bf16x8*)(lds + PG8_SB(b, h) + boff + n * 2048 + k * 1024); } while (0)
#define PG8_MMA(ai, bj, At, Bt) do { __builtin_amdgcn_s_setprio(1); _Pragma("unroll") for (int m = 0; m < 4; ++m) _Pragma("unroll") for (int n = 0; n < 2; ++n) _Pragma("unroll") for (int k = 0; k < 2; ++k) \
        acc[ai][bj][m][n] = __builtin_amdgcn_mfma_f32_16x16x32_bf16(Bt[n][k], At[m][k], acc[ai][bj][m][n], 0, 0, 0); __builtin_amdgcn_s_setprio(0); } while (0)
#define PG8_WAIT_V(n) asm volatile("s_waitcnt vmcnt(" #n ")" ::: "memory")
#define PG8_WAIT_L(n) asm volatile("s_waitcnt lgkmcnt(" #n ")" ::: "memory")
#define PG8_BAR __builtin_amdgcn_s_barrier()
#define PG8_SCHED __builtin_amdgcn_sched_barrier(0)
    Unit cur, nxt; int ui = 0;
    if (!S.next(0, cur)) return;
    f32x4 acc[2][2][4][2];
#pragma unroll
    for (int a = 0; a < 2; ++a)
#pragma unroll
        for (int b = 0; b < 2; ++b)
#pragma unroll
            for (int m = 0; m < 4; ++m)
#pragma unroll
                for (int n = 0; n < 2; ++n) acc[a][b][m][n] = (f32x4){0.f, 0.f, 0.f, 0.f};
    bf16x8 At[4][2], B0[2][2], B1[2][2];
    unsigned oA[2][2], nOA[2][2];
    S.aoff(cur, Rr, Cc, oA);
    const char* cA = cur.A; const char* cB = cur.B;
    PG8_STAGEB(PG8_SB(0, 0), cB); PG8_STAGEB(PG8_SB(0, 1), cB + hstepB); PG8_STAGE2(PG8_SA(0, 0), cA, oA[0][0], oA[0][1]); PG8_STAGE2(PG8_SA(0, 1), cA, oA[1][0], oA[1][1]);
    if (wr == 1) PG8_BAR;
    PG8_WAIT_V(2); PG8_BAR;
    PG8_STAGEB(PG8_SB(1, 0), cB + kstep); PG8_STAGE2(PG8_SA(1, 0), cA + kstep, oA[0][0], oA[0][1]); PG8_STAGEB(PG8_SB(1, 1), cB + hstepB + kstep);
    PG8_WAIT_V(6); PG8_BAR;
    for (;;) {
        const bool has_next = S.next(ui + 1, nxt);
        const char* nA = has_next ? nxt.A : cA; const char* nB = has_next ? nxt.B : cB;
        if (Sched::GATHER) { if (has_next) S.aoff(nxt, Rr, Cc, nOA); else {
#pragma unroll
            for (int h = 0; h < 2; ++h)
#pragma unroll
                for (int i = 0; i < 2; ++i) nOA[h][i] = oA[h][i]; }
            asm volatile("" : "+v"(nOA[0][0]), "+v"(nOA[0][1]), "+v"(nOA[1][0]), "+v"(nOA[1][1])); }
        for (int t = 0; t < nt; t += 2) {
            const bool last = (t == nt - 2);
            const char* a1 = cA + (size_t)(t + 1) * kstep;
            const char* a2 = last ? nA : cA + (size_t)(t + 2) * kstep; const char* b2 = last ? nB : cB + (size_t)(t + 2) * kstep;
            const char* a3 = a2 + kstep; const char* b3 = b2 + kstep;
            unsigned q00 = oA[0][0], q01 = oA[0][1], q10 = oA[1][0], q11 = oA[1][1];
            if (Sched::GATHER) { q00 = last ? nOA[0][0] : q00; q01 = last ? nOA[0][1] : q01; q10 = last ? nOA[1][0] : q10; q11 = last ? nOA[1][1] : q11; }
            PG8_LDB(B0, 0, 0); PG8_LDB(B1, 0, 1); PG8_SCHED; PG8_LDA(At, 0, 0); PG8_STAGE2(PG8_SA(1, 1), a1, oA[1][0], oA[1][1]);
            PG8_WAIT_V(8); PG8_WAIT_L(0); PG8_BAR; PG8_MMA(0, 0, At, B0); PG8_MMA(0, 1, At, B1); PG8_BAR; PG8_SCHED;
            PG8_LDA(At, 0, 1); PG8_STAGEB(PG8_SB(0, 0), b2); PG8_STAGEB(PG8_SB(0, 1), b2 + hstepB); PG8_STAGE2(PG8_SA(0, 0), a2, q00, q01);
            PG8_WAIT_V(8); PG8_WAIT_L(0); PG8_BAR; PG8_MMA(1, 0, At, B0); PG8_MMA(1, 1, At, B1); PG8_BAR; PG8_SCHED;
            PG8_LDB(B0, 1, 0); PG8_LDB(B1, 1, 1); PG8_SCHED; PG8_LDA(At, 1, 0); PG8_STAGE2(PG8_SA(0, 1), a2, q10, q11);
            PG8_WAIT_V(8); PG8_WAIT_L(0); PG8_BAR; PG8_MMA(0, 0, At, B0); PG8_MMA(0, 1, At, B1); PG8_BAR; PG8_SCHED;
            PG8_LDA(At, 1, 1); PG8_STAGEB(PG8_SB(1, 0), b3); PG8_STAGEB(PG8_SB(1, 1), b3 + hstepB); PG8_STAGE2(PG8_SA(1, 0), a3, q00, q01);
            PG8_WAIT_V(8); PG8_WAIT_L(0); PG8_BAR; PG8_MMA(1, 0, At, B0); PG8_MMA(1, 1, At, B1); PG8_BAR; PG8_SCHED;
        }
        if (wr == 0) PG8_BAR;
        E(acc, cur, wr, wc, fr, fq);
        if (!has_next) break;
#pragma unroll
        for (int a = 0; a < 2; ++a)
#pragma unroll
            for (int b = 0; b < 2; ++b)
#pragma unroll
                for (int m = 0; m < 4; ++m)
#pragma unroll
                    for (int n = 0; n < 2; ++n) acc[a][b][m][n] = (f32x4){0.f, 0.f, 0.f, 0.f};
        cur = nxt; cA = nA; cB = nB; ++ui;
        if (Sched::GATHER) {
#pragma unroll
            for (int h = 0; h < 2; ++h)
#pragma unroll
                for (int i = 0; i < 2; ++i) oA[h][i] = nOA[h][i]; }
        if (wr == 1) PG8_BAR;
    }
    PG8_WAIT_V(0);
    PG8_BAR;
#undef PG8_SA
#undef PG8_SB
#undef PG8_STAGE2
#undef PG8_STAGEB
#undef PG8_LDA
#undef PG8_LDB
#undef PG8_MMA
#undef PG8_WAIT_V
#undef PG8_WAIT_L
#undef PG8_BAR
#undef PG8_SCHED
}

typedef f32x4 Acc[2][2][4][2];

struct EpiBf16 {
    static constexpr bool PERM = true;
    bf16_t* O; int ldc; int ncols;
    __device__ __forceinline__ void operator()(const Acc& acc, const Unit& u, int wr, int wc, int fr, int fq) const {
        const int row0 = u.pm * BM + wr * 64 + fr, col0 = u.pn * BM + wc * 32 + 8 * fq;
#pragma unroll
        for (int ai = 0; ai < 2; ++ai)
#pragma unroll
            for (int m = 0; m < 4; ++m) { bf16_t* rowp = O + (size_t)(row0 + ai * HALF + m * 16) * ldc + col0;
#pragma unroll
                for (int bj = 0; bj < 2; ++bj) { if (col0 + bj * HALF < ncols) { const f32x4 v0 = acc[ai][bj][m][0], v1 = acc[ai][bj][m][1];
                    u32x4 w; w.x = cvt_pk_bf16(v0[0], v0[1]); w.y = cvt_pk_bf16(v0[2], v0[3]); w.z = cvt_pk_bf16(v1[0], v1[1]); w.w = cvt_pk_bf16(v1[2], v1[3]);
                    *(u32x4*)(rowp + bj * HALF) = w; } } }
    }
};
struct EpiFourT {
    static constexpr bool PERM = true;
    bf16_t* TT; bf16_t* TTC;
    __device__ __forceinline__ void operator()(const Acc& acc, const Unit& u, int wr, int wc, int fr, int fq) const {
        const int part = u.pm; const int ch0 = wr * 64 + fr; const int tok0 = u.pn * BM + wc * 32 + 8 * fq;
#pragma unroll
        for (int bj = 0; bj < 2; ++bj) { const int tok = tok0 + bj * HALF; bf16_t* base; int ldt;
            if (tok < TC) { const int b = tok >> 8, n = tok & 255; base = TTC + (size_t)b * 256 * 512 + part * 256 + n; ldt = 512; }
            else { const int tl = tok - TC, b = tl >> 12, n = tl & 4095; base = TT + (size_t)b * 256 * 8192 + part * 4096 + n; ldt = 8192; }
#pragma unroll
            for (int ai = 0; ai < 2; ++ai)
#pragma unroll
                for (int m = 0; m < 4; ++m) { const int ch = ch0 + ai * HALF + m * 16; const f32x4 v0 = acc[ai][bj][m][0], v1 = acc[ai][bj][m][1];
                    u32x4 w; w.x = cvt_pk_bf16(v0[0], v0[1]); w.y = cvt_pk_bf16(v0[2], v0[3]); w.z = cvt_pk_bf16(v1[0], v1[1]); w.w = cvt_pk_bf16(v1[2], v1[3]);
                    *(u32x4*)(base + (size_t)ch * ldt) = w; } }
    }
};
struct EpiRS {
    static constexpr bool PERM = true;
    bf16_t* O; const float* rs; int ldc, ncols;
    __device__ __forceinline__ void operator()(const Acc& acc, const Unit& u, int wr, int wc, int fr, int fq) const {
        const int row0 = u.pm * BM + wr * 64 + fr, col0 = u.pn * BM + wc * 32 + 8 * fq;
#pragma unroll
        for (int ai = 0; ai < 2; ++ai)
#pragma unroll
            for (int m = 0; m < 4; ++m) { const int row = row0 + ai * HALF + m * 16; const float s = rs[row]; bf16_t* rowp = O + (size_t)row * ldc + col0;
#pragma unroll
                for (int bj = 0; bj < 2; ++bj) { if (col0 + bj * HALF >= ncols) continue; const f32x4 v0 = acc[ai][bj][m][0] * s, v1 = acc[ai][bj][m][1] * s;
                    u32x4 w; w.x = cvt_pk_bf16(v0[0], v0[1]); w.y = cvt_pk_bf16(v0[2], v0[3]); w.z = cvt_pk_bf16(v1[0], v1[1]); w.w = cvt_pk_bf16(v1[2], v1[3]);
                    *(u32x4*)(rowp + bj * HALF) = w; } }
    }
};
struct EpiFourOut {
    static constexpr bool PERM = true;
    bf16_t* MIX; int rowbase, rows_per_b;
    __device__ __forceinline__ void operator()(const Acc& acc, const Unit& u, int wr, int wc, int fr, int fq) const {
        const int row0 = rowbase + u.e * rows_per_b + u.pm * BM + wr * 64 + fr, col0 = 768 + wc * 32 + 8 * fq;
#pragma unroll
        for (int ai = 0; ai < 2; ++ai)
#pragma unroll
            for (int m = 0; m < 4; ++m) { bf16_t* rowp = MIX + (size_t)(row0 + ai * HALF + m * 16) * D + col0;
#pragma unroll
                for (int bj = 0; bj < 2; ++bj) { const f32x4 v0 = acc[ai][bj][m][0], v1 = acc[ai][bj][m][1];
                    u32x4 w; w.x = cvt_pk_bf16(v0[0], v0[1]); w.y = cvt_pk_bf16(v0[2], v0[3]); w.z = cvt_pk_bf16(v1[0], v1[1]); w.w = cvt_pk_bf16(v1[2], v1[3]);
                    *(u32x4*)(rowp + bj * HALF) = w; } }
    }
};
struct EpiDual0 {
    static constexpr bool PERM = true;
    EpiBf16 e0; EpiFourT e1;
    __device__ __forceinline__ void operator()(const Acc& acc, const Unit& u, int wr, int wc, int fr, int fq) const { if (u.e == 0) e0(acc, u, wr, wc, fr, fq); else e1(acc, u, wr, wc, fr, fq); }
};
struct EpiResid {
    static constexpr bool PERM = false;
    const float* base_ctx; const float* base_lat; float* out_ctx; float* out_lat; const float* modv; int goff; int rowoff;
    __device__ __forceinline__ void operator()(const Acc& acc, const Unit& u, int wr, int wc, int fr, int fq) const {
        const int rt = rowoff + u.pm * BM;
        const bool isctx = rt < TC; const int mr = isctx ? 8 : ((rt - TC) >> 12);
        const float* base = isctx ? base_ctx + (size_t)rt * D : base_lat + (size_t)(rt - TC) * D;
        float* out = isctx ? out_ctx + (size_t)rt * D : out_lat + (size_t)(rt - TC) * D;
        const float* gv = modv + mr * 6144 + goff;
        const int r0 = wr * 64 + fr, col0 = u.pn * BM + wc * 32 + 4 * fq;
        f32x4 g[2][2];
#pragma unroll
        for (int bj = 0; bj < 2; ++bj)
#pragma unroll
            for (int n = 0; n < 2; ++n) g[bj][n] = *(const f32x4*)(gv + col0 + bj * HALF + n * 16);
#pragma unroll
        for (int ai = 0; ai < 2; ++ai) {
            f32x4 bs[4][2][2];
#pragma unroll
            for (int m = 0; m < 4; ++m) { const size_t off = (size_t)(r0 + ai * HALF + m * 16) * D + col0;
#pragma unroll
                for (int bj = 0; bj < 2; ++bj)
#pragma unroll
                    for (int n = 0; n < 2; ++n) bs[m][bj][n] = *(const f32x4*)(base + off + bj * HALF + n * 16); }
#pragma unroll
            for (int m = 0; m < 4; ++m) { const size_t off = (size_t)(r0 + ai * HALF + m * 16) * D + col0;
#pragma unroll
                for (int bj = 0; bj < 2; ++bj)
#pragma unroll
                    for (int n = 0; n < 2; ++n) *(f32x4*)(out + off + bj * HALF + n * 16) = bs[m][bj][n] + g[bj][n] * acc[ai][bj][m][n]; }
            asm volatile("" ::: "memory"); }
    }
};
struct EpiGateBf16 {
    static constexpr bool PERM = true; static constexpr int NSTORE = 16;
    bf16_t* Y; const float* modv; int goff, rowoff, ybase;
    __device__ __forceinline__ void operator()(const Acc& acc, const Unit& u, int wr, int wc, int fr, int fq) const {
        const int rt = rowoff + u.pm * BM; const int mr = rt < TC ? 8 : ((rt - TC) >> 12);
        const float* gv = modv + mr * 6144 + goff; const int col0 = u.pn * BM + wc * 32 + 8 * fq;
        f32x4 g[2][2];
#pragma unroll
        for (int bj = 0; bj < 2; ++bj)
#pragma unroll
            for (int n = 0; n < 2; ++n) g[bj][n] = *(const f32x4*)(gv + col0 + bj * HALF + 4 * n);
        bf16_t* yb = Y + (size_t)(rt - ybase + wr * 64 + fr) * D + col0;
#pragma unroll
        for (int ai = 0; ai < 2; ++ai)
#pragma unroll
            for (int m = 0; m < 4; ++m) { bf16_t* rowp = yb + (size_t)(ai * HALF + m * 16) * D;
#pragma unroll
                for (int bj = 0; bj < 2; ++bj) { const f32x4 v0 = acc[ai][bj][m][0] * g[bj][0], v1 = acc[ai][bj][m][1] * g[bj][1];
                    u32x4 w; w.x = cvt_pk_bf16(v0[0], v0[1]); w.y = cvt_pk_bf16(v0[2], v0[3]); w.z = cvt_pk_bf16(v1[0], v1[1]); w.w = cvt_pk_bf16(v1[2], v1[3]);
                    *(u32x4*)(rowp + bj * HALF) = w; } }
    }
};
struct EpiSwiglu {
    static constexpr bool PERM = true;
    bf16_t* ACT; const float* bgu;
    __device__ __forceinline__ void operator()(const Acc& acc, const Unit& u, int wr, int wc, int fr, int fq) const {
        const int row0 = u.pm * BM + wr * 64 + fr, a0 = u.pn * HALF + wc * 32 + 8 * fq;
        const float* bp = bgu + (size_t)u.e * 2048 + 2 * a0;
        float bg[8], bl[8];
#pragma unroll
        for (int q = 0; q < 4; ++q) { const f32x4 t = *(const f32x4*)(bp + 4 * q); bg[2 * q] = t[0]; bl[2 * q] = t[1]; bg[2 * q + 1] = t[2]; bl[2 * q + 1] = t[3]; }
#pragma unroll
        for (int ai = 0; ai < 2; ++ai)
#pragma unroll
            for (int m = 0; m < 4; ++m) { float o[8];
#pragma unroll
                for (int j = 0; j < 8; ++j) { float xg = acc[ai][0][m][j >> 2][j & 3] + bg[j], xl = acc[ai][1][m][j >> 2][j & 3] + bl[j];
                    xg = fminf(xg, 7.0f); xl = fminf(fmaxf(xl, -7.0f), 7.0f);
                    o[j] = xg * __builtin_amdgcn_rcpf(1.0f + __builtin_amdgcn_exp2f(xg * (-1.702f * 1.4426950408889634f))) * (xl + 1.0f); }
                u32x4 w; w.x = cvt_pk_bf16(o[0], o[1]); w.y = cvt_pk_bf16(o[2], o[3]); w.z = cvt_pk_bf16(o[4], o[5]); w.w = cvt_pk_bf16(o[6], o[7]);
                *(u32x4*)(ACT + (size_t)(row0 + ai * HALF + m * 16) * FF + a0) = w; }
    }
};
struct EpiDown {
    static constexpr bool PERM = true;
    bf16_t* YB; const float* bdn;
    __device__ __forceinline__ void operator()(const Acc& acc, const Unit& u, int wr, int wc, int fr, int fq) const {
        const int row0 = u.pm * BM + wr * 64 + fr, col0 = u.pn * BM + wc * 32 + 8 * fq;
        f32x4 bv[2][2];
#pragma unroll
        for (int bj = 0; bj < 2; ++bj)
#pragma unroll
            for (int n = 0; n < 2; ++n) bv[bj][n] = *(const f32x4*)(bdn + (size_t)u.e * D + col0 + bj * HALF + 4 * n);
#pragma unroll
        for (int ai = 0; ai < 2; ++ai)
#pragma unroll
            for (int m = 0; m < 4; ++m) { bf16_t* rowp = YB + (size_t)(row0 + ai * HALF + m * 16) * D + col0;
#pragma unroll
                for (int bj = 0; bj < 2; ++bj) { const f32x4 v0 = acc[ai][bj][m][0] + bv[bj][0], v1 = acc[ai][bj][m][1] + bv[bj][1];
                    u32x4 w; w.x = cvt_pk_bf16(v0[0], v0[1]); w.y = cvt_pk_bf16(v0[2], v0[3]); w.z = cvt_pk_bf16(v1[0], v1[1]); w.w = cvt_pk_bf16(v1[2], v1[3]);
                    *(u32x4*)(rowp + bj * HALF) = w; } }
    }
};
}

struct Args { const float* in[38]; float* out; unsigned char* ws; int ph_lo, ph_hi; };
enum { I_X = 0, I_C, I_CTX, I_CCTX, I_FNG,
       I0_MODW, I0_MODB, I0_N1G, I0_WIN, I0_QNG, I0_WQUP, I0_KVNG, I0_WKVUP, I0_WOUT, I0_N2G, I0_RW, I0_RB, I0_WGU, I0_BGU, I0_WDN, I0_BDN,
       I1_MODW, I1_MODB, I1_N1G, I1_WIN, I1_WGKF, I1_BGKF, I1_WGKB, I1_BGKB, I1_GNG, I1_WOUT, I1_N2G, I1_RW, I1_RB, I1_WGU, I1_BGU, I1_WDN, I1_BDN };

struct Frame {
    const float* const* in; float* out; unsigned char* ws; LAS unsigned char* lds; LAS unsigned char* ring;
    int tid, lane, wave, G, bid;
};
#define WSP(T_, off) ((T_*)(F.ws + (off)))

__device__ __forceinline__ int gu_row(int n) { const int a = n >> 1, half = n & 1; return 256 * (a >> 7) + 128 * half + (a & 127); }
template <int MODE>
__device__ __forceinline__ void cvt_tile(const Frame& F, LAS bf16_t* tile  , const float* src, int ldsrc, int k0, int n0, bf16_t* dst, int ldd, const float* sk, float mul) {
    const int t = F.tid;
    { const int kl = t >> 3, nc = (t & 7) * 8; const float* p = src + (size_t)(k0 + kl) * ldsrc + n0 + nc;
      const f32x4 a = *(const f32x4*)p, b = *(const f32x4*)(p + 4); const float s = (sk ? sk[k0 + kl] : 1.0f) * mul;
      tile[(nc + 0) * 72 + kl] = f2bf(a[0] * s); tile[(nc + 1) * 72 + kl] = f2bf(a[1] * s); tile[(nc + 2) * 72 + kl] = f2bf(a[2] * s); tile[(nc + 3) * 72 + kl] = f2bf(a[3] * s);
      tile[(nc + 4) * 72 + kl] = f2bf(b[0] * s); tile[(nc + 5) * 72 + kl] = f2bf(b[1] * s); tile[(nc + 6) * 72 + kl] = f2bf(b[2] * s); tile[(nc + 7) * 72 + kl] = f2bf(b[3] * s); }
    __syncthreads();
    { const int nl = t >> 3, kc = (t & 7) * 8; const int n = n0 + nl; const int row = MODE == 1 ? gu_row(n) : n;
      const u32x4 v = *(const LAS u32x4*)(tile + nl * 72 + kc); *(u32x4*)(dst + (size_t)row * ldd + k0 + kc) = v; }
    __syncthreads();
}
template <int MODE>
__device__ __forceinline__ void cvt_blk(const Frame& F, LAS float* tl, const float* src, int ldsrc, int k0, int n0, bf16_t* dst, int ldd) {
    const int t = F.tid, w = t >> 6, l = t & 63;
    f32x4 v[8];
#pragma unroll
    for (int i = 0; i < 8; ++i) v[i] = *(const f32x4*)(src + (size_t)(k0 + w + 8 * i) * ldsrc + n0 + 4 * l);
#pragma unroll
    for (int i = 0; i < 8; ++i) *(LAS f32x4*)(tl + (w + 8 * i) * 260 + 4 * l) = v[i];
    __syncthreads();
    { const int n = t & 255, kh = t >> 8; const int row = MODE == 1 ? gu_row(n0 + n) : n0 + n; bf16_t* dp = dst + (size_t)row * ldd + k0 + kh * 32;
#pragma unroll
      for (int q = 0; q < 4; ++q) { float x[8];
#pragma unroll
          for (int j = 0; j < 8; ++j) x[j] = tl[(kh * 32 + 8 * q + j) * 260 + n];
          u32x4 o; o.x = cvt_pk_bf16(x[0], x[1]); o.y = cvt_pk_bf16(x[2], x[3]); o.z = cvt_pk_bf16(x[4], x[5]); o.w = cvt_pk_bf16(x[6], x[7]);
          *(u32x4*)(dp + 8 * q) = o; } }
    __syncthreads();
}
constexpr int CVT_NGU = NE * 16 * 8, CVT_NDN = NE * 16 * 4, CVT_JOBS = CVT_NGU + CVT_NDN;
__device__ __forceinline__ void cvt_moe_job(const Frame& F, LAS float* tl, const float* wgu, const float* wdn, int j) {
    bf16_t* WGU = WSP(bf16_t, WS_WGU); bf16_t* WDN = WSP(bf16_t, WS_WDN);
    if (j < CVT_NGU) { const int e = j >> 7, r = j & 127, kt = r >> 3, ntl = r & 7; cvt_blk<1>(F, tl, wgu + (size_t)e * 1024 * 2048, 2048, kt * 64, ntl * 256, WGU + (size_t)e * 2048 * 1024, 1024); }
    else { const int jj = j - CVT_NGU, e = jj >> 6, r = jj & 63, kt = r >> 2, ntl = r & 3; cvt_blk<0>(F, tl, wdn + (size_t)e * 1024 * 1024, 1024, kt * 64, ntl * 256, WDN + (size_t)e * 1024 * 1024, 1024); }
}
__device__ __forceinline__ void cvt_moe_weights(const Frame& F, LAS float* tl, const float* wgu, const float* wdn) {
    for (int j = F.bid; j < CVT_JOBS; j += F.G) cvt_moe_job(F, tl, wgu, wdn, j);
}
__device__ __forceinline__ void ph_prologue(const Frame& F) {
    LAS float* sc = (LAS float*)(F.ring);
    LAS float* red = (LAS float*)(F.ring + 36864);
    LAS float* ctab = (LAS float*)(F.ring + 55296);
    LAS float* stab = ctab + 4096;
    LAS bf16_t* tile = (LAS bf16_t*)(F.ring + 88064);
    LAS float* wt = (LAS float*)(F.ring + 97280);
    const int t = F.tid;
    for (int i = t; i < 9 * 1024; i += NTHR) { const int r = i >> 10, k = i & 1023; const float v = (r < 8) ? F.in[I_C][r * 1024 + k] : F.in[I_CCTX][k]; sc[i] = siluf(v); }
    for (int i = t; i < 4096; i += NTHR) { const float x = (float)i * (1.0f / 2048.0f); ctab[i] = cospif(x); stab[i] = sinpif(x); }
    __syncthreads();
    for (int u = F.bid; u < 2 * 96; u += F.G) {
        const int l = u / 96, j0 = (u % 96) * 64; const float* W = l ? F.in[I1_MODW] : F.in[I0_MODW]; const float* Bv = l ? F.in[I1_MODB] : F.in[I0_MODB];
        const int c4 = t & 15, kb = F.wave * 128 + ((t >> 4) & 3) * 32; f32x4 a[9];
#pragma unroll
        for (int r = 0; r < 9; ++r) a[r] = (f32x4){0.f, 0.f, 0.f, 0.f};
#pragma unroll 8
        for (int q = 0; q < 32; ++q) { const f32x4 w = *(const f32x4*)(W + (size_t)(kb + q) * 6144 + j0 + 4 * c4);
#pragma unroll
            for (int r = 0; r < 9; ++r) a[r] += w * sc[r * 1024 + kb + q]; }
#pragma unroll
        for (int r = 0; r < 9; ++r) {
#pragma unroll
            for (int j = 0; j < 4; ++j) { float v = a[r][j]; v += __shfl_xor(v, 16); v += __shfl_xor(v, 32); a[r][j] = v; }
            if ((t & 48) == 0) *(LAS f32x4*)(red + (F.wave * 9 + r) * 64 + 4 * c4) = a[r]; }
        __syncthreads();
        for (int i = t; i < 576; i += NTHR) { const int r = i >> 6, c = i & 63; float s = 0.f;
#pragma unroll
            for (int q = 0; q < 8; ++q) s += red[(q * 9 + r) * 64 + c];
            WSP(float, WS_MODV)[(size_t)(l * 9 + r) * 6144 + j0 + c] = s + Bv[j0 + c]; }
        __syncthreads();
    }
    if (F.bid == (1 % F.G)) { for (int i = t; i < 1024; i += NTHR) { const int pos = i >> 4, j = i & 15; const float inv = powf(10000.0f, -(float)j / 16.0f); const float ang = (float)pos * inv;
        WSP(float, WS_ROPE)[i] = cosf(ang); WSP(float, WS_ROPE)[1024 + i] = sinf(ang); } }
    { bf16_t* DFT = WSP(bf16_t, R0_DFT); bf16_t* DFTC = WSP(bf16_t, R0_DFTC);
      for (int k = F.bid; k < 4096 + 256; k += F.G) {
          if (k < 4096) { for (int jc = t; jc < 512; jc += NTHR) { const int j0 = jc * 8; float v[8];
#pragma unroll
                  for (int q = 0; q < 8; ++q) { const int j = j0 + q; const bool isS = j > 2048; const int idx = (k * (isS ? j - 2048 : j)) & 4095; v[q] = (isS ? stab[idx] : ctab[idx]) * (1.0f / 512.0f); }
                  u32x4 w; w.x = pk2(v[0], v[1]); w.y = pk2(v[2], v[3]); w.z = pk2(v[4], v[5]); w.w = pk2(v[6], v[7]); *(u32x4*)(DFT + (size_t)k * 4096 + j0) = w; } }
          else { const int kk = k - 4096; for (int jc = t; jc < 32; jc += NTHR) { const int j0 = jc * 8; float v[8];
#pragma unroll
                  for (int q = 0; q < 8; ++q) { const int j = j0 + q; const bool isS = j > 128; const int idx = ((kk * (isS ? j - 128 : j)) & 255) * 16; v[q] = (isS ? stab[idx] : ctab[idx]) * (1.0f / 128.0f); }
                  u32x4 w; w.x = pk2(v[0], v[1]); w.y = pk2(v[2], v[3]); w.z = pk2(v[4], v[5]); w.w = pk2(v[6], v[7]); *(u32x4*)(DFTC + (size_t)kk * 256 + j0) = w; } }
      } }
    { bf16_t* WF = WSP(bf16_t, WS_WF); const float* Win = F.in[I0_WIN];
      for (int j = (F.bid + 64) % F.G; j < 64; j += F.G) { const int k0 = (j >> 2) * 64, g = j & 3;
          for (int i = t; i < 4096; i += NTHR) { const int kl = i >> 6, c = i & 63; wt[kl * 65 + c] = Win[(size_t)(k0 + kl) * 960 + 704 + g * 64 + c]; }
          __syncthreads();
          { const int kl = t & 63, mg = t >> 6;
#pragma unroll 1
            for (int mm = 0; mm < 8; ++mm) { const int m = mg * 8 + mm; float ac = 0.f, as = 0.f;
                for (int c = 0; c < 64; ++c) { const int idx = ((m * c) & 63) * 64; const float w = wt[kl * 65 + c]; ac = fmaf(w, ctab[idx], ac); as = fmaf(w, stab[idx], as); }
                WF[(size_t)(g * 64 + m) * 1024 + k0 + kl] = f2bf(ac); WF[(size_t)(256 + g * 64 + m) * 1024 + k0 + kl] = f2bf(-as); } }
          __syncthreads(); } }
    for (int i = F.bid * NTHR + t; i < 2 * 32 * 1024; i += F.G * NTHR) { const int l = i >> 15, e = (i >> 10) & 31, k = i & 1023; const float w = (l ? F.in[I1_RW] : F.in[I0_RW])[k * 32 + e];
        const bf16_t hi = f2bf(w); const bf16_t lo = f2bf(w - bf2f(hi)); bf16_t* base = WSP(bf16_t, WS_RWT) + (size_t)l * 2 * 32 * 1024; base[e * 1024 + k] = hi; base[32 * 1024 + e * 1024 + k] = lo; }
    {
      constexpr int J_WIN0 = 16 * 11, J_WQ = 6 * 18, J_WKV = 4 * 24, J_WO = 16 * 16, J_WIN1 = 16 * 48;
      constexpr int JT = J_WIN0 + J_WQ + J_WKV + 2 * J_WO + J_WIN1;
      for (int j = F.bid; j < JT; j += F.G) { int r = j;
          if (r < J_WIN0) { cvt_tile<0>(F, tile, F.in[I0_WIN], 960, (r / 11) * 64, (r % 11) * 64, WSP(bf16_t, WS_WIN0), 1024, nullptr, 1.0f); continue; } r -= J_WIN0;
          if (r < J_WQ) { cvt_tile<0>(F, tile, F.in[I0_WQUP], 1152, (r / 18) * 64, (r % 18) * 64, WSP(bf16_t, WS_WQ), QL, F.in[I0_QNG], 1.0f); continue; } r -= J_WQ;
          if (r < J_WKV) { cvt_tile<0>(F, tile, F.in[I0_WKVUP], 1536, (r / 24) * 64, (r % 24) * 64, WSP(bf16_t, WS_WKV), KVL, F.in[I0_KVNG], 1.0f); continue; } r -= J_WKV;
          if (r < J_WO) { cvt_tile<0>(F, tile, F.in[I0_WOUT], 1024, (r / 16) * 64, (r % 16) * 64, WSP(bf16_t, WS_WOUT0), 1024, nullptr, 1.0f); continue; } r -= J_WO;
          if (r < J_WO) { cvt_tile<0>(F, tile, F.in[I1_WOUT], 1024, (r / 16) * 64, (r % 16) * 64, WSP(bf16_t, WS_WOUT1), 1024, nullptr, 1.0f); continue; } r -= J_WO;
          { const int n0 = (r % 48) * 64; cvt_tile<0>(F, tile, F.in[I1_WIN], 3104, (r / 48) * 64, n0, WSP(bf16_t, WS_WIN1), 1024, nullptr, n0 < 512 ? 0.08838834764831845f : 1.0f); }
      }
      for (int i = F.bid * NTHR + t; i < (64 * 1024 + 128 * QL) / 8; i += F.G * NTHR) { const u32x4 z = {0u, 0u, 0u, 0u};
          if (i < 64 * 1024 / 8) *(u32x4*)(WSP(bf16_t, WS_WIN0) + (size_t)704 * 1024 + (size_t)i * 8) = z; else *(u32x4*)(WSP(bf16_t, WS_WQ) + (size_t)1152 * QL + (size_t)(i - 64 * 1024 / 8) * 8) = z; }
    }
}

__device__ __forceinline__ const float* xrow_in(const Frame& F, int r) { return r < TC ? F.in[I_CTX] + (size_t)r * D : F.in[I_X] + (size_t)(r - TC) * D; }
__device__ __forceinline__ float* xrow_res(const Frame& F, int r) { return r < TC ? WSP(float, WS_XCTX) + (size_t)r * D : F.out + (size_t)(r - TC) * D; }
__device__ __forceinline__ int modrow(int r) { return r < TC ? 8 : ((r - TC) >> 12); }
__device__ __forceinline__ void ld16f(const float* p, int lane, float (&v)[16]) {
#pragma unroll
    for (int h = 0; h < 2; ++h) { const f32x4 a = *(const f32x4*)(p + 8 * lane + 512 * h), b = *(const f32x4*)(p + 8 * lane + 512 * h + 4);
        v[8 * h] = a[0]; v[8 * h + 1] = a[1]; v[8 * h + 2] = a[2]; v[8 * h + 3] = a[3]; v[8 * h + 4] = b[0]; v[8 * h + 5] = b[1]; v[8 * h + 6] = b[2]; v[8 * h + 7] = b[3]; }
}
__device__ __forceinline__ void st16f(float* p, int lane, const float (&v)[16]) {
#pragma unroll
    for (int h = 0; h < 2; ++h) { *(f32x4*)(p + 8 * lane + 512 * h) = (f32x4){v[8 * h], v[8 * h + 1], v[8 * h + 2], v[8 * h + 3]}; *(f32x4*)(p + 8 * lane + 512 * h + 4) = (f32x4){v[8 * h + 4], v[8 * h + 5], v[8 * h + 6], v[8 * h + 7]}; }
}
__device__ __forceinline__ void ld16b(const bf16_t* p, int lane, float (&v)[16]) {
#pragma unroll
    for (int h = 0; h < 2; ++h) { const u32x4 w = *(const u32x4*)(p + 8 * lane + 512 * h);
#pragma unroll
        for (int q = 0; q < 4; ++q) { v[8 * h + 2 * q] = __uint_as_float(w[q] << 16); v[8 * h + 2 * q + 1] = __uint_as_float(w[q] & 0xffff0000u); } }
}
__device__ __forceinline__ void st16b(bf16_t* p, int lane, const float (&v)[16]) {
#pragma unroll
    for (int h = 0; h < 2; ++h) { u32x4 w; w.x = cvt_pk_bf16(v[8 * h], v[8 * h + 1]); w.y = cvt_pk_bf16(v[8 * h + 2], v[8 * h + 3]); w.z = cvt_pk_bf16(v[8 * h + 4], v[8 * h + 5]); w.w = cvt_pk_bf16(v[8 * h + 6], v[8 * h + 7]);
        *(u32x4*)(p + 8 * lane + 512 * h) = w; }
}
__device__ __forceinline__ void modulate16(float (&v)[16], const float* g, const float* scale, const float* shift, int lane) {
    float ss = 0.f;
#pragma unroll
    for (int i = 0; i < 16; ++i) ss = fmaf(v[i], v[i], ss);
    const float rs = rsqrtf(wsum(ss) * (1.0f / D) + EPS);
    float gg[16], sc[16], sh[16]; ld16f(g, lane, gg); ld16f(scale, lane, sc); ld16f(shift, lane, sh);
#pragma unroll
    for (int i = 0; i < 16; ++i) v[i] = v[i] * rs * gg[i] * (1.0f + sc[i]) + sh[i];
}

__device__ __forceinline__ void ph_mod0(const Frame& F) {
    const float* g = F.in[I0_N1G]; bf16_t* H = WSP(bf16_t, WS_H);
    for (int r = F.bid * NWAVE + F.wave; r < T; r += F.G * NWAVE) {
        const float* mv = WSP(float, WS_MODV) + (size_t)modrow(r) * 6144;
        float v[16]; ld16f(xrow_in(F, r), F.lane, v);
        modulate16(v, g, mv + 1024, mv, F.lane);
        st16b(H + (size_t)r * D, F.lane, v);
    }
}
__device__ __forceinline__ void ph_rowstats(const Frame& F) {
    const bf16_t* U0 = WSP(bf16_t, R0_U0); float* rsq = WSP(float, WS_RS); float* rskv = rsq + T; bf16_t* KR = WSP(bf16_t, R0_KR);
    const float* rc = WSP(float, WS_ROPE); const float* rsn = rc + 1024;
    for (int r = F.bid * NWAVE + F.wave; r < T; r += F.G * NWAVE) {
        const bf16_t* u = U0 + (size_t)r * U0W; const int lane = F.lane;
        float a[8], b[8];
        { const u32x4 w = *(const u32x4*)(u + 8 * lane);
#pragma unroll
          for (int q = 0; q < 4; ++q) { a[2 * q] = __uint_as_float(w[q] << 16); a[2 * q + 1] = __uint_as_float(w[q] & 0xffff0000u); } }
        { u32x4 w = {0u, 0u, 0u, 0u}; if (lane < 32) w = *(const u32x4*)(u + 512 + 8 * lane);
#pragma unroll
          for (int q = 0; q < 4; ++q) { b[2 * q] = __uint_as_float(w[q] << 16); b[2 * q + 1] = __uint_as_float(w[q] & 0xffff0000u); } }
        float sa = 0.f, sb = 0.f;
#pragma unroll
        for (int j = 0; j < 8; ++j) { sa = fmaf(a[j], a[j], sa); sb = fmaf(b[j], b[j], sb); }
        const float sq = wsum(lane < 48 ? sa : 0.f), skv = wsum((lane >= 48 ? sa : 0.f) + (lane < 16 ? sb : 0.f));
        float pr[8];
#pragma unroll
        for (int j = 0; j < 8; ++j) pr[j] = __shfl_xor(b[j], 2);
        if (lane >= 16 && lane < 24) { const int jq = lane - 16, quarter = jq >> 1;
            if (r >= TC) { const int n = (r - TC) & 4095; const int pos = (quarter >= 2) ? (n & 63) : (n >> 6); const float* cp = rc + pos * 16 + (jq & 1) * 8; const float* sp = rsn + pos * 16 + (jq & 1) * 8;
#pragma unroll
                for (int j = 0; j < 8; ++j) b[j] = (quarter & 1) ? (b[j] * cp[j] + pr[j] * sp[j]) : (b[j] * cp[j] - pr[j] * sp[j]); }
            u32x4 w; w.x = cvt_pk_bf16(b[0], b[1]); w.y = cvt_pk_bf16(b[2], b[3]); w.z = cvt_pk_bf16(b[4], b[5]); w.w = cvt_pk_bf16(b[6], b[7]);
            *(u32x4*)(KR + (size_t)r * ROPE + 8 * jq) = w; }
        if (lane == 0) { rsq[r] = rsqrtf(sq * (1.0f / QL) + EPS); rskv[r] = rsqrtf(skv * (1.0f / KVL) + EPS); }
    }
    { const bf16_t* TT = WSP(bf16_t, R0_TT); const bf16_t* TTC = WSP(bf16_t, R0_TTC); bf16_t* TT2 = WSP(bf16_t, R0_TT2); bf16_t* TTC2 = WSP(bf16_t, R0_TTC2);
      const int nch_l = NB * 256 * 512, nch_c = NB * 256 * 32;
      for (int i = F.bid * NTHR + F.tid; i < nch_l + nch_c; i += F.G * NTHR) {
          const bool lat = i < nch_l; const int ii = lat ? i : i - nch_l; const int N = lat ? 4096 : 256; const int cpr = N >> 3; const int row = ii / cpr, p0 = (ii % cpr) * 8;
          const bf16_t* src = (lat ? TT : TTC) + (size_t)row * 2 * N; bf16_t* dst = (lat ? TT2 : TTC2) + (size_t)row * N + p0; float v[8];
#pragma unroll
          for (int q = 0; q < 8; ++q) { const int pp = p0 + q; const bool cs = pp <= (N >> 1); const int j = cs ? pp : pp - (N >> 1); const bf16_t* X = cs ? src : src + N;
              const float a = bf2f(X[j]); const float bmir = (j == 0 || j == (N >> 1)) ? 0.f : bf2f(X[N - j]); v[q] = cs ? a + bmir : a - bmir; }
          u32x4 w; w.x = pk2(v[0], v[1]); w.y = pk2(v[2], v[3]); w.z = pk2(v[4], v[5]); w.w = pk2(v[6], v[7]); *(u32x4*)dst = w; }
    }
}

namespace att {
typedef float f32x16 __attribute__((ext_vector_type(16)));
typedef short s16x4 __attribute__((ext_vector_type(4)));
constexpr float SCALE = 0.07216878364870322f, THR = 8.f;
constexpr int SHM_V = 16384, SHM_KN = 64 * 272, SHM_KR = 64 * 144, SHM_QW = 32 * 272;
constexpr int OFF_V = 0, OFF_KN = 2 * SHM_V, OFF_KR = OFF_KN + 2 * SHM_KN, OFF_WS = OFF_KR + 2 * SHM_KR, OFF_QR = OFF_WS + 2048;
#define KNSWZ(row, cb) ((row) * 272 + (cb))
#define KRSWZ(row, cb) ((row) * 144 + (cb))
#define SBAR() __builtin_amdgcn_sched_barrier(0)
__device__ __forceinline__ int crow(int r, int hi) { return (r & 3) + 8 * (r >> 2) + 4 * hi; }
__device__ __forceinline__ void partialSM(f32x16& p0, f32x16& p1, float& m_reg, float& mn, float& alpha) {
  constexpr float C = SCALE * 1.4426950408889634f;
  float pmax = p0[0];
#pragma unroll
  for (int r = 1; r < 16; ++r) pmax = fmaxf(pmax, p0[r]);
#pragma unroll
  for (int r = 0; r < 16; ++r) pmax = fmaxf(pmax, p1[r]);
  { auto rr = __builtin_amdgcn_permlane32_swap(__float_as_uint(pmax), __float_as_uint(pmax), false, false);
    pmax = fmaxf(__uint_as_float(rr[0]), __uint_as_float(rr[1])); }
  if (__builtin_expect(__all(pmax - m_reg <= THR / SCALE), 1)) { mn = m_reg; alpha = 1.f; }
  else { mn = fmaxf(m_reg, pmax); alpha = __builtin_amdgcn_exp2f((m_reg - mn) * C); m_reg = mn; }
  const float mnC = -mn * C;
#pragma unroll
  for (int r = 0; r < 16; ++r) p0[r] = fmaf(p0[r], C, mnC);
#pragma unroll
  for (int r = 0; r < 16; ++r) p1[r] = fmaf(p1[r], C, mnC);
#pragma unroll
  for (int r = 0; r < 16; ++r) p0[r] = __builtin_amdgcn_exp2f(p0[r]);
}
__device__ __forceinline__ void finishSM(f32x16& p0, f32x16& p1, float alpha, float& l_reg, bf16x8& pa0, bf16x8& pa1, bf16x8& pa2, bf16x8& pa3) {
#pragma unroll
  for (int r = 0; r < 16; ++r) p1[r] = __builtin_amdgcn_exp2f(p1[r]);
  float ps = 0;
#pragma unroll
  for (int r = 0; r < 16; ++r) ps += p0[r];
#pragma unroll
  for (int r = 0; r < 16; ++r) ps += p1[r];
  { auto rr = __builtin_amdgcn_permlane32_swap(__float_as_uint(ps), __float_as_uint(ps), false, false);
    ps = __uint_as_float(rr[0]) + __uint_as_float(rr[1]); }
  l_reg = l_reg * alpha + ps;
#define PK4(P, BASE, OUT) do { unsigned a0 = cvt_pk_bf16(P[BASE + 0], P[BASE + 1]), a1 = cvt_pk_bf16(P[BASE + 2], P[BASE + 3]);   \
    unsigned b0 = cvt_pk_bf16(P[BASE + 4], P[BASE + 5]), b1 = cvt_pk_bf16(P[BASE + 6], P[BASE + 7]);                              \
    auto r0 = __builtin_amdgcn_permlane32_swap(a0, b0, false, false); auto r1 = __builtin_amdgcn_permlane32_swap(a1, b1, false, false); \
    u32x4 w = {r0[0], r1[0], r0[1], r1[1]}; OUT = *reinterpret_cast<bf16x8*>(&w); } while (0)
  PK4(p0, 0, pa0); PK4(p0, 8, pa1); PK4(p1, 0, pa2); PK4(p1, 8, pa3);
#undef PK4
}
__device__ __forceinline__ void qkt(f32x16& p0, f32x16& p1, const LAS char* Kn, const LAS char* Kr, const bf16x8 (&qr)[4], const LAS char* Qr, int r32, int hi) {
  p0 = f32x16{}; p1 = f32x16{};
#pragma unroll
  for (int d0 = 0; d0 < 8; ++d0) { const int cb = (d0 * 16 + hi * 8) * 2;
    const bf16x8 b0 = *(const LAS bf16x8*)(Kn + KNSWZ(r32, cb));
    const bf16x8 b1 = *(const LAS bf16x8*)(Kn + KNSWZ(32 + r32, cb));
    bf16x8 qq; if (d0 < 4) qq = qr[d0]; else qq = *(const LAS bf16x8*)(Qr + KNSWZ(r32, ((d0 - 4) * 16 + hi * 8) * 2));
    p0 = __builtin_amdgcn_mfma_f32_32x32x16_bf16(b0, qq, p0, 0, 0, 0);
    p1 = __builtin_amdgcn_mfma_f32_32x32x16_bf16(b1, qq, p1, 0, 0, 0); }
#pragma unroll
  for (int d0 = 0; d0 < 4; ++d0) { const int cb = (d0 * 16 + hi * 8) * 2;
    const bf16x8 b0 = *(const LAS bf16x8*)(Kr + KRSWZ(r32, cb));
    const bf16x8 b1 = *(const LAS bf16x8*)(Kr + KRSWZ(32 + r32, cb));
    const bf16x8 qq = *(const LAS bf16x8*)(Qr + KNSWZ(r32, ((4 + d0) * 16 + hi * 8) * 2));
    p0 = __builtin_amdgcn_mfma_f32_32x32x16_bf16(b0, qq, p0, 0, 0, 0);
    p1 = __builtin_amdgcn_mfma_f32_32x32x16_bf16(b1, qq, p1, 0, 0, 0); }
}
__device__ __forceinline__ int v_st(int k, int c) { const int kk = (k & ~0xC) | ((k & 4) << 1) | ((k & 8) >> 1); return ((kk >> 3) * 4 + (c >> 5)) * 512 + ((kk & 7) * 32 + (c & 31)) * 2; }
__device__ __forceinline__ int v_rd_base(int lane) { return ((lane & 3) << 3) | (((lane >> 2) & 3) << 6) | (((lane >> 4) & 1) << 5) | (((lane >> 5) & 1) << 8); }
constexpr int v_rd_off(int d0, int ks, int half) { return d0 * 512 + ks * 4096 + half * 2048; }
template <int OFF> __device__ __forceinline__ s16x4 tr_read(int vb) {
  s16x4 r; asm volatile("ds_read_b64_tr_b16 %0, %1 offset:%2" : "=&v"(r) : "v"(vb), "i"(OFF) : "memory"); return r;
}
template <int D0> __device__ __forceinline__ void pv_one(f32x16& od, int vb, bf16x8 pa0, bf16x8 pa1, bf16x8 pa2, bf16x8 pa3) {
  const s16x4 l0 = tr_read<v_rd_off(D0, 0, 0)>(vb), h0 = tr_read<v_rd_off(D0, 0, 1)>(vb), l1 = tr_read<v_rd_off(D0, 1, 0)>(vb), h1 = tr_read<v_rd_off(D0, 1, 1)>(vb);
  const s16x4 l2 = tr_read<v_rd_off(D0, 2, 0)>(vb), h2 = tr_read<v_rd_off(D0, 2, 1)>(vb), l3 = tr_read<v_rd_off(D0, 3, 0)>(vb), h3 = tr_read<v_rd_off(D0, 3, 1)>(vb);
  asm volatile("s_waitcnt lgkmcnt(0)" ::: "memory"); SBAR();
#define PK(L, H) (bf16x8){L[0], L[1], L[2], L[3], H[0], H[1], H[2], H[3]}
  od = __builtin_amdgcn_mfma_f32_32x32x16_bf16(pa0, PK(l0, h0), od, 0, 0, 0);
  od = __builtin_amdgcn_mfma_f32_32x32x16_bf16(pa1, PK(l1, h1), od, 0, 0, 0);
  od = __builtin_amdgcn_mfma_f32_32x32x16_bf16(pa2, PK(l2, h2), od, 0, 0, 0);
  od = __builtin_amdgcn_mfma_f32_32x32x16_bf16(pa3, PK(l3, h3), od, 0, 0, 0);
#undef PK
}
__device__ __forceinline__ void pv_d0(f32x16 (&o)[4], int vb, bf16x8 pa0, bf16x8 pa1, bf16x8 pa2, bf16x8 pa3) {
  pv_one<0>(o[0], vb, pa0, pa1, pa2, pa3); pv_one<1>(o[1], vb, pa0, pa1, pa2, pa3); pv_one<2>(o[2], vb, pa0, pa1, pa2, pa3); pv_one<3>(o[3], vb, pa0, pa1, pa2, pa3);
}
__device__ __forceinline__ void attn_unit(const bf16_t* __restrict__ Q, const bf16_t* __restrict__ KV, const bf16_t* __restrict__ KR, bf16_t* __restrict__ MIX,
                                          const float* __restrict__ ropec, const float* __restrict__ ropes, int h, int qrow0, bool lat, int crow0, int lrow0, int NT, LAS char* lds) {
  int tid = threadIdx.x; asm volatile("" : "+v"(tid));
  const int wid = __builtin_amdgcn_readfirstlane(tid >> 6), lane = tid & 63, r32 = lane & 31, hi = lane >> 5;
  LAS char* V_lds = lds + OFF_V; LAS char* KN_lds = lds + OFF_KN; LAS char* KR_lds = lds + OFF_KR;
  LAS float* ws = (LAS float*)(lds + OFF_WS) + wid * 64; LAS float* li_l = ws; LAS float* al_l = ws + 32;
  float m_reg = -1e30f, l_reg = 0; f32x16 o[4] = {}; bf16x8 qr[4];
  LAS char* Qr = lds + OFF_QR + wid * SHM_QW;
  { const int qrow = qrow0 + wid * 32 + r32; const bf16_t* Qw = Q + (size_t)qrow * QW + h * QKD + hi * 8;
#pragma unroll
    for (int d0 = 0; d0 < 4; ++d0) qr[d0] = *(const bf16x8*)(Qw + d0 * 16);
#pragma unroll
    for (int d0 = 4; d0 < 8; ++d0) *(LAS bf16x8*)(Qr + KNSWZ(r32, ((d0 - 4) * 16 + hi * 8) * 2)) = *(const bf16x8*)(Qw + d0 * 16);
    const int n = (qrow - TC) & 4095;
#pragma unroll
    for (int ax = 0; ax < 2; ++ax) {
      const bf16x8 q1 = *(const bf16x8*)(Qw + (8 + 2 * ax) * 16), q2 = *(const bf16x8*)(Qw + (9 + 2 * ax) * 16);
      u32x4 w1 = *reinterpret_cast<const u32x4*>(&q1), w2 = *reinterpret_cast<const u32x4*>(&q2);
      if (lat) { const int pos = ax ? (n & 63) : (n >> 6); const float* cp = ropec + pos * 16 + hi * 8; const float* sp = ropes + pos * 16 + hi * 8;
#pragma unroll
        for (int j = 0; j < 4; ++j) { const float c0 = cp[2 * j], s0 = sp[2 * j], c1 = cp[2 * j + 1], s1 = sp[2 * j + 1];
          const float a0 = bf2f((bf16_t)q1[2 * j]), a1 = bf2f((bf16_t)q1[2 * j + 1]), b0 = bf2f((bf16_t)q2[2 * j]), b1 = bf2f((bf16_t)q2[2 * j + 1]);
          w1[j] = cvt_pk_bf16(a0 * c0 - b0 * s0, a1 * c1 - b1 * s1);
          w2[j] = cvt_pk_bf16(b0 * c0 + a0 * s0, b1 * c1 + a1 * s1); } }
      *(LAS u32x4*)(Qr + KNSWZ(r32, ((4 + 2 * ax) * 16 + hi * 8) * 2)) = w1; *(LAS u32x4*)(Qr + KNSWZ(r32, ((5 + 2 * ax) * 16 + hi * 8) * 2)) = w2; }
  }
  const int sr = tid >> 4, sc = (tid & 15) * 8, vst0 = v_st(sr, sc), vst1 = v_st(32 + sr, sc);
  const int rr = tid >> 3, rc = (tid & 7) * 8;
  const int vb0 = (int)(uintptr_t)V_lds + v_rd_base(lane);
  const bf16_t* KVh = KV + h * 256;
  const int nctx_t = lat ? 4 : NT;
  bf16x8 vs0, vs1, ks0, ks1, krs;
#define TROW(kt) ((kt) < nctx_t ? crow0 + (kt) * 64 : lrow0 + ((kt) - nctx_t) * 64)
#define SLOAD(kt) do { const int _r0 = TROW(kt); const bf16_t* _p0 = KVh + (size_t)(_r0 + sr) * KVW + sc; const bf16_t* _p1 = KVh + (size_t)(_r0 + 32 + sr) * KVW + sc; \
    vs0 = *(const bf16x8*)(_p0 + 128); vs1 = *(const bf16x8*)(_p1 + 128); ks0 = *(const bf16x8*)_p0; ks1 = *(const bf16x8*)_p1; krs = *(const bf16x8*)(KR + (size_t)(_r0 + rr) * ROPE + rc); } while (0)
#define SWRITE(b) do { *(LAS bf16x8*)(V_lds + (b) * SHM_V + vst0) = vs0; *(LAS bf16x8*)(V_lds + (b) * SHM_V + vst1) = vs1; \
    *(LAS bf16x8*)(KN_lds + (b) * SHM_KN + KNSWZ(sr, sc * 2)) = ks0; *(LAS bf16x8*)(KN_lds + (b) * SHM_KN + KNSWZ(32 + sr, sc * 2)) = ks1; \
    *(LAS bf16x8*)(KR_lds + (b) * SHM_KR + KRSWZ(rr, rc * 2)) = krs; } while (0)
#define SWAIT() asm volatile("s_waitcnt vmcnt(0)" ::: "memory")
#define RESC(a) do { if (__any((a) < 1.f)) { if (hi == 0) al_l[r32] = (a); asm volatile("s_waitcnt lgkmcnt(0)" ::: "memory"); \
    _Pragma("unroll") for (int d = 0; d < 4; ++d) _Pragma("unroll") for (int r = 0; r < 16; ++r) o[d][r] *= al_l[crow(r, hi)]; } } while (0)
  f32x16 pA0, pA1, pB0, pB1; float mnA, mnB, alA, alB; bf16x8 pa0, pa1, pa2, pa3;
  SLOAD(0); SWAIT(); SWRITE(0); __syncthreads();
  qkt(pA0, pA1, KN_lds, KR_lds, qr, Qr, r32, hi); partialSM(pA0, pA1, m_reg, mnA, alA);
  SLOAD(1); SWAIT(); SWRITE(1); __syncthreads();
  for (int j = 1; j + 1 < NT; j += 2) {
    SBAR(); qkt(pB0, pB1, KN_lds + SHM_KN, KR_lds + SHM_KR, qr, Qr, r32, hi);
    finishSM(pA0, pA1, alA, l_reg, pa0, pa1, pa2, pa3); SBAR();
    SLOAD(j + 1); SBAR();
    pv_d0(o, vb0, pa0, pa1, pa2, pa3); partialSM(pB0, pB1, m_reg, mnB, alB);
    __syncthreads(); SWAIT(); SWRITE(0);
    RESC(alB); __syncthreads();
    SBAR(); qkt(pA0, pA1, KN_lds, KR_lds, qr, Qr, r32, hi);
    finishSM(pB0, pB1, alB, l_reg, pa0, pa1, pa2, pa3); SBAR();
    SLOAD(j + 2); SBAR();
    pv_d0(o, vb0 + SHM_V, pa0, pa1, pa2, pa3); partialSM(pA0, pA1, m_reg, mnA, alA);
    __syncthreads(); SWAIT(); SWRITE(1);
    RESC(alA); __syncthreads();
  }
  SBAR(); qkt(pB0, pB1, KN_lds + SHM_KN, KR_lds + SHM_KR, qr, Qr, r32, hi);
  finishSM(pA0, pA1, alA, l_reg, pa0, pa1, pa2, pa3); SBAR();
  pv_d0(o, vb0, pa0, pa1, pa2, pa3); partialSM(pB0, pB1, m_reg, mnB, alB);
  __syncthreads(); RESC(alB);
  finishSM(pB0, pB1, alB, l_reg, pa0, pa1, pa2, pa3); SBAR();
  pv_d0(o, vb0 + SHM_V, pa0, pa1, pa2, pa3);
  if (hi == 0) li_l[r32] = l_reg; asm volatile("s_waitcnt lgkmcnt(0)" ::: "memory");
  float rli[16];
#pragma unroll
  for (int r = 0; r < 16; ++r) rli[r] = __builtin_amdgcn_rcpf(li_l[crow(r, hi)]);
  int tid2 = threadIdx.x; asm volatile("" : "+v"(tid2));
  const int r32e = tid2 & 31, hie = (tid2 >> 5) & 1;
  bf16_t* Ow = MIX + (size_t)(qrow0 + wid * 32) * D + h * VD + r32e;
#pragma unroll
  for (int r = 0; r < 16; ++r) { const int orow = crow(r, hie);
#pragma unroll
    for (int d0 = 0; d0 < 4; ++d0) Ow[(size_t)orow * D + d0 * 32] = f2bf(o[d0][r] * rli[r]); }
  __syncthreads();
#undef TROW
#undef SLOAD
#undef SWRITE
#undef SWAIT
#undef RESC
}
}
constexpr int Q5_ATT = 768, Q5_DFT = Q5_ATT + 128, Q5_ATTC = Q5_DFT + 48, Q5_DFTC = Q5_ATTC + 8, Q5_END = Q5_DFTC + CVT_JOBS;
__device__ __forceinline__ void ph_queue5(const Frame& F) {
    unsigned* qhead = (unsigned*)(F.ws + WS_CTL + CW_Q5);
    LAS int* qslot = (LAS int*)(F.lds + 640);
    const bf16_t* Q = WSP(bf16_t, R0_Q); const bf16_t* KV = WSP(bf16_t, R0_KV); const bf16_t* KR = WSP(bf16_t, R0_KR); bf16_t* MIX = WSP(bf16_t, R0_MIX);
    const float* rc = WSP(float, WS_ROPE); const float* rs = rc + 1024;
    for (;;) {
        __syncthreads();
        if (F.tid == 0) qslot[0] = (int)__hip_atomic_fetch_add(qhead, 1u, __ATOMIC_RELAXED, __HIP_MEMORY_SCOPE_AGENT);
        __syncthreads();
        const int it = __builtin_amdgcn_readfirstlane(qslot[0]);
        if (it >= Q5_END) break;
        if (it < Q5_ATT) { const int b = it / 96, rem = it % 96, h = rem / 16, qb = rem % 16;
            att::attn_unit(Q, KV, KR, MIX, rc, rs, h, TC + b * 4096 + qb * 256, true, b * 256, TC + b * 4096, 68, (LAS char*)F.ring); }
        else if (it < Q5_DFT || (it >= Q5_ATTC && it < Q5_DFTC)) {
            const bool lat = it < Q5_DFT; const int i = lat ? it - Q5_ATT : it - Q5_ATTC; const int b = lat ? i >> 4 : i, pm = lat ? i & 15 : 0; const int K = lat ? 4096 : 256;
            pg8::OneUnit S; S.lda = K; S.u0.pm = pm; S.u0.pn = 0; S.u0.e = b; S.u0.cnt = 0;
            S.u0.A = (const char*)(lat ? WSP(bf16_t, R0_DFT) : WSP(bf16_t, R0_DFTC)) + (size_t)pm * 256 * K * 2;
            S.u0.B = (const char*)(lat ? WSP(bf16_t, R0_TT2) : WSP(bf16_t, R0_TTC2)) + (size_t)b * 256 * K * 2;
            pg8::EpiFourOut E{MIX, lat ? TC : 0, lat ? 4096 : 256};
            pg8::gemm_phase<pg8::EpiFourOut, pg8::OneUnit>(F.ring, pg8::Gemm{K, K, K}, S, E); }
        else if (it < Q5_ATTC) { const int uu = it - Q5_DFT, b = uu / 6, h = uu % 6;
            att::attn_unit(Q, KV, KR, MIX, rc, rs, h, b * 256, false, b * 256, 0, 4, (LAS char*)F.ring); }
        else cvt_moe_job(F, (LAS float*)F.ring, F.in[I0_WGU], F.in[I0_WDN], it - Q5_DFTC);
    }
}

__device__ __forceinline__ void load_w32(const Frame& F, LAS float* wl, const float* W, int ldw) {
    for (int i = F.tid; i < 1024 * 8; i += NTHR) { const int r = i >> 3, q = i & 7; const int c = 8 * (r & 63) + 512 * (r >> 9) + ((r >> 6) & 7); const f32x4 v = *(const f32x4*)(W + (size_t)c * ldw + q * 4); *(LAS f32x4*)(wl + r * 36 + q * 4) = v; }
}
__device__ __forceinline__ float row_gemv32(const float (&v)[16], const LAS float* wl, int lane) {
    float p[32];
#pragma unroll
    for (int e = 0; e < 32; ++e) p[e] = 0.f;
#pragma unroll
    for (int i = 0; i < 16; ++i) { const LAS float* wr_ = wl + (lane + 64 * i) * 36;
#pragma unroll
        for (int q = 0; q < 8; ++q) { const f32x4 w = *(const LAS f32x4*)(wr_ + q * 4); p[4 * q] = fmaf(v[i], w[0], p[4 * q]); p[4 * q + 1] = fmaf(v[i], w[1], p[4 * q + 1]); p[4 * q + 2] = fmaf(v[i], w[2], p[4 * q + 2]); p[4 * q + 3] = fmaf(v[i], w[3], p[4 * q + 3]); }
        asm volatile("" ::: "memory"); }
    float a16[16], a8[8], a4[4], a2[2];
    { const bool up = (lane & 32) != 0;
#pragma unroll
      for (int i = 0; i < 16; ++i) { const float send = up ? p[i] : p[i + 16], keep = up ? p[i + 16] : p[i]; a16[i] = keep + __shfl_xor(send, 32); } }
    { const bool up = (lane & 16) != 0;
#pragma unroll
      for (int i = 0; i < 8; ++i) { const float send = up ? a16[i] : a16[i + 8], keep = up ? a16[i + 8] : a16[i]; a8[i] = keep + __shfl_xor(send, 16); } }
    { const bool up = (lane & 8) != 0;
#pragma unroll
      for (int i = 0; i < 4; ++i) { const float send = up ? a8[i] : a8[i + 4], keep = up ? a8[i + 4] : a8[i]; a4[i] = keep + __shfl_xor(send, 8); } }
    { const bool up = (lane & 4) != 0;
#pragma unroll
      for (int i = 0; i < 2; ++i) { const float send = up ? a4[i] : a4[i + 2], keep = up ? a4[i + 2] : a4[i]; a2[i] = keep + __shfl_xor(send, 4); } }
    float a1; { const bool up = (lane & 2) != 0; const float send = up ? a2[0] : a2[1], keep = up ? a2[1] : a2[0]; a1 = keep + __shfl_xor(send, 2); }
    a1 += __shfl_xor(a1, 1);
    return a1;
}
__device__ __forceinline__ void row_gemv32x2(const float (&va)[16], const float (&vb)[16], const LAS float* wl, int lane, float& ya, float& yb) {
    float p[32], q[32];
#pragma unroll
    for (int e = 0; e < 32; ++e) { p[e] = 0.f; q[e] = 0.f; }
#pragma unroll
    for (int i = 0; i < 16; ++i) { const LAS float* wr_ = wl + (lane + 64 * i) * 36;
#pragma unroll
        for (int k = 0; k < 8; ++k) { const f32x4 w = *(const LAS f32x4*)(wr_ + k * 4);
            p[4 * k] = fmaf(va[i], w[0], p[4 * k]); p[4 * k + 1] = fmaf(va[i], w[1], p[4 * k + 1]); p[4 * k + 2] = fmaf(va[i], w[2], p[4 * k + 2]); p[4 * k + 3] = fmaf(va[i], w[3], p[4 * k + 3]);
            q[4 * k] = fmaf(vb[i], w[0], q[4 * k]); q[4 * k + 1] = fmaf(vb[i], w[1], q[4 * k + 1]); q[4 * k + 2] = fmaf(vb[i], w[2], q[4 * k + 2]); q[4 * k + 3] = fmaf(vb[i], w[3], q[4 * k + 3]); }
        asm volatile("" ::: "memory"); }
    float a16[16], b16[16], a8[8], b8[8], a4[4], b4[4], a2[2], b2[2];
    { const bool up = (lane & 32) != 0;
#pragma unroll
      for (int i = 0; i < 16; ++i) { a16[i] = (up ? p[i + 16] : p[i]) + __shfl_xor(up ? p[i] : p[i + 16], 32); b16[i] = (up ? q[i + 16] : q[i]) + __shfl_xor(up ? q[i] : q[i + 16], 32); } }
    { const bool up = (lane & 16) != 0;
#pragma unroll
      for (int i = 0; i < 8; ++i) { a8[i] = (up ? a16[i + 8] : a16[i]) + __shfl_xor(up ? a16[i] : a16[i + 8], 16); b8[i] = (up ? b16[i + 8] : b16[i]) + __shfl_xor(up ? b16[i] : b16[i + 8], 16); } }
    { const bool up = (lane & 8) != 0;
#pragma unroll
      for (int i = 0; i < 4; ++i) { a4[i] = (up ? a8[i + 4] : a8[i]) + __shfl_xor(up ? a8[i] : a8[i + 4], 8); b4[i] = (up ? b8[i + 4] : b8[i]) + __shfl_xor(up ? b8[i] : b8[i + 4], 8); } }
    { const bool up = (lane & 4) != 0;
#pragma unroll
      for (int i = 0; i < 2; ++i) { a2[i] = (up ? a4[i + 2] : a4[i]) + __shfl_xor(up ? a4[i] : a4[i + 2], 4); b2[i] = (up ? b4[i + 2] : b4[i]) + __shfl_xor(up ? b4[i] : b4[i + 2], 4); } }
    { const bool up = (lane & 2) != 0; ya = (up ? a2[1] : a2[0]) + __shfl_xor(up ? a2[0] : a2[1], 2); yb = (up ? b2[1] : b2[0]) + __shfl_xor(up ? b2[0] : b2[1], 2); }
    ya += __shfl_xor(ya, 1); yb += __shfl_xor(yb, 1);
}
__device__ __forceinline__ void ph_router(const Frame& F, int layer, int r0) {
    typedef float f32x16 __attribute__((ext_vector_type(16)));
    constexpr int HROW = 2064;
    LAS char* HHI = (LAS char*)F.ring; LAS char* HLO = HHI + 32 * HROW; LAS float* RED = (LAS float*)F.ring;
    LAS float* SCR = (LAS float*)(F.ring + 2 * 32 * HROW);
    LAS unsigned* lcnt = (LAS unsigned*)(F.lds + 512);
    const float* g = F.in[layer ? I1_N2G : I0_N2G]; const float* rb_ = F.in[layer ? I1_RB : I0_RB];
    if (F.tid < 64) lcnt[F.tid] = 0u;
    __syncthreads();
    bf16_t* H = WSP(bf16_t, WS_H); unsigned* cnt = (unsigned*)(F.ws + WS_CTL + CW_CNT) + layer * 64;
    int* list = WSP(int, WS_LIST); int* toke = WSP(int, WS_TOKE); int* tokp = WSP(int, WS_TOKP); float* tokg = WSP(float, WS_TOKG);
    const float* modv = WSP(float, WS_MODV) + (size_t)layer * 9 * 6144;
    const bf16_t* WT = WSP(bf16_t, WS_RWT) + (size_t)layer * 2 * 32 * 1024;
    const bf16_t* Yb = layer == 0 ? WSP(bf16_t, R0_U0) : WSP(bf16_t, R1_OF) - (size_t)TC * D;
    const int per = (T - r0 + F.G - 1) / F.G; const int rbeg = r0 + F.bid * per; const int rend = (rbeg + per < T) ? rbeg + per : T;
    const int lane = F.lane, wave = F.wave, r32 = lane & 31, hi2 = lane >> 5;
    float gg[16]; ld16f(g, lane, gg);
    float scv[16], shv[16]; int curm = -1;
    for (int tb = rbeg; tb < rend; tb += 32) {
#pragma unroll 1
        for (int q = 0; q < 4; ++q) { const int tr = 4 * wave + q, r = tb + tr; if (r >= rend) break;
            float v[16];
            { float y[16]; ld16f(layer == 0 ? xrow_in(F, r) : xrow_res(F, r), lane, v); ld16b(Yb + (size_t)r * D, lane, y);
#pragma unroll
              for (int i = 0; i < 16; ++i) v[i] += y[i];
              st16f(xrow_res(F, r), lane, v); }
            float ss = 0.f;
#pragma unroll
            for (int i = 0; i < 16; ++i) ss = fmaf(v[i], v[i], ss);
            const float rs = rsqrtf(wsum(ss) * (1.0f / D) + EPS);
            const int m = modrow(r);
            if (m != curm) { const float* mv = modv + (size_t)m * 6144; ld16f(mv + 4096, lane, scv); ld16f(mv + 3072, lane, shv); curm = m; }
#pragma unroll
            for (int i = 0; i < 16; ++i) v[i] = v[i] * rs * gg[i] * (1.0f + scv[i]) + shv[i];
#pragma unroll
            for (int h = 0; h < 2; ++h) { u32x4 whi, wlo;
#pragma unroll
                for (int k = 0; k < 4; ++k) { const unsigned ph = cvt_pk_bf16(v[8 * h + 2 * k], v[8 * h + 2 * k + 1]); whi[k] = ph;
                    wlo[k] = cvt_pk_bf16(v[8 * h + 2 * k] - __uint_as_float(ph << 16), v[8 * h + 2 * k + 1] - __uint_as_float(ph & 0xffff0000u)); }
                *(u32x4*)(H + (size_t)r * D + 8 * lane + 512 * h) = whi;
                *(LAS u32x4*)(HHI + tr * HROW + (8 * lane + 512 * h) * 2) = whi; *(LAS u32x4*)(HLO + tr * HROW + (8 * lane + 512 * h) * 2) = wlo; } }
        __syncthreads();
        f32x16 acc = {};
        { const LAS char* ah = HHI + r32 * HROW + (wave * 128 + hi2 * 8) * 2; const LAS char* al = HLO + r32 * HROW + (wave * 128 + hi2 * 8) * 2;
          const bf16_t* wh = WT + (size_t)r32 * 1024 + wave * 128 + hi2 * 8; const bf16_t* wlp = wh + 32 * 1024;
#pragma unroll
          for (int sst = 0; sst < 8; ++sst) { const bf16x8 a_h = *(const LAS bf16x8*)(ah + sst * 32), a_l = *(const LAS bf16x8*)(al + sst * 32);
              const bf16x8 b_h = *(const bf16x8*)(wh + sst * 16), b_l = *(const bf16x8*)(wlp + sst * 16);
              acc = __builtin_amdgcn_mfma_f32_32x32x16_bf16(a_h, b_h, acc, 0, 0, 0);
              acc = __builtin_amdgcn_mfma_f32_32x32x16_bf16(a_h, b_l, acc, 0, 0, 0);
              acc = __builtin_amdgcn_mfma_f32_32x32x16_bf16(a_l, b_h, acc, 0, 0, 0); } }
        __syncthreads();
#pragma unroll
        for (int r = 0; r < 16; ++r) { const int row = (r & 3) + 8 * (r >> 2) + 4 * hi2; RED[(wave * 32 + row) * 32 + r32] = acc[r]; }
        __syncthreads();
#pragma unroll 1
        for (int pq = 0; pq < 2; ++pq) { const int tr = 4 * wave + 2 * pq + hi2, r = tb + tr; const int e = r32;
            float lg = rb_[e];
#pragma unroll
            for (int w8 = 0; w8 < 8; ++w8) lg += RED[(w8 * 32 + tr) * 32 + e];
            LAS float* sc_ = SCR + tr * 40;
            sc_[e] = lg;
            asm volatile("s_waitcnt lgkmcnt(0)" ::: "memory");
            int rank = 0;
#pragma unroll
            for (int q8 = 0; q8 < 8; ++q8) { const f32x4 v4 = *(const LAS f32x4*)(sc_ + 4 * q8);
#pragma unroll
                for (int j = 0; j < 4; ++j) rank += (int)((v4[j] > lg) | ((v4[j] == lg) & ((4 * q8 + j) < e))); }
            if (rank < 4) { sc_[32 + rank] = lg; ((LAS int*)sc_)[36 + rank] = e; }
            asm volatile("s_waitcnt lgkmcnt(0)" ::: "memory");
            const f32x4 tvv = *(const LAS f32x4*)(sc_ + 32); const u32x4 tev = *(const LAS u32x4*)(sc_ + 36);
            asm volatile("s_waitcnt lgkmcnt(0)" ::: "memory");
            const float e1 = __expf(tvv[1] - tvv[0]), e2 = __expf(tvv[2] - tvv[0]), e3 = __expf(tvv[3] - tvv[0]); const float inv = 1.0f / (1.0f + e1 + e2 + e3);
            if (r32 < 4 && r < rend) { const int k = r32; const int ek = (int)(k == 0 ? tev[0] : k == 1 ? tev[1] : k == 2 ? tev[2] : tev[3]); const float gk = (k == 0 ? 1.0f : k == 1 ? e1 : k == 2 ? e2 : e3) * inv;
                const unsigned lp = __hip_atomic_fetch_add(lcnt + ek, 1u, __ATOMIC_RELAXED, __HIP_MEMORY_SCOPE_WORKGROUP);
                toke[r * 4 + k] = ek; tokp[r * 4 + k] = (int)lp; tokg[r * 4 + k] = gk; } }
        __syncthreads();
    }
    __syncthreads();
    if (F.tid < 32) { const unsigned c = lcnt[F.tid]; lcnt[32 + F.tid] = c ? __hip_atomic_fetch_add(cnt + F.tid, c, __ATOMIC_RELAXED, __HIP_MEMORY_SCOPE_AGENT) : 0u; }
    __syncthreads();
    for (int i = rbeg * 4 + F.tid; i < rend * 4; i += NTHR) {
        const int ek = __hip_atomic_load(toke + i, __ATOMIC_RELAXED, __HIP_MEMORY_SCOPE_AGENT); const int pos = __hip_atomic_load(tokp + i, __ATOMIC_RELAXED, __HIP_MEMORY_SCOPE_AGENT) + (int)lcnt[32 + ek]; tokp[i] = pos; list[(size_t)ek * T + pos] = i >> 2; }
}
__device__ __forceinline__ int moe_tstart(const Frame& F, int layer, LAS int* tstart) {
    unsigned* cnt = (unsigned*)(F.ws + WS_CTL + CW_CNT) + layer * 64;
    __syncthreads();
    if (F.tid == 0) { int s = 0; for (int e = 0; e < NE; ++e) { const int c = (int)__hip_atomic_load(cnt + e, __ATOMIC_RELAXED, __HIP_MEMORY_SCOPE_AGENT); tstart[e] = s; tstart[40 + e] = c; s += (c + 255) >> 8; } tstart[NE] = s; }
    __syncthreads();
    { LAS int* t2e = (LAS int*)(F.ring + 140000); const int nt = tstart[NE];
      for (int t = F.tid; t < nt; t += NTHR) { int e = 0; for (int j = 1; j < NE; ++j) e += (t >= tstart[j]) ? 1 : 0; t2e[t] = e; } }
    __syncthreads();
    return __builtin_amdgcn_readfirstlane(tstart[NE]);
}
__device__ __forceinline__ void ph_moe1(const Frame& F, int layer) {
    LAS int* tstart = (LAS int*)(F.lds + 64); const int ntile = moe_tstart(F, layer, tstart);
    pg8::MoeOrder<true> S; S.A = (const char*)WSP(bf16_t, WS_H); S.B = (const char*)WSP(bf16_t, WS_WGU); S.sB = (size_t)2048 * 1024 * 2; S.lda = D; S.ldb = D; S.npn = 8; S.nwg = ntile * 8; S.G = F.G; S.c = F.bid;
    S.tstart = tstart; S.cnt = tstart + 40; S.list = WSP(int, WS_LIST); S.t2e = (const LAS int*)(F.ring + 140000);
    pg8::EpiSwiglu E{WSP(bf16_t, WS_ACT), F.in[layer ? I1_BGU : I0_BGU]};
    pg8::gemm_phase<pg8::EpiSwiglu, pg8::MoeOrder<true>>(F.ring, pg8::Gemm{D, D, D}, S, E);
}
__device__ __forceinline__ void ph_moe2(const Frame& F, int layer) {
    LAS int* tstart = (LAS int*)(F.lds + 64); const int ntile = moe_tstart(F, layer, tstart);
    pg8::MoeOrder<false> S; S.A = (const char*)WSP(bf16_t, WS_ACT); S.B = (const char*)WSP(bf16_t, WS_WDN); S.sB = (size_t)1024 * 1024 * 2; S.lda = FF; S.ldb = FF; S.npn = 4; S.nwg = ntile * 4; S.G = F.G; S.c = F.bid;
    S.tstart = tstart; S.cnt = tstart + 40; S.list = nullptr; S.t2e = (const LAS int*)(F.ring + 140000);
    pg8::EpiDown E{WSP(bf16_t, RM_YB), F.in[layer ? I1_BDN : I0_BDN]};
    pg8::gemm_phase<pg8::EpiDown, pg8::MoeOrder<false>>(F.ring, pg8::Gemm{FF, FF, FF}, S, E);
}
__device__ __forceinline__ void moe_combine_row(const Frame& F, int layer, int r, const LAS int* tstart, float (&v)[16]) {
    const int* toke = WSP(int, WS_TOKE); const int* tokp = WSP(int, WS_TOKP); const float* tokg = WSP(float, WS_TOKG); const bf16_t* YB = WSP(bf16_t, RM_YB);
    const float* g2 = WSP(float, WS_MODV) + (size_t)(layer * 9 + modrow(r)) * 6144 + 5120;
    float y[16];
#pragma unroll
    for (int i = 0; i < 16; ++i) y[i] = 0.f;
#pragma unroll
    for (int k = 0; k < 4; ++k) { const int e = toke[r * 4 + k]; const size_t prow = (size_t)tstart[e] * 256 + tokp[r * 4 + k]; const float gk = tokg[r * 4 + k]; float yy[16]; ld16b(YB + prow * D, F.lane, yy);
#pragma unroll
        for (int i = 0; i < 16; ++i) y[i] = fmaf(gk, yy[i], y[i]); }
    float gg[16]; ld16f(g2, F.lane, gg); ld16f(xrow_res(F, r), F.lane, v);
#pragma unroll
    for (int i = 0; i < 16; ++i) v[i] = fmaf(gg[i], y[i], v[i]);
}
__device__ __forceinline__ void ph_combine_mod1(const Frame& F) {
    LAS int* tstart = (LAS int*)(F.lds + 64); moe_tstart(F, 0, tstart);
    LAS float* wl = (LAS float*)F.ring;
    load_w32(F, wl, F.in[I1_WIN] + 3072, 3104);
    __syncthreads();
    const float* g = F.in[I1_N1G]; bf16_t* H = WSP(bf16_t, WS_H); float* GD = WSP(float, WS_GD);
    const float* modv = WSP(float, WS_MODV) + (size_t)9 * 6144;
    for (int r = F.bid * NWAVE + F.wave; r < T; r += F.G * NWAVE) {
        float v[16]; moe_combine_row(F, 0, r, tstart, v);
        const float* mv = modv + (size_t)modrow(r) * 6144;
        st16f(xrow_res(F, r), F.lane, v);
        modulate16(v, g, mv + 1024, mv, F.lane);
        st16b(H + (size_t)r * D, F.lane, v);
        const float gd = row_gemv32(v, wl, F.lane);
        if ((F.lane & 1) == 0) GD[(size_t)r * 32 + (F.lane >> 1)] = gd;
    }
    __syncthreads();
    cvt_moe_weights(F, (LAS float*)F.ring, F.in[I1_WGU], F.in[I1_WDN]);
}
__device__ __forceinline__ void ph_final(const Frame& F) {
    LAS int* tstart = (LAS int*)(F.lds + 64); moe_tstart(F, 1, tstart);
    const float* g = F.in[I_FNG];
    for (int r = TC + F.bid * NWAVE + F.wave; r < T; r += F.G * NWAVE) {
        float v[16]; moe_combine_row(F, 1, r, tstart, v); float ss = 0.f;
#pragma unroll
        for (int i = 0; i < 16; ++i) ss = fmaf(v[i], v[i], ss);
        const float rs = rsqrtf(wsum(ss) * (1.0f / D) + EPS); float gg[16]; ld16f(g, F.lane, gg);
#pragma unroll
        for (int i = 0; i < 16; ++i) v[i] = v[i] * rs * gg[i];
        st16f(F.out + (size_t)(r - TC) * D, F.lane, v);
    }
}

namespace gla3 {
using att::f32x16; using att::s16x4; using att::crow; using att::v_st; using att::v_rd_base; using att::v_rd_off; using att::tr_read;
constexpr int ROWB = 272;
constexpr int P_GD = 0, P_TOT = 4096, P_WG = 8192;
constexpr int O_QD = 0, O_KD = 17408, O_KS = 34816, O_VV = 51200, O_ST = 67584, O_DEC = 102400;
constexpr size_t TILE_B = 64 * 128 * 2, ITEM_B = 2 * TILE_B;
#define GPK(L, H) (bf16x8){L[0], L[1], L[2], L[3], H[0], H[1], H[2], H[3]}
#define CH_ROW0(b, dir, cc) ((cc) < 4 ? ((b) * 256 + ((dir) ? 3 - (cc) : (cc)) * 64) : (TC + (b) * 4096 + ((dir) ? 67 - (cc) : (cc) - 4) * 64))
#define TOK(dir, jj) ((dir) ? 63 - (jj) : (jj))
__device__ __forceinline__ void pre_phase(const Frame& F) {
  LAS char* lds = (LAS char*)F.ring;
  int tid = threadIdx.x; asm volatile("" : "+v"(tid));
  const int wid = __builtin_amdgcn_readfirstlane(tid >> 6), lane = tid & 63;
  LAS float* gds = (LAS float*)(lds + P_GD); LAS float* tot = (LAS float*)(lds + P_TOT); LAS float* wgall = (LAS float*)(lds + P_WG);
  const bf16_t* U1 = WSP(bf16_t, R1_U1); const float* GD = WSP(float, WS_GD);
  char* tiles = (char*)(F.ws + WS_ACT); float* decbuf = (float*)(F.ws + WS_ACT + (size_t)4352 * ITEM_B);
  for (int i = tid; i < 8 * 17 * 128; i += NTHR) { const int tb = i / (17 * 128), rem = i % (17 * 128), r = rem >> 7, d = rem & 127, hd = tb >> 1, dir = tb & 1;
    const float* Wg = dir ? F.in[I1_WGKB] : F.in[I1_WGKF]; const float* Bg = dir ? F.in[I1_BGKB] : F.in[I1_BGKF]; wgall[i] = (r < 16) ? Wg[r * 512 + hd * 128 + d] : Bg[hd * 128 + d]; }
  const int d0 = 2 * lane, tg = wid, gj = tid >> 3, gr = (tid & 7) * 2;
  unsigned qreg[8], kreg[8]; f32x2 gdreg;
#define PLOAD(u) do { const int _cc = (u) % 68, _s = (u) / 68, _dir = _s & 1, _hd = (_s >> 1) & 3, _b = _s >> 3; const int _r0 = CH_ROW0(_b, _dir, _cc); \
    const bf16_t* _uq = U1 + _hd * 128 + d0; \
    _Pragma("unroll") for (int i = 0; i < 8; ++i) { const bf16_t* _p = _uq + (size_t)(_r0 + TOK(_dir, 8 * tg + i)) * U1W; qreg[i] = *(const unsigned*)_p; kreg[i] = *(const unsigned*)(_p + 512); } \
    gdreg = *(const f32x2*)(GD + (size_t)(_r0 + TOK(_dir, gj)) * 32 + _dir * 16 + gr); } while (0)
  int u = F.bid;
  if (u < 4352) PLOAD(u);
  __syncthreads();
  for (; u < 4352; u += F.G) {
    const int sc = u / 68, dir = sc & 1, hd = (sc >> 1) & 3;
    const LAS float* wg = wgall + (hd * 2 + dir) * 17 * 128;
    *(LAS f32x2*)(gds + gj * 16 + gr) = gdreg;
    __syncthreads();
    float cl0[8], cl1[8];
    { float z0[8], z1[8]; const f32x2 bb = *(const LAS f32x2*)(wg + 16 * 128 + d0);
#pragma unroll
      for (int i = 0; i < 8; ++i) { z0[i] = bb[0]; z1[i] = bb[1]; }
#pragma unroll
      for (int r4 = 0; r4 < 4; ++r4) { f32x2 w[4];
#pragma unroll
        for (int q = 0; q < 4; ++q) w[q] = *(const LAS f32x2*)(wg + (4 * r4 + q) * 128 + d0);
#pragma unroll
        for (int i = 0; i < 8; ++i) { const f32x4 g4 = *(const LAS f32x4*)(gds + (8 * tg + i) * 16 + 4 * r4);
#pragma unroll
          for (int q = 0; q < 4; ++q) { z0[i] = fmaf(g4[q], w[q][0], z0[i]); z1[i] = fmaf(g4[q], w[q][1], z1[i]); } } }
      float a0 = 0.f, a1 = 0.f;
#pragma unroll
      for (int i = 0; i < 8; ++i) { const float l0 = fminf(z0[i], 0.f) - __logf(1.0f + __expf(-fabsf(z0[i]))), l1 = fminf(z1[i], 0.f) - __logf(1.0f + __expf(-fabsf(z1[i])));
        a0 += l0 * (1.0f / 16.0f); a1 += l1 * (1.0f / 16.0f); cl0[i] = a0; cl1[i] = a1; }
      *(LAS f32x2*)(tot + tg * 128 + d0) = (f32x2){a0, a1}; }
    __syncthreads();
    { float off0 = 0.f, off1 = 0.f, last0 = 0.f, last1 = 0.f;
#pragma unroll
      for (int g = 0; g < 8; ++g) { const f32x2 tv = *(const LAS f32x2*)(tot + g * 128 + d0); if (g < tg) { off0 += tv[0]; off1 += tv[1]; } last0 += tv[0]; last1 += tv[1]; }
      const float el0 = __expf(last0), el1 = __expf(last1);
      if (tg == 0) *(f32x2*)(decbuf + (size_t)u * 128 + d0) = (f32x2){el0, el1};
      char* it = tiles + (size_t)u * ITEM_B + d0 * 2;
#pragma unroll
      for (int i = 0; i < 8; ++i) { const int jj = 8 * tg + i; const float e0 = __expf(off0 + cl0[i]), e1 = __expf(off1 + cl1[i]); const float r0 = __builtin_amdgcn_rcpf(e0), r1 = __builtin_amdgcn_rcpf(e1);
        const float q0 = __uint_as_float(qreg[i] << 16), q1 = __uint_as_float(qreg[i] & 0xffff0000u), k0 = __uint_as_float(kreg[i] << 16), k1 = __uint_as_float(kreg[i] & 0xffff0000u);
        *(unsigned*)(it + jj * 256) = cvt_pk_bf16(q0 * e0, q1 * e1);
        *(unsigned*)(it + TILE_B + jj * 256) = cvt_pk_bf16(k0 * r0, k1 * r1); } }
    if (u + F.G < 4352) PLOAD(u + F.G);
    __syncthreads();
  }
#undef PLOAD
}
constexpr int SB_QD = 0, SB_KD = 16384, SB_VV = 32768, SB_DEC = 40960, SB_BYTES = 41984, O_ST2 = 3 * SB_BYTES;
constexpr int vc_off(int d0, int ks, int half) { return d0 * 512 + ks * 2048 + half * 1024; }
struct SeqCtx { LAS char* lds; const char* tiles; const char* decb; const bf16_t* Uv; bf16_t* OUT; unsigned sQ[2], sK[2], ldsw; int vk, b, dir, hd, dvs, wid, lane, r32, hi, trb, xq, eb, db, kdo; };
#define DMA16(gptr, ldsoff) __builtin_amdgcn_global_load_lds((const unsigned*)(gptr), (LAS unsigned*)(C.lds + (ldsoff)), 16, 0, 0)
__device__ __forceinline__ void seq_issue(const SeqCtx& C, int cc) {
    const int bo = (cc % 3) * SB_BYTES; const char* t = C.tiles + (size_t)cc * ITEM_B;
    DMA16(t + C.sQ[0], bo + SB_QD + C.ldsw); DMA16(t + C.sQ[1], bo + SB_QD + 8192 + C.ldsw);
    DMA16(t + TILE_B + C.sK[0], bo + SB_KD + C.ldsw); DMA16(t + TILE_B + C.sK[1], bo + SB_KD + 8192 + C.ldsw);
    DMA16(C.Uv + (size_t)(CH_ROW0(C.b, C.dir, cc) + TOK(C.dir, C.vk)) * U1W, bo + SB_VV + C.ldsw);
    if (C.wid == 7) DMA16(C.decb + (size_t)cc * 512 + C.lane * 16, bo + SB_DEC);
}
#undef DMA16
template <int IB> __device__ __forceinline__ void seq_out_loop(const SeqCtx& C) {
  const int r32 = C.r32, hi = C.hi, xq = C.xq;
  for (int cc = 0; cc < 68; ++cc) {
    if (cc >= 6 && cc < 67) asm volatile("s_waitcnt vmcnt(37)" ::: "memory"); else if (cc >= 1 && cc < 67) asm volatile("s_waitcnt vmcnt(5)" ::: "memory"); else asm volatile("s_waitcnt vmcnt(0)" ::: "memory");
    asm volatile("s_waitcnt lgkmcnt(0)" ::: "memory");
    __builtin_amdgcn_s_barrier();
    asm volatile("" ::: "memory");
    if (cc + 2 < 68) seq_issue(C, cc + 2);
    if (cc < 4) continue;
    const LAS char* sb = C.lds + (cc % 3) * SB_BYTES;
    const LAS char* STp = C.lds + O_ST2 + ((cc + 1) & 1) * 17408;
    f32x16 p0 = {}, p1 = {}, o = {};
    const LAS char* QDr = sb + SB_QD + (32 * IB + r32) * 256; const LAS char* KDr = sb + SB_KD + C.kdo;
#pragma unroll
    for (int k = 0; k < 8; ++k) { const int po = (k << 5) ^ xq; const bf16x8 qf = *(const LAS bf16x8*)(QDr + po); const bf16x8 k0f = *(const LAS bf16x8*)(KDr + (k >> 1) * 512 + (k & 1) * 32);
      p0 = __builtin_amdgcn_mfma_f32_32x32x16_bf16(k0f, qf, p0, 0, 0, 0);
      if (IB) { const bf16x8 k1f = *(const LAS bf16x8*)(KDr + 8192 + (k >> 1) * 512 + (k & 1) * 32); p1 = __builtin_amdgcn_mfma_f32_32x32x16_bf16(k1f, qf, p1, 0, 0, 0); } }
#pragma unroll
    for (int r = 0; r < 16; ++r) { const bool kill = crow(r, hi) > r32; if (IB == 0) p0[r] = kill ? 0.f : p0[r]; else p1[r] = kill ? 0.f : p1[r]; }
    bf16x8 pa0, pa1, pa2, pa3;
#define PK4(P, BASE, OUT_) do { unsigned a0 = cvt_pk_bf16(P[BASE + 0], P[BASE + 1]), a1 = cvt_pk_bf16(P[BASE + 2], P[BASE + 3]);   \
    unsigned b0 = cvt_pk_bf16(P[BASE + 4], P[BASE + 5]), b1 = cvt_pk_bf16(P[BASE + 6], P[BASE + 7]);                              \
    auto r0 = __builtin_amdgcn_permlane32_swap(a0, b0, false, false); auto r1 = __builtin_amdgcn_permlane32_swap(a1, b1, false, false); \
    u32x4 w = {r0[0], r1[0], r0[1], r1[1]}; OUT_ = *reinterpret_cast<bf16x8*>(&w); } while (0)
    PK4(p0, 0, pa0); PK4(p0, 8, pa1); if (IB) { PK4(p1, 0, pa2); PK4(p1, 8, pa3); }
#undef PK4
    { const int vb = (int)(uintptr_t)(sb + SB_VV) + C.trb + C.eb * 512;
      const s16x4 l0 = tr_read<vc_off(0, 0, 0)>(vb), h0 = tr_read<vc_off(0, 0, 1)>(vb), l1 = tr_read<vc_off(0, 1, 0)>(vb), h1 = tr_read<vc_off(0, 1, 1)>(vb);
      s16x4 l2, h2, l3, h3;
      if (IB) { l2 = tr_read<vc_off(0, 2, 0)>(vb); h2 = tr_read<vc_off(0, 2, 1)>(vb); l3 = tr_read<vc_off(0, 3, 0)>(vb); h3 = tr_read<vc_off(0, 3, 1)>(vb); }
      asm volatile("s_waitcnt lgkmcnt(0)" ::: "memory"); __builtin_amdgcn_sched_barrier(0);
      o = __builtin_amdgcn_mfma_f32_32x32x16_bf16(pa0, GPK(l0, h0), o, 0, 0, 0);
      o = __builtin_amdgcn_mfma_f32_32x32x16_bf16(pa1, GPK(l1, h1), o, 0, 0, 0);
      if (IB) { o = __builtin_amdgcn_mfma_f32_32x32x16_bf16(pa2, GPK(l2, h2), o, 0, 0, 0);
                o = __builtin_amdgcn_mfma_f32_32x32x16_bf16(pa3, GPK(l3, h3), o, 0, 0, 0); } }
    { const LAS char* STr = STp + (32 * C.eb + r32) * ROWB + hi * 16;
#pragma unroll
      for (int k = 0; k < 8; ++k) { const bf16x8 qf = *(const LAS bf16x8*)(QDr + ((k << 5) ^ xq)); const bf16x8 sf = *(const LAS bf16x8*)(STr + k * 32);
        o = __builtin_amdgcn_mfma_f32_32x32x16_bf16(qf, sf, o, 0, 0, 0); } }
    bf16_t* op = C.OUT + (size_t)(CH_ROW0(C.b, C.dir, cc) - TC) * D + C.hd * 256 + C.dvs * 64 + 32 * C.eb + r32;
#pragma unroll
    for (int r = 0; r < 16; ++r) { const int i = 32 * IB + crow(r, hi); op[(size_t)TOK(C.dir, i) * D] = f2bf(o[r]); }
  }
}
__device__ __forceinline__ void seq_state_loop(const SeqCtx& C) {
  const int r32 = C.r32, hi = C.hi, db = C.db;
  f32x16 S0 = {}, S1 = {};
  for (int cc = 0; cc < 68; ++cc) {
    if (cc >= 1 && cc < 67) { if (C.wid == 7) asm volatile("s_waitcnt vmcnt(6)" ::: "memory"); else asm volatile("s_waitcnt vmcnt(5)" ::: "memory"); } else asm volatile("s_waitcnt vmcnt(0)" ::: "memory");
    asm volatile("s_waitcnt lgkmcnt(0)" ::: "memory");
    __builtin_amdgcn_s_barrier();
    asm volatile("" ::: "memory");
    if (cc + 2 < 68) seq_issue(C, cc + 2);
    const LAS char* sb = C.lds + (cc % 3) * SB_BYTES;
    LAS char* STn = C.lds + O_ST2 + (cc & 1) * 17408;
    const int kb = (int)(uintptr_t)(sb + SB_KD) + C.trb + db * 512, vb = (int)(uintptr_t)(sb + SB_VV) + C.trb;
    { const s16x4 al0 = tr_read<v_rd_off(0, 0, 0)>(kb), ah0 = tr_read<v_rd_off(0, 0, 1)>(kb), al1 = tr_read<v_rd_off(0, 1, 0)>(kb), ah1 = tr_read<v_rd_off(0, 1, 1)>(kb);
      const s16x4 al2 = tr_read<v_rd_off(0, 2, 0)>(kb), ah2 = tr_read<v_rd_off(0, 2, 1)>(kb), al3 = tr_read<v_rd_off(0, 3, 0)>(kb), ah3 = tr_read<v_rd_off(0, 3, 1)>(kb);
      const s16x4 bl0 = tr_read<vc_off(0, 0, 0)>(vb), bh0 = tr_read<vc_off(0, 0, 1)>(vb), bl1 = tr_read<vc_off(0, 1, 0)>(vb), bh1 = tr_read<vc_off(0, 1, 1)>(vb);
      const s16x4 bl2 = tr_read<vc_off(0, 2, 0)>(vb), bh2 = tr_read<vc_off(0, 2, 1)>(vb), bl3 = tr_read<vc_off(0, 3, 0)>(vb), bh3 = tr_read<vc_off(0, 3, 1)>(vb);
      const s16x4 cl0_ = tr_read<vc_off(1, 0, 0)>(vb), ch0 = tr_read<vc_off(1, 0, 1)>(vb), cl1_ = tr_read<vc_off(1, 1, 0)>(vb), ch1 = tr_read<vc_off(1, 1, 1)>(vb);
      const s16x4 cl2 = tr_read<vc_off(1, 2, 0)>(vb), ch2 = tr_read<vc_off(1, 2, 1)>(vb), cl3 = tr_read<vc_off(1, 3, 0)>(vb), ch3 = tr_read<vc_off(1, 3, 1)>(vb);
      asm volatile("s_waitcnt lgkmcnt(0)" ::: "memory"); __builtin_amdgcn_sched_barrier(0);
      S0 = __builtin_amdgcn_mfma_f32_32x32x16_bf16(GPK(al0, ah0), GPK(bl0, bh0), S0, 0, 0, 0); S1 = __builtin_amdgcn_mfma_f32_32x32x16_bf16(GPK(al0, ah0), GPK(cl0_, ch0), S1, 0, 0, 0);
      S0 = __builtin_amdgcn_mfma_f32_32x32x16_bf16(GPK(al1, ah1), GPK(bl1, bh1), S0, 0, 0, 0); S1 = __builtin_amdgcn_mfma_f32_32x32x16_bf16(GPK(al1, ah1), GPK(cl1_, ch1), S1, 0, 0, 0);
      S0 = __builtin_amdgcn_mfma_f32_32x32x16_bf16(GPK(al2, ah2), GPK(bl2, bh2), S0, 0, 0, 0); S1 = __builtin_amdgcn_mfma_f32_32x32x16_bf16(GPK(al2, ah2), GPK(cl2, ch2), S1, 0, 0, 0);
      S0 = __builtin_amdgcn_mfma_f32_32x32x16_bf16(GPK(al3, ah3), GPK(bl3, bh3), S0, 0, 0, 0); S1 = __builtin_amdgcn_mfma_f32_32x32x16_bf16(GPK(al3, ah3), GPK(cl3, ch3), S1, 0, 0, 0); }
#pragma unroll
    for (int g = 0; g < 4; ++g) { const f32x4 dc = *(const LAS f32x4*)(sb + SB_DEC + (32 * db + 8 * g + 4 * hi) * 4);
                                  S0[4 * g] *= dc[0]; S0[4 * g + 1] *= dc[1]; S0[4 * g + 2] *= dc[2]; S0[4 * g + 3] *= dc[3];
                                  S1[4 * g] *= dc[0]; S1[4 * g + 1] *= dc[1]; S1[4 * g + 2] *= dc[2]; S1[4 * g + 3] *= dc[3]; }
#pragma unroll
    for (int g = 0; g < 4; ++g) { u32x2 w0, w1; w0.x = cvt_pk_bf16(S0[4 * g], S0[4 * g + 1]); w0.y = cvt_pk_bf16(S0[4 * g + 2], S0[4 * g + 3]); w1.x = cvt_pk_bf16(S1[4 * g], S1[4 * g + 1]); w1.y = cvt_pk_bf16(S1[4 * g + 2], S1[4 * g + 3]);
      *(LAS u32x2*)(STn + r32 * ROWB + (32 * db + 8 * g + 4 * hi) * 2) = w0; *(LAS u32x2*)(STn + (32 + r32) * ROWB + (32 * db + 8 * g + 4 * hi) * 2) = w1; }
  }
}
__device__ __forceinline__ void seq_unit(const Frame& F, int b, int hd, int dir, int dvs, LAS char* lds) {
  int tid = threadIdx.x; asm volatile("" : "+v"(tid));
  SeqCtx C; C.lds = lds; C.wid = __builtin_amdgcn_readfirstlane(tid >> 6); C.lane = tid & 63; C.r32 = C.lane & 31; C.hi = C.lane >> 5; C.b = b; C.dir = dir; C.hd = hd; C.dvs = dvs;
  const int sc = (b * 4 + hd) * 2 + dir;
  C.OUT = WSP(bf16_t, dir ? R1_OB : R1_OF);
  C.tiles = (const char*)(F.ws + WS_ACT) + (size_t)sc * 68 * ITEM_B; C.decb = (const char*)(F.ws + WS_ACT + (size_t)4352 * ITEM_B) + (size_t)sc * 68 * 512;
  for (int i = tid; i < 2 * 17408 / 4; i += NTHR) ((LAS unsigned*)(lds + O_ST2))[i] = 0u;
  int vcol;
#pragma unroll
  for (int rd = 0; rd < 2; ++rd) { const int o = rd * 8192 + C.wid * 1024 + C.lane * 16;
    { const int row = o >> 8, slot = (o >> 4) & 15; C.sQ[rd] = (unsigned)(row * 256 + ((slot ^ (row & 15)) << 4)); }
    { const int sub = o >> 9, kkhi = sub >> 2, cblk = sub & 3, w = (o & 511) >> 1, kklo = w >> 5, cin = w & 31; const int kk = kkhi * 8 + kklo; const int k = (kk & ~0xC) | ((kk & 4) << 1) | ((kk & 8) >> 1);
      C.sK[rd] = (unsigned)(k * 256 + (cblk * 32 + cin) * 2); } }
  { const int o = C.wid * 1024 + C.lane * 16; const int sub = o >> 9, kkhi = sub >> 1, cblk = sub & 1, w = (o & 511) >> 1, kklo = w >> 5, cin = w & 31; const int kk = kkhi * 8 + kklo;
    C.vk = (kk & ~0xC) | ((kk & 4) << 1) | ((kk & 8) >> 1); vcol = cblk * 32 + cin; }
  C.Uv = WSP(bf16_t, R1_U1) + 1024 + hd * 256 + dvs * 64 + vcol;
  C.ldsw = (unsigned)C.wid * 1024u;
  C.eb = C.wid & 1; C.db = C.wid & 3; C.trb = v_rd_base(C.lane); C.xq = ((C.r32 & 15) ^ C.hi) << 4;
  { const int j = C.r32, kk = (j & ~0xC) | ((j & 4) << 1) | ((j & 8) >> 1); C.kdo = (kk >> 3) * 2048 + (kk & 7) * 64 + C.hi * 16; }
  seq_issue(C, 0); seq_issue(C, 1);
  if (C.wid < 4) { if (C.wid & 2) seq_out_loop<1>(C); else seq_out_loop<0>(C); }
  else seq_state_loop(C);
  asm volatile("s_waitcnt vmcnt(0) lgkmcnt(0)" ::: "memory");
  __builtin_amdgcn_s_barrier();
}
__device__ __forceinline__ void seq_phase(const Frame& F) {
  for (int un = F.bid; un < 256; un += F.G) {
    const int dvs = un & 3, sc = un >> 2, dir = sc & 1, hd = (sc >> 1) & 3, b = sc >> 3;
    __syncthreads();
    seq_unit(F, b, hd, dir, dvs, (LAS char*)F.ring);
  }
}
#undef GPK
#undef CH_ROW0
#undef TOK
}

__device__ __forceinline__ void ph_gla_out(const Frame& F) {
    const bf16_t* OF = WSP(bf16_t, R1_OF); const bf16_t* OB = WSP(bf16_t, R1_OB); const bf16_t* U1 = WSP(bf16_t, R1_U1); bf16_t* MIX = WSP(bf16_t, R1_MIX); const float* gn = F.in[I1_GNG];
    for (int rl = F.bid * NWAVE + F.wave; rl < TL; rl += F.G * NWAVE) {
        float o[16], ob[16], go[16]; ld16b(OF + (size_t)rl * D, F.lane, o); ld16b(OB + (size_t)rl * D, F.lane, ob); ld16b(U1 + (size_t)(TC + rl) * U1W + 2048, F.lane, go);
        float s0 = 0.f, s1 = 0.f;
#pragma unroll
        for (int i = 0; i < 8; ++i) { o[i] += ob[i]; o[8 + i] += ob[8 + i]; s0 = fmaf(o[i], o[i], s0); s1 = fmaf(o[8 + i], o[8 + i], s1); }
        for (int k = 16; k >= 1; k >>= 1) { s0 += __shfl_xor(s0, k); s1 += __shfl_xor(s1, k); }
        const float r0 = rsqrtf(s0 * (1.0f / 256.0f) + EPS), r1 = rsqrtf(s1 * (1.0f / 256.0f) + EPS);
        const float* gp = gn + ((8 * F.lane) & 255);
#pragma unroll
        for (int i = 0; i < 8; ++i) { const float gw = gp[i]; o[i] = o[i] * r0 * gw * silu_fast(go[i]); o[8 + i] = o[8 + i] * r1 * gw * silu_fast(go[8 + i]); }
        st16b(MIX + (size_t)rl * D, F.lane, o);
    }
}

constexpr int NPHASE = 20;
__global__ void __launch_bounds__(NTHR, 2) fwd_kernel(Args args) {
    extern __shared__ __attribute__((aligned(16))) unsigned char lds_raw[];
    Frame F; F.in = args.in; F.out = args.out; F.ws = args.ws; F.lds = (LAS unsigned char*)lds_raw; F.ring = F.lds + RING_OFF;
    F.tid = threadIdx.x; F.lane = F.tid & 63; F.wave = __builtin_amdgcn_readfirstlane(F.tid >> 6); F.G = gridDim.x; F.bid = blockIdx.x;
    if (F.tid < 4) ((LAS unsigned*)F.lds)[F.tid] = 0u;
    __syncthreads();
    const int lo = args.ph_lo, hi = args.ph_hi;
    const bool multi = (hi - lo) > 1;
    XcdBarrier bar; bar.bar = (unsigned*)(F.ws + WS_CTL + CW_BAR); bar.x = 0; bar.st = (volatile LAS unsigned*)F.lds;
    if (multi) bar = xcd_barrier_post((unsigned*)(F.ws + WS_CTL + CW_BAR), (volatile LAS unsigned*)F.lds);
#define IN(k) (lo <= (k) && (k) < hi)
#define SEAM(k) do { if (IN((k) + 1)) xcd_barrier(bar); } while (0)
#define REFRESH() do { int t_ = threadIdx.x; asm volatile("" : "+v"(t_)); F.tid = t_; F.lane = t_ & 63; F.wave = __builtin_amdgcn_readfirstlane(t_ >> 6); } while (0)

    if (IN(0)) { REFRESH(); ph_prologue(F); SEAM(0); }
    if (IN(1)) { REFRESH(); ph_mod0(F); SEAM(1); }
    if (IN(2)) { REFRESH();
        pg8::DualOrder S; S.a.init(WSP(bf16_t, WS_H), WSP(bf16_t, WS_WIN0), D, D, T, U0W, F.G, F.bid); S.b.init(WSP(bf16_t, WS_WF), WSP(bf16_t, WS_H), D, D, 512, T, F.G, F.bid);
        pg8::EpiDual0 E{pg8::EpiBf16{WSP(bf16_t, R0_U0), U0W, U0W}, pg8::EpiFourT{WSP(bf16_t, R0_TT), WSP(bf16_t, R0_TTC)}};
        pg8::gemm_phase<pg8::EpiDual0, pg8::DualOrder>(F.ring, pg8::Gemm{D, D, D}, S, E);
        SEAM(2); }
    if (IN(3)) { REFRESH(); ph_rowstats(F); SEAM(3); }
    if (IN(4)) { REFRESH();
        { pg8::DenseOrder S; S.init(WSP(bf16_t, R0_U0), WSP(bf16_t, WS_WQ), U0W, QL, T, QWP, F.G, F.bid);
          pg8::EpiRS E{WSP(bf16_t, R0_Q), WSP(float, WS_RS), QW, QW}; pg8::gemm_phase<pg8::EpiRS, pg8::DenseOrder>(F.ring, pg8::Gemm{QL, U0W, QL}, S, E); }
        { pg8::DenseOrder S; S.init(WSP(bf16_t, R0_U0) + QL, WSP(bf16_t, WS_WKV), U0W, KVL, T, KVW, F.G, F.bid);
          pg8::EpiRS E{WSP(bf16_t, R0_KV), WSP(float, WS_RS) + T, KVW, KVW}; pg8::gemm_phase<pg8::EpiRS, pg8::DenseOrder>(F.ring, pg8::Gemm{KVL, U0W, KVL}, S, E); }
        SEAM(4); }
    if (IN(5)) { REFRESH();
        ph_queue5(F); SEAM(5); }
    if (IN(6)) { REFRESH();
        pg8::DenseOrder S; S.init(WSP(bf16_t, R0_MIX), WSP(bf16_t, WS_WOUT0), D, D, T, D, F.G, F.bid);
        pg8::EpiGateBf16 E{WSP(bf16_t, R0_U0), WSP(float, WS_MODV), 2048, 0, 0};
        pg8::gemm_phase<pg8::EpiGateBf16, pg8::DenseOrder>(F.ring, pg8::Gemm{D, D, D}, S, E); SEAM(6); }
    if (IN(7)) { REFRESH(); ph_router(F, 0, 0); SEAM(7); }
    if (IN(8)) { REFRESH(); ph_moe1(F, 0); SEAM(8); }
    if (IN(9)) { REFRESH(); ph_moe2(F, 0); SEAM(9); }
    if (IN(10)) { REFRESH(); ph_combine_mod1(F); SEAM(10); }
    if (IN(11)) { REFRESH();
        pg8::DenseOrder S; S.init(WSP(bf16_t, WS_H), WSP(bf16_t, WS_WIN1), D, D, T, U1W, F.G, F.bid);
        pg8::EpiBf16 E{WSP(bf16_t, R1_U1), U1W, U1W}; pg8::gemm_phase<pg8::EpiBf16, pg8::DenseOrder>(F.ring, pg8::Gemm{D, D, D}, S, E); SEAM(11); }
    if (IN(12)) { REFRESH(); gla3::pre_phase(F); SEAM(12); }
    if (IN(13)) { REFRESH(); gla3::seq_phase(F); SEAM(13); }
    if (IN(14)) { REFRESH(); ph_gla_out(F); SEAM(14); }
    if (IN(15)) { REFRESH();
        pg8::DenseOrder S; S.init(WSP(bf16_t, R1_MIX), WSP(bf16_t, WS_WOUT1), D, D, TL, D, F.G, F.bid);
        pg8::EpiGateBf16 E{WSP(bf16_t, R1_OF), WSP(float, WS_MODV) + 9 * 6144, 2048, TC, TC};
        pg8::gemm_phase<pg8::EpiGateBf16, pg8::DenseOrder>(F.ring, pg8::Gemm{D, D, D}, S, E); SEAM(15); }
    if (IN(16)) { REFRESH(); ph_router(F, 1, TC); SEAM(16); }
    if (IN(17)) { REFRESH(); ph_moe1(F, 1); SEAM(17); }
    if (IN(18)) { REFRESH(); ph_moe2(F, 1); SEAM(18); }
    if (IN(19)) { REFRESH(); ph_final(F); }
#undef IN
#undef SEAM
}

#ifndef ONE_LAUNCH
#define ONE_LAUNCH 1
#endif
extern "C" void kernel_launch(void* const* d_in, const int* in_sizes, int n_in, void* d_out, int out_size, void* d_ws, size_t ws_size, hipStream_t stream) {
    static int grid = 0;
    if (grid == 0) {
        if (n_in != 38 || out_size != TL * D || ws_size < WS_END) { fprintf(stderr, "kernel_launch: unexpected shapes: n_in %d out %d ws %zu (need %zu)\n", n_in, out_size, ws_size, (size_t)WS_END); grid = -1; return; }
        int dev = 0, cus = 0, per_cu = 0;
        if (hipGetDevice(&dev) != hipSuccess || hipDeviceGetAttribute(&cus, hipDeviceAttributeMultiprocessorCount, dev) != hipSuccess) { grid = -1; return; }
        if (hipFuncSetAttribute((const void*)fwd_kernel, hipFuncAttributeMaxDynamicSharedMemorySize, LDS_BYTES) != hipSuccess) { fprintf(stderr, "kernel_launch: hipFuncSetAttribute failed\n"); grid = -1; return; }
        if (hipOccupancyMaxActiveBlocksPerMultiprocessor(&per_cu, (const void*)fwd_kernel, NTHR, LDS_BYTES) != hipSuccess || per_cu < 1) { fprintf(stderr, "kernel_launch: occupancy query says %d\n", per_cu); }
        (void)hipGetLastError();
        grid = cus;
    }
    if (grid < 0) return;
    (void)hipMemsetAsync((char*)d_ws + WS_CTL, 0, CTL_BYTES, stream);
    Args a{};
    for (int i = 0; i < 38; ++i) a.in[i] = (const float*)d_in[i];
    a.out = (float*)d_out; a.ws = (unsigned char*)d_ws;
#if ONE_LAUNCH
    a.ph_lo = 0; a.ph_hi = NPHASE;
    hipLaunchKernelGGL(fwd_kernel, dim3(grid), dim3(NTHR), LDS_BYTES, stream, a);
#else
    for (int p = 0; p < NPHASE; ++p) { a.ph_lo = p; a.ph_hi = p + 1; hipLaunchKernelGGL(fwd_kernel, dim3(grid), dim3(NTHR), LDS_BYTES, stream, a); }
#endif
}
```

```cpp
#include <hip/hip_runtime.h>
#include <stdint.h>
#include <stdio.h>

#define LAS __attribute__((address_space(3)))
typedef unsigned short bf16_t;
typedef short bf16x8 __attribute__((ext_vector_type(8)));
typedef float f32x4 __attribute__((ext_vector_type(4)));
typedef float f32x2 __attribute__((ext_vector_type(2)));
typedef unsigned u32x4 __attribute__((ext_vector_type(4)));
typedef unsigned u32x2 __attribute__((ext_vector_type(2)));

#ifndef NAIVE_ATTN
#define NAIVE_ATTN 0
#endif
#ifndef NAIVE_GLA
#define NAIVE_GLA 0
#endif
constexpr int D = 1024, NB = 8, SEQ = 4096, CTXL = 256;
constexpr int TC = NB * CTXL, TL = NB * SEQ, T = TC + TL;
constexpr int QL = 384, KVL = 256, ROPE = 64, NH = 6, QKD = 192, VD = 128;
constexpr int U0W = 768;
constexpr int QW = NH * QKD  , QWP = 1280, KVW = NH * 256  ;
constexpr int NE = 32, TOPK = 4, FF = 1024;
constexpr int U1W = 3072;
constexpr int NPAD = 147456;
constexpr float EPS = 1e-6f;
constexpr int NTHR = 512, NWAVE = 8;

constexpr size_t al256(size_t x) { return (x + 255) / 256 * 256; }
constexpr size_t XCD_BAR_WORDS_C = 3456;
constexpr size_t CW_BAR = 0;
constexpr size_t CW_Q5 = 15360;
constexpr size_t CW_CNT = 16384;
constexpr size_t CTL_BYTES = 32768;
constexpr size_t WS_CTL = 0;
constexpr size_t WS_MODV = WS_CTL + CTL_BYTES;
constexpr size_t WS_ROPE = WS_MODV + al256(2 * 9 * 6144 * 4);
constexpr size_t WS_RS = WS_ROPE + al256(2 * 64 * 16 * 4);
constexpr size_t WS_XCTX = WS_RS + al256((size_t)2 * T * 4);
constexpr size_t WS_H = WS_XCTX + al256((size_t)TC * D * 4);
constexpr size_t WS_WIN0 = WS_H + al256((size_t)T * D * 2);
constexpr size_t WS_WF = WS_WIN0 + al256((size_t)U0W * D * 2);
constexpr size_t WS_WQ = WS_WF + al256((size_t)512 * D * 2);
constexpr size_t WS_WKV = WS_WQ + al256((size_t)QWP * QL * 2);
constexpr size_t WS_WOUT0 = WS_WKV + al256((size_t)KVW * KVL * 2);
constexpr size_t WS_WIN1 = WS_WOUT0 + al256((size_t)D * D * 2);
constexpr size_t WS_WOUT1 = WS_WIN1 + al256((size_t)U1W * D * 2);
constexpr size_t WS_WGU = WS_WOUT1 + al256((size_t)D * D * 2);
constexpr size_t WS_WDN = WS_WGU + al256((size_t)NE * 2048 * D * 2);
constexpr size_t WS_ACT = WS_WDN + al256((size_t)NE * D * FF * 2);
constexpr size_t WS_LIST = WS_ACT + al256((size_t)NPAD * FF * 2);
constexpr size_t WS_TOKE = WS_LIST + al256((size_t)NE * T * 4);
constexpr size_t WS_TOKP = WS_TOKE + al256((size_t)T * 4 * 4);
constexpr size_t WS_TOKG = WS_TOKP + al256((size_t)T * 4 * 4);
constexpr size_t WS_RWT = WS_TOKG + al256((size_t)T * 4 * 4);
constexpr size_t WS_GD = WS_RWT + al256((size_t)2 * 2 * 32 * 1024 * 2);
constexpr size_t WS_REG = WS_GD + al256((size_t)T * 32 * 4);
constexpr size_t R0_U0 = WS_REG;
constexpr size_t R0_TT = R0_U0 + al256((size_t)T * U0W * 2);
constexpr size_t R0_TTC = R0_TT + al256((size_t)NB * 256 * 8192 * 2);
constexpr size_t R0_Q = R0_TTC + al256((size_t)NB * 256 * 512 * 2);
constexpr size_t R0_KV = R0_Q + al256((size_t)T * QW * 2);
constexpr size_t R0_KR = R0_KV + al256((size_t)T * KVW * 2);
constexpr size_t R0_MIX = R0_KR + al256((size_t)T * ROPE * 2);
constexpr size_t R0_DFT = R0_MIX + al256((size_t)T * D * 2);
constexpr size_t R0_DFTC = R0_DFT + al256((size_t)4096 * 4096 * 2);
constexpr size_t R0_TT2 = R0_DFTC + al256((size_t)256 * 256 * 2);
constexpr size_t R0_TTC2 = R0_TT2 + al256((size_t)NB * 256 * 4096 * 2);
constexpr size_t R0_END = R0_TTC2 + al256((size_t)NB * 256 * 256 * 2);
constexpr size_t R1_U1 = WS_REG;
constexpr size_t R1_OF = R1_U1 + al256((size_t)T * U1W * 2);
constexpr size_t R1_OB = R1_OF + al256((size_t)TL * D * 2);
constexpr size_t R1_MIX = R1_OB + al256((size_t)TL * D * 2);
constexpr size_t R1_END = R1_MIX + al256((size_t)TL * D * 2);
constexpr size_t RM_YB = WS_REG;
constexpr size_t RM_END = RM_YB + al256((size_t)NPAD * D * 2);
constexpr size_t cmax(size_t a, size_t b) { return a > b ? a : b; }
constexpr size_t WS_END = cmax(cmax(R0_END, R1_END), RM_END);

constexpr int LDS_BYTES = 160 * 1024;
constexpr int LDS_MISC = 1024;
constexpr int RING_OFF = LDS_MISC;

__device__ __forceinline__ float bf2f(bf16_t b) { return __uint_as_float(((unsigned)b) << 16); }
__device__ __forceinline__ bf16_t f2bf(float f) { unsigned u = __float_as_uint(f); u += 0x7FFFu + ((u >> 16) & 1u); return (bf16_t)(u >> 16); }
__device__ __forceinline__ unsigned pk2(float lo, float hi) { return (unsigned)f2bf(lo) | ((unsigned)f2bf(hi) << 16); }
typedef __bf16 bf16v2_t __attribute__((ext_vector_type(2)));
__device__ __forceinline__ unsigned cvt_pk_bf16(float lo, float hi) { const f32x2 v = {lo, hi}; bf16v2_t b = __builtin_convertvector(v, bf16v2_t); return *reinterpret_cast<unsigned*>(&b); }
__device__ __forceinline__ float wsum(float v) { for (int o = 32; o >= 1; o >>= 1) v += __shfl_xor(v, o); return v; }
__device__ __forceinline__ float siluf(float x) { return x / (1.0f + __expf(-x)); }
__device__ __forceinline__ float silu_fast(float x) { return x * __builtin_amdgcn_rcpf(1.0f + __builtin_amdgcn_exp2f(x * -1.4426950408889634f)); }

#define XB_TMO      128
#define XB_XCNT(j)  (256  + 64 * (j))
#define XB_XSUB(j)  (1280 + 64 * (j))
#define XB_XGEN(j)  (2304 + 64 * (j))
#define XB_TOP      3328
#define XB_TOPGEN   3392
#define XCD_BAR_WORDS 3456
#define XB_SPIN_CAP (1u << 20)
__device__ __forceinline__ unsigned xb_ld(unsigned* p)              { return __hip_atomic_load(p, __ATOMIC_RELAXED, __HIP_MEMORY_SCOPE_AGENT); }
__device__ __forceinline__ unsigned xb_add(unsigned* p, unsigned v) { return __hip_atomic_fetch_add(p, v, __ATOMIC_RELAXED, __HIP_MEMORY_SCOPE_AGENT); }
__device__ __forceinline__ unsigned xb_xcc_id() { return (unsigned)__builtin_amdgcn_s_getreg((3 << 11) | 20) & 0xFu; }
#define XB_SPIN(cond, bar) do { unsigned _sp = 0; while (cond) { __builtin_amdgcn_s_sleep(1); \
    if ((++_sp & 255u) == 0u) { if (xb_ld(&(bar)[XB_TMO])) break; if (_sp > XB_SPIN_CAP) { atomicAdd(&(bar)[XB_TMO], 1u); break; } } } } while (0)
struct XcdBarrier { unsigned* bar; unsigned x; volatile LAS unsigned* st; };
__device__ __forceinline__ XcdBarrier xcd_barrier_post(unsigned* bar, volatile LAS unsigned* st) {
    XcdBarrier b; b.bar = bar; b.x = xb_xcc_id(); b.st = st;
    if (threadIdx.x == 0) (void)xb_add(&bar[XB_XCNT(b.x)], 1u);
    return b;
}
__device__ __forceinline__ void xcd_barrier_complete(unsigned* bar, unsigned x, unsigned& nloc, unsigned& nx) {
    const unsigned G = gridDim.x * gridDim.y * gridDim.z;
    unsigned sum, cnt, mine, sp = 0u;
    for (;;) {
        sum = 0u; cnt = 0u; mine = 0u;
#pragma unroll
        for (unsigned j = 0; j < 16; ++j) { const unsigned c = xb_ld(&bar[XB_XCNT(j)]); sum += c; cnt += (c > 0u) ? 1u : 0u; mine = (j == x) ? c : mine; }
        if (sum == G) break;
        __builtin_amdgcn_s_sleep(1);
        if ((++sp & 255u) == 0u) { if (xb_ld(&bar[XB_TMO])) break; if (sp > XB_SPIN_CAP) { atomicAdd(&bar[XB_TMO], 1u); break; } }
    }
    nloc = mine > 0u ? mine : 1u; nx = cnt > 0u ? cnt : 1u;
}
__device__ __forceinline__ void xcd_barrier(const XcdBarrier& b) {
    asm volatile("s_waitcnt vmcnt(0)" ::: "memory");
    __syncthreads();
    if (threadIdx.x == 0) {
        unsigned* bar = b.bar;
        __builtin_amdgcn_s_waitcnt(0);
        unsigned nloc = b.st[0], nx = b.st[1];
        if (nloc == 0u) { xcd_barrier_complete(bar, b.x, nloc, nx); b.st[0] = nloc; b.st[1] = nx; }
        const unsigned old = xb_add(&bar[XB_XSUB(b.x)], 1u);
        const unsigned gen = old / nloc;
        if (old + 1u == (gen + 1u) * nloc) {
            __builtin_amdgcn_fence(__ATOMIC_RELEASE, "agent");
            asm volatile("s_waitcnt vmcnt(0)" ::: "memory");
            const unsigned og = xb_add(&bar[XB_TOP], 1u);
            const unsigned tg = og / nx;
            if (og + 1u == (tg + 1u) * nx) xb_add(&bar[XB_TOPGEN], 1u);
            else XB_SPIN(xb_ld(&bar[XB_TOPGEN]) == tg, bar);
            __builtin_amdgcn_fence(__ATOMIC_ACQUIRE, "agent");
            xb_add(&bar[XB_XGEN(b.x)], 1u);
            asm volatile("s_waitcnt vmcnt(0)" ::: "memory");
        } else {
            XB_SPIN(xb_ld(&bar[XB_XGEN(b.x)]) == gen, bar);
            __builtin_amdgcn_fence(__ATOMIC_ACQUIRE, "agent");
            asm volatile("s_waitcnt vmcnt(0)" ::: "memory");
        }
    }
    __syncthreads();
}

namespace pg8 {
constexpr int BM = 256, BK = 64, HALF = 128, HTB = HALF * BK * 2, STAGE_BYTES = 8 * HTB, NXCD = 8, WGM = 8;
__host__ __device__ __forceinline__ int lds_byte(int r, int c) { const int st = (r >> 4) * 2 + (c >> 5), rr = r & 15, cc = c & 31, ob = rr * 64 + cc * 2; return st * 1024 + (ob ^ (((ob >> 9) & 1) << 5)); }
__host__ __device__ __forceinline__ void stage_rc(int b, int& R, int& C) { const int st = b / 1024, sb = b % 1024, swz = sb ^ (((sb >> 9) & 1) << 5); R = (st >> 1) * 16 + swz / 64; C = (st & 1) * 32 + (swz % 64) / 2; }
__host__ __device__ __forceinline__ int perm32(int rho) { const int n = rho >> 4, i = rho & 15; return 8 * (i >> 2) + 4 * n + (i & 3); }

struct Unit { int pm, pn, e, cnt; const char* A; const char* B; };
struct Gemm { int K, lda, ldb; };

struct DenseOrder {
    const char* A; const char* B; int lda, ldb; int nM, nN, nwg, G, c;
    static constexpr bool GATHER = false;
    __device__ void init(const void* A_, const void* B_, int lda_, int ldb_, int M, int N, int G_, int c_) { A = (const char*)A_; B = (const char*)B_; lda = lda_; ldb = ldb_; nM = M / BM; nN = N / BM; nwg = nM * nN; G = G_; c = c_; }
    __device__ bool next(int i, Unit& u) const {
        const long L = (long)i * G + c; if (L >= nwg) return false;
        int wgid = (int)L; { const int q = nwg / NXCD, r = nwg % NXCD, xcd = wgid % NXCD, off = wgid / NXCD; wgid = (xcd < r ? xcd * (q + 1) : r * (q + 1) + (xcd - r) * q) + off; }
        const int nig = WGM * nN, gid = wgid / nig, fm = gid * WGM, gsz = (nM - fm) < WGM ? (nM - fm) : WGM;
        u.pm = fm + ((wgid % nig) % gsz); u.pn = (wgid % nig) / gsz; u.e = 0; u.cnt = 0;
        u.A = A + (size_t)u.pm * BM * lda * 2; u.B = B + (size_t)u.pn * BM * ldb * 2; return true;
    }
    __device__ __forceinline__ void aoff(const Unit&, const int (&R)[2], const int (&C)[2], unsigned (&off)[2][2]) const {
#pragma unroll
        for (int h = 0; h < 2; ++h)
#pragma unroll
            for (int i = 0; i < 2; ++i) off[h][i] = (unsigned)((h * HALF + R[i]) * lda + C[i]) * 2u;
    }
};
struct BatchOrder {
    const char* A; const char* B; size_t sA, sB; int lda, ldb; int nM, nN, per, nwg, G, c;
    static constexpr bool GATHER = false;
    __device__ void init(const void* A_, const void* B_, size_t sA_, size_t sB_, int lda_, int ldb_, int nb, int M, int N, int G_, int c_) { A = (const char*)A_; B = (const char*)B_; sA = sA_; sB = sB_; lda = lda_; ldb = ldb_; nM = M / BM; nN = N / BM; per = nM * nN; nwg = per * nb; G = G_; c = c_; }
    __device__ bool next(int i, Unit& u) const {
        const long L = (long)i * G + c; if (L >= nwg) return false;
        const int b = (int)L / per, r = (int)L % per; u.pm = r / nN; u.pn = r % nN; u.e = b; u.cnt = 0;
        u.A = A + (size_t)b * sA + (size_t)u.pm * BM * lda * 2; u.B = B + (size_t)b * sB + (size_t)u.pn * BM * ldb * 2; return true;
    }
    __device__ __forceinline__ void aoff(const Unit&, const int (&R)[2], const int (&C)[2], unsigned (&off)[2][2]) const {
#pragma unroll
        for (int h = 0; h < 2; ++h)
#pragma unroll
            for (int i = 0; i < 2; ++i) off[h][i] = (unsigned)((h * HALF + R[i]) * lda + C[i]) * 2u;
    }
};
struct DualOrder {
    DenseOrder a, b;
    static constexpr bool GATHER = false;
    __device__ __forceinline__ void aoff_issue(const Unit&, const int (&)[2], unsigned (&)[2][2]) const {}
    __device__ __forceinline__ void aoff_finish(const int (&)[2], unsigned (&)[2][2], unsigned (&)[2][2]) const {}
    __device__ bool next(int i, Unit& u) const {
        const long L = (long)i * a.G + a.c;
        if (L < a.nwg) { return a.next(i, u); }
        const long Lb = L - a.nwg; if (Lb >= b.nwg) return false;
        DenseOrder t = b; t.c = (int)(Lb % b.G); const bool ok = t.next((int)(Lb / b.G), u); u.e = 1; return ok;
    }
    __device__ __forceinline__ void aoff(const Unit& u, const int (&R)[2], const int (&C)[2], unsigned (&off)[2][2]) const { a.aoff(u, R, C, off); }
};
struct OneUnit {
    Unit u0; int lda;
    static constexpr bool GATHER = false;
    __device__ bool next(int i, Unit& u) const { if (i != 0) return false; u = u0; return true; }
    __device__ __forceinline__ void aoff(const Unit&, const int (&R)[2], const int (&C)[2], unsigned (&off)[2][2]) const {
#pragma unroll
        for (int h = 0; h < 2; ++h)
#pragma unroll
            for (int i = 0; i < 2; ++i) off[h][i] = (unsigned)((h * HALF + R[i]) * lda + C[i]) * 2u;
    }
};
template <bool GATHER_> struct MoeOrder {
    const char* A; const char* B; size_t sB; int lda, ldb; int npn, nwg, G, c;
    const LAS int* tstart; const LAS int* cnt; const int* list;
    const LAS int* t2e;
    __device__ __forceinline__ int ts(int j) const { return __builtin_amdgcn_readfirstlane(tstart[j]); }
    static constexpr bool GATHER = GATHER_;
    __device__ bool next(int i, Unit& u) const {
        const long L = (long)i * G + c; if (L >= nwg) return false;
        int wgid = (int)L; { const int q = nwg / NXCD, r = nwg % NXCD, xcd = wgid % NXCD, off = wgid / NXCD; wgid = (xcd < r ? xcd * (q + 1) : r * (q + 1) + (xcd - r) * q) + off; }
        const int e = __builtin_amdgcn_readfirstlane(t2e[wgid / npn]);
        const int t0 = ts(e), nt = ts(e + 1) - t0, l = wgid - t0 * npn, pn = l / nt, ti = l % nt;
        u.pm = t0 + ti; u.pn = pn; u.e = e; u.cnt = __builtin_amdgcn_readfirstlane(cnt[e]) - ti * BM;
        u.A = GATHER ? A : A + (size_t)u.pm * BM * lda * 2;
        u.B = B + (size_t)e * sB + (size_t)pn * BM * ldb * 2; return true;
    }
    __device__ __forceinline__ void aoff(const Unit& u, const int (&R)[2], const int (&C)[2], unsigned (&off)[2][2]) const {
        if (GATHER) {
            const int ti = u.pm - ts(u.e);
#pragma unroll
            for (int h = 0; h < 2; ++h)
#pragma unroll
                for (int i = 0; i < 2; ++i) { const int r = h * HALF + R[i]; const int tok = (r < u.cnt) ? list[(size_t)u.e * T + ti * BM + r] : 0; off[h][i] = (unsigned)(tok * lda + C[i]) * 2u; }
        } else {
#pragma unroll
            for (int h = 0; h < 2; ++h)
#pragma unroll
                for (int i = 0; i < 2; ++i) off[h][i] = (unsigned)((h * HALF + R[i]) * lda + C[i]) * 2u;
        }
    }
};

template <class Epi, class Sched>
__device__ __forceinline__ void gemm_phase(LAS unsigned char* lds, const Gemm g, const Sched& S, const Epi& E) {
    const int tid = threadIdx.x, wid = __builtin_amdgcn_readfirstlane(tid >> 6), lane = tid & 63, wr = wid >> 2, wc = wid & 3, fr = lane & 15, fq = lane >> 4;
    const int K = g.K, nt = K / BK;
    int Rr[2], Cc[2]; unsigned voffB[2];
#pragma unroll
    for (int i = 0; i < 2; ++i) { int R, C; stage_rc(tid * 16 + i * 8192, R, C); const int Rb = Epi::PERM ? ((R & ~31) + perm32(R & 31)) : R; Rr[i] = R; Cc[i] = C; voffB[i] = (unsigned)(Rb * g.ldb + C) * 2u; }
    const size_t kstep = (size_t)(BK * 2);
    const size_t hstepB = (size_t)HALF * g.ldb * 2;
    const unsigned ldsw = (unsigned)wid * 1024u;
    const int aoff = lds_byte(wr * 64 + fr, fq * 8), boff = lds_byte(wc * 32 + fr, fq * 8);
#define PG8_SA(b, h) (((b) * 2 + (h)) * HTB)
#define PG8_SB(b, h) ((4 + (b) * 2 + (h)) * HTB)
#define PG8_STAGE2(bufoff, gbase, o0, o1) do { \
        __builtin_amdgcn_global_load_lds((const unsigned*)((const char*)(gbase) + (o0)), (LAS unsigned*)(lds + (bufoff) + ldsw), 16, 0, 0); \
        __builtin_amdgcn_global_load_lds((const unsigned*)((const char*)(gbase) + (o1)), (LAS unsigned*)(lds + (bufoff) + ldsw + 8192), 16, 0, 0); } while (0)
#define PG8_STAGEB(bufoff, gbase) PG8_STAGE2(bufoff, gbase, voffB[0], voffB[1])
#define PG8_LDA(dst, b, h) do { _Pragma("unroll") for (int m = 0; m < 4; ++m) _Pragma("unroll") for (int k = 0; k < 2; ++k) dst[m][k] = *(const LAS bf16x8*)(lds + PG8_SA(b, h) + aoff + m * 2048 + k * 1024); } while (0)
#define PG8_LDB(dst, b, h) do { _Pragma("unroll") for (int n = 0; n < 2; ++n) _Pragma("unroll") for (int k = 0; k < 2; ++k) dst[n][k] = *(const LAS bf16x8*)(lds + PG8_SB(b, h) + boff + n * 2048 + k * 1024); } while (0)
#define PG8_MMA(ai, bj, At, Bt) do { __builtin_amdgcn_s_setprio(1); _Pragma("unroll") for (int m = 0; m < 4; ++m) _Pragma("unroll") for (int n = 0; n < 2; ++n) _Pragma("unroll") for (int k = 0; k < 2; ++k) \
        acc[ai][bj][m][n] = __builtin_amdgcn_mfma_f32_16x16x32_bf16(Bt[n][k], At[m][k], acc[ai][bj][m][n], 0, 0, 0); __builtin_amdgcn_s_setprio(0); } while (0)
#define PG8_WAIT_V(n) asm volatile("s_waitcnt vmcnt(" #n ")" ::: "memory")
#define PG8_WAIT_L(n) asm volatile("s_waitcnt lgkmcnt(" #n ")" ::: "memory")
#define PG8_BAR __builtin_amdgcn_s_barrier()
#define PG8_SCHED __builtin_amdgcn_sched_barrier(0)
    Unit cur, nxt; int ui = 0;
    if (!S.next(0, cur)) return;
    f32x4 acc[2][2][4][2];
#pragma unroll
    for (int a = 0; a < 2; ++a)
#pragma unroll
        for (int b = 0; b < 2; ++b)
#pragma unroll
            for (int m = 0; m < 4; ++m)
#pragma unroll
                for (int n = 0; n < 2; ++n) acc[a][b][m][n] = (f32x4){0.f, 0.f, 0.f, 0.f};
    bf16x8 At[4][2], B0[2][2], B1[2][2];
    unsigned oA[2][2], nOA[2][2];
    S.aoff(cur, Rr, Cc, oA);
    const char* cA = cur.A; const char* cB = cur.B;
    PG8_STAGEB(PG8_SB(0, 0), cB); PG8_STAGEB(PG8_SB(0, 1), cB + hstepB); PG8_STAGE2(PG8_SA(0, 0), cA, oA[0][0], oA[0][1]); PG8_STAGE2(PG8_SA(0, 1), cA, oA[1][0], oA[1][1]);
    if (wr == 1) PG8_BAR;
    PG8_WAIT_V(2); PG8_BAR;
    PG8_STAGEB(PG8_SB(1, 0), cB + kstep); PG8_STAGE2(PG8_SA(1, 0), cA + kstep, oA[0][0], oA[0][1]); PG8_STAGEB(PG8_SB(1, 1), cB + hstepB + kstep);
    PG8_WAIT_V(6); PG8_BAR;
    for (;;) {
        const bool has_next = S.next(ui + 1, nxt);
        const char* nA = has_next ? nxt.A : cA; const char* nB = has_next ? nxt.B : cB;
        if (Sched::GATHER) { if (has_next) S.aoff(nxt, Rr, Cc, nOA); else {
#pragma unroll
            for (int h = 0; h < 2; ++h)
#pragma unroll
                for (int i = 0; i < 2; ++i) nOA[h][i] = oA[h][i]; }
            asm volatile("" : "+v"(nOA[0][0]), "+v"(nOA[0][1]), "+v"(nOA[1][0]), "+v"(nOA[1][1])); }
        for (int t = 0; t < nt; t += 2) {
            const bool last = (t == nt - 2);
            const char* a1 = cA + (size_t)(t + 1) * kstep;
            const char* a2 = last ? nA : cA + (size_t)(t + 2) * kstep; const char* b2 = last ? nB : cB + (size_t)(t + 2) * kstep;
            const char* a3 = a2 + kstep; const char* b3 = b2 + kstep;
            unsigned q00 = oA[0][0], q01 = oA[0][1], q10 = oA[1][0], q11 = oA[1][1];
            if (Sched::GATHER) { q00 = last ? nOA[0][0] : q00; q01 = last ? nOA[0][1] : q01; q10 = last ? nOA[1][0] : q10; q11 = last ? nOA[1][1] : q11; }
            PG8_LDB(B0, 0, 0); PG8_LDB(B1, 0, 1); PG8_SCHED; PG8_LDA(At, 0, 0); PG8_STAGE2(PG8_SA(1, 1), a1, oA[1][0], oA[1][1]);
            PG8_WAIT_V(8); PG8_WAIT_L(0); PG8_BAR; PG8_MMA(0, 0, At, B0); PG8_MMA(0, 1, At, B1); PG8_BAR; PG8_SCHED;
            PG8_LDA(At, 0, 1); PG8_STAGEB(PG8_SB(0, 0), b2); PG8_STAGEB(PG8_SB(0, 1), b2 + hstepB); PG8_STAGE2(PG8_SA(0, 0), a2, q00, q01);
            PG8_WAIT_V(8); PG8_WAIT_L(0); PG8_BAR; PG8_MMA(1, 0, At, B0); PG8_MMA(1, 1, At, B1); PG8_BAR; PG8_SCHED;
            PG8_LDB(B0, 1, 0); PG8_LDB(B1, 1, 1); PG8_SCHED; PG8_LDA(At, 1, 0); PG8_STAGE2(PG8_SA(0, 1), a2, q10, q11);
            PG8_WAIT_V(8); PG8_WAIT_L(0); PG8_BAR; PG8_MMA(0, 0, At, B0); PG8_MMA(0, 1, At, B1); PG8_BAR; PG8_SCHED;
            PG8_LDA(At, 1, 1); PG8_STAGEB(PG8_SB(1, 0), b3); PG8_STAGEB(PG8_SB(1, 1), b3 + hstepB); PG8_STAGE2(PG8_SA(1, 0), a3, q00, q01);
            PG8_WAIT_V(8); PG8_WAIT_L(0); PG8_BAR; PG8_MMA(1, 0, At, B0); PG8_MMA(1, 1, At, B1); PG8_BAR; PG8_SCHED;
        }
        if (wr == 0) PG8_BAR;
        E(acc, cur, wr, wc, fr, fq);
        if (!has_next) break;
#pragma unroll
        for (int a = 0; a < 2; ++a)
#pragma unroll
            for (int b = 0; b < 2; ++b)
#pragma unroll
                for (int m = 0; m < 4; ++m)
#pragma unroll
                    for (int n = 0; n < 2; ++n) acc[a][b][m][n] = (f32x4){0.f, 0.f, 0.f, 0.f};
        cur = nxt; cA = nA; cB = nB; ++ui;
        if (Sched::GATHER) {
#pragma unroll
            for (int h = 0; h < 2; ++h)
#pragma unroll
                for (int i = 0; i < 2; ++i) oA[h][i] = nOA[h][i]; }
        if (wr == 1) PG8_BAR;
    }
    PG8_WAIT_V(0);
    PG8_BAR;
#undef PG8_SA
#undef PG8_SB
#undef PG8_STAGE2
#undef PG8_STAGEB
#undef PG8_LDA
#undef PG8_LDB
#undef PG8_MMA
#undef PG8_WAIT_V
#undef PG8_WAIT_L
#undef PG8_BAR
#undef PG8_SCHED
}

typedef f32x4 Acc[2][2][4][2];

struct EpiBf16 {
    static constexpr bool PERM = true;
    bf16_t* O; int ldc; int ncols;
    __device__ __forceinline__ void operator()(const Acc& acc, const Unit& u, int wr, int wc, int fr, int fq) const {
        const int row0 = u.pm * BM + wr * 64 + fr, col0 = u.pn * BM + wc * 32 + 8 * fq;
#pragma unroll
        for (int ai = 0; ai < 2; ++ai)
#pragma unroll
            for (int m = 0; m < 4; ++m) { bf16_t* rowp = O + (size_t)(row0 + ai * HALF + m * 16) * ldc + col0;
#pragma unroll
                for (int bj = 0; bj < 2; ++bj) { if (col0 + bj * HALF < ncols) { const f32x4 v0 = acc[ai][bj][m][0], v1 = acc[ai][bj][m][1];
                    u32x4 w; w.x = cvt_pk_bf16(v0[0], v0[1]); w.y = cvt_pk_bf16(v0[2], v0[3]); w.z = cvt_pk_bf16(v1[0], v1[1]); w.w = cvt_pk_bf16(v1[2], v1[3]);
                    *(u32x4*)(rowp + bj * HALF) = w; } } }
    }
};
struct EpiFourT {
    static constexpr bool PERM = true;
    bf16_t* TT; bf16_t* TTC;
    __device__ __forceinline__ void operator()(const Acc& acc, const Unit& u, int wr, int wc, int fr, int fq) const {
        const int part = u.pm; const int ch0 = wr * 64 + fr; const int tok0 = u.pn * BM + wc * 32 + 8 * fq;
#pragma unroll
        for (int bj = 0; bj < 2; ++bj) { const int tok = tok0 + bj * HALF; bf16_t* base; int ldt;
            if (tok < TC) { const int b = tok >> 8, n = tok & 255; base = TTC + (size_t)b * 256 * 512 + part * 256 + n; ldt = 512; }
            else { const int tl = tok - TC, b = tl >> 12, n = tl & 4095; base = TT + (size_t)b * 256 * 8192 + part * 4096 + n; ldt = 8192; }
#pragma unroll
            for (int ai = 0; ai < 2; ++ai)
#pragma unroll
                for (int m = 0; m < 4; ++m) { const int ch = ch0 + ai * HALF + m * 16; const f32x4 v0 = acc[ai][bj][m][0], v1 = acc[ai][bj][m][1];
                    u32x4 w; w.x = cvt_pk_bf16(v0[0], v0[1]); w.y = cvt_pk_bf16(v0[2], v0[3]); w.z = cvt_pk_bf16(v1[0], v1[1]); w.w = cvt_pk_bf16(v1[2], v1[3]);
                    *(u32x4*)(base + (size_t)ch * ldt) = w; } }
    }
};
struct EpiRS {
    static constexpr bool PERM = true;
    bf16_t* O; const float* rs; int ldc, ncols;
    __device__ __forceinline__ void operator()(const Acc& acc, const Unit& u, int wr, int wc, int fr, int fq) const {
        const int row0 = u.pm * BM + wr * 64 + fr, col0 = u.pn * BM + wc * 32 + 8 * fq;
#pragma unroll
        for (int ai = 0; ai < 2; ++ai)
#pragma unroll
            for (int m = 0; m < 4; ++m) { const int row = row0 + ai * HALF + m * 16; const float s = rs[row]; bf16_t* rowp = O + (size_t)row * ldc + col0;
#pragma unroll
                for (int bj = 0; bj < 2; ++bj) { if (col0 + bj * HALF >= ncols) continue; const f32x4 v0 = acc[ai][bj][m][0] * s, v1 = acc[ai][bj][m][1] * s;
                    u32x4 w; w.x = cvt_pk_bf16(v0[0], v0[1]); w.y = cvt_pk_bf16(v0[2], v0[3]); w.z = cvt_pk_bf16(v1[0], v1[1]); w.w = cvt_pk_bf16(v1[2], v1[3]);
                    *(u32x4*)(rowp + bj * HALF) = w; } }
    }
};
struct EpiFourOut {
    static constexpr bool PERM = true;
    bf16_t* MIX; int rowbase, rows_per_b;
    __device__ __forceinline__ void operator()(const Acc& acc, const Unit& u, int wr, int wc, int fr, int fq) const {
        const int row0 = rowbase + u.e * rows_per_b + u.pm * BM + wr * 64 + fr, col0 = 768 + wc * 32 + 8 * fq;
#pragma unroll
        for (int ai = 0; ai < 2; ++ai)
#pragma unroll
            for (int m = 0; m < 4; ++m) { bf16_t* rowp = MIX + (size_t)(row0 + ai * HALF + m * 16) * D + col0;
#pragma unroll
                for (int bj = 0; bj < 2; ++bj) { const f32x4 v0 = acc[ai][bj][m][0], v1 = acc[ai][bj][m][1];
                    u32x4 w; w.x = cvt_pk_bf16(v0[0], v0[1]); w.y = cvt_pk_bf16(v0[2], v0[3]); w.z = cvt_pk_bf16(v1[0], v1[1]); w.w = cvt_pk_bf16(v1[2], v1[3]);
                    *(u32x4*)(rowp + bj * HALF) = w; } }
    }
};
struct EpiDual0 {
    static constexpr bool PERM = true;
    EpiBf16 e0; EpiFourT e1;
    __device__ __forceinline__ void operator()(const Acc& acc, const Unit& u, int wr, int wc, int fr, int fq) const { if (u.e == 0) e0(acc, u, wr, wc, fr, fq); else e1(acc, u, wr, wc, fr, fq); }
};
struct EpiResid {
    static constexpr bool PERM = false;
    const float* base_ctx; const float* base_lat; float* out_ctx; float* out_lat; const float* modv; int goff; int rowoff;
    __device__ __forceinline__ void operator()(const Acc& acc, const Unit& u, int wr, int wc, int fr, int fq) const {
        const int rt = rowoff + u.pm * BM;
        const bool isctx = rt < TC; const int mr = isctx ? 8 : ((rt - TC) >> 12);
        const float* base = isctx ? base_ctx + (size_t)rt * D : base_lat + (size_t)(rt - TC) * D;
        float* out = isctx ? out_ctx + (size_t)rt * D : out_lat + (size_t)(rt - TC) * D;
        const float* gv = modv + mr * 6144 + goff;
        const int r0 = wr * 64 + fr, col0 = u.pn * BM + wc * 32 + 4 * fq;
        f32x4 g[2][2];
#pragma unroll
        for (int bj = 0; bj < 2; ++bj)
#pragma unroll
            for (int n = 0; n < 2; ++n) g[bj][n] = *(const f32x4*)(gv + col0 + bj * HALF + n * 16);
#pragma unroll
        for (int ai = 0; ai < 2; ++ai) {
            f32x4 bs[4][2][2];
#pragma unroll
            for (int m = 0; m < 4; ++m) { const size_t off = (size_t)(r0 + ai * HALF + m * 16) * D + col0;
#pragma unroll
                for (int bj = 0; bj < 2; ++bj)
#pragma unroll
                    for (int n = 0; n < 2; ++n) bs[m][bj][n] = *(const f32x4*)(base + off + bj * HALF + n * 16); }
#pragma unroll
            for (int m = 0; m < 4; ++m) { const size_t off = (size_t)(r0 + ai * HALF + m * 16) * D + col0;
#pragma unroll
                for (int bj = 0; bj < 2; ++bj)
#pragma unroll
                    for (int n = 0; n < 2; ++n) *(f32x4*)(out + off + bj * HALF + n * 16) = bs[m][bj][n] + g[bj][n] * acc[ai][bj][m][n]; }
            asm volatile("" ::: "memory"); }
    }
};
struct EpiGateBf16 {
    static constexpr bool PERM = true; static constexpr int NSTORE = 16;
    bf16_t* Y; const float* modv; int goff, rowoff, ybase;
    __device__ __forceinline__ void operator()(const Acc& acc, const Unit& u, int wr, int wc, int fr, int fq) const {
        const int rt = rowoff + u.pm * BM; const int mr = rt < TC ? 8 : ((rt - TC) >> 12);
        const float* gv = modv + mr * 6144 + goff; const int col0 = u.pn * BM + wc * 32 + 8 * fq;
        f32x4 g[2][2];
#pragma unroll
        for (int bj = 0; bj < 2; ++bj)
#pragma unroll
            for (int n = 0; n < 2; ++n) g[bj][n] = *(const f32x4*)(gv + col0 + bj * HALF + 4 * n);
        bf16_t* yb = Y + (size_t)(rt - ybase + wr * 64 + fr) * D + col0;
#pragma unroll
        for (int ai = 0; ai < 2; ++ai)
#pragma unroll
            for (int m = 0; m < 4; ++m) { bf16_t* rowp = yb + (size_t)(ai * HALF + m * 16) * D;
#pragma unroll
                for (int bj = 0; bj < 2; ++bj) { const f32x4 v0 = acc[ai][bj][m][0] * g[bj][0], v1 = acc[ai][bj][m][1] * g[bj][1];
                    u32x4 w; w.x = cvt_pk_bf16(v0[0], v0[1]); w.y = cvt_pk_bf16(v0[2], v0[3]); w.z = cvt_pk_bf16(v1[0], v1[1]); w.w = cvt_pk_bf16(v1[2], v1[3]);
                    *(u32x4*)(rowp + bj * HALF) = w; } }
    }
};
struct EpiSwiglu {
    static constexpr bool PERM = true;
    bf16_t* ACT; const float* bgu;
    __device__ __forceinline__ void operator()(const Acc& acc, const Unit& u, int wr, int wc, int fr, int fq) const {
        const int row0 = u.pm * BM + wr * 64 + fr, a0 = u.pn * HALF + wc * 32 + 8 * fq;
        const float* bp = bgu + (size_t)u.e * 2048 + 2 * a0;
        float bg[8], bl[8];
#pragma unroll
        for (int q = 0; q < 4; ++q) { const f32x4 t = *(const f32x4*)(bp + 4 * q); bg[2 * q] = t[0]; bl[2 * q] = t[1]; bg[2 * q + 1] = t[2]; bl[2 * q + 1] = t[3]; }
#pragma unroll
        for (int ai = 0; ai < 2; ++ai)
#pragma unroll
            for (int m = 0; m < 4; ++m) { float o[8];
#pragma unroll
                for (int j = 0; j < 8; ++j) { float xg = acc[ai][0][m][j >> 2][j & 3] + bg[j], xl = acc[ai][1][m][j >> 2][j & 3] + bl[j];
                    xg = fminf(xg, 7.0f); xl = fminf(fmaxf(xl, -7.0f), 7.0f);
                    o[j] = xg * __builtin_amdgcn_rcpf(1.0f + __builtin_amdgcn_exp2f(xg * (-1.702f * 1.4426950408889634f))) * (xl + 1.0f); }
                u32x4 w; w.x = cvt_pk_bf16(o[0], o[1]); w.y = cvt_pk_bf16(o[2], o[3]); w.z = cvt_pk_bf16(o[4], o[5]); w.w = cvt_pk_bf16(o[6], o[7]);
                *(u32x4*)(ACT + (size_t)(row0 + ai * HALF + m * 16) * FF + a0) = w; }
    }
};
struct EpiDown {
    static constexpr bool PERM = true;
    bf16_t* YB; const float* bdn;
    __device__ __forceinline__ void operator()(const Acc& acc, const Unit& u, int wr, int wc, int fr, int fq) const {
        const int row0 = u.pm * BM + wr * 64 + fr, col0 = u.pn * BM + wc * 32 + 8 * fq;
        f32x4 bv[2][2];
#pragma unroll
        for (int bj = 0; bj < 2; ++bj)
#pragma unroll
            for (int n = 0; n < 2; ++n) bv[bj][n] = *(const f32x4*)(bdn + (size_t)u.e * D + col0 + bj * HALF + 4 * n);
#pragma unroll
        for (int ai = 0; ai < 2; ++ai)
#pragma unroll
            for (int m = 0; m < 4; ++m) { bf16_t* rowp = YB + (size_t)(row0 + ai * HALF + m * 16) * D + col0;
#pragma unroll
                for (int bj = 0; bj < 2; ++bj) { const f32x4 v0 = acc[ai][bj][m][0] + bv[bj][0], v1 = acc[ai][bj][m][1] + bv[bj][1];
                    u32x4 w; w.x = cvt_pk_bf16(v0[0], v0[1]); w.y = cvt_pk_bf16(v0[2], v0[3]); w.z = cvt_pk_bf16(v1[0], v1[1]); w.w = cvt_pk_bf16(v1[2], v1[3]);
                    *(u32x4*)(rowp + bj * HALF) = w; } }
    }
};
}

struct Args { const float* in[38]; float* out; unsigned char* ws; int ph_lo, ph_hi; };
enum { I_X = 0, I_C, I_CTX, I_CCTX, I_FNG,
       I0_MODW, I0_MODB, I0_N1G, I0_WIN, I0_QNG, I0_WQUP, I0_KVNG, I0_WKVUP, I0_WOUT, I0_N2G, I0_RW, I0_RB, I0_WGU, I0_BGU, I0_WDN, I0_BDN,
       I1_MODW, I1_MODB, I1_N1G, I1_WIN, I1_WGKF, I1_BGKF, I1_WGKB, I1_BGKB, I1_GNG, I1_WOUT, I1_N2G, I1_RW, I1_RB, I1_WGU, I1_BGU, I1_WDN, I1_BDN };

struct Frame {
    const float* const* in; float* out; unsigned char* ws; LAS unsigned char* lds; LAS unsigned char* ring;
    int tid, lane, wave, G, bid;
};
#define WSP(T_, off) ((T_*)(F.ws + (off)))

__device__ __forceinline__ int gu_row(int n) { const int a = n >> 1, half = n & 1; return 256 * (a >> 7) + 128 * half + (a & 127); }
template <int MODE>
__device__ __forceinline__ void cvt_tile(const Frame& F, LAS bf16_t* tile  , const float* src, int ldsrc, int k0, int n0, bf16_t* dst, int ldd, const float* sk, float mul) {
    const int t = F.tid;
    { const int kl = t >> 3, nc = (t & 7) * 8; const float* p = src + (size_t)(k0 + kl) * ldsrc + n0 + nc;
      const f32x4 a = *(const f32x4*)p, b = *(const f32x4*)(p + 4); const float s = (sk ? sk[k0 + kl] : 1.0f) * mul;
      tile[(nc + 0) * 72 + kl] = f2bf(a[0] * s); tile[(nc + 1) * 72 + kl] = f2bf(a[1] * s); tile[(nc + 2) * 72 + kl] = f2bf(a[2] * s); tile[(nc + 3) * 72 + kl] = f2bf(a[3] * s);
      tile[(nc + 4) * 72 + kl] = f2bf(b[0] * s); tile[(nc + 5) * 72 + kl] = f2bf(b[1] * s); tile[(nc + 6) * 72 + kl] = f2bf(b[2] * s); tile[(nc + 7) * 72 + kl] = f2bf(b[3] * s); }
    __syncthreads();
    { const int nl = t >> 3, kc = (t & 7) * 8; const int n = n0 + nl; const int row = MODE == 1 ? gu_row(n) : n;
      const u32x4 v = *(const LAS u32x4*)(tile + nl * 72 + kc); *(u32x4*)(dst + (size_t)row * ldd + k0 + kc) = v; }
    __syncthreads();
}
template <int MODE>
__device__ __forceinline__ void cvt_blk(const Frame& F, LAS float* tl, const float* src, int ldsrc, int k0, int n0, bf16_t* dst, int ldd) {
    const int t = F.tid, w = t >> 6, l = t & 63;
    f32x4 v[8];
#pragma unroll
    for (int i = 0; i < 8; ++i) v[i] = *(const f32x4*)(src + (size_t)(k0 + w + 8 * i) * ldsrc + n0 + 4 * l);
#pragma unroll
    for (int i = 0; i < 8; ++i) *(LAS f32x4*)(tl + (w + 8 * i) * 260 + 4 * l) = v[i];
    __syncthreads();
    { const int n = t & 255, kh = t >> 8; const int row = MODE == 1 ? gu_row(n0 + n) : n0 + n; bf16_t* dp = dst + (size_t)row * ldd + k0 + kh * 32;
#pragma unroll
      for (int q = 0; q < 4; ++q) { float x[8];
#pragma unroll
          for (int j = 0; j < 8; ++j) x[j] = tl[(kh * 32 + 8 * q + j) * 260 + n];
          u32x4 o; o.x = cvt_pk_bf16(x[0], x[1]); o.y = cvt_pk_bf16(x[2], x[3]); o.z = cvt_pk_bf16(x[4], x[5]); o.w = cvt_pk_bf16(x[6], x[7]);
          *(u32x4*)(dp + 8 * q) = o; } }
    __syncthreads();
}
constexpr int CVT_NGU = NE * 16 * 8, CVT_NDN = NE * 16 * 4, CVT_JOBS = CVT_NGU + CVT_NDN;
__device__ __forceinline__ void cvt_moe_job(const Frame& F, LAS float* tl, const float* wgu, const float* wdn, int j) {
    bf16_t* WGU = WSP(bf16_t, WS_WGU); bf16_t* WDN = WSP(bf16_t, WS_WDN);
    if (j < CVT_NGU) { const int e = j >> 7, r = j & 127, kt = r >> 3, ntl = r & 7; cvt_blk<1>(F, tl, wgu + (size_t)e * 1024 * 2048, 2048, kt * 64, ntl * 256, WGU + (size_t)e * 2048 * 1024, 1024); }
    else { const int jj = j - CVT_NGU, e = jj >> 6, r = jj & 63, kt = r >> 2, ntl = r & 3; cvt_blk<0>(F, tl, wdn + (size_t)e * 1024 * 1024, 1024, kt * 64, ntl * 256, WDN + (size_t)e * 1024 * 1024, 1024); }
}
__device__ __forceinline__ void cvt_moe_weights(const Frame& F, LAS float* tl, const float* wgu, const float* wdn) {
    for (int j = F.bid; j < CVT_JOBS; j += F.G) cvt_moe_job(F, tl, wgu, wdn, j);
}
__device__ __forceinline__ void ph_prologue(const Frame& F) {
    LAS float* sc = (LAS float*)(F.ring);
    LAS float* red = (LAS float*)(F.ring + 36864);
    LAS float* ctab = (LAS float*)(F.ring + 55296);
    LAS float* stab = ctab + 4096;
    LAS bf16_t* tile = (LAS bf16_t*)(F.ring + 88064);
    LAS float* wt = (LAS float*)(F.ring + 97280);
    const int t = F.tid;
    for (int i = t; i < 9 * 1024; i += NTHR) { const int r = i >> 10, k = i & 1023; const float v = (r < 8) ? F.in[I_C][r * 1024 + k] : F.in[I_CCTX][k]; sc[i] = siluf(v); }
    for (int i = t; i < 4096; i += NTHR) { const float x = (float)i * (1.0f / 2048.0f); ctab[i] = cospif(x); stab[i] = sinpif(x); }
    __syncthreads();
    for (int u = F.bid; u < 2 * 96; u += F.G) {
        const int l = u / 96, j0 = (u % 96) * 64; const float* W = l ? F.in[I1_MODW] : F.in[I0_MODW]; const float* Bv = l ? F.in[I1_MODB] : F.in[I0_MODB];
        const int c4 = t & 15, kb = F.wave * 128 + ((t >> 4) & 3) * 32; f32x4 a[9];
#pragma unroll
        for (int r = 0; r < 9; ++r) a[r] = (f32x4){0.f, 0.f, 0.f, 0.f};
#pragma unroll 8
        for (int q = 0; q < 32; ++q) { const f32x4 w = *(const f32x4*)(W + (size_t)(kb + q) * 6144 + j0 + 4 * c4);
#pragma unroll
            for (int r = 0; r < 9; ++r) a[r] += w * sc[r * 1024 + kb + q]; }
#pragma unroll
        for (int r = 0; r < 9; ++r) {
#pragma unroll
            for (int j = 0; j < 4; ++j) { float v = a[r][j]; v += __shfl_xor(v, 16); v += __shfl_xor(v, 32); a[r][j] = v; }
            if ((t & 48) == 0) *(LAS f32x4*)(red + (F.wave * 9 + r) * 64 + 4 * c4) = a[r]; }
        __syncthreads();
        for (int i = t; i < 576; i += NTHR) { const int r = i >> 6, c = i & 63; float s = 0.f;
#pragma unroll
            for (int q = 0; q < 8; ++q) s += red[(q * 9 + r) * 64 + c];
            WSP(float, WS_MODV)[(size_t)(l * 9 + r) * 6144 + j0 + c] = s + Bv[j0 + c]; }
        __syncthreads();
    }
    if (F.bid == (1 % F.G)) { for (int i = t; i < 1024; i += NTHR) { const int pos = i >> 4, j = i & 15; const float inv = powf(10000.0f, -(float)j / 16.0f); const float ang = (float)pos * inv;
        WSP(float, WS_ROPE)[i] = cosf(ang); WSP(float, WS_ROPE)[1024 + i] = sinf(ang); } }
    { bf16_t* DFT = WSP(bf16_t, R0_DFT); bf16_t* DFTC = WSP(bf16_t, R0_DFTC);
      for (int k = F.bid; k < 4096 + 256; k += F.G) {
          if (k < 4096) { for (int jc = t; jc < 512; jc += NTHR) { const int j0 = jc * 8; float v[8];
#pragma unroll
                  for (int q = 0; q < 8; ++q) { const int j = j0 + q; const bool isS = j > 2048; const int idx = (k * (isS ? j - 2048 : j)) & 4095; v[q] = (isS ? stab[idx] : ctab[idx]) * (1.0f / 512.0f); }
                  u32x4 w; w.x = pk2(v[0], v[1]); w.y = pk2(v[2], v[3]); w.z = pk2(v[4], v[5]); w.w = pk2(v[6], v[7]); *(u32x4*)(DFT + (size_t)k * 4096 + j0) = w; } }
          else { const int kk = k - 4096; for (int jc = t; jc < 32; jc += NTHR) { const int j0 = jc * 8; float v[8];
#pragma unroll
                  for (int q = 0; q < 8; ++q) { const int j = j0 + q; const bool isS = j > 128; const int idx = ((kk * (isS ? j - 128 : j)) & 255) * 16; v[q] = (isS ? stab[idx] : ctab[idx]) * (1.0f / 128.0f); }
                  u32x4 w; w.x = pk2(v[0], v[1]); w.y = pk2(v[2], v[3]); w.z = pk2(v[4], v[5]); w.w = pk2(v[6], v[7]); *(u32x4*)(DFTC + (size_t)kk * 256 + j0) = w; } }
      } }
    { bf16_t* WF = WSP(bf16_t, WS_WF); const float* Win = F.in[I0_WIN];
      for (int j = (F.bid + 64) % F.G; j < 64; j += F.G) { const int k0 = (j >> 2) * 64, g = j & 3;
          for (int i = t; i < 4096; i += NTHR) { const int kl = i >> 6, c = i & 63; wt[kl * 65 + c] = Win[(size_t)(k0 + kl) * 960 + 704 + g * 64 + c]; }
          __syncthreads();
          { const int kl = t & 63, mg = t >> 6;
#pragma unroll 1
            for (int mm = 0; mm < 8; ++mm) { const int m = mg * 8 + mm; float ac = 0.f, as = 0.f;
                for (int c = 0; c < 64; ++c) { const int idx = ((m * c) & 63) * 64; const float w = wt[kl * 65 + c]; ac = fmaf(w, ctab[idx], ac); as = fmaf(w, stab[idx], as); }
                WF[(size_t)(g * 64 + m) * 1024 + k0 + kl] = f2bf(ac); WF[(size_t)(256 + g * 64 + m) * 1024 + k0 + kl] = f2bf(-as); } }
          __syncthreads(); } }
    for (int i = F.bid * NTHR + t; i < 2 * 32 * 1024; i += F.G * NTHR) { const int l = i >> 15, e = (i >> 10) & 31, k = i & 1023; const float w = (l ? F.in[I1_RW] : F.in[I0_RW])[k * 32 + e];
        const bf16_t hi = f2bf(w); const bf16_t lo = f2bf(w - bf2f(hi)); bf16_t* base = WSP(bf16_t, WS_RWT) + (size_t)l * 2 * 32 * 1024; base[e * 1024 + k] = hi; base[32 * 1024 + e * 1024 + k] = lo; }
    {
      constexpr int J_WIN0 = 16 * 11, J_WQ = 6 * 18, J_WKV = 4 * 24, J_WO = 16 * 16, J_WIN1 = 16 * 48;
      constexpr int JT = J_WIN0 + J_WQ + J_WKV + 2 * J_WO + J_WIN1;
      for (int j = F.bid; j < JT; j += F.G) { int r = j;
          if (r < J_WIN0) { cvt_tile<0>(F, tile, F.in[I0_WIN], 960, (r / 11) * 64, (r % 11) * 64, WSP(bf16_t, WS_WIN0), 1024, nullptr, 1.0f); continue; } r -= J_WIN0;
          if (r < J_WQ) { cvt_tile<0>(F, tile, F.in[I0_WQUP], 1152, (r / 18) * 64, (r % 18) * 64, WSP(bf16_t, WS_WQ), QL, F.in[I0_QNG], 1.0f); continue; } r -= J_WQ;
          if (r < J_WKV) { cvt_tile<0>(F, tile, F.in[I0_WKVUP], 1536, (r / 24) * 64, (r % 24) * 64, WSP(bf16_t, WS_WKV), KVL, F.in[I0_KVNG], 1.0f); continue; } r -= J_WKV;
          if (r < J_WO) { cvt_tile<0>(F, tile, F.in[I0_WOUT], 1024, (r / 16) * 64, (r % 16) * 64, WSP(bf16_t, WS_WOUT0), 1024, nullptr, 1.0f); continue; } r -= J_WO;
          if (r < J_WO) { cvt_tile<0>(F, tile, F.in[I1_WOUT], 1024, (r / 16) * 64, (r % 16) * 64, WSP(bf16_t, WS_WOUT1), 1024, nullptr, 1.0f); continue; } r -= J_WO;
          { const int n0 = (r % 48) * 64; cvt_tile<0>(F, tile, F.in[I1_WIN], 3104, (r / 48) * 64, n0, WSP(bf16_t, WS_WIN1), 1024, nullptr, n0 < 512 ? 0.08838834764831845f : 1.0f); }
      }
      for (int i = F.bid * NTHR + t; i < (64 * 1024 + 128 * QL) / 8; i += F.G * NTHR) { const u32x4 z = {0u, 0u, 0u, 0u};
          if (i < 64 * 1024 / 8) *(u32x4*)(WSP(bf16_t, WS_WIN0) + (size_t)704 * 1024 + (size_t)i * 8) = z; else *(u32x4*)(WSP(bf16_t, WS_WQ) + (size_t)1152 * QL + (size_t)(i - 64 * 1024 / 8) * 8) = z; }
    }
}

__device__ __forceinline__ const float* xrow_in(const Frame& F, int r) { return r < TC ? F.in[I_CTX] + (size_t)r * D : F.in[I_X] + (size_t)(r - TC) * D; }
__device__ __forceinline__ float* xrow_res(const Frame& F, int r) { return r < TC ? WSP(float, WS_XCTX) + (size_t)r * D : F.out + (size_t)(r - TC) * D; }
__device__ __forceinline__ int modrow(int r) { return r < TC ? 8 : ((r - TC) >> 12); }
__device__ __forceinline__ void ld16f(const float* p, int lane, float (&v)[16]) {
#pragma unroll
    for (int h = 0; h < 2; ++h) { const f32x4 a = *(const f32x4*)(p + 8 * lane + 512 * h), b = *(const f32x4*)(p + 8 * lane + 512 * h + 4);
        v[8 * h] = a[0]; v[8 * h + 1] = a[1]; v[8 * h + 2] = a[2]; v[8 * h + 3] = a[3]; v[8 * h + 4] = b[0]; v[8 * h + 5] = b[1]; v[8 * h + 6] = b[2]; v[8 * h + 7] = b[3]; }
}
__device__ __forceinline__ void st16f(float* p, int lane, const float (&v)[16]) {
#pragma unroll
    for (int h = 0; h < 2; ++h) { *(f32x4*)(p + 8 * lane + 512 * h) = (f32x4){v[8 * h], v[8 * h + 1], v[8 * h + 2], v[8 * h + 3]}; *(f32x4*)(p + 8 * lane + 512 * h + 4) = (f32x4){v[8 * h + 4], v[8 * h + 5], v[8 * h + 6], v[8 * h + 7]}; }
}
__device__ __forceinline__ void ld16b(const bf16_t* p, int lane, float (&v)[16]) {
#pragma unroll
    for (int h = 0; h < 2; ++h) { const u32x4 w = *(const u32x4*)(p + 8 * lane + 512 * h);
#pragma unroll
        for (int q = 0; q < 4; ++q) { v[8 * h + 2 * q] = __uint_as_float(w[q] << 16); v[8 * h + 2 * q + 1] = __uint_as_float(w[q] & 0xffff0000u); } }
}
__device__ __forceinline__ void st16b(bf16_t* p, int lane, const float (&v)[16]) {
#pragma unroll
    for (int h = 0; h < 2; ++h) { u32x4 w; w.x = cvt_pk_bf16(v[8 * h], v[8 * h + 1]); w.y = cvt_pk_bf16(v[8 * h + 2], v[8 * h + 3]); w.z = cvt_pk_bf16(v[8 * h + 4], v[8 * h + 5]); w.w = cvt_pk_bf16(v[8 * h + 6], v[8 * h + 7]);
        *(u32x4*)(p + 8 * lane + 512 * h) = w; }
}
__device__ __forceinline__ void modulate16(float (&v)[16], const float* g, const float* scale, const float* shift, int lane) {
    float ss = 0.f;
#pragma unroll
    for (int i = 0; i < 16; ++i) ss = fmaf(v[i], v[i], ss);
    const float rs = rsqrtf(wsum(ss) * (1.0f / D) + EPS);
    float gg[16], sc[16], sh[16]; ld16f(g, lane, gg); ld16f(scale, lane, sc); ld16f(shift, lane, sh);
#pragma unroll
    for (int i = 0; i < 16; ++i) v[i] = v[i] * rs * gg[i] * (1.0f + sc[i]) + sh[i];
}

__device__ __forceinline__ void ph_mod0(const Frame& F) {
    const float* g = F.in[I0_N1G]; bf16_t* H = WSP(bf16_t, WS_H);
    for (int r = F.bid * NWAVE + F.wave; r < T; r += F.G * NWAVE) {
        const float* mv = WSP(float, WS_MODV) + (size_t)modrow(r) * 6144;
        float v[16]; ld16f(xrow_in(F, r), F.lane, v);
        modulate16(v, g, mv + 1024, mv, F.lane);
        st16b(H + (size_t)r * D, F.lane, v);
    }
}
__device__ __forceinline__ void ph_rowstats(const Frame& F) {
    const bf16_t* U0 = WSP(bf16_t, R0_U0); float* rsq = WSP(float, WS_RS); float* rskv = rsq + T; bf16_t* KR = WSP(bf16_t, R0_KR);
    const float* rc = WSP(float, WS_ROPE); const float* rsn = rc + 1024;
    for (int r = F.bid * NWAVE + F.wave; r < T; r += F.G * NWAVE) {
        const bf16_t* u = U0 + (size_t)r * U0W; const int lane = F.lane;
        float a[8], b[8];
        { const u32x4 w = *(const u32x4*)(u + 8 * lane);
#pragma unroll
          for (int q = 0; q < 4; ++q) { a[2 * q] = __uint_as_float(w[q] << 16); a[2 * q + 1] = __uint_as_float(w[q] & 0xffff0000u); } }
        { u32x4 w = {0u, 0u, 0u, 0u}; if (lane < 32) w = *(const u32x4*)(u + 512 + 8 * lane);
#pragma unroll
          for (int q = 0; q < 4; ++q) { b[2 * q] = __uint_as_float(w[q] << 16); b[2 * q + 1] = __uint_as_float(w[q] & 0xffff0000u); } }
        float sa = 0.f, sb = 0.f;
#pragma unroll
        for (int j = 0; j < 8; ++j) { sa = fmaf(a[j], a[j], sa); sb = fmaf(b[j], b[j], sb); }
        const float sq = wsum(lane < 48 ? sa : 0.f), skv = wsum((lane >= 48 ? sa : 0.f) + (lane < 16 ? sb : 0.f));
        float pr[8];
#pragma unroll
        for (int j = 0; j < 8; ++j) pr[j] = __shfl_xor(b[j], 2);
        if (lane >= 16 && lane < 24) { const int jq = lane - 16, quarter = jq >> 1;
            if (r >= TC) { const int n = (r - TC) & 4095; const int pos = (quarter >= 2) ? (n & 63) : (n >> 6); const float* cp = rc + pos * 16 + (jq & 1) * 8; const float* sp = rsn + pos * 16 + (jq & 1) * 8;
#pragma unroll
                for (int j = 0; j < 8; ++j) b[j] = (quarter & 1) ? (b[j] * cp[j] + pr[j] * sp[j]) : (b[j] * cp[j] - pr[j] * sp[j]); }
            u32x4 w; w.x = cvt_pk_bf16(b[0], b[1]); w.y = cvt_pk_bf16(b[2], b[3]); w.z = cvt_pk_bf16(b[4], b[5]); w.w = cvt_pk_bf16(b[6], b[7]);
            *(u32x4*)(KR + (size_t)r * ROPE + 8 * jq) = w; }
        if (lane == 0) { rsq[r] = rsqrtf(sq * (1.0f / QL) + EPS); rskv[r] = rsqrtf(skv * (1.0f / KVL) + EPS); }
    }
    { const bf16_t* TT = WSP(bf16_t, R0_TT); const bf16_t* TTC = WSP(bf16_t, R0_TTC); bf16_t* TT2 = WSP(bf16_t, R0_TT2); bf16_t* TTC2 = WSP(bf16_t, R0_TTC2);
      const int nch_l = NB * 256 * 512, nch_c = NB * 256 * 32;
      for (int i = F.bid * NTHR + F.tid; i < nch_l + nch_c; i += F.G * NTHR) {
          const bool lat = i < nch_l; const int ii = lat ? i : i - nch_l; const int N = lat ? 4096 : 256; const int cpr = N >> 3; const int row = ii / cpr, p0 = (ii % cpr) * 8;
          const bf16_t* src = (lat ? TT : TTC) + (size_t)row * 2 * N; bf16_t* dst = (lat ? TT2 : TTC2) + (size_t)row * N + p0; float v[8];
#pragma unroll
          for (int q = 0; q < 8; ++q) { const int pp = p0 + q; const bool cs = pp <= (N >> 1); const int j = cs ? pp : pp - (N >> 1); const bf16_t* X = cs ? src : src + N;
              const float a = bf2f(X[j]); const float bmir = (j == 0 || j == (N >> 1)) ? 0.f : bf2f(X[N - j]); v[q] = cs ? a + bmir : a - bmir; }
          u32x4 w; w.x = pk2(v[0], v[1]); w.y = pk2(v[2], v[3]); w.z = pk2(v[4], v[5]); w.w = pk2(v[6], v[7]); *(u32x4*)dst = w; }
    }
}

namespace att {
typedef float f32x16 __attribute__((ext_vector_type(16)));
typedef short s16x4 __attribute__((ext_vector_type(4)));
constexpr float SCALE = 0.07216878364870322f, THR = 8.f;
constexpr int SHM_V = 16384, SHM_KN = 64 * 272, SHM_KR = 64 * 144, SHM_QW = 32 * 272;
constexpr int OFF_V = 0, OFF_KN = 2 * SHM_V, OFF_KR = OFF_KN + 2 * SHM_KN, OFF_WS = OFF_KR + 2 * SHM_KR, OFF_QR = OFF_WS + 2048;
#define KNSWZ(row, cb) ((row) * 272 + (cb))
#define KRSWZ(row, cb) ((row) * 144 + (cb))
#define SBAR() __builtin_amdgcn_sched_barrier(0)
__device__ __forceinline__ int crow(int r, int hi) { return (r & 3) + 8 * (r >> 2) + 4 * hi; }
__device__ __forceinline__ void partialSM(f32x16& p0, f32x16& p1, float& m_reg, float& mn, float& alpha) {
  constexpr float C = SCALE * 1.4426950408889634f;
  float pmax = p0[0];
#pragma unroll
  for (int r = 1; r < 16; ++r) pmax = fmaxf(pmax, p0[r]);
#pragma unroll
  for (int r = 0; r < 16; ++r) pmax = fmaxf(pmax, p1[r]);
  { auto rr = __builtin_amdgcn_permlane32_swap(__float_as_uint(pmax), __float_as_uint(pmax), false, false);
    pmax = fmaxf(__uint_as_float(rr[0]), __uint_as_float(rr[1])); }
  if (__builtin_expect(__all(pmax - m_reg <= THR / SCALE), 1)) { mn = m_reg; alpha = 1.f; }
  else { mn = fmaxf(m_reg, pmax); alpha = __builtin_amdgcn_exp2f((m_reg - mn) * C); m_reg = mn; }
  const float mnC = -mn * C;
#pragma unroll
  for (int r = 0; r < 16; ++r) p0[r] = fmaf(p0[r], C, mnC);
#pragma unroll
  for (int r = 0; r < 16; ++r) p1[r] = fmaf(p1[r], C, mnC);
#pragma unroll
  for (int r = 0; r < 16; ++r) p0[r] = __builtin_amdgcn_exp2f(p0[r]);
}
__device__ __forceinline__ void finishSM(f32x16& p0, f32x16& p1, float alpha, float& l_reg, bf16x8& pa0, bf16x8& pa1, bf16x8& pa2, bf16x8& pa3) {
#pragma unroll
  for (int r = 0; r < 16; ++r) p1[r] = __builtin_amdgcn_exp2f(p1[r]);
  float ps = 0;
#pragma unroll
  for (int r = 0; r < 16; ++r) ps += p0[r];
#pragma unroll
  for (int r = 0; r < 16; ++r) ps += p1[r];
  { auto rr = __builtin_amdgcn_permlane32_swap(__float_as_uint(ps), __float_as_uint(ps), false, false);
    ps = __uint_as_float(rr[0]) + __uint_as_float(rr[1]); }
  l_reg = l_reg * alpha + ps;
#define PK4(P, BASE, OUT) do { unsigned a0 = cvt_pk_bf16(P[BASE + 0], P[BASE + 1]), a1 = cvt_pk_bf16(P[BASE + 2], P[BASE + 3]);   \
    unsigned b0 = cvt_pk_bf16(P[BASE + 4], P[BASE + 5]), b1 = cvt_pk_bf16(P[BASE + 6], P[BASE + 7]);                              \
    auto r0 = __builtin_amdgcn_permlane32_swap(a0, b0, false, false); auto r1 = __builtin_amdgcn_permlane32_swap(a1, b1, false, false); \
    u32x4 w = {r0[0], r1[0], r0[1], r1[1]}; OUT = *reinterpret_cast<bf16x8*>(&w); } while (0)
  PK4(p0, 0, pa0); PK4(p0, 8, pa1); PK4(p1, 0, pa2); PK4(p1, 8, pa3);
#undef PK4
}
__device__ __forceinline__ void qkt(f32x16& p0, f32x16& p1, const LAS char* Kn, const LAS char* Kr, const bf16x8 (&qr)[4], const LAS char* Qr, int r32, int hi) {
  p0 = f32x16{}; p1 = f32x16{};
#pragma unroll
  for (int d0 = 0; d0 < 8; ++d0) { const int cb = (d0 * 16 + hi * 8) * 2;
    const bf16x8 b0 = *(const LAS bf16x8*)(Kn + KNSWZ(r32, cb));
    const bf16x8 b1 = *(const LAS bf16x8*)(Kn + KNSWZ(32 + r32, cb));
    bf16x8 qq; if (d0 < 4) qq = qr[d0]; else qq = *(const LAS bf16x8*)(Qr + KNSWZ(r32, ((d0 - 4) * 16 + hi * 8) * 2));
    p0 = __builtin_amdgcn_mfma_f32_32x32x16_bf16(b0, qq, p0, 0, 0, 0);
    p1 = __builtin_amdgcn_mfma_f32_32x32x16_bf16(b1, qq, p1, 0, 0, 0); }
#pragma unroll
  for (int d0 = 0; d0 < 4; ++d0) { const int cb = (d0 * 16 + hi * 8) * 2;
    const bf16x8 b0 = *(const LAS bf16x8*)(Kr + KRSWZ(r32, cb));
    const bf16x8 b1 = *(const LAS bf16x8*)(Kr + KRSWZ(32 + r32, cb));
    const bf16x8 qq = *(const LAS bf16x8*)(Qr + KNSWZ(r32, ((4 + d0) * 16 + hi * 8) * 2));
    p0 = __builtin_amdgcn_mfma_f32_32x32x16_bf16(b0, qq, p0, 0, 0, 0);
    p1 = __builtin_amdgcn_mfma_f32_32x32x16_bf16(b1, qq, p1, 0, 0, 0); }
}
__device__ __forceinline__ int v_st(int k, int c) { const int kk = (k & ~0xC) | ((k & 4) << 1) | ((k & 8) >> 1); return ((kk >> 3) * 4 + (c >> 5)) * 512 + ((kk & 7) * 32 + (c & 31)) * 2; }
__device__ __forceinline__ int v_rd_base(int lane) { return ((lane & 3) << 3) | (((lane >> 2) & 3) << 6) | (((lane >> 4) & 1) << 5) | (((lane >> 5) & 1) << 8); }
constexpr int v_rd_off(int d0, int ks, int half) { return d0 * 512 + ks * 4096 + half * 2048; }
template <int OFF> __device__ __forceinline__ s16x4 tr_read(int vb) {
  s16x4 r; asm volatile("ds_read_b64_tr_b16 %0, %1 offset:%2" : "=&v"(r) : "v"(vb), "i"(OFF) : "memory"); return r;
}
template <int D0> __device__ __forceinline__ void pv_one(f32x16& od, int vb, bf16x8 pa0, bf16x8 pa1, bf16x8 pa2, bf16x8 pa3) {
  const s16x4 l0 = tr_read<v_rd_off(D0, 0, 0)>(vb), h0 = tr_read<v_rd_off(D0, 0, 1)>(vb), l1 = tr_read<v_rd_off(D0, 1, 0)>(vb), h1 = tr_read<v_rd_off(D0, 1, 1)>(vb);
  const s16x4 l2 = tr_read<v_rd_off(D0, 2, 0)>(vb), h2 = tr_read<v_rd_off(D0, 2, 1)>(vb), l3 = tr_read<v_rd_off(D0, 3, 0)>(vb), h3 = tr_read<v_rd_off(D0, 3, 1)>(vb);
  asm volatile("s_waitcnt lgkmcnt(0)" ::: "memory"); SBAR();
#define PK(L, H) (bf16x8){L[0], L[1], L[2], L[3], H[0], H[1], H[2], H[3]}
  od = __builtin_amdgcn_mfma_f32_32x32x16_bf16(pa0, PK(l0, h0), od, 0, 0, 0);
  od = __builtin_amdgcn_mfma_f32_32x32x16_bf16(pa1, PK(l1, h1), od, 0, 0, 0);
  od = __builtin_amdgcn_mfma_f32_32x32x16_bf16(pa2, PK(l2, h2), od, 0, 0, 0);
  od = __builtin_amdgcn_mfma_f32_32x32x16_bf16(pa3, PK(l3, h3), od, 0, 0, 0);
#undef PK
}
__device__ __forceinline__ void pv_d0(f32x16 (&o)[4], int vb, bf16x8 pa0, bf16x8 pa1, bf16x8 pa2, bf16x8 pa3) {
  pv_one<0>(o[0], vb, pa0, pa1, pa2, pa3); pv_one<1>(o[1], vb, pa0, pa1, pa2, pa3); pv_one<2>(o[2], vb, pa0, pa1, pa2, pa3); pv_one<3>(o[3], vb, pa0, pa1, pa2, pa3);
}
__device__ __forceinline__ void attn_unit(const bf16_t* __restrict__ Q, const bf16_t* __restrict__ KV, const bf16_t* __restrict__ KR, bf16_t* __restrict__ MIX,
                                          const float* __restrict__ ropec, const float* __restrict__ ropes, int h, int qrow0, bool lat, int crow0, int lrow0, int NT, LAS char* lds) {
  int tid = threadIdx.x; asm volatile("" : "+v"(tid));
  const int wid = __builtin_amdgcn_readfirstlane(tid >> 6), lane = tid & 63, r32 = lane & 31, hi = lane >> 5;
  LAS char* V_lds = lds + OFF_V; LAS char* KN_lds = lds + OFF_KN; LAS char* KR_lds = lds + OFF_KR;
  LAS float* ws = (LAS float*)(lds + OFF_WS) + wid * 64; LAS float* li_l = ws; LAS float* al_l = ws + 32;
  float m_reg = -1e30f, l_reg = 0; f32x16 o[4] = {}; bf16x8 qr[4];
  LAS char* Qr = lds + OFF_QR + wid * SHM_QW;
  { const int qrow = qrow0 + wid * 32 + r32; const bf16_t* Qw = Q + (size_t)qrow * QW + h * QKD + hi * 8;
#pragma unroll
    for (int d0 = 0; d0 < 4; ++d0) qr[d0] = *(const bf16x8*)(Qw + d0 * 16);
#pragma unroll
    for (int d0 = 4; d0 < 8; ++d0) *(LAS bf16x8*)(Qr + KNSWZ(r32, ((d0 - 4) * 16 + hi * 8) * 2)) = *(const bf16x8*)(Qw + d0 * 16);
    const int n = (qrow - TC) & 4095;
#pragma unroll
    for (int ax = 0; ax < 2; ++ax) {
      const bf16x8 q1 = *(const bf16x8*)(Qw + (8 + 2 * ax) * 16), q2 = *(const bf16x8*)(Qw + (9 + 2 * ax) * 16);
      u32x4 w1 = *reinterpret_cast<const u32x4*>(&q1), w2 = *reinterpret_cast<const u32x4*>(&q2);
      if (lat) { const int pos = ax ? (n & 63) : (n >> 6); const float* cp = ropec + pos * 16 + hi * 8; const float* sp = ropes + pos * 16 + hi * 8;
#pragma unroll
        for (int j = 0; j < 4; ++j) { const float c0 = cp[2 * j], s0 = sp[2 * j], c1 = cp[2 * j + 1], s1 = sp[2 * j + 1];
          const float a0 = bf2f((bf16_t)q1[2 * j]), a1 = bf2f((bf16_t)q1[2 * j + 1]), b0 = bf2f((bf16_t)q2[2 * j]), b1 = bf2f((bf16_t)q2[2 * j + 1]);
          w1[j] = cvt_pk_bf16(a0 * c0 - b0 * s0, a1 * c1 - b1 * s1);
          w2[j] = cvt_pk_bf16(b0 * c0 + a0 * s0, b1 * c1 + a1 * s1); } }
      *(LAS u32x4*)(Qr + KNSWZ(r32, ((4 + 2 * ax) * 16 + hi * 8) * 2)) = w1; *(LAS u32x4*)(Qr + KNSWZ(r32, ((5 + 2 * ax) * 16 + hi * 8) * 2)) = w2; }
  }
  const int sr = tid >> 4, sc = (tid & 15) * 8, vst0 = v_st(sr, sc), vst1 = v_st(32 + sr, sc);
  const int rr = tid >> 3, rc = (tid & 7) * 8;
  const int vb0 = (int)(uintptr_t)V_lds + v_rd_base(lane);
  const bf16_t* KVh = KV + h * 256;
  const int nctx_t = lat ? 4 : NT;
  bf16x8 vs0, vs1, ks0, ks1, krs;
#define TROW(kt) ((kt) < nctx_t ? crow0 + (kt) * 64 : lrow0 + ((kt) - nctx_t) * 64)
#define SLOAD(kt) do { const int _r0 = TROW(kt); const bf16_t* _p0 = KVh + (size_t)(_r0 + sr) * KVW + sc; const bf16_t* _p1 = KVh + (size_t)(_r0 + 32 + sr) * KVW + sc; \
    vs0 = *(const bf16x8*)(_p0 + 128); vs1 = *(const bf16x8*)(_p1 + 128); ks0 = *(const bf16x8*)_p0; ks1 = *(const bf16x8*)_p1; krs = *(const bf16x8*)(KR + (size_t)(_r0 + rr) * ROPE + rc); } while (0)
#define SWRITE(b) do { *(LAS bf16x8*)(V_lds + (b) * SHM_V + vst0) = vs0; *(LAS bf16x8*)(V_lds + (b) * SHM_V + vst1) = vs1; \
    *(LAS bf16x8*)(KN_lds + (b) * SHM_KN + KNSWZ(sr, sc * 2)) = ks0; *(LAS bf16x8*)(KN_lds + (b) * SHM_KN + KNSWZ(32 + sr, sc * 2)) = ks1; \
    *(LAS bf16x8*)(KR_lds + (b) * SHM_KR + KRSWZ(rr, rc * 2)) = krs; } while (0)
#define SWAIT() asm volatile("s_waitcnt vmcnt(0)" ::: "memory")
#define RESC(a) do { if (__any((a) < 1.f)) { if (hi == 0) al_l[r32] = (a); asm volatile("s_waitcnt lgkmcnt(0)" ::: "memory"); \
    _Pragma("unroll") for (int d = 0; d < 4; ++d) _Pragma("unroll") for (int r = 0; r < 16; ++r) o[d][r] *= al_l[crow(r, hi)]; } } while (0)
  f32x16 pA0, pA1, pB0, pB1; float mnA, mnB, alA, alB; bf16x8 pa0, pa1, pa2, pa3;
  SLOAD(0); SWAIT(); SWRITE(0); __syncthreads();
  qkt(pA0, pA1, KN_lds, KR_lds, qr, Qr, r32, hi); partialSM(pA0, pA1, m_reg, mnA, alA);
  SLOAD(1); SWAIT(); SWRITE(1); __syncthreads();
  for (int j = 1; j + 1 < NT; j += 2) {
    SBAR(); qkt(pB0, pB1, KN_lds + SHM_KN, KR_lds + SHM_KR, qr, Qr, r32, hi);
    finishSM(pA0, pA1, alA, l_reg, pa0, pa1, pa2, pa3); SBAR();
    SLOAD(j + 1); SBAR();
    pv_d0(o, vb0, pa0, pa1, pa2, pa3); partialSM(pB0, pB1, m_reg, mnB, alB);
    __syncthreads(); SWAIT(); SWRITE(0);
    RESC(alB); __syncthreads();
    SBAR(); qkt(pA0, pA1, KN_lds, KR_lds, qr, Qr, r32, hi);
    finishSM(pB0, pB1, alB, l_reg, pa0, pa1, pa2, pa3); SBAR();
    SLOAD(j + 2); SBAR();
    pv_d0(o, vb0 + SHM_V, pa0, pa1, pa2, pa3); partialSM(pA0, pA1, m_reg, mnA, alA);
    __syncthreads(); SWAIT(); SWRITE(1);
    RESC(alA); __syncthreads();
  }
  SBAR(); qkt(pB0, pB1, KN_lds + SHM_KN, KR_lds + SHM_KR, qr, Qr, r32, hi);
  finishSM(pA0, pA1, alA, l_reg, pa0, pa1, pa2, pa3); SBAR();
  pv_d0(o, vb0, pa0, pa1, pa2, pa3); partialSM(pB0, pB1, m_reg, mnB, alB);
  __syncthreads(); RESC(alB);
  finishSM(pB0, pB1, alB, l_reg, pa0, pa1, pa2, pa3); SBAR();
  pv_d0(o, vb0 + SHM_V, pa0, pa1, pa2, pa3);
  if (hi == 0) li_l[r32] = l_reg; asm volatile("s_waitcnt lgkmcnt(0)" ::: "memory");
  float rli[16];
#pragma unroll
  for (int r = 0; r < 16; ++r) rli[r] = __builtin_amdgcn_rcpf(li_l[crow(r, hi)]);
  int tid2 = threadIdx.x; asm volatile("" : "+v"(tid2));
  const int r32e = tid2 & 31, hie = (tid2 >> 5) & 1;
  bf16_t* Ow = MIX + (size_t)(qrow0 + wid * 32) * D + h * VD + r32e;
#pragma unroll
  for (int r = 0; r < 16; ++r) { const int orow = crow(r, hie);
#pragma unroll
    for (int d0 = 0; d0 < 4; ++d0) Ow[(size_t)orow * D + d0 * 32] = f2bf(o[d0][r] * rli[r]); }
  __syncthreads();
#undef TROW
#undef SLOAD
#undef SWRITE
#undef SWAIT
#undef RESC
}
}
constexpr int Q5_ATT = 768, Q5_DFT = Q5_ATT + 128, Q5_ATTC = Q5_DFT + 48, Q5_DFTC = Q5_ATTC + 8, Q5_END = Q5_DFTC + CVT_JOBS;
__device__ __forceinline__ void ph_queue5(const Frame& F) {
    unsigned* qhead = (unsigned*)(F.ws + WS_CTL + CW_Q5);
    LAS int* qslot = (LAS int*)(F.lds + 640);
    const bf16_t* Q = WSP(bf16_t, R0_Q); const bf16_t* KV = WSP(bf16_t, R0_KV); const bf16_t* KR = WSP(bf16_t, R0_KR); bf16_t* MIX = WSP(bf16_t, R0_MIX);
    const float* rc = WSP(float, WS_ROPE); const float* rs = rc + 1024;
    for (;;) {
        __syncthreads();
        if (F.tid == 0) qslot[0] = (int)__hip_atomic_fetch_add(qhead, 1u, __ATOMIC_RELAXED, __HIP_MEMORY_SCOPE_AGENT);
        __syncthreads();
        const int it = __builtin_amdgcn_readfirstlane(qslot[0]);
        if (it >= Q5_END) break;
        if (it < Q5_ATT) { const int b = it / 96, rem = it % 96, h = rem / 16, qb = rem % 16;
            att::attn_unit(Q, KV, KR, MIX, rc, rs, h, TC + b * 4096 + qb * 256, true, b * 256, TC + b * 4096, 68, (LAS char*)F.ring); }
        else if (it < Q5_DFT || (it >= Q5_ATTC && it < Q5_DFTC)) {
            const bool lat = it < Q5_DFT; const int i = lat ? it - Q5_ATT : it - Q5_ATTC; const int b = lat ? i >> 4 : i, pm = lat ? i & 15 : 0; const int K = lat ? 4096 : 256;
            pg8::OneUnit S; S.lda = K; S.u0.pm = pm; S.u0.pn = 0; S.u0.e = b; S.u0.cnt = 0;
            S.u0.A = (const char*)(lat ? WSP(bf16_t, R0_DFT) : WSP(bf16_t, R0_DFTC)) + (size_t)pm * 256 * K * 2;
            S.u0.B = (const char*)(lat ? WSP(bf16_t, R0_TT2) : WSP(bf16_t, R0_TTC2)) + (size_t)b * 256 * K * 2;
            pg8::EpiFourOut E{MIX, lat ? TC : 0, lat ? 4096 : 256};
            pg8::gemm_phase<pg8::EpiFourOut, pg8::OneUnit>(F.ring, pg8::Gemm{K, K, K}, S, E); }
        else if (it < Q5_ATTC) { const int uu = it - Q5_DFT, b = uu / 6, h = uu % 6;
            att::attn_unit(Q, KV, KR, MIX, rc, rs, h, b * 256, false, b * 256, 0, 4, (LAS char*)F.ring); }
        else cvt_moe_job(F, (LAS float*)F.ring, F.in[I0_WGU], F.in[I0_WDN], it - Q5_DFTC);
    }
}

__device__ __forceinline__ void load_w32(const Frame& F, LAS float* wl, const float* W, int ldw) {
    for (int i = F.tid; i < 1024 * 8; i += NTHR) { const int r = i >> 3, q = i & 7; const int c = 8 * (r & 63) + 512 * (r >> 9) + ((r >> 6) & 7); const f32x4 v = *(const f32x4*)(W + (size_t)c * ldw + q * 4); *(LAS f32x4*)(wl + r * 36 + q * 4) = v; }
}
__device__ __forceinline__ float row_gemv32(const float (&v)[16], const LAS float* wl, int lane) {
    float p[32];
#pragma unroll
    for (int e = 0; e < 32; ++e) p[e] = 0.f;
#pragma unroll
    for (int i = 0; i < 16; ++i) { const LAS float* wr_ = wl + (lane + 64 * i) * 36;
#pragma unroll
        for (int q = 0; q < 8; ++q) { const f32x4 w = *(const LAS f32x4*)(wr_ + q * 4); p[4 * q] = fmaf(v[i], w[0], p[4 * q]); p[4 * q + 1] = fmaf(v[i], w[1], p[4 * q + 1]); p[4 * q + 2] = fmaf(v[i], w[2], p[4 * q + 2]); p[4 * q + 3] = fmaf(v[i], w[3], p[4 * q + 3]); }
        asm volatile("" ::: "memory"); }
    float a16[16], a8[8], a4[4], a2[2];
    { const bool up = (lane & 32) != 0;
#pragma unroll
      for (int i = 0; i < 16; ++i) { const float send = up ? p[i] : p[i + 16], keep = up ? p[i + 16] : p[i]; a16[i] = keep + __shfl_xor(send, 32); } }
    { const bool up = (lane & 16) != 0;
#pragma unroll
      for (int i = 0; i < 8; ++i) { const float send = up ? a16[i] : a16[i + 8], keep = up ? a16[i + 8] : a16[i]; a8[i] = keep + __shfl_xor(send, 16); } }
    { const bool up = (lane & 8) != 0;
#pragma unroll
      for (int i = 0; i < 4; ++i) { const float send = up ? a8[i] : a8[i + 4], keep = up ? a8[i + 4] : a8[i]; a4[i] = keep + __shfl_xor(send, 8); } }
    { const bool up = (lane & 4) != 0;
#pragma unroll
      for (int i = 0; i < 2; ++i) { const float send = up ? a4[i] : a4[i + 2], keep = up ? a4[i + 2] : a4[i]; a2[i] = keep + __shfl_xor(send, 4); } }
    float a1; { const bool up = (lane & 2) != 0; const float send = up ? a2[0] : a2[1], keep = up ? a2[1] : a2[0]; a1 = keep + __shfl_xor(send, 2); }
    a1 += __shfl_xor(a1, 1);
    return a1;
}
__device__ __forceinline__ void row_gemv32x2(const float (&va)[16], const float (&vb)[16], const LAS float* wl, int lane, float& ya, float& yb) {
    float p[32], q[32];
#pragma unroll
    for (int e = 0; e < 32; ++e) { p[e] = 0.f; q[e] = 0.f; }
#pragma unroll
    for (int i = 0; i < 16; ++i) { const LAS float* wr_ = wl + (lane + 64 * i) * 36;
#pragma unroll
        for (int k = 0; k < 8; ++k) { const f32x4 w = *(const LAS f32x4*)(wr_ + k * 4);
            p[4 * k] = fmaf(va[i], w[0], p[4 * k]); p[4 * k + 1] = fmaf(va[i], w[1], p[4 * k + 1]); p[4 * k + 2] = fmaf(va[i], w[2], p[4 * k + 2]); p[4 * k + 3] = fmaf(va[i], w[3], p[4 * k + 3]);
            q[4 * k] = fmaf(vb[i], w[0], q[4 * k]); q[4 * k + 1] = fmaf(vb[i], w[1], q[4 * k + 1]); q[4 * k + 2] = fmaf(vb[i], w[2], q[4 * k + 2]); q[4 * k + 3] = fmaf(vb[i], w[3], q[4 * k + 3]); }
        asm volatile("" ::: "memory"); }
    float a16[16], b16[16], a8[8], b8[8], a4[4], b4[4], a2[2], b2[2];
    { const bool up = (lane & 32) != 0;
#pragma unroll
      for (int i = 0; i < 16; ++i) { a16[i] = (up ? p[i + 16] : p[i]) + __shfl_xor(up ? p[i] : p[i + 16], 32); b16[i] = (up ? q[i + 16] : q[i]) + __shfl_xor(up ? q[i] : q[i + 16], 32); } }
    { const bool up = (lane & 16) != 0;
#pragma unroll
      for (int i = 0; i < 8; ++i) { a8[i] = (up ? a16[i + 8] : a16[i]) + __shfl_xor(up ? a16[i] : a16[i + 8], 16); b8[i] = (up ? b16[i + 8] : b16[i]) + __shfl_xor(up ? b16[i] : b16[i + 8], 16); } }
    { const bool up = (lane & 8) != 0;
#pragma unroll
      for (int i = 0; i < 4; ++i) { a4[i] = (up ? a8[i + 4] : a8[i]) + __shfl_xor(up ? a8[i] : a8[i + 4], 8); b4[i] = (up ? b8[i + 4] : b8[i]) + __shfl_xor(up ? b8[i] : b8[i + 4], 8); } }
    { const bool up = (lane & 4) != 0;
#pragma unroll
      for (int i = 0; i < 2; ++i) { a2[i] = (up ? a4[i + 2] : a4[i]) + __shfl_xor(up ? a4[i] : a4[i + 2], 4); b2[i] = (up ? b4[i + 2] : b4[i]) + __shfl_xor(up ? b4[i] : b4[i + 2], 4); } }
    { const bool up = (lane & 2) != 0; ya = (up ? a2[1] : a2[0]) + __shfl_xor(up ? a2[0] : a2[1], 2); yb = (up ? b2[1] : b2[0]) + __shfl_xor(up ? b2[0] : b2[1], 2); }
    ya += __shfl_xor(ya, 1); yb += __shfl_xor(yb, 1);
}
__device__ __forceinline__ void ph_router(const Frame& F, int layer, int r0) {
    typedef float f32x16 __attribute__((ext_vector_type(16)));
    constexpr int HROW = 2064;
    LAS char* HHI = (LAS char*)F.ring; LAS char* HLO = HHI + 32 * HROW; LAS float* RED = (LAS float*)F.ring;
    LAS float* SCR = (LAS float*)(F.ring + 2 * 32 * HROW);
    LAS unsigned* lcnt = (LAS unsigned*)(F.lds + 512);
    const float* g = F.in[layer ? I1_N2G : I0_N2G]; const float* rb_ = F.in[layer ? I1_RB : I0_RB];
    if (F.tid < 64) lcnt[F.tid] = 0u;
    __syncthreads();
    bf16_t* H = WSP(bf16_t, WS_H); unsigned* cnt = (unsigned*)(F.ws + WS_CTL + CW_CNT) + layer * 64;
    int* list = WSP(int, WS_LIST); int* toke = WSP(int, WS_TOKE); int* tokp = WSP(int, WS_TOKP); float* tokg = WSP(float, WS_TOKG);
    const float* modv = WSP(float, WS_MODV) + (size_t)layer * 9 * 6144;
    const bf16_t* WT = WSP(bf16_t, WS_RWT) + (size_t)layer * 2 * 32 * 1024;
    const bf16_t* Yb = layer == 0 ? WSP(bf16_t, R0_U0) : WSP(bf16_t, R1_OF) - (size_t)TC * D;
    const int per = (T - r0 + F.G - 1) / F.G; const int rbeg = r0 + F.bid * per; const int rend = (rbeg + per < T) ? rbeg + per : T;
    const int lane = F.lane, wave = F.wave, r32 = lane & 31, hi2 = lane >> 5;
    float gg[16]; ld16f(g, lane, gg);
    float scv[16], shv[16]; int curm = -1;
    for (int tb = rbeg; tb < rend; tb += 32) {
        f32x4 xr[4][4]; u32x4 yr[4][2];
#pragma unroll
        for (int q = 0; q < 4; ++q) { int r = tb + 4 * wave + q; r = r < rend ? r : rend - 1; const float* xp = layer == 0 ? xrow_in(F, r) : xrow_res(F, r); const bf16_t* yp = Yb + (size_t)r * D;
#pragma unroll
            for (int h = 0; h < 2; ++h) { xr[q][2 * h] = *(const f32x4*)(xp + 8 * lane + 512 * h); xr[q][2 * h + 1] = *(const f32x4*)(xp + 8 * lane + 512 * h + 4); yr[q][h] = *(const u32x4*)(yp + 8 * lane + 512 * h); } }
#pragma unroll
        for (int q = 0; q < 4; ++q) { const int tr = 4 * wave + q, r = tb + tr;
            if (r < rend) {
            float v[16];
#pragma unroll
            for (int h = 0; h < 2; ++h) {
#pragma unroll
                for (int k = 0; k < 4; ++k) { v[8 * h + 2 * k] = xr[q][2 * h + (k >> 1)][2 * (k & 1)] + __uint_as_float(yr[q][h][k] << 16); v[8 * h + 2 * k + 1] = xr[q][2 * h + (k >> 1)][2 * (k & 1) + 1] + __uint_as_float(yr[q][h][k] & 0xffff0000u); } }
            st16f(xrow_res(F, r), lane, v);
            float ss = 0.f;
#pragma unroll
            for (int i = 0; i < 16; ++i) ss = fmaf(v[i], v[i], ss);
            const float rs = rsqrtf(wsum(ss) * (1.0f / D) + EPS);
            const int m = modrow(r);
            if (m != curm) { const float* mv = modv + (size_t)m * 6144; ld16f(mv + 4096, lane, scv); ld16f(mv + 3072, lane, shv); curm = m; }
#pragma unroll
            for (int i = 0; i < 16; ++i) v[i] = v[i] * rs * gg[i] * (1.0f + scv[i]) + shv[i];
#pragma unroll
            for (int h = 0; h < 2; ++h) { u32x4 whi, wlo;
#pragma unroll
                for (int k = 0; k < 4; ++k) { const unsigned ph = cvt_pk_bf16(v[8 * h + 2 * k], v[8 * h + 2 * k + 1]); whi[k] = ph;
                    wlo[k] = cvt_pk_bf16(v[8 * h + 2 * k] - __uint_as_float(ph << 16), v[8 * h + 2 * k + 1] - __uint_as_float(ph & 0xffff0000u)); }
                *(u32x4*)(H + (size_t)r * D + 8 * lane + 512 * h) = whi;
                *(LAS u32x4*)(HHI + tr * HROW + (8 * lane + 512 * h) * 2) = whi; *(LAS u32x4*)(HLO + tr * HROW + (8 * lane + 512 * h) * 2) = wlo; } } }
        __syncthreads();
        f32x16 acc = {};
        { const LAS char* ah = HHI + r32 * HROW + (wave * 128 + hi2 * 8) * 2; const LAS char* al = HLO + r32 * HROW + (wave * 128 + hi2 * 8) * 2;
          const bf16_t* wh = WT + (size_t)r32 * 1024 + wave * 128 + hi2 * 8; const bf16_t* wlp = wh + 32 * 1024;
#pragma unroll
          for (int sst = 0; sst < 8; ++sst) { const bf16x8 a_h = *(const LAS bf16x8*)(ah + sst * 32), a_l = *(const LAS bf16x8*)(al + sst * 32);
              const bf16x8 b_h = *(const bf16x8*)(wh + sst * 16), b_l = *(const bf16x8*)(wlp + sst * 16);
              acc = __builtin_amdgcn_mfma_f32_32x32x16_bf16(a_h, b_h, acc, 0, 0, 0);
              acc = __builtin_amdgcn_mfma_f32_32x32x16_bf16(a_h, b_l, acc, 0, 0, 0);
              acc = __builtin_amdgcn_mfma_f32_32x32x16_bf16(a_l, b_h, acc, 0, 0, 0); } }
        __syncthreads();
#pragma unroll
        for (int r = 0; r < 16; ++r) { const int row = (r & 3) + 8 * (r >> 2) + 4 * hi2; RED[(wave * 32 + row) * 32 + r32] = acc[r]; }
        __syncthreads();
#pragma unroll 1
        for (int pq = 0; pq < 2; ++pq) { const int tr = 4 * wave + 2 * pq + hi2, r = tb + tr; const int e = r32;
            float lg = rb_[e];
#pragma unroll
            for (int w8 = 0; w8 < 8; ++w8) lg += RED[(w8 * 32 + tr) * 32 + e];
            LAS float* sc_ = SCR + tr * 40;
            sc_[e] = lg;
            asm volatile("s_waitcnt lgkmcnt(0)" ::: "memory");
            int rank = 0;
#pragma unroll
            for (int q8 = 0; q8 < 8; ++q8) { const f32x4 v4 = *(const LAS f32x4*)(sc_ + 4 * q8);
#pragma unroll
                for (int j = 0; j < 4; ++j) rank += (int)((v4[j] > lg) | ((v4[j] == lg) & ((4 * q8 + j) < e))); }
            if (rank < 4) { sc_[32 + rank] = lg; ((LAS int*)sc_)[36 + rank] = e; }
            asm volatile("s_waitcnt lgkmcnt(0)" ::: "memory");
            const f32x4 tvv = *(const LAS f32x4*)(sc_ + 32); const u32x4 tev = *(const LAS u32x4*)(sc_ + 36);
            asm volatile("s_waitcnt lgkmcnt(0)" ::: "memory");
            const float e1 = __expf(tvv[1] - tvv[0]), e2 = __expf(tvv[2] - tvv[0]), e3 = __expf(tvv[3] - tvv[0]); const float inv = 1.0f / (1.0f + e1 + e2 + e3);
            if (r32 < 4 && r < rend) { const int k = r32; const int ek = (int)(k == 0 ? tev[0] : k == 1 ? tev[1] : k == 2 ? tev[2] : tev[3]); const float gk = (k == 0 ? 1.0f : k == 1 ? e1 : k == 2 ? e2 : e3) * inv;
                const unsigned lp = __hip_atomic_fetch_add(lcnt + ek, 1u, __ATOMIC_RELAXED, __HIP_MEMORY_SCOPE_WORKGROUP);
                toke[r * 4 + k] = ek; tokp[r * 4 + k] = (int)lp; tokg[r * 4 + k] = gk; } }
        __syncthreads();
    }
    __syncthreads();
    if (F.tid < 32) { const unsigned c = lcnt[F.tid]; lcnt[32 + F.tid] = c ? __hip_atomic_fetch_add(cnt + F.tid, c, __ATOMIC_RELAXED, __HIP_MEMORY_SCOPE_AGENT) : 0u; }
    __syncthreads();
    for (int i = rbeg * 4 + F.tid; i < rend * 4; i += NTHR) {
        const int ek = __hip_atomic_load(toke + i, __ATOMIC_RELAXED, __HIP_MEMORY_SCOPE_AGENT); const int pos = __hip_atomic_load(tokp + i, __ATOMIC_RELAXED, __HIP_MEMORY_SCOPE_AGENT) + (int)lcnt[32 + ek]; tokp[i] = pos; list[(size_t)ek * T + pos] = i >> 2; }
}
__device__ __forceinline__ int moe_tstart(const Frame& F, int layer, LAS int* tstart) {
    unsigned* cnt = (unsigned*)(F.ws + WS_CTL + CW_CNT) + layer * 64;
    __syncthreads();
    if (F.tid == 0) { int s = 0; for (int e = 0; e < NE; ++e) { const int c = (int)__hip_atomic_load(cnt + e, __ATOMIC_RELAXED, __HIP_MEMORY_SCOPE_AGENT); tstart[e] = s; tstart[40 + e] = c; s += (c + 255) >> 8; } tstart[NE] = s; }
    __syncthreads();
    { LAS int* t2e = (LAS int*)(F.ring + 140000); const int nt = tstart[NE];
      for (int t = F.tid; t < nt; t += NTHR) { int e = 0; for (int j = 1; j < NE; ++j) e += (t >= tstart[j]) ? 1 : 0; t2e[t] = e; } }
    __syncthreads();
    return __builtin_amdgcn_readfirstlane(tstart[NE]);
}
__device__ __forceinline__ void ph_moe1(const Frame& F, int layer) {
    LAS int* tstart = (LAS int*)(F.lds + 64); const int ntile = moe_tstart(F, layer, tstart);
    pg8::MoeOrder<true> S; S.A = (const char*)WSP(bf16_t, WS_H); S.B = (const char*)WSP(bf16_t, WS_WGU); S.sB = (size_t)2048 * 1024 * 2; S.lda = D; S.ldb = D; S.npn = 8; S.nwg = ntile * 8; S.G = F.G; S.c = F.bid;
    S.tstart = tstart; S.cnt = tstart + 40; S.list = WSP(int, WS_LIST); S.t2e = (const LAS int*)(F.ring + 140000);
    pg8::EpiSwiglu E{WSP(bf16_t, WS_ACT), F.in[layer ? I1_BGU : I0_BGU]};
    pg8::gemm_phase<pg8::EpiSwiglu, pg8::MoeOrder<true>>(F.ring, pg8::Gemm{D, D, D}, S, E);
}
__device__ __forceinline__ void ph_moe2(const Frame& F, int layer) {
    LAS int* tstart = (LAS int*)(F.lds + 64); const int ntile = moe_tstart(F, layer, tstart);
    pg8::MoeOrder<false> S; S.A = (const char*)WSP(bf16_t, WS_ACT); S.B = (const char*)WSP(bf16_t, WS_WDN); S.sB = (size_t)1024 * 1024 * 2; S.lda = FF; S.ldb = FF; S.npn = 4; S.nwg = ntile * 4; S.G = F.G; S.c = F.bid;
    S.tstart = tstart; S.cnt = tstart + 40; S.list = nullptr; S.t2e = (const LAS int*)(F.ring + 140000);
    pg8::EpiDown E{WSP(bf16_t, RM_YB), F.in[layer ? I1_BDN : I0_BDN]};
    pg8::gemm_phase<pg8::EpiDown, pg8::MoeOrder<false>>(F.ring, pg8::Gemm{FF, FF, FF}, S, E);
}
__device__ __forceinline__ void moe_combine_row(const Frame& F, int layer, int r, const LAS int* tstart, float (&v)[16]) {
    const int* toke = WSP(int, WS_TOKE); const int* tokp = WSP(int, WS_TOKP); const float* tokg = WSP(float, WS_TOKG); const bf16_t* YB = WSP(bf16_t, RM_YB);
    const float* g2 = WSP(float, WS_MODV) + (size_t)(layer * 9 + modrow(r)) * 6144 + 5120;
    float y[16];
#pragma unroll
    for (int i = 0; i < 16; ++i) y[i] = 0.f;
#pragma unroll
    for (int k = 0; k < 4; ++k) { const int e = toke[r * 4 + k]; const size_t prow = (size_t)tstart[e] * 256 + tokp[r * 4 + k]; const float gk = tokg[r * 4 + k]; float yy[16]; ld16b(YB + prow * D, F.lane, yy);
#pragma unroll
        for (int i = 0; i < 16; ++i) y[i] = fmaf(gk, yy[i], y[i]); }
    float gg[16]; ld16f(g2, F.lane, gg); ld16f(xrow_res(F, r), F.lane, v);
#pragma unroll
    for (int i = 0; i < 16; ++i) v[i] = fmaf(gg[i], y[i], v[i]);
}
__device__ __forceinline__ void ph_combine_mod1(const Frame& F) {
    LAS int* tstart = (LAS int*)(F.lds + 64); moe_tstart(F, 0, tstart);
    LAS float* wl = (LAS float*)F.ring;
    load_w32(F, wl, F.in[I1_WIN] + 3072, 3104);
    __syncthreads();
    const float* g = F.in[I1_N1G]; bf16_t* H = WSP(bf16_t, WS_H); float* GD = WSP(float, WS_GD);
    const float* modv = WSP(float, WS_MODV) + (size_t)9 * 6144;
    for (int r = F.bid * NWAVE + F.wave; r < T; r += F.G * NWAVE) {
        float v[16]; moe_combine_row(F, 0, r, tstart, v);
        const float* mv = modv + (size_t)modrow(r) * 6144;
        st16f(xrow_res(F, r), F.lane, v);
        modulate16(v, g, mv + 1024, mv, F.lane);
        st16b(H + (size_t)r * D, F.lane, v);
        const float gd = row_gemv32(v, wl, F.lane);
        if ((F.lane & 1) == 0) GD[(size_t)r * 32 + (F.lane >> 1)] = gd;
    }
    __syncthreads();
    cvt_moe_weights(F, (LAS float*)F.ring, F.in[I1_WGU], F.in[I1_WDN]);
}
__device__ __forceinline__ void ph_final(const Frame& F) {
    LAS int* tstart = (LAS int*)(F.lds + 64); moe_tstart(F, 1, tstart);
    const float* g = F.in[I_FNG];
    for (int r = TC + F.bid * NWAVE + F.wave; r < T; r += F.G * NWAVE) {
        float v[16]; moe_combine_row(F, 1, r, tstart, v); float ss = 0.f;
#pragma unroll
        for (int i = 0; i < 16; ++i) ss = fmaf(v[i], v[i], ss);
        const float rs = rsqrtf(wsum(ss) * (1.0f / D) + EPS); float gg[16]; ld16f(g, F.lane, gg);
#pragma unroll
        for (int i = 0; i < 16; ++i) v[i] = v[i] * rs * gg[i];
        st16f(F.out + (size_t)(r - TC) * D, F.lane, v);
    }
}

namespace gla3 {
using att::f32x16; using att::s16x4; using att::crow; using att::v_st; using att::v_rd_base; using att::v_rd_off; using att::tr_read;
constexpr int ROWB = 272;
constexpr int P_GD = 0, P_TOT = 4096, P_WG = 8192;
constexpr int O_QD = 0, O_KD = 17408, O_KS = 34816, O_VV = 51200, O_ST = 67584, O_DEC = 102400;
constexpr size_t TILE_B = 64 * 128 * 2, ITEM_B = 2 * TILE_B;
#define GPK(L, H) (bf16x8){L[0], L[1], L[2], L[3], H[0], H[1], H[2], H[3]}
#define CH_ROW0(b, dir, cc) ((cc) < 4 ? ((b) * 256 + ((dir) ? 3 - (cc) : (cc)) * 64) : (TC + (b) * 4096 + ((dir) ? 67 - (cc) : (cc) - 4) * 64))
#define TOK(dir, jj) ((dir) ? 63 - (jj) : (jj))
__device__ __forceinline__ void pre_phase(const Frame& F) {
  LAS char* lds = (LAS char*)F.ring;
  int tid = threadIdx.x; asm volatile("" : "+v"(tid));
  const int wid = __builtin_amdgcn_readfirstlane(tid >> 6), lane = tid & 63;
  LAS float* gds = (LAS float*)(lds + P_GD); LAS float* tot = (LAS float*)(lds + P_TOT); LAS float* wgall = (LAS float*)(lds + P_WG);
  const bf16_t* U1 = WSP(bf16_t, R1_U1); const float* GD = WSP(float, WS_GD);
  char* tiles = (char*)(F.ws + WS_ACT); float* decbuf = (float*)(F.ws + WS_ACT + (size_t)4352 * ITEM_B);
  for (int i = tid; i < 8 * 17 * 128; i += NTHR) { const int tb = i / (17 * 128), rem = i % (17 * 128), r = rem >> 7, d = rem & 127, hd = tb >> 1, dir = tb & 1;
    const float* Wg = dir ? F.in[I1_WGKB] : F.in[I1_WGKF]; const float* Bg = dir ? F.in[I1_BGKB] : F.in[I1_BGKF]; wgall[i] = (r < 16) ? Wg[r * 512 + hd * 128 + d] : Bg[hd * 128 + d]; }
  const int d0 = 2 * lane, tg = wid, gj = tid >> 3, gr = (tid & 7) * 2;
  unsigned qreg[8], kreg[8]; f32x2 gdreg;
#define PLOAD(u) do { const int _cc = (u) % 68, _s = (u) / 68, _dir = _s & 1, _hd = (_s >> 1) & 3, _b = _s >> 3; const int _r0 = CH_ROW0(_b, _dir, _cc); \
    const bf16_t* _uq = U1 + _hd * 128 + d0; \
    _Pragma("unroll") for (int i = 0; i < 8; ++i) { const bf16_t* _p = _uq + (size_t)(_r0 + TOK(_dir, 8 * tg + i)) * U1W; qreg[i] = *(const unsigned*)_p; kreg[i] = *(const unsigned*)(_p + 512); } \
    gdreg = *(const f32x2*)(GD + (size_t)(_r0 + TOK(_dir, gj)) * 32 + _dir * 16 + gr); } while (0)
  int u = F.bid;
  if (u < 4352) PLOAD(u);
  __syncthreads();
  for (; u < 4352; u += F.G) {
    const int sc = u / 68, dir = sc & 1, hd = (sc >> 1) & 3;
    const LAS float* wg = wgall + (hd * 2 + dir) * 17 * 128;
    *(LAS f32x2*)(gds + gj * 16 + gr) = gdreg;
    __syncthreads();
    float cl0[8], cl1[8];
    { float z0[8], z1[8]; const f32x2 bb = *(const LAS f32x2*)(wg + 16 * 128 + d0);
#pragma unroll
      for (int i = 0; i < 8; ++i) { z0[i] = bb[0]; z1[i] = bb[1]; }
#pragma unroll
      for (int r4 = 0; r4 < 4; ++r4) { f32x2 w[4];
#pragma unroll
        for (int q = 0; q < 4; ++q) w[q] = *(const LAS f32x2*)(wg + (4 * r4 + q) * 128 + d0);
#pragma unroll
        for (int i = 0; i < 8; ++i) { const f32x4 g4 = *(const LAS f32x4*)(gds + (8 * tg + i) * 16 + 4 * r4);
#pragma unroll
          for (int q = 0; q < 4; ++q) { z0[i] = fmaf(g4[q], w[q][0], z0[i]); z1[i] = fmaf(g4[q], w[q][1], z1[i]); } } }
      float a0 = 0.f, a1 = 0.f;
#pragma unroll
      for (int i = 0; i < 8; ++i) { const float l0 = fminf(z0[i], 0.f) - __logf(1.0f + __expf(-fabsf(z0[i]))), l1 = fminf(z1[i], 0.f) - __logf(1.0f + __expf(-fabsf(z1[i])));
        a0 += l0 * (1.0f / 16.0f); a1 += l1 * (1.0f / 16.0f); cl0[i] = a0; cl1[i] = a1; }
      *(LAS f32x2*)(tot + tg * 128 + d0) = (f32x2){a0, a1}; }
    __syncthreads();
    { float off0 = 0.f, off1 = 0.f, last0 = 0.f, last1 = 0.f;
#pragma unroll
      for (int g = 0; g < 8; ++g) { const f32x2 tv = *(const LAS f32x2*)(tot + g * 128 + d0); if (g < tg) { off0 += tv[0]; off1 += tv[1]; } last0 += tv[0]; last1 += tv[1]; }
      const float el0 = __expf(last0), el1 = __expf(last1);
      if (tg == 0) *(f32x2*)(decbuf + (size_t)u * 128 + d0) = (f32x2){el0, el1};
      char* it = tiles + (size_t)u * ITEM_B + d0 * 2;
#pragma unroll
      for (int i = 0; i < 8; ++i) { const int jj = 8 * tg + i; const float e0 = __expf(off0 + cl0[i]), e1 = __expf(off1 + cl1[i]); const float r0 = __builtin_amdgcn_rcpf(e0), r1 = __builtin_amdgcn_rcpf(e1);
        const float q0 = __uint_as_float(qreg[i] << 16), q1 = __uint_as_float(qreg[i] & 0xffff0000u), k0 = __uint_as_float(kreg[i] << 16), k1 = __uint_as_float(kreg[i] & 0xffff0000u);
        *(unsigned*)(it + jj * 256) = cvt_pk_bf16(q0 * e0, q1 * e1);
        *(unsigned*)(it + TILE_B + jj * 256) = cvt_pk_bf16(k0 * r0, k1 * r1); } }
    if (u + F.G < 4352) PLOAD(u + F.G);
    __syncthreads();
  }
#undef PLOAD
}
constexpr int SB_QD = 0, SB_KD = 16384, SB_VV = 32768, SB_DEC = 40960, SB_BYTES = 41984, O_ST2 = 3 * SB_BYTES;
constexpr int vc_off(int d0, int ks, int half) { return d0 * 512 + ks * 2048 + half * 1024; }
struct SeqCtx { LAS char* lds; const char* tiles; const char* decb; const bf16_t* Uv; bf16_t* OUT; unsigned sQ[2], sK[2], ldsw; int vk, b, dir, hd, dvs, wid, lane, r32, hi, trb, xq, eb, db, kdo; };
#define DMA16(gptr, ldsoff) __builtin_amdgcn_global_load_lds((const unsigned*)(gptr), (LAS unsigned*)(C.lds + (ldsoff)), 16, 0, 0)
__device__ __forceinline__ void seq_issue(const SeqCtx& C, int cc) {
    const int bo = (cc % 3) * SB_BYTES; const char* t = C.tiles + (size_t)cc * ITEM_B;
    DMA16(t + C.sQ[0], bo + SB_QD + C.ldsw); DMA16(t + C.sQ[1], bo + SB_QD + 8192 + C.ldsw);
    DMA16(t + TILE_B + C.sK[0], bo + SB_KD + C.ldsw); DMA16(t + TILE_B + C.sK[1], bo + SB_KD + 8192 + C.ldsw);
    DMA16(C.Uv + (size_t)(CH_ROW0(C.b, C.dir, cc) + TOK(C.dir, C.vk)) * U1W, bo + SB_VV + C.ldsw);
    if (C.wid == 7) DMA16(C.decb + (size_t)cc * 512 + C.lane * 16, bo + SB_DEC);
}
#undef DMA16
template <int IB> __device__ __forceinline__ void seq_out_loop(const SeqCtx& C) {
  const int r32 = C.r32, hi = C.hi, xq = C.xq;
  for (int cc = 0; cc < 68; ++cc) {
    if (cc >= 6 && cc < 67) asm volatile("s_waitcnt vmcnt(37)" ::: "memory"); else if (cc >= 1 && cc < 67) asm volatile("s_waitcnt vmcnt(5)" ::: "memory"); else asm volatile("s_waitcnt vmcnt(0)" ::: "memory");
    asm volatile("s_waitcnt lgkmcnt(0)" ::: "memory");
    __builtin_amdgcn_s_barrier();
    asm volatile("" ::: "memory");
    if (cc + 2 < 68) seq_issue(C, cc + 2);
    if (cc < 4) continue;
    const LAS char* sb = C.lds + (cc % 3) * SB_BYTES;
    const LAS char* STp = C.lds + O_ST2 + ((cc + 1) & 1) * 17408;
    f32x16 p0 = {}, p1 = {}, o = {};
    const LAS char* QDr = sb + SB_QD + (32 * IB + r32) * 256; const LAS char* KDr = sb + SB_KD + C.kdo;
#pragma unroll
    for (int k = 0; k < 8; ++k) { const int po = (k << 5) ^ xq; const bf16x8 qf = *(const LAS bf16x8*)(QDr + po); const bf16x8 k0f = *(const LAS bf16x8*)(KDr + (k >> 1) * 512 + (k & 1) * 32);
      p0 = __builtin_amdgcn_mfma_f32_32x32x16_bf16(k0f, qf, p0, 0, 0, 0);
      if (IB) { const bf16x8 k1f = *(const LAS bf16x8*)(KDr + 8192 + (k >> 1) * 512 + (k & 1) * 32); p1 = __builtin_amdgcn_mfma_f32_32x32x16_bf16(k1f, qf, p1, 0, 0, 0); } }
#pragma unroll
    for (int r = 0; r < 16; ++r) { const bool kill = crow(r, hi) > r32; if (IB == 0) p0[r] = kill ? 0.f : p0[r]; else p1[r] = kill ? 0.f : p1[r]; }
    bf16x8 pa0, pa1, pa2, pa3;
#define PK4(P, BASE, OUT_) do { unsigned a0 = cvt_pk_bf16(P[BASE + 0], P[BASE + 1]), a1 = cvt_pk_bf16(P[BASE + 2], P[BASE + 3]);   \
    unsigned b0 = cvt_pk_bf16(P[BASE + 4], P[BASE + 5]), b1 = cvt_pk_bf16(P[BASE + 6], P[BASE + 7]);                              \
    auto r0 = __builtin_amdgcn_permlane32_swap(a0, b0, false, false); auto r1 = __builtin_amdgcn_permlane32_swap(a1, b1, false, false); \
    u32x4 w = {r0[0], r1[0], r0[1], r1[1]}; OUT_ = *reinterpret_cast<bf16x8*>(&w); } while (0)
    PK4(p0, 0, pa0); PK4(p0, 8, pa1); if (IB) { PK4(p1, 0, pa2); PK4(p1, 8, pa3); }
#undef PK4
    { const int vb = (int)(uintptr_t)(sb + SB_VV) + C.trb + C.eb * 512;
      const s16x4 l0 = tr_read<vc_off(0, 0, 0)>(vb), h0 = tr_read<vc_off(0, 0, 1)>(vb), l1 = tr_read<vc_off(0, 1, 0)>(vb), h1 = tr_read<vc_off(0, 1, 1)>(vb);
      s16x4 l2, h2, l3, h3;
      if (IB) { l2 = tr_read<vc_off(0, 2, 0)>(vb); h2 = tr_read<vc_off(0, 2, 1)>(vb); l3 = tr_read<vc_off(0, 3, 0)>(vb); h3 = tr_read<vc_off(0, 3, 1)>(vb); }
      asm volatile("s_waitcnt lgkmcnt(0)" ::: "memory"); __builtin_amdgcn_sched_barrier(0);
      o = __builtin_amdgcn_mfma_f32_32x32x16_bf16(pa0, GPK(l0, h0), o, 0, 0, 0);
      o = __builtin_amdgcn_mfma_f32_32x32x16_bf16(pa1, GPK(l1, h1), o, 0, 0, 0);
      if (IB) { o = __builtin_amdgcn_mfma_f32_32x32x16_bf16(pa2, GPK(l2, h2), o, 0, 0, 0);
                o = __builtin_amdgcn_mfma_f32_32x32x16_bf16(pa3, GPK(l3, h3), o, 0, 0, 0); } }
    { const LAS char* STr = STp + (32 * C.eb + r32) * ROWB + hi * 16;
#pragma unroll
      for (int k = 0; k < 8; ++k) { const bf16x8 qf = *(const LAS bf16x8*)(QDr + ((k << 5) ^ xq)); const bf16x8 sf = *(const LAS bf16x8*)(STr + k * 32);
        o = __builtin_amdgcn_mfma_f32_32x32x16_bf16(qf, sf, o, 0, 0, 0); } }
    bf16_t* op = C.OUT + (size_t)(CH_ROW0(C.b, C.dir, cc) - TC) * D + C.hd * 256 + C.dvs * 64 + 32 * C.eb + r32;
#pragma unroll
    for (int r = 0; r < 16; ++r) { const int i = 32 * IB + crow(r, hi); op[(size_t)TOK(C.dir, i) * D] = f2bf(o[r]); }
  }
}
__device__ __forceinline__ void seq_state_loop(const SeqCtx& C) {
  const int r32 = C.r32, hi = C.hi, db = C.db;
  f32x16 S0 = {}, S1 = {};
  for (int cc = 0; cc < 68; ++cc) {
    if (cc >= 1 && cc < 67) { if (C.wid == 7) asm volatile("s_waitcnt vmcnt(6)" ::: "memory"); else asm volatile("s_waitcnt vmcnt(5)" ::: "memory"); } else asm volatile("s_waitcnt vmcnt(0)" ::: "memory");
    asm volatile("s_waitcnt lgkmcnt(0)" ::: "memory");
    __builtin_amdgcn_s_barrier();
    asm volatile("" ::: "memory");
    if (cc + 2 < 68) seq_issue(C, cc + 2);
    const LAS char* sb = C.lds + (cc % 3) * SB_BYTES;
    LAS char* STn = C.lds + O_ST2 + (cc & 1) * 17408;
    const int kb = (int)(uintptr_t)(sb + SB_KD) + C.trb + db * 512, vb = (int)(uintptr_t)(sb + SB_VV) + C.trb;
    { const s16x4 al0 = tr_read<v_rd_off(0, 0, 0)>(kb), ah0 = tr_read<v_rd_off(0, 0, 1)>(kb), al1 = tr_read<v_rd_off(0, 1, 0)>(kb), ah1 = tr_read<v_rd_off(0, 1, 1)>(kb);
      const s16x4 al2 = tr_read<v_rd_off(0, 2, 0)>(kb), ah2 = tr_read<v_rd_off(0, 2, 1)>(kb), al3 = tr_read<v_rd_off(0, 3, 0)>(kb), ah3 = tr_read<v_rd_off(0, 3, 1)>(kb);
      const s16x4 bl0 = tr_read<vc_off(0, 0, 0)>(vb), bh0 = tr_read<vc_off(0, 0, 1)>(vb), bl1 = tr_read<vc_off(0, 1, 0)>(vb), bh1 = tr_read<vc_off(0, 1, 1)>(vb);
      const s16x4 bl2 = tr_read<vc_off(0, 2, 0)>(vb), bh2 = tr_read<vc_off(0, 2, 1)>(vb), bl3 = tr_read<vc_off(0, 3, 0)>(vb), bh3 = tr_read<vc_off(0, 3, 1)>(vb);
      const s16x4 cl0_ = tr_read<vc_off(1, 0, 0)>(vb), ch0 = tr_read<vc_off(1, 0, 1)>(vb), cl1_ = tr_read<vc_off(1, 1, 0)>(vb), ch1 = tr_read<vc_off(1, 1, 1)>(vb);
      const s16x4 cl2 = tr_read<vc_off(1, 2, 0)>(vb), ch2 = tr_read<vc_off(1, 2, 1)>(vb), cl3 = tr_read<vc_off(1, 3, 0)>(vb), ch3 = tr_read<vc_off(1, 3, 1)>(vb);
      asm volatile("s_waitcnt lgkmcnt(0)" ::: "memory"); __builtin_amdgcn_sched_barrier(0);
      S0 = __builtin_amdgcn_mfma_f32_32x32x16_bf16(GPK(al0, ah0), GPK(bl0, bh0), S0, 0, 0, 0); S1 = __builtin_amdgcn_mfma_f32_32x32x16_bf16(GPK(al0, ah0), GPK(cl0_, ch0), S1, 0, 0, 0);
      S0 = __builtin_amdgcn_mfma_f32_32x32x16_bf16(GPK(al1, ah1), GPK(bl1, bh1), S0, 0, 0, 0); S1 = __builtin_amdgcn_mfma_f32_32x32x16_bf16(GPK(al1, ah1), GPK(cl1_, ch1), S1, 0, 0, 0);
      S0 = __builtin_amdgcn_mfma_f32_32x32x16_bf16(GPK(al2, ah2), GPK(bl2, bh2), S0, 0, 0, 0); S1 = __builtin_amdgcn_mfma_f32_32x32x16_bf16(GPK(al2, ah2), GPK(cl2, ch2), S1, 0, 0, 0);
      S0 = __builtin_amdgcn_mfma_f32_32x32x16_bf16(GPK(al3, ah3), GPK(bl3, bh3), S0, 0, 0, 0); S1 = __builtin_amdgcn_mfma_f32_32x32x16_bf16(GPK(al3, ah3), GPK(cl3, ch3), S1, 0, 0, 0); }
#pragma unroll
    for (int g = 0; g < 4; ++g) { const f32x4 dc = *(const LAS f32x4*)(sb + SB_DEC + (32 * db + 8 * g + 4 * hi) * 4);
                                  S0[4 * g] *= dc[0]; S0[4 * g + 1] *= dc[1]; S0[4 * g + 2] *= dc[2]; S0[4 * g + 3] *= dc[3];
                                  S1[4 * g] *= dc[0]; S1[4 * g + 1] *= dc[1]; S1[4 * g + 2] *= dc[2]; S1[4 * g + 3] *= dc[3]; }
#pragma unroll
    for (int g = 0; g < 4; ++g) { u32x2 w0, w1; w0.x = cvt_pk_bf16(S0[4 * g], S0[4 * g + 1]); w0.y = cvt_pk_bf16(S0[4 * g + 2], S0[4 * g + 3]); w1.x = cvt_pk_bf16(S1[4 * g], S1[4 * g + 1]); w1.y = cvt_pk_bf16(S1[4 * g + 2], S1[4 * g + 3]);
      *(LAS u32x2*)(STn + r32 * ROWB + (32 * db + 8 * g + 4 * hi) * 2) = w0; *(LAS u32x2*)(STn + (32 + r32) * ROWB + (32 * db + 8 * g + 4 * hi) * 2) = w1; }
  }
}
__device__ __forceinline__ void seq_unit(const Frame& F, int b, int hd, int dir, int dvs, LAS char* lds) {
  int tid = threadIdx.x; asm volatile("" : "+v"(tid));
  SeqCtx C; C.lds = lds; C.wid = __builtin_amdgcn_readfirstlane(tid >> 6); C.lane = tid & 63; C.r32 = C.lane & 31; C.hi = C.lane >> 5; C.b = b; C.dir = dir; C.hd = hd; C.dvs = dvs;
  const int sc = (b * 4 + hd) * 2 + dir;
  C.OUT = WSP(bf16_t, dir ? R1_OB : R1_OF);
  C.tiles = (const char*)(F.ws + WS_ACT) + (size_t)sc * 68 * ITEM_B; C.decb = (const char*)(F.ws + WS_ACT + (size_t)4352 * ITEM_B) + (size_t)sc * 68 * 512;
  for (int i = tid; i < 2 * 17408 / 4; i += NTHR) ((LAS unsigned*)(lds + O_ST2))[i] = 0u;
  int vcol;
#pragma unroll
  for (int rd = 0; rd < 2; ++rd) { const int o = rd * 8192 + C.wid * 1024 + C.lane * 16;
    { const int row = o >> 8, slot = (o >> 4) & 15; C.sQ[rd] = (unsigned)(row * 256 + ((slot ^ (row & 15)) << 4)); }
    { const int sub = o >> 9, kkhi = sub >> 2, cblk = sub & 3, w = (o & 511) >> 1, kklo = w >> 5, cin = w & 31; const int kk = kkhi * 8 + kklo; const int k = (kk & ~0xC) | ((kk & 4) << 1) | ((kk & 8) >> 1);
      C.sK[rd] = (unsigned)(k * 256 + (cblk * 32 + cin) * 2); } }
  { const int o = C.wid * 1024 + C.lane * 16; const int sub = o >> 9, kkhi = sub >> 1, cblk = sub & 1, w = (o & 511) >> 1, kklo = w >> 5, cin = w & 31; const int kk = kkhi * 8 + kklo;
    C.vk = (kk & ~0xC) | ((kk & 4) << 1) | ((kk & 8) >> 1); vcol = cblk * 32 + cin; }
  C.Uv = WSP(bf16_t, R1_U1) + 1024 + hd * 256 + dvs * 64 + vcol;
  C.ldsw = (unsigned)C.wid * 1024u;
  C.eb = C.wid & 1; C.db = C.wid & 3; C.trb = v_rd_base(C.lane); C.xq = ((C.r32 & 15) ^ C.hi) << 4;
  { const int j = C.r32, kk = (j & ~0xC) | ((j & 4) << 1) | ((j & 8) >> 1); C.kdo = (kk >> 3) * 2048 + (kk & 7) * 64 + C.hi * 16; }
  seq_issue(C, 0); seq_issue(C, 1);
  if (C.wid < 4) { if (C.wid & 2) seq_out_loop<1>(C); else seq_out_loop<0>(C); }
  else seq_state_loop(C);
  asm volatile("s_waitcnt vmcnt(0) lgkmcnt(0)" ::: "memory");
  __builtin_amdgcn_s_barrier();
}
__device__ __forceinline__ void seq_phase(const Frame& F) {
  for (int un = F.bid; un < 256; un += F.G) {
    const int dvs = un & 3, sc = un >> 2, dir = sc & 1, hd = (sc >> 1) & 3, b = sc >> 3;
    __syncthreads();
    seq_unit(F, b, hd, dir, dvs, (LAS char*)F.ring);
  }
}
#undef GPK
#undef CH_ROW0
#undef TOK
}

__device__ __forceinline__ void ph_gla_out(const Frame& F) {
    const bf16_t* OF = WSP(bf16_t, R1_OF); const bf16_t* OB = WSP(bf16_t, R1_OB); const bf16_t* U1 = WSP(bf16_t, R1_U1); bf16_t* MIX = WSP(bf16_t, R1_MIX); const float* gn = F.in[I1_GNG];
    for (int rl = F.bid * NWAVE + F.wave; rl < TL; rl += F.G * NWAVE) {
        float o[16], ob[16], go[16]; ld16b(OF + (size_t)rl * D, F.lane, o); ld16b(OB + (size_t)rl * D, F.lane, ob); ld16b(U1 + (size_t)(TC + rl) * U1W + 2048, F.lane, go);
        float s0 = 0.f, s1 = 0.f;
#pragma unroll
        for (int i = 0; i < 8; ++i) { o[i] += ob[i]; o[8 + i] += ob[8 + i]; s0 = fmaf(o[i], o[i], s0); s1 = fmaf(o[8 + i], o[8 + i], s1); }
        for (int k = 16; k >= 1; k >>= 1) { s0 += __shfl_xor(s0, k); s1 += __shfl_xor(s1, k); }
        const float r0 = rsqrtf(s0 * (1.0f / 256.0f) + EPS), r1 = rsqrtf(s1 * (1.0f / 256.0f) + EPS);
        const float* gp = gn + ((8 * F.lane) & 255);
#pragma unroll
        for (int i = 0; i < 8; ++i) { const float gw = gp[i]; o[i] = o[i] * r0 * gw * silu_fast(go[i]); o[8 + i] = o[8 + i] * r1 * gw * silu_fast(go[8 + i]); }
        st16b(MIX + (size_t)rl * D, F.lane, o);
    }
}

constexpr int NPHASE = 20;
__global__ void __launch_bounds__(NTHR, 2) fwd_kernel(Args args) {
    extern __shared__ __attribute__((aligned(16))) unsigned char lds_raw[];
    Frame F; F.in = args.in; F.out = args.out; F.ws = args.ws; F.lds = (LAS unsigned char*)lds_raw; F.ring = F.lds + RING_OFF;
    F.tid = threadIdx.x; F.lane = F.tid & 63; F.wave = __builtin_amdgcn_readfirstlane(F.tid >> 6); F.G = gridDim.x; F.bid = blockIdx.x;
    if (F.tid < 4) ((LAS unsigned*)F.lds)[F.tid] = 0u;
    __syncthreads();
    const int lo = args.ph_lo, hi = args.ph_hi;
    const bool multi = (hi - lo) > 1;
    XcdBarrier bar; bar.bar = (unsigned*)(F.ws + WS_CTL + CW_BAR); bar.x = 0; bar.st = (volatile LAS unsigned*)F.lds;
    if (multi) bar = xcd_barrier_post((unsigned*)(F.ws + WS_CTL + CW_BAR), (volatile LAS unsigned*)F.lds);
#define IN(k) (lo <= (k) && (k) < hi)
#define SEAM(k) do { if (IN((k) + 1)) xcd_barrier(bar); } while (0)
#define REFRESH() do { int t_ = threadIdx.x; asm volatile("" : "+v"(t_)); F.tid = t_; F.lane = t_ & 63; F.wave = __builtin_amdgcn_readfirstlane(t_ >> 6); } while (0)

    if (IN(0)) { REFRESH(); ph_prologue(F); SEAM(0); }
    if (IN(1)) { REFRESH(); ph_mod0(F); SEAM(1); }
    if (IN(2)) { REFRESH();
        pg8::DualOrder S; S.a.init(WSP(bf16_t, WS_H), WSP(bf16_t, WS_WIN0), D, D, T, U0W, F.G, F.bid); S.b.init(WSP(bf16_t, WS_WF), WSP(bf16_t, WS_H), D, D, 512, T, F.G, F.bid);
        pg8::EpiDual0 E{pg8::EpiBf16{WSP(bf16_t, R0_U0), U0W, U0W}, pg8::EpiFourT{WSP(bf16_t, R0_TT), WSP(bf16_t, R0_TTC)}};
        pg8::gemm_phase<pg8::EpiDual0, pg8::DualOrder>(F.ring, pg8::Gemm{D, D, D}, S, E);
        SEAM(2); }
    if (IN(3)) { REFRESH(); ph_rowstats(F); SEAM(3); }
    if (IN(4)) { REFRESH();
        { pg8::DenseOrder S; S.init(WSP(bf16_t, R0_U0), WSP(bf16_t, WS_WQ), U0W, QL, T, QWP, F.G, F.bid);
          pg8::EpiRS E{WSP(bf16_t, R0_Q), WSP(float, WS_RS), QW, QW}; pg8::gemm_phase<pg8::EpiRS, pg8::DenseOrder>(F.ring, pg8::Gemm{QL, U0W, QL}, S, E); }
        { pg8::DenseOrder S; S.init(WSP(bf16_t, R0_U0) + QL, WSP(bf16_t, WS_WKV), U0W, KVL, T, KVW, F.G, F.bid);
          pg8::EpiRS E{WSP(bf16_t, R0_KV), WSP(float, WS_RS) + T, KVW, KVW}; pg8::gemm_phase<pg8::EpiRS, pg8::DenseOrder>(F.ring, pg8::Gemm{KVL, U0W, KVL}, S, E); }
        SEAM(4); }
    if (IN(5)) { REFRESH();
        ph_queue5(F); SEAM(5); }
    if (IN(6)) { REFRESH();
        pg8::DenseOrder S; S.init(WSP(bf16_t, R0_MIX), WSP(bf16_t, WS_WOUT0), D, D, T, D, F.G, F.bid);
        pg8::EpiGateBf16 E{WSP(bf16_t, R0_U0), WSP(float, WS_MODV), 2048, 0, 0};
        pg8::gemm_phase<pg8::EpiGateBf16, pg8::DenseOrder>(F.ring, pg8::Gemm{D, D, D}, S, E); SEAM(6); }
    if (IN(7)) { REFRESH(); ph_router(F, 0, 0); SEAM(7); }
    if (IN(8)) { REFRESH(); ph_moe1(F, 0); SEAM(8); }
    if (IN(9)) { REFRESH(); ph_moe2(F, 0); SEAM(9); }
    if (IN(10)) { REFRESH(); ph_combine_mod1(F); SEAM(10); }
    if (IN(11)) { REFRESH();
        pg8::DenseOrder S; S.init(WSP(bf16_t, WS_H), WSP(bf16_t, WS_WIN1), D, D, T, U1W, F.G, F.bid);
        pg8::EpiBf16 E{WSP(bf16_t, R1_U1), U1W, U1W}; pg8::gemm_phase<pg8::EpiBf16, pg8::DenseOrder>(F.ring, pg8::Gemm{D, D, D}, S, E); SEAM(11); }
    if (IN(12)) { REFRESH(); gla3::pre_phase(F); SEAM(12); }
    if (IN(13)) { REFRESH(); gla3::seq_phase(F); SEAM(13); }
    if (IN(14)) { REFRESH(); ph_gla_out(F); SEAM(14); }
    if (IN(15)) { REFRESH();
        pg8::DenseOrder S; S.init(WSP(bf16_t, R1_MIX), WSP(bf16_t, WS_WOUT1), D, D, TL, D, F.G, F.bid);
        pg8::EpiGateBf16 E{WSP(bf16_t, R1_OF), WSP(float, WS_MODV) + 9 * 6144, 2048, TC, TC};
        pg8::gemm_phase<pg8::EpiGateBf16, pg8::DenseOrder>(F.ring, pg8::Gemm{D, D, D}, S, E); SEAM(15); }
    if (IN(16)) { REFRESH(); ph_router(F, 1, TC); SEAM(16); }
    if (IN(17)) { REFRESH(); ph_moe1(F, 1); SEAM(17); }
    if (IN(18)) { REFRESH(); ph_moe2(F, 1); SEAM(18); }
    if (IN(19)) { REFRESH(); ph_final(F); }
#undef IN
#undef SEAM
}

#ifndef ONE_LAUNCH
#define ONE_LAUNCH 1
#endif
extern "C" void kernel_launch(void* const* d_in, const int* in_sizes, int n_in, void* d_out, int out_size, void* d_ws, size_t ws_size, hipStream_t stream) {
    static int grid = 0;
    if (grid == 0) {
        if (n_in != 38 || out_size != TL * D || ws_size < WS_END) { fprintf(stderr, "kernel_launch: unexpected shapes: n_in %d out %d ws %zu (need %zu)\n", n_in, out_size, ws_size, (size_t)WS_END); grid = -1; return; }
        int dev = 0, cus = 0, per_cu = 0;
        if (hipGetDevice(&dev) != hipSuccess || hipDeviceGetAttribute(&cus, hipDeviceAttributeMultiprocessorCount, dev) != hipSuccess) { grid = -1; return; }
        if (hipFuncSetAttribute((const void*)fwd_kernel, hipFuncAttributeMaxDynamicSharedMemorySize, LDS_BYTES) != hipSuccess) { fprintf(stderr, "kernel_launch: hipFuncSetAttribute failed\n"); grid = -1; return; }
        if (hipOccupancyMaxActiveBlocksPerMultiprocessor(&per_cu, (const void*)fwd_kernel, NTHR, LDS_BYTES) != hipSuccess || per_cu < 1) { fprintf(stderr, "kernel_launch: occupancy query says %d\n", per_cu); }
        (void)hipGetLastError();
        grid = cus;
    }
    if (grid < 0) return;
    (void)hipMemsetAsync((char*)d_ws + WS_CTL, 0, CTL_BYTES, stream);
    Args a{};
    for (int i = 0; i < 38; ++i) a.in[i] = (const float*)d_in[i];
    a.out = (float*)d_out; a.ws = (unsigned char*)d_ws;
#if ONE_LAUNCH
    a.ph_lo = 0; a.ph_hi = NPHASE;
    hipLaunchKernelGGL(fwd_kernel, dim3(grid), dim3(NTHR), LDS_BYTES, stream, a);
#else
    for (int p = 0; p < NPHASE; ++p) { a.ph_lo = p; a.ph_hi = p + 1; hipLaunchKernelGGL(fwd_kernel, dim3(grid), dim3(NTHR), LDS_BYTES, stream, a); }
#endif
}
```

```cpp
#include <hip/hip_runtime.h>
#include <stdint.h>
#include <stdio.h>

#define LAS __attribute__((address_space(3)))
typedef unsigned short bf16_t;
typedef short bf16x8 __attribute__((ext_vector_type(8)));
typedef float f32x4 __attribute__((ext_vector_type(4)));
typedef float f32x2 __attribute__((ext_vector_type(2)));
typedef unsigned u32x4 __attribute__((ext_vector_type(4)));
typedef unsigned u32x2 __attribute__((ext_vector_type(2)));

#ifndef NAIVE_ATTN
#define NAIVE_ATTN 0
#endif
#ifndef NAIVE_GLA
#define NAIVE_GLA 0
#endif
constexpr int D = 1024, NB = 8, SEQ = 4096, CTXL = 256;
constexpr int TC = NB * CTXL, TL = NB * SEQ, T = TC + TL;
constexpr int QL = 384, KVL = 256, ROPE = 64, NH = 6, QKD = 192, VD = 128;
constexpr int U0W = 768;
constexpr int QW = NH * QKD  , QWP = 1280, KVW = NH * 256  ;
constexpr int NE = 32, TOPK = 4, FF = 1024;
constexpr int U1W = 3072;
constexpr int NPAD = 147456;
constexpr float EPS = 1e-6f;
constexpr int NTHR = 512, NWAVE = 8;

constexpr size_t al256(size_t x) { return (x + 255) / 256 * 256; }
constexpr size_t XCD_BAR_WORDS_C = 3456;
constexpr size_t CW_BAR = 0;
constexpr size_t CW_Q5 = 15360;
constexpr size_t CW_CNT = 16384;
constexpr size_t CTL_BYTES = 32768;
constexpr size_t WS_CTL = 0;
constexpr size_t WS_MODV = WS_CTL + CTL_BYTES;
constexpr size_t WS_ROPE = WS_MODV + al256(2 * 9 * 6144 * 4);
constexpr size_t WS_RS = WS_ROPE + al256(2 * 64 * 16 * 4);
constexpr size_t WS_XCTX = WS_RS + al256((size_t)2 * T * 4);
constexpr size_t WS_H = WS_XCTX + al256((size_t)TC * D * 4);
constexpr size_t WS_WIN0 = WS_H + al256((size_t)T * D * 2);
constexpr size_t WS_WF = WS_WIN0 + al256((size_t)U0W * D * 2);
constexpr size_t WS_WQ = WS_WF + al256((size_t)512 * D * 2);
constexpr size_t WS_WKV = WS_WQ + al256((size_t)QWP * QL * 2);
constexpr size_t WS_WOUT0 = WS_WKV + al256((size_t)KVW * KVL * 2);
constexpr size_t WS_WIN1 = WS_WOUT0 + al256((size_t)D * D * 2);
constexpr size_t WS_WOUT1 = WS_WIN1 + al256((size_t)U1W * D * 2);
constexpr size_t WS_WGU = WS_WOUT1 + al256((size_t)D * D * 2);
constexpr size_t WS_WDN = WS_WGU + al256((size_t)NE * 2048 * D * 2);
constexpr size_t WS_ACT = WS_WDN + al256((size_t)NE * D * FF * 2);
constexpr size_t WS_LIST = WS_ACT + al256((size_t)NPAD * FF * 2);
constexpr size_t WS_TOKE = WS_LIST + al256((size_t)NE * T * 4);
constexpr size_t WS_TOKP = WS_TOKE + al256((size_t)T * 4 * 4);
constexpr size_t WS_TOKG = WS_TOKP + al256((size_t)T * 4 * 4);
constexpr size_t WS_RWT = WS_TOKG + al256((size_t)T * 4 * 4);
constexpr size_t WS_GD = WS_RWT + al256((size_t)2 * 2 * 32 * 1024 * 2);
constexpr size_t WS_REG = WS_GD + al256((size_t)T * 32 * 4);
constexpr size_t R0_U0 = WS_REG;
constexpr size_t R0_TT = R0_U0 + al256((size_t)T * U0W * 2);
constexpr size_t R0_TTC = R0_TT + al256((size_t)NB * 256 * 8192 * 2);
constexpr size_t R0_Q = R0_TTC + al256((size_t)NB * 256 * 512 * 2);
constexpr size_t R0_KV = R0_Q + al256((size_t)T * QW * 2);
constexpr size_t R0_KR = R0_KV + al256((size_t)T * KVW * 2);
constexpr size_t R0_MIX = R0_KR + al256((size_t)T * ROPE * 2);
constexpr size_t R0_DFT = R0_MIX + al256((size_t)T * D * 2);
constexpr size_t R0_DFTC = R0_DFT + al256((size_t)4096 * 4096 * 2);
constexpr size_t R0_TT2 = R0_DFTC + al256((size_t)256 * 256 * 2);
constexpr size_t R0_TTC2 = R0_TT2 + al256((size_t)NB * 256 * 4096 * 2);
constexpr size_t R0_END = R0_TTC2 + al256((size_t)NB * 256 * 256 * 2);
constexpr size_t R1_U1 = WS_REG;
constexpr size_t R1_OF = R1_U1 + al256((size_t)T * U1W * 2);
constexpr size_t R1_OB = R1_OF + al256((size_t)TL * D * 2);
constexpr size_t R1_MIX = R1_OB + al256((size_t)TL * D * 2);
constexpr size_t R1_END = R1_MIX + al256((size_t)TL * D * 2);
constexpr size_t RM_YB = WS_REG;
constexpr size_t RM_END = RM_YB + al256((size_t)NPAD * D * 2);
constexpr size_t cmax(size_t a, size_t b) { return a > b ? a : b; }
constexpr size_t WS_END = cmax(cmax(R0_END, R1_END), RM_END);

constexpr int LDS_BYTES = 160 * 1024;
constexpr int LDS_MISC = 1024;
constexpr int RING_OFF = LDS_MISC;

__device__ __forceinline__ float bf2f(bf16_t b) { return __uint_as_float(((unsigned)b) << 16); }
__device__ __forceinline__ bf16_t f2bf(float f) { unsigned u = __float_as_uint(f); u += 0x7FFFu + ((u >> 16) & 1u); return (bf16_t)(u >> 16); }
__device__ __forceinline__ unsigned pk2(float lo, float hi) { return (unsigned)f2bf(lo) | ((unsigned)f2bf(hi) << 16); }
typedef __bf16 bf16v2_t __attribute__((ext_vector_type(2)));
__device__ __forceinline__ unsigned cvt_pk_bf16(float lo, float hi) { const f32x2 v = {lo, hi}; bf16v2_t b = __builtin_convertvector(v, bf16v2_t); return *reinterpret_cast<unsigned*>(&b); }
__device__ __forceinline__ float wsum(float v) { for (int o = 32; o >= 1; o >>= 1) v += __shfl_xor(v, o); return v; }
__device__ __forceinline__ float siluf(float x) { return x / (1.0f + __expf(-x)); }
__device__ __forceinline__ float silu_fast(float x) { return x * __builtin_amdgcn_rcpf(1.0f + __builtin_amdgcn_exp2f(x * -1.4426950408889634f)); }

#define XB_TMO      128
#define XB_XCNT(j)  (256  + 64 * (j))
#define XB_XSUB(j)  (1280 + 64 * (j))
#define XB_XGEN(j)  (2304 + 64 * (j))
#define XB_TOP      3328
#define XB_TOPGEN   3392
#define XCD_BAR_WORDS 3456
#define XB_SPIN_CAP (1u << 20)
__device__ __forceinline__ unsigned xb_ld(unsigned* p)              { return __hip_atomic_load(p, __ATOMIC_RELAXED, __HIP_MEMORY_SCOPE_AGENT); }
__device__ __forceinline__ unsigned xb_add(unsigned* p, unsigned v) { return __hip_atomic_fetch_add(p, v, __ATOMIC_RELAXED, __HIP_MEMORY_SCOPE_AGENT); }
__device__ __forceinline__ unsigned xb_xcc_id() { return (unsigned)__builtin_amdgcn_s_getreg((3 << 11) | 20) & 0xFu; }
#define XB_SPIN(cond, bar) do { unsigned _sp = 0; while (cond) { __builtin_amdgcn_s_sleep(1); \
    if ((++_sp & 255u) == 0u) { if (xb_ld(&(bar)[XB_TMO])) break; if (_sp > XB_SPIN_CAP) { atomicAdd(&(bar)[XB_TMO], 1u); break; } } } } while (0)
struct XcdBarrier { unsigned* bar; unsigned x; volatile LAS unsigned* st; };
__device__ __forceinline__ XcdBarrier xcd_barrier_post(unsigned* bar, volatile LAS unsigned* st) {
    XcdBarrier b; b.bar = bar; b.x = xb_xcc_id(); b.st = st;
    if (threadIdx.x == 0) (void)xb_add(&bar[XB_XCNT(b.x)], 1u);
    return b;
}
__device__ __forceinline__ void xcd_barrier_complete(unsigned* bar, unsigned x, unsigned& nloc, unsigned& nx) {
    const unsigned G = gridDim.x * gridDim.y * gridDim.z;
    unsigned sum, cnt, mine, sp = 0u;
    for (;;) {
        sum = 0u; cnt = 0u; mine = 0u;
#pragma unroll
        for (unsigned j = 0; j < 16; ++j) { const unsigned c = xb_ld(&bar[XB_XCNT(j)]); sum += c; cnt += (c > 0u) ? 1u : 0u; mine = (j == x) ? c : mine; }
        if (sum == G) break;
        __builtin_amdgcn_s_sleep(1);
        if ((++sp & 255u) == 0u) { if (xb_ld(&bar[XB_TMO])) break; if (sp > XB_SPIN_CAP) { atomicAdd(&bar[XB_TMO], 1u); break; } }
    }
    nloc = mine > 0u ? mine : 1u; nx = cnt > 0u ? cnt : 1u;
}
__device__ __forceinline__ void xcd_barrier(const XcdBarrier& b) {
    asm volatile("s_waitcnt vmcnt(0)" ::: "memory");
    __syncthreads();
    if (threadIdx.x == 0) {
        unsigned* bar = b.bar;
        __builtin_amdgcn_s_waitcnt(0);
        unsigned nloc = b.st[0], nx = b.st[1];
        if (nloc == 0u) { xcd_barrier_complete(bar, b.x, nloc, nx); b.st[0] = nloc; b.st[1] = nx; }
        const unsigned old = xb_add(&bar[XB_XSUB(b.x)], 1u);
        const unsigned gen = old / nloc;
        if (old + 1u == (gen + 1u) * nloc) {
            __builtin_amdgcn_fence(__ATOMIC_RELEASE, "agent");
            asm volatile("s_waitcnt vmcnt(0)" ::: "memory");
            const unsigned og = xb_add(&bar[XB_TOP], 1u);
            const unsigned tg = og / nx;
            if (og + 1u == (tg + 1u) * nx) xb_add(&bar[XB_TOPGEN], 1u);
            else XB_SPIN(xb_ld(&bar[XB_TOPGEN]) == tg, bar);
            __builtin_amdgcn_fence(__ATOMIC_ACQUIRE, "agent");
            xb_add(&bar[XB_XGEN(b.x)], 1u);
            asm volatile("s_waitcnt vmcnt(0)" ::: "memory");
        } else {
            XB_SPIN(xb_ld(&bar[XB_XGEN(b.x)]) == gen, bar);
            __builtin_amdgcn_fence(__ATOMIC_ACQUIRE, "agent");
            asm volatile("s_waitcnt vmcnt(0)" ::: "memory");
        }
    }
    __syncthreads();
}

namespace pg8 {
constexpr int BM = 256, BK = 64, HALF = 128, HTB = HALF * BK * 2, STAGE_BYTES = 8 * HTB, NXCD = 8, WGM = 8;
__host__ __device__ __forceinline__ int lds_byte(int r, int c) { const int st = (r >> 4) * 2 + (c >> 5), rr = r & 15, cc = c & 31, ob = rr * 64 + cc * 2; return st * 1024 + (ob ^ (((ob >> 9) & 1) << 5)); }
__host__ __device__ __forceinline__ void stage_rc(int b, int& R, int& C) { const int st = b / 1024, sb = b % 1024, swz = sb ^ (((sb >> 9) & 1) << 5); R = (st >> 1) * 16 + swz / 64; C = (st & 1) * 32 + (swz % 64) / 2; }
__host__ __device__ __forceinline__ int perm32(int rho) { const int n = rho >> 4, i = rho & 15; return 8 * (i >> 2) + 4 * n + (i & 3); }

struct Unit { int pm, pn, e, cnt; const char* A; const char* B; };
struct Gemm { int K, lda, ldb; };

struct DenseOrder {
    const char* A; const char* B; int lda, ldb; int nM, nN, nwg, G, c;
    static constexpr bool GATHER = false;
    __device__ void init(const void* A_, const void* B_, int lda_, int ldb_, int M, int N, int G_, int c_) { A = (const char*)A_; B = (const char*)B_; lda = lda_; ldb = ldb_; nM = M / BM; nN = N / BM; nwg = nM * nN; G = G_; c = c_; }
    __device__ bool next(int i, Unit& u) const {
        const long L = (long)i * G + c; if (L >= nwg) return false;
        int wgid = (int)L; { const int q = nwg / NXCD, r = nwg % NXCD, xcd = wgid % NXCD, off = wgid / NXCD; wgid = (xcd < r ? xcd * (q + 1) : r * (q + 1) + (xcd - r) * q) + off; }
        const int nig = WGM * nN, gid = wgid / nig, fm = gid * WGM, gsz = (nM - fm) < WGM ? (nM - fm) : WGM;
        u.pm = fm + ((wgid % nig) % gsz); u.pn = (wgid % nig) / gsz; u.e = 0; u.cnt = 0;
        u.A = A + (size_t)u.pm * BM * lda * 2; u.B = B + (size_t)u.pn * BM * ldb * 2; return true;
    }
    __device__ __forceinline__ void aoff(const Unit&, const int (&R)[2], const int (&C)[2], unsigned (&off)[2][2]) const {
#pragma unroll
        for (int h = 0; h < 2; ++h)
#pragma unroll
            for (int i = 0; i < 2; ++i) off[h][i] = (unsigned)((h * HALF + R[i]) * lda + C[i]) * 2u;
    }
};
struct BatchOrder {
    const char* A; const char* B; size_t sA, sB; int lda, ldb; int nM, nN, per, nwg, G, c;
    static constexpr bool GATHER = false;
    __device__ void init(const void* A_, const void* B_, size_t sA_, size_t sB_, int lda_, int ldb_, int nb, int M, int N, int G_, int c_) { A = (const char*)A_; B = (const char*)B_; sA = sA_; sB = sB_; lda = lda_; ldb = ldb_; nM = M / BM; nN = N / BM; per = nM * nN; nwg = per * nb; G = G_; c = c_; }
    __device__ bool next(int i, Unit& u) const {
        const long L = (long)i * G + c; if (L >= nwg) return false;
        const int b = (int)L / per, r = (int)L % per; u.pm = r / nN; u.pn = r % nN; u.e = b; u.cnt = 0;
        u.A = A + (size_t)b * sA + (size_t)u.pm * BM * lda * 2; u.B = B + (size_t)b * sB + (size_t)u.pn * BM * ldb * 2; return true;
    }
    __device__ __forceinline__ void aoff(const Unit&, const int (&R)[2], const int (&C)[2], unsigned (&off)[2][2]) const {
#pragma unroll
        for (int h = 0; h < 2; ++h)
#pragma unroll
            for (int i = 0; i < 2; ++i) off[h][i] = (unsigned)((h * HALF + R[i]) * lda + C[i]) * 2u;
    }
};
struct DualOrder {
    DenseOrder a, b;
    static constexpr bool GATHER = false;
    __device__ __forceinline__ void aoff_issue(const Unit&, const int (&)[2], unsigned (&)[2][2]) const {}
    __device__ __forceinline__ void aoff_finish(const int (&)[2], unsigned (&)[2][2], unsigned (&)[2][2]) const {}
    __device__ bool next(int i, Unit& u) const {
        const long L = (long)i * a.G + a.c;
        if (L < a.nwg) { return a.next(i, u); }
        const long Lb = L - a.nwg; if (Lb >= b.nwg) return false;
        DenseOrder t = b; t.c = (int)(Lb % b.G); const bool ok = t.next((int)(Lb / b.G), u); u.e = 1; return ok;
    }
    __device__ __forceinline__ void aoff(const Unit& u, const int (&R)[2], const int (&C)[2], unsigned (&off)[2][2]) const { a.aoff(u, R, C, off); }
};
struct OneUnit {
    Unit u0; int lda;
    static constexpr bool GATHER = false;
    __device__ bool next(int i, Unit& u) const { if (i != 0) return false; u = u0; return true; }
    __device__ __forceinline__ void aoff(const Unit&, const int (&R)[2], const int (&C)[2], unsigned (&off)[2][2]) const {
#pragma unroll
        for (int h = 0; h < 2; ++h)
#pragma unroll
            for (int i = 0; i < 2; ++i) off[h][i] = (unsigned)((h * HALF + R[i]) * lda + C[i]) * 2u;
    }
};
template <bool GATHER_> struct MoeOrder {
    const char* A; const char* B; size_t sB; int lda, ldb; int npn, nwg, G, c;
    const LAS int* tstart; const LAS int* cnt; const int* list;
    const LAS int* t2e;
    __device__ __forceinline__ int ts(int j) const { return __builtin_amdgcn_readfirstlane(tstart[j]); }
    static constexpr bool GATHER = GATHER_;
    __device__ bool next(int i, Unit& u) const {
        const long L = (long)i * G + c; if (L >= nwg) return false;
        int wgid = (int)L; { const int q = nwg / NXCD, r = nwg % NXCD, xcd = wgid % NXCD, off = wgid / NXCD; wgid = (xcd < r ? xcd * (q + 1) : r * (q + 1) + (xcd - r) * q) + off; }
        const int e = __builtin_amdgcn_readfirstlane(t2e[wgid / npn]);
        const int t0 = ts(e), nt = ts(e + 1) - t0, l = wgid - t0 * npn, pn = l / nt, ti = l % nt;
        u.pm = t0 + ti; u.pn = pn; u.e = e; u.cnt = __builtin_amdgcn_readfirstlane(cnt[e]) - ti * BM;
        u.A = GATHER ? A : A + (size_t)u.pm * BM * lda * 2;
        u.B = B + (size_t)e * sB + (size_t)pn * BM * ldb * 2; return true;
    }
    __device__ __forceinline__ void aoff(const Unit& u, const int (&R)[2], const int (&C)[2], unsigned (&off)[2][2]) const {
        if (GATHER) {
            const int ti = u.pm - ts(u.e);
#pragma unroll
            for (int h = 0; h < 2; ++h)
#pragma unroll
                for (int i = 0; i < 2; ++i) { const int r = h * HALF + R[i]; const int tok = (r < u.cnt) ? list[(size_t)u.e * T + ti * BM + r] : 0; off[h][i] = (unsigned)(tok * lda + C[i]) * 2u; }
        } else {
#pragma unroll
            for (int h = 0; h < 2; ++h)
#pragma unroll
                for (int i = 0; i < 2; ++i) off[h][i] = (unsigned)((h * HALF + R[i]) * lda + C[i]) * 2u;
        }
    }
};

template <class Epi, class Sched>
__device__ __forceinline__ void gemm_phase(LAS unsigned char* lds, const Gemm g, const Sched& S, const Epi& E) {
    const int tid = threadIdx.x, wid = __builtin_amdgcn_readfirstlane(tid >> 6), lane = tid & 63, wr = wid >> 2, wc = wid & 3, fr = lane & 15, fq = lane >> 4;
    const int K = g.K, nt = K / BK;
    int Rr[2], Cc[2]; unsigned voffB[2];
#pragma unroll
    for (int i = 0; i < 2; ++i) { int R, C; stage_rc(tid * 16 + i * 8192, R, C); const int Rb = Epi::PERM ? ((R & ~31) + perm32(R & 31)) : R; Rr[i] = R; Cc[i] = C; voffB[i] = (unsigned)(Rb * g.ldb + C) * 2u; }
    const size_t kstep = (size_t)(BK * 2);
    const size_t hstepB = (size_t)HALF * g.ldb * 2;
    const unsigned ldsw = (unsigned)wid * 1024u;
    const int aoff = lds_byte(wr * 64 + fr, fq * 8), boff = lds_byte(wc * 32 + fr, fq * 8);
#define PG8_SA(b, h) (((b) * 2 + (h)) * HTB)
#define PG8_SB(b, h) ((4 + (b) * 2 + (h)) * HTB)
#define PG8_STAGE2(bufoff, gbase, o0, o1) do { \
        __builtin_amdgcn_global_load_lds((const unsigned*)((const char*)(gbase) + (o0)), (LAS unsigned*)(lds + (bufoff) + ldsw), 16, 0, 0); \
        __builtin_amdgcn_global_load_lds((const unsigned*)((const char*)(gbase) + (o1)), (LAS unsigned*)(lds + (bufoff) + ldsw + 8192), 16, 0, 0); } while (0)
#define PG8_STAGEB(bufoff, gbase) PG8_STAGE2(bufoff, gbase, voffB[0], voffB[1])
#define PG8_LDA(dst, b, h) do { _Pragma("unroll") for (int m = 0; m < 4; ++m) _Pragma("unroll") for (int k = 0; k < 2; ++k) dst[m][k] = *(const LAS bf16x8*)(lds + PG8_SA(b, h) + aoff + m * 2048 + k * 1024); } while (0)
#define PG8_LDB(dst, b, h) do { _Pragma("unroll") for (int n = 0; n < 2; ++n) _Pragma("unroll") for (int k = 0; k < 2; ++k) dst[n][k] = *(const LAS bf16x8*)(lds + PG8_SB(b, h) + boff + n * 2048 + k * 1024); } while (0)
#define PG8_MMA(ai, bj, At, Bt) do { __builtin_amdgcn_s_setprio(1); _Pragma("unroll") for (int m = 0; m < 4; ++m) _Pragma("unroll") for (int n = 0; n < 2; ++n) _Pragma("unroll") for (int k = 0; k < 2; ++k) \
        acc[ai][bj][m][n] = __builtin_amdgcn_mfma_f32_16x16x32_bf16(Bt[n][k], At[m][k], acc[ai][bj][m][n], 0, 0, 0); __builtin_amdgcn_s_setprio(0); } while (0)
#define PG8_WAIT_V(n) asm volatile("s_waitcnt vmcnt(" #n ")" ::: "memory")
#define PG8_WAIT_L(n) asm volatile("s_waitcnt lgkmcnt(" #n ")" ::: "memory")
#define PG8_BAR __builtin_amdgcn_s_barrier()
#define PG8_SCHED __builtin_amdgcn_sched_barrier(0)
    Unit cur, nxt; int ui = 0;
    if (!S.next(0, cur)) return;
    f32x4 acc[2][2][4][2];
#pragma unroll
    for (int a = 0; a < 2; ++a)
#pragma unroll
        for (int b = 0; b < 2; ++b)
#pragma unroll
            for (int m = 0; m < 4; ++m)
#pragma unroll
                for (int n = 0; n < 2; ++n) acc[a][b][m][n] = (f32x4){0.f, 0.f, 0.f, 0.f};
    bf16x8 At[4][2], B0[2][2], B1[2][2];
    unsigned oA[2][2], nOA[2][2];
    S.aoff(cur, Rr, Cc, oA);
    const char* cA = cur.A; const char* cB = cur.B;
    PG8_STAGEB(PG8_SB(0, 0), cB); PG8_STAGEB(PG8_SB(0, 1), cB + hstepB); PG8_STAGE2(PG8_SA(0, 0), cA, oA[0][0], oA[0][1]); PG8_STAGE2(PG8_SA(0, 1), cA, oA[1][0], oA[1][1]);
    if (wr == 1) PG8_BAR;
    PG8_WAIT_V(2); PG8_BAR;
    PG8_STAGEB(PG8_SB(1, 0), cB + kstep); PG8_STAGE2(PG8_SA(1, 0), cA + kstep, oA[0][0], oA[0][1]); PG8_STAGEB(PG8_SB(1, 1), cB + hstepB + kstep);
    PG8_WAIT_V(6); PG8_BAR;
    for (;;) {
        const bool has_next = S.next(ui + 1, nxt);
        const char* nA = has_next ? nxt.A : cA; const char* nB = has_next ? nxt.B : cB;
        if (Sched::GATHER) { if (has_next) S.aoff(nxt, Rr, Cc, nOA); else {
#pragma unroll
            for (int h = 0; h < 2; ++h)
#pragma unroll
                for (int i = 0; i < 2; ++i) nOA[h][i] = oA[h][i]; }
            asm volatile("" : "+v"(nOA[0][0]), "+v"(nOA[0][1]), "+v"(nOA[1][0]), "+v"(nOA[1][1])); }
        for (int t = 0; t < nt; t += 2) {
            const bool last = (t == nt - 2);
            const char* a1 = cA + (size_t)(t + 1) * kstep;
            const char* a2 = last ? nA : cA + (size_t)(t + 2) * kstep; const char* b2 = last ? nB : cB + (size_t)(t + 2) * kstep;
            const char* a3 = a2 + kstep; const char* b3 = b2 + kstep;
            unsigned q00 = oA[0][0], q01 = oA[0][1], q10 = oA[1][0], q11 = oA[1][1];
            if (Sched::GATHER) { q00 = last ? nOA[0][0] : q00; q01 = last ? nOA[0][1] : q01; q10 = last ? nOA[1][0] : q10; q11 = last ? nOA[1][1] : q11; }
            PG8_LDB(B0, 0, 0); PG8_LDB(B1, 0, 1); PG8_SCHED; PG8_LDA(At, 0, 0); PG8_STAGE2(PG8_SA(1, 1), a1, oA[1][0], oA[1][1]);
            PG8_WAIT_V(8); PG8_WAIT_L(0); PG8_BAR; PG8_MMA(0, 0, At, B0); PG8_MMA(0, 1, At, B1); PG8_BAR; PG8_SCHED;
            PG8_LDA(At, 0, 1); PG8_STAGEB(PG8_SB(0, 0), b2); PG8_STAGEB(PG8_SB(0, 1), b2 + hstepB); PG8_STAGE2(PG8_SA(0, 0), a2, q00, q01);
            PG8_WAIT_V(8); PG8_WAIT_L(0); PG8_BAR; PG8_MMA(1, 0, At, B0); PG8_MMA(1, 1, At, B1); PG8_BAR; PG8_SCHED;
            PG8_LDB(B0, 1, 0); PG8_LDB(B1, 1, 1); PG8_SCHED; PG8_LDA(At, 1, 0); PG8_STAGE2(PG8_SA(0, 1), a2, q10, q11);
            PG8_WAIT_V(8); PG8_WAIT_L(0); PG8_BAR; PG8_MMA(0, 0, At, B0); PG8_MMA(0, 1, At, B1); PG8_BAR; PG8_SCHED;
            PG8_LDA(At, 1, 1); PG8_STAGEB(PG8_SB(1, 0), b3); PG8_STAGEB(PG8_SB(1, 1), b3 + hstepB); PG8_STAGE2(PG8_SA(1, 0), a3, q00, q01);
            PG8_WAIT_V(8); PG8_WAIT_L(0); PG8_BAR; PG8_MMA(1, 0, At, B0); PG8_MMA(1, 1, At, B1); PG8_BAR; PG8_SCHED;
        }
        if (wr == 0) PG8_BAR;
        E(acc, cur, wr, wc, fr, fq, lds + 3 * HTB + ldsw);
        if (!has_next) break;
#pragma unroll
        for (int a = 0; a < 2; ++a)
#pragma unroll
            for (int b = 0; b < 2; ++b)
#pragma unroll
                for (int m = 0; m < 4; ++m)
#pragma unroll
                    for (int n = 0; n < 2; ++n) acc[a][b][m][n] = (f32x4){0.f, 0.f, 0.f, 0.f};
        cur = nxt; cA = nA; cB = nB; ++ui;
        if (Sched::GATHER) {
#pragma unroll
            for (int h = 0; h < 2; ++h)
#pragma unroll
                for (int i = 0; i < 2; ++i) oA[h][i] = nOA[h][i]; }
        if (wr == 1) PG8_BAR;
    }
    PG8_WAIT_V(0);
    PG8_BAR;
#undef PG8_SA
#undef PG8_SB
#undef PG8_STAGE2
#undef PG8_STAGEB
#undef PG8_LDA
#undef PG8_LDB
#undef PG8_MMA
#undef PG8_WAIT_V
#undef PG8_WAIT_L
#undef PG8_BAR
#undef PG8_SCHED
}

typedef f32x4 Acc[2][2][4][2];

struct XStore {
    LAS unsigned char* w; LAS unsigned char* r; int rr, cc;
    __device__ __forceinline__ XStore(LAS unsigned char* xs, int fr, int fq) {
        const int lane = fq * 16 + fr; rr = lane >> 2; cc = lane & 3;
        w = xs + fr * 64 + ((fq ^ ((fr >> 1) & 3)) * 16); r = xs + rr * 64 + ((cc ^ ((rr >> 1) & 3)) * 16); }
    __device__ __forceinline__ void put(const u32x4& x, const u32x4& y) const { *(LAS u32x4*)w = x; *(LAS u32x4*)(w + 8192) = y; }
    __device__ __forceinline__ void get(u32x4& x, u32x4& y) const { x = *(const LAS u32x4*)r; y = *(const LAS u32x4*)(r + 8192); }
};
struct EpiBf16 {
    static constexpr bool PERM = true;
    bf16_t* O; int ldc; int ncols;
    __device__ __forceinline__ void operator()(const Acc& acc, const Unit& u, int wr, int wc, int fr, int fq, LAS unsigned char* xs) const {
        const XStore X(xs, fr, fq);
        const int colw = u.pn * BM + wc * 32; const bool ok0 = colw < ncols, ok1 = colw + HALF < ncols;
        bf16_t* ob = O + (size_t)(u.pm * BM + wr * 64 + X.rr) * ldc + colw + 8 * X.cc;
#pragma unroll
        for (int ai = 0; ai < 2; ++ai)
#pragma unroll
            for (int m = 0; m < 4; ++m) { u32x4 w[2];
#pragma unroll
                for (int bj = 0; bj < 2; ++bj) { const f32x4 v0 = acc[ai][bj][m][0], v1 = acc[ai][bj][m][1];
                    w[bj].x = cvt_pk_bf16(v0[0], v0[1]); w[bj].y = cvt_pk_bf16(v0[2], v0[3]); w[bj].z = cvt_pk_bf16(v1[0], v1[1]); w[bj].w = cvt_pk_bf16(v1[2], v1[3]); }
                X.put(w[0], w[1]); u32x4 a, b; X.get(a, b);
                bf16_t* rowp = ob + (size_t)(ai * HALF + m * 16) * ldc; if (ok0) *(u32x4*)rowp = a; if (ok1) *(u32x4*)(rowp + HALF) = b; }
    }
};
struct EpiFourT {
    static constexpr bool PERM = true;
    bf16_t* TT; bf16_t* TTC;
    __device__ __forceinline__ void operator()(const Acc& acc, const Unit& u, int wr, int wc, int fr, int fq, LAS unsigned char* xs) const {
        const XStore X(xs, fr, fq);
        const int part = u.pm; const int ch0 = wr * 64 + X.rr; const int tokw = u.pn * BM + wc * 32;
        bf16_t* base[2]; int ldt[2];
#pragma unroll
        for (int bj = 0; bj < 2; ++bj) { const int tok = tokw + bj * HALF;
            if (tok < TC) { const int b = tok >> 8, n = tok & 255; base[bj] = TTC + (size_t)b * 256 * 512 + part * 256 + n + 8 * X.cc; ldt[bj] = 512; }
            else { const int tl = tok - TC, b = tl >> 12, n = tl & 4095; base[bj] = TT + (size_t)b * 256 * 8192 + part * 4096 + n + 8 * X.cc; ldt[bj] = 8192; } }
#pragma unroll
        for (int ai = 0; ai < 2; ++ai)
#pragma unroll
            for (int m = 0; m < 4; ++m) { const int ch = ch0 + ai * HALF + m * 16; u32x4 w[2];
#pragma unroll
                for (int bj = 0; bj < 2; ++bj) { const f32x4 v0 = acc[ai][bj][m][0], v1 = acc[ai][bj][m][1];
                    w[bj].x = cvt_pk_bf16(v0[0], v0[1]); w[bj].y = cvt_pk_bf16(v0[2], v0[3]); w[bj].z = cvt_pk_bf16(v1[0], v1[1]); w[bj].w = cvt_pk_bf16(v1[2], v1[3]); }
                X.put(w[0], w[1]); u32x4 a, b; X.get(a, b);
                *(u32x4*)(base[0] + (size_t)ch * ldt[0]) = a; *(u32x4*)(base[1] + (size_t)ch * ldt[1]) = b; }
    }
};
struct EpiRS {
    static constexpr bool PERM = true;
    bf16_t* O; const float* rs; int ldc, ncols;
    __device__ __forceinline__ void operator()(const Acc& acc, const Unit& u, int wr, int wc, int fr, int fq, LAS unsigned char* xs) const {
        const XStore X(xs, fr, fq);
        const int row0 = u.pm * BM + wr * 64 + fr, colw = u.pn * BM + wc * 32; const bool ok0 = colw < ncols, ok1 = colw + HALF < ncols;
        bf16_t* ob = O + (size_t)(u.pm * BM + wr * 64 + X.rr) * ldc + colw + 8 * X.cc;
#pragma unroll
        for (int ai = 0; ai < 2; ++ai)
#pragma unroll
            for (int m = 0; m < 4; ++m) { const float sc = rs[row0 + ai * HALF + m * 16]; u32x4 w[2];
#pragma unroll
                for (int bj = 0; bj < 2; ++bj) { const f32x4 v0 = acc[ai][bj][m][0] * sc, v1 = acc[ai][bj][m][1] * sc;
                    w[bj].x = cvt_pk_bf16(v0[0], v0[1]); w[bj].y = cvt_pk_bf16(v0[2], v0[3]); w[bj].z = cvt_pk_bf16(v1[0], v1[1]); w[bj].w = cvt_pk_bf16(v1[2], v1[3]); }
                X.put(w[0], w[1]); u32x4 a, b; X.get(a, b);
                bf16_t* rowp = ob + (size_t)(ai * HALF + m * 16) * ldc; if (ok0) *(u32x4*)rowp = a; if (ok1) *(u32x4*)(rowp + HALF) = b; }
    }
};
struct EpiFourOut {
    static constexpr bool PERM = true;
    bf16_t* MIX; int rowbase, rows_per_b;
    __device__ __forceinline__ void operator()(const Acc& acc, const Unit& u, int wr, int wc, int fr, int fq, LAS unsigned char* xs) const {
        const XStore X(xs, fr, fq);
        bf16_t* ob = MIX + (size_t)(rowbase + u.e * rows_per_b + u.pm * BM + wr * 64 + X.rr) * D + 768 + wc * 32 + 8 * X.cc;
#pragma unroll
        for (int ai = 0; ai < 2; ++ai)
#pragma unroll
            for (int m = 0; m < 4; ++m) { u32x4 w[2];
#pragma unroll
                for (int bj = 0; bj < 2; ++bj) { const f32x4 v0 = acc[ai][bj][m][0], v1 = acc[ai][bj][m][1];
                    w[bj].x = cvt_pk_bf16(v0[0], v0[1]); w[bj].y = cvt_pk_bf16(v0[2], v0[3]); w[bj].z = cvt_pk_bf16(v1[0], v1[1]); w[bj].w = cvt_pk_bf16(v1[2], v1[3]); }
                X.put(w[0], w[1]); u32x4 a, b; X.get(a, b);
                bf16_t* rowp = ob + (size_t)(ai * HALF + m * 16) * D; *(u32x4*)rowp = a; *(u32x4*)(rowp + HALF) = b; }
    }
};
struct EpiDual0 {
    static constexpr bool PERM = true;
    EpiBf16 e0; EpiFourT e1;
    __device__ __forceinline__ void operator()(const Acc& acc, const Unit& u, int wr, int wc, int fr, int fq, LAS unsigned char* xs) const { if (u.e == 0) e0(acc, u, wr, wc, fr, fq, xs); else e1(acc, u, wr, wc, fr, fq, xs); }
};
struct EpiResid {
    static constexpr bool PERM = false;
    const float* base_ctx; const float* base_lat; float* out_ctx; float* out_lat; const float* modv; int goff; int rowoff;
    __device__ __forceinline__ void operator()(const Acc& acc, const Unit& u, int wr, int wc, int fr, int fq, LAS unsigned char* xs) const {
        const int rt = rowoff + u.pm * BM;
        const bool isctx = rt < TC; const int mr = isctx ? 8 : ((rt - TC) >> 12);
        const float* base = isctx ? base_ctx + (size_t)rt * D : base_lat + (size_t)(rt - TC) * D;
        float* out = isctx ? out_ctx + (size_t)rt * D : out_lat + (size_t)(rt - TC) * D;
        const float* gv = modv + mr * 6144 + goff;
        const int r0 = wr * 64 + fr, col0 = u.pn * BM + wc * 32 + 4 * fq;
        f32x4 g[2][2];
#pragma unroll
        for (int bj = 0; bj < 2; ++bj)
#pragma unroll
            for (int n = 0; n < 2; ++n) g[bj][n] = *(const f32x4*)(gv + col0 + bj * HALF + n * 16);
#pragma unroll
        for (int ai = 0; ai < 2; ++ai) {
            f32x4 bs[4][2][2];
#pragma unroll
            for (int m = 0; m < 4; ++m) { const size_t off = (size_t)(r0 + ai * HALF + m * 16) * D + col0;
#pragma unroll
                for (int bj = 0; bj < 2; ++bj)
#pragma unroll
                    for (int n = 0; n < 2; ++n) bs[m][bj][n] = *(const f32x4*)(base + off + bj * HALF + n * 16); }
#pragma unroll
            for (int m = 0; m < 4; ++m) { const size_t off = (size_t)(r0 + ai * HALF + m * 16) * D + col0;
#pragma unroll
                for (int bj = 0; bj < 2; ++bj)
#pragma unroll
                    for (int n = 0; n < 2; ++n) *(f32x4*)(out + off + bj * HALF + n * 16) = bs[m][bj][n] + g[bj][n] * acc[ai][bj][m][n]; }
            asm volatile("" ::: "memory"); }
    }
};
struct EpiGateBf16 {
    static constexpr bool PERM = true; static constexpr int NSTORE = 16;
    bf16_t* Y; const float* modv; int goff, rowoff, ybase;
    __device__ __forceinline__ void operator()(const Acc& acc, const Unit& u, int wr, int wc, int fr, int fq, LAS unsigned char* xs) const {
        const XStore X(xs, fr, fq);
        const int rt = rowoff + u.pm * BM; const int mr = rt < TC ? 8 : ((rt - TC) >> 12);
        const float* gv = modv + mr * 6144 + goff; const int col0 = u.pn * BM + wc * 32 + 8 * fq;
        f32x4 g[2][2];
#pragma unroll
        for (int bj = 0; bj < 2; ++bj)
#pragma unroll
            for (int n = 0; n < 2; ++n) g[bj][n] = *(const f32x4*)(gv + col0 + bj * HALF + 4 * n);
        bf16_t* yb = Y + (size_t)(rt - ybase + wr * 64 + X.rr) * D + u.pn * BM + wc * 32 + 8 * X.cc;
#pragma unroll
        for (int ai = 0; ai < 2; ++ai)
#pragma unroll
            for (int m = 0; m < 4; ++m) { u32x4 w[2];
#pragma unroll
                for (int bj = 0; bj < 2; ++bj) { const f32x4 v0 = acc[ai][bj][m][0] * g[bj][0], v1 = acc[ai][bj][m][1] * g[bj][1];
                    w[bj].x = cvt_pk_bf16(v0[0], v0[1]); w[bj].y = cvt_pk_bf16(v0[2], v0[3]); w[bj].z = cvt_pk_bf16(v1[0], v1[1]); w[bj].w = cvt_pk_bf16(v1[2], v1[3]); }
                X.put(w[0], w[1]); u32x4 a, b; X.get(a, b);
                bf16_t* rowp = yb + (size_t)(ai * HALF + m * 16) * D; *(u32x4*)rowp = a; *(u32x4*)(rowp + HALF) = b; }
    }
};
struct EpiSwiglu {
    static constexpr bool PERM = true;
    bf16_t* ACT; const float* bgu;
    __device__ __forceinline__ void operator()(const Acc& acc, const Unit& u, int wr, int wc, int fr, int fq, LAS unsigned char* xs) const {
        const XStore X(xs, fr, fq);
        const int a0 = u.pn * HALF + wc * 32 + 8 * fq;
        const float* bp = bgu + (size_t)u.e * 2048 + 2 * a0;
        float bg[8], bl[8];
#pragma unroll
        for (int q = 0; q < 4; ++q) { const f32x4 t = *(const f32x4*)(bp + 4 * q); bg[2 * q] = t[0]; bl[2 * q] = t[1]; bg[2 * q + 1] = t[2]; bl[2 * q + 1] = t[3]; }
        bf16_t* ab = ACT + (size_t)(u.pm * BM + wr * 64 + X.rr) * FF + u.pn * HALF + wc * 32 + 8 * X.cc;
#pragma unroll
        for (int ai = 0; ai < 2; ++ai)
#pragma unroll
            for (int mp = 0; mp < 2; ++mp) { u32x4 w[2];
#pragma unroll
                for (int mm = 0; mm < 2; ++mm) { const int m = 2 * mp + mm; float o[8];
#pragma unroll
                    for (int j = 0; j < 8; ++j) { float xg = acc[ai][0][m][j >> 2][j & 3] + bg[j], xl = acc[ai][1][m][j >> 2][j & 3] + bl[j];
                        xg = fminf(xg, 7.0f); xl = fminf(fmaxf(xl, -7.0f), 7.0f);
                        o[j] = xg * __builtin_amdgcn_rcpf(1.0f + __builtin_amdgcn_exp2f(xg * (-1.702f * 1.4426950408889634f))) * (xl + 1.0f); }
                    w[mm].x = cvt_pk_bf16(o[0], o[1]); w[mm].y = cvt_pk_bf16(o[2], o[3]); w[mm].z = cvt_pk_bf16(o[4], o[5]); w[mm].w = cvt_pk_bf16(o[6], o[7]); }
                X.put(w[0], w[1]); u32x4 a, b; X.get(a, b);
                bf16_t* rowp = ab + (size_t)(ai * HALF + mp * 32) * FF; *(u32x4*)rowp = a; *(u32x4*)(rowp + (size_t)16 * FF) = b; }
    }
};
struct EpiDown {
    static constexpr bool PERM = true;
    bf16_t* YB; const float* bdn;
    __device__ __forceinline__ void operator()(const Acc& acc, const Unit& u, int wr, int wc, int fr, int fq, LAS unsigned char* xs) const {
        const int col0 = u.pn * BM + wc * 32 + 8 * fq;
        f32x4 bv[2][2];
#pragma unroll
        for (int bj = 0; bj < 2; ++bj)
#pragma unroll
            for (int n = 0; n < 2; ++n) bv[bj][n] = *(const f32x4*)(bdn + (size_t)u.e * D + col0 + bj * HALF + 4 * n);
        const XStore X(xs, fr, fq);
        bf16_t* yb = YB + (size_t)(u.pm * BM + wr * 64 + X.rr) * D + u.pn * BM + wc * 32 + 8 * X.cc;
#pragma unroll
        for (int ai = 0; ai < 2; ++ai)
#pragma unroll
            for (int m = 0; m < 4; ++m) { u32x4 w[2];
#pragma unroll
                for (int bj = 0; bj < 2; ++bj) { const f32x4 v0 = acc[ai][bj][m][0] + bv[bj][0], v1 = acc[ai][bj][m][1] + bv[bj][1];
                    w[bj].x = cvt_pk_bf16(v0[0], v0[1]); w[bj].y = cvt_pk_bf16(v0[2], v0[3]); w[bj].z = cvt_pk_bf16(v1[0], v1[1]); w[bj].w = cvt_pk_bf16(v1[2], v1[3]); }
                X.put(w[0], w[1]); u32x4 a, b; X.get(a, b);
                bf16_t* rowp = yb + (size_t)(ai * HALF + m * 16) * D; *(u32x4*)rowp = a; *(u32x4*)(rowp + HALF) = b; }
    }
};
}

struct Args { const float* in[38]; float* out; unsigned char* ws; int ph_lo, ph_hi; };
enum { I_X = 0, I_C, I_CTX, I_CCTX, I_FNG,
       I0_MODW, I0_MODB, I0_N1G, I0_WIN, I0_QNG, I0_WQUP, I0_KVNG, I0_WKVUP, I0_WOUT, I0_N2G, I0_RW, I0_RB, I0_WGU, I0_BGU, I0_WDN, I0_BDN,
       I1_MODW, I1_MODB, I1_N1G, I1_WIN, I1_WGKF, I1_BGKF, I1_WGKB, I1_BGKB, I1_GNG, I1_WOUT, I1_N2G, I1_RW, I1_RB, I1_WGU, I1_BGU, I1_WDN, I1_BDN };

struct Frame {
    const float* const* in; float* out; unsigned char* ws; LAS unsigned char* lds; LAS unsigned char* ring;
    int tid, lane, wave, G, bid;
};
#define WSP(T_, off) ((T_*)(F.ws + (off)))

__device__ __forceinline__ int gu_row(int n) { const int a = n >> 1, half = n & 1; return 256 * (a >> 7) + 128 * half + (a & 127); }
template <int MODE>
__device__ __forceinline__ void cvt_tile(const Frame& F, LAS bf16_t* tile  , const float* src, int ldsrc, int k0, int n0, bf16_t* dst, int ldd, const float* sk, float mul) {
    const int t = F.tid;
    { const int kl = t >> 3, nc = (t & 7) * 8; const float* p = src + (size_t)(k0 + kl) * ldsrc + n0 + nc;
      const f32x4 a = *(const f32x4*)p, b = *(const f32x4*)(p + 4); const float s = (sk ? sk[k0 + kl] : 1.0f) * mul;
      tile[(nc + 0) * 72 + kl] = f2bf(a[0] * s); tile[(nc + 1) * 72 + kl] = f2bf(a[1] * s); tile[(nc + 2) * 72 + kl] = f2bf(a[2] * s); tile[(nc + 3) * 72 + kl] = f2bf(a[3] * s);
      tile[(nc + 4) * 72 + kl] = f2bf(b[0] * s); tile[(nc + 5) * 72 + kl] = f2bf(b[1] * s); tile[(nc + 6) * 72 + kl] = f2bf(b[2] * s); tile[(nc + 7) * 72 + kl] = f2bf(b[3] * s); }
    __syncthreads();
    { const int nl = t >> 3, kc = (t & 7) * 8; const int n = n0 + nl; const int row = MODE == 1 ? gu_row(n) : n;
      const u32x4 v = *(const LAS u32x4*)(tile + nl * 72 + kc); *(u32x4*)(dst + (size_t)row * ldd + k0 + kc) = v; }
    __syncthreads();
}
template <int MODE>
__device__ __forceinline__ void cvt_blk(const Frame& F, LAS float* tl, const float* src, int ldsrc, int k0, int n0, bf16_t* dst, int ldd) {
    const int t = F.tid, w = t >> 6, l = t & 63;
    f32x4 v[8];
#pragma unroll
    for (int i = 0; i < 8; ++i) v[i] = *(const f32x4*)(src + (size_t)(k0 + w + 8 * i) * ldsrc + n0 + 4 * l);
#pragma unroll
    for (int i = 0; i < 8; ++i) *(LAS f32x4*)(tl + (w + 8 * i) * 260 + 4 * l) = v[i];
    __syncthreads();
    { const int n = t & 255, kh = t >> 8; const int row = MODE == 1 ? gu_row(n0 + n) : n0 + n; bf16_t* dp = dst + (size_t)row * ldd + k0 + kh * 32;
#pragma unroll
      for (int q = 0; q < 4; ++q) { float x[8];
#pragma unroll
          for (int j = 0; j < 8; ++j) x[j] = tl[(kh * 32 + 8 * q + j) * 260 + n];
          u32x4 o; o.x = cvt_pk_bf16(x[0], x[1]); o.y = cvt_pk_bf16(x[2], x[3]); o.z = cvt_pk_bf16(x[4], x[5]); o.w = cvt_pk_bf16(x[6], x[7]);
          *(u32x4*)(dp + 8 * q) = o; } }
    __syncthreads();
}
constexpr int CVT_NGU = NE * 16 * 8, CVT_NDN = NE * 16 * 4, CVT_JOBS = CVT_NGU + CVT_NDN;
__device__ __forceinline__ void cvt_moe_job(const Frame& F, LAS float* tl, const float* wgu, const float* wdn, int j) {
    bf16_t* WGU = WSP(bf16_t, WS_WGU); bf16_t* WDN = WSP(bf16_t, WS_WDN);
    if (j < CVT_NGU) { const int e = j >> 7, r = j & 127, kt = r >> 3, ntl = r & 7; cvt_blk<1>(F, tl, wgu + (size_t)e * 1024 * 2048, 2048, kt * 64, ntl * 256, WGU + (size_t)e * 2048 * 1024, 1024); }
    else { const int jj = j - CVT_NGU, e = jj >> 6, r = jj & 63, kt = r >> 2, ntl = r & 3; cvt_blk<0>(F, tl, wdn + (size_t)e * 1024 * 1024, 1024, kt * 64, ntl * 256, WDN + (size_t)e * 1024 * 1024, 1024); }
}
__device__ __forceinline__ void cvt_moe_weights(const Frame& F, LAS float* tl, const float* wgu, const float* wdn) {
    for (int j = F.bid; j < CVT_JOBS; j += F.G) cvt_moe_job(F, tl, wgu, wdn, j);
}
__device__ __forceinline__ void ph_prologue(const Frame& F) {
    LAS float* sc = (LAS float*)(F.ring);
    LAS float* red = (LAS float*)(F.ring + 36864);
    LAS float* ctab = (LAS float*)(F.ring + 55296);
    LAS float* stab = ctab + 4096;
    LAS bf16_t* tile = (LAS bf16_t*)(F.ring + 88064);
    LAS float* wt = (LAS float*)(F.ring + 97280);
    const int t = F.tid;
    for (int i = t; i < 9 * 1024; i += NTHR) { const int r = i >> 10, k = i & 1023; const float v = (r < 8) ? F.in[I_C][r * 1024 + k] : F.in[I_CCTX][k]; sc[i] = siluf(v); }
    for (int i = t; i < 4096; i += NTHR) { const float x = (float)i * (1.0f / 2048.0f); ctab[i] = cospif(x); stab[i] = sinpif(x); }
    __syncthreads();
    for (int u = F.bid; u < 2 * 96; u += F.G) {
        const int l = u / 96, j0 = (u % 96) * 64; const float* W = l ? F.in[I1_MODW] : F.in[I0_MODW]; const float* Bv = l ? F.in[I1_MODB] : F.in[I0_MODB];
        const int c4 = t & 15, kb = F.wave * 128 + ((t >> 4) & 3) * 32; f32x4 a[9];
#pragma unroll
        for (int r = 0; r < 9; ++r) a[r] = (f32x4){0.f, 0.f, 0.f, 0.f};
#pragma unroll 8
        for (int q = 0; q < 32; ++q) { const f32x4 w = *(const f32x4*)(W + (size_t)(kb + q) * 6144 + j0 + 4 * c4);
#pragma unroll
            for (int r = 0; r < 9; ++r) a[r] += w * sc[r * 1024 + kb + q]; }
#pragma unroll
        for (int r = 0; r < 9; ++r) {
#pragma unroll
            for (int j = 0; j < 4; ++j) { float v = a[r][j]; v += __shfl_xor(v, 16); v += __shfl_xor(v, 32); a[r][j] = v; }
            if ((t & 48) == 0) *(LAS f32x4*)(red + (F.wave * 9 + r) * 64 + 4 * c4) = a[r]; }
        __syncthreads();
        for (int i = t; i < 576; i += NTHR) { const int r = i >> 6, c = i & 63; float s = 0.f;
#pragma unroll
            for (int q = 0; q < 8; ++q) s += red[(q * 9 + r) * 64 + c];
            WSP(float, WS_MODV)[(size_t)(l * 9 + r) * 6144 + j0 + c] = s + Bv[j0 + c]; }
        __syncthreads();
    }
    if (F.bid == (1 % F.G)) { for (int i = t; i < 1024; i += NTHR) { const int pos = i >> 4, j = i & 15; const float inv = powf(10000.0f, -(float)j / 16.0f); const float ang = (float)pos * inv;
        WSP(float, WS_ROPE)[i] = cosf(ang); WSP(float, WS_ROPE)[1024 + i] = sinf(ang); } }
    { bf16_t* DFT = WSP(bf16_t, R0_DFT); bf16_t* DFTC = WSP(bf16_t, R0_DFTC);
      for (int k = F.bid; k < 4096 + 256; k += F.G) {
          if (k < 4096) { for (int jc = t; jc < 512; jc += NTHR) { const int j0 = jc * 8; float v[8];
#pragma unroll
                  for (int q = 0; q < 8; ++q) { const int j = j0 + q; const bool isS = j > 2048; const int idx = (k * (isS ? j - 2048 : j)) & 4095; v[q] = (isS ? stab[idx] : ctab[idx]) * (1.0f / 512.0f); }
                  u32x4 w; w.x = pk2(v[0], v[1]); w.y = pk2(v[2], v[3]); w.z = pk2(v[4], v[5]); w.w = pk2(v[6], v[7]); *(u32x4*)(DFT + (size_t)k * 4096 + j0) = w; } }
          else { const int kk = k - 4096; for (int jc = t; jc < 32; jc += NTHR) { const int j0 = jc * 8; float v[8];
#pragma unroll
                  for (int q = 0; q < 8; ++q) { const int j = j0 + q; const bool isS = j > 128; const int idx = ((kk * (isS ? j - 128 : j)) & 255) * 16; v[q] = (isS ? stab[idx] : ctab[idx]) * (1.0f / 128.0f); }
                  u32x4 w; w.x = pk2(v[0], v[1]); w.y = pk2(v[2], v[3]); w.z = pk2(v[4], v[5]); w.w = pk2(v[6], v[7]); *(u32x4*)(DFTC + (size_t)kk * 256 + j0) = w; } }
      } }
    { bf16_t* WF = WSP(bf16_t, WS_WF); const float* Win = F.in[I0_WIN];
      for (int j = (F.bid + 64) % F.G; j < 64; j += F.G) { const int k0 = (j >> 2) * 64, g = j & 3;
          for (int i = t; i < 4096; i += NTHR) { const int kl = i >> 6, c = i & 63; wt[kl * 65 + c] = Win[(size_t)(k0 + kl) * 960 + 704 + g * 64 + c]; }
          __syncthreads();
          { const int kl = t & 63, mg = t >> 6;
#pragma unroll 1
            for (int mm = 0; mm < 8; ++mm) { const int m = mg * 8 + mm; float ac = 0.f, as = 0.f;
                for (int c = 0; c < 64; ++c) { const int idx = ((m * c) & 63) * 64; const float w = wt[kl * 65 + c]; ac = fmaf(w, ctab[idx], ac); as = fmaf(w, stab[idx], as); }
                WF[(size_t)(g * 64 + m) * 1024 + k0 + kl] = f2bf(ac); WF[(size_t)(256 + g * 64 + m) * 1024 + k0 + kl] = f2bf(-as); } }
          __syncthreads(); } }
    for (int i = F.bid * NTHR + t; i < 2 * 32 * 1024; i += F.G * NTHR) { const int l = i >> 15, e = (i >> 10) & 31, k = i & 1023; const float w = (l ? F.in[I1_RW] : F.in[I0_RW])[k * 32 + e];
        const bf16_t hi = f2bf(w); const bf16_t lo = f2bf(w - bf2f(hi)); bf16_t* base = WSP(bf16_t, WS_RWT) + (size_t)l * 2 * 32 * 1024; base[e * 1024 + k] = hi; base[32 * 1024 + e * 1024 + k] = lo; }
    {
      constexpr int J_WIN0 = 16 * 11, J_WQ = 6 * 18, J_WKV = 4 * 24, J_WO = 16 * 16, J_WIN1 = 16 * 48;
      constexpr int JT = J_WIN0 + J_WQ + J_WKV + 2 * J_WO + J_WIN1;
      for (int j = F.bid; j < JT; j += F.G) { int r = j;
          if (r < J_WIN0) { cvt_tile<0>(F, tile, F.in[I0_WIN], 960, (r / 11) * 64, (r % 11) * 64, WSP(bf16_t, WS_WIN0), 1024, nullptr, 1.0f); continue; } r -= J_WIN0;
          if (r < J_WQ) { cvt_tile<0>(F, tile, F.in[I0_WQUP], 1152, (r / 18) * 64, (r % 18) * 64, WSP(bf16_t, WS_WQ), QL, F.in[I0_QNG], 1.0f); continue; } r -= J_WQ;
          if (r < J_WKV) { cvt_tile<0>(F, tile, F.in[I0_WKVUP], 1536, (r / 24) * 64, (r % 24) * 64, WSP(bf16_t, WS_WKV), KVL, F.in[I0_KVNG], 1.0f); continue; } r -= J_WKV;
          if (r < J_WO) { cvt_tile<0>(F, tile, F.in[I0_WOUT], 1024, (r / 16) * 64, (r % 16) * 64, WSP(bf16_t, WS_WOUT0), 1024, nullptr, 1.0f); continue; } r -= J_WO;
          if (r < J_WO) { cvt_tile<0>(F, tile, F.in[I1_WOUT], 1024, (r / 16) * 64, (r % 16) * 64, WSP(bf16_t, WS_WOUT1), 1024, nullptr, 1.0f); continue; } r -= J_WO;
          { const int n0 = (r % 48) * 64; cvt_tile<0>(F, tile, F.in[I1_WIN], 3104, (r / 48) * 64, n0, WSP(bf16_t, WS_WIN1), 1024, nullptr, n0 < 512 ? 0.08838834764831845f : 1.0f); }
      }
      for (int i = F.bid * NTHR + t; i < (64 * 1024 + 128 * QL) / 8; i += F.G * NTHR) { const u32x4 z = {0u, 0u, 0u, 0u};
          if (i < 64 * 1024 / 8) *(u32x4*)(WSP(bf16_t, WS_WIN0) + (size_t)704 * 1024 + (size_t)i * 8) = z; else *(u32x4*)(WSP(bf16_t, WS_WQ) + (size_t)1152 * QL + (size_t)(i - 64 * 1024 / 8) * 8) = z; }
    }
}

__device__ __forceinline__ const float* xrow_in(const Frame& F, int r) { return r < TC ? F.in[I_CTX] + (size_t)r * D : F.in[I_X] + (size_t)(r - TC) * D; }
__device__ __forceinline__ float* xrow_res(const Frame& F, int r) { return r < TC ? WSP(float, WS_XCTX) + (size_t)r * D : F.out + (size_t)(r - TC) * D; }
__device__ __forceinline__ int modrow(int r) { return r < TC ? 8 : ((r - TC) >> 12); }
__device__ __forceinline__ void ld16f(const float* p, int lane, float (&v)[16]) {
#pragma unroll
    for (int h = 0; h < 2; ++h) { const f32x4 a = *(const f32x4*)(p + 8 * lane + 512 * h), b = *(const f32x4*)(p + 8 * lane + 512 * h + 4);
        v[8 * h] = a[0]; v[8 * h + 1] = a[1]; v[8 * h + 2] = a[2]; v[8 * h + 3] = a[3]; v[8 * h + 4] = b[0]; v[8 * h + 5] = b[1]; v[8 * h + 6] = b[2]; v[8 * h + 7] = b[3]; }
}
__device__ __forceinline__ void st16f(float* p, int lane, const float (&v)[16]) {
#pragma unroll
    for (int h = 0; h < 2; ++h) { *(f32x4*)(p + 8 * lane + 512 * h) = (f32x4){v[8 * h], v[8 * h + 1], v[8 * h + 2], v[8 * h + 3]}; *(f32x4*)(p + 8 * lane + 512 * h + 4) = (f32x4){v[8 * h + 4], v[8 * h + 5], v[8 * h + 6], v[8 * h + 7]}; }
}
__device__ __forceinline__ void ld16b(const bf16_t* p, int lane, float (&v)[16]) {
#pragma unroll
    for (int h = 0; h < 2; ++h) { const u32x4 w = *(const u32x4*)(p + 8 * lane + 512 * h);
#pragma unroll
        for (int q = 0; q < 4; ++q) { v[8 * h + 2 * q] = __uint_as_float(w[q] << 16); v[8 * h + 2 * q + 1] = __uint_as_float(w[q] & 0xffff0000u); } }
}
__device__ __forceinline__ void st16b(bf16_t* p, int lane, const float (&v)[16]) {
#pragma unroll
    for (int h = 0; h < 2; ++h) { u32x4 w; w.x = cvt_pk_bf16(v[8 * h], v[8 * h + 1]); w.y = cvt_pk_bf16(v[8 * h + 2], v[8 * h + 3]); w.z = cvt_pk_bf16(v[8 * h + 4], v[8 * h + 5]); w.w = cvt_pk_bf16(v[8 * h + 6], v[8 * h + 7]);
        *(u32x4*)(p + 8 * lane + 512 * h) = w; }
}
__device__ __forceinline__ void modulate16(float (&v)[16], const float* g, const float* scale, const float* shift, int lane) {
    float ss = 0.f;
#pragma unroll
    for (int i = 0; i < 16; ++i) ss = fmaf(v[i], v[i], ss);
    const float rs = rsqrtf(wsum(ss) * (1.0f / D) + EPS);
    float gg[16], sc[16], sh[16]; ld16f(g, lane, gg); ld16f(scale, lane, sc); ld16f(shift, lane, sh);
#pragma unroll
    for (int i = 0; i < 16; ++i) v[i] = v[i] * rs * gg[i] * (1.0f + sc[i]) + sh[i];
}

__device__ __forceinline__ void ph_mod0(const Frame& F) {
    const float* g = F.in[I0_N1G]; bf16_t* H = WSP(bf16_t, WS_H);
    for (int r = F.bid * NWAVE + F.wave; r < T; r += F.G * NWAVE) {
        const float* mv = WSP(float, WS_MODV) + (size_t)modrow(r) * 6144;
        float v[16]; ld16f(xrow_in(F, r), F.lane, v);
        modulate16(v, g, mv + 1024, mv, F.lane);
        st16b(H + (size_t)r * D, F.lane, v);
    }
}
__device__ __forceinline__ void ph_rowstats(const Frame& F) {
    const bf16_t* U0 = WSP(bf16_t, R0_U0); float* rsq = WSP(float, WS_RS); float* rskv = rsq + T; bf16_t* KR = WSP(bf16_t, R0_KR);
    const float* rc = WSP(float, WS_ROPE); const float* rsn = rc + 1024;
    for (int r = F.bid * NWAVE + F.wave; r < T; r += F.G * NWAVE) {
        const bf16_t* u = U0 + (size_t)r * U0W; const int lane = F.lane;
        float a[8], b[8];
        { const u32x4 w = *(const u32x4*)(u + 8 * lane);
#pragma unroll
          for (int q = 0; q < 4; ++q) { a[2 * q] = __uint_as_float(w[q] << 16); a[2 * q + 1] = __uint_as_float(w[q] & 0xffff0000u); } }
        { u32x4 w = {0u, 0u, 0u, 0u}; if (lane < 32) w = *(const u32x4*)(u + 512 + 8 * lane);
#pragma unroll
          for (int q = 0; q < 4; ++q) { b[2 * q] = __uint_as_float(w[q] << 16); b[2 * q + 1] = __uint_as_float(w[q] & 0xffff0000u); } }
        float sa = 0.f, sb = 0.f;
#pragma unroll
        for (int j = 0; j < 8; ++j) { sa = fmaf(a[j], a[j], sa); sb = fmaf(b[j], b[j], sb); }
        const float sq = wsum(lane < 48 ? sa : 0.f), skv = wsum((lane >= 48 ? sa : 0.f) + (lane < 16 ? sb : 0.f));
        float pr[8];
#pragma unroll
        for (int j = 0; j < 8; ++j) pr[j] = __shfl_xor(b[j], 2);
        if (lane >= 16 && lane < 24) { const int jq = lane - 16, quarter = jq >> 1;
            if (r >= TC) { const int n = (r - TC) & 4095; const int pos = (quarter >= 2) ? (n & 63) : (n >> 6); const float* cp = rc + pos * 16 + (jq & 1) * 8; const float* sp = rsn + pos * 16 + (jq & 1) * 8;
#pragma unroll
                for (int j = 0; j < 8; ++j) b[j] = (quarter & 1) ? (b[j] * cp[j] + pr[j] * sp[j]) : (b[j] * cp[j] - pr[j] * sp[j]); }
            u32x4 w; w.x = cvt_pk_bf16(b[0], b[1]); w.y = cvt_pk_bf16(b[2], b[3]); w.z = cvt_pk_bf16(b[4], b[5]); w.w = cvt_pk_bf16(b[6], b[7]);
            *(u32x4*)(KR + (size_t)r * ROPE + 8 * jq) = w; }
        if (lane == 0) { rsq[r] = rsqrtf(sq * (1.0f / QL) + EPS); rskv[r] = rsqrtf(skv * (1.0f / KVL) + EPS); }
    }
    { const bf16_t* TT = WSP(bf16_t, R0_TT); const bf16_t* TTC = WSP(bf16_t, R0_TTC); bf16_t* TT2 = WSP(bf16_t, R0_TT2); bf16_t* TTC2 = WSP(bf16_t, R0_TTC2);
      const int nch_l = NB * 256 * 512, nch_c = NB * 256 * 32;
      for (int i = F.bid * NTHR + F.tid; i < nch_l + nch_c; i += F.G * NTHR) {
          const bool lat = i < nch_l; const int ii = lat ? i : i - nch_l; const int N = lat ? 4096 : 256; const int cpr = N >> 3; const int row = ii / cpr, p0 = (ii % cpr) * 8;
          const bf16_t* src = (lat ? TT : TTC) + (size_t)row * 2 * N; bf16_t* dst = (lat ? TT2 : TTC2) + (size_t)row * N + p0; float v[8];
#pragma unroll
          for (int q = 0; q < 8; ++q) { const int pp = p0 + q; const bool cs = pp <= (N >> 1); const int j = cs ? pp : pp - (N >> 1); const bf16_t* X = cs ? src : src + N;
              const float a = bf2f(X[j]); const float bmir = (j == 0 || j == (N >> 1)) ? 0.f : bf2f(X[N - j]); v[q] = cs ? a + bmir : a - bmir; }
          u32x4 w; w.x = pk2(v[0], v[1]); w.y = pk2(v[2], v[3]); w.z = pk2(v[4], v[5]); w.w = pk2(v[6], v[7]); *(u32x4*)dst = w; }
    }
}

namespace att {
typedef float f32x16 __attribute__((ext_vector_type(16)));
typedef short s16x4 __attribute__((ext_vector_type(4)));
constexpr float SCALE = 0.07216878364870322f, THR = 8.f;
constexpr int SHM_V = 16384, SHM_KN = 64 * 272, SHM_KR = 64 * 144, SHM_QW = 32 * 272;
constexpr int OFF_V = 0, OFF_KN = 2 * SHM_V, OFF_KR = OFF_KN + 2 * SHM_KN, OFF_WS = OFF_KR + 2 * SHM_KR, OFF_QR = OFF_WS + 2048;
#define KNSWZ(row, cb) ((row) * 272 + (cb))
#define KRSWZ(row, cb) ((row) * 144 + (cb))
#define SBAR() __builtin_amdgcn_sched_barrier(0)
__device__ __forceinline__ int crow(int r, int hi) { return (r & 3) + 8 * (r >> 2) + 4 * hi; }
__device__ __forceinline__ void partialSM(f32x16& p0, f32x16& p1, float& m_reg, float& mn, float& alpha) {
  constexpr float C = SCALE * 1.4426950408889634f;
  float pmax = p0[0];
#pragma unroll
  for (int r = 1; r < 16; ++r) pmax = fmaxf(pmax, p0[r]);
#pragma unroll
  for (int r = 0; r < 16; ++r) pmax = fmaxf(pmax, p1[r]);
  { auto rr = __builtin_amdgcn_permlane32_swap(__float_as_uint(pmax), __float_as_uint(pmax), false, false);
    pmax = fmaxf(__uint_as_float(rr[0]), __uint_as_float(rr[1])); }
  if (__builtin_expect(__all(pmax - m_reg <= THR / SCALE), 1)) { mn = m_reg; alpha = 1.f; }
  else { mn = fmaxf(m_reg, pmax); alpha = __builtin_amdgcn_exp2f((m_reg - mn) * C); m_reg = mn; }
  const float mnC = -mn * C;
#pragma unroll
  for (int r = 0; r < 16; ++r) p0[r] = fmaf(p0[r], C, mnC);
#pragma unroll
  for (int r = 0; r < 16; ++r) p1[r] = fmaf(p1[r], C, mnC);
#pragma unroll
  for (int r = 0; r < 16; ++r) p0[r] = __builtin_amdgcn_exp2f(p0[r]);
}
__device__ __forceinline__ void finishSM(f32x16& p0, f32x16& p1, float alpha, float& l_reg, bf16x8& pa0, bf16x8& pa1, bf16x8& pa2, bf16x8& pa3) {
#pragma unroll
  for (int r = 0; r < 16; ++r) p1[r] = __builtin_amdgcn_exp2f(p1[r]);
  float ps = 0;
#pragma unroll
  for (int r = 0; r < 16; ++r) ps += p0[r];
#pragma unroll
  for (int r = 0; r < 16; ++r) ps += p1[r];
  { auto rr = __builtin_amdgcn_permlane32_swap(__float_as_uint(ps), __float_as_uint(ps), false, false);
    ps = __uint_as_float(rr[0]) + __uint_as_float(rr[1]); }
  l_reg = l_reg * alpha + ps;
#define PK4(P, BASE, OUT) do { unsigned a0 = cvt_pk_bf16(P[BASE + 0], P[BASE + 1]), a1 = cvt_pk_bf16(P[BASE + 2], P[BASE + 3]);   \
    unsigned b0 = cvt_pk_bf16(P[BASE + 4], P[BASE + 5]), b1 = cvt_pk_bf16(P[BASE + 6], P[BASE + 7]);                              \
    auto r0 = __builtin_amdgcn_permlane32_swap(a0, b0, false, false); auto r1 = __builtin_amdgcn_permlane32_swap(a1, b1, false, false); \
    u32x4 w = {r0[0], r1[0], r0[1], r1[1]}; OUT = *reinterpret_cast<bf16x8*>(&w); } while (0)
  PK4(p0, 0, pa0); PK4(p0, 8, pa1); PK4(p1, 0, pa2); PK4(p1, 8, pa3);
#undef PK4
}
__device__ __forceinline__ void qkt(f32x16& p0, f32x16& p1, const LAS char* Kn, const LAS char* Kr, const bf16x8 (&qr)[4], const LAS char* Qr, int r32, int hi) {
  p0 = f32x16{}; p1 = f32x16{};
#pragma unroll
  for (int d0 = 0; d0 < 8; ++d0) { const int cb = (d0 * 16 + hi * 8) * 2;
    const bf16x8 b0 = *(const LAS bf16x8*)(Kn + KNSWZ(r32, cb));
    const bf16x8 b1 = *(const LAS bf16x8*)(Kn + KNSWZ(32 + r32, cb));
    bf16x8 qq; if (d0 < 4) qq = qr[d0]; else qq = *(const LAS bf16x8*)(Qr + KNSWZ(r32, ((d0 - 4) * 16 + hi * 8) * 2));
    p0 = __builtin_amdgcn_mfma_f32_32x32x16_bf16(b0, qq, p0, 0, 0, 0);
    p1 = __builtin_amdgcn_mfma_f32_32x32x16_bf16(b1, qq, p1, 0, 0, 0); }
#pragma unroll
  for (int d0 = 0; d0 < 4; ++d0) { const int cb = (d0 * 16 + hi * 8) * 2;
    const bf16x8 b0 = *(const LAS bf16x8*)(Kr + KRSWZ(r32, cb));
    const bf16x8 b1 = *(const LAS bf16x8*)(Kr + KRSWZ(32 + r32, cb));
    const bf16x8 qq = *(const LAS bf16x8*)(Qr + KNSWZ(r32, ((4 + d0) * 16 + hi * 8) * 2));
    p0 = __builtin_amdgcn_mfma_f32_32x32x16_bf16(b0, qq, p0, 0, 0, 0);
    p1 = __builtin_amdgcn_mfma_f32_32x32x16_bf16(b1, qq, p1, 0, 0, 0); }
}
__device__ __forceinline__ int v_st(int k, int c) { const int kk = (k & ~0xC) | ((k & 4) << 1) | ((k & 8) >> 1); return ((kk >> 3) * 4 + (c >> 5)) * 512 + ((kk & 7) * 32 + (c & 31)) * 2; }
__device__ __forceinline__ int v_rd_base(int lane) { return ((lane & 3) << 3) | (((lane >> 2) & 3) << 6) | (((lane >> 4) & 1) << 5) | (((lane >> 5) & 1) << 8); }
constexpr int v_rd_off(int d0, int ks, int half) { return d0 * 512 + ks * 4096 + half * 2048; }
template <int OFF> __device__ __forceinline__ s16x4 tr_read(int vb) {
  s16x4 r; asm volatile("ds_read_b64_tr_b16 %0, %1 offset:%2" : "=&v"(r) : "v"(vb), "i"(OFF) : "memory"); return r;
}
template <int D0> __device__ __forceinline__ void pv_one(f32x16& od, int vb, bf16x8 pa0, bf16x8 pa1, bf16x8 pa2, bf16x8 pa3) {
  const s16x4 l0 = tr_read<v_rd_off(D0, 0, 0)>(vb), h0 = tr_read<v_rd_off(D0, 0, 1)>(vb), l1 = tr_read<v_rd_off(D0, 1, 0)>(vb), h1 = tr_read<v_rd_off(D0, 1, 1)>(vb);
  const s16x4 l2 = tr_read<v_rd_off(D0, 2, 0)>(vb), h2 = tr_read<v_rd_off(D0, 2, 1)>(vb), l3 = tr_read<v_rd_off(D0, 3, 0)>(vb), h3 = tr_read<v_rd_off(D0, 3, 1)>(vb);
  asm volatile("s_waitcnt lgkmcnt(0)" ::: "memory"); SBAR();
#define PK(L, H) (bf16x8){L[0], L[1], L[2], L[3], H[0], H[1], H[2], H[3]}
  od = __builtin_amdgcn_mfma_f32_32x32x16_bf16(pa0, PK(l0, h0), od, 0, 0, 0);
  od = __builtin_amdgcn_mfma_f32_32x32x16_bf16(pa1, PK(l1, h1), od, 0, 0, 0);
  od = __builtin_amdgcn_mfma_f32_32x32x16_bf16(pa2, PK(l2, h2), od, 0, 0, 0);
  od = __builtin_amdgcn_mfma_f32_32x32x16_bf16(pa3, PK(l3, h3), od, 0, 0, 0);
#undef PK
}
__device__ __forceinline__ void pv_d0(f32x16 (&o)[4], int vb, bf16x8 pa0, bf16x8 pa1, bf16x8 pa2, bf16x8 pa3) {
  pv_one<0>(o[0], vb, pa0, pa1, pa2, pa3); pv_one<1>(o[1], vb, pa0, pa1, pa2, pa3); pv_one<2>(o[2], vb, pa0, pa1, pa2, pa3); pv_one<3>(o[3], vb, pa0, pa1, pa2, pa3);
}
__device__ __forceinline__ void attn_unit(const bf16_t* __restrict__ Q, const bf16_t* __restrict__ KV, const bf16_t* __restrict__ KR, bf16_t* __restrict__ MIX,
                                          const float* __restrict__ ropec, const float* __restrict__ ropes, int h, int qrow0, bool lat, int crow0, int lrow0, int NT, LAS char* lds) {
  int tid = threadIdx.x; asm volatile("" : "+v"(tid));
  const int wid = __builtin_amdgcn_readfirstlane(tid >> 6), lane = tid & 63, r32 = lane & 31, hi = lane >> 5;
  LAS char* V_lds = lds + OFF_V; LAS char* KN_lds = lds + OFF_KN; LAS char* KR_lds = lds + OFF_KR;
  LAS float* ws = (LAS float*)(lds + OFF_WS) + wid * 64; LAS float* li_l = ws; LAS float* al_l = ws + 32;
  float m_reg = -1e30f, l_reg = 0; f32x16 o[4] = {}; bf16x8 qr[4];
  LAS char* Qr = lds + OFF_QR + wid * SHM_QW;
  { const int qrow = qrow0 + wid * 32 + r32; const bf16_t* Qw = Q + (size_t)qrow * QW + h * QKD + hi * 8;
#pragma unroll
    for (int d0 = 0; d0 < 4; ++d0) qr[d0] = *(const bf16x8*)(Qw + d0 * 16);
#pragma unroll
    for (int d0 = 4; d0 < 8; ++d0) *(LAS bf16x8*)(Qr + KNSWZ(r32, ((d0 - 4) * 16 + hi * 8) * 2)) = *(const bf16x8*)(Qw + d0 * 16);
    const int n = (qrow - TC) & 4095;
#pragma unroll
    for (int ax = 0; ax < 2; ++ax) {
      const bf16x8 q1 = *(const bf16x8*)(Qw + (8 + 2 * ax) * 16), q2 = *(const bf16x8*)(Qw + (9 + 2 * ax) * 16);
      u32x4 w1 = *reinterpret_cast<const u32x4*>(&q1), w2 = *reinterpret_cast<const u32x4*>(&q2);
      if (lat) { const int pos = ax ? (n & 63) : (n >> 6); const float* cp = ropec + pos * 16 + hi * 8; const float* sp = ropes + pos * 16 + hi * 8;
#pragma unroll
        for (int j = 0; j < 4; ++j) { const float c0 = cp[2 * j], s0 = sp[2 * j], c1 = cp[2 * j + 1], s1 = sp[2 * j + 1];
          const float a0 = bf2f((bf16_t)q1[2 * j]), a1 = bf2f((bf16_t)q1[2 * j + 1]), b0 = bf2f((bf16_t)q2[2 * j]), b1 = bf2f((bf16_t)q2[2 * j + 1]);
          w1[j] = cvt_pk_bf16(a0 * c0 - b0 * s0, a1 * c1 - b1 * s1);
          w2[j] = cvt_pk_bf16(b0 * c0 + a0 * s0, b1 * c1 + a1 * s1); } }
      *(LAS u32x4*)(Qr + KNSWZ(r32, ((4 + 2 * ax) * 16 + hi * 8) * 2)) = w1; *(LAS u32x4*)(Qr + KNSWZ(r32, ((5 + 2 * ax) * 16 + hi * 8) * 2)) = w2; }
  }
  const int sr = tid >> 4, sc = (tid & 15) * 8, vst0 = v_st(sr, sc), vst1 = v_st(32 + sr, sc);
  const int rr = tid >> 3, rc = (tid & 7) * 8;
  const int vb0 = (int)(uintptr_t)V_lds + v_rd_base(lane);
  const bf16_t* KVh = KV + h * 256;
  const int nctx_t = lat ? 4 : NT;
  bf16x8 vs0, vs1, ks0, ks1, krs;
#define TROW(kt) ((kt) < nctx_t ? crow0 + (kt) * 64 : lrow0 + ((kt) - nctx_t) * 64)
#define SLOAD(kt) do { const int _r0 = TROW(kt); const bf16_t* _p0 = KVh + (size_t)(_r0 + sr) * KVW + sc; const bf16_t* _p1 = KVh + (size_t)(_r0 + 32 + sr) * KVW + sc; \
    vs0 = *(const bf16x8*)(_p0 + 128); vs1 = *(const bf16x8*)(_p1 + 128); ks0 = *(const bf16x8*)_p0; ks1 = *(const bf16x8*)_p1; krs = *(const bf16x8*)(KR + (size_t)(_r0 + rr) * ROPE + rc); } while (0)
#define SWRITE(b) do { *(LAS bf16x8*)(V_lds + (b) * SHM_V + vst0) = vs0; *(LAS bf16x8*)(V_lds + (b) * SHM_V + vst1) = vs1; \
    *(LAS bf16x8*)(KN_lds + (b) * SHM_KN + KNSWZ(sr, sc * 2)) = ks0; *(LAS bf16x8*)(KN_lds + (b) * SHM_KN + KNSWZ(32 + sr, sc * 2)) = ks1; \
    *(LAS bf16x8*)(KR_lds + (b) * SHM_KR + KRSWZ(rr, rc * 2)) = krs; } while (0)
#define SWAIT() asm volatile("s_waitcnt vmcnt(0)" ::: "memory")
#define RESC(a) do { if (__any((a) < 1.f)) { if (hi == 0) al_l[r32] = (a); asm volatile("s_waitcnt lgkmcnt(0)" ::: "memory"); \
    _Pragma("unroll") for (int d = 0; d < 4; ++d) _Pragma("unroll") for (int r = 0; r < 16; ++r) o[d][r] *= al_l[crow(r, hi)]; } } while (0)
  f32x16 pA0, pA1, pB0, pB1; float mnA, mnB, alA, alB; bf16x8 pa0, pa1, pa2, pa3;
  SLOAD(0); SWAIT(); SWRITE(0); __syncthreads();
  qkt(pA0, pA1, KN_lds, KR_lds, qr, Qr, r32, hi); partialSM(pA0, pA1, m_reg, mnA, alA);
  SLOAD(1); SWAIT(); SWRITE(1); __syncthreads();
  for (int j = 1; j + 1 < NT; j += 2) {
    SBAR(); qkt(pB0, pB1, KN_lds + SHM_KN, KR_lds + SHM_KR, qr, Qr, r32, hi);
    finishSM(pA0, pA1, alA, l_reg, pa0, pa1, pa2, pa3); SBAR();
    SLOAD(j + 1); SBAR();
    pv_d0(o, vb0, pa0, pa1, pa2, pa3); partialSM(pB0, pB1, m_reg, mnB, alB);
    __syncthreads(); SWAIT(); SWRITE(0);
    RESC(alB); __syncthreads();
    SBAR(); qkt(pA0, pA1, KN_lds, KR_lds, qr, Qr, r32, hi);
    finishSM(pB0, pB1, alB, l_reg, pa0, pa1, pa2, pa3); SBAR();
    SLOAD(j + 2); SBAR();
    pv_d0(o, vb0 + SHM_V, pa0, pa1, pa2, pa3); partialSM(pA0, pA1, m_reg, mnA, alA);
    __syncthreads(); SWAIT(); SWRITE(1);
    RESC(alA); __syncthreads();
  }
  SBAR(); qkt(pB0, pB1, KN_lds + SHM_KN, KR_lds + SHM_KR, qr, Qr, r32, hi);
  finishSM(pA0, pA1, alA, l_reg, pa0, pa1, pa2, pa3); SBAR();
  pv_d0(o, vb0, pa0, pa1, pa2, pa3); partialSM(pB0, pB1, m_reg, mnB, alB);
  __syncthreads(); RESC(alB);
  finishSM(pB0, pB1, alB, l_reg, pa0, pa1, pa2, pa3); SBAR();
  pv_d0(o, vb0 + SHM_V, pa0, pa1, pa2, pa3);
  if (hi == 0) li_l[r32] = l_reg; asm volatile("s_waitcnt lgkmcnt(0)" ::: "memory");
  float rli[16];
#pragma unroll
  for (int r = 0; r < 16; ++r) rli[r] = __builtin_amdgcn_rcpf(li_l[crow(r, hi)]);
  int tid2 = threadIdx.x; asm volatile("" : "+v"(tid2));
  const int r32e = tid2 & 31, hie = (tid2 >> 5) & 1;
  bf16_t* Ow = MIX + (size_t)(qrow0 + wid * 32) * D + h * VD + r32e;
#pragma unroll
  for (int r = 0; r < 16; ++r) { const int orow = crow(r, hie);
#pragma unroll
    for (int d0 = 0; d0 < 4; ++d0) Ow[(size_t)orow * D + d0 * 32] = f2bf(o[d0][r] * rli[r]); }
  __syncthreads();
#undef TROW
#undef SLOAD
#undef SWRITE
#undef SWAIT
#undef RESC
}
}
constexpr int Q5_ATT = 768, Q5_DFT = Q5_ATT + 128, Q5_ATTC = Q5_DFT + 48, Q5_DFTC = Q5_ATTC + 8, Q5_END = Q5_DFTC + CVT_JOBS;
__device__ __forceinline__ void ph_queue5(const Frame& F) {
    unsigned* qhead = (unsigned*)(F.ws + WS_CTL + CW_Q5);
    LAS int* qslot = (LAS int*)(F.lds + 640);
    const bf16_t* Q = WSP(bf16_t, R0_Q); const bf16_t* KV = WSP(bf16_t, R0_KV); const bf16_t* KR = WSP(bf16_t, R0_KR); bf16_t* MIX = WSP(bf16_t, R0_MIX);
    const float* rc = WSP(float, WS_ROPE); const float* rs = rc + 1024;
    for (;;) {
        __syncthreads();
        if (F.tid == 0) qslot[0] = (int)__hip_atomic_fetch_add(qhead, 1u, __ATOMIC_RELAXED, __HIP_MEMORY_SCOPE_AGENT);
        __syncthreads();
        const int it = __builtin_amdgcn_readfirstlane(qslot[0]);
        if (it >= Q5_END) break;
        if (it < Q5_ATT) { const int b = it / 96, rem = it % 96, h = rem / 16, qb = rem % 16;
            att::attn_unit(Q, KV, KR, MIX, rc, rs, h, TC + b * 4096 + qb * 256, true, b * 256, TC + b * 4096, 68, (LAS char*)F.ring); }
        else if (it < Q5_DFT || (it >= Q5_ATTC && it < Q5_DFTC)) {
            const bool lat = it < Q5_DFT; const int i = lat ? it - Q5_ATT : it - Q5_ATTC; const int b = lat ? i >> 4 : i, pm = lat ? i & 15 : 0; const int K = lat ? 4096 : 256;
            pg8::OneUnit S; S.lda = K; S.u0.pm = pm; S.u0.pn = 0; S.u0.e = b; S.u0.cnt = 0;
            S.u0.A = (const char*)(lat ? WSP(bf16_t, R0_DFT) : WSP(bf16_t, R0_DFTC)) + (size_t)pm * 256 * K * 2;
            S.u0.B = (const char*)(lat ? WSP(bf16_t, R0_TT2) : WSP(bf16_t, R0_TTC2)) + (size_t)b * 256 * K * 2;
            pg8::EpiFourOut E{MIX, lat ? TC : 0, lat ? 4096 : 256};
            pg8::gemm_phase<pg8::EpiFourOut, pg8::OneUnit>(F.ring, pg8::Gemm{K, K, K}, S, E); }
        else if (it < Q5_ATTC) { const int uu = it - Q5_DFT, b = uu / 6, h = uu % 6;
            att::attn_unit(Q, KV, KR, MIX, rc, rs, h, b * 256, false, b * 256, 0, 4, (LAS char*)F.ring); }
        else cvt_moe_job(F, (LAS float*)F.ring, F.in[I0_WGU], F.in[I0_WDN], it - Q5_DFTC);
    }
}

__device__ __forceinline__ void load_w32(const Frame& F, LAS float* wl, const float* W, int ldw) {
    for (int i = F.tid; i < 1024 * 8; i += NTHR) { const int r = i >> 3, q = i & 7; const int c = 8 * (r & 63) + 512 * (r >> 9) + ((r >> 6) & 7); const f32x4 v = *(const f32x4*)(W + (size_t)c * ldw + q * 4); *(LAS f32x4*)(wl + r * 36 + q * 4) = v; }
}
__device__ __forceinline__ float row_gemv32(const float (&v)[16], const LAS float* wl, int lane) {
    float p[32];
#pragma unroll
    for (int e = 0; e < 32; ++e) p[e] = 0.f;
#pragma unroll
    for (int i = 0; i < 16; ++i) { const LAS float* wr_ = wl + (lane + 64 * i) * 36;
#pragma unroll
        for (int q = 0; q < 8; ++q) { const f32x4 w = *(const LAS f32x4*)(wr_ + q * 4); p[4 * q] = fmaf(v[i], w[0], p[4 * q]); p[4 * q + 1] = fmaf(v[i], w[1], p[4 * q + 1]); p[4 * q + 2] = fmaf(v[i], w[2], p[4 * q + 2]); p[4 * q + 3] = fmaf(v[i], w[3], p[4 * q + 3]); }
        asm volatile("" ::: "memory"); }
    float a16[16], a8[8], a4[4], a2[2];
    { const bool up = (lane & 32) != 0;
#pragma unroll
      for (int i = 0; i < 16; ++i) { const float send = up ? p[i] : p[i + 16], keep = up ? p[i + 16] : p[i]; a16[i] = keep + __shfl_xor(send, 32); } }
    { const bool up = (lane & 16) != 0;
#pragma unroll
      for (int i = 0; i < 8; ++i) { const float send = up ? a16[i] : a16[i + 8], keep = up ? a16[i + 8] : a16[i]; a8[i] = keep + __shfl_xor(send, 16); } }
    { const bool up = (lane & 8) != 0;
#pragma unroll
      for (int i = 0; i < 4; ++i) { const float send = up ? a8[i] : a8[i + 4], keep = up ? a8[i + 4] : a8[i]; a4[i] = keep + __shfl_xor(send, 8); } }
    { const bool up = (lane & 4) != 0;
#pragma unroll
      for (int i = 0; i < 2; ++i) { const float send = up ? a4[i] : a4[i + 2], keep = up ? a4[i + 2] : a4[i]; a2[i] = keep + __shfl_xor(send, 4); } }
    float a1; { const bool up = (lane & 2) != 0; const float send = up ? a2[0] : a2[1], keep = up ? a2[1] : a2[0]; a1 = keep + __shfl_xor(send, 2); }
    a1 += __shfl_xor(a1, 1);
    return a1;
}
__device__ __forceinline__ void row_gemv32x2(const float (&va)[16], const float (&vb)[16], const LAS float* wl, int lane, float& ya, float& yb) {
    float p[32], q[32];
#pragma unroll
    for (int e = 0; e < 32; ++e) { p[e] = 0.f; q[e] = 0.f; }
#pragma unroll
    for (int i = 0; i < 16; ++i) { const LAS float* wr_ = wl + (lane + 64 * i) * 36;
#pragma unroll
        for (int k = 0; k < 8; ++k) { const f32x4 w = *(const LAS f32x4*)(wr_ + k * 4);
            p[4 * k] = fmaf(va[i], w[0], p[4 * k]); p[4 * k + 1] = fmaf(va[i], w[1], p[4 * k + 1]); p[4 * k + 2] = fmaf(va[i], w[2], p[4 * k + 2]); p[4 * k + 3] = fmaf(va[i], w[3], p[4 * k + 3]);
            q[4 * k] = fmaf(vb[i], w[0], q[4 * k]); q[4 * k + 1] = fmaf(vb[i], w[1], q[4 * k + 1]); q[4 * k + 2] = fmaf(vb[i], w[2], q[4 * k + 2]); q[4 * k + 3] = fmaf(vb[i], w[3], q[4 * k + 3]); }
        asm volatile("" ::: "memory"); }
    float a16[16], b16[16], a8[8], b8[8], a4[4], b4[4], a2[2], b2[2];
    { const bool up = (lane & 32) != 0;
#pragma unroll
      for (int i = 0; i < 16; ++i) { a16[i] = (up ? p[i + 16] : p[i]) + __shfl_xor(up ? p[i] : p[i + 16], 32); b16[i] = (up ? q[i + 16] : q[i]) + __shfl_xor(up ? q[i] : q[i + 16], 32); } }
    { const bool up = (lane & 16) != 0;
#pragma unroll
      for (int i = 0; i < 8; ++i) { a8[i] = (up ? a16[i + 8] : a16[i]) + __shfl_xor(up ? a16[i] : a16[i + 8], 16); b8[i] = (up ? b16[i + 8] : b16[i]) + __shfl_xor(up ? b16[i] : b16[i + 8], 16); } }
    { const bool up = (lane & 8) != 0;
#pragma unroll
      for (int i = 0; i < 4; ++i) { a4[i] = (up ? a8[i + 4] : a8[i]) + __shfl_xor(up ? a8[i] : a8[i + 4], 8); b4[i] = (up ? b8[i + 4] : b8[i]) + __shfl_xor(up ? b8[i] : b8[i + 4], 8); } }
    { const bool up = (lane & 4) != 0;
#pragma unroll
      for (int i = 0; i < 2; ++i) { a2[i] = (up ? a4[i + 2] : a4[i]) + __shfl_xor(up ? a4[i] : a4[i + 2], 4); b2[i] = (up ? b4[i + 2] : b4[i]) + __shfl_xor(up ? b4[i] : b4[i + 2], 4); } }
    { const bool up = (lane & 2) != 0; ya = (up ? a2[1] : a2[0]) + __shfl_xor(up ? a2[0] : a2[1], 2); yb = (up ? b2[1] : b2[0]) + __shfl_xor(up ? b2[0] : b2[1], 2); }
    ya += __shfl_xor(ya, 1); yb += __shfl_xor(yb, 1);
}
__device__ __forceinline__ void ph_router(const Frame& F, int layer, int r0) {
    typedef float f32x16 __attribute__((ext_vector_type(16)));
    constexpr int HROW = 2064;
    LAS char* HHI = (LAS char*)F.ring; LAS char* HLO = HHI + 32 * HROW; LAS float* RED = (LAS float*)F.ring;
    LAS float* SCR = (LAS float*)(F.ring + 2 * 32 * HROW);
    LAS unsigned* lcnt = (LAS unsigned*)(F.lds + 512);
    const float* g = F.in[layer ? I1_N2G : I0_N2G]; const float* rb_ = F.in[layer ? I1_RB : I0_RB];
    if (F.tid < 64) lcnt[F.tid] = 0u;
    __syncthreads();
    bf16_t* H = WSP(bf16_t, WS_H); unsigned* cnt = (unsigned*)(F.ws + WS_CTL + CW_CNT) + layer * 64;
    int* list = WSP(int, WS_LIST); int* toke = WSP(int, WS_TOKE); int* tokp = WSP(int, WS_TOKP); float* tokg = WSP(float, WS_TOKG);
    const float* modv = WSP(float, WS_MODV) + (size_t)layer * 9 * 6144;
    const bf16_t* WT = WSP(bf16_t, WS_RWT) + (size_t)layer * 2 * 32 * 1024;
    const bf16_t* Yb = layer == 0 ? WSP(bf16_t, R0_U0) : WSP(bf16_t, R1_OF) - (size_t)TC * D;
    const int per = (T - r0 + F.G - 1) / F.G; const int rbeg = r0 + F.bid * per; const int rend = (rbeg + per < T) ? rbeg + per : T;
    const int lane = F.lane, wave = F.wave, r32 = lane & 31, hi2 = lane >> 5;
    float gg[16]; ld16f(g, lane, gg);
    float scv[16], shv[16]; int curm = -1;
    for (int tb = rbeg; tb < rend; tb += 32) {
        f32x4 xr[4][4]; u32x4 yr[4][2];
#pragma unroll
        for (int q = 0; q < 4; ++q) { int r = tb + 4 * wave + q; r = r < rend ? r : rend - 1; const float* xp = layer == 0 ? xrow_in(F, r) : xrow_res(F, r); const bf16_t* yp = Yb + (size_t)r * D;
#pragma unroll
            for (int h = 0; h < 2; ++h) { xr[q][2 * h] = *(const f32x4*)(xp + 8 * lane + 512 * h); xr[q][2 * h + 1] = *(const f32x4*)(xp + 8 * lane + 512 * h + 4); yr[q][h] = *(const u32x4*)(yp + 8 * lane + 512 * h); } }
#pragma unroll
        for (int q = 0; q < 4; ++q) { const int tr = 4 * wave + q, r = tb + tr;
            if (r < rend) {
            float v[16];
#pragma unroll
            for (int h = 0; h < 2; ++h) {
#pragma unroll
                for (int k = 0; k < 4; ++k) { v[8 * h + 2 * k] = xr[q][2 * h + (k >> 1)][2 * (k & 1)] + __uint_as_float(yr[q][h][k] << 16); v[8 * h + 2 * k + 1] = xr[q][2 * h + (k >> 1)][2 * (k & 1) + 1] + __uint_as_float(yr[q][h][k] & 0xffff0000u); } }
            st16f(xrow_res(F, r), lane, v);
            float ss = 0.f;
#pragma unroll
            for (int i = 0; i < 16; ++i) ss = fmaf(v[i], v[i], ss);
            const float rs = rsqrtf(wsum(ss) * (1.0f / D) + EPS);
            const int m = modrow(r);
            if (m != curm) { const float* mv = modv + (size_t)m * 6144; ld16f(mv + 4096, lane, scv); ld16f(mv + 3072, lane, shv); curm = m; }
#pragma unroll
            for (int i = 0; i < 16; ++i) v[i] = v[i] * rs * gg[i] * (1.0f + scv[i]) + shv[i];
#pragma unroll
            for (int h = 0; h < 2; ++h) { u32x4 whi, wlo;
#pragma unroll
                for (int k = 0; k < 4; ++k) { const unsigned ph = cvt_pk_bf16(v[8 * h + 2 * k], v[8 * h + 2 * k + 1]); whi[k] = ph;
                    wlo[k] = cvt_pk_bf16(v[8 * h + 2 * k] - __uint_as_float(ph << 16), v[8 * h + 2 * k + 1] - __uint_as_float(ph & 0xffff0000u)); }
                *(u32x4*)(H + (size_t)r * D + 8 * lane + 512 * h) = whi;
                *(LAS u32x4*)(HHI + tr * HROW + (8 * lane + 512 * h) * 2) = whi; *(LAS u32x4*)(HLO + tr * HROW + (8 * lane + 512 * h) * 2) = wlo; } } }
        __syncthreads();
        f32x16 acc = {};
        { const LAS char* ah = HHI + r32 * HROW + (wave * 128 + hi2 * 8) * 2; const LAS char* al = HLO + r32 * HROW + (wave * 128 + hi2 * 8) * 2;
          const bf16_t* wh = WT + (size_t)r32 * 1024 + wave * 128 + hi2 * 8; const bf16_t* wlp = wh + 32 * 1024;
#pragma unroll
          for (int sst = 0; sst < 8; ++sst) { const bf16x8 a_h = *(const LAS bf16x8*)(ah + sst * 32), a_l = *(const LAS bf16x8*)(al + sst * 32);
              const bf16x8 b_h = *(const bf16x8*)(wh + sst * 16), b_l = *(const bf16x8*)(wlp + sst * 16);
              acc = __builtin_amdgcn_mfma_f32_32x32x16_bf16(a_h, b_h, acc, 0, 0, 0);
              acc = __builtin_amdgcn_mfma_f32_32x32x16_bf16(a_h, b_l, acc, 0, 0, 0);
              acc = __builtin_amdgcn_mfma_f32_32x32x16_bf16(a_l, b_h, acc, 0, 0, 0); } }
        __syncthreads();
#pragma unroll
        for (int r = 0; r < 16; ++r) { const int row = (r & 3) + 8 * (r >> 2) + 4 * hi2; RED[(wave * 32 + row) * 32 + r32] = acc[r]; }
        __syncthreads();
#pragma unroll 1
        for (int pq = 0; pq < 2; ++pq) { const int tr = 4 * wave + 2 * pq + hi2, r = tb + tr; const int e = r32;
            float lg = rb_[e];
#pragma unroll
            for (int w8 = 0; w8 < 8; ++w8) lg += RED[(w8 * 32 + tr) * 32 + e];
            LAS float* sc_ = SCR + tr * 40;
            sc_[e] = lg;
            asm volatile("s_waitcnt lgkmcnt(0)" ::: "memory");
            int rank = 0;
#pragma unroll
            for (int q8 = 0; q8 < 8; ++q8) { const f32x4 v4 = *(const LAS f32x4*)(sc_ + 4 * q8);
#pragma unroll
                for (int j = 0; j < 4; ++j) rank += (int)((v4[j] > lg) | ((v4[j] == lg) & ((4 * q8 + j) < e))); }
            if (rank < 4) { sc_[32 + rank] = lg; ((LAS int*)sc_)[36 + rank] = e; }
            asm volatile("s_waitcnt lgkmcnt(0)" ::: "memory");
            const f32x4 tvv = *(const LAS f32x4*)(sc_ + 32); const u32x4 tev = *(const LAS u32x4*)(sc_ + 36);
            asm volatile("s_waitcnt lgkmcnt(0)" ::: "memory");
            const float e1 = __expf(tvv[1] - tvv[0]), e2 = __expf(tvv[2] - tvv[0]), e3 = __expf(tvv[3] - tvv[0]); const float inv = 1.0f / (1.0f + e1 + e2 + e3);
            if (r32 < 4 && r < rend) { const int k = r32; const int ek = (int)(k == 0 ? tev[0] : k == 1 ? tev[1] : k == 2 ? tev[2] : tev[3]); const float gk = (k == 0 ? 1.0f : k == 1 ? e1 : k == 2 ? e2 : e3) * inv;
                const unsigned lp = __hip_atomic_fetch_add(lcnt + ek, 1u, __ATOMIC_RELAXED, __HIP_MEMORY_SCOPE_WORKGROUP);
                toke[r * 4 + k] = ek; tokp[r * 4 + k] = (int)lp; tokg[r * 4 + k] = gk; } }
        __syncthreads();
    }
    __syncthreads();
    if (F.tid < 32) { const unsigned c = lcnt[F.tid]; lcnt[32 + F.tid] = c ? __hip_atomic_fetch_add(cnt + F.tid, c, __ATOMIC_RELAXED, __HIP_MEMORY_SCOPE_AGENT) : 0u; }
    __syncthreads();
    for (int i = rbeg * 4 + F.tid; i < rend * 4; i += NTHR) {
        const int ek = __hip_atomic_load(toke + i, __ATOMIC_RELAXED, __HIP_MEMORY_SCOPE_AGENT); const int pos = __hip_atomic_load(tokp + i, __ATOMIC_RELAXED, __HIP_MEMORY_SCOPE_AGENT) + (int)lcnt[32 + ek]; tokp[i] = pos; list[(size_t)ek * T + pos] = i >> 2; }
}
__device__ __forceinline__ int moe_tstart(const Frame& F, int layer, LAS int* tstart) {
    unsigned* cnt = (unsigned*)(F.ws + WS_CTL + CW_CNT) + layer * 64;
    __syncthreads();
    if (F.tid == 0) { int s = 0; for (int e = 0; e < NE; ++e) { const int c = (int)__hip_atomic_load(cnt + e, __ATOMIC_RELAXED, __HIP_MEMORY_SCOPE_AGENT); tstart[e] = s; tstart[40 + e] = c; s += (c + 255) >> 8; } tstart[NE] = s; }
    __syncthreads();
    { LAS int* t2e = (LAS int*)(F.ring + 140000); const int nt = tstart[NE];
      for (int t = F.tid; t < nt; t += NTHR) { int e = 0; for (int j = 1; j < NE; ++j) e += (t >= tstart[j]) ? 1 : 0; t2e[t] = e; } }
    __syncthreads();
    return __builtin_amdgcn_readfirstlane(tstart[NE]);
}
__device__ __forceinline__ void ph_moe1(const Frame& F, int layer) {
    LAS int* tstart = (LAS int*)(F.lds + 64); const int ntile = moe_tstart(F, layer, tstart);
    pg8::MoeOrder<true> S; S.A = (const char*)WSP(bf16_t, WS_H); S.B = (const char*)WSP(bf16_t, WS_WGU); S.sB = (size_t)2048 * 1024 * 2; S.lda = D; S.ldb = D; S.npn = 8; S.nwg = ntile * 8; S.G = F.G; S.c = F.bid;
    S.tstart = tstart; S.cnt = tstart + 40; S.list = WSP(int, WS_LIST); S.t2e = (const LAS int*)(F.ring + 140000);
    pg8::EpiSwiglu E{WSP(bf16_t, WS_ACT), F.in[layer ? I1_BGU : I0_BGU]};
    pg8::gemm_phase<pg8::EpiSwiglu, pg8::MoeOrder<true>>(F.ring, pg8::Gemm{D, D, D}, S, E);
}
__device__ __forceinline__ void ph_moe2(const Frame& F, int layer) {
    LAS int* tstart = (LAS int*)(F.lds + 64); const int ntile = moe_tstart(F, layer, tstart);
    pg8::MoeOrder<false> S; S.A = (const char*)WSP(bf16_t, WS_ACT); S.B = (const char*)WSP(bf16_t, WS_WDN); S.sB = (size_t)1024 * 1024 * 2; S.lda = FF; S.ldb = FF; S.npn = 4; S.nwg = ntile * 4; S.G = F.G; S.c = F.bid;
    S.tstart = tstart; S.cnt = tstart + 40; S.list = nullptr; S.t2e = (const LAS int*)(F.ring + 140000);
    pg8::EpiDown E{WSP(bf16_t, RM_YB), F.in[layer ? I1_BDN : I0_BDN]};
    pg8::gemm_phase<pg8::EpiDown, pg8::MoeOrder<false>>(F.ring, pg8::Gemm{FF, FF, FF}, S, E);
}
__device__ __forceinline__ void moe_combine_row(const Frame& F, int layer, int r, const LAS int* tstart, float (&v)[16]) {
    const int* toke = WSP(int, WS_TOKE); const int* tokp = WSP(int, WS_TOKP); const float* tokg = WSP(float, WS_TOKG); const bf16_t* YB = WSP(bf16_t, RM_YB);
    const float* g2 = WSP(float, WS_MODV) + (size_t)(layer * 9 + modrow(r)) * 6144 + 5120;
    float y[16];
#pragma unroll
    for (int i = 0; i < 16; ++i) y[i] = 0.f;
#pragma unroll
    for (int k = 0; k < 4; ++k) { const int e = toke[r * 4 + k]; const size_t prow = (size_t)tstart[e] * 256 + tokp[r * 4 + k]; const float gk = tokg[r * 4 + k]; float yy[16]; ld16b(YB + prow * D, F.lane, yy);
#pragma unroll
        for (int i = 0; i < 16; ++i) y[i] = fmaf(gk, yy[i], y[i]); }
    float gg[16]; ld16f(g2, F.lane, gg); ld16f(xrow_res(F, r), F.lane, v);
#pragma unroll
    for (int i = 0; i < 16; ++i) v[i] = fmaf(gg[i], y[i], v[i]);
}
__device__ __forceinline__ void ph_combine_mod1(const Frame& F) {
    LAS int* tstart = (LAS int*)(F.lds + 64); moe_tstart(F, 0, tstart);
    LAS float* wl = (LAS float*)F.ring;
    load_w32(F, wl, F.in[I1_WIN] + 3072, 3104);
    __syncthreads();
    const float* g = F.in[I1_N1G]; bf16_t* H = WSP(bf16_t, WS_H); float* GD = WSP(float, WS_GD);
    const float* modv = WSP(float, WS_MODV) + (size_t)9 * 6144;
    for (int r = F.bid * NWAVE + F.wave; r < T; r += F.G * NWAVE) {
        float v[16]; moe_combine_row(F, 0, r, tstart, v);
        const float* mv = modv + (size_t)modrow(r) * 6144;
        st16f(xrow_res(F, r), F.lane, v);
        modulate16(v, g, mv + 1024, mv, F.lane);
        st16b(H + (size_t)r * D, F.lane, v);
        const float gd = row_gemv32(v, wl, F.lane);
        if ((F.lane & 1) == 0) GD[(size_t)r * 32 + (F.lane >> 1)] = gd;
    }
    __syncthreads();
    cvt_moe_weights(F, (LAS float*)F.ring, F.in[I1_WGU], F.in[I1_WDN]);
}
__device__ __forceinline__ void ph_final(const Frame& F) {
    LAS int* tstart = (LAS int*)(F.lds + 64); moe_tstart(F, 1, tstart);
    const float* g = F.in[I_FNG];
    for (int r = TC + F.bid * NWAVE + F.wave; r < T; r += F.G * NWAVE) {
        float v[16]; moe_combine_row(F, 1, r, tstart, v); float ss = 0.f;
#pragma unroll
        for (int i = 0; i < 16; ++i) ss = fmaf(v[i], v[i], ss);
        const float rs = rsqrtf(wsum(ss) * (1.0f / D) + EPS); float gg[16]; ld16f(g, F.lane, gg);
#pragma unroll
        for (int i = 0; i < 16; ++i) v[i] = v[i] * rs * gg[i];
        st16f(F.out + (size_t)(r - TC) * D, F.lane, v);
    }
}

namespace gla3 {
using att::f32x16; using att::s16x4; using att::crow; using att::v_st; using att::v_rd_base; using att::v_rd_off; using att::tr_read;
constexpr int ROWB = 272;
constexpr int P_GD = 0, P_TOT = 4096, P_WG = 8192;
constexpr int O_QD = 0, O_KD = 17408, O_KS = 34816, O_VV = 51200, O_ST = 67584, O_DEC = 102400;
constexpr size_t TILE_B = 64 * 128 * 2, ITEM_B = 2 * TILE_B;
#define GPK(L, H) (bf16x8){L[0], L[1], L[2], L[3], H[0], H[1], H[2], H[3]}
#define CH_ROW0(b, dir, cc) ((cc) < 4 ? ((b) * 256 + ((dir) ? 3 - (cc) : (cc)) * 64) : (TC + (b) * 4096 + ((dir) ? 67 - (cc) : (cc) - 4) * 64))
#define TOK(dir, jj) ((dir) ? 63 - (jj) : (jj))
__device__ __forceinline__ void pre_phase(const Frame& F) {
  LAS char* lds = (LAS char*)F.ring;
  int tid = threadIdx.x; asm volatile("" : "+v"(tid));
  const int wid = __builtin_amdgcn_readfirstlane(tid >> 6), lane = tid & 63;
  LAS float* gds = (LAS float*)(lds + P_GD); LAS float* tot = (LAS float*)(lds + P_TOT); LAS float* wgall = (LAS float*)(lds + P_WG);
  const bf16_t* U1 = WSP(bf16_t, R1_U1); const float* GD = WSP(float, WS_GD);
  char* tiles = (char*)(F.ws + WS_ACT); float* decbuf = (float*)(F.ws + WS_ACT + (size_t)4352 * ITEM_B);
  for (int i = tid; i < 8 * 17 * 128; i += NTHR) { const int tb = i / (17 * 128), rem = i % (17 * 128), r = rem >> 7, d = rem & 127, hd = tb >> 1, dir = tb & 1;
    const float* Wg = dir ? F.in[I1_WGKB] : F.in[I1_WGKF]; const float* Bg = dir ? F.in[I1_BGKB] : F.in[I1_BGKF]; wgall[i] = (r < 16) ? Wg[r * 512 + hd * 128 + d] : Bg[hd * 128 + d]; }
  const int d0 = 2 * lane, tg = wid, gj = tid >> 3, gr = (tid & 7) * 2;
  unsigned qreg[8], kreg[8]; f32x2 gdreg;
#define PLOAD(u) do { const int _cc = (u) % 68, _s = (u) / 68, _dir = _s & 1, _hd = (_s >> 1) & 3, _b = _s >> 3; const int _r0 = CH_ROW0(_b, _dir, _cc); \
    const bf16_t* _uq = U1 + _hd * 128 + d0; \
    _Pragma("unroll") for (int i = 0; i < 8; ++i) { const bf16_t* _p = _uq + (size_t)(_r0 + TOK(_dir, 8 * tg + i)) * U1W; qreg[i] = *(const unsigned*)_p; kreg[i] = *(const unsigned*)(_p + 512); } \
    gdreg = *(const f32x2*)(GD + (size_t)(_r0 + TOK(_dir, gj)) * 32 + _dir * 16 + gr); } while (0)
  int u = F.bid;
  if (u < 4352) PLOAD(u);
  __syncthreads();
  for (; u < 4352; u += F.G) {
    const int sc = u / 68, dir = sc & 1, hd = (sc >> 1) & 3;
    const LAS float* wg = wgall + (hd * 2 + dir) * 17 * 128;
    *(LAS f32x2*)(gds + gj * 16 + gr) = gdreg;
    __syncthreads();
    float cl0[8], cl1[8];
    { float z0[8], z1[8]; const f32x2 bb = *(const LAS f32x2*)(wg + 16 * 128 + d0);
#pragma unroll
      for (int i = 0; i < 8; ++i) { z0[i] = bb[0]; z1[i] = bb[1]; }
#pragma unroll
      for (int r4 = 0; r4 < 4; ++r4) { f32x2 w[4];
#pragma unroll
        for (int q = 0; q < 4; ++q) w[q] = *(const LAS f32x2*)(wg + (4 * r4 + q) * 128 + d0);
#pragma unroll
        for (int i = 0; i < 8; ++i) { const f32x4 g4 = *(const LAS f32x4*)(gds + (8 * tg + i) * 16 + 4 * r4);
#pragma unroll
          for (int q = 0; q < 4; ++q) { z0[i] = fmaf(g4[q], w[q][0], z0[i]); z1[i] = fmaf(g4[q], w[q][1], z1[i]); } } }
      float a0 = 0.f, a1 = 0.f;
#pragma unroll
      for (int i = 0; i < 8; ++i) { const float l0 = fminf(z0[i], 0.f) - __logf(1.0f + __expf(-fabsf(z0[i]))), l1 = fminf(z1[i], 0.f) - __logf(1.0f + __expf(-fabsf(z1[i])));
        a0 += l0 * (1.0f / 16.0f); a1 += l1 * (1.0f / 16.0f); cl0[i] = a0; cl1[i] = a1; }
      *(LAS f32x2*)(tot + tg * 128 + d0) = (f32x2){a0, a1}; }
    __syncthreads();
    { float off0 = 0.f, off1 = 0.f, last0 = 0.f, last1 = 0.f;
#pragma unroll
      for (int g = 0; g < 8; ++g) { const f32x2 tv = *(const LAS f32x2*)(tot + g * 128 + d0); if (g < tg) { off0 += tv[0]; off1 += tv[1]; } last0 += tv[0]; last1 += tv[1]; }
      const float el0 = __expf(last0), el1 = __expf(last1);
      if (tg == 0) *(f32x2*)(decbuf + (size_t)u * 128 + d0) = (f32x2){el0, el1};
      char* it = tiles + (size_t)u * ITEM_B + d0 * 2;
#pragma unroll
      for (int i = 0; i < 8; ++i) { const int jj = 8 * tg + i; const float e0 = __expf(off0 + cl0[i]), e1 = __expf(off1 + cl1[i]); const float r0 = __builtin_amdgcn_rcpf(e0), r1 = __builtin_amdgcn_rcpf(e1);
        const float q0 = __uint_as_float(qreg[i] << 16), q1 = __uint_as_float(qreg[i] & 0xffff0000u), k0 = __uint_as_float(kreg[i] << 16), k1 = __uint_as_float(kreg[i] & 0xffff0000u);
        *(unsigned*)(it + jj * 256) = cvt_pk_bf16(q0 * e0, q1 * e1);
        *(unsigned*)(it + TILE_B + jj * 256) = cvt_pk_bf16(k0 * r0, k1 * r1); } }
    if (u + F.G < 4352) PLOAD(u + F.G);
    __syncthreads();
  }
#undef PLOAD
}
constexpr int SB_QD = 0, SB_KD = 16384, SB_VV = 32768, SB_DEC = 40960, SB_BYTES = 41984, O_ST2 = 3 * SB_BYTES;
constexpr int vc_off(int d0, int ks, int half) { return d0 * 512 + ks * 2048 + half * 1024; }
struct SeqCtx { LAS char* lds; const char* tiles; const char* decb; const bf16_t* Uv; bf16_t* OUT; unsigned sQ[2], sK[2], ldsw; int vk, b, dir, hd, dvs, wid, lane, r32, hi, trb, xq, eb, db, kdo; };
#define DMA16(gptr, ldsoff) __builtin_amdgcn_global_load_lds((const unsigned*)(gptr), (LAS unsigned*)(C.lds + (ldsoff)), 16, 0, 0)
__device__ __forceinline__ void seq_issue(const SeqCtx& C, int cc) {
    const int bo = (cc % 3) * SB_BYTES; const char* t = C.tiles + (size_t)cc * ITEM_B;
    DMA16(t + C.sQ[0], bo + SB_QD + C.ldsw); DMA16(t + C.sQ[1], bo + SB_QD + 8192 + C.ldsw);
    DMA16(t + TILE_B + C.sK[0], bo + SB_KD + C.ldsw); DMA16(t + TILE_B + C.sK[1], bo + SB_KD + 8192 + C.ldsw);
    DMA16(C.Uv + (size_t)(CH_ROW0(C.b, C.dir, cc) + TOK(C.dir, C.vk)) * U1W, bo + SB_VV + C.ldsw);
    if (C.wid == 7) DMA16(C.decb + (size_t)cc * 512 + C.lane * 16, bo + SB_DEC);
}
#undef DMA16
template <int IB> __device__ __forceinline__ void seq_out_loop(const SeqCtx& C) {
  const int r32 = C.r32, hi = C.hi, xq = C.xq;
  for (int cc = 0; cc < 68; ++cc) {
    if (cc >= 6 && cc < 67) asm volatile("s_waitcnt vmcnt(37)" ::: "memory"); else if (cc >= 1 && cc < 67) asm volatile("s_waitcnt vmcnt(5)" ::: "memory"); else asm volatile("s_waitcnt vmcnt(0)" ::: "memory");
    asm volatile("s_waitcnt lgkmcnt(0)" ::: "memory");
    __builtin_amdgcn_s_barrier();
    asm volatile("" ::: "memory");
    if (cc + 2 < 68) seq_issue(C, cc + 2);
    if (cc < 4) continue;
    const LAS char* sb = C.lds + (cc % 3) * SB_BYTES;
    const LAS char* STp = C.lds + O_ST2 + ((cc + 1) & 1) * 17408;
    f32x16 p0 = {}, p1 = {}, o = {};
    const LAS char* QDr = sb + SB_QD + (32 * IB + r32) * 256; const LAS char* KDr = sb + SB_KD + C.kdo;
#pragma unroll
    for (int k = 0; k < 8; ++k) { const int po = (k << 5) ^ xq; const bf16x8 qf = *(const LAS bf16x8*)(QDr + po); const bf16x8 k0f = *(const LAS bf16x8*)(KDr + (k >> 1) * 512 + (k & 1) * 32);
      p0 = __builtin_amdgcn_mfma_f32_32x32x16_bf16(k0f, qf, p0, 0, 0, 0);
      if (IB) { const bf16x8 k1f = *(const LAS bf16x8*)(KDr + 8192 + (k >> 1) * 512 + (k & 1) * 32); p1 = __builtin_amdgcn_mfma_f32_32x32x16_bf16(k1f, qf, p1, 0, 0, 0); } }
#pragma unroll
    for (int r = 0; r < 16; ++r) { const bool kill = crow(r, hi) > r32; if (IB == 0) p0[r] = kill ? 0.f : p0[r]; else p1[r] = kill ? 0.f : p1[r]; }
    bf16x8 pa0, pa1, pa2, pa3;
#define PK4(P, BASE, OUT_) do { unsigned a0 = cvt_pk_bf16(P[BASE + 0], P[BASE + 1]), a1 = cvt_pk_bf16(P[BASE + 2], P[BASE + 3]);   \
    unsigned b0 = cvt_pk_bf16(P[BASE + 4], P[BASE + 5]), b1 = cvt_pk_bf16(P[BASE + 6], P[BASE + 7]);                              \
    auto r0 = __builtin_amdgcn_permlane32_swap(a0, b0, false, false); auto r1 = __builtin_amdgcn_permlane32_swap(a1, b1, false, false); \
    u32x4 w = {r0[0], r1[0], r0[1], r1[1]}; OUT_ = *reinterpret_cast<bf16x8*>(&w); } while (0)
    PK4(p0, 0, pa0); PK4(p0, 8, pa1); if (IB) { PK4(p1, 0, pa2); PK4(p1, 8, pa3); }
#undef PK4
    { const int vb = (int)(uintptr_t)(sb + SB_VV) + C.trb + C.eb * 512;
      const s16x4 l0 = tr_read<vc_off(0, 0, 0)>(vb), h0 = tr_read<vc_off(0, 0, 1)>(vb), l1 = tr_read<vc_off(0, 1, 0)>(vb), h1 = tr_read<vc_off(0, 1, 1)>(vb);
      s16x4 l2, h2, l3, h3;
      if (IB) { l2 = tr_read<vc_off(0, 2, 0)>(vb); h2 = tr_read<vc_off(0, 2, 1)>(vb); l3 = tr_read<vc_off(0, 3, 0)>(vb); h3 = tr_read<vc_off(0, 3, 1)>(vb); }
      asm volatile("s_waitcnt lgkmcnt(0)" ::: "memory"); __builtin_amdgcn_sched_barrier(0);
      o = __builtin_amdgcn_mfma_f32_32x32x16_bf16(pa0, GPK(l0, h0), o, 0, 0, 0);
      o = __builtin_amdgcn_mfma_f32_32x32x16_bf16(pa1, GPK(l1, h1), o, 0, 0, 0);
      if (IB) { o = __builtin_amdgcn_mfma_f32_32x32x16_bf16(pa2, GPK(l2, h2), o, 0, 0, 0);
                o = __builtin_amdgcn_mfma_f32_32x32x16_bf16(pa3, GPK(l3, h3), o, 0, 0, 0); } }
    { const LAS char* STr = STp + (32 * C.eb + r32) * ROWB + hi * 16;
#pragma unroll
      for (int k = 0; k < 8; ++k) { const bf16x8 qf = *(const LAS bf16x8*)(QDr + ((k << 5) ^ xq)); const bf16x8 sf = *(const LAS bf16x8*)(STr + k * 32);
        o = __builtin_amdgcn_mfma_f32_32x32x16_bf16(qf, sf, o, 0, 0, 0); } }
    bf16_t* op = C.OUT + (size_t)(CH_ROW0(C.b, C.dir, cc) - TC) * D + C.hd * 256 + C.dvs * 64 + 32 * C.eb + r32;
#pragma unroll
    for (int r = 0; r < 16; ++r) { const int i = 32 * IB + crow(r, hi); op[(size_t)TOK(C.dir, i) * D] = f2bf(o[r]); }
  }
}
__device__ __forceinline__ void seq_state_loop(const SeqCtx& C) {
  const int r32 = C.r32, hi = C.hi, db = C.db;
  f32x16 S0 = {}, S1 = {};
  for (int cc = 0; cc < 68; ++cc) {
    if (cc >= 1 && cc < 67) { if (C.wid == 7) asm volatile("s_waitcnt vmcnt(6)" ::: "memory"); else asm volatile("s_waitcnt vmcnt(5)" ::: "memory"); } else asm volatile("s_waitcnt vmcnt(0)" ::: "memory");
    asm volatile("s_waitcnt lgkmcnt(0)" ::: "memory");
    __builtin_amdgcn_s_barrier();
    asm volatile("" ::: "memory");
    if (cc + 2 < 68) seq_issue(C, cc + 2);
    const LAS char* sb = C.lds + (cc % 3) * SB_BYTES;
    LAS char* STn = C.lds + O_ST2 + (cc & 1) * 17408;
    const int kb = (int)(uintptr_t)(sb + SB_KD) + C.trb + db * 512, vb = (int)(uintptr_t)(sb + SB_VV) + C.trb;
    { const s16x4 al0 = tr_read<v_rd_off(0, 0, 0)>(kb), ah0 = tr_read<v_rd_off(0, 0, 1)>(kb), al1 = tr_read<v_rd_off(0, 1, 0)>(kb), ah1 = tr_read<v_rd_off(0, 1, 1)>(kb);
      const s16x4 al2 = tr_read<v_rd_off(0, 2, 0)>(kb), ah2 = tr_read<v_rd_off(0, 2, 1)>(kb), al3 = tr_read<v_rd_off(0, 3, 0)>(kb), ah3 = tr_read<v_rd_off(0, 3, 1)>(kb);
      const s16x4 bl0 = tr_read<vc_off(0, 0, 0)>(vb), bh0 = tr_read<vc_off(0, 0, 1)>(vb), bl1 = tr_read<vc_off(0, 1, 0)>(vb), bh1 = tr_read<vc_off(0, 1, 1)>(vb);
      const s16x4 bl2 = tr_read<vc_off(0, 2, 0)>(vb), bh2 = tr_read<vc_off(0, 2, 1)>(vb), bl3 = tr_read<vc_off(0, 3, 0)>(vb), bh3 = tr_read<vc_off(0, 3, 1)>(vb);
      const s16x4 cl0_ = tr_read<vc_off(1, 0, 0)>(vb), ch0 = tr_read<vc_off(1, 0, 1)>(vb), cl1_ = tr_read<vc_off(1, 1, 0)>(vb), ch1 = tr_read<vc_off(1, 1, 1)>(vb);
      const s16x4 cl2 = tr_read<vc_off(1, 2, 0)>(vb), ch2 = tr_read<vc_off(1, 2, 1)>(vb), cl3 = tr_read<vc_off(1, 3, 0)>(vb), ch3 = tr_read<vc_off(1, 3, 1)>(vb);
      asm volatile("s_waitcnt lgkmcnt(0)" ::: "memory"); __builtin_amdgcn_sched_barrier(0);
      S0 = __builtin_amdgcn_mfma_f32_32x32x16_bf16(GPK(al0, ah0), GPK(bl0, bh0), S0, 0, 0, 0); S1 = __builtin_amdgcn_mfma_f32_32x32x16_bf16(GPK(al0, ah0), GPK(cl0_, ch0), S1, 0, 0, 0);
      S0 = __builtin_amdgcn_mfma_f32_32x32x16_bf16(GPK(al1, ah1), GPK(bl1, bh1), S0, 0, 0, 0); S1 = __builtin_amdgcn_mfma_f32_32x32x16_bf16(GPK(al1, ah1), GPK(cl1_, ch1), S1, 0, 0, 0);
      S0 = __builtin_amdgcn_mfma_f32_32x32x16_bf16(GPK(al2, ah2), GPK(bl2, bh2), S0, 0, 0, 0); S1 = __builtin_amdgcn_mfma_f32_32x32x16_bf16(GPK(al2, ah2), GPK(cl2, ch2), S1, 0, 0, 0);
      S0 = __builtin_amdgcn_mfma_f32_32x32x16_bf16(GPK(al3, ah3), GPK(bl3, bh3), S0, 0, 0, 0); S1 = __builtin_amdgcn_mfma_f32_32x32x16_bf16(GPK(al3, ah3), GPK(cl3, ch3), S1, 0, 0, 0); }
#pragma unroll
    for (int g = 0; g < 4; ++g) { const f32x4 dc = *(const LAS f32x4*)(sb + SB_DEC + (32 * db + 8 * g + 4 * hi) * 4);
                                  S0[4 * g] *= dc[0]; S0[4 * g + 1] *= dc[1]; S0[4 * g + 2] *= dc[2]; S0[4 * g + 3] *= dc[3];
                                  S1[4 * g] *= dc[0]; S1[4 * g + 1] *= dc[1]; S1[4 * g + 2] *= dc[2]; S1[4 * g + 3] *= dc[3]; }
#pragma unroll
    for (int g = 0; g < 4; ++g) { u32x2 w0, w1; w0.x = cvt_pk_bf16(S0[4 * g], S0[4 * g + 1]); w0.y = cvt_pk_bf16(S0[4 * g + 2], S0[4 * g + 3]); w1.x = cvt_pk_bf16(S1[4 * g], S1[4 * g + 1]); w1.y = cvt_pk_bf16(S1[4 * g + 2], S1[4 * g + 3]);
      *(LAS u32x2*)(STn + r32 * ROWB + (32 * db + 8 * g + 4 * hi) * 2) = w0; *(LAS u32x2*)(STn + (32 + r32) * ROWB + (32 * db + 8 * g + 4 * hi) * 2) = w1; }
  }
}
__device__ __forceinline__ void seq_unit(const Frame& F, int b, int hd, int dir, int dvs, LAS char* lds) {
  int tid = threadIdx.x; asm volatile("" : "+v"(tid));
  SeqCtx C; C.lds = lds; C.wid = __builtin_amdgcn_readfirstlane(tid >> 6); C.lane = tid & 63; C.r32 = C.lane & 31; C.hi = C.lane >> 5; C.b = b; C.dir = dir; C.hd = hd; C.dvs = dvs;
  const int sc = (b * 4 + hd) * 2 + dir;
  C.OUT = WSP(bf16_t, dir ? R1_OB : R1_OF);
  C.tiles = (const char*)(F.ws + WS_ACT) + (size_t)sc * 68 * ITEM_B; C.decb = (const char*)(F.ws + WS_ACT + (size_t)4352 * ITEM_B) + (size_t)sc * 68 * 512;
  for (int i = tid; i < 2 * 17408 / 4; i += NTHR) ((LAS unsigned*)(lds + O_ST2))[i] = 0u;
  int vcol;
#pragma unroll
  for (int rd = 0; rd < 2; ++rd) { const int o = rd * 8192 + C.wid * 1024 + C.lane * 16;
    { const int row = o >> 8, slot = (o >> 4) & 15; C.sQ[rd] = (unsigned)(row * 256 + ((slot ^ (row & 15)) << 4)); }
    { const int sub = o >> 9, kkhi = sub >> 2, cblk = sub & 3, w = (o & 511) >> 1, kklo = w >> 5, cin = w & 31; const int kk = kkhi * 8 + kklo; const int k = (kk & ~0xC) | ((kk & 4) << 1) | ((kk & 8) >> 1);
      C.sK[rd] = (unsigned)(k * 256 + (cblk * 32 + cin) * 2); } }
  { const int o = C.wid * 1024 + C.lane * 16; const int sub = o >> 9, kkhi = sub >> 1, cblk = sub & 1, w = (o & 511) >> 1, kklo = w >> 5, cin = w & 31; const int kk = kkhi * 8 + kklo;
    C.vk = (kk & ~0xC) | ((kk & 4) << 1) | ((kk & 8) >> 1); vcol = cblk * 32 + cin; }
  C.Uv = WSP(bf16_t, R1_U1) + 1024 + hd * 256 + dvs * 64 + vcol;
  C.ldsw = (unsigned)C.wid * 1024u;
  C.eb = C.wid & 1; C.db = C.wid & 3; C.trb = v_rd_base(C.lane); C.xq = ((C.r32 & 15) ^ C.hi) << 4;
  { const int j = C.r32, kk = (j & ~0xC) | ((j & 4) << 1) | ((j & 8) >> 1); C.kdo = (kk >> 3) * 2048 + (kk & 7) * 64 + C.hi * 16; }
  seq_issue(C, 0); seq_issue(C, 1);
  if (C.wid < 4) { if (C.wid & 2) seq_out_loop<1>(C); else seq_out_loop<0>(C); }
  else seq_state_loop(C);
  asm volatile("s_waitcnt vmcnt(0) lgkmcnt(0)" ::: "memory");
  __builtin_amdgcn_s_barrier();
}
__device__ __forceinline__ void seq_phase(const Frame& F) {
  for (int un = F.bid; un < 256; un += F.G) {
    const int dvs = un & 3, sc = un >> 2, dir = sc & 1, hd = (sc >> 1) & 3, b = sc >> 3;
    __syncthreads();
    seq_unit(F, b, hd, dir, dvs, (LAS char*)F.ring);
  }
}
#undef GPK
#undef CH_ROW0
#undef TOK
}

__device__ __forceinline__ void ph_gla_out(const Frame& F) {
    const bf16_t* OF = WSP(bf16_t, R1_OF); const bf16_t* OB = WSP(bf16_t, R1_OB); const bf16_t* U1 = WSP(bf16_t, R1_U1); bf16_t* MIX = WSP(bf16_t, R1_MIX); const float* gn = F.in[I1_GNG];
    for (int rl = F.bid * NWAVE + F.wave; rl < TL; rl += F.G * NWAVE) {
        float o[16], ob[16], go[16]; ld16b(OF + (size_t)rl * D, F.lane, o); ld16b(OB + (size_t)rl * D, F.lane, ob); ld16b(U1 + (size_t)(TC + rl) * U1W + 2048, F.lane, go);
        float s0 = 0.f, s1 = 0.f;
#pragma unroll
        for (int i = 0; i < 8; ++i) { o[i] += ob[i]; o[8 + i] += ob[8 + i]; s0 = fmaf(o[i], o[i], s0); s1 = fmaf(o[8 + i], o[8 + i], s1); }
        for (int k = 16; k >= 1; k >>= 1) { s0 += __shfl_xor(s0, k); s1 += __shfl_xor(s1, k); }
        const float r0 = rsqrtf(s0 * (1.0f / 256.0f) + EPS), r1 = rsqrtf(s1 * (1.0f / 256.0f) + EPS);
        const float* gp = gn + ((8 * F.lane) & 255);
#pragma unroll
        for (int i = 0; i < 8; ++i) { const float gw = gp[i]; o[i] = o[i] * r0 * gw * silu_fast(go[i]); o[8 + i] = o[8 + i] * r1 * gw * silu_fast(go[8 + i]); }
        st16b(MIX + (size_t)rl * D, F.lane, o);
    }
}

constexpr int NPHASE = 20;
__global__ void __launch_bounds__(NTHR, 2) fwd_kernel(Args args) {
    extern __shared__ __attribute__((aligned(16))) unsigned char lds_raw[];
    Frame F; F.in = args.in; F.out = args.out; F.ws = args.ws; F.lds = (LAS unsigned char*)lds_raw; F.ring = F.lds + RING_OFF;
    F.tid = threadIdx.x; F.lane = F.tid & 63; F.wave = __builtin_amdgcn_readfirstlane(F.tid >> 6); F.G = gridDim.x; F.bid = blockIdx.x;
    if (F.tid < 4) ((LAS unsigned*)F.lds)[F.tid] = 0u;
    __syncthreads();
    const int lo = args.ph_lo, hi = args.ph_hi;
    const bool multi = (hi - lo) > 1;
    XcdBarrier bar; bar.bar = (unsigned*)(F.ws + WS_CTL + CW_BAR); bar.x = 0; bar.st = (volatile LAS unsigned*)F.lds;
    if (multi) bar = xcd_barrier_post((unsigned*)(F.ws + WS_CTL + CW_BAR), (volatile LAS unsigned*)F.lds);
#define IN(k) (lo <= (k) && (k) < hi)
#define SEAM(k) do { if (IN((k) + 1)) xcd_barrier(bar); } while (0)
#define REFRESH() do { int t_ = threadIdx.x; asm volatile("" : "+v"(t_)); F.tid = t_; F.lane = t_ & 63; F.wave = __builtin_amdgcn_readfirstlane(t_ >> 6); } while (0)

    if (IN(0)) { REFRESH(); ph_prologue(F); SEAM(0); }
    if (IN(1)) { REFRESH(); ph_mod0(F); SEAM(1); }
    if (IN(2)) { REFRESH();
        pg8::DualOrder S; S.a.init(WSP(bf16_t, WS_H), WSP(bf16_t, WS_WIN0), D, D, T, U0W, F.G, F.bid); S.b.init(WSP(bf16_t, WS_WF), WSP(bf16_t, WS_H), D, D, 512, T, F.G, F.bid);
        pg8::EpiDual0 E{pg8::EpiBf16{WSP(bf16_t, R0_U0), U0W, U0W}, pg8::EpiFourT{WSP(bf16_t, R0_TT), WSP(bf16_t, R0_TTC)}};
        pg8::gemm_phase<pg8::EpiDual0, pg8::DualOrder>(F.ring, pg8::Gemm{D, D, D}, S, E);
        SEAM(2); }
    if (IN(3)) { REFRESH(); ph_rowstats(F); SEAM(3); }
    if (IN(4)) { REFRESH();
        { pg8::DenseOrder S; S.init(WSP(bf16_t, R0_U0), WSP(bf16_t, WS_WQ), U0W, QL, T, QWP, F.G, F.bid);
          pg8::EpiRS E{WSP(bf16_t, R0_Q), WSP(float, WS_RS), QW, QW}; pg8::gemm_phase<pg8::EpiRS, pg8::DenseOrder>(F.ring, pg8::Gemm{QL, U0W, QL}, S, E); }
        { pg8::DenseOrder S; S.init(WSP(bf16_t, R0_U0) + QL, WSP(bf16_t, WS_WKV), U0W, KVL, T, KVW, F.G, F.bid);
          pg8::EpiRS E{WSP(bf16_t, R0_KV), WSP(float, WS_RS) + T, KVW, KVW}; pg8::gemm_phase<pg8::EpiRS, pg8::DenseOrder>(F.ring, pg8::Gemm{KVL, U0W, KVL}, S, E); }
        SEAM(4); }
    if (IN(5)) { REFRESH();
        ph_queue5(F); SEAM(5); }
    if (IN(6)) { REFRESH();
        pg8::DenseOrder S; S.init(WSP(bf16_t, R0_MIX), WSP(bf16_t, WS_WOUT0), D, D, T, D, F.G, F.bid);
        pg8::EpiGateBf16 E{WSP(bf16_t, R0_U0), WSP(float, WS_MODV), 2048, 0, 0};
        pg8::gemm_phase<pg8::EpiGateBf16, pg8::DenseOrder>(F.ring, pg8::Gemm{D, D, D}, S, E); SEAM(6); }
    if (IN(7)) { REFRESH(); ph_router(F, 0, 0); SEAM(7); }
    if (IN(8)) { REFRESH(); ph_moe1(F, 0); SEAM(8); }
    if (IN(9)) { REFRESH(); ph_moe2(F, 0); SEAM(9); }
    if (IN(10)) { REFRESH(); ph_combine_mod1(F); SEAM(10); }
    if (IN(11)) { REFRESH();
        pg8::DenseOrder S; S.init(WSP(bf16_t, WS_H), WSP(bf16_t, WS_WIN1), D, D, T, U1W, F.G, F.bid);
        pg8::EpiBf16 E{WSP(bf16_t, R1_U1), U1W, U1W}; pg8::gemm_phase<pg8::EpiBf16, pg8::DenseOrder>(F.ring, pg8::Gemm{D, D, D}, S, E); SEAM(11); }
    if (IN(12)) { REFRESH(); gla3::pre_phase(F); SEAM(12); }
    if (IN(13)) { REFRESH(); gla3::seq_phase(F); SEAM(13); }
    if (IN(14)) { REFRESH(); ph_gla_out(F); SEAM(14); }
    if (IN(15)) { REFRESH();
        pg8::DenseOrder S; S.init(WSP(bf16_t, R1_MIX), WSP(bf16_t, WS_WOUT1), D, D, TL, D, F.G, F.bid);
        pg8::EpiGateBf16 E{WSP(bf16_t, R1_OF), WSP(float, WS_MODV) + 9 * 6144, 2048, TC, TC};
        pg8::gemm_phase<pg8::EpiGateBf16, pg8::DenseOrder>(F.ring, pg8::Gemm{D, D, D}, S, E); SEAM(15); }
    if (IN(16)) { REFRESH(); ph_router(F, 1, TC); SEAM(16); }
    if (IN(17)) { REFRESH(); ph_moe1(F, 1); SEAM(17); }
    if (IN(18)) { REFRESH(); ph_moe2(F, 1); SEAM(18); }
    if (IN(19)) { REFRESH(); ph_final(F); }
#undef IN
#undef SEAM
}

#ifndef ONE_LAUNCH
#define ONE_LAUNCH 1
#endif
extern "C" void kernel_launch(void* const* d_in, const int* in_sizes, int n_in, void* d_out, int out_size, void* d_ws, size_t ws_size, hipStream_t stream) {
    static int grid = 0;
    if (grid == 0) {
        if (n_in != 38 || out_size != TL * D || ws_size < WS_END) { fprintf(stderr, "kernel_launch: unexpected shapes: n_in %d out %d ws %zu (need %zu)\n", n_in, out_size, ws_size, (size_t)WS_END); grid = -1; return; }
        int dev = 0, cus = 0, per_cu = 0;
        if (hipGetDevice(&dev) != hipSuccess || hipDeviceGetAttribute(&cus, hipDeviceAttributeMultiprocessorCount, dev) != hipSuccess) { grid = -1; return; }
        if (hipFuncSetAttribute((const void*)fwd_kernel, hipFuncAttributeMaxDynamicSharedMemorySize, LDS_BYTES) != hipSuccess) { fprintf(stderr, "kernel_launch: hipFuncSetAttribute failed\n"); grid = -1; return; }
        if (hipOccupancyMaxActiveBlocksPerMultiprocessor(&per_cu, (const void*)fwd_kernel, NTHR, LDS_BYTES) != hipSuccess || per_cu < 1) { fprintf(stderr, "kernel_launch: occupancy query says %d\n", per_cu); }
        (void)hipGetLastError();
        grid = cus;
    }
    if (grid < 0) return;
    (void)hipMemsetAsync((char*)d_ws + WS_CTL, 0, CTL_BYTES, stream);
    Args a{};
    for (int i = 0; i < 38; ++i) a.in[i] = (const float*)d_in[i];
    a.out = (float*)d_out; a.ws = (unsigned char*)d_ws;
#if ONE_LAUNCH
    a.ph_lo = 0; a.ph_hi = NPHASE;
    hipLaunchKernelGGL(fwd_kernel, dim3(grid), dim3(NTHR), LDS_BYTES, stream, a);
#else
    for (int p = 0; p < NPHASE; ++p) { a.ph_lo = p; a.ph_hi = p + 1; hipLaunchKernelGGL(fwd_kernel, dim3(grid), dim3(NTHR), LDS_BYTES, stream, a); }
#endif
}
```

```cpp
#include <hip/hip_runtime.h>
#include <stdint.h>
#include <stdio.h>

#define LAS __attribute__((address_space(3)))
typedef unsigned short bf16_t;
typedef short bf16x8 __attribute__((ext_vector_type(8)));
typedef float f32x4 __attribute__((ext_vector_type(4)));
typedef float f32x2 __attribute__((ext_vector_type(2)));
typedef unsigned u32x4 __attribute__((ext_vector_type(4)));
typedef unsigned u32x2 __attribute__((ext_vector_type(2)));

#ifndef NAIVE_ATTN
#define NAIVE_ATTN 0
#endif
#ifndef NAIVE_GLA
#define NAIVE_GLA 0
#endif
constexpr int D = 1024, NB = 8, SEQ = 4096, CTXL = 256;
constexpr int TC = NB * CTXL, TL = NB * SEQ, T = TC + TL;
constexpr int QL = 384, KVL = 256, ROPE = 64, NH = 6, QKD = 192, VD = 128;
constexpr int U0W = 768;
constexpr int QW = NH * QKD  , QWP = 1280, KVW = NH * 256  ;
constexpr int NE = 32, TOPK = 4, FF = 1024;
constexpr int U1W = 3072;
constexpr int NPAD = 147456;
constexpr float EPS = 1e-6f;
constexpr int NTHR = 512, NWAVE = 8;

constexpr size_t al256(size_t x) { return (x + 255) / 256 * 256; }
constexpr size_t XCD_BAR_WORDS_C = 3456;
constexpr size_t CW_BAR = 0;
constexpr size_t CW_Q5 = 15360;
constexpr size_t CW_CNT = 16384;
constexpr size_t CTL_BYTES = 32768;
constexpr size_t WS_CTL = 0;
constexpr size_t WS_MODV = WS_CTL + CTL_BYTES;
constexpr size_t WS_ROPE = WS_MODV + al256(2 * 9 * 6144 * 4);
constexpr size_t WS_RS = WS_ROPE + al256(2 * 64 * 16 * 4);
constexpr size_t WS_XCTX = WS_RS + al256((size_t)2 * T * 4);
constexpr size_t WS_H = WS_XCTX + al256((size_t)TC * D * 4);
constexpr size_t WS_WIN0 = WS_H + al256((size_t)T * D * 2);
constexpr size_t WS_WF = WS_WIN0 + al256((size_t)U0W * D * 2);
constexpr size_t WS_WQ = WS_WF + al256((size_t)512 * D * 2);
constexpr size_t WS_WKV = WS_WQ + al256((size_t)QWP * QL * 2);
constexpr size_t WS_WOUT0 = WS_WKV + al256((size_t)KVW * KVL * 2);
constexpr size_t WS_WIN1 = WS_WOUT0 + al256((size_t)D * D * 2);
constexpr size_t WS_WOUT1 = WS_WIN1 + al256((size_t)U1W * D * 2);
constexpr size_t WS_WGU = WS_WOUT1 + al256((size_t)D * D * 2);
constexpr size_t WS_WDN = WS_WGU + al256((size_t)NE * 2048 * D * 2);
constexpr size_t WS_ACT = WS_WDN + al256((size_t)NE * D * FF * 2);
constexpr size_t WS_LIST = WS_ACT + al256((size_t)NPAD * FF * 2);
constexpr size_t WS_TOKE = WS_LIST + al256((size_t)NE * T * 4);
constexpr size_t WS_TOKP = WS_TOKE + al256((size_t)T * 4 * 4);
constexpr size_t WS_TOKG = WS_TOKP + al256((size_t)T * 4 * 4);
constexpr size_t WS_RWT = WS_TOKG + al256((size_t)T * 4 * 4);
constexpr size_t WS_GD = WS_RWT + al256((size_t)2 * 2 * 32 * 1024 * 2);
constexpr size_t WS_REG = WS_GD + al256((size_t)T * 32 * 4);
constexpr size_t R0_U0 = WS_REG;
constexpr size_t R0_TT = R0_U0 + al256((size_t)T * U0W * 2);
constexpr size_t R0_TTC = R0_TT + al256((size_t)NB * 256 * 8192 * 2);
constexpr size_t R0_Q = R0_TTC + al256((size_t)NB * 256 * 512 * 2);
constexpr size_t R0_KV = R0_Q + al256((size_t)T * QW * 2);
constexpr size_t R0_KR = R0_KV + al256((size_t)T * KVW * 2);
constexpr size_t R0_MIX = R0_KR + al256((size_t)T * ROPE * 2);
constexpr size_t R0_DFT = R0_MIX + al256((size_t)T * D * 2);
constexpr size_t R0_DFTC = R0_DFT + al256((size_t)4096 * 4096 * 2);
constexpr size_t R0_TT2 = R0_DFTC + al256((size_t)256 * 256 * 2);
constexpr size_t R0_TTC2 = R0_TT2 + al256((size_t)NB * 256 * 4096 * 2);
constexpr size_t R0_END = R0_TTC2 + al256((size_t)NB * 256 * 256 * 2);
constexpr size_t R1_U1 = WS_REG;
constexpr size_t R1_OF = R1_U1 + al256((size_t)T * U1W * 2);
constexpr size_t R1_OB = R1_OF + al256((size_t)TL * D * 2);
constexpr size_t R1_XB = R1_OB + al256((size_t)TL * D * 2);
constexpr size_t R1_END = R1_XB + al256((size_t)TL * D * 2);
constexpr size_t RM_YB = WS_REG;
constexpr size_t RM_END = RM_YB + al256((size_t)NPAD * D * 2);
constexpr size_t cmax(size_t a, size_t b) { return a > b ? a : b; }
constexpr size_t WS_END = cmax(cmax(R0_END, R1_END), RM_END);

constexpr int LDS_BYTES = 160 * 1024;
constexpr int LDS_MISC = 1024;
constexpr int RING_OFF = LDS_MISC;

__device__ __forceinline__ float bf2f(bf16_t b) { return __uint_as_float(((unsigned)b) << 16); }
__device__ __forceinline__ bf16_t f2bf(float f) { unsigned u = __float_as_uint(f); u += 0x7FFFu + ((u >> 16) & 1u); return (bf16_t)(u >> 16); }
__device__ __forceinline__ unsigned pk2(float lo, float hi) { return (unsigned)f2bf(lo) | ((unsigned)f2bf(hi) << 16); }
typedef __bf16 bf16v2_t __attribute__((ext_vector_type(2)));
__device__ __forceinline__ unsigned cvt_pk_bf16(float lo, float hi) { const f32x2 v = {lo, hi}; bf16v2_t b = __builtin_convertvector(v, bf16v2_t); return *reinterpret_cast<unsigned*>(&b); }
__device__ __forceinline__ float wsum(float v) { for (int o = 32; o >= 1; o >>= 1) v += __shfl_xor(v, o); return v; }
__device__ __forceinline__ float siluf(float x) { return x / (1.0f + __expf(-x)); }
__device__ __forceinline__ float silu_fast(float x) { return x * __builtin_amdgcn_rcpf(1.0f + __builtin_amdgcn_exp2f(x * -1.4426950408889634f)); }

#define XB_TMO      128
#define XB_XCNT(j)  (256  + 64 * (j))
#define XB_XSUB(j)  (1280 + 64 * (j))
#define XB_XGEN(j)  (2304 + 64 * (j))
#define XB_TOP      3328
#define XB_TOPGEN   3392
#define XCD_BAR_WORDS 3456
#define XB_SPIN_CAP (1u << 20)
__device__ __forceinline__ unsigned xb_ld(unsigned* p)              { return __hip_atomic_load(p, __ATOMIC_RELAXED, __HIP_MEMORY_SCOPE_AGENT); }
__device__ __forceinline__ unsigned xb_add(unsigned* p, unsigned v) { return __hip_atomic_fetch_add(p, v, __ATOMIC_RELAXED, __HIP_MEMORY_SCOPE_AGENT); }
__device__ __forceinline__ unsigned xb_xcc_id() { return (unsigned)__builtin_amdgcn_s_getreg((3 << 11) | 20) & 0xFu; }
#define XB_SPIN(cond, bar) do { unsigned _sp = 0; while (cond) { __builtin_amdgcn_s_sleep(1); \
    if ((++_sp & 255u) == 0u) { if (xb_ld(&(bar)[XB_TMO])) break; if (_sp > XB_SPIN_CAP) { atomicAdd(&(bar)[XB_TMO], 1u); break; } } } } while (0)
struct XcdBarrier { unsigned* bar; unsigned x; volatile LAS unsigned* st; };
__device__ __forceinline__ XcdBarrier xcd_barrier_post(unsigned* bar, volatile LAS unsigned* st) {
    XcdBarrier b; b.bar = bar; b.x = xb_xcc_id(); b.st = st;
    if (threadIdx.x == 0) (void)xb_add(&bar[XB_XCNT(b.x)], 1u);
    return b;
}
__device__ __forceinline__ void xcd_barrier_complete(unsigned* bar, unsigned x, unsigned& nloc, unsigned& nx) {
    const unsigned G = gridDim.x * gridDim.y * gridDim.z;
    unsigned sum, cnt, mine, sp = 0u;
    for (;;) {
        sum = 0u; cnt = 0u; mine = 0u;
#pragma unroll
        for (unsigned j = 0; j < 16; ++j) { const unsigned c = xb_ld(&bar[XB_XCNT(j)]); sum += c; cnt += (c > 0u) ? 1u : 0u; mine = (j == x) ? c : mine; }
        if (sum == G) break;
        __builtin_amdgcn_s_sleep(1);
        if ((++sp & 255u) == 0u) { if (xb_ld(&bar[XB_TMO])) break; if (sp > XB_SPIN_CAP) { atomicAdd(&bar[XB_TMO], 1u); break; } }
    }
    nloc = mine > 0u ? mine : 1u; nx = cnt > 0u ? cnt : 1u;
}
__device__ __forceinline__ void xcd_barrier(const XcdBarrier& b) {
    asm volatile("s_waitcnt vmcnt(0)" ::: "memory");
    __syncthreads();
    if (threadIdx.x == 0) {
        unsigned* bar = b.bar;
        __builtin_amdgcn_s_waitcnt(0);
        unsigned nloc = b.st[0], nx = b.st[1];
        if (nloc == 0u) { xcd_barrier_complete(bar, b.x, nloc, nx); b.st[0] = nloc; b.st[1] = nx; }
        const unsigned old = xb_add(&bar[XB_XSUB(b.x)], 1u);
        const unsigned gen = old / nloc;
        if (old + 1u == (gen + 1u) * nloc) {
            __builtin_amdgcn_fence(__ATOMIC_RELEASE, "agent");
            asm volatile("s_waitcnt vmcnt(0)" ::: "memory");
            const unsigned og = xb_add(&bar[XB_TOP], 1u);
            const unsigned tg = og / nx;
            if (og + 1u == (tg + 1u) * nx) xb_add(&bar[XB_TOPGEN], 1u);
            else XB_SPIN(xb_ld(&bar[XB_TOPGEN]) == tg, bar);
            __builtin_amdgcn_fence(__ATOMIC_ACQUIRE, "agent");
            xb_add(&bar[XB_XGEN(b.x)], 1u);
            asm volatile("s_waitcnt vmcnt(0)" ::: "memory");
        } else {
            XB_SPIN(xb_ld(&bar[XB_XGEN(b.x)]) == gen, bar);
            __builtin_amdgcn_fence(__ATOMIC_ACQUIRE, "agent");
            asm volatile("s_waitcnt vmcnt(0)" ::: "memory");
        }
    }
    __syncthreads();
}

namespace pg8 {
constexpr int BM = 256, BK = 64, HALF = 128, HTB = HALF * BK * 2, STAGE_BYTES = 8 * HTB, NXCD = 8, WGM = 8;
__host__ __device__ __forceinline__ int lds_byte(int r, int c) { const int st = (r >> 4) * 2 + (c >> 5), rr = r & 15, cc = c & 31, ob = rr * 64 + cc * 2; return st * 1024 + (ob ^ (((ob >> 9) & 1) << 5)); }
__host__ __device__ __forceinline__ void stage_rc(int b, int& R, int& C) { const int st = b / 1024, sb = b % 1024, swz = sb ^ (((sb >> 9) & 1) << 5); R = (st >> 1) * 16 + swz / 64; C = (st & 1) * 32 + (swz % 64) / 2; }
__host__ __device__ __forceinline__ int perm32(int rho) { const int n = rho >> 4, i = rho & 15; return 8 * (i >> 2) + 4 * n + (i & 3); }

struct Unit { int pm, pn, e, cnt; const char* A; const char* B; };
struct Gemm { int K, lda, ldb; };

struct DenseOrder {
    const char* A; const char* B; int lda, ldb; int nM, nN, nwg, G, c;
    static constexpr bool GATHER = false;
    __device__ void init(const void* A_, const void* B_, int lda_, int ldb_, int M, int N, int G_, int c_) { A = (const char*)A_; B = (const char*)B_; lda = lda_; ldb = ldb_; nM = M / BM; nN = N / BM; nwg = nM * nN; G = G_; c = c_; }
    __device__ bool next(int i, Unit& u) const {
        const long L = (long)i * G + c; if (L >= nwg) return false;
        int wgid = (int)L; { const int q = nwg / NXCD, r = nwg % NXCD, xcd = wgid % NXCD, off = wgid / NXCD; wgid = (xcd < r ? xcd * (q + 1) : r * (q + 1) + (xcd - r) * q) + off; }
        const int nig = WGM * nN, gid = wgid / nig, fm = gid * WGM, gsz = (nM - fm) < WGM ? (nM - fm) : WGM;
        u.pm = fm + ((wgid % nig) % gsz); u.pn = (wgid % nig) / gsz; u.e = 0; u.cnt = 0;
        u.A = A + (size_t)u.pm * BM * lda * 2; u.B = B + (size_t)u.pn * BM * ldb * 2; return true;
    }
    __device__ __forceinline__ void aoff(const Unit&, const int (&R)[2], const int (&C)[2], unsigned (&off)[2][2]) const {
#pragma unroll
        for (int h = 0; h < 2; ++h)
#pragma unroll
            for (int i = 0; i < 2; ++i) off[h][i] = (unsigned)((h * HALF + R[i]) * lda + C[i]) * 2u;
    }
};
struct BatchOrder {
    const char* A; const char* B; size_t sA, sB; int lda, ldb; int nM, nN, per, nwg, G, c;
    static constexpr bool GATHER = false;
    __device__ void init(const void* A_, const void* B_, size_t sA_, size_t sB_, int lda_, int ldb_, int nb, int M, int N, int G_, int c_) { A = (const char*)A_; B = (const char*)B_; sA = sA_; sB = sB_; lda = lda_; ldb = ldb_; nM = M / BM; nN = N / BM; per = nM * nN; nwg = per * nb; G = G_; c = c_; }
    __device__ bool next(int i, Unit& u) const {
        const long L = (long)i * G + c; if (L >= nwg) return false;
        const int b = (int)L / per, r = (int)L % per; u.pm = r / nN; u.pn = r % nN; u.e = b; u.cnt = 0;
        u.A = A + (size_t)b * sA + (size_t)u.pm * BM * lda * 2; u.B = B + (size_t)b * sB + (size_t)u.pn * BM * ldb * 2; return true;
    }
    __device__ __forceinline__ void aoff(const Unit&, const int (&R)[2], const int (&C)[2], unsigned (&off)[2][2]) const {
#pragma unroll
        for (int h = 0; h < 2; ++h)
#pragma unroll
            for (int i = 0; i < 2; ++i) off[h][i] = (unsigned)((h * HALF + R[i]) * lda + C[i]) * 2u;
    }
};
struct DualOrder {
    DenseOrder a, b;
    static constexpr bool GATHER = false;
    __device__ __forceinline__ void aoff_issue(const Unit&, const int (&)[2], unsigned (&)[2][2]) const {}
    __device__ __forceinline__ void aoff_finish(const int (&)[2], unsigned (&)[2][2], unsigned (&)[2][2]) const {}
    __device__ bool next(int i, Unit& u) const {
        const long L = (long)i * a.G + a.c;
        if (L < a.nwg) { return a.next(i, u); }
        const long Lb = L - a.nwg; if (Lb >= b.nwg) return false;
        DenseOrder t = b; t.c = (int)(Lb % b.G); const bool ok = t.next((int)(Lb / b.G), u); u.e = 1; return ok;
    }
    __device__ __forceinline__ void aoff(const Unit& u, const int (&R)[2], const int (&C)[2], unsigned (&off)[2][2]) const { a.aoff(u, R, C, off); }
};
struct OneUnit {
    Unit u0; int lda;
    static constexpr bool GATHER = false;
    __device__ bool next(int i, Unit& u) const { if (i != 0) return false; u = u0; return true; }
    __device__ __forceinline__ void aoff(const Unit&, const int (&R)[2], const int (&C)[2], unsigned (&off)[2][2]) const {
#pragma unroll
        for (int h = 0; h < 2; ++h)
#pragma unroll
            for (int i = 0; i < 2; ++i) off[h][i] = (unsigned)((h * HALF + R[i]) * lda + C[i]) * 2u;
    }
};
template <bool GATHER_> struct MoeOrder {
    const char* A; const char* B; size_t sB; int lda, ldb; int npn, nwg, G, c;
    const LAS int* tstart; const LAS int* cnt; const int* list;
    const LAS int* t2e;
    __device__ __forceinline__ int ts(int j) const { return __builtin_amdgcn_readfirstlane(tstart[j]); }
    static constexpr bool GATHER = GATHER_;
    __device__ bool next(int i, Unit& u) const {
        const long L = (long)i * G + c; if (L >= nwg) return false;
        int wgid = (int)L; { const int q = nwg / NXCD, r = nwg % NXCD, xcd = wgid % NXCD, off = wgid / NXCD; wgid = (xcd < r ? xcd * (q + 1) : r * (q + 1) + (xcd - r) * q) + off; }
        const int e = __builtin_amdgcn_readfirstlane(t2e[wgid / npn]);
        const int t0 = ts(e), nt = ts(e + 1) - t0, l = wgid - t0 * npn, pn = l / nt, ti = l % nt;
        u.pm = t0 + ti; u.pn = pn; u.e = e; u.cnt = __builtin_amdgcn_readfirstlane(cnt[e]) - ti * BM;
        u.A = GATHER ? A : A + (size_t)u.pm * BM * lda * 2;
        u.B = B + (size_t)e * sB + (size_t)pn * BM * ldb * 2; return true;
    }
    __device__ __forceinline__ void aoff(const Unit& u, const int (&R)[2], const int (&C)[2], unsigned (&off)[2][2]) const {
        if (GATHER) {
            const int ti = u.pm - ts(u.e);
#pragma unroll
            for (int h = 0; h < 2; ++h)
#pragma unroll
                for (int i = 0; i < 2; ++i) { const int r = h * HALF + R[i]; const int tok = (r < u.cnt) ? list[(size_t)u.e * T + ti * BM + r] : 0; off[h][i] = (unsigned)(tok * lda + C[i]) * 2u; }
        } else {
#pragma unroll
            for (int h = 0; h < 2; ++h)
#pragma unroll
                for (int i = 0; i < 2; ++i) off[h][i] = (unsigned)((h * HALF + R[i]) * lda + C[i]) * 2u;
        }
    }
};

template <class Epi, class Sched>
__device__ __forceinline__ void gemm_phase(LAS unsigned char* lds, const Gemm g, const Sched& S, const Epi& E) {
    const int tid = threadIdx.x, wid = __builtin_amdgcn_readfirstlane(tid >> 6), lane = tid & 63, wr = wid >> 2, wc = wid & 3, fr = lane & 15, fq = lane >> 4;
    const int K = g.K, nt = K / BK;
    int Rr[2], Cc[2]; unsigned voffB[2];
#pragma unroll
    for (int i = 0; i < 2; ++i) { int R, C; stage_rc(tid * 16 + i * 8192, R, C); const int Rb = Epi::PERM ? ((R & ~31) + perm32(R & 31)) : R; Rr[i] = R; Cc[i] = C; voffB[i] = (unsigned)(Rb * g.ldb + C) * 2u; }
    const size_t kstep = (size_t)(BK * 2);
    const size_t hstepB = (size_t)HALF * g.ldb * 2;
    const unsigned ldsw = (unsigned)wid * 1024u;
    const int aoff = lds_byte(wr * 64 + fr, fq * 8), boff = lds_byte(wc * 32 + fr, fq * 8);
#define PG8_SA(b, h) (((b) * 2 + (h)) * HTB)
#define PG8_SB(b, h) ((4 + (b) * 2 + (h)) * HTB)
#define PG8_STAGE2(bufoff, gbase, o0, o1) do { \
        __builtin_amdgcn_global_load_lds((const unsigned*)((const char*)(gbase) + (o0)), (LAS unsigned*)(lds + (bufoff) + ldsw), 16, 0, 0); \
        __builtin_amdgcn_global_load_lds((const unsigned*)((const char*)(gbase) + (o1)), (LAS unsigned*)(lds + (bufoff) + ldsw + 8192), 16, 0, 0); } while (0)
#define PG8_STAGEB(bufoff, gbase) PG8_STAGE2(bufoff, gbase, voffB[0], voffB[1])
#define PG8_LDA(dst, b, h) do { _Pragma("unroll") for (int m = 0; m < 4; ++m) _Pragma("unroll") for (int k = 0; k < 2; ++k) dst[m][k] = *(const LAS bf16x8*)(lds + PG8_SA(b, h) + aoff + m * 2048 + k * 1024); } while (0)
#define PG8_LDB(dst, b, h) do { _Pragma("unroll") for (int n = 0; n < 2; ++n) _Pragma("unroll") for (int k = 0; k < 2; ++k) dst[n][k] = *(const LAS bf16x8*)(lds + PG8_SB(b, h) + boff + n * 2048 + k * 1024); } while (0)
#define PG8_MMA(ai, bj, At, Bt) do { __builtin_amdgcn_s_setprio(1); _Pragma("unroll") for (int m = 0; m < 4; ++m) _Pragma("unroll") for (int n = 0; n < 2; ++n) _Pragma("unroll") for (int k = 0; k < 2; ++k) \
        acc[ai][bj][m][n] = __builtin_amdgcn_mfma_f32_16x16x32_bf16(Bt[n][k], At[m][k], acc[ai][bj][m][n], 0, 0, 0); __builtin_amdgcn_s_setprio(0); } while (0)
#define PG8_WAIT_V(n) asm volatile("s_waitcnt vmcnt(" #n ")" ::: "memory")
#define PG8_WAIT_L(n) asm volatile("s_waitcnt lgkmcnt(" #n ")" ::: "memory")
#define PG8_BAR __builtin_amdgcn_s_barrier()
#define PG8_SCHED __builtin_amdgcn_sched_barrier(0)
    Unit cur, nxt; int ui = 0;
    if (!S.next(0, cur)) return;
    f32x4 acc[2][2][4][2];
#pragma unroll
    for (int a = 0; a < 2; ++a)
#pragma unroll
        for (int b = 0; b < 2; ++b)
#pragma unroll
            for (int m = 0; m < 4; ++m)
#pragma unroll
                for (int n = 0; n < 2; ++n) acc[a][b][m][n] = (f32x4){0.f, 0.f, 0.f, 0.f};
    bf16x8 At[4][2], B0[2][2], B1[2][2];
    unsigned oA[2][2], nOA[2][2];
    S.aoff(cur, Rr, Cc, oA);
    const char* cA = cur.A; const char* cB = cur.B;
    PG8_STAGEB(PG8_SB(0, 0), cB); PG8_STAGEB(PG8_SB(0, 1), cB + hstepB); PG8_STAGE2(PG8_SA(0, 0), cA, oA[0][0], oA[0][1]); PG8_STAGE2(PG8_SA(0, 1), cA, oA[1][0], oA[1][1]);
    if (wr == 1) PG8_BAR;
    PG8_WAIT_V(2); PG8_BAR;
    PG8_STAGEB(PG8_SB(1, 0), cB + kstep); PG8_STAGE2(PG8_SA(1, 0), cA + kstep, oA[0][0], oA[0][1]); PG8_STAGEB(PG8_SB(1, 1), cB + hstepB + kstep);
    PG8_WAIT_V(6); PG8_BAR;
    for (;;) {
        const bool has_next = S.next(ui + 1, nxt);
        const char* nA = has_next ? nxt.A : cA; const char* nB = has_next ? nxt.B : cB;
        if (Sched::GATHER) { if (has_next) S.aoff(nxt, Rr, Cc, nOA); else {
#pragma unroll
            for (int h = 0; h < 2; ++h)
#pragma unroll
                for (int i = 0; i < 2; ++i) nOA[h][i] = oA[h][i]; }
            asm volatile("" : "+v"(nOA[0][0]), "+v"(nOA[0][1]), "+v"(nOA[1][0]), "+v"(nOA[1][1])); }
        for (int t = 0; t < nt; t += 2) {
            const bool last = (t == nt - 2);
            const char* a1 = cA + (size_t)(t + 1) * kstep;
            const char* a2 = last ? nA : cA + (size_t)(t + 2) * kstep; const char* b2 = last ? nB : cB + (size_t)(t + 2) * kstep;
            const char* a3 = a2 + kstep; const char* b3 = b2 + kstep;
            unsigned q00 = oA[0][0], q01 = oA[0][1], q10 = oA[1][0], q11 = oA[1][1];
            if (Sched::GATHER) { q00 = last ? nOA[0][0] : q00; q01 = last ? nOA[0][1] : q01; q10 = last ? nOA[1][0] : q10; q11 = last ? nOA[1][1] : q11; }
            PG8_LDB(B0, 0, 0); PG8_LDB(B1, 0, 1); PG8_SCHED; PG8_LDA(At, 0, 0); PG8_STAGE2(PG8_SA(1, 1), a1, oA[1][0], oA[1][1]);
            PG8_WAIT_V(8); PG8_WAIT_L(0); PG8_BAR; PG8_MMA(0, 0, At, B0); PG8_MMA(0, 1, At, B1); PG8_BAR; PG8_SCHED;
            PG8_LDA(At, 0, 1); PG8_STAGEB(PG8_SB(0, 0), b2); PG8_STAGEB(PG8_SB(0, 1), b2 + hstepB); PG8_STAGE2(PG8_SA(0, 0), a2, q00, q01);
            PG8_WAIT_V(8); PG8_WAIT_L(0); PG8_BAR; PG8_MMA(1, 0, At, B0); PG8_MMA(1, 1, At, B1); PG8_BAR; PG8_SCHED;
            PG8_LDB(B0, 1, 0); PG8_LDB(B1, 1, 1); PG8_SCHED; PG8_LDA(At, 1, 0); PG8_STAGE2(PG8_SA(0, 1), a2, q10, q11);
            PG8_WAIT_V(8); PG8_WAIT_L(0); PG8_BAR; PG8_MMA(0, 0, At, B0); PG8_MMA(0, 1, At, B1); PG8_BAR; PG8_SCHED;
            PG8_LDA(At, 1, 1); PG8_STAGEB(PG8_SB(1, 0), b3); PG8_STAGEB(PG8_SB(1, 1), b3 + hstepB); PG8_STAGE2(PG8_SA(1, 0), a3, q00, q01);
            PG8_WAIT_V(8); PG8_WAIT_L(0); PG8_BAR; PG8_MMA(1, 0, At, B0); PG8_MMA(1, 1, At, B1); PG8_BAR; PG8_SCHED;
        }
        if (wr == 0) PG8_BAR;
        E(acc, cur, wr, wc, fr, fq, lds + 3 * HTB + ldsw);
        if (!has_next) break;
#pragma unroll
        for (int a = 0; a < 2; ++a)
#pragma unroll
            for (int b = 0; b < 2; ++b)
#pragma unroll
                for (int m = 0; m < 4; ++m)
#pragma unroll
                    for (int n = 0; n < 2; ++n) acc[a][b][m][n] = (f32x4){0.f, 0.f, 0.f, 0.f};
        cur = nxt; cA = nA; cB = nB; ++ui;
        if (Sched::GATHER) {
#pragma unroll
            for (int h = 0; h < 2; ++h)
#pragma unroll
                for (int i = 0; i < 2; ++i) oA[h][i] = nOA[h][i]; }
        if (wr == 1) PG8_BAR;
    }
    PG8_WAIT_V(0);
    PG8_BAR;
#undef PG8_SA
#undef PG8_SB
#undef PG8_STAGE2
#undef PG8_STAGEB
#undef PG8_LDA
#undef PG8_LDB
#undef PG8_MMA
#undef PG8_WAIT_V
#undef PG8_WAIT_L
#undef PG8_BAR
#undef PG8_SCHED
}

typedef f32x4 Acc[2][2][4][2];

struct XStore {
    LAS unsigned char* w; LAS unsigned char* r; int rr, cc;
    __device__ __forceinline__ XStore(LAS unsigned char* xs, int fr, int fq) {
        const int lane = fq * 16 + fr; rr = lane >> 2; cc = lane & 3;
        w = xs + fr * 64 + ((fq ^ ((fr >> 1) & 3)) * 16); r = xs + rr * 64 + ((cc ^ ((rr >> 1) & 3)) * 16); }
    __device__ __forceinline__ void put(const u32x4& x, const u32x4& y) const { *(LAS u32x4*)w = x; *(LAS u32x4*)(w + 8192) = y; }
    __device__ __forceinline__ void get(u32x4& x, u32x4& y) const { x = *(const LAS u32x4*)r; y = *(const LAS u32x4*)(r + 8192); }
};
struct EpiBf16 {
    static constexpr bool PERM = true;
    bf16_t* O; int ldc; int ncols;
    __device__ __forceinline__ void operator()(const Acc& acc, const Unit& u, int wr, int wc, int fr, int fq, LAS unsigned char* xs) const {
        const XStore X(xs, fr, fq);
        const int colw = u.pn * BM + wc * 32; const bool ok0 = colw < ncols, ok1 = colw + HALF < ncols;
        bf16_t* ob = O + (size_t)(u.pm * BM + wr * 64 + X.rr) * ldc + colw + 8 * X.cc;
#pragma unroll
        for (int ai = 0; ai < 2; ++ai)
#pragma unroll
            for (int m = 0; m < 4; ++m) { u32x4 w[2];
#pragma unroll
                for (int bj = 0; bj < 2; ++bj) { const f32x4 v0 = acc[ai][bj][m][0], v1 = acc[ai][bj][m][1];
                    w[bj].x = cvt_pk_bf16(v0[0], v0[1]); w[bj].y = cvt_pk_bf16(v0[2], v0[3]); w[bj].z = cvt_pk_bf16(v1[0], v1[1]); w[bj].w = cvt_pk_bf16(v1[2], v1[3]); }
                X.put(w[0], w[1]); u32x4 a, b; X.get(a, b);
                bf16_t* rowp = ob + (size_t)(ai * HALF + m * 16) * ldc; if (ok0) *(u32x4*)rowp = a; if (ok1) *(u32x4*)(rowp + HALF) = b; }
    }
};
struct EpiFourT {
    static constexpr bool PERM = true;
    bf16_t* TT; bf16_t* TTC;
    __device__ __forceinline__ void operator()(const Acc& acc, const Unit& u, int wr, int wc, int fr, int fq, LAS unsigned char* xs) const {
        const XStore X(xs, fr, fq);
        const int part = u.pm; const int ch0 = wr * 64 + X.rr; const int tokw = u.pn * BM + wc * 32;
        bf16_t* base[2]; int ldt[2];
#pragma unroll
        for (int bj = 0; bj < 2; ++bj) { const int tok = tokw + bj * HALF;
            if (tok < TC) { const int b = tok >> 8, n = tok & 255; base[bj] = TTC + (size_t)b * 256 * 512 + part * 256 + n + 8 * X.cc; ldt[bj] = 512; }
            else { const int tl = tok - TC, b = tl >> 12, n = tl & 4095; base[bj] = TT + (size_t)b * 256 * 8192 + part * 4096 + n + 8 * X.cc; ldt[bj] = 8192; } }
#pragma unroll
        for (int ai = 0; ai < 2; ++ai)
#pragma unroll
            for (int m = 0; m < 4; ++m) { const int ch = ch0 + ai * HALF + m * 16; u32x4 w[2];
#pragma unroll
                for (int bj = 0; bj < 2; ++bj) { const f32x4 v0 = acc[ai][bj][m][0], v1 = acc[ai][bj][m][1];
                    w[bj].x = cvt_pk_bf16(v0[0], v0[1]); w[bj].y = cvt_pk_bf16(v0[2], v0[3]); w[bj].z = cvt_pk_bf16(v1[0], v1[1]); w[bj].w = cvt_pk_bf16(v1[2], v1[3]); }
                X.put(w[0], w[1]); u32x4 a, b; X.get(a, b);
                *(u32x4*)(base[0] + (size_t)ch * ldt[0]) = a; *(u32x4*)(base[1] + (size_t)ch * ldt[1]) = b; }
    }
};
struct EpiRS {
    static constexpr bool PERM = true;
    bf16_t* O; const float* rs; int ldc, ncols;
    __device__ __forceinline__ void operator()(const Acc& acc, const Unit& u, int wr, int wc, int fr, int fq, LAS unsigned char* xs) const {
        const XStore X(xs, fr, fq);
        const int row0 = u.pm * BM + wr * 64 + fr, colw = u.pn * BM + wc * 32; const bool ok0 = colw < ncols, ok1 = colw + HALF < ncols;
        bf16_t* ob = O + (size_t)(u.pm * BM + wr * 64 + X.rr) * ldc + colw + 8 * X.cc;
#pragma unroll
        for (int ai = 0; ai < 2; ++ai)
#pragma unroll
            for (int m = 0; m < 4; ++m) { const float sc = rs[row0 + ai * HALF + m * 16]; u32x4 w[2];
#pragma unroll
                for (int bj = 0; bj < 2; ++bj) { const f32x4 v0 = acc[ai][bj][m][0] * sc, v1 = acc[ai][bj][m][1] * sc;
                    w[bj].x = cvt_pk_bf16(v0[0], v0[1]); w[bj].y = cvt_pk_bf16(v0[2], v0[3]); w[bj].z = cvt_pk_bf16(v1[0], v1[1]); w[bj].w = cvt_pk_bf16(v1[2], v1[3]); }
                X.put(w[0], w[1]); u32x4 a, b; X.get(a, b);
                bf16_t* rowp = ob + (size_t)(ai * HALF + m * 16) * ldc; if (ok0) *(u32x4*)rowp = a; if (ok1) *(u32x4*)(rowp + HALF) = b; }
    }
};
struct EpiFourOut {
    static constexpr bool PERM = true;
    bf16_t* MIX; int rowbase, rows_per_b;
    __device__ __forceinline__ void operator()(const Acc& acc, const Unit& u, int wr, int wc, int fr, int fq, LAS unsigned char* xs) const {
        const XStore X(xs, fr, fq);
        bf16_t* ob = MIX + (size_t)(rowbase + u.e * rows_per_b + u.pm * BM + wr * 64 + X.rr) * D + 768 + wc * 32 + 8 * X.cc;
#pragma unroll
        for (int ai = 0; ai < 2; ++ai)
#pragma unroll
            for (int m = 0; m < 4; ++m) { u32x4 w[2];
#pragma unroll
                for (int bj = 0; bj < 2; ++bj) { const f32x4 v0 = acc[ai][bj][m][0], v1 = acc[ai][bj][m][1];
                    w[bj].x = cvt_pk_bf16(v0[0], v0[1]); w[bj].y = cvt_pk_bf16(v0[2], v0[3]); w[bj].z = cvt_pk_bf16(v1[0], v1[1]); w[bj].w = cvt_pk_bf16(v1[2], v1[3]); }
                X.put(w[0], w[1]); u32x4 a, b; X.get(a, b);
                bf16_t* rowp = ob + (size_t)(ai * HALF + m * 16) * D; *(u32x4*)rowp = a; *(u32x4*)(rowp + HALF) = b; }
    }
};
struct EpiDual0 {
    static constexpr bool PERM = true;
    EpiBf16 e0; EpiFourT e1;
    __device__ __forceinline__ void operator()(const Acc& acc, const Unit& u, int wr, int wc, int fr, int fq, LAS unsigned char* xs) const { if (u.e == 0) e0(acc, u, wr, wc, fr, fq, xs); else e1(acc, u, wr, wc, fr, fq, xs); }
};
struct EpiResid {
    static constexpr bool PERM = false;
    const float* base_ctx; const float* base_lat; float* out_ctx; float* out_lat; const float* modv; int goff; int rowoff;
    __device__ __forceinline__ void operator()(const Acc& acc, const Unit& u, int wr, int wc, int fr, int fq, LAS unsigned char* xs) const {
        const int rt = rowoff + u.pm * BM;
        const bool isctx = rt < TC; const int mr = isctx ? 8 : ((rt - TC) >> 12);
        const float* base = isctx ? base_ctx + (size_t)rt * D : base_lat + (size_t)(rt - TC) * D;
        float* out = isctx ? out_ctx + (size_t)rt * D : out_lat + (size_t)(rt - TC) * D;
        const float* gv = modv + mr * 6144 + goff;
        const int r0 = wr * 64 + fr, col0 = u.pn * BM + wc * 32 + 4 * fq;
        f32x4 g[2][2];
#pragma unroll
        for (int bj = 0; bj < 2; ++bj)
#pragma unroll
            for (int n = 0; n < 2; ++n) g[bj][n] = *(const f32x4*)(gv + col0 + bj * HALF + n * 16);
#pragma unroll
        for (int ai = 0; ai < 2; ++ai) {
            f32x4 bs[4][2][2];
#pragma unroll
            for (int m = 0; m < 4; ++m) { const size_t off = (size_t)(r0 + ai * HALF + m * 16) * D + col0;
#pragma unroll
                for (int bj = 0; bj < 2; ++bj)
#pragma unroll
                    for (int n = 0; n < 2; ++n) bs[m][bj][n] = *(const f32x4*)(base + off + bj * HALF + n * 16); }
#pragma unroll
            for (int m = 0; m < 4; ++m) { const size_t off = (size_t)(r0 + ai * HALF + m * 16) * D + col0;
#pragma unroll
                for (int bj = 0; bj < 2; ++bj)
#pragma unroll
                    for (int n = 0; n < 2; ++n) *(f32x4*)(out + off + bj * HALF + n * 16) = bs[m][bj][n] + g[bj][n] * acc[ai][bj][m][n]; }
            asm volatile("" ::: "memory"); }
    }
};
struct EpiGateBf16 {
    static constexpr bool PERM = true; static constexpr int NSTORE = 16;
    bf16_t* Y; const float* modv; int goff, rowoff, ybase;
    __device__ __forceinline__ void operator()(const Acc& acc, const Unit& u, int wr, int wc, int fr, int fq, LAS unsigned char* xs) const {
        const XStore X(xs, fr, fq);
        const int rt = rowoff + u.pm * BM; const int mr = rt < TC ? 8 : ((rt - TC) >> 12);
        const float* gv = modv + mr * 6144 + goff; const int col0 = u.pn * BM + wc * 32 + 8 * fq;
        f32x4 g[2][2];
#pragma unroll
        for (int bj = 0; bj < 2; ++bj)
#pragma unroll
            for (int n = 0; n < 2; ++n) g[bj][n] = *(const f32x4*)(gv + col0 + bj * HALF + 4 * n);
        bf16_t* yb = Y + (size_t)(rt - ybase + wr * 64 + X.rr) * D + u.pn * BM + wc * 32 + 8 * X.cc;
#pragma unroll
        for (int ai = 0; ai < 2; ++ai)
#pragma unroll
            for (int m = 0; m < 4; ++m) { u32x4 w[2];
#pragma unroll
                for (int bj = 0; bj < 2; ++bj) { const f32x4 v0 = acc[ai][bj][m][0] * g[bj][0], v1 = acc[ai][bj][m][1] * g[bj][1];
                    w[bj].x = cvt_pk_bf16(v0[0], v0[1]); w[bj].y = cvt_pk_bf16(v0[2], v0[3]); w[bj].z = cvt_pk_bf16(v1[0], v1[1]); w[bj].w = cvt_pk_bf16(v1[2], v1[3]); }
                X.put(w[0], w[1]); u32x4 a, b; X.get(a, b);
                bf16_t* rowp = yb + (size_t)(ai * HALF + m * 16) * D; *(u32x4*)rowp = a; *(u32x4*)(rowp + HALF) = b; }
    }
};
struct EpiSwiglu {
    static constexpr bool PERM = true;
    bf16_t* ACT; const float* bgu;
    __device__ __forceinline__ void operator()(const Acc& acc, const Unit& u, int wr, int wc, int fr, int fq, LAS unsigned char* xs) const {
        const XStore X(xs, fr, fq);
        const int a0 = u.pn * HALF + wc * 32 + 8 * fq;
        const float* bp = bgu + (size_t)u.e * 2048 + 2 * a0;
        float bg[8], bl[8];
#pragma unroll
        for (int q = 0; q < 4; ++q) { const f32x4 t = *(const f32x4*)(bp + 4 * q); bg[2 * q] = t[0]; bl[2 * q] = t[1]; bg[2 * q + 1] = t[2]; bl[2 * q + 1] = t[3]; }
        bf16_t* ab = ACT + (size_t)(u.pm * BM + wr * 64 + X.rr) * FF + u.pn * HALF + wc * 32 + 8 * X.cc;
#pragma unroll
        for (int ai = 0; ai < 2; ++ai)
#pragma unroll
            for (int mp = 0; mp < 2; ++mp) { u32x4 w[2];
#pragma unroll
                for (int mm = 0; mm < 2; ++mm) { const int m = 2 * mp + mm; float o[8];
#pragma unroll
                    for (int j = 0; j < 8; ++j) { float xg = acc[ai][0][m][j >> 2][j & 3] + bg[j], xl = acc[ai][1][m][j >> 2][j & 3] + bl[j];
                        xg = fminf(xg, 7.0f); xl = fminf(fmaxf(xl, -7.0f), 7.0f);
                        o[j] = xg * __builtin_amdgcn_rcpf(1.0f + __builtin_amdgcn_exp2f(xg * (-1.702f * 1.4426950408889634f))) * (xl + 1.0f); }
                    w[mm].x = cvt_pk_bf16(o[0], o[1]); w[mm].y = cvt_pk_bf16(o[2], o[3]); w[mm].z = cvt_pk_bf16(o[4], o[5]); w[mm].w = cvt_pk_bf16(o[6], o[7]); }
                X.put(w[0], w[1]); u32x4 a, b; X.get(a, b);
                bf16_t* rowp = ab + (size_t)(ai * HALF + mp * 32) * FF; *(u32x4*)rowp = a; *(u32x4*)(rowp + (size_t)16 * FF) = b; }
    }
};
struct EpiDown {
    static constexpr bool PERM = true;
    bf16_t* YB; const float* bdn;
    __device__ __forceinline__ void operator()(const Acc& acc, const Unit& u, int wr, int wc, int fr, int fq, LAS unsigned char* xs) const {
        const int col0 = u.pn * BM + wc * 32 + 8 * fq;
        f32x4 bv[2][2];
#pragma unroll
        for (int bj = 0; bj < 2; ++bj)
#pragma unroll
            for (int n = 0; n < 2; ++n) bv[bj][n] = *(const f32x4*)(bdn + (size_t)u.e * D + col0 + bj * HALF + 4 * n);
        const XStore X(xs, fr, fq);
        bf16_t* yb = YB + (size_t)(u.pm * BM + wr * 64 + X.rr) * D + u.pn * BM + wc * 32 + 8 * X.cc;
#pragma unroll
        for (int ai = 0; ai < 2; ++ai)
#pragma unroll
            for (int m = 0; m < 4; ++m) { u32x4 w[2];
#pragma unroll
                for (int bj = 0; bj < 2; ++bj) { const f32x4 v0 = acc[ai][bj][m][0] + bv[bj][0], v1 = acc[ai][bj][m][1] + bv[bj][1];
                    w[bj].x = cvt_pk_bf16(v0[0], v0[1]); w[bj].y = cvt_pk_bf16(v0[2], v0[3]); w[bj].z = cvt_pk_bf16(v1[0], v1[1]); w[bj].w = cvt_pk_bf16(v1[2], v1[3]); }
                X.put(w[0], w[1]); u32x4 a, b; X.get(a, b);
                bf16_t* rowp = yb + (size_t)(ai * HALF + m * 16) * D; *(u32x4*)rowp = a; *(u32x4*)(rowp + HALF) = b; }
    }
};
}

struct Args { const float* in[38]; float* out; unsigned char* ws; int ph_lo, ph_hi; };
enum { I_X = 0, I_C, I_CTX, I_CCTX, I_FNG,
       I0_MODW, I0_MODB, I0_N1G, I0_WIN, I0_QNG, I0_WQUP, I0_KVNG, I0_WKVUP, I0_WOUT, I0_N2G, I0_RW, I0_RB, I0_WGU, I0_BGU, I0_WDN, I0_BDN,
       I1_MODW, I1_MODB, I1_N1G, I1_WIN, I1_WGKF, I1_BGKF, I1_WGKB, I1_BGKB, I1_GNG, I1_WOUT, I1_N2G, I1_RW, I1_RB, I1_WGU, I1_BGU, I1_WDN, I1_BDN };

struct Frame {
    const float* const* in; float* out; unsigned char* ws; LAS unsigned char* lds; LAS unsigned char* ring;
    int tid, lane, wave, G, bid;
};
#define WSP(T_, off) ((T_*)(F.ws + (off)))

__device__ __forceinline__ int gu_row(int n) { const int a = n >> 1, half = n & 1; return 256 * (a >> 7) + 128 * half + (a & 127); }
template <int MODE>
__device__ __forceinline__ void cvt_tile(const Frame& F, LAS bf16_t* tile  , const float* src, int ldsrc, int k0, int n0, bf16_t* dst, int ldd, const float* sk, float mul) {
    const int t = F.tid;
    { const int kl = t >> 3, nc = (t & 7) * 8; const float* p = src + (size_t)(k0 + kl) * ldsrc + n0 + nc;
      const f32x4 a = *(const f32x4*)p, b = *(const f32x4*)(p + 4); const float s = (sk ? sk[k0 + kl] : 1.0f) * mul;
      tile[(nc + 0) * 72 + kl] = f2bf(a[0] * s); tile[(nc + 1) * 72 + kl] = f2bf(a[1] * s); tile[(nc + 2) * 72 + kl] = f2bf(a[2] * s); tile[(nc + 3) * 72 + kl] = f2bf(a[3] * s);
      tile[(nc + 4) * 72 + kl] = f2bf(b[0] * s); tile[(nc + 5) * 72 + kl] = f2bf(b[1] * s); tile[(nc + 6) * 72 + kl] = f2bf(b[2] * s); tile[(nc + 7) * 72 + kl] = f2bf(b[3] * s); }
    __syncthreads();
    { const int nl = t >> 3, kc = (t & 7) * 8; const int n = n0 + nl; const int row = MODE == 1 ? gu_row(n) : n;
      const u32x4 v = *(const LAS u32x4*)(tile + nl * 72 + kc); *(u32x4*)(dst + (size_t)row * ldd + k0 + kc) = v; }
    __syncthreads();
}
template <int MODE>
__device__ __forceinline__ void cvt_blk(const Frame& F, LAS float* tl, const float* src, int ldsrc, int k0, int n0, bf16_t* dst, int ldd) {
    const int t = F.tid, w = t >> 6, l = t & 63;
    f32x4 v[8];
#pragma unroll
    for (int i = 0; i < 8; ++i) v[i] = *(const f32x4*)(src + (size_t)(k0 + w + 8 * i) * ldsrc + n0 + 4 * l);
#pragma unroll
    for (int i = 0; i < 8; ++i) *(LAS f32x4*)(tl + (w + 8 * i) * 260 + 4 * l) = v[i];
    __syncthreads();
    { const int n = t & 255, kh = t >> 8; const int row = MODE == 1 ? gu_row(n0 + n) : n0 + n; bf16_t* dp = dst + (size_t)row * ldd + k0 + kh * 32;
#pragma unroll
      for (int q = 0; q < 4; ++q) { float x[8];
#pragma unroll
          for (int j = 0; j < 8; ++j) x[j] = tl[(kh * 32 + 8 * q + j) * 260 + n];
          u32x4 o; o.x = cvt_pk_bf16(x[0], x[1]); o.y = cvt_pk_bf16(x[2], x[3]); o.z = cvt_pk_bf16(x[4], x[5]); o.w = cvt_pk_bf16(x[6], x[7]);
          *(u32x4*)(dp + 8 * q) = o; } }
    __syncthreads();
}
constexpr int CVT_NGU = NE * 16 * 8, CVT_NDN = NE * 16 * 4, CVT_JOBS = CVT_NGU + CVT_NDN;
__device__ __forceinline__ void cvt_moe_job(const Frame& F, LAS float* tl, const float* wgu, const float* wdn, int j) {
    bf16_t* WGU = WSP(bf16_t, WS_WGU); bf16_t* WDN = WSP(bf16_t, WS_WDN);
    if (j < CVT_NGU) { const int e = j >> 7, r = j & 127, kt = r >> 3, ntl = r & 7; cvt_blk<1>(F, tl, wgu + (size_t)e * 1024 * 2048, 2048, kt * 64, ntl * 256, WGU + (size_t)e * 2048 * 1024, 1024); }
    else { const int jj = j - CVT_NGU, e = jj >> 6, r = jj & 63, kt = r >> 2, ntl = r & 3; cvt_blk<0>(F, tl, wdn + (size_t)e * 1024 * 1024, 1024, kt * 64, ntl * 256, WDN + (size_t)e * 1024 * 1024, 1024); }
}
__device__ __forceinline__ void cvt_moe_weights(const Frame& F, LAS float* tl, const float* wgu, const float* wdn) {
    for (int j = F.bid; j < CVT_JOBS; j += F.G) cvt_moe_job(F, tl, wgu, wdn, j);
}
__device__ __forceinline__ void ph_prologue(const Frame& F) {
    LAS float* sc = (LAS float*)(F.ring);
    LAS float* red = (LAS float*)(F.ring + 36864);
    LAS float* ctab = (LAS float*)(F.ring + 55296);
    LAS float* stab = ctab + 4096;
    LAS bf16_t* tile = (LAS bf16_t*)(F.ring + 88064);
    LAS float* wt = (LAS float*)(F.ring + 97280);
    const int t = F.tid;
    for (int i = t; i < 9 * 1024; i += NTHR) { const int r = i >> 10, k = i & 1023; const float v = (r < 8) ? F.in[I_C][r * 1024 + k] : F.in[I_CCTX][k]; sc[i] = siluf(v); }
    for (int i = t; i < 4096; i += NTHR) { const float x = (float)i * (1.0f / 2048.0f); ctab[i] = cospif(x); stab[i] = sinpif(x); }
    __syncthreads();
    for (int u = F.bid; u < 2 * 96; u += F.G) {
        const int l = u / 96, j0 = (u % 96) * 64; const float* W = l ? F.in[I1_MODW] : F.in[I0_MODW]; const float* Bv = l ? F.in[I1_MODB] : F.in[I0_MODB];
        const int c4 = t & 15, kb = F.wave * 128 + ((t >> 4) & 3) * 32; f32x4 a[9];
#pragma unroll
        for (int r = 0; r < 9; ++r) a[r] = (f32x4){0.f, 0.f, 0.f, 0.f};
#pragma unroll 8
        for (int q = 0; q < 32; ++q) { const f32x4 w = *(const f32x4*)(W + (size_t)(kb + q) * 6144 + j0 + 4 * c4);
#pragma unroll
            for (int r = 0; r < 9; ++r) a[r] += w * sc[r * 1024 + kb + q]; }
#pragma unroll
        for (int r = 0; r < 9; ++r) {
#pragma unroll
            for (int j = 0; j < 4; ++j) { float v = a[r][j]; v += __shfl_xor(v, 16); v += __shfl_xor(v, 32); a[r][j] = v; }
            if ((t & 48) == 0) *(LAS f32x4*)(red + (F.wave * 9 + r) * 64 + 4 * c4) = a[r]; }
        __syncthreads();
        for (int i = t; i < 576; i += NTHR) { const int r = i >> 6, c = i & 63; float s = 0.f;
#pragma unroll
            for (int q = 0; q < 8; ++q) s += red[(q * 9 + r) * 64 + c];
            WSP(float, WS_MODV)[(size_t)(l * 9 + r) * 6144 + j0 + c] = s + Bv[j0 + c]; }
        __syncthreads();
    }
    if (F.bid == (1 % F.G)) { for (int i = t; i < 1024; i += NTHR) { const int pos = i >> 4, j = i & 15; const float inv = powf(10000.0f, -(float)j / 16.0f); const float ang = (float)pos * inv;
        WSP(float, WS_ROPE)[i] = cosf(ang); WSP(float, WS_ROPE)[1024 + i] = sinf(ang); } }
    { bf16_t* DFT = WSP(bf16_t, R0_DFT); bf16_t* DFTC = WSP(bf16_t, R0_DFTC);
      for (int k = F.bid; k < 4096 + 256; k += F.G) {
          if (k < 4096) { for (int jc = t; jc < 512; jc += NTHR) { const int j0 = jc * 8; float v[8];
#pragma unroll
                  for (int q = 0; q < 8; ++q) { const int j = j0 + q; const bool isS = j > 2048; const int idx = (k * (isS ? j - 2048 : j)) & 4095; v[q] = (isS ? stab[idx] : ctab[idx]) * (1.0f / 512.0f); }
                  u32x4 w; w.x = pk2(v[0], v[1]); w.y = pk2(v[2], v[3]); w.z = pk2(v[4], v[5]); w.w = pk2(v[6], v[7]); *(u32x4*)(DFT + (size_t)k * 4096 + j0) = w; } }
          else { const int kk = k - 4096; for (int jc = t; jc < 32; jc += NTHR) { const int j0 = jc * 8; float v[8];
#pragma unroll
                  for (int q = 0; q < 8; ++q) { const int j = j0 + q; const bool isS = j > 128; const int idx = ((kk * (isS ? j - 128 : j)) & 255) * 16; v[q] = (isS ? stab[idx] : ctab[idx]) * (1.0f / 128.0f); }
                  u32x4 w; w.x = pk2(v[0], v[1]); w.y = pk2(v[2], v[3]); w.z = pk2(v[4], v[5]); w.w = pk2(v[6], v[7]); *(u32x4*)(DFTC + (size_t)kk * 256 + j0) = w; } }
      } }
    { bf16_t* WF = WSP(bf16_t, WS_WF); const float* Win = F.in[I0_WIN];
      for (int j = (F.bid + 64) % F.G; j < 64; j += F.G) { const int k0 = (j >> 2) * 64, g = j & 3;
          for (int i = t; i < 4096; i += NTHR) { const int kl = i >> 6, c = i & 63; wt[kl * 65 + c] = Win[(size_t)(k0 + kl) * 960 + 704 + g * 64 + c]; }
          __syncthreads();
          { const int kl = t & 63, mg = t >> 6;
#pragma unroll 1
            for (int mm = 0; mm < 8; ++mm) { const int m = mg * 8 + mm; float ac = 0.f, as = 0.f;
                for (int c = 0; c < 64; ++c) { const int idx = ((m * c) & 63) * 64; const float w = wt[kl * 65 + c]; ac = fmaf(w, ctab[idx], ac); as = fmaf(w, stab[idx], as); }
                WF[(size_t)(g * 64 + m) * 1024 + k0 + kl] = f2bf(ac); WF[(size_t)(256 + g * 64 + m) * 1024 + k0 + kl] = f2bf(-as); } }
          __syncthreads(); } }
    for (int i = F.bid * NTHR + t; i < 2 * 32 * 1024; i += F.G * NTHR) { const int l = i >> 15, e = (i >> 10) & 31, k = i & 1023; const float w = (l ? F.in[I1_RW] : F.in[I0_RW])[k * 32 + e];
        const bf16_t hi = f2bf(w); const bf16_t lo = f2bf(w - bf2f(hi)); bf16_t* base = WSP(bf16_t, WS_RWT) + (size_t)l * 2 * 32 * 1024; base[e * 1024 + k] = hi; base[32 * 1024 + e * 1024 + k] = lo; }
    {
      constexpr int J_WIN0 = 16 * 11, J_WQ = 6 * 18, J_WKV = 4 * 24, J_WO = 16 * 16, J_WIN1 = 16 * 48;
      constexpr int JT = J_WIN0 + J_WQ + J_WKV + 2 * J_WO + J_WIN1;
      for (int j = F.bid; j < JT; j += F.G) { int r = j;
          if (r < J_WIN0) { cvt_tile<0>(F, tile, F.in[I0_WIN], 960, (r / 11) * 64, (r % 11) * 64, WSP(bf16_t, WS_WIN0), 1024, nullptr, 1.0f); continue; } r -= J_WIN0;
          if (r < J_WQ) { cvt_tile<0>(F, tile, F.in[I0_WQUP], 1152, (r / 18) * 64, (r % 18) * 64, WSP(bf16_t, WS_WQ), QL, F.in[I0_QNG], 1.0f); continue; } r -= J_WQ;
          if (r < J_WKV) { cvt_tile<0>(F, tile, F.in[I0_WKVUP], 1536, (r / 24) * 64, (r % 24) * 64, WSP(bf16_t, WS_WKV), KVL, F.in[I0_KVNG], 1.0f); continue; } r -= J_WKV;
          if (r < J_WO) { cvt_tile<0>(F, tile, F.in[I0_WOUT], 1024, (r / 16) * 64, (r % 16) * 64, WSP(bf16_t, WS_WOUT0), 1024, nullptr, 1.0f); continue; } r -= J_WO;
          if (r < J_WO) { cvt_tile<0>(F, tile, F.in[I1_WOUT], 1024, (r / 16) * 64, (r % 16) * 64, WSP(bf16_t, WS_WOUT1), 1024, nullptr, 1.0f); continue; } r -= J_WO;
          { const int n0 = (r % 48) * 64; cvt_tile<0>(F, tile, F.in[I1_WIN], 3104, (r / 48) * 64, n0, WSP(bf16_t, WS_WIN1), 1024, nullptr, n0 < 512 ? 0.08838834764831845f : 1.0f); }
      }
      for (int i = F.bid * NTHR + t; i < (64 * 1024 + 128 * QL) / 8; i += F.G * NTHR) { const u32x4 z = {0u, 0u, 0u, 0u};
          if (i < 64 * 1024 / 8) *(u32x4*)(WSP(bf16_t, WS_WIN0) + (size_t)704 * 1024 + (size_t)i * 8) = z; else *(u32x4*)(WSP(bf16_t, WS_WQ) + (size_t)1152 * QL + (size_t)(i - 64 * 1024 / 8) * 8) = z; }
    }
}

__device__ __forceinline__ const float* xrow_in(const Frame& F, int r) { return r < TC ? F.in[I_CTX] + (size_t)r * D : F.in[I_X] + (size_t)(r - TC) * D; }
__device__ __forceinline__ float* xrow_res(const Frame& F, int r) { return r < TC ? WSP(float, WS_XCTX) + (size_t)r * D : F.out + (size_t)(r - TC) * D; }
__device__ __forceinline__ bf16_t* xrow_b(const Frame& F, int r) { return WSP(bf16_t, R1_XB) + (size_t)(r - TC) * D; }
__device__ __forceinline__ int modrow(int r) { return r < TC ? 8 : ((r - TC) >> 12); }
__device__ __forceinline__ void ld16f(const float* p, int lane, float (&v)[16]) {
#pragma unroll
    for (int h = 0; h < 2; ++h) { const f32x4 a = *(const f32x4*)(p + 8 * lane + 512 * h), b = *(const f32x4*)(p + 8 * lane + 512 * h + 4);
        v[8 * h] = a[0]; v[8 * h + 1] = a[1]; v[8 * h + 2] = a[2]; v[8 * h + 3] = a[3]; v[8 * h + 4] = b[0]; v[8 * h + 5] = b[1]; v[8 * h + 6] = b[2]; v[8 * h + 7] = b[3]; }
}
__device__ __forceinline__ void st16f(float* p, int lane, const float (&v)[16]) {
#pragma unroll
    for (int h = 0; h < 2; ++h) { *(f32x4*)(p + 8 * lane + 512 * h) = (f32x4){v[8 * h], v[8 * h + 1], v[8 * h + 2], v[8 * h + 3]}; *(f32x4*)(p + 8 * lane + 512 * h + 4) = (f32x4){v[8 * h + 4], v[8 * h + 5], v[8 * h + 6], v[8 * h + 7]}; }
}
__device__ __forceinline__ void ld16b(const bf16_t* p, int lane, float (&v)[16]) {
#pragma unroll
    for (int h = 0; h < 2; ++h) { const u32x4 w = *(const u32x4*)(p + 8 * lane + 512 * h);
#pragma unroll
        for (int q = 0; q < 4; ++q) { v[8 * h + 2 * q] = __uint_as_float(w[q] << 16); v[8 * h + 2 * q + 1] = __uint_as_float(w[q] & 0xffff0000u); } }
}
__device__ __forceinline__ void st16b(bf16_t* p, int lane, const float (&v)[16]) {
#pragma unroll
    for (int h = 0; h < 2; ++h) { u32x4 w; w.x = cvt_pk_bf16(v[8 * h], v[8 * h + 1]); w.y = cvt_pk_bf16(v[8 * h + 2], v[8 * h + 3]); w.z = cvt_pk_bf16(v[8 * h + 4], v[8 * h + 5]); w.w = cvt_pk_bf16(v[8 * h + 6], v[8 * h + 7]);
        *(u32x4*)(p + 8 * lane + 512 * h) = w; }
}
__device__ __forceinline__ void modulate16(float (&v)[16], const float* g, const float* scale, const float* shift, int lane) {
    float ss = 0.f;
#pragma unroll
    for (int i = 0; i < 16; ++i) ss = fmaf(v[i], v[i], ss);
    const float rs = rsqrtf(wsum(ss) * (1.0f / D) + EPS);
    float gg[16], sc[16], sh[16]; ld16f(g, lane, gg); ld16f(scale, lane, sc); ld16f(shift, lane, sh);
#pragma unroll
    for (int i = 0; i < 16; ++i) v[i] = v[i] * rs * gg[i] * (1.0f + sc[i]) + sh[i];
}

__device__ __forceinline__ void ph_mod0(const Frame& F) {
    const float* g = F.in[I0_N1G]; bf16_t* H = WSP(bf16_t, WS_H);
    for (int r = F.bid * NWAVE + F.wave; r < T; r += F.G * NWAVE) {
        const float* mv = WSP(float, WS_MODV) + (size_t)modrow(r) * 6144;
        float v[16]; ld16f(xrow_in(F, r), F.lane, v);
        modulate16(v, g, mv + 1024, mv, F.lane);
        st16b(H + (size_t)r * D, F.lane, v);
    }
}
__device__ __forceinline__ void ph_rowstats(const Frame& F) {
    const bf16_t* U0 = WSP(bf16_t, R0_U0); float* rsq = WSP(float, WS_RS); float* rskv = rsq + T; bf16_t* KR = WSP(bf16_t, R0_KR);
    const float* rc = WSP(float, WS_ROPE); const float* rsn = rc + 1024;
    for (int r = F.bid * NWAVE + F.wave; r < T; r += F.G * NWAVE) {
        const bf16_t* u = U0 + (size_t)r * U0W; const int lane = F.lane;
        float a[8], b[8];
        { const u32x4 w = *(const u32x4*)(u + 8 * lane);
#pragma unroll
          for (int q = 0; q < 4; ++q) { a[2 * q] = __uint_as_float(w[q] << 16); a[2 * q + 1] = __uint_as_float(w[q] & 0xffff0000u); } }
        { u32x4 w = {0u, 0u, 0u, 0u}; if (lane < 32) w = *(const u32x4*)(u + 512 + 8 * lane);
#pragma unroll
          for (int q = 0; q < 4; ++q) { b[2 * q] = __uint_as_float(w[q] << 16); b[2 * q + 1] = __uint_as_float(w[q] & 0xffff0000u); } }
        float sa = 0.f, sb = 0.f;
#pragma unroll
        for (int j = 0; j < 8; ++j) { sa = fmaf(a[j], a[j], sa); sb = fmaf(b[j], b[j], sb); }
        const float sq = wsum(lane < 48 ? sa : 0.f), skv = wsum((lane >= 48 ? sa : 0.f) + (lane < 16 ? sb : 0.f));
        float pr[8];
#pragma unroll
        for (int j = 0; j < 8; ++j) pr[j] = __shfl_xor(b[j], 2);
        if (lane >= 16 && lane < 24) { const int jq = lane - 16, quarter = jq >> 1;
            if (r >= TC) { const int n = (r - TC) & 4095; const int pos = (quarter >= 2) ? (n & 63) : (n >> 6); const float* cp = rc + pos * 16 + (jq & 1) * 8; const float* sp = rsn + pos * 16 + (jq & 1) * 8;
#pragma unroll
                for (int j = 0; j < 8; ++j) b[j] = (quarter & 1) ? (b[j] * cp[j] + pr[j] * sp[j]) : (b[j] * cp[j] - pr[j] * sp[j]); }
            u32x4 w; w.x = cvt_pk_bf16(b[0], b[1]); w.y = cvt_pk_bf16(b[2], b[3]); w.z = cvt_pk_bf16(b[4], b[5]); w.w = cvt_pk_bf16(b[6], b[7]);
            *(u32x4*)(KR + (size_t)r * ROPE + 8 * jq) = w; }
        if (lane == 0) { rsq[r] = rsqrtf(sq * (1.0f / QL) + EPS); rskv[r] = rsqrtf(skv * (1.0f / KVL) + EPS); }
    }
    { const bf16_t* TT = WSP(bf16_t, R0_TT); const bf16_t* TTC = WSP(bf16_t, R0_TTC); bf16_t* TT2 = WSP(bf16_t, R0_TT2); bf16_t* TTC2 = WSP(bf16_t, R0_TTC2);
      const int nch_l = NB * 256 * 512, nch_c = NB * 256 * 32;
      for (int i = F.bid * NTHR + F.tid; i < nch_l + nch_c; i += F.G * NTHR) {
          const bool lat = i < nch_l; const int ii = lat ? i : i - nch_l; const int N = lat ? 4096 : 256; const int cpr = N >> 3; const int row = ii / cpr, p0 = (ii % cpr) * 8;
          const bf16_t* src = (lat ? TT : TTC) + (size_t)row * 2 * N; bf16_t* dst = (lat ? TT2 : TTC2) + (size_t)row * N + p0; float v[8];
#pragma unroll
          for (int q = 0; q < 8; ++q) { const int pp = p0 + q; const bool cs = pp <= (N >> 1); const int j = cs ? pp : pp - (N >> 1); const bf16_t* X = cs ? src : src + N;
              const float a = bf2f(X[j]); const float bmir = (j == 0 || j == (N >> 1)) ? 0.f : bf2f(X[N - j]); v[q] = cs ? a + bmir : a - bmir; }
          u32x4 w; w.x = pk2(v[0], v[1]); w.y = pk2(v[2], v[3]); w.z = pk2(v[4], v[5]); w.w = pk2(v[6], v[7]); *(u32x4*)dst = w; }
    }
}

namespace att {
typedef float f32x16 __attribute__((ext_vector_type(16)));
typedef short s16x4 __attribute__((ext_vector_type(4)));
constexpr float SCALE = 0.07216878364870322f, THR = 8.f;
constexpr int SHM_V = 16384, SHM_KN = 64 * 272, SHM_KR = 64 * 144, SHM_QW = 32 * 272;
constexpr int OFF_V = 0, OFF_KN = 2 * SHM_V, OFF_KR = OFF_KN + 2 * SHM_KN, OFF_WS = OFF_KR + 2 * SHM_KR, OFF_QR = OFF_WS + 2048;
#define KNSWZ(row, cb) ((row) * 272 + (cb))
#define KRSWZ(row, cb) ((row) * 144 + (cb))
#define SBAR() __builtin_amdgcn_sched_barrier(0)
__device__ __forceinline__ int crow(int r, int hi) { return (r & 3) + 8 * (r >> 2) + 4 * hi; }
__device__ __forceinline__ void partialSM(f32x16& p0, f32x16& p1, float& m_reg, float& mn, float& alpha) {
  constexpr float C = SCALE * 1.4426950408889634f;
  float pmax = p0[0];
#pragma unroll
  for (int r = 1; r < 16; ++r) pmax = fmaxf(pmax, p0[r]);
#pragma unroll
  for (int r = 0; r < 16; ++r) pmax = fmaxf(pmax, p1[r]);
  { auto rr = __builtin_amdgcn_permlane32_swap(__float_as_uint(pmax), __float_as_uint(pmax), false, false);
    pmax = fmaxf(__uint_as_float(rr[0]), __uint_as_float(rr[1])); }
  if (__builtin_expect(__all(pmax - m_reg <= THR / SCALE), 1)) { mn = m_reg; alpha = 1.f; }
  else { mn = fmaxf(m_reg, pmax); alpha = __builtin_amdgcn_exp2f((m_reg - mn) * C); m_reg = mn; }
  const float mnC = -mn * C;
#pragma unroll
  for (int r = 0; r < 16; ++r) p0[r] = fmaf(p0[r], C, mnC);
#pragma unroll
  for (int r = 0; r < 16; ++r) p1[r] = fmaf(p1[r], C, mnC);
#pragma unroll
  for (int r = 0; r < 16; ++r) p0[r] = __builtin_amdgcn_exp2f(p0[r]);
}
__device__ __forceinline__ void finishSM(f32x16& p0, f32x16& p1, float alpha, float& l_reg, bf16x8& pa0, bf16x8& pa1, bf16x8& pa2, bf16x8& pa3) {
#pragma unroll
  for (int r = 0; r < 16; ++r) p1[r] = __builtin_amdgcn_exp2f(p1[r]);
  float ps = 0;
#pragma unroll
  for (int r = 0; r < 16; ++r) ps += p0[r];
#pragma unroll
  for (int r = 0; r < 16; ++r) ps += p1[r];
  { auto rr = __builtin_amdgcn_permlane32_swap(__float_as_uint(ps), __float_as_uint(ps), false, false);
    ps = __uint_as_float(rr[0]) + __uint_as_float(rr[1]); }
  l_reg = l_reg * alpha + ps;
#define PK4(P, BASE, OUT) do { unsigned a0 = cvt_pk_bf16(P[BASE + 0], P[BASE + 1]), a1 = cvt_pk_bf16(P[BASE + 2], P[BASE + 3]);   \
    unsigned b0 = cvt_pk_bf16(P[BASE + 4], P[BASE + 5]), b1 = cvt_pk_bf16(P[BASE + 6], P[BASE + 7]);                              \
    auto r0 = __builtin_amdgcn_permlane32_swap(a0, b0, false, false); auto r1 = __builtin_amdgcn_permlane32_swap(a1, b1, false, false); \
    u32x4 w = {r0[0], r1[0], r0[1], r1[1]}; OUT = *reinterpret_cast<bf16x8*>(&w); } while (0)
  PK4(p0, 0, pa0); PK4(p0, 8, pa1); PK4(p1, 0, pa2); PK4(p1, 8, pa3);
#undef PK4
}
__device__ __forceinline__ void qkt(f32x16& p0, f32x16& p1, const LAS char* Kn, const LAS char* Kr, const bf16x8 (&qr)[4], const LAS char* Qr, int r32, int hi) {
  p0 = f32x16{}; p1 = f32x16{};
#pragma unroll
  for (int d0 = 0; d0 < 8; ++d0) { const int cb = (d0 * 16 + hi * 8) * 2;
    const bf16x8 b0 = *(const LAS bf16x8*)(Kn + KNSWZ(r32, cb));
    const bf16x8 b1 = *(const LAS bf16x8*)(Kn + KNSWZ(32 + r32, cb));
    bf16x8 qq; if (d0 < 4) qq = qr[d0]; else qq = *(const LAS bf16x8*)(Qr + KNSWZ(r32, ((d0 - 4) * 16 + hi * 8) * 2));
    p0 = __builtin_amdgcn_mfma_f32_32x32x16_bf16(b0, qq, p0, 0, 0, 0);
    p1 = __builtin_amdgcn_mfma_f32_32x32x16_bf16(b1, qq, p1, 0, 0, 0); }
#pragma unroll
  for (int d0 = 0; d0 < 4; ++d0) { const int cb = (d0 * 16 + hi * 8) * 2;
    const bf16x8 b0 = *(const LAS bf16x8*)(Kr + KRSWZ(r32, cb));
    const bf16x8 b1 = *(const LAS bf16x8*)(Kr + KRSWZ(32 + r32, cb));
    const bf16x8 qq = *(const LAS bf16x8*)(Qr + KNSWZ(r32, ((4 + d0) * 16 + hi * 8) * 2));
    p0 = __builtin_amdgcn_mfma_f32_32x32x16_bf16(b0, qq, p0, 0, 0, 0);
    p1 = __builtin_amdgcn_mfma_f32_32x32x16_bf16(b1, qq, p1, 0, 0, 0); }
}
__device__ __forceinline__ int v_st(int k, int c) { const int kk = (k & ~0xC) | ((k & 4) << 1) | ((k & 8) >> 1); return ((kk >> 3) * 4 + (c >> 5)) * 512 + ((kk & 7) * 32 + (c & 31)) * 2; }
__device__ __forceinline__ int v_rd_base(int lane) { return ((lane & 3) << 3) | (((lane >> 2) & 3) << 6) | (((lane >> 4) & 1) << 5) | (((lane >> 5) & 1) << 8); }
constexpr int v_rd_off(int d0, int ks, int half) { return d0 * 512 + ks * 4096 + half * 2048; }
template <int OFF> __device__ __forceinline__ s16x4 tr_read(int vb) {
  s16x4 r; asm volatile("ds_read_b64_tr_b16 %0, %1 offset:%2" : "=&v"(r) : "v"(vb), "i"(OFF) : "memory"); return r;
}
template <int D0> __device__ __forceinline__ void pv_one(f32x16& od, int vb, bf16x8 pa0, bf16x8 pa1, bf16x8 pa2, bf16x8 pa3) {
  const s16x4 l0 = tr_read<v_rd_off(D0, 0, 0)>(vb), h0 = tr_read<v_rd_off(D0, 0, 1)>(vb), l1 = tr_read<v_rd_off(D0, 1, 0)>(vb), h1 = tr_read<v_rd_off(D0, 1, 1)>(vb);
  const s16x4 l2 = tr_read<v_rd_off(D0, 2, 0)>(vb), h2 = tr_read<v_rd_off(D0, 2, 1)>(vb), l3 = tr_read<v_rd_off(D0, 3, 0)>(vb), h3 = tr_read<v_rd_off(D0, 3, 1)>(vb);
  asm volatile("s_waitcnt lgkmcnt(0)" ::: "memory"); SBAR();
#define PK(L, H) (bf16x8){L[0], L[1], L[2], L[3], H[0], H[1], H[2], H[3]}
  od = __builtin_amdgcn_mfma_f32_32x32x16_bf16(pa0, PK(l0, h0), od, 0, 0, 0);
  od = __builtin_amdgcn_mfma_f32_32x32x16_bf16(pa1, PK(l1, h1), od, 0, 0, 0);
  od = __builtin_amdgcn_mfma_f32_32x32x16_bf16(pa2, PK(l2, h2), od, 0, 0, 0);
  od = __builtin_amdgcn_mfma_f32_32x32x16_bf16(pa3, PK(l3, h3), od, 0, 0, 0);
#undef PK
}
__device__ __forceinline__ void pv_d0(f32x16 (&o)[4], int vb, bf16x8 pa0, bf16x8 pa1, bf16x8 pa2, bf16x8 pa3) {
  pv_one<0>(o[0], vb, pa0, pa1, pa2, pa3); pv_one<1>(o[1], vb, pa0, pa1, pa2, pa3); pv_one<2>(o[2], vb, pa0, pa1, pa2, pa3); pv_one<3>(o[3], vb, pa0, pa1, pa2, pa3);
}
__device__ __forceinline__ void attn_unit(const bf16_t* __restrict__ Q, const bf16_t* __restrict__ KV, const bf16_t* __restrict__ KR, bf16_t* __restrict__ MIX,
                                          const float* __restrict__ ropec, const float* __restrict__ ropes, int h, int qrow0, bool lat, int crow0, int lrow0, int NT, LAS char* lds) {
  int tid = threadIdx.x; asm volatile("" : "+v"(tid));
  const int wid = __builtin_amdgcn_readfirstlane(tid >> 6), lane = tid & 63, r32 = lane & 31, hi = lane >> 5;
  LAS char* V_lds = lds + OFF_V; LAS char* KN_lds = lds + OFF_KN; LAS char* KR_lds = lds + OFF_KR;
  LAS float* ws = (LAS float*)(lds + OFF_WS) + wid * 64; LAS float* li_l = ws; LAS float* al_l = ws + 32;
  float m_reg = -1e30f, l_reg = 0; f32x16 o[4] = {}; bf16x8 qr[4];
  LAS char* Qr = lds + OFF_QR + wid * SHM_QW;
  { const int qrow = qrow0 + wid * 32 + r32; const bf16_t* Qw = Q + (size_t)qrow * QW + h * QKD + hi * 8;
#pragma unroll
    for (int d0 = 0; d0 < 4; ++d0) qr[d0] = *(const bf16x8*)(Qw + d0 * 16);
#pragma unroll
    for (int d0 = 4; d0 < 8; ++d0) *(LAS bf16x8*)(Qr + KNSWZ(r32, ((d0 - 4) * 16 + hi * 8) * 2)) = *(const bf16x8*)(Qw + d0 * 16);
    const int n = (qrow - TC) & 4095;
#pragma unroll
    for (int ax = 0; ax < 2; ++ax) {
      const bf16x8 q1 = *(const bf16x8*)(Qw + (8 + 2 * ax) * 16), q2 = *(const bf16x8*)(Qw + (9 + 2 * ax) * 16);
      u32x4 w1 = *reinterpret_cast<const u32x4*>(&q1), w2 = *reinterpret_cast<const u32x4*>(&q2);
      if (lat) { const int pos = ax ? (n & 63) : (n >> 6); const float* cp = ropec + pos * 16 + hi * 8; const float* sp = ropes + pos * 16 + hi * 8;
#pragma unroll
        for (int j = 0; j < 4; ++j) { const float c0 = cp[2 * j], s0 = sp[2 * j], c1 = cp[2 * j + 1], s1 = sp[2 * j + 1];
          const float a0 = bf2f((bf16_t)q1[2 * j]), a1 = bf2f((bf16_t)q1[2 * j + 1]), b0 = bf2f((bf16_t)q2[2 * j]), b1 = bf2f((bf16_t)q2[2 * j + 1]);
          w1[j] = cvt_pk_bf16(a0 * c0 - b0 * s0, a1 * c1 - b1 * s1);
          w2[j] = cvt_pk_bf16(b0 * c0 + a0 * s0, b1 * c1 + a1 * s1); } }
      *(LAS u32x4*)(Qr + KNSWZ(r32, ((4 + 2 * ax) * 16 + hi * 8) * 2)) = w1; *(LAS u32x4*)(Qr + KNSWZ(r32, ((5 + 2 * ax) * 16 + hi * 8) * 2)) = w2; }
  }
  const int sr = tid >> 4, sc = (tid & 15) * 8, vst0 = v_st(sr, sc), vst1 = v_st(32 + sr, sc);
  const int rr = tid >> 3, rc = (tid & 7) * 8;
  const int vb0 = (int)(uintptr_t)V_lds + v_rd_base(lane);
  const bf16_t* KVh = KV + h * 256;
  const int nctx_t = lat ? 4 : NT;
  bf16x8 vs0, vs1, ks0, ks1, krs;
#define TROW(kt) ((kt) < nctx_t ? crow0 + (kt) * 64 : lrow0 + ((kt) - nctx_t) * 64)
#define SLOAD(kt) do { const int _r0 = TROW(kt); const bf16_t* _p0 = KVh + (size_t)(_r0 + sr) * KVW + sc; const bf16_t* _p1 = KVh + (size_t)(_r0 + 32 + sr) * KVW + sc; \
    vs0 = *(const bf16x8*)(_p0 + 128); vs1 = *(const bf16x8*)(_p1 + 128); ks0 = *(const bf16x8*)_p0; ks1 = *(const bf16x8*)_p1; krs = *(const bf16x8*)(KR + (size_t)(_r0 + rr) * ROPE + rc); } while (0)
#define SWRITE(b) do { *(LAS bf16x8*)(V_lds + (b) * SHM_V + vst0) = vs0; *(LAS bf16x8*)(V_lds + (b) * SHM_V + vst1) = vs1; \
    *(LAS bf16x8*)(KN_lds + (b) * SHM_KN + KNSWZ(sr, sc * 2)) = ks0; *(LAS bf16x8*)(KN_lds + (b) * SHM_KN + KNSWZ(32 + sr, sc * 2)) = ks1; \
    *(LAS bf16x8*)(KR_lds + (b) * SHM_KR + KRSWZ(rr, rc * 2)) = krs; } while (0)
#define SWAIT() asm volatile("s_waitcnt vmcnt(0)" ::: "memory")
#define RESC(a) do { if (__any((a) < 1.f)) { if (hi == 0) al_l[r32] = (a); asm volatile("s_waitcnt lgkmcnt(0)" ::: "memory"); \
    _Pragma("unroll") for (int d = 0; d < 4; ++d) _Pragma("unroll") for (int r = 0; r < 16; ++r) o[d][r] *= al_l[crow(r, hi)]; } } while (0)
  f32x16 pA0, pA1, pB0, pB1; float mnA, mnB, alA, alB; bf16x8 pa0, pa1, pa2, pa3;
  SLOAD(0); SWAIT(); SWRITE(0); __syncthreads();
  qkt(pA0, pA1, KN_lds, KR_lds, qr, Qr, r32, hi); partialSM(pA0, pA1, m_reg, mnA, alA);
  SLOAD(1); SWAIT(); SWRITE(1); __syncthreads();
  for (int j = 1; j + 1 < NT; j += 2) {
    SBAR(); qkt(pB0, pB1, KN_lds + SHM_KN, KR_lds + SHM_KR, qr, Qr, r32, hi);
    finishSM(pA0, pA1, alA, l_reg, pa0, pa1, pa2, pa3); SBAR();
    SLOAD(j + 1); SBAR();
    pv_d0(o, vb0, pa0, pa1, pa2, pa3); partialSM(pB0, pB1, m_reg, mnB, alB);
    __syncthreads(); SWAIT(); SWRITE(0);
    RESC(alB); __syncthreads();
    SBAR(); qkt(pA0, pA1, KN_lds, KR_lds, qr, Qr, r32, hi);
    finishSM(pB0, pB1, alB, l_reg, pa0, pa1, pa2, pa3); SBAR();
    SLOAD(j + 2); SBAR();
    pv_d0(o, vb0 + SHM_V, pa0, pa1, pa2, pa3); partialSM(pA0, pA1, m_reg, mnA, alA);
    __syncthreads(); SWAIT(); SWRITE(1);
    RESC(alA); __syncthreads();
  }
  SBAR(); qkt(pB0, pB1, KN_lds + SHM_KN, KR_lds + SHM_KR, qr, Qr, r32, hi);
  finishSM(pA0, pA1, alA, l_reg, pa0, pa1, pa2, pa3); SBAR();
  pv_d0(o, vb0, pa0, pa1, pa2, pa3); partialSM(pB0, pB1, m_reg, mnB, alB);
  __syncthreads(); RESC(alB);
  finishSM(pB0, pB1, alB, l_reg, pa0, pa1, pa2, pa3); SBAR();
  pv_d0(o, vb0 + SHM_V, pa0, pa1, pa2, pa3);
  if (hi == 0) li_l[r32] = l_reg; asm volatile("s_waitcnt lgkmcnt(0)" ::: "memory");
  float rli[16];
#pragma unroll
  for (int r = 0; r < 16; ++r) rli[r] = __builtin_amdgcn_rcpf(li_l[crow(r, hi)]);
  int tid2 = threadIdx.x; asm volatile("" : "+v"(tid2));
  const int r32e = tid2 & 31, hie = (tid2 >> 5) & 1;
  bf16_t* Ow = MIX + (size_t)(qrow0 + wid * 32) * D + h * VD + r32e;
#pragma unroll
  for (int r = 0; r < 16; ++r) { const int orow = crow(r, hie);
#pragma unroll
    for (int d0 = 0; d0 < 4; ++d0) Ow[(size_t)orow * D + d0 * 32] = f2bf(o[d0][r] * rli[r]); }
  __syncthreads();
#undef TROW
#undef SLOAD
#undef SWRITE
#undef SWAIT
#undef RESC
}
}
constexpr int Q5_ATT = 768, Q5_DFT = Q5_ATT + 128, Q5_ATTC = Q5_DFT + 48, Q5_DFTC = Q5_ATTC + 8, Q5_END = Q5_DFTC + CVT_JOBS;
__device__ __forceinline__ void ph_queue5(const Frame& F) {
    unsigned* qhead = (unsigned*)(F.ws + WS_CTL + CW_Q5);
    LAS int* qslot = (LAS int*)(F.lds + 640);
    const bf16_t* Q = WSP(bf16_t, R0_Q); const bf16_t* KV = WSP(bf16_t, R0_KV); const bf16_t* KR = WSP(bf16_t, R0_KR); bf16_t* MIX = WSP(bf16_t, R0_MIX);
    const float* rc = WSP(float, WS_ROPE); const float* rs = rc + 1024;
    for (;;) {
        __syncthreads();
        if (F.tid == 0) qslot[0] = (int)__hip_atomic_fetch_add(qhead, 1u, __ATOMIC_RELAXED, __HIP_MEMORY_SCOPE_AGENT);
        __syncthreads();
        const int it = __builtin_amdgcn_readfirstlane(qslot[0]);
        if (it >= Q5_END) break;
        if (it < Q5_ATT) { const int b = it / 96, rem = it % 96, h = rem / 16, qb = rem % 16;
            att::attn_unit(Q, KV, KR, MIX, rc, rs, h, TC + b * 4096 + qb * 256, true, b * 256, TC + b * 4096, 68, (LAS char*)F.ring); }
        else if (it < Q5_DFT || (it >= Q5_ATTC && it < Q5_DFTC)) {
            const bool lat = it < Q5_DFT; const int i = lat ? it - Q5_ATT : it - Q5_ATTC; const int b = lat ? i >> 4 : i, pm = lat ? i & 15 : 0; const int K = lat ? 4096 : 256;
            pg8::OneUnit S; S.lda = K; S.u0.pm = pm; S.u0.pn = 0; S.u0.e = b; S.u0.cnt = 0;
            S.u0.A = (const char*)(lat ? WSP(bf16_t, R0_DFT) : WSP(bf16_t, R0_DFTC)) + (size_t)pm * 256 * K * 2;
            S.u0.B = (const char*)(lat ? WSP(bf16_t, R0_TT2) : WSP(bf16_t, R0_TTC2)) + (size_t)b * 256 * K * 2;
            pg8::EpiFourOut E{MIX, lat ? TC : 0, lat ? 4096 : 256};
            pg8::gemm_phase<pg8::EpiFourOut, pg8::OneUnit>(F.ring, pg8::Gemm{K, K, K}, S, E); }
        else if (it < Q5_ATTC) { const int uu = it - Q5_DFT, b = uu / 6, h = uu % 6;
            att::attn_unit(Q, KV, KR, MIX, rc, rs, h, b * 256, false, b * 256, 0, 4, (LAS char*)F.ring); }
        else cvt_moe_job(F, (LAS float*)F.ring, F.in[I0_WGU], F.in[I0_WDN], it - Q5_DFTC);
    }
}

__device__ __forceinline__ void load_w32(const Frame& F, LAS float* wl, const float* W, int ldw) {
    for (int i = F.tid; i < 1024 * 8; i += NTHR) { const int r = i >> 3, q = i & 7; const int c = 8 * (r & 63) + 512 * (r >> 9) + ((r >> 6) & 7); const f32x4 v = *(const f32x4*)(W + (size_t)c * ldw + q * 4); *(LAS f32x4*)(wl + r * 36 + q * 4) = v; }
}
__device__ __forceinline__ float row_gemv32(const float (&v)[16], const LAS float* wl, int lane) {
    float p[32];
#pragma unroll
    for (int e = 0; e < 32; ++e) p[e] = 0.f;
#pragma unroll
    for (int i = 0; i < 16; ++i) { const LAS float* wr_ = wl + (lane + 64 * i) * 36;
#pragma unroll
        for (int q = 0; q < 8; ++q) { const f32x4 w = *(const LAS f32x4*)(wr_ + q * 4); p[4 * q] = fmaf(v[i], w[0], p[4 * q]); p[4 * q + 1] = fmaf(v[i], w[1], p[4 * q + 1]); p[4 * q + 2] = fmaf(v[i], w[2], p[4 * q + 2]); p[4 * q + 3] = fmaf(v[i], w[3], p[4 * q + 3]); }
        asm volatile("" ::: "memory"); }
    float a16[16], a8[8], a4[4], a2[2];
    { const bool up = (lane & 32) != 0;
#pragma unroll
      for (int i = 0; i < 16; ++i) { const float send = up ? p[i] : p[i + 16], keep = up ? p[i + 16] : p[i]; a16[i] = keep + __shfl_xor(send, 32); } }
    { const bool up = (lane & 16) != 0;
#pragma unroll
      for (int i = 0; i < 8; ++i) { const float send = up ? a16[i] : a16[i + 8], keep = up ? a16[i + 8] : a16[i]; a8[i] = keep + __shfl_xor(send, 16); } }
    { const bool up = (lane & 8) != 0;
#pragma unroll
      for (int i = 0; i < 4; ++i) { const float send = up ? a8[i] : a8[i + 4], keep = up ? a8[i + 4] : a8[i]; a4[i] = keep + __shfl_xor(send, 8); } }
    { const bool up = (lane & 4) != 0;
#pragma unroll
      for (int i = 0; i < 2; ++i) { const float send = up ? a4[i] : a4[i + 2], keep = up ? a4[i + 2] : a4[i]; a2[i] = keep + __shfl_xor(send, 4); } }
    float a1; { const bool up = (lane & 2) != 0; const float send = up ? a2[0] : a2[1], keep = up ? a2[1] : a2[0]; a1 = keep + __shfl_xor(send, 2); }
    a1 += __shfl_xor(a1, 1);
    return a1;
}
__device__ __forceinline__ void row_gemv32x2(const float (&va)[16], const float (&vb)[16], const LAS float* wl, int lane, float& ya, float& yb) {
    float p[32], q[32];
#pragma unroll
    for (int e = 0; e < 32; ++e) { p[e] = 0.f; q[e] = 0.f; }
#pragma unroll
    for (int i = 0; i < 16; ++i) { const LAS float* wr_ = wl + (lane + 64 * i) * 36;
#pragma unroll
        for (int k = 0; k < 8; ++k) { const f32x4 w = *(const LAS f32x4*)(wr_ + k * 4);
            p[4 * k] = fmaf(va[i], w[0], p[4 * k]); p[4 * k + 1] = fmaf(va[i], w[1], p[4 * k + 1]); p[4 * k + 2] = fmaf(va[i], w[2], p[4 * k + 2]); p[4 * k + 3] = fmaf(va[i], w[3], p[4 * k + 3]);
            q[4 * k] = fmaf(vb[i], w[0], q[4 * k]); q[4 * k + 1] = fmaf(vb[i], w[1], q[4 * k + 1]); q[4 * k + 2] = fmaf(vb[i], w[2], q[4 * k + 2]); q[4 * k + 3] = fmaf(vb[i], w[3], q[4 * k + 3]); }
        asm volatile("" ::: "memory"); }
    float a16[16], b16[16], a8[8], b8[8], a4[4], b4[4], a2[2], b2[2];
    { const bool up = (lane & 32) != 0;
#pragma unroll
      for (int i = 0; i < 16; ++i) { a16[i] = (up ? p[i + 16] : p[i]) + __shfl_xor(up ? p[i] : p[i + 16], 32); b16[i] = (up ? q[i + 16] : q[i]) + __shfl_xor(up ? q[i] : q[i + 16], 32); } }
    { const bool up = (lane & 16) != 0;
#pragma unroll
      for (int i = 0; i < 8; ++i) { a8[i] = (up ? a16[i + 8] : a16[i]) + __shfl_xor(up ? a16[i] : a16[i + 8], 16); b8[i] = (up ? b16[i + 8] : b16[i]) + __shfl_xor(up ? b16[i] : b16[i + 8], 16); } }
    { const bool up = (lane & 8) != 0;
#pragma unroll
      for (int i = 0; i < 4; ++i) { a4[i] = (up ? a8[i + 4] : a8[i]) + __shfl_xor(up ? a8[i] : a8[i + 4], 8); b4[i] = (up ? b8[i + 4] : b8[i]) + __shfl_xor(up ? b8[i] : b8[i + 4], 8); } }
    { const bool up = (lane & 4) != 0;
#pragma unroll
      for (int i = 0; i < 2; ++i) { a2[i] = (up ? a4[i + 2] : a4[i]) + __shfl_xor(up ? a4[i] : a4[i + 2], 4); b2[i] = (up ? b4[i + 2] : b4[i]) + __shfl_xor(up ? b4[i] : b4[i + 2], 4); } }
    { const bool up = (lane & 2) != 0; ya = (up ? a2[1] : a2[0]) + __shfl_xor(up ? a2[0] : a2[1], 2); yb = (up ? b2[1] : b2[0]) + __shfl_xor(up ? b2[0] : b2[1], 2); }
    ya += __shfl_xor(ya, 1); yb += __shfl_xor(yb, 1);
}
__device__ __forceinline__ void ph_router(const Frame& F, int layer, int r0) {
    typedef float f32x16 __attribute__((ext_vector_type(16)));
    constexpr int HROW = 2064;
    LAS char* HHI = (LAS char*)F.ring; LAS char* HLO = HHI + 32 * HROW; LAS float* RED = (LAS float*)F.ring;
    LAS float* SCR = (LAS float*)(F.ring + 2 * 32 * HROW);
    LAS unsigned* lcnt = (LAS unsigned*)(F.lds + 512);
    const float* g = F.in[layer ? I1_N2G : I0_N2G]; const float* rb_ = F.in[layer ? I1_RB : I0_RB];
    if (F.tid < 64) lcnt[F.tid] = 0u;
    __syncthreads();
    bf16_t* H = WSP(bf16_t, WS_H); unsigned* cnt = (unsigned*)(F.ws + WS_CTL + CW_CNT) + layer * 64;
    int* list = WSP(int, WS_LIST); int* toke = WSP(int, WS_TOKE); int* tokp = WSP(int, WS_TOKP); float* tokg = WSP(float, WS_TOKG);
    const float* modv = WSP(float, WS_MODV) + (size_t)layer * 9 * 6144;
    const bf16_t* WT = WSP(bf16_t, WS_RWT) + (size_t)layer * 2 * 32 * 1024;
    const bf16_t* Yb = layer == 0 ? WSP(bf16_t, R0_U0) : WSP(bf16_t, R1_OB) - (size_t)TC * D;
    const int per = (T - r0 + F.G - 1) / F.G; const int rbeg = r0 + F.bid * per; const int rend = (rbeg + per < T) ? rbeg + per : T;
    const int lane = F.lane, wave = F.wave, r32 = lane & 31, hi2 = lane >> 5;
    float gg[16]; ld16f(g, lane, gg);
    float scv[16], shv[16]; int curm = -1;
    for (int tb = rbeg; tb < rend; tb += 32) {
        f32x4 xr[4][4]; u32x4 xq[4][2]; u32x4 yr[4][2];
#pragma unroll
        for (int q = 0; q < 4; ++q) { int r = tb + 4 * wave + q; r = r < rend ? r : rend - 1; const bf16_t* yp = Yb + (size_t)r * D;
            if (layer == 0) { const float* xp = xrow_in(F, r);
#pragma unroll
                for (int h = 0; h < 2; ++h) { xr[q][2 * h] = *(const f32x4*)(xp + 8 * lane + 512 * h); xr[q][2 * h + 1] = *(const f32x4*)(xp + 8 * lane + 512 * h + 4); } }
            else { const bf16_t* xp = xrow_b(F, r);
#pragma unroll
                for (int h = 0; h < 2; ++h) xq[q][h] = *(const u32x4*)(xp + 8 * lane + 512 * h); }
#pragma unroll
            for (int h = 0; h < 2; ++h) yr[q][h] = *(const u32x4*)(yp + 8 * lane + 512 * h); }
#pragma unroll
        for (int q = 0; q < 4; ++q) { const int tr = 4 * wave + q, r = tb + tr;
            if (r < rend) {
            float v[16];
#pragma unroll
            for (int h = 0; h < 2; ++h) {
#pragma unroll
                for (int k = 0; k < 4; ++k) { const float xa = layer == 0 ? xr[q][2 * h + (k >> 1)][2 * (k & 1)] : __uint_as_float(xq[q][h][k] << 16), xb = layer == 0 ? xr[q][2 * h + (k >> 1)][2 * (k & 1) + 1] : __uint_as_float(xq[q][h][k] & 0xffff0000u);
                    v[8 * h + 2 * k] = xa + __uint_as_float(yr[q][h][k] << 16); v[8 * h + 2 * k + 1] = xb + __uint_as_float(yr[q][h][k] & 0xffff0000u); } }
            if (layer == 0) { if (r < TC) st16f(xrow_res(F, r), lane, v); else st16b(xrow_b(F, r), lane, v); }
            else st16f(xrow_res(F, r), lane, v);
            float ss = 0.f;
#pragma unroll
            for (int i = 0; i < 16; ++i) ss = fmaf(v[i], v[i], ss);
            const float rs = rsqrtf(wsum(ss) * (1.0f / D) + EPS);
            const int m = modrow(r);
            if (m != curm) { const float* mv = modv + (size_t)m * 6144; ld16f(mv + 4096, lane, scv); ld16f(mv + 3072, lane, shv); curm = m; }
#pragma unroll
            for (int i = 0; i < 16; ++i) v[i] = v[i] * rs * gg[i] * (1.0f + scv[i]) + shv[i];
#pragma unroll
            for (int h = 0; h < 2; ++h) { u32x4 whi, wlo;
#pragma unroll
                for (int k = 0; k < 4; ++k) { const unsigned ph = cvt_pk_bf16(v[8 * h + 2 * k], v[8 * h + 2 * k + 1]); whi[k] = ph;
                    wlo[k] = cvt_pk_bf16(v[8 * h + 2 * k] - __uint_as_float(ph << 16), v[8 * h + 2 * k + 1] - __uint_as_float(ph & 0xffff0000u)); }
                *(u32x4*)(H + (size_t)r * D + 8 * lane + 512 * h) = whi;
                *(LAS u32x4*)(HHI + tr * HROW + (8 * lane + 512 * h) * 2) = whi; *(LAS u32x4*)(HLO + tr * HROW + (8 * lane + 512 * h) * 2) = wlo; } } }
        __syncthreads();
        f32x16 acc = {};
        { const LAS char* ah = HHI + r32 * HROW + (wave * 128 + hi2 * 8) * 2; const LAS char* al = HLO + r32 * HROW + (wave * 128 + hi2 * 8) * 2;
          const bf16_t* wh = WT + (size_t)r32 * 1024 + wave * 128 + hi2 * 8; const bf16_t* wlp = wh + 32 * 1024;
#pragma unroll
          for (int sst = 0; sst < 8; ++sst) { const bf16x8 a_h = *(const LAS bf16x8*)(ah + sst * 32), a_l = *(const LAS bf16x8*)(al + sst * 32);
              const bf16x8 b_h = *(const bf16x8*)(wh + sst * 16), b_l = *(const bf16x8*)(wlp + sst * 16);
              acc = __builtin_amdgcn_mfma_f32_32x32x16_bf16(a_h, b_h, acc, 0, 0, 0);
              acc = __builtin_amdgcn_mfma_f32_32x32x16_bf16(a_h, b_l, acc, 0, 0, 0);
              acc = __builtin_amdgcn_mfma_f32_32x32x16_bf16(a_l, b_h, acc, 0, 0, 0); } }
        __syncthreads();
#pragma unroll
        for (int r = 0; r < 16; ++r) { const int row = (r & 3) + 8 * (r >> 2) + 4 * hi2; RED[(wave * 32 + row) * 32 + r32] = acc[r]; }
        __syncthreads();
#pragma unroll 1
        for (int pq = 0; pq < 2; ++pq) { const int tr = 4 * wave + 2 * pq + hi2, r = tb + tr; const int e = r32;
            float lg = rb_[e];
#pragma unroll
            for (int w8 = 0; w8 < 8; ++w8) lg += RED[(w8 * 32 + tr) * 32 + e];
            LAS float* sc_ = SCR + tr * 40;
            sc_[e] = lg;
            asm volatile("s_waitcnt lgkmcnt(0)" ::: "memory");
            int rank = 0;
#pragma unroll
            for (int q8 = 0; q8 < 8; ++q8) { const f32x4 v4 = *(const LAS f32x4*)(sc_ + 4 * q8);
#pragma unroll
                for (int j = 0; j < 4; ++j) rank += (int)((v4[j] > lg) | ((v4[j] == lg) & ((4 * q8 + j) < e))); }
            if (rank < 4) { sc_[32 + rank] = lg; ((LAS int*)sc_)[36 + rank] = e; }
            asm volatile("s_waitcnt lgkmcnt(0)" ::: "memory");
            const f32x4 tvv = *(const LAS f32x4*)(sc_ + 32); const u32x4 tev = *(const LAS u32x4*)(sc_ + 36);
            asm volatile("s_waitcnt lgkmcnt(0)" ::: "memory");
            const float e1 = __expf(tvv[1] - tvv[0]), e2 = __expf(tvv[2] - tvv[0]), e3 = __expf(tvv[3] - tvv[0]); const float inv = 1.0f / (1.0f + e1 + e2 + e3);
            if (r32 < 4 && r < rend) { const int k = r32; const int ek = (int)(k == 0 ? tev[0] : k == 1 ? tev[1] : k == 2 ? tev[2] : tev[3]); const float gk = (k == 0 ? 1.0f : k == 1 ? e1 : k == 2 ? e2 : e3) * inv;
                const unsigned lp = __hip_atomic_fetch_add(lcnt + ek, 1u, __ATOMIC_RELAXED, __HIP_MEMORY_SCOPE_WORKGROUP);
                toke[r * 4 + k] = ek; tokp[r * 4 + k] = (int)lp; tokg[r * 4 + k] = gk; } }
        __syncthreads();
    }
    __syncthreads();
    if (F.tid < 32) { const unsigned c = lcnt[F.tid]; lcnt[32 + F.tid] = c ? __hip_atomic_fetch_add(cnt + F.tid, c, __ATOMIC_RELAXED, __HIP_MEMORY_SCOPE_AGENT) : 0u; }
    __syncthreads();
    for (int i = rbeg * 4 + F.tid; i < rend * 4; i += NTHR) {
        const int ek = __hip_atomic_load(toke + i, __ATOMIC_RELAXED, __HIP_MEMORY_SCOPE_AGENT); const int pos = __hip_atomic_load(tokp + i, __ATOMIC_RELAXED, __HIP_MEMORY_SCOPE_AGENT) + (int)lcnt[32 + ek]; tokp[i] = pos; list[(size_t)ek * T + pos] = i >> 2; }
}
__device__ __forceinline__ int moe_tstart(const Frame& F, int layer, LAS int* tstart) {
    unsigned* cnt = (unsigned*)(F.ws + WS_CTL + CW_CNT) + layer * 64;
    __syncthreads();
    if (F.tid == 0) { int s = 0; for (int e = 0; e < NE; ++e) { const int c = (int)__hip_atomic_load(cnt + e, __ATOMIC_RELAXED, __HIP_MEMORY_SCOPE_AGENT); tstart[e] = s; tstart[40 + e] = c; s += (c + 255) >> 8; } tstart[NE] = s; }
    __syncthreads();
    { LAS int* t2e = (LAS int*)(F.ring + 140000); const int nt = tstart[NE];
      for (int t = F.tid; t < nt; t += NTHR) { int e = 0; for (int j = 1; j < NE; ++j) e += (t >= tstart[j]) ? 1 : 0; t2e[t] = e; } }
    __syncthreads();
    return __builtin_amdgcn_readfirstlane(tstart[NE]);
}
__device__ __forceinline__ void ph_moe1(const Frame& F, int layer) {
    LAS int* tstart = (LAS int*)(F.lds + 64); const int ntile = moe_tstart(F, layer, tstart);
    pg8::MoeOrder<true> S; S.A = (const char*)WSP(bf16_t, WS_H); S.B = (const char*)WSP(bf16_t, WS_WGU); S.sB = (size_t)2048 * 1024 * 2; S.lda = D; S.ldb = D; S.npn = 8; S.nwg = ntile * 8; S.G = F.G; S.c = F.bid;
    S.tstart = tstart; S.cnt = tstart + 40; S.list = WSP(int, WS_LIST); S.t2e = (const LAS int*)(F.ring + 140000);
    pg8::EpiSwiglu E{WSP(bf16_t, WS_ACT), F.in[layer ? I1_BGU : I0_BGU]};
    pg8::gemm_phase<pg8::EpiSwiglu, pg8::MoeOrder<true>>(F.ring, pg8::Gemm{D, D, D}, S, E);
}
__device__ __forceinline__ void ph_moe2(const Frame& F, int layer) {
    LAS int* tstart = (LAS int*)(F.lds + 64); const int ntile = moe_tstart(F, layer, tstart);
    pg8::MoeOrder<false> S; S.A = (const char*)WSP(bf16_t, WS_ACT); S.B = (const char*)WSP(bf16_t, WS_WDN); S.sB = (size_t)1024 * 1024 * 2; S.lda = FF; S.ldb = FF; S.npn = 4; S.nwg = ntile * 4; S.G = F.G; S.c = F.bid;
    S.tstart = tstart; S.cnt = tstart + 40; S.list = nullptr; S.t2e = (const LAS int*)(F.ring + 140000);
    pg8::EpiDown E{WSP(bf16_t, RM_YB), F.in[layer ? I1_BDN : I0_BDN]};
    pg8::gemm_phase<pg8::EpiDown, pg8::MoeOrder<false>>(F.ring, pg8::Gemm{FF, FF, FF}, S, E);
}
__device__ __forceinline__ void moe_combine_row(const Frame& F, int layer, int r, const LAS int* tstart, float (&v)[16]) {
    const int* toke = WSP(int, WS_TOKE); const int* tokp = WSP(int, WS_TOKP); const float* tokg = WSP(float, WS_TOKG); const bf16_t* YB = WSP(bf16_t, RM_YB);
    const float* g2 = WSP(float, WS_MODV) + (size_t)(layer * 9 + modrow(r)) * 6144 + 5120;
    float y[16];
#pragma unroll
    for (int i = 0; i < 16; ++i) y[i] = 0.f;
#pragma unroll
    for (int k = 0; k < 4; ++k) { const int e = toke[r * 4 + k]; const size_t prow = (size_t)tstart[e] * 256 + tokp[r * 4 + k]; const float gk = tokg[r * 4 + k]; float yy[16]; ld16b(YB + prow * D, F.lane, yy);
#pragma unroll
        for (int i = 0; i < 16; ++i) y[i] = fmaf(gk, yy[i], y[i]); }
    float gg[16]; ld16f(g2, F.lane, gg); if (layer == 0 && r >= TC) ld16b(xrow_b(F, r), F.lane, v); else ld16f(xrow_res(F, r), F.lane, v);
#pragma unroll
    for (int i = 0; i < 16; ++i) v[i] = fmaf(gg[i], y[i], v[i]);
}
__device__ __forceinline__ void ph_combine_mod1(const Frame& F) {
    LAS int* tstart = (LAS int*)(F.lds + 64); moe_tstart(F, 0, tstart);
    LAS float* wl = (LAS float*)F.ring;
    load_w32(F, wl, F.in[I1_WIN] + 3072, 3104);
    __syncthreads();
    const float* g = F.in[I1_N1G]; bf16_t* H = WSP(bf16_t, WS_H); float* GD = WSP(float, WS_GD);
    const float* modv = WSP(float, WS_MODV) + (size_t)9 * 6144;
    for (int r = F.bid * NWAVE + F.wave; r < T; r += F.G * NWAVE) {
        float v[16]; moe_combine_row(F, 0, r, tstart, v);
        const float* mv = modv + (size_t)modrow(r) * 6144;
        if (r < TC) st16f(xrow_res(F, r), F.lane, v); else st16b(xrow_b(F, r), F.lane, v);
        modulate16(v, g, mv + 1024, mv, F.lane);
        st16b(H + (size_t)r * D, F.lane, v);
        const float gd = row_gemv32(v, wl, F.lane);
        if ((F.lane & 1) == 0) GD[(size_t)r * 32 + (F.lane >> 1)] = gd;
    }
    __syncthreads();
    cvt_moe_weights(F, (LAS float*)F.ring, F.in[I1_WGU], F.in[I1_WDN]);
}
__device__ __forceinline__ void ph_final(const Frame& F) {
    LAS int* tstart = (LAS int*)(F.lds + 64); moe_tstart(F, 1, tstart);
    const float* g = F.in[I_FNG];
    for (int r = TC + F.bid * NWAVE + F.wave; r < T; r += F.G * NWAVE) {
        float v[16]; moe_combine_row(F, 1, r, tstart, v); float ss = 0.f;
#pragma unroll
        for (int i = 0; i < 16; ++i) ss = fmaf(v[i], v[i], ss);
        const float rs = rsqrtf(wsum(ss) * (1.0f / D) + EPS); float gg[16]; ld16f(g, F.lane, gg);
#pragma unroll
        for (int i = 0; i < 16; ++i) v[i] = v[i] * rs * gg[i];
        st16f(F.out + (size_t)(r - TC) * D, F.lane, v);
    }
}

namespace gla3 {
using att::f32x16; using att::s16x4; using att::crow; using att::v_st; using att::v_rd_base; using att::v_rd_off; using att::tr_read;
constexpr int ROWB = 272;
constexpr int P_GD = 0, P_TOT = 4096, P_WG = 8192;
constexpr int O_QD = 0, O_KD = 17408, O_KS = 34816, O_VV = 51200, O_ST = 67584, O_DEC = 102400;
constexpr size_t TILE_B = 64 * 128 * 2, ITEM_B = 2 * TILE_B;
#define GPK(L, H) (bf16x8){L[0], L[1], L[2], L[3], H[0], H[1], H[2], H[3]}
#define CH_ROW0(b, dir, cc) ((cc) < 4 ? ((b) * 256 + ((dir) ? 3 - (cc) : (cc)) * 64) : (TC + (b) * 4096 + ((dir) ? 67 - (cc) : (cc) - 4) * 64))
#define TOK(dir, jj) ((dir) ? 63 - (jj) : (jj))
__device__ __forceinline__ void pre_phase(const Frame& F) {
  LAS char* lds = (LAS char*)F.ring;
  int tid = threadIdx.x; asm volatile("" : "+v"(tid));
  const int wid = __builtin_amdgcn_readfirstlane(tid >> 6), lane = tid & 63;
  LAS float* gds = (LAS float*)(lds + P_GD); LAS float* tot = (LAS float*)(lds + P_TOT); LAS float* wgall = (LAS float*)(lds + P_WG);
  const bf16_t* U1 = WSP(bf16_t, R1_U1); const float* GD = WSP(float, WS_GD);
  char* tiles = (char*)(F.ws + WS_ACT); float* decbuf = (float*)(F.ws + WS_ACT + (size_t)4352 * ITEM_B);
  for (int i = tid; i < 8 * 17 * 128; i += NTHR) { const int tb = i / (17 * 128), rem = i % (17 * 128), r = rem >> 7, d = rem & 127, hd = tb >> 1, dir = tb & 1;
    const float* Wg = dir ? F.in[I1_WGKB] : F.in[I1_WGKF]; const float* Bg = dir ? F.in[I1_BGKB] : F.in[I1_BGKF]; wgall[i] = (r < 16) ? Wg[r * 512 + hd * 128 + d] : Bg[hd * 128 + d]; }
  const int d0 = 2 * lane, tg = wid, gj = tid >> 3, gr = (tid & 7) * 2;
  unsigned qreg[8], kreg[8]; f32x2 gdreg;
#define PLOAD(u) do { const int _cc = (u) % 68, _s = (u) / 68, _dir = _s & 1, _hd = (_s >> 1) & 3, _b = _s >> 3; const int _r0 = CH_ROW0(_b, _dir, _cc); \
    const bf16_t* _uq = U1 + _hd * 128 + d0; \
    _Pragma("unroll") for (int i = 0; i < 8; ++i) { const bf16_t* _p = _uq + (size_t)(_r0 + TOK(_dir, 8 * tg + i)) * U1W; qreg[i] = *(const unsigned*)_p; kreg[i] = *(const unsigned*)(_p + 512); } \
    gdreg = *(const f32x2*)(GD + (size_t)(_r0 + TOK(_dir, gj)) * 32 + _dir * 16 + gr); } while (0)
  int u = F.bid;
  if (u < 4352) PLOAD(u);
  __syncthreads();
  for (; u < 4352; u += F.G) {
    const int sc = u / 68, dir = sc & 1, hd = (sc >> 1) & 3;
    const LAS float* wg = wgall + (hd * 2 + dir) * 17 * 128;
    *(LAS f32x2*)(gds + gj * 16 + gr) = gdreg;
    __syncthreads();
    float cl0[8], cl1[8];
    { float z0[8], z1[8]; const f32x2 bb = *(const LAS f32x2*)(wg + 16 * 128 + d0);
#pragma unroll
      for (int i = 0; i < 8; ++i) { z0[i] = bb[0]; z1[i] = bb[1]; }
#pragma unroll
      for (int r4 = 0; r4 < 4; ++r4) { f32x2 w[4];
#pragma unroll
        for (int q = 0; q < 4; ++q) w[q] = *(const LAS f32x2*)(wg + (4 * r4 + q) * 128 + d0);
#pragma unroll
        for (int i = 0; i < 8; ++i) { const f32x4 g4 = *(const LAS f32x4*)(gds + (8 * tg + i) * 16 + 4 * r4);
#pragma unroll
          for (int q = 0; q < 4; ++q) { z0[i] = fmaf(g4[q], w[q][0], z0[i]); z1[i] = fmaf(g4[q], w[q][1], z1[i]); } } }
      float a0 = 0.f, a1 = 0.f;
#pragma unroll
      for (int i = 0; i < 8; ++i) { const float l0 = fminf(z0[i], 0.f) - __logf(1.0f + __expf(-fabsf(z0[i]))), l1 = fminf(z1[i], 0.f) - __logf(1.0f + __expf(-fabsf(z1[i])));
        a0 += l0 * (1.0f / 16.0f); a1 += l1 * (1.0f / 16.0f); cl0[i] = a0; cl1[i] = a1; }
      *(LAS f32x2*)(tot + tg * 128 + d0) = (f32x2){a0, a1}; }
    __syncthreads();
    { float off0 = 0.f, off1 = 0.f, last0 = 0.f, last1 = 0.f;
#pragma unroll
      for (int g = 0; g < 8; ++g) { const f32x2 tv = *(const LAS f32x2*)(tot + g * 128 + d0); if (g < tg) { off0 += tv[0]; off1 += tv[1]; } last0 += tv[0]; last1 += tv[1]; }
      const float el0 = __expf(last0), el1 = __expf(last1);
      if (tg == 0) *(f32x2*)(decbuf + (size_t)u * 128 + d0) = (f32x2){el0, el1};
      char* it = tiles + (size_t)u * ITEM_B + d0 * 2;
#pragma unroll
      for (int i = 0; i < 8; ++i) { const int jj = 8 * tg + i; const float e0 = __expf(off0 + cl0[i]), e1 = __expf(off1 + cl1[i]); const float r0 = __builtin_amdgcn_rcpf(e0), r1 = __builtin_amdgcn_rcpf(e1);
        const float q0 = __uint_as_float(qreg[i] << 16), q1 = __uint_as_float(qreg[i] & 0xffff0000u), k0 = __uint_as_float(kreg[i] << 16), k1 = __uint_as_float(kreg[i] & 0xffff0000u);
        *(unsigned*)(it + jj * 256) = cvt_pk_bf16(q0 * e0, q1 * e1);
        *(unsigned*)(it + TILE_B + jj * 256) = cvt_pk_bf16(k0 * r0, k1 * r1); } }
    if (u + F.G < 4352) PLOAD(u + F.G);
    __syncthreads();
  }
#undef PLOAD
}
constexpr int SB_QD = 0, SB_KD = 16384, SB_VV = 32768, SB_DEC = 40960, SB_BYTES = 41984, O_ST2 = 3 * SB_BYTES;
constexpr int vc_off(int d0, int ks, int half) { return d0 * 512 + ks * 2048 + half * 1024; }
struct SeqCtx { LAS char* lds; const char* tiles; const char* decb; const bf16_t* Uv; bf16_t* OUT; unsigned sQ[2], sK[2], ldsw; int vk, b, dir, hd, dvs, wid, lane, r32, hi, trb, xq, eb, db, kdo; };
#define DMA16(gptr, ldsoff) __builtin_amdgcn_global_load_lds((const unsigned*)(gptr), (LAS unsigned*)(C.lds + (ldsoff)), 16, 0, 0)
__device__ __forceinline__ void seq_issue(const SeqCtx& C, int cc) {
    const int bo = (cc % 3) * SB_BYTES; const char* t = C.tiles + (size_t)cc * ITEM_B;
    DMA16(t + C.sQ[0], bo + SB_QD + C.ldsw); DMA16(t + C.sQ[1], bo + SB_QD + 8192 + C.ldsw);
    DMA16(t + TILE_B + C.sK[0], bo + SB_KD + C.ldsw); DMA16(t + TILE_B + C.sK[1], bo + SB_KD + 8192 + C.ldsw);
    DMA16(C.Uv + (size_t)(CH_ROW0(C.b, C.dir, cc) + TOK(C.dir, C.vk)) * U1W, bo + SB_VV + C.ldsw);
    if (C.wid == 7) DMA16(C.decb + (size_t)cc * 512 + C.lane * 16, bo + SB_DEC);
}
#undef DMA16
template <int IB> __device__ __forceinline__ void seq_out_loop(const SeqCtx& C) {
  const int r32 = C.r32, hi = C.hi, xq = C.xq;
  for (int cc = 0; cc < 68; ++cc) {
    if (cc >= 6 && cc < 67) asm volatile("s_waitcnt vmcnt(37)" ::: "memory"); else if (cc >= 1 && cc < 67) asm volatile("s_waitcnt vmcnt(5)" ::: "memory"); else asm volatile("s_waitcnt vmcnt(0)" ::: "memory");
    asm volatile("s_waitcnt lgkmcnt(0)" ::: "memory");
    __builtin_amdgcn_s_barrier();
    asm volatile("" ::: "memory");
    if (cc + 2 < 68) seq_issue(C, cc + 2);
    if (cc < 4) continue;
    const LAS char* sb = C.lds + (cc % 3) * SB_BYTES;
    const LAS char* STp = C.lds + O_ST2 + ((cc + 1) & 1) * 17408;
    f32x16 p0 = {}, p1 = {}, o = {};
    const LAS char* QDr = sb + SB_QD + (32 * IB + r32) * 256; const LAS char* KDr = sb + SB_KD + C.kdo;
#pragma unroll
    for (int k = 0; k < 8; ++k) { const int po = (k << 5) ^ xq; const bf16x8 qf = *(const LAS bf16x8*)(QDr + po); const bf16x8 k0f = *(const LAS bf16x8*)(KDr + (k >> 1) * 512 + (k & 1) * 32);
      p0 = __builtin_amdgcn_mfma_f32_32x32x16_bf16(k0f, qf, p0, 0, 0, 0);
      if (IB) { const bf16x8 k1f = *(const LAS bf16x8*)(KDr + 8192 + (k >> 1) * 512 + (k & 1) * 32); p1 = __builtin_amdgcn_mfma_f32_32x32x16_bf16(k1f, qf, p1, 0, 0, 0); } }
#pragma unroll
    for (int r = 0; r < 16; ++r) { const bool kill = crow(r, hi) > r32; if (IB == 0) p0[r] = kill ? 0.f : p0[r]; else p1[r] = kill ? 0.f : p1[r]; }
    bf16x8 pa0, pa1, pa2, pa3;
#define PK4(P, BASE, OUT_) do { unsigned a0 = cvt_pk_bf16(P[BASE + 0], P[BASE + 1]), a1 = cvt_pk_bf16(P[BASE + 2], P[BASE + 3]);   \
    unsigned b0 = cvt_pk_bf16(P[BASE + 4], P[BASE + 5]), b1 = cvt_pk_bf16(P[BASE + 6], P[BASE + 7]);                              \
    auto r0 = __builtin_amdgcn_permlane32_swap(a0, b0, false, false); auto r1 = __builtin_amdgcn_permlane32_swap(a1, b1, false, false); \
    u32x4 w = {r0[0], r1[0], r0[1], r1[1]}; OUT_ = *reinterpret_cast<bf16x8*>(&w); } while (0)
    PK4(p0, 0, pa0); PK4(p0, 8, pa1); if (IB) { PK4(p1, 0, pa2); PK4(p1, 8, pa3); }
#undef PK4
    { const int vb = (int)(uintptr_t)(sb + SB_VV) + C.trb + C.eb * 512;
      const s16x4 l0 = tr_read<vc_off(0, 0, 0)>(vb), h0 = tr_read<vc_off(0, 0, 1)>(vb), l1 = tr_read<vc_off(0, 1, 0)>(vb), h1 = tr_read<vc_off(0, 1, 1)>(vb);
      s16x4 l2, h2, l3, h3;
      if (IB) { l2 = tr_read<vc_off(0, 2, 0)>(vb); h2 = tr_read<vc_off(0, 2, 1)>(vb); l3 = tr_read<vc_off(0, 3, 0)>(vb); h3 = tr_read<vc_off(0, 3, 1)>(vb); }
      asm volatile("s_waitcnt lgkmcnt(0)" ::: "memory"); __builtin_amdgcn_sched_barrier(0);
      o = __builtin_amdgcn_mfma_f32_32x32x16_bf16(pa0, GPK(l0, h0), o, 0, 0, 0);
      o = __builtin_amdgcn_mfma_f32_32x32x16_bf16(pa1, GPK(l1, h1), o, 0, 0, 0);
      if (IB) { o = __builtin_amdgcn_mfma_f32_32x32x16_bf16(pa2, GPK(l2, h2), o, 0, 0, 0);
                o = __builtin_amdgcn_mfma_f32_32x32x16_bf16(pa3, GPK(l3, h3), o, 0, 0, 0); } }
    { const LAS char* STr = STp + (32 * C.eb + r32) * ROWB + hi * 16;
#pragma unroll
      for (int k = 0; k < 8; ++k) { const bf16x8 qf = *(const LAS bf16x8*)(QDr + ((k << 5) ^ xq)); const bf16x8 sf = *(const LAS bf16x8*)(STr + k * 32);
        o = __builtin_amdgcn_mfma_f32_32x32x16_bf16(qf, sf, o, 0, 0, 0); } }
    bf16_t* op = C.OUT + (size_t)(CH_ROW0(C.b, C.dir, cc) - TC) * D + C.hd * 256 + C.dvs * 64 + 32 * C.eb + r32;
#pragma unroll
    for (int r = 0; r < 16; ++r) { const int i = 32 * IB + crow(r, hi); op[(size_t)TOK(C.dir, i) * D] = f2bf(o[r]); }
  }
}
__device__ __forceinline__ void seq_state_loop(const SeqCtx& C) {
  const int r32 = C.r32, hi = C.hi, db = C.db;
  f32x16 S0 = {}, S1 = {};
  for (int cc = 0; cc < 68; ++cc) {
    if (cc >= 1 && cc < 67) { if (C.wid == 7) asm volatile("s_waitcnt vmcnt(6)" ::: "memory"); else asm volatile("s_waitcnt vmcnt(5)" ::: "memory"); } else asm volatile("s_waitcnt vmcnt(0)" ::: "memory");
    asm volatile("s_waitcnt lgkmcnt(0)" ::: "memory");
    __builtin_amdgcn_s_barrier();
    asm volatile("" ::: "memory");
    if (cc + 2 < 68) seq_issue(C, cc + 2);
    const LAS char* sb = C.lds + (cc % 3) * SB_BYTES;
    LAS char* STn = C.lds + O_ST2 + (cc & 1) * 17408;
    const int kb = (int)(uintptr_t)(sb + SB_KD) + C.trb + db * 512, vb = (int)(uintptr_t)(sb + SB_VV) + C.trb;
    { const s16x4 al0 = tr_read<v_rd_off(0, 0, 0)>(kb), ah0 = tr_read<v_rd_off(0, 0, 1)>(kb), al1 = tr_read<v_rd_off(0, 1, 0)>(kb), ah1 = tr_read<v_rd_off(0, 1, 1)>(kb);
      const s16x4 al2 = tr_read<v_rd_off(0, 2, 0)>(kb), ah2 = tr_read<v_rd_off(0, 2, 1)>(kb), al3 = tr_read<v_rd_off(0, 3, 0)>(kb), ah3 = tr_read<v_rd_off(0, 3, 1)>(kb);
      const s16x4 bl0 = tr_read<vc_off(0, 0, 0)>(vb), bh0 = tr_read<vc_off(0, 0, 1)>(vb), bl1 = tr_read<vc_off(0, 1, 0)>(vb), bh1 = tr_read<vc_off(0, 1, 1)>(vb);
      const s16x4 bl2 = tr_read<vc_off(0, 2, 0)>(vb), bh2 = tr_read<vc_off(0, 2, 1)>(vb), bl3 = tr_read<vc_off(0, 3, 0)>(vb), bh3 = tr_read<vc_off(0, 3, 1)>(vb);
      const s16x4 cl0_ = tr_read<vc_off(1, 0, 0)>(vb), ch0 = tr_read<vc_off(1, 0, 1)>(vb), cl1_ = tr_read<vc_off(1, 1, 0)>(vb), ch1 = tr_read<vc_off(1, 1, 1)>(vb);
      const s16x4 cl2 = tr_read<vc_off(1, 2, 0)>(vb), ch2 = tr_read<vc_off(1, 2, 1)>(vb), cl3 = tr_read<vc_off(1, 3, 0)>(vb), ch3 = tr_read<vc_off(1, 3, 1)>(vb);
      asm volatile("s_waitcnt lgkmcnt(0)" ::: "memory"); __builtin_amdgcn_sched_barrier(0);
      S0 = __builtin_amdgcn_mfma_f32_32x32x16_bf16(GPK(al0, ah0), GPK(bl0, bh0), S0, 0, 0, 0); S1 = __builtin_amdgcn_mfma_f32_32x32x16_bf16(GPK(al0, ah0), GPK(cl0_, ch0), S1, 0, 0, 0);
      S0 = __builtin_amdgcn_mfma_f32_32x32x16_bf16(GPK(al1, ah1), GPK(bl1, bh1), S0, 0, 0, 0); S1 = __builtin_amdgcn_mfma_f32_32x32x16_bf16(GPK(al1, ah1), GPK(cl1_, ch1), S1, 0, 0, 0);
      S0 = __builtin_amdgcn_mfma_f32_32x32x16_bf16(GPK(al2, ah2), GPK(bl2, bh2), S0, 0, 0, 0); S1 = __builtin_amdgcn_mfma_f32_32x32x16_bf16(GPK(al2, ah2), GPK(cl2, ch2), S1, 0, 0, 0);
      S0 = __builtin_amdgcn_mfma_f32_32x32x16_bf16(GPK(al3, ah3), GPK(bl3, bh3), S0, 0, 0, 0); S1 = __builtin_amdgcn_mfma_f32_32x32x16_bf16(GPK(al3, ah3), GPK(cl3, ch3), S1, 0, 0, 0); }
#pragma unroll
    for (int g = 0; g < 4; ++g) { const f32x4 dc = *(const LAS f32x4*)(sb + SB_DEC + (32 * db + 8 * g + 4 * hi) * 4);
                                  S0[4 * g] *= dc[0]; S0[4 * g + 1] *= dc[1]; S0[4 * g + 2] *= dc[2]; S0[4 * g + 3] *= dc[3];
                                  S1[4 * g] *= dc[0]; S1[4 * g + 1] *= dc[1]; S1[4 * g + 2] *= dc[2]; S1[4 * g + 3] *= dc[3]; }
#pragma unroll
    for (int g = 0; g < 4; ++g) { u32x2 w0, w1; w0.x = cvt_pk_bf16(S0[4 * g], S0[4 * g + 1]); w0.y = cvt_pk_bf16(S0[4 * g + 2], S0[4 * g + 3]); w1.x = cvt_pk_bf16(S1[4 * g], S1[4 * g + 1]); w1.y = cvt_pk_bf16(S1[4 * g + 2], S1[4 * g + 3]);
      *(LAS u32x2*)(STn + r32 * ROWB + (32 * db + 8 * g + 4 * hi) * 2) = w0; *(LAS u32x2*)(STn + (32 + r32) * ROWB + (32 * db + 8 * g + 4 * hi) * 2) = w1; }
  }
}
__device__ __forceinline__ void seq_unit(const Frame& F, int b, int hd, int dir, int dvs, LAS char* lds) {
  int tid = threadIdx.x; asm volatile("" : "+v"(tid));
  SeqCtx C; C.lds = lds; C.wid = __builtin_amdgcn_readfirstlane(tid >> 6); C.lane = tid & 63; C.r32 = C.lane & 31; C.hi = C.lane >> 5; C.b = b; C.dir = dir; C.hd = hd; C.dvs = dvs;
  const int sc = (b * 4 + hd) * 2 + dir;
  C.OUT = WSP(bf16_t, dir ? R1_OB : R1_OF);
  C.tiles = (const char*)(F.ws + WS_ACT) + (size_t)sc * 68 * ITEM_B; C.decb = (const char*)(F.ws + WS_ACT + (size_t)4352 * ITEM_B) + (size_t)sc * 68 * 512;
  for (int i = tid; i < 2 * 17408 / 4; i += NTHR) ((LAS unsigned*)(lds + O_ST2))[i] = 0u;
  int vcol;
#pragma unroll
  for (int rd = 0; rd < 2; ++rd) { const int o = rd * 8192 + C.wid * 1024 + C.lane * 16;
    { const int row = o >> 8, slot = (o >> 4) & 15; C.sQ[rd] = (unsigned)(row * 256 + ((slot ^ (row & 15)) << 4)); }
    { const int sub = o >> 9, kkhi = sub >> 2, cblk = sub & 3, w = (o & 511) >> 1, kklo = w >> 5, cin = w & 31; const int kk = kkhi * 8 + kklo; const int k = (kk & ~0xC) | ((kk & 4) << 1) | ((kk & 8) >> 1);
      C.sK[rd] = (unsigned)(k * 256 + (cblk * 32 + cin) * 2); } }
  { const int o = C.wid * 1024 + C.lane * 16; const int sub = o >> 9, kkhi = sub >> 1, cblk = sub & 1, w = (o & 511) >> 1, kklo = w >> 5, cin = w & 31; const int kk = kkhi * 8 + kklo;
    C.vk = (kk & ~0xC) | ((kk & 4) << 1) | ((kk & 8) >> 1); vcol = cblk * 32 + cin; }
  C.Uv = WSP(bf16_t, R1_U1) + 1024 + hd * 256 + dvs * 64 + vcol;
  C.ldsw = (unsigned)C.wid * 1024u;
  C.eb = C.wid & 1; C.db = C.wid & 3; C.trb = v_rd_base(C.lane); C.xq = ((C.r32 & 15) ^ C.hi) << 4;
  { const int j = C.r32, kk = (j & ~0xC) | ((j & 4) << 1) | ((j & 8) >> 1); C.kdo = (kk >> 3) * 2048 + (kk & 7) * 64 + C.hi * 16; }
  seq_issue(C, 0); seq_issue(C, 1);
  if (C.wid < 4) { if (C.wid & 2) seq_out_loop<1>(C); else seq_out_loop<0>(C); }
  else seq_state_loop(C);
  asm volatile("s_waitcnt vmcnt(0) lgkmcnt(0)" ::: "memory");
  __builtin_amdgcn_s_barrier();
}
__device__ __forceinline__ void seq_phase(const Frame& F) {
  for (int un = F.bid; un < 256; un += F.G) {
    const int dvs = un & 3, sc = un >> 2, dir = sc & 1, hd = (sc >> 1) & 3, b = sc >> 3;
    __syncthreads();
    seq_unit(F, b, hd, dir, dvs, (LAS char*)F.ring);
  }
}
#undef GPK
#undef CH_ROW0
#undef TOK
}

__device__ __forceinline__ void ph_gla_out(const Frame& F) {
    const bf16_t* OF = WSP(bf16_t, R1_OF); const bf16_t* OB = WSP(bf16_t, R1_OB); const bf16_t* U1 = WSP(bf16_t, R1_U1); bf16_t* MIX = WSP(bf16_t, R1_OF); const float* gn = F.in[I1_GNG];
    for (int rl = F.bid * NWAVE + F.wave; rl < TL; rl += F.G * NWAVE) {
        float o[16], ob[16], go[16]; ld16b(OF + (size_t)rl * D, F.lane, o); ld16b(OB + (size_t)rl * D, F.lane, ob); ld16b(U1 + (size_t)(TC + rl) * U1W + 2048, F.lane, go);
        float s0 = 0.f, s1 = 0.f;
#pragma unroll
        for (int i = 0; i < 8; ++i) { o[i] += ob[i]; o[8 + i] += ob[8 + i]; s0 = fmaf(o[i], o[i], s0); s1 = fmaf(o[8 + i], o[8 + i], s1); }
        for (int k = 16; k >= 1; k >>= 1) { s0 += __shfl_xor(s0, k); s1 += __shfl_xor(s1, k); }
        const float r0 = rsqrtf(s0 * (1.0f / 256.0f) + EPS), r1 = rsqrtf(s1 * (1.0f / 256.0f) + EPS);
        const float* gp = gn + ((8 * F.lane) & 255);
#pragma unroll
        for (int i = 0; i < 8; ++i) { const float gw = gp[i]; o[i] = o[i] * r0 * gw * silu_fast(go[i]); o[8 + i] = o[8 + i] * r1 * gw * silu_fast(go[8 + i]); }
        st16b(MIX + (size_t)rl * D, F.lane, o);
    }
}

constexpr int NPHASE = 20;
__global__ void __launch_bounds__(NTHR, 2) fwd_kernel(Args args) {
    extern __shared__ __attribute__((aligned(16))) unsigned char lds_raw[];
    Frame F; F.in = args.in; F.out = args.out; F.ws = args.ws; F.lds = (LAS unsigned char*)lds_raw; F.ring = F.lds + RING_OFF;
    F.tid = threadIdx.x; F.lane = F.tid & 63; F.wave = __builtin_amdgcn_readfirstlane(F.tid >> 6); F.G = gridDim.x; F.bid = blockIdx.x;
    if (F.tid < 4) ((LAS unsigned*)F.lds)[F.tid] = 0u;
    __syncthreads();
    const int lo = args.ph_lo, hi = args.ph_hi;
    const bool multi = (hi - lo) > 1;
    XcdBarrier bar; bar.bar = (unsigned*)(F.ws + WS_CTL + CW_BAR); bar.x = 0; bar.st = (volatile LAS unsigned*)F.lds;
    if (multi) bar = xcd_barrier_post((unsigned*)(F.ws + WS_CTL + CW_BAR), (volatile LAS unsigned*)F.lds);
#define IN(k) (lo <= (k) && (k) < hi)
#define SEAM(k) do { if (IN((k) + 1)) xcd_barrier(bar); } while (0)
#define REFRESH() do { int t_ = threadIdx.x; asm volatile("" : "+v"(t_)); F.tid = t_; F.lane = t_ & 63; F.wave = __builtin_amdgcn_readfirstlane(t_ >> 6); } while (0)

    if (IN(0)) { REFRESH(); ph_prologue(F); SEAM(0); }
    if (IN(1)) { REFRESH(); ph_mod0(F); SEAM(1); }
    if (IN(2)) { REFRESH();
        pg8::DualOrder S; S.a.init(WSP(bf16_t, WS_H), WSP(bf16_t, WS_WIN0), D, D, T, U0W, F.G, F.bid); S.b.init(WSP(bf16_t, WS_WF), WSP(bf16_t, WS_H), D, D, 512, T, F.G, F.bid);
        pg8::EpiDual0 E{pg8::EpiBf16{WSP(bf16_t, R0_U0), U0W, U0W}, pg8::EpiFourT{WSP(bf16_t, R0_TT), WSP(bf16_t, R0_TTC)}};
        pg8::gemm_phase<pg8::EpiDual0, pg8::DualOrder>(F.ring, pg8::Gemm{D, D, D}, S, E);
        SEAM(2); }
    if (IN(3)) { REFRESH(); ph_rowstats(F); SEAM(3); }
    if (IN(4)) { REFRESH();
        { pg8::DenseOrder S; S.init(WSP(bf16_t, R0_U0), WSP(bf16_t, WS_WQ), U0W, QL, T, QWP, F.G, F.bid);
          pg8::EpiRS E{WSP(bf16_t, R0_Q), WSP(float, WS_RS), QW, QW}; pg8::gemm_phase<pg8::EpiRS, pg8::DenseOrder>(F.ring, pg8::Gemm{QL, U0W, QL}, S, E); }
        { pg8::DenseOrder S; S.init(WSP(bf16_t, R0_U0) + QL, WSP(bf16_t, WS_WKV), U0W, KVL, T, KVW, F.G, F.bid);
          pg8::EpiRS E{WSP(bf16_t, R0_KV), WSP(float, WS_RS) + T, KVW, KVW}; pg8::gemm_phase<pg8::EpiRS, pg8::DenseOrder>(F.ring, pg8::Gemm{KVL, U0W, KVL}, S, E); }
        SEAM(4); }
    if (IN(5)) { REFRESH();
        ph_queue5(F); SEAM(5); }
    if (IN(6)) { REFRESH();
        pg8::DenseOrder S; S.init(WSP(bf16_t, R0_MIX), WSP(bf16_t, WS_WOUT0), D, D, T, D, F.G, F.bid);
        pg8::EpiGateBf16 E{WSP(bf16_t, R0_U0), WSP(float, WS_MODV), 2048, 0, 0};
        pg8::gemm_phase<pg8::EpiGateBf16, pg8::DenseOrder>(F.ring, pg8::Gemm{D, D, D}, S, E); SEAM(6); }
    if (IN(7)) { REFRESH(); ph_router(F, 0, 0); SEAM(7); }
    if (IN(8)) { REFRESH(); ph_moe1(F, 0); SEAM(8); }
    if (IN(9)) { REFRESH(); ph_moe2(F, 0); SEAM(9); }
    if (IN(10)) { REFRESH(); ph_combine_mod1(F); SEAM(10); }
    if (IN(11)) { REFRESH();
        pg8::DenseOrder S; S.init(WSP(bf16_t, WS_H), WSP(bf16_t, WS_WIN1), D, D, T, U1W, F.G, F.bid);
        pg8::EpiBf16 E{WSP(bf16_t, R1_U1), U1W, U1W}; pg8::gemm_phase<pg8::EpiBf16, pg8::DenseOrder>(F.ring, pg8::Gemm{D, D, D}, S, E); SEAM(11); }
    if (IN(12)) { REFRESH(); gla3::pre_phase(F); SEAM(12); }
    if (IN(13)) { REFRESH(); gla3::seq_phase(F); SEAM(13); }
    if (IN(14)) { REFRESH(); ph_gla_out(F); SEAM(14); }
    if (IN(15)) { REFRESH();
        pg8::DenseOrder S; S.init(WSP(bf16_t, R1_OF), WSP(bf16_t, WS_WOUT1), D, D, TL, D, F.G, F.bid);
        pg8::EpiGateBf16 E{WSP(bf16_t, R1_OB), WSP(float, WS_MODV) + 9 * 6144, 2048, TC, TC};
        pg8::gemm_phase<pg8::EpiGateBf16, pg8::DenseOrder>(F.ring, pg8::Gemm{D, D, D}, S, E); SEAM(15); }
    if (IN(16)) { REFRESH(); ph_router(F, 1, TC); SEAM(16); }
    if (IN(17)) { REFRESH(); ph_moe1(F, 1); SEAM(17); }
    if (IN(18)) { REFRESH(); ph_moe2(F, 1); SEAM(18); }
    if (IN(19)) { REFRESH(); ph_final(F); }
#undef IN
#undef SEAM
}

#ifndef ONE_LAUNCH
#define ONE_LAUNCH 1
#endif
extern "C" void kernel_launch(void* const* d_in, const int* in_sizes, int n_in, void* d_out, int out_size, void* d_ws, size_t ws_size, hipStream_t stream) {
    static int grid = 0;
    if (grid == 0) {
        if (n_in != 38 || out_size != TL * D || ws_size < WS_END) { fprintf(stderr, "kernel_launch: unexpected shapes: n_in %d out %d ws %zu (need %zu)\n", n_in, out_size, ws_size, (size_t)WS_END); grid = -1; return; }
        int dev = 0, cus = 0, per_cu = 0;
        if (hipGetDevice(&dev) != hipSuccess || hipDeviceGetAttribute(&cus, hipDeviceAttributeMultiprocessorCount, dev) != hipSuccess) { grid = -1; return; }
        if (hipFuncSetAttribute((const void*)fwd_kernel, hipFuncAttributeMaxDynamicSharedMemorySize, LDS_BYTES) != hipSuccess) { fprintf(stderr, "kernel_launch: hipFuncSetAttribute failed\n"); grid = -1; return; }
        if (hipOccupancyMaxActiveBlocksPerMultiprocessor(&per_cu, (const void*)fwd_kernel, NTHR, LDS_BYTES) != hipSuccess || per_cu < 1) { fprintf(stderr, "kernel_launch: occupancy query says %d\n", per_cu); }
        (void)hipGetLastError();
        grid = cus;
    }
    if (grid < 0) return;
    (void)hipMemsetAsync((char*)d_ws + WS_CTL, 0, CTL_BYTES, stream);
    Args a{};
    for (int i = 0; i < 38; ++i) a.in[i] = (const float*)d_in[i];
    a.out = (float*)d_out; a.ws = (unsigned char*)d_ws;
#if ONE_LAUNCH
    a.ph_lo = 0; a.ph_hi = NPHASE;
    hipLaunchKernelGGL(fwd_kernel, dim3(grid), dim3(NTHR), LDS_BYTES, stream, a);
#else
    for (int p = 0; p < NPHASE; ++p) { a.ph_lo = p; a.ph_hi = p + 1; hipLaunchKernelGGL(fwd_kernel, dim3(grid), dim3(NTHR), LDS_BYTES, stream, a); }
#endif
}
```

```cpp
#include <hip/hip_runtime.h>
#include <stdint.h>
#include <stdio.h>

#define LAS __attribute__((address_space(3)))
typedef unsigned short bf16_t;
typedef short bf16x8 __attribute__((ext_vector_type(8)));
typedef float f32x4 __attribute__((ext_vector_type(4)));
typedef float f32x2 __attribute__((ext_vector_type(2)));
typedef unsigned u32x4 __attribute__((ext_vector_type(4)));
typedef unsigned u32x2 __attribute__((ext_vector_type(2)));

#ifndef NAIVE_ATTN
#define NAIVE_ATTN 0
#endif
#ifndef NAIVE_GLA
#define NAIVE_GLA 0
#endif
constexpr int D = 1024, NB = 8, SEQ = 4096, CTXL = 256;
constexpr int TC = NB * CTXL, TL = NB * SEQ, T = TC + TL;
constexpr int QL = 384, KVL = 256, ROPE = 64, NH = 6, QKD = 192, VD = 128;
constexpr int U0W = 768;
constexpr int QW = NH * QKD  , QWP = 1280, KVW = NH * 256  ;
constexpr int NE = 32, TOPK = 4, FF = 1024;
constexpr int U1W = 3072;
constexpr int NPAD = 147456;
constexpr float EPS = 1e-6f;
constexpr int NTHR = 512, NWAVE = 8;

constexpr size_t al256(size_t x) { return (x + 255) / 256 * 256; }
constexpr size_t XCD_BAR_WORDS_C = 3456;
constexpr size_t CW_BAR = 0;
constexpr size_t CW_Q5 = 15360;
constexpr size_t CW_CNT = 16384;
constexpr size_t CTL_BYTES = 32768;
constexpr size_t WS_CTL = 0;
constexpr size_t WS_MODV = WS_CTL + CTL_BYTES;
constexpr size_t WS_ROPE = WS_MODV + al256(2 * 9 * 6144 * 4);
constexpr size_t WS_RS = WS_ROPE + al256(2 * 64 * 16 * 4);
constexpr size_t WS_XCTX = WS_RS + al256((size_t)2 * T * 4);
constexpr size_t WS_H = WS_XCTX + al256((size_t)TC * D * 4);
constexpr size_t WS_WIN0 = WS_H + al256((size_t)T * D * 2);
constexpr size_t WS_WF = WS_WIN0 + al256((size_t)U0W * D * 2);
constexpr size_t WS_WQ = WS_WF + al256((size_t)512 * D * 2);
constexpr size_t WS_WKV = WS_WQ + al256((size_t)QWP * QL * 2);
constexpr size_t WS_WOUT0 = WS_WKV + al256((size_t)KVW * KVL * 2);
constexpr size_t WS_WIN1 = WS_WOUT0 + al256((size_t)D * D * 2);
constexpr size_t WS_WOUT1 = WS_WIN1 + al256((size_t)U1W * D * 2);
constexpr size_t WS_WGU = WS_WOUT1 + al256((size_t)D * D * 2);
constexpr size_t WS_WDN = WS_WGU + al256((size_t)NE * 2048 * D * 2);
constexpr size_t WS_ACT = WS_WDN + al256((size_t)NE * D * FF * 2);
constexpr size_t WS_LIST = WS_ACT + al256((size_t)NPAD * FF * 2);
constexpr size_t WS_TOKE = WS_LIST + al256((size_t)NE * T * 4);
constexpr size_t WS_TOKP = WS_TOKE + al256((size_t)T * 4 * 4);
constexpr size_t WS_TOKG = WS_TOKP + al256((size_t)T * 4 * 4);
constexpr size_t WS_RWT = WS_TOKG + al256((size_t)T * 4 * 4);
constexpr size_t WS_GD = WS_RWT + al256((size_t)2 * 2 * 32 * 1024 * 2);
constexpr size_t WS_REG = WS_GD + al256((size_t)T * 32 * 4);
constexpr size_t R0_U0 = WS_REG;
constexpr size_t R0_TT = R0_U0 + al256((size_t)T * U0W * 2);
constexpr size_t R0_TTC = R0_TT + al256((size_t)NB * 256 * 8192 * 2);
constexpr size_t R0_Q = R0_TTC + al256((size_t)NB * 256 * 512 * 2);
constexpr size_t R0_KV = R0_Q + al256((size_t)T * QW * 2);
constexpr size_t R0_KR = R0_KV + al256((size_t)T * KVW * 2);
constexpr size_t R0_MIX = R0_KR + al256((size_t)T * ROPE * 2);
constexpr size_t R0_DFT = R0_MIX + al256((size_t)T * D * 2);
constexpr size_t R0_DFTC = R0_DFT + al256((size_t)4096 * 4096 * 2);
constexpr size_t R0_TT2 = R0_DFTC + al256((size_t)256 * 256 * 2);
constexpr size_t R0_TTC2 = R0_TT2 + al256((size_t)NB * 256 * 4096 * 2);
constexpr size_t R0_END = R0_TTC2 + al256((size_t)NB * 256 * 256 * 2);
constexpr size_t R1_U1 = WS_REG;
constexpr size_t R1_OF = R1_U1 + al256((size_t)T * U1W * 2);
constexpr size_t R1_OB = R1_OF + al256((size_t)TL * D * 2);
constexpr size_t R1_XB = R1_OB + al256((size_t)TL * D * 2);
constexpr size_t R1_END = R1_XB + al256((size_t)TL * D * 2);
constexpr size_t RM_YB = WS_REG;
constexpr size_t RM_END = RM_YB + al256((size_t)NPAD * D * 2);
constexpr size_t cmax(size_t a, size_t b) { return a > b ? a : b; }
constexpr size_t WS_END = cmax(cmax(R0_END, R1_END), RM_END);

constexpr int LDS_BYTES = 160 * 1024;
constexpr int LDS_MISC = 1024;
constexpr int RING_OFF = LDS_MISC;

__device__ __forceinline__ float bf2f(bf16_t b) { return __uint_as_float(((unsigned)b) << 16); }
__device__ __forceinline__ bf16_t f2bf(float f) { unsigned u = __float_as_uint(f); u += 0x7FFFu + ((u >> 16) & 1u); return (bf16_t)(u >> 16); }
__device__ __forceinline__ unsigned pk2(float lo, float hi) { return (unsigned)f2bf(lo) | ((unsigned)f2bf(hi) << 16); }
typedef __bf16 bf16v2_t __attribute__((ext_vector_type(2)));
__device__ __forceinline__ unsigned cvt_pk_bf16(float lo, float hi) { const f32x2 v = {lo, hi}; bf16v2_t b = __builtin_convertvector(v, bf16v2_t); return *reinterpret_cast<unsigned*>(&b); }
__device__ __forceinline__ float wsum(float v) { for (int o = 32; o >= 1; o >>= 1) v += __shfl_xor(v, o); return v; }
__device__ __forceinline__ float siluf(float x) { return x / (1.0f + __expf(-x)); }
__device__ __forceinline__ float silu_fast(float x) { return x * __builtin_amdgcn_rcpf(1.0f + __builtin_amdgcn_exp2f(x * -1.4426950408889634f)); }

#define XB_TMO      128
#define XB_XCNT(j)  (256  + 64 * (j))
#define XB_XSUB(j)  (1280 + 64 * (j))
#define XB_XGEN(j)  (2304 + 64 * (j))
#define XB_TOP      3328
#define XB_TOPGEN   3392
#define XCD_BAR_WORDS 3456
#define XB_SPIN_CAP (1u << 20)
__device__ __forceinline__ unsigned xb_ld(unsigned* p)              { return __hip_atomic_load(p, __ATOMIC_RELAXED, __HIP_MEMORY_SCOPE_AGENT); }
__device__ __forceinline__ unsigned xb_add(unsigned* p, unsigned v) { return __hip_atomic_fetch_add(p, v, __ATOMIC_RELAXED, __HIP_MEMORY_SCOPE_AGENT); }
__device__ __forceinline__ unsigned xb_xcc_id() { return (unsigned)__builtin_amdgcn_s_getreg((3 << 11) | 20) & 0xFu; }
#define XB_SPIN(cond, bar) do { unsigned _sp = 0; while (cond) { __builtin_amdgcn_s_sleep(1); \
    if ((++_sp & 255u) == 0u) { if (xb_ld(&(bar)[XB_TMO])) break; if (_sp > XB_SPIN_CAP) { atomicAdd(&(bar)[XB_TMO], 1u); break; } } } } while (0)
struct XcdBarrier { unsigned* bar; unsigned x; volatile LAS unsigned* st; };
__device__ __forceinline__ XcdBarrier xcd_barrier_post(unsigned* bar, volatile LAS unsigned* st) {
    XcdBarrier b; b.bar = bar; b.x = xb_xcc_id(); b.st = st;
    if (threadIdx.x == 0) (void)xb_add(&bar[XB_XCNT(b.x)], 1u);
    return b;
}
__device__ __forceinline__ void xcd_barrier_complete(unsigned* bar, unsigned x, unsigned& nloc, unsigned& nx) {
    const unsigned G = gridDim.x * gridDim.y * gridDim.z;
    unsigned sum, cnt, mine, sp = 0u;
    for (;;) {
        sum = 0u; cnt = 0u; mine = 0u;
#pragma unroll
        for (unsigned j = 0; j < 16; ++j) { const unsigned c = xb_ld(&bar[XB_XCNT(j)]); sum += c; cnt += (c > 0u) ? 1u : 0u; mine = (j == x) ? c : mine; }
        if (sum == G) break;
        __builtin_amdgcn_s_sleep(1);
        if ((++sp & 255u) == 0u) { if (xb_ld(&bar[XB_TMO])) break; if (sp > XB_SPIN_CAP) { atomicAdd(&bar[XB_TMO], 1u); break; } }
    }
    nloc = mine > 0u ? mine : 1u; nx = cnt > 0u ? cnt : 1u;
}
__device__ __forceinline__ void xcd_barrier(const XcdBarrier& b) {
    asm volatile("s_waitcnt vmcnt(0)" ::: "memory");
    __syncthreads();
    if (threadIdx.x == 0) {
        unsigned* bar = b.bar;
        __builtin_amdgcn_s_waitcnt(0);
        unsigned nloc = b.st[0], nx = b.st[1];
        if (nloc == 0u) { xcd_barrier_complete(bar, b.x, nloc, nx); b.st[0] = nloc; b.st[1] = nx; }
        const unsigned old = xb_add(&bar[XB_XSUB(b.x)], 1u);
        const unsigned gen = old / nloc;
        if (old + 1u == (gen + 1u) * nloc) {
            __builtin_amdgcn_fence(__ATOMIC_RELEASE, "agent");
            asm volatile("s_waitcnt vmcnt(0)" ::: "memory");
            const unsigned og = xb_add(&bar[XB_TOP], 1u);
            const unsigned tg = og / nx;
            if (og + 1u == (tg + 1u) * nx) xb_add(&bar[XB_TOPGEN], 1u);
            else XB_SPIN(xb_ld(&bar[XB_TOPGEN]) == tg, bar);
            __builtin_amdgcn_fence(__ATOMIC_ACQUIRE, "agent");
            xb_add(&bar[XB_XGEN(b.x)], 1u);
            asm volatile("s_waitcnt vmcnt(0)" ::: "memory");
        } else {
            XB_SPIN(xb_ld(&bar[XB_XGEN(b.x)]) == gen, bar);
            __builtin_amdgcn_fence(__ATOMIC_ACQUIRE, "agent");
            asm volatile("s_waitcnt vmcnt(0)" ::: "memory");
        }
    }
    __syncthreads();
}

namespace pg8 {
constexpr int BM = 256, BK = 64, HALF = 128, HTB = HALF * BK * 2, STAGE_BYTES = 8 * HTB, NXCD = 8, WGM = 8;
__host__ __device__ __forceinline__ int lds_byte(int r, int c) { const int st = (r >> 4) * 2 + (c >> 5), rr = r & 15, cc = c & 31, ob = rr * 64 + cc * 2; return st * 1024 + (ob ^ (((ob >> 9) & 1) << 5)); }
__host__ __device__ __forceinline__ void stage_rc(int b, int& R, int& C) { const int st = b / 1024, sb = b % 1024, swz = sb ^ (((sb >> 9) & 1) << 5); R = (st >> 1) * 16 + swz / 64; C = (st & 1) * 32 + (swz % 64) / 2; }
__host__ __device__ __forceinline__ int perm32(int rho) { const int n = rho >> 4, i = rho & 15; return 8 * (i >> 2) + 4 * n + (i & 3); }

struct Unit { int pm, pn, e, cnt; const char* A; const char* B; };
struct Gemm { int K, lda, ldb; };

struct DenseOrder {
    const char* A; const char* B; int lda, ldb; int nM, nN, nwg, G, c;
    static constexpr bool GATHER = false;
    __device__ void init(const void* A_, const void* B_, int lda_, int ldb_, int M, int N, int G_, int c_) { A = (const char*)A_; B = (const char*)B_; lda = lda_; ldb = ldb_; nM = M / BM; nN = N / BM; nwg = nM * nN; G = G_; c = c_; }
    __device__ bool next(int i, Unit& u) const {
        const long L = (long)i * G + c; if (L >= nwg) return false;
        int wgid = (int)L; { const int q = nwg / NXCD, r = nwg % NXCD, xcd = wgid % NXCD, off = wgid / NXCD; wgid = (xcd < r ? xcd * (q + 1) : r * (q + 1) + (xcd - r) * q) + off; }
        const int nig = WGM * nN, gid = wgid / nig, fm = gid * WGM, gsz = (nM - fm) < WGM ? (nM - fm) : WGM;
        u.pm = fm + ((wgid % nig) % gsz); u.pn = (wgid % nig) / gsz; u.e = 0; u.cnt = 0;
        u.A = A + (size_t)u.pm * BM * lda * 2; u.B = B + (size_t)u.pn * BM * ldb * 2; return true;
    }
    __device__ __forceinline__ void aoff(const Unit&, const int (&R)[2], const int (&C)[2], unsigned (&off)[2][2]) const {
#pragma unroll
        for (int h = 0; h < 2; ++h)
#pragma unroll
            for (int i = 0; i < 2; ++i) off[h][i] = (unsigned)((h * HALF + R[i]) * lda + C[i]) * 2u;
    }
};
struct BatchOrder {
    const char* A; const char* B; size_t sA, sB; int lda, ldb; int nM, nN, per, nwg, G, c;
    static constexpr bool GATHER = false;
    __device__ void init(const void* A_, const void* B_, size_t sA_, size_t sB_, int lda_, int ldb_, int nb, int M, int N, int G_, int c_) { A = (const char*)A_; B = (const char*)B_; sA = sA_; sB = sB_; lda = lda_; ldb = ldb_; nM = M / BM; nN = N / BM; per = nM * nN; nwg = per * nb; G = G_; c = c_; }
    __device__ bool next(int i, Unit& u) const {
        const long L = (long)i * G + c; if (L >= nwg) return false;
        const int b = (int)L / per, r = (int)L % per; u.pm = r / nN; u.pn = r % nN; u.e = b; u.cnt = 0;
        u.A = A + (size_t)b * sA + (size_t)u.pm * BM * lda * 2; u.B = B + (size_t)b * sB + (size_t)u.pn * BM * ldb * 2; return true;
    }
    __device__ __forceinline__ void aoff(const Unit&, const int (&R)[2], const int (&C)[2], unsigned (&off)[2][2]) const {
#pragma unroll
        for (int h = 0; h < 2; ++h)
#pragma unroll
            for (int i = 0; i < 2; ++i) off[h][i] = (unsigned)((h * HALF + R[i]) * lda + C[i]) * 2u;
    }
};
struct DualOrder {
    DenseOrder a, b;
    static constexpr bool GATHER = false;
    __device__ __forceinline__ void aoff_issue(const Unit&, const int (&)[2], unsigned (&)[2][2]) const {}
    __device__ __forceinline__ void aoff_finish(const int (&)[2], unsigned (&)[2][2], unsigned (&)[2][2]) const {}
    __device__ bool next(int i, Unit& u) const {
        const long L = (long)i * a.G + a.c;
        if (L < a.nwg) { return a.next(i, u); }
        const long Lb = L - a.nwg; if (Lb >= b.nwg) return false;
        DenseOrder t = b; t.c = (int)(Lb % b.G); const bool ok = t.next((int)(Lb / b.G), u); u.e = 1; return ok;
    }
    __device__ __forceinline__ void aoff(const Unit& u, const int (&R)[2], const int (&C)[2], unsigned (&off)[2][2]) const { a.aoff(u, R, C, off); }
};
struct OneUnit {
    Unit u0; int lda;
    static constexpr bool GATHER = false;
    __device__ bool next(int i, Unit& u) const { if (i != 0) return false; u = u0; return true; }
    __device__ __forceinline__ void aoff(const Unit&, const int (&R)[2], const int (&C)[2], unsigned (&off)[2][2]) const {
#pragma unroll
        for (int h = 0; h < 2; ++h)
#pragma unroll
            for (int i = 0; i < 2; ++i) off[h][i] = (unsigned)((h * HALF + R[i]) * lda + C[i]) * 2u;
    }
};
template <bool GATHER_> struct MoeOrder {
    const char* A; const char* B; size_t sB; int lda, ldb; int npn, nwg, G, c;
    const LAS int* tstart; const LAS int* cnt; const int* list;
    const LAS int* t2e;
    __device__ __forceinline__ int ts(int j) const { return __builtin_amdgcn_readfirstlane(tstart[j]); }
    static constexpr bool GATHER = GATHER_;
    __device__ bool next(int i, Unit& u) const {
        const long L = (long)i * G + c; if (L >= nwg) return false;
        int wgid = (int)L; { const int q = nwg / NXCD, r = nwg % NXCD, xcd = wgid % NXCD, off = wgid / NXCD; wgid = (xcd < r ? xcd * (q + 1) : r * (q + 1) + (xcd - r) * q) + off; }
        const int e = __builtin_amdgcn_readfirstlane(t2e[wgid / npn]);
        const int t0 = ts(e), nt = ts(e + 1) - t0, l = wgid - t0 * npn, pn = l / nt, ti = l % nt;
        u.pm = t0 + ti; u.pn = pn; u.e = e; u.cnt = __builtin_amdgcn_readfirstlane(cnt[e]) - ti * BM;
        u.A = GATHER ? A : A + (size_t)u.pm * BM * lda * 2;
        u.B = B + (size_t)e * sB + (size_t)pn * BM * ldb * 2; return true;
    }
    __device__ __forceinline__ void aoff(const Unit& u, const int (&R)[2], const int (&C)[2], unsigned (&off)[2][2]) const {
        if (GATHER) {
            const int ti = u.pm - ts(u.e);
#pragma unroll
            for (int h = 0; h < 2; ++h)
#pragma unroll
                for (int i = 0; i < 2; ++i) { const int r = h * HALF + R[i]; const int tok = (r < u.cnt) ? list[(size_t)u.e * T + ti * BM + r] : 0; off[h][i] = (unsigned)(tok * lda + C[i]) * 2u; }
        } else {
#pragma unroll
            for (int h = 0; h < 2; ++h)
#pragma unroll
                for (int i = 0; i < 2; ++i) off[h][i] = (unsigned)((h * HALF + R[i]) * lda + C[i]) * 2u;
        }
    }
};

template <class Epi, class Sched>
__device__ __forceinline__ void gemm_phase(LAS unsigned char* lds, const Gemm g, const Sched& S, const Epi& E) {
    const int tid = threadIdx.x, wid = __builtin_amdgcn_readfirstlane(tid >> 6), lane = tid & 63, wr = wid >> 2, wc = wid & 3, fr = lane & 15, fq = lane >> 4;
    const int K = g.K, nt = K / BK;
    int Rr[2], Cc[2]; unsigned voffB[2];
#pragma unroll
    for (int i = 0; i < 2; ++i) { int R, C; stage_rc(tid * 16 + i * 8192, R, C); const int Rb = Epi::PERM ? ((R & ~31) + perm32(R & 31)) : R; Rr[i] = R; Cc[i] = C; voffB[i] = (unsigned)(Rb * g.ldb + C) * 2u; }
    const size_t kstep = (size_t)(BK * 2);
    const size_t hstepB = (size_t)HALF * g.ldb * 2;
    const unsigned ldsw = (unsigned)wid * 1024u;
    const int aoff = lds_byte(wr * 64 + fr, fq * 8), boff = lds_byte(wc * 32 + fr, fq * 8);
#define PG8_SA(b, h) (((b) * 2 + (h)) * HTB)
#define PG8_SB(b, h) ((4 + (b) * 2 + (h)) * HTB)
#define PG8_STAGE2(bufoff, gbase, o0, o1) do { \
        __builtin_amdgcn_global_load_lds((const unsigned*)((const char*)(gbase) + (o0)), (LAS unsigned*)(lds + (bufoff) + ldsw), 16, 0, 0); \
        __builtin_amdgcn_global_load_lds((const unsigned*)((const char*)(gbase) + (o1)), (LAS unsigned*)(lds + (bufoff) + ldsw + 8192), 16, 0, 0); } while (0)
#define PG8_STAGEB(bufoff, gbase) PG8_STAGE2(bufoff, gbase, voffB[0], voffB[1])
#define PG8_LDA(dst, b, h) do { _Pragma("unroll") for (int m = 0; m < 4; ++m) _Pragma("unroll") for (int k = 0; k < 2; ++k) dst[m][k] = *(const LAS bf16x8*)(lds + PG8_SA(b, h) + aoff + m * 2048 + k * 1024); } while (0)
#define PG8_LDB(dst, b, h) do { _Pragma("unroll") for (int n = 0; n < 2; ++n) _Pragma("unroll") for (int k = 0; k < 2; ++k) dst[n][k] = *(const LAS bf16x8*)(lds + PG8_SB(b, h) + boff + n * 2048 + k * 1024); } while (0)
#define PG8_MMA(ai, bj, At, Bt) do { __builtin_amdgcn_s_setprio(1); _Pragma("unroll") for (int m = 0; m < 4; ++m) _Pragma("unroll") for (int n = 0; n < 2; ++n) _Pragma("unroll") for (int k = 0; k < 2; ++k) \
        acc[ai][bj][m][n] = __builtin_amdgcn_mfma_f32_16x16x32_bf16(Bt[n][k], At[m][k], acc[ai][bj][m][n], 0, 0, 0); __builtin_amdgcn_s_setprio(0); } while (0)
#define PG8_WAIT_V(n) asm volatile("s_waitcnt vmcnt(" #n ")" ::: "memory")
#define PG8_WAIT_L(n) asm volatile("s_waitcnt lgkmcnt(" #n ")" ::: "memory")
#define PG8_BAR __builtin_amdgcn_s_barrier()
#define PG8_SCHED __builtin_amdgcn_sched_barrier(0)
    Unit cur, nxt; int ui = 0;
    if (!S.next(0, cur)) return;
    f32x4 acc[2][2][4][2];
#pragma unroll
    for (int a = 0; a < 2; ++a)
#pragma unroll
        for (int b = 0; b < 2; ++b)
#pragma unroll
            for (int m = 0; m < 4; ++m)
#pragma unroll
                for (int n = 0; n < 2; ++n) acc[a][b][m][n] = (f32x4){0.f, 0.f, 0.f, 0.f};
    bf16x8 At[4][2], B0[2][2], B1[2][2];
    unsigned oA[2][2], nOA[2][2];
    S.aoff(cur, Rr, Cc, oA);
    const char* cA = cur.A; const char* cB = cur.B;
    PG8_STAGEB(PG8_SB(0, 0), cB); PG8_STAGEB(PG8_SB(0, 1), cB + hstepB); PG8_STAGE2(PG8_SA(0, 0), cA, oA[0][0], oA[0][1]); PG8_STAGE2(PG8_SA(0, 1), cA, oA[1][0], oA[1][1]);
    if (wr == 1) PG8_BAR;
    PG8_WAIT_V(2); PG8_BAR;
    PG8_STAGEB(PG8_SB(1, 0), cB + kstep); PG8_STAGE2(PG8_SA(1, 0), cA + kstep, oA[0][0], oA[0][1]); PG8_STAGEB(PG8_SB(1, 1), cB + hstepB + kstep);
    PG8_WAIT_V(6); PG8_BAR;
    for (;;) {
        const bool has_next = S.next(ui + 1, nxt);
        const char* nA = has_next ? nxt.A : cA; const char* nB = has_next ? nxt.B : cB;
        if (Sched::GATHER) { if (has_next) S.aoff(nxt, Rr, Cc, nOA); else {
#pragma unroll
            for (int h = 0; h < 2; ++h)
#pragma unroll
                for (int i = 0; i < 2; ++i) nOA[h][i] = oA[h][i]; }
            asm volatile("" : "+v"(nOA[0][0]), "+v"(nOA[0][1]), "+v"(nOA[1][0]), "+v"(nOA[1][1])); }
        for (int t = 0; t < nt; t += 2) {
            const bool last = (t == nt - 2);
            const char* a1 = cA + (size_t)(t + 1) * kstep;
            const char* a2 = last ? nA : cA + (size_t)(t + 2) * kstep; const char* b2 = last ? nB : cB + (size_t)(t + 2) * kstep;
            const char* a3 = a2 + kstep; const char* b3 = b2 + kstep;
            unsigned q00 = oA[0][0], q01 = oA[0][1], q10 = oA[1][0], q11 = oA[1][1];
            if (Sched::GATHER) { q00 = last ? nOA[0][0] : q00; q01 = last ? nOA[0][1] : q01; q10 = last ? nOA[1][0] : q10; q11 = last ? nOA[1][1] : q11; }
            PG8_LDB(B0, 0, 0); PG8_LDB(B1, 0, 1); PG8_SCHED; PG8_LDA(At, 0, 0); PG8_STAGE2(PG8_SA(1, 1), a1, oA[1][0], oA[1][1]);
            PG8_WAIT_V(8); PG8_WAIT_L(0); PG8_BAR; PG8_MMA(0, 0, At, B0); PG8_MMA(0, 1, At, B1); PG8_BAR; PG8_SCHED;
            PG8_LDA(At, 0, 1); PG8_STAGEB(PG8_SB(0, 0), b2); PG8_STAGEB(PG8_SB(0, 1), b2 + hstepB); PG8_STAGE2(PG8_SA(0, 0), a2, q00, q01);
            PG8_WAIT_V(8); PG8_WAIT_L(0); PG8_BAR; PG8_MMA(1, 0, At, B0); PG8_MMA(1, 1, At, B1); PG8_BAR; PG8_SCHED;
            PG8_LDB(B0, 1, 0); PG8_LDB(B1, 1, 1); PG8_SCHED; PG8_LDA(At, 1, 0); PG8_STAGE2(PG8_SA(0, 1), a2, q10, q11);
            PG8_WAIT_V(8); PG8_WAIT_L(0); PG8_BAR; PG8_MMA(0, 0, At, B0); PG8_MMA(0, 1, At, B1); PG8_BAR; PG8_SCHED;
            PG8_LDA(At, 1, 1); PG8_STAGEB(PG8_SB(1, 0), b3); PG8_STAGEB(PG8_SB(1, 1), b3 + hstepB); PG8_STAGE2(PG8_SA(1, 0), a3, q00, q01);
            PG8_WAIT_V(8); PG8_WAIT_L(0); PG8_BAR; PG8_MMA(1, 0, At, B0); PG8_MMA(1, 1, At, B1); PG8_BAR; PG8_SCHED;
        }
        if (wr == 0) PG8_BAR;
        E(acc, cur, wr, wc, fr, fq, lds + 3 * HTB + ldsw);
        if (!has_next) break;
#pragma unroll
        for (int a = 0; a < 2; ++a)
#pragma unroll
            for (int b = 0; b < 2; ++b)
#pragma unroll
                for (int m = 0; m < 4; ++m)
#pragma unroll
                    for (int n = 0; n < 2; ++n) acc[a][b][m][n] = (f32x4){0.f, 0.f, 0.f, 0.f};
        cur = nxt; cA = nA; cB = nB; ++ui;
        if (Sched::GATHER) {
#pragma unroll
            for (int h = 0; h < 2; ++h)
#pragma unroll
                for (int i = 0; i < 2; ++i) oA[h][i] = nOA[h][i]; }
        if (wr == 1) PG8_BAR;
    }
    PG8_WAIT_V(0);
    PG8_BAR;
#undef PG8_SA
#undef PG8_SB
#undef PG8_STAGE2
#undef PG8_STAGEB
#undef PG8_LDA
#undef PG8_LDB
#undef PG8_MMA
#undef PG8_WAIT_V
#undef PG8_WAIT_L
#undef PG8_BAR
#undef PG8_SCHED
}

typedef f32x4 Acc[2][2][4][2];

struct XStore {
    LAS unsigned char* w; LAS unsigned char* r; int rr, cc;
    __device__ __forceinline__ XStore(LAS unsigned char* xs, int fr, int fq) {
        const int lane = fq * 16 + fr; rr = lane >> 2; cc = lane & 3;
        w = xs + fr * 64 + ((fq ^ ((fr >> 1) & 3)) * 16); r = xs + rr * 64 + ((cc ^ ((rr >> 1) & 3)) * 16); }
    __device__ __forceinline__ void put(const u32x4& x, const u32x4& y) const { *(LAS u32x4*)w = x; *(LAS u32x4*)(w + 8192) = y; }
    __device__ __forceinline__ void get(u32x4& x, u32x4& y) const { x = *(const LAS u32x4*)r; y = *(const LAS u32x4*)(r + 8192); }
};
struct EpiBf16 {
    static constexpr bool PERM = true;
    bf16_t* O; int ldc; int ncols;
    __device__ __forceinline__ void operator()(const Acc& acc, const Unit& u, int wr, int wc, int fr, int fq, LAS unsigned char* xs) const {
        const XStore X(xs, fr, fq);
        const int colw = u.pn * BM + wc * 32; const bool ok0 = colw < ncols, ok1 = colw + HALF < ncols;
        bf16_t* ob = O + (size_t)(u.pm * BM + wr * 64 + X.rr) * ldc + colw + 8 * X.cc;
#pragma unroll
        for (int ai = 0; ai < 2; ++ai)
#pragma unroll
            for (int m = 0; m < 4; ++m) { u32x4 w[2];
#pragma unroll
                for (int bj = 0; bj < 2; ++bj) { const f32x4 v0 = acc[ai][bj][m][0], v1 = acc[ai][bj][m][1];
                    w[bj].x = cvt_pk_bf16(v0[0], v0[1]); w[bj].y = cvt_pk_bf16(v0[2], v0[3]); w[bj].z = cvt_pk_bf16(v1[0], v1[1]); w[bj].w = cvt_pk_bf16(v1[2], v1[3]); }
                X.put(w[0], w[1]); u32x4 a, b; X.get(a, b);
                bf16_t* rowp = ob + (size_t)(ai * HALF + m * 16) * ldc; if (ok0) *(u32x4*)rowp = a; if (ok1) *(u32x4*)(rowp + HALF) = b; }
    }
};
struct EpiFourT {
    static constexpr bool PERM = true;
    bf16_t* TT; bf16_t* TTC;
    __device__ __forceinline__ void operator()(const Acc& acc, const Unit& u, int wr, int wc, int fr, int fq, LAS unsigned char* xs) const {
        const XStore X(xs, fr, fq);
        const int part = u.pm; const int ch0 = wr * 64 + X.rr; const int tokw = u.pn * BM + wc * 32;
        bf16_t* base[2]; int ldt[2];
#pragma unroll
        for (int bj = 0; bj < 2; ++bj) { const int tok = tokw + bj * HALF;
            if (tok < TC) { const int b = tok >> 8, n = tok & 255; base[bj] = TTC + (size_t)b * 256 * 512 + part * 256 + n + 8 * X.cc; ldt[bj] = 512; }
            else { const int tl = tok - TC, b = tl >> 12, n = tl & 4095; base[bj] = TT + (size_t)b * 256 * 8192 + part * 4096 + n + 8 * X.cc; ldt[bj] = 8192; } }
#pragma unroll
        for (int ai = 0; ai < 2; ++ai)
#pragma unroll
            for (int m = 0; m < 4; ++m) { const int ch = ch0 + ai * HALF + m * 16; u32x4 w[2];
#pragma unroll
                for (int bj = 0; bj < 2; ++bj) { const f32x4 v0 = acc[ai][bj][m][0], v1 = acc[ai][bj][m][1];
                    w[bj].x = cvt_pk_bf16(v0[0], v0[1]); w[bj].y = cvt_pk_bf16(v0[2], v0[3]); w[bj].z = cvt_pk_bf16(v1[0], v1[1]); w[bj].w = cvt_pk_bf16(v1[2], v1[3]); }
                X.put(w[0], w[1]); u32x4 a, b; X.get(a, b);
                *(u32x4*)(base[0] + (size_t)ch * ldt[0]) = a; *(u32x4*)(base[1] + (size_t)ch * ldt[1]) = b; }
    }
};
struct EpiRS {
    static constexpr bool PERM = true;
    bf16_t* O; const float* rs; int ldc, ncols;
    __device__ __forceinline__ void operator()(const Acc& acc, const Unit& u, int wr, int wc, int fr, int fq, LAS unsigned char* xs) const {
        const XStore X(xs, fr, fq);
        const int row0 = u.pm * BM + wr * 64 + fr, colw = u.pn * BM + wc * 32; const bool ok0 = colw < ncols, ok1 = colw + HALF < ncols;
        bf16_t* ob = O + (size_t)(u.pm * BM + wr * 64 + X.rr) * ldc + colw + 8 * X.cc;
#pragma unroll
        for (int ai = 0; ai < 2; ++ai)
#pragma unroll
            for (int m = 0; m < 4; ++m) { const float sc = rs[row0 + ai * HALF + m * 16]; u32x4 w[2];
#pragma unroll
                for (int bj = 0; bj < 2; ++bj) { const f32x4 v0 = acc[ai][bj][m][0] * sc, v1 = acc[ai][bj][m][1] * sc;
                    w[bj].x = cvt_pk_bf16(v0[0], v0[1]); w[bj].y = cvt_pk_bf16(v0[2], v0[3]); w[bj].z = cvt_pk_bf16(v1[0], v1[1]); w[bj].w = cvt_pk_bf16(v1[2], v1[3]); }
                X.put(w[0], w[1]); u32x4 a, b; X.get(a, b);
                bf16_t* rowp = ob + (size_t)(ai * HALF + m * 16) * ldc; if (ok0) *(u32x4*)rowp = a; if (ok1) *(u32x4*)(rowp + HALF) = b; }
    }
};
struct EpiFourOut {
    static constexpr bool PERM = true;
    bf16_t* MIX; int rowbase, rows_per_b;
    __device__ __forceinline__ void operator()(const Acc& acc, const Unit& u, int wr, int wc, int fr, int fq, LAS unsigned char* xs) const {
        const XStore X(xs, fr, fq);
        bf16_t* ob = MIX + (size_t)(rowbase + u.e * rows_per_b + u.pm * BM + wr * 64 + X.rr) * D + 768 + wc * 32 + 8 * X.cc;
#pragma unroll
        for (int ai = 0; ai < 2; ++ai)
#pragma unroll
            for (int m = 0; m < 4; ++m) { u32x4 w[2];
#pragma unroll
                for (int bj = 0; bj < 2; ++bj) { const f32x4 v0 = acc[ai][bj][m][0], v1 = acc[ai][bj][m][1];
                    w[bj].x = cvt_pk_bf16(v0[0], v0[1]); w[bj].y = cvt_pk_bf16(v0[2], v0[3]); w[bj].z = cvt_pk_bf16(v1[0], v1[1]); w[bj].w = cvt_pk_bf16(v1[2], v1[3]); }
                X.put(w[0], w[1]); u32x4 a, b; X.get(a, b);
                bf16_t* rowp = ob + (size_t)(ai * HALF + m * 16) * D; *(u32x4*)rowp = a; *(u32x4*)(rowp + HALF) = b; }
    }
};
struct EpiDual0 {
    static constexpr bool PERM = true;
    EpiBf16 e0; EpiFourT e1;
    __device__ __forceinline__ void operator()(const Acc& acc, const Unit& u, int wr, int wc, int fr, int fq, LAS unsigned char* xs) const { if (u.e == 0) e0(acc, u, wr, wc, fr, fq, xs); else e1(acc, u, wr, wc, fr, fq, xs); }
};
struct EpiResid {
    static constexpr bool PERM = false;
    const float* base_ctx; const float* base_lat; float* out_ctx; float* out_lat; const float* modv; int goff; int rowoff;
    __device__ __forceinline__ void operator()(const Acc& acc, const Unit& u, int wr, int wc, int fr, int fq, LAS unsigned char* xs) const {
        const int rt = rowoff + u.pm * BM;
        const bool isctx = rt < TC; const int mr = isctx ? 8 : ((rt - TC) >> 12);
        const float* base = isctx ? base_ctx + (size_t)rt * D : base_lat + (size_t)(rt - TC) * D;
        float* out = isctx ? out_ctx + (size_t)rt * D : out_lat + (size_t)(rt - TC) * D;
        const float* gv = modv + mr * 6144 + goff;
        const int r0 = wr * 64 + fr, col0 = u.pn * BM + wc * 32 + 4 * fq;
        f32x4 g[2][2];
#pragma unroll
        for (int bj = 0; bj < 2; ++bj)
#pragma unroll
            for (int n = 0; n < 2; ++n) g[bj][n] = *(const f32x4*)(gv + col0 + bj * HALF + n * 16);
#pragma unroll
        for (int ai = 0; ai < 2; ++ai) {
            f32x4 bs[4][2][2];
#pragma unroll
            for (int m = 0; m < 4; ++m) { const size_t off = (size_t)(r0 + ai * HALF + m * 16) * D + col0;
#pragma unroll
                for (int bj = 0; bj < 2; ++bj)
#pragma unroll
                    for (int n = 0; n < 2; ++n) bs[m][bj][n] = *(const f32x4*)(base + off + bj * HALF + n * 16); }
#pragma unroll
            for (int m = 0; m < 4; ++m) { const size_t off = (size_t)(r0 + ai * HALF + m * 16) * D + col0;
#pragma unroll
                for (int bj = 0; bj < 2; ++bj)
#pragma unroll
                    for (int n = 0; n < 2; ++n) *(f32x4*)(out + off + bj * HALF + n * 16) = bs[m][bj][n] + g[bj][n] * acc[ai][bj][m][n]; }
            asm volatile("" ::: "memory"); }
    }
};
struct EpiGateBf16 {
    static constexpr bool PERM = true; static constexpr int NSTORE = 16;
    bf16_t* Y; const float* modv; int goff, rowoff, ybase;
    __device__ __forceinline__ void operator()(const Acc& acc, const Unit& u, int wr, int wc, int fr, int fq, LAS unsigned char* xs) const {
        const XStore X(xs, fr, fq);
        const int rt = rowoff + u.pm * BM; const int mr = rt < TC ? 8 : ((rt - TC) >> 12);
        const float* gv = modv + mr * 6144 + goff; const int col0 = u.pn * BM + wc * 32 + 8 * fq;
        f32x4 g[2][2];
#pragma unroll
        for (int bj = 0; bj < 2; ++bj)
#pragma unroll
            for (int n = 0; n < 2; ++n) g[bj][n] = *(const f32x4*)(gv + col0 + bj * HALF + 4 * n);
        bf16_t* yb = Y + (size_t)(rt - ybase + wr * 64 + X.rr) * D + u.pn * BM + wc * 32 + 8 * X.cc;
#pragma unroll
        for (int ai = 0; ai < 2; ++ai)
#pragma unroll
            for (int m = 0; m < 4; ++m) { u32x4 w[2];
#pragma unroll
                for (int bj = 0; bj < 2; ++bj) { const f32x4 v0 = acc[ai][bj][m][0] * g[bj][0], v1 = acc[ai][bj][m][1] * g[bj][1];
                    w[bj].x = cvt_pk_bf16(v0[0], v0[1]); w[bj].y = cvt_pk_bf16(v0[2], v0[3]); w[bj].z = cvt_pk_bf16(v1[0], v1[1]); w[bj].w = cvt_pk_bf16(v1[2], v1[3]); }
                X.put(w[0], w[1]); u32x4 a, b; X.get(a, b);
                bf16_t* rowp = yb + (size_t)(ai * HALF + m * 16) * D; *(u32x4*)rowp = a; *(u32x4*)(rowp + HALF) = b; }
    }
};
struct EpiSwiglu {
    static constexpr bool PERM = true;
    bf16_t* ACT; const float* bgu;
    __device__ __forceinline__ void operator()(const Acc& acc, const Unit& u, int wr, int wc, int fr, int fq, LAS unsigned char* xs) const {
        const XStore X(xs, fr, fq);
        const int a0 = u.pn * HALF + wc * 32 + 8 * fq;
        const float* bp = bgu + (size_t)u.e * 2048 + 2 * a0;
        float bg[8], bl[8];
#pragma unroll
        for (int q = 0; q < 4; ++q) { const f32x4 t = *(const f32x4*)(bp + 4 * q); bg[2 * q] = t[0]; bl[2 * q] = t[1]; bg[2 * q + 1] = t[2]; bl[2 * q + 1] = t[3]; }
        bf16_t* ab = ACT + (size_t)(u.pm * BM + wr * 64 + X.rr) * FF + u.pn * HALF + wc * 32 + 8 * X.cc;
#pragma unroll
        for (int ai = 0; ai < 2; ++ai)
#pragma unroll
            for (int mp = 0; mp < 2; ++mp) { u32x4 w[2];
#pragma unroll
                for (int mm = 0; mm < 2; ++mm) { const int m = 2 * mp + mm; float o[8];
#pragma unroll
                    for (int j = 0; j < 8; ++j) { float xg = acc[ai][0][m][j >> 2][j & 3] + bg[j], xl = acc[ai][1][m][j >> 2][j & 3] + bl[j];
                        xg = fminf(xg, 7.0f); xl = fminf(fmaxf(xl, -7.0f), 7.0f);
                        o[j] = xg * __builtin_amdgcn_rcpf(1.0f + __builtin_amdgcn_exp2f(xg * (-1.702f * 1.4426950408889634f))) * (xl + 1.0f); }
                    w[mm].x = cvt_pk_bf16(o[0], o[1]); w[mm].y = cvt_pk_bf16(o[2], o[3]); w[mm].z = cvt_pk_bf16(o[4], o[5]); w[mm].w = cvt_pk_bf16(o[6], o[7]); }
                X.put(w[0], w[1]); u32x4 a, b; X.get(a, b);
                bf16_t* rowp = ab + (size_t)(ai * HALF + mp * 32) * FF; *(u32x4*)rowp = a; *(u32x4*)(rowp + (size_t)16 * FF) = b; }
    }
};
struct EpiDown {
    static constexpr bool PERM = true;
    bf16_t* YB; const float* bdn;
    __device__ __forceinline__ void operator()(const Acc& acc, const Unit& u, int wr, int wc, int fr, int fq, LAS unsigned char* xs) const {
        const int col0 = u.pn * BM + wc * 32 + 8 * fq;
        f32x4 bv[2][2];
#pragma unroll
        for (int bj = 0; bj < 2; ++bj)
#pragma unroll
            for (int n = 0; n < 2; ++n) bv[bj][n] = *(const f32x4*)(bdn + (size_t)u.e * D + col0 + bj * HALF + 4 * n);
        const XStore X(xs, fr, fq);
        bf16_t* yb = YB + (size_t)(u.pm * BM + wr * 64 + X.rr) * D + u.pn * BM + wc * 32 + 8 * X.cc;
#pragma unroll
        for (int ai = 0; ai < 2; ++ai)
#pragma unroll
            for (int m = 0; m < 4; ++m) { u32x4 w[2];
#pragma unroll
                for (int bj = 0; bj < 2; ++bj) { const f32x4 v0 = acc[ai][bj][m][0] + bv[bj][0], v1 = acc[ai][bj][m][1] + bv[bj][1];
                    w[bj].x = cvt_pk_bf16(v0[0], v0[1]); w[bj].y = cvt_pk_bf16(v0[2], v0[3]); w[bj].z = cvt_pk_bf16(v1[0], v1[1]); w[bj].w = cvt_pk_bf16(v1[2], v1[3]); }
                X.put(w[0], w[1]); u32x4 a, b; X.get(a, b);
                bf16_t* rowp = yb + (size_t)(ai * HALF + m * 16) * D; *(u32x4*)rowp = a; *(u32x4*)(rowp + HALF) = b; }
    }
};
}

struct Args { const float* in[38]; float* out; unsigned char* ws; int ph_lo, ph_hi; };
enum { I_X = 0, I_C, I_CTX, I_CCTX, I_FNG,
       I0_MODW, I0_MODB, I0_N1G, I0_WIN, I0_QNG, I0_WQUP, I0_KVNG, I0_WKVUP, I0_WOUT, I0_N2G, I0_RW, I0_RB, I0_WGU, I0_BGU, I0_WDN, I0_BDN,
       I1_MODW, I1_MODB, I1_N1G, I1_WIN, I1_WGKF, I1_BGKF, I1_WGKB, I1_BGKB, I1_GNG, I1_WOUT, I1_N2G, I1_RW, I1_RB, I1_WGU, I1_BGU, I1_WDN, I1_BDN };

struct Frame {
    const float* const* in; float* out; unsigned char* ws; LAS unsigned char* lds; LAS unsigned char* ring;
    int tid, lane, wave, G, bid;
};
#define WSP(T_, off) ((T_*)(F.ws + (off)))

__device__ __forceinline__ int gu_row(int n) { const int a = n >> 1, half = n & 1; return 256 * (a >> 7) + 128 * half + (a & 127); }
template <int MODE>
__device__ __forceinline__ void cvt_tile(const Frame& F, LAS bf16_t* tile  , const float* src, int ldsrc, int k0, int n0, bf16_t* dst, int ldd, const float* sk, float mul) {
    const int t = F.tid;
    { const int kl = t >> 3, nc = (t & 7) * 8; const float* p = src + (size_t)(k0 + kl) * ldsrc + n0 + nc;
      const f32x4 a = *(const f32x4*)p, b = *(const f32x4*)(p + 4); const float s = (sk ? sk[k0 + kl] : 1.0f) * mul;
      tile[(nc + 0) * 72 + kl] = f2bf(a[0] * s); tile[(nc + 1) * 72 + kl] = f2bf(a[1] * s); tile[(nc + 2) * 72 + kl] = f2bf(a[2] * s); tile[(nc + 3) * 72 + kl] = f2bf(a[3] * s);
      tile[(nc + 4) * 72 + kl] = f2bf(b[0] * s); tile[(nc + 5) * 72 + kl] = f2bf(b[1] * s); tile[(nc + 6) * 72 + kl] = f2bf(b[2] * s); tile[(nc + 7) * 72 + kl] = f2bf(b[3] * s); }
    __syncthreads();
    { const int nl = t >> 3, kc = (t & 7) * 8; const int n = n0 + nl; const int row = MODE == 1 ? gu_row(n) : n;
      const u32x4 v = *(const LAS u32x4*)(tile + nl * 72 + kc); *(u32x4*)(dst + (size_t)row * ldd + k0 + kc) = v; }
    __syncthreads();
}
template <int MODE>
__device__ __forceinline__ void cvt_blk(const Frame& F, LAS float* tl, const float* src, int ldsrc, int k0, int n0, bf16_t* dst, int ldd) {
    const int t = F.tid, w = t >> 6, l = t & 63;
    f32x4 v[8];
#pragma unroll
    for (int i = 0; i < 8; ++i) v[i] = *(const f32x4*)(src + (size_t)(k0 + w + 8 * i) * ldsrc + n0 + 4 * l);
#pragma unroll
    for (int i = 0; i < 8; ++i) *(LAS f32x4*)(tl + (w + 8 * i) * 260 + 4 * l) = v[i];
    __syncthreads();
    { const int n = t & 255, kh = t >> 8; const int row = MODE == 1 ? gu_row(n0 + n) : n0 + n; bf16_t* dp = dst + (size_t)row * ldd + k0 + kh * 32;
#pragma unroll
      for (int q = 0; q < 4; ++q) { float x[8];
#pragma unroll
          for (int j = 0; j < 8; ++j) x[j] = tl[(kh * 32 + 8 * q + j) * 260 + n];
          u32x4 o; o.x = cvt_pk_bf16(x[0], x[1]); o.y = cvt_pk_bf16(x[2], x[3]); o.z = cvt_pk_bf16(x[4], x[5]); o.w = cvt_pk_bf16(x[6], x[7]);
          *(u32x4*)(dp + 8 * q) = o; } }
    __syncthreads();
}
constexpr int CVT_NGU = NE * 16 * 8, CVT_NDN = NE * 16 * 4, CVT_JOBS = CVT_NGU + CVT_NDN;
__device__ __forceinline__ void cvt_moe_job(const Frame& F, LAS float* tl, const float* wgu, const float* wdn, int j) {
    bf16_t* WGU = WSP(bf16_t, WS_WGU); bf16_t* WDN = WSP(bf16_t, WS_WDN);
    if (j < CVT_NGU) { const int e = j >> 7, r = j & 127, kt = r >> 3, ntl = r & 7; cvt_blk<1>(F, tl, wgu + (size_t)e * 1024 * 2048, 2048, kt * 64, ntl * 256, WGU + (size_t)e * 2048 * 1024, 1024); }
    else { const int jj = j - CVT_NGU, e = jj >> 6, r = jj & 63, kt = r >> 2, ntl = r & 3; cvt_blk<0>(F, tl, wdn + (size_t)e * 1024 * 1024, 1024, kt * 64, ntl * 256, WDN + (size_t)e * 1024 * 1024, 1024); }
}
__device__ __forceinline__ void cvt_moe_weights(const Frame& F, LAS float* tl, const float* wgu, const float* wdn) {
    for (int j = F.bid; j < CVT_JOBS; j += F.G) cvt_moe_job(F, tl, wgu, wdn, j);
}
__device__ __forceinline__ void ph_prologue(const Frame& F) {
    LAS float* sc = (LAS float*)(F.ring);
    LAS float* red = (LAS float*)(F.ring + 36864);
    LAS float* ctab = (LAS float*)(F.ring + 55296);
    LAS float* stab = ctab + 4096;
    LAS bf16_t* tile = (LAS bf16_t*)(F.ring + 88064);
    LAS float* wt = (LAS float*)(F.ring + 97280);
    const int t = F.tid;
    for (int i = t; i < 9 * 1024; i += NTHR) { const int r = i >> 10, k = i & 1023; const float v = (r < 8) ? F.in[I_C][r * 1024 + k] : F.in[I_CCTX][k]; sc[i] = siluf(v); }
    for (int i = t; i < 4096; i += NTHR) { const float x = (float)i * (1.0f / 2048.0f); ctab[i] = cospif(x); stab[i] = sinpif(x); }
    __syncthreads();
    for (int u = F.bid; u < 2 * 96; u += F.G) {
        const int l = u / 96, j0 = (u % 96) * 64; const float* W = l ? F.in[I1_MODW] : F.in[I0_MODW]; const float* Bv = l ? F.in[I1_MODB] : F.in[I0_MODB];
        const int c4 = t & 15, kb = F.wave * 128 + ((t >> 4) & 3) * 32; f32x4 a[9];
#pragma unroll
        for (int r = 0; r < 9; ++r) a[r] = (f32x4){0.f, 0.f, 0.f, 0.f};
#pragma unroll 8
        for (int q = 0; q < 32; ++q) { const f32x4 w = *(const f32x4*)(W + (size_t)(kb + q) * 6144 + j0 + 4 * c4);
#pragma unroll
            for (int r = 0; r < 9; ++r) a[r] += w * sc[r * 1024 + kb + q]; }
#pragma unroll
        for (int r = 0; r < 9; ++r) {
#pragma unroll
            for (int j = 0; j < 4; ++j) { float v = a[r][j]; v += __shfl_xor(v, 16); v += __shfl_xor(v, 32); a[r][j] = v; }
            if ((t & 48) == 0) *(LAS f32x4*)(red + (F.wave * 9 + r) * 64 + 4 * c4) = a[r]; }
        __syncthreads();
        for (int i = t; i < 576; i += NTHR) { const int r = i >> 6, c = i & 63; float s = 0.f;
#pragma unroll
            for (int q = 0; q < 8; ++q) s += red[(q * 9 + r) * 64 + c];
            WSP(float, WS_MODV)[(size_t)(l * 9 + r) * 6144 + j0 + c] = s + Bv[j0 + c]; }
        __syncthreads();
    }
    if (F.bid == (1 % F.G)) { for (int i = t; i < 1024; i += NTHR) { const int pos = i >> 4, j = i & 15; const float inv = powf(10000.0f, -(float)j / 16.0f); const float ang = (float)pos * inv;
        WSP(float, WS_ROPE)[i] = cosf(ang); WSP(float, WS_ROPE)[1024 + i] = sinf(ang); } }
    { bf16_t* DFT = WSP(bf16_t, R0_DFT); bf16_t* DFTC = WSP(bf16_t, R0_DFTC);
      for (int k = F.bid; k < 4096 + 256; k += F.G) {
          if (k < 4096) { for (int jc = t; jc < 512; jc += NTHR) { const int j0 = jc * 8; float v[8];
#pragma unroll
                  for (int q = 0; q < 8; ++q) { const int j = j0 + q; const bool isS = j > 2048; const int idx = (k * (isS ? j - 2048 : j)) & 4095; v[q] = (isS ? stab[idx] : ctab[idx]) * (1.0f / 512.0f); }
                  u32x4 w; w.x = pk2(v[0], v[1]); w.y = pk2(v[2], v[3]); w.z = pk2(v[4], v[5]); w.w = pk2(v[6], v[7]); *(u32x4*)(DFT + (size_t)k * 4096 + j0) = w; } }
          else { const int kk = k - 4096; for (int jc = t; jc < 32; jc += NTHR) { const int j0 = jc * 8; float v[8];
#pragma unroll
                  for (int q = 0; q < 8; ++q) { const int j = j0 + q; const bool isS = j > 128; const int idx = ((kk * (isS ? j - 128 : j)) & 255) * 16; v[q] = (isS ? stab[idx] : ctab[idx]) * (1.0f / 128.0f); }
                  u32x4 w; w.x = pk2(v[0], v[1]); w.y = pk2(v[2], v[3]); w.z = pk2(v[4], v[5]); w.w = pk2(v[6], v[7]); *(u32x4*)(DFTC + (size_t)kk * 256 + j0) = w; } }
      } }
    { bf16_t* WF = WSP(bf16_t, WS_WF); const float* Win = F.in[I0_WIN];
      for (int j = (F.bid + 64) % F.G; j < 64; j += F.G) { const int k0 = (j >> 2) * 64, g = j & 3;
          for (int i = t; i < 4096; i += NTHR) { const int kl = i >> 6, c = i & 63; wt[kl * 65 + c] = Win[(size_t)(k0 + kl) * 960 + 704 + g * 64 + c]; }
          __syncthreads();
          { const int kl = t & 63, mg = t >> 6;
#pragma unroll 1
            for (int mm = 0; mm < 8; ++mm) { const int m = mg * 8 + mm; float ac = 0.f, as = 0.f;
                for (int c = 0; c < 64; ++c) { const int idx = ((m * c) & 63) * 64; const float w = wt[kl * 65 + c]; ac = fmaf(w, ctab[idx], ac); as = fmaf(w, stab[idx], as); }
                WF[(size_t)(g * 64 + m) * 1024 + k0 + kl] = f2bf(ac); WF[(size_t)(256 + g * 64 + m) * 1024 + k0 + kl] = f2bf(-as); } }
          __syncthreads(); } }
    for (int i = F.bid * NTHR + t; i < 2 * 32 * 1024; i += F.G * NTHR) { const int l = i >> 15, e = (i >> 10) & 31, k = i & 1023; const float w = (l ? F.in[I1_RW] : F.in[I0_RW])[k * 32 + e];
        const bf16_t hi = f2bf(w); const bf16_t lo = f2bf(w - bf2f(hi)); bf16_t* base = WSP(bf16_t, WS_RWT) + (size_t)l * 2 * 32 * 1024; base[e * 1024 + k] = hi; base[32 * 1024 + e * 1024 + k] = lo; }
    {
      constexpr int J_WIN0 = 16 * 11, J_WQ = 6 * 18, J_WKV = 4 * 24, J_WO = 16 * 16, J_WIN1 = 16 * 48;
      constexpr int JT = J_WIN0 + J_WQ + J_WKV + 2 * J_WO + J_WIN1;
      for (int j = F.bid; j < JT; j += F.G) { int r = j;
          if (r < J_WIN0) { cvt_tile<0>(F, tile, F.in[I0_WIN], 960, (r / 11) * 64, (r % 11) * 64, WSP(bf16_t, WS_WIN0), 1024, nullptr, 1.0f); continue; } r -= J_WIN0;
          if (r < J_WQ) { cvt_tile<0>(F, tile, F.in[I0_WQUP], 1152, (r / 18) * 64, (r % 18) * 64, WSP(bf16_t, WS_WQ), QL, F.in[I0_QNG], 1.0f); continue; } r -= J_WQ;
          if (r < J_WKV) { cvt_tile<0>(F, tile, F.in[I0_WKVUP], 1536, (r / 24) * 64, (r % 24) * 64, WSP(bf16_t, WS_WKV), KVL, F.in[I0_KVNG], 1.0f); continue; } r -= J_WKV;
          if (r < J_WO) { cvt_tile<0>(F, tile, F.in[I0_WOUT], 1024, (r / 16) * 64, (r % 16) * 64, WSP(bf16_t, WS_WOUT0), 1024, nullptr, 1.0f); continue; } r -= J_WO;
          if (r < J_WO) { cvt_tile<0>(F, tile, F.in[I1_WOUT], 1024, (r / 16) * 64, (r % 16) * 64, WSP(bf16_t, WS_WOUT1), 1024, nullptr, 1.0f); continue; } r -= J_WO;
          { const int n0 = (r % 48) * 64; cvt_tile<0>(F, tile, F.in[I1_WIN], 3104, (r / 48) * 64, n0, WSP(bf16_t, WS_WIN1), 1024, nullptr, n0 < 512 ? 0.08838834764831845f : 1.0f); }
      }
      for (int i = F.bid * NTHR + t; i < (64 * 1024 + 128 * QL) / 8; i += F.G * NTHR) { const u32x4 z = {0u, 0u, 0u, 0u};
          if (i < 64 * 1024 / 8) *(u32x4*)(WSP(bf16_t, WS_WIN0) + (size_t)704 * 1024 + (size_t)i * 8) = z; else *(u32x4*)(WSP(bf16_t, WS_WQ) + (size_t)1152 * QL + (size_t)(i - 64 * 1024 / 8) * 8) = z; }
    }
}

__device__ __forceinline__ const float* xrow_in(const Frame& F, int r) { return r < TC ? F.in[I_CTX] + (size_t)r * D : F.in[I_X] + (size_t)(r - TC) * D; }
__device__ __forceinline__ float* xrow_res(const Frame& F, int r) { return r < TC ? WSP(float, WS_XCTX) + (size_t)r * D : F.out + (size_t)(r - TC) * D; }
__device__ __forceinline__ bf16_t* xrow_b(const Frame& F, int r) { return WSP(bf16_t, R1_XB) + (size_t)(r - TC) * D; }
__device__ __forceinline__ int modrow(int r) { return r < TC ? 8 : ((r - TC) >> 12); }
__device__ __forceinline__ void ld16f(const float* p, int lane, float (&v)[16]) {
#pragma unroll
    for (int h = 0; h < 2; ++h) { const f32x4 a = *(const f32x4*)(p + 8 * lane + 512 * h), b = *(const f32x4*)(p + 8 * lane + 512 * h + 4);
        v[8 * h] = a[0]; v[8 * h + 1] = a[1]; v[8 * h + 2] = a[2]; v[8 * h + 3] = a[3]; v[8 * h + 4] = b[0]; v[8 * h + 5] = b[1]; v[8 * h + 6] = b[2]; v[8 * h + 7] = b[3]; }
}
__device__ __forceinline__ void st16f(float* p, int lane, const float (&v)[16]) {
#pragma unroll
    for (int h = 0; h < 2; ++h) { *(f32x4*)(p + 8 * lane + 512 * h) = (f32x4){v[8 * h], v[8 * h + 1], v[8 * h + 2], v[8 * h + 3]}; *(f32x4*)(p + 8 * lane + 512 * h + 4) = (f32x4){v[8 * h + 4], v[8 * h + 5], v[8 * h + 6], v[8 * h + 7]}; }
}
__device__ __forceinline__ void ld16b(const bf16_t* p, int lane, float (&v)[16]) {
#pragma unroll
    for (int h = 0; h < 2; ++h) { const u32x4 w = *(const u32x4*)(p + 8 * lane + 512 * h);
#pragma unroll
        for (int q = 0; q < 4; ++q) { v[8 * h + 2 * q] = __uint_as_float(w[q] << 16); v[8 * h + 2 * q + 1] = __uint_as_float(w[q] & 0xffff0000u); } }
}
__device__ __forceinline__ void st16b(bf16_t* p, int lane, const float (&v)[16]) {
#pragma unroll
    for (int h = 0; h < 2; ++h) { u32x4 w; w.x = cvt_pk_bf16(v[8 * h], v[8 * h + 1]); w.y = cvt_pk_bf16(v[8 * h + 2], v[8 * h + 3]); w.z = cvt_pk_bf16(v[8 * h + 4], v[8 * h + 5]); w.w = cvt_pk_bf16(v[8 * h + 6], v[8 * h + 7]);
        *(u32x4*)(p + 8 * lane + 512 * h) = w; }
}
__device__ __forceinline__ void modulate16(float (&v)[16], const float* g, const float* scale, const float* shift, int lane) {
    float ss = 0.f;
#pragma unroll
    for (int i = 0; i < 16; ++i) ss = fmaf(v[i], v[i], ss);
    const float rs = rsqrtf(wsum(ss) * (1.0f / D) + EPS);
    float gg[16], sc[16], sh[16]; ld16f(g, lane, gg); ld16f(scale, lane, sc); ld16f(shift, lane, sh);
#pragma unroll
    for (int i = 0; i < 16; ++i) v[i] = v[i] * rs * gg[i] * (1.0f + sc[i]) + sh[i];
}

__device__ __forceinline__ void ph_mod0(const Frame& F) {
    const float* g = F.in[I0_N1G]; bf16_t* H = WSP(bf16_t, WS_H);
    for (int r = F.bid * NWAVE + F.wave; r < T; r += F.G * NWAVE) {
        const float* mv = WSP(float, WS_MODV) + (size_t)modrow(r) * 6144;
        float v[16]; ld16f(xrow_in(F, r), F.lane, v);
        modulate16(v, g, mv + 1024, mv, F.lane);
        st16b(H + (size_t)r * D, F.lane, v);
    }
}
__device__ __forceinline__ void ph_rowstats(const Frame& F) {
    const bf16_t* U0 = WSP(bf16_t, R0_U0); float* rsq = WSP(float, WS_RS); float* rskv = rsq + T; bf16_t* KR = WSP(bf16_t, R0_KR);
    const float* rc = WSP(float, WS_ROPE); const float* rsn = rc + 1024;
    for (int r = F.bid * NWAVE + F.wave; r < T; r += F.G * NWAVE) {
        const bf16_t* u = U0 + (size_t)r * U0W; const int lane = F.lane;
        float a[8], b[8];
        { const u32x4 w = *(const u32x4*)(u + 8 * lane);
#pragma unroll
          for (int q = 0; q < 4; ++q) { a[2 * q] = __uint_as_float(w[q] << 16); a[2 * q + 1] = __uint_as_float(w[q] & 0xffff0000u); } }
        { u32x4 w = {0u, 0u, 0u, 0u}; if (lane < 32) w = *(const u32x4*)(u + 512 + 8 * lane);
#pragma unroll
          for (int q = 0; q < 4; ++q) { b[2 * q] = __uint_as_float(w[q] << 16); b[2 * q + 1] = __uint_as_float(w[q] & 0xffff0000u); } }
        float sa = 0.f, sb = 0.f;
#pragma unroll
        for (int j = 0; j < 8; ++j) { sa = fmaf(a[j], a[j], sa); sb = fmaf(b[j], b[j], sb); }
        const float sq = wsum(lane < 48 ? sa : 0.f), skv = wsum((lane >= 48 ? sa : 0.f) + (lane < 16 ? sb : 0.f));
        float pr[8];
#pragma unroll
        for (int j = 0; j < 8; ++j) pr[j] = __shfl_xor(b[j], 2);
        if (lane >= 16 && lane < 24) { const int jq = lane - 16, quarter = jq >> 1;
            if (r >= TC) { const int n = (r - TC) & 4095; const int pos = (quarter >= 2) ? (n & 63) : (n >> 6); const float* cp = rc + pos * 16 + (jq & 1) * 8; const float* sp = rsn + pos * 16 + (jq & 1) * 8;
#pragma unroll
                for (int j = 0; j < 8; ++j) b[j] = (quarter & 1) ? (b[j] * cp[j] + pr[j] * sp[j]) : (b[j] * cp[j] - pr[j] * sp[j]); }
            u32x4 w; w.x = cvt_pk_bf16(b[0], b[1]); w.y = cvt_pk_bf16(b[2], b[3]); w.z = cvt_pk_bf16(b[4], b[5]); w.w = cvt_pk_bf16(b[6], b[7]);
            *(u32x4*)(KR + (size_t)r * ROPE + 8 * jq) = w; }
        if (lane == 0) { rsq[r] = rsqrtf(sq * (1.0f / QL) + EPS); rskv[r] = rsqrtf(skv * (1.0f / KVL) + EPS); }
    }
    { const bf16_t* TT = WSP(bf16_t, R0_TT); const bf16_t* TTC = WSP(bf16_t, R0_TTC); bf16_t* TT2 = WSP(bf16_t, R0_TT2); bf16_t* TTC2 = WSP(bf16_t, R0_TTC2);
      const int nch_l = NB * 256 * 512, nch_c = NB * 256 * 32;
      for (int i = F.bid * NTHR + F.tid; i < nch_l + nch_c; i += F.G * NTHR) {
          const bool lat = i < nch_l; const int ii = lat ? i : i - nch_l; const int N = lat ? 4096 : 256; const int cpr = N >> 3; const int row = ii / cpr, p0 = (ii % cpr) * 8;
          const bf16_t* src = (lat ? TT : TTC) + (size_t)row * 2 * N; bf16_t* dst = (lat ? TT2 : TTC2) + (size_t)row * N + p0; float v[8];
#pragma unroll
          for (int q = 0; q < 8; ++q) { const int pp = p0 + q; const bool cs = pp <= (N >> 1); const int j = cs ? pp : pp - (N >> 1); const bf16_t* X = cs ? src : src + N;
              const float a = bf2f(X[j]); const float bmir = (j == 0 || j == (N >> 1)) ? 0.f : bf2f(X[N - j]); v[q] = cs ? a + bmir : a - bmir; }
          u32x4 w; w.x = pk2(v[0], v[1]); w.y = pk2(v[2], v[3]); w.z = pk2(v[4], v[5]); w.w = pk2(v[6], v[7]); *(u32x4*)dst = w; }
    }
}

namespace att {
typedef float f32x16 __attribute__((ext_vector_type(16)));
typedef short s16x4 __attribute__((ext_vector_type(4)));
constexpr float SCALE = 0.07216878364870322f, THR = 8.f;
constexpr int SHM_V = 16384, SHM_KN = 64 * 272, SHM_KR = 64 * 144, SHM_QW = 32 * 272;
constexpr int OFF_V = 0, OFF_KN = 2 * SHM_V, OFF_KR = OFF_KN + 2 * SHM_KN, OFF_WS = OFF_KR + 2 * SHM_KR, OFF_QR = OFF_WS + 2048;
#define KNSWZ(row, cb) ((row) * 272 + (cb))
#define KRSWZ(row, cb) ((row) * 144 + (cb))
#define SBAR() __builtin_amdgcn_sched_barrier(0)
__device__ __forceinline__ int crow(int r, int hi) { return (r & 3) + 8 * (r >> 2) + 4 * hi; }
__device__ __forceinline__ void partialSM(f32x16& p0, f32x16& p1, float& m_reg, float& mn, float& alpha) {
  constexpr float C = SCALE * 1.4426950408889634f;
  float pmax = p0[0];
#pragma unroll
  for (int r = 1; r < 16; ++r) pmax = fmaxf(pmax, p0[r]);
#pragma unroll
  for (int r = 0; r < 16; ++r) pmax = fmaxf(pmax, p1[r]);
  { auto rr = __builtin_amdgcn_permlane32_swap(__float_as_uint(pmax), __float_as_uint(pmax), false, false);
    pmax = fmaxf(__uint_as_float(rr[0]), __uint_as_float(rr[1])); }
  if (__builtin_expect(__all(pmax - m_reg <= THR / SCALE), 1)) { mn = m_reg; alpha = 1.f; }
  else { mn = fmaxf(m_reg, pmax); alpha = __builtin_amdgcn_exp2f((m_reg - mn) * C); m_reg = mn; }
  const float mnC = -mn * C;
#pragma unroll
  for (int r = 0; r < 16; ++r) p0[r] = fmaf(p0[r], C, mnC);
#pragma unroll
  for (int r = 0; r < 16; ++r) p1[r] = fmaf(p1[r], C, mnC);
#pragma unroll
  for (int r = 0; r < 16; ++r) p0[r] = __builtin_amdgcn_exp2f(p0[r]);
}
__device__ __forceinline__ void finishSM(f32x16& p0, f32x16& p1, float alpha, float& l_reg, bf16x8& pa0, bf16x8& pa1, bf16x8& pa2, bf16x8& pa3) {
#pragma unroll
  for (int r = 0; r < 16; ++r) p1[r] = __builtin_amdgcn_exp2f(p1[r]);
  float ps = 0;
#pragma unroll
  for (int r = 0; r < 16; ++r) ps += p0[r];
#pragma unroll
  for (int r = 0; r < 16; ++r) ps += p1[r];
  { auto rr = __builtin_amdgcn_permlane32_swap(__float_as_uint(ps), __float_as_uint(ps), false, false);
    ps = __uint_as_float(rr[0]) + __uint_as_float(rr[1]); }
  l_reg = l_reg * alpha + ps;
#define PK4(P, BASE, OUT) do { unsigned a0 = cvt_pk_bf16(P[BASE + 0], P[BASE + 1]), a1 = cvt_pk_bf16(P[BASE + 2], P[BASE + 3]);   \
    unsigned b0 = cvt_pk_bf16(P[BASE + 4], P[BASE + 5]), b1 = cvt_pk_bf16(P[BASE + 6], P[BASE + 7]);                              \
    auto r0 = __builtin_amdgcn_permlane32_swap(a0, b0, false, false); auto r1 = __builtin_amdgcn_permlane32_swap(a1, b1, false, false); \
    u32x4 w = {r0[0], r1[0], r0[1], r1[1]}; OUT = *reinterpret_cast<bf16x8*>(&w); } while (0)
  PK4(p0, 0, pa0); PK4(p0, 8, pa1); PK4(p1, 0, pa2); PK4(p1, 8, pa3);
#undef PK4
}
__device__ __forceinline__ void qkt(f32x16& p0, f32x16& p1, const LAS char* Kn, const LAS char* Kr, const bf16x8 (&qr)[4], const LAS char* Qr, int r32, int hi) {
  p0 = f32x16{}; p1 = f32x16{};
#pragma unroll
  for (int d0 = 0; d0 < 8; ++d0) { const int cb = (d0 * 16 + hi * 8) * 2;
    const bf16x8 b0 = *(const LAS bf16x8*)(Kn + KNSWZ(r32, cb));
    const bf16x8 b1 = *(const LAS bf16x8*)(Kn + KNSWZ(32 + r32, cb));
    bf16x8 qq; if (d0 < 4) qq = qr[d0]; else qq = *(const LAS bf16x8*)(Qr + KNSWZ(r32, ((d0 - 4) * 16 + hi * 8) * 2));
    p0 = __builtin_amdgcn_mfma_f32_32x32x16_bf16(b0, qq, p0, 0, 0, 0);
    p1 = __builtin_amdgcn_mfma_f32_32x32x16_bf16(b1, qq, p1, 0, 0, 0); }
#pragma unroll
  for (int d0 = 0; d0 < 4; ++d0) { const int cb = (d0 * 16 + hi * 8) * 2;
    const bf16x8 b0 = *(const LAS bf16x8*)(Kr + KRSWZ(r32, cb));
    const bf16x8 b1 = *(const LAS bf16x8*)(Kr + KRSWZ(32 + r32, cb));
    const bf16x8 qq = *(const LAS bf16x8*)(Qr + KNSWZ(r32, ((4 + d0) * 16 + hi * 8) * 2));
    p0 = __builtin_amdgcn_mfma_f32_32x32x16_bf16(b0, qq, p0, 0, 0, 0);
    p1 = __builtin_amdgcn_mfma_f32_32x32x16_bf16(b1, qq, p1, 0, 0, 0); }
}
__device__ __forceinline__ int v_st(int k, int c) { const int kk = (k & ~0xC) | ((k & 4) << 1) | ((k & 8) >> 1); return ((kk >> 3) * 4 + (c >> 5)) * 512 + ((kk & 7) * 32 + (c & 31)) * 2; }
__device__ __forceinline__ int v_rd_base(int lane) { return ((lane & 3) << 3) | (((lane >> 2) & 3) << 6) | (((lane >> 4) & 1) << 5) | (((lane >> 5) & 1) << 8); }
constexpr int v_rd_off(int d0, int ks, int half) { return d0 * 512 + ks * 4096 + half * 2048; }
template <int OFF> __device__ __forceinline__ s16x4 tr_read(int vb) {
  s16x4 r; asm volatile("ds_read_b64_tr_b16 %0, %1 offset:%2" : "=&v"(r) : "v"(vb), "i"(OFF) : "memory"); return r;
}
template <int D0> __device__ __forceinline__ void pv_one(f32x16& od, int vb, bf16x8 pa0, bf16x8 pa1, bf16x8 pa2, bf16x8 pa3) {
  const s16x4 l0 = tr_read<v_rd_off(D0, 0, 0)>(vb), h0 = tr_read<v_rd_off(D0, 0, 1)>(vb), l1 = tr_read<v_rd_off(D0, 1, 0)>(vb), h1 = tr_read<v_rd_off(D0, 1, 1)>(vb);
  const s16x4 l2 = tr_read<v_rd_off(D0, 2, 0)>(vb), h2 = tr_read<v_rd_off(D0, 2, 1)>(vb), l3 = tr_read<v_rd_off(D0, 3, 0)>(vb), h3 = tr_read<v_rd_off(D0, 3, 1)>(vb);
  asm volatile("s_waitcnt lgkmcnt(0)" ::: "memory"); SBAR();
#define PK(L, H) (bf16x8){L[0], L[1], L[2], L[3], H[0], H[1], H[2], H[3]}
  od = __builtin_amdgcn_mfma_f32_32x32x16_bf16(pa0, PK(l0, h0), od, 0, 0, 0);
  od = __builtin_amdgcn_mfma_f32_32x32x16_bf16(pa1, PK(l1, h1), od, 0, 0, 0);
  od = __builtin_amdgcn_mfma_f32_32x32x16_bf16(pa2, PK(l2, h2), od, 0, 0, 0);
  od = __builtin_amdgcn_mfma_f32_32x32x16_bf16(pa3, PK(l3, h3), od, 0, 0, 0);
#undef PK
}
__device__ __forceinline__ void pv_d0(f32x16 (&o)[4], int vb, bf16x8 pa0, bf16x8 pa1, bf16x8 pa2, bf16x8 pa3) {
  pv_one<0>(o[0], vb, pa0, pa1, pa2, pa3); pv_one<1>(o[1], vb, pa0, pa1, pa2, pa3); pv_one<2>(o[2], vb, pa0, pa1, pa2, pa3); pv_one<3>(o[3], vb, pa0, pa1, pa2, pa3);
}
__device__ __forceinline__ void attn_unit(const bf16_t* __restrict__ Q, const bf16_t* __restrict__ KV, const bf16_t* __restrict__ KR, bf16_t* __restrict__ MIX,
                                          const float* __restrict__ ropec, const float* __restrict__ ropes, int h, int qrow0, bool lat, int crow0, int lrow0, int NT, LAS char* lds) {
  int tid = threadIdx.x; asm volatile("" : "+v"(tid));
  const int wid = __builtin_amdgcn_readfirstlane(tid >> 6), lane = tid & 63, r32 = lane & 31, hi = lane >> 5;
  LAS char* V_lds = lds + OFF_V; LAS char* KN_lds = lds + OFF_KN; LAS char* KR_lds = lds + OFF_KR;
  LAS float* ws = (LAS float*)(lds + OFF_WS) + wid * 64; LAS float* li_l = ws; LAS float* al_l = ws + 32;
  float m_reg = -1e30f, l_reg = 0; f32x16 o[4] = {}; bf16x8 qr[4];
  LAS char* Qr = lds + OFF_QR + wid * SHM_QW;
  { const int qrow = qrow0 + wid * 32 + r32; const bf16_t* Qw = Q + (size_t)qrow * QW + h * QKD + hi * 8;
#pragma unroll
    for (int d0 = 0; d0 < 4; ++d0) qr[d0] = *(const bf16x8*)(Qw + d0 * 16);
#pragma unroll
    for (int d0 = 4; d0 < 8; ++d0) *(LAS bf16x8*)(Qr + KNSWZ(r32, ((d0 - 4) * 16 + hi * 8) * 2)) = *(const bf16x8*)(Qw + d0 * 16);
    const int n = (qrow - TC) & 4095;
#pragma unroll
    for (int ax = 0; ax < 2; ++ax) {
      const bf16x8 q1 = *(const bf16x8*)(Qw + (8 + 2 * ax) * 16), q2 = *(const bf16x8*)(Qw + (9 + 2 * ax) * 16);
      u32x4 w1 = *reinterpret_cast<const u32x4*>(&q1), w2 = *reinterpret_cast<const u32x4*>(&q2);
      if (lat) { const int pos = ax ? (n & 63) : (n >> 6); const float* cp = ropec + pos * 16 + hi * 8; const float* sp = ropes + pos * 16 + hi * 8;
#pragma unroll
        for (int j = 0; j < 4; ++j) { const float c0 = cp[2 * j], s0 = sp[2 * j], c1 = cp[2 * j + 1], s1 = sp[2 * j + 1];
          const float a0 = bf2f((bf16_t)q1[2 * j]), a1 = bf2f((bf16_t)q1[2 * j + 1]), b0 = bf2f((bf16_t)q2[2 * j]), b1 = bf2f((bf16_t)q2[2 * j + 1]);
          w1[j] = cvt_pk_bf16(a0 * c0 - b0 * s0, a1 * c1 - b1 * s1);
          w2[j] = cvt_pk_bf16(b0 * c0 + a0 * s0, b1 * c1 + a1 * s1); } }
      *(LAS u32x4*)(Qr + KNSWZ(r32, ((4 + 2 * ax) * 16 + hi * 8) * 2)) = w1; *(LAS u32x4*)(Qr + KNSWZ(r32, ((5 + 2 * ax) * 16 + hi * 8) * 2)) = w2; }
  }
  const int sr = tid >> 4, sc = (tid & 15) * 8, vst0 = v_st(sr, sc), vst1 = v_st(32 + sr, sc);
  const int rr = tid >> 3, rc = (tid & 7) * 8;
  const int vb0 = (int)(uintptr_t)V_lds + v_rd_base(lane);
  const bf16_t* KVh = KV + h * 256;
  const int nctx_t = lat ? 4 : NT;
  bf16x8 vs0, vs1, ks0, ks1, krs;
#define TROW(kt) ((kt) < nctx_t ? crow0 + (kt) * 64 : lrow0 + ((kt) - nctx_t) * 64)
#define SLOAD(kt) do { const int _r0 = TROW(kt); const bf16_t* _p0 = KVh + (size_t)(_r0 + sr) * KVW + sc; const bf16_t* _p1 = KVh + (size_t)(_r0 + 32 + sr) * KVW + sc; \
    vs0 = *(const bf16x8*)(_p0 + 128); vs1 = *(const bf16x8*)(_p1 + 128); ks0 = *(const bf16x8*)_p0; ks1 = *(const bf16x8*)_p1; krs = *(const bf16x8*)(KR + (size_t)(_r0 + rr) * ROPE + rc); } while (0)
#define SWRITE(b) do { *(LAS bf16x8*)(V_lds + (b) * SHM_V + vst0) = vs0; *(LAS bf16x8*)(V_lds + (b) * SHM_V + vst1) = vs1; \
    *(LAS bf16x8*)(KN_lds + (b) * SHM_KN + KNSWZ(sr, sc * 2)) = ks0; *(LAS bf16x8*)(KN_lds + (b) * SHM_KN + KNSWZ(32 + sr, sc * 2)) = ks1; \
    *(LAS bf16x8*)(KR_lds + (b) * SHM_KR + KRSWZ(rr, rc * 2)) = krs; } while (0)
#define SWAIT() asm volatile("s_waitcnt vmcnt(0)" ::: "memory")
#define RESC(a) do { if (__any((a) < 1.f)) { if (hi == 0) al_l[r32] = (a); asm volatile("s_waitcnt lgkmcnt(0)" ::: "memory"); \
    _Pragma("unroll") for (int d = 0; d < 4; ++d) _Pragma("unroll") for (int r = 0; r < 16; ++r) o[d][r] *= al_l[crow(r, hi)]; } } while (0)
  f32x16 pA0, pA1, pB0, pB1; float mnA, mnB, alA, alB; bf16x8 pa0, pa1, pa2, pa3;
  SLOAD(0); SWAIT(); SWRITE(0); __syncthreads();
  qkt(pA0, pA1, KN_lds, KR_lds, qr, Qr, r32, hi); partialSM(pA0, pA1, m_reg, mnA, alA);
  SLOAD(1); SWAIT(); SWRITE(1); __syncthreads();
  for (int j = 1; j + 1 < NT; j += 2) {
    SBAR(); qkt(pB0, pB1, KN_lds + SHM_KN, KR_lds + SHM_KR, qr, Qr, r32, hi);
    finishSM(pA0, pA1, alA, l_reg, pa0, pa1, pa2, pa3); SBAR();
    SLOAD(j + 1); SBAR();
    pv_d0(o, vb0, pa0, pa1, pa2, pa3); partialSM(pB0, pB1, m_reg, mnB, alB);
    __syncthreads(); SWAIT(); SWRITE(0);
    RESC(alB); __syncthreads();
    SBAR(); qkt(pA0, pA1, KN_lds, KR_lds, qr, Qr, r32, hi);
    finishSM(pB0, pB1, alB, l_reg, pa0, pa1, pa2, pa3); SBAR();
    SLOAD(j + 2); SBAR();
    pv_d0(o, vb0 + SHM_V, pa0, pa1, pa2, pa3); partialSM(pA0, pA1, m_reg, mnA, alA);
    __syncthreads(); SWAIT(); SWRITE(1);
    RESC(alA); __syncthreads();
  }
  SBAR(); qkt(pB0, pB1, KN_lds + SHM_KN, KR_lds + SHM_KR, qr, Qr, r32, hi);
  finishSM(pA0, pA1, alA, l_reg, pa0, pa1, pa2, pa3); SBAR();
  pv_d0(o, vb0, pa0, pa1, pa2, pa3); partialSM(pB0, pB1, m_reg, mnB, alB);
  __syncthreads(); RESC(alB);
  finishSM(pB0, pB1, alB, l_reg, pa0, pa1, pa2, pa3); SBAR();
  pv_d0(o, vb0 + SHM_V, pa0, pa1, pa2, pa3);
  if (hi == 0) li_l[r32] = l_reg; asm volatile("s_waitcnt lgkmcnt(0)" ::: "memory");
  float rli[16];
#pragma unroll
  for (int r = 0; r < 16; ++r) rli[r] = __builtin_amdgcn_rcpf(li_l[crow(r, hi)]);
  int tid2 = threadIdx.x; asm volatile("" : "+v"(tid2));
  const int r32e = tid2 & 31, hie = (tid2 >> 5) & 1;
  bf16_t* Ow = MIX + (size_t)(qrow0 + wid * 32) * D + h * VD + r32e;
#pragma unroll
  for (int r = 0; r < 16; ++r) { const int orow = crow(r, hie);
#pragma unroll
    for (int d0 = 0; d0 < 4; ++d0) Ow[(size_t)orow * D + d0 * 32] = f2bf(o[d0][r] * rli[r]); }
  __syncthreads();
#undef TROW
#undef SLOAD
#undef SWRITE
#undef SWAIT
#undef RESC
}
}
constexpr int Q5_ATT = 768, Q5_DFT = Q5_ATT + 128, Q5_ATTC = Q5_DFT + 48, Q5_DFTC = Q5_ATTC + 8, Q5_END = Q5_DFTC + CVT_JOBS;
__device__ __forceinline__ void ph_queue5(const Frame& F) {
    unsigned* qhead = (unsigned*)(F.ws + WS_CTL + CW_Q5);
    LAS int* qslot = (LAS int*)(F.lds + 640);
    const bf16_t* Q = WSP(bf16_t, R0_Q); const bf16_t* KV = WSP(bf16_t, R0_KV); const bf16_t* KR = WSP(bf16_t, R0_KR); bf16_t* MIX = WSP(bf16_t, R0_MIX);
    const float* rc = WSP(float, WS_ROPE); const float* rs = rc + 1024;
    for (;;) {
        __syncthreads();
        if (F.tid == 0) qslot[0] = (int)__hip_atomic_fetch_add(qhead, 1u, __ATOMIC_RELAXED, __HIP_MEMORY_SCOPE_AGENT);
        __syncthreads();
        const int it = __builtin_amdgcn_readfirstlane(qslot[0]);
        if (it >= Q5_END) break;
        if (it < Q5_ATT) { const int b = it / 96, rem = it % 96, h = rem / 16, qb = rem % 16;
            att::attn_unit(Q, KV, KR, MIX, rc, rs, h, TC + b * 4096 + qb * 256, true, b * 256, TC + b * 4096, 68, (LAS char*)F.ring); }
        else if (it < Q5_DFT || (it >= Q5_ATTC && it < Q5_DFTC)) {
            const bool lat = it < Q5_DFT; const int i = lat ? it - Q5_ATT : it - Q5_ATTC; const int b = lat ? i >> 4 : i, pm = lat ? i & 15 : 0; const int K = lat ? 4096 : 256;
            pg8::OneUnit S; S.lda = K; S.u0.pm = pm; S.u0.pn = 0; S.u0.e = b; S.u0.cnt = 0;
            S.u0.A = (const char*)(lat ? WSP(bf16_t, R0_DFT) : WSP(bf16_t, R0_DFTC)) + (size_t)pm * 256 * K * 2;
            S.u0.B = (const char*)(lat ? WSP(bf16_t, R0_TT2) : WSP(bf16_t, R0_TTC2)) + (size_t)b * 256 * K * 2;
            pg8::EpiFourOut E{MIX, lat ? TC : 0, lat ? 4096 : 256};
            pg8::gemm_phase<pg8::EpiFourOut, pg8::OneUnit>(F.ring, pg8::Gemm{K, K, K}, S, E); }
        else if (it < Q5_ATTC) { const int uu = it - Q5_DFT, b = uu / 6, h = uu % 6;
            att::attn_unit(Q, KV, KR, MIX, rc, rs, h, b * 256, false, b * 256, 0, 4, (LAS char*)F.ring); }
        else cvt_moe_job(F, (LAS float*)F.ring, F.in[I0_WGU], F.in[I0_WDN], it - Q5_DFTC);
    }
}

__device__ __forceinline__ void load_w32(const Frame& F, LAS float* wl, const float* W, int ldw) {
    for (int i = F.tid; i < 1024 * 8; i += NTHR) { const int r = i >> 3, q = i & 7; const int c = 8 * (r & 63) + 512 * (r >> 9) + ((r >> 6) & 7); const f32x4 v = *(const f32x4*)(W + (size_t)c * ldw + q * 4); *(LAS f32x4*)(wl + r * 36 + q * 4) = v; }
}
__device__ __forceinline__ float row_gemv32(const float (&v)[16], const LAS float* wl, int lane) {
    float p[32];
#pragma unroll
    for (int e = 0; e < 32; ++e) p[e] = 0.f;
#pragma unroll
    for (int i = 0; i < 16; ++i) { const LAS float* wr_ = wl + (lane + 64 * i) * 36;
#pragma unroll
        for (int q = 0; q < 8; ++q) { const f32x4 w = *(const LAS f32x4*)(wr_ + q * 4); p[4 * q] = fmaf(v[i], w[0], p[4 * q]); p[4 * q + 1] = fmaf(v[i], w[1], p[4 * q + 1]); p[4 * q + 2] = fmaf(v[i], w[2], p[4 * q + 2]); p[4 * q + 3] = fmaf(v[i], w[3], p[4 * q + 3]); }
        asm volatile("" ::: "memory"); }
    float a16[16], a8[8], a4[4], a2[2];
    { const bool up = (lane & 32) != 0;
#pragma unroll
      for (int i = 0; i < 16; ++i) { const float send = up ? p[i] : p[i + 16], keep = up ? p[i + 16] : p[i]; a16[i] = keep + __shfl_xor(send, 32); } }
    { const bool up = (lane & 16) != 0;
#pragma unroll
      for (int i = 0; i < 8; ++i) { const float send = up ? a16[i] : a16[i + 8], keep = up ? a16[i + 8] : a16[i]; a8[i] = keep + __shfl_xor(send, 16); } }
    { const bool up = (lane & 8) != 0;
#pragma unroll
      for (int i = 0; i < 4; ++i) { const float send = up ? a8[i] : a8[i + 4], keep = up ? a8[i + 4] : a8[i]; a4[i] = keep + __shfl_xor(send, 8); } }
    { const bool up = (lane & 4) != 0;
#pragma unroll
      for (int i = 0; i < 2; ++i) { const float send = up ? a4[i] : a4[i + 2], keep = up ? a4[i + 2] : a4[i]; a2[i] = keep + __shfl_xor(send, 4); } }
    float a1; { const bool up = (lane & 2) != 0; const float send = up ? a2[0] : a2[1], keep = up ? a2[1] : a2[0]; a1 = keep + __shfl_xor(send, 2); }
    a1 += __shfl_xor(a1, 1);
    return a1;
}
__device__ __forceinline__ void row_gemv32x2(const float (&va)[16], const float (&vb)[16], const LAS float* wl, int lane, float& ya, float& yb) {
    float p[32], q[32];
#pragma unroll
    for (int e = 0; e < 32; ++e) { p[e] = 0.f; q[e] = 0.f; }
#pragma unroll
    for (int i = 0; i < 16; ++i) { const LAS float* wr_ = wl + (lane + 64 * i) * 36;
#pragma unroll
        for (int k = 0; k < 8; ++k) { const f32x4 w = *(const LAS f32x4*)(wr_ + k * 4);
            p[4 * k] = fmaf(va[i], w[0], p[4 * k]); p[4 * k + 1] = fmaf(va[i], w[1], p[4 * k + 1]); p[4 * k + 2] = fmaf(va[i], w[2], p[4 * k + 2]); p[4 * k + 3] = fmaf(va[i], w[3], p[4 * k + 3]);
            q[4 * k] = fmaf(vb[i], w[0], q[4 * k]); q[4 * k + 1] = fmaf(vb[i], w[1], q[4 * k + 1]); q[4 * k + 2] = fmaf(vb[i], w[2], q[4 * k + 2]); q[4 * k + 3] = fmaf(vb[i], w[3], q[4 * k + 3]); }
        asm volatile("" ::: "memory"); }
    float a16[16], b16[16], a8[8], b8[8], a4[4], b4[4], a2[2], b2[2];
    { const bool up = (lane & 32) != 0;
#pragma unroll
      for (int i = 0; i < 16; ++i) { a16[i] = (up ? p[i + 16] : p[i]) + __shfl_xor(up ? p[i] : p[i + 16], 32); b16[i] = (up ? q[i + 16] : q[i]) + __shfl_xor(up ? q[i] : q[i + 16], 32); } }
    { const bool up = (lane & 16) != 0;
#pragma unroll
      for (int i = 0; i < 8; ++i) { a8[i] = (up ? a16[i + 8] : a16[i]) + __shfl_xor(up ? a16[i] : a16[i + 8], 16); b8[i] = (up ? b16[i + 8] : b16[i]) + __shfl_xor(up ? b16[i] : b16[i + 8], 16); } }
    { const bool up = (lane & 8) != 0;
#pragma unroll
      for (int i = 0; i < 4; ++i) { a4[i] = (up ? a8[i + 4] : a8[i]) + __shfl_xor(up ? a8[i] : a8[i + 4], 8); b4[i] = (up ? b8[i + 4] : b8[i]) + __shfl_xor(up ? b8[i] : b8[i + 4], 8); } }
    { const bool up = (lane & 4) != 0;
#pragma unroll
      for (int i = 0; i < 2; ++i) { a2[i] = (up ? a4[i + 2] : a4[i]) + __shfl_xor(up ? a4[i] : a4[i + 2], 4); b2[i] = (up ? b4[i + 2] : b4[i]) + __shfl_xor(up ? b4[i] : b4[i + 2], 4); } }
    { const bool up = (lane & 2) != 0; ya = (up ? a2[1] : a2[0]) + __shfl_xor(up ? a2[0] : a2[1], 2); yb = (up ? b2[1] : b2[0]) + __shfl_xor(up ? b2[0] : b2[1], 2); }
    ya += __shfl_xor(ya, 1); yb += __shfl_xor(yb, 1);
}
__device__ __forceinline__ void ph_router(const Frame& F, int layer, int r0) {
    typedef float f32x16 __attribute__((ext_vector_type(16)));
    constexpr int HROW = 2064;
    LAS char* HHI = (LAS char*)F.ring; LAS char* HLO = HHI + 32 * HROW; LAS float* RED = (LAS float*)F.ring;
    LAS float* SCR = (LAS float*)(F.ring + 2 * 32 * HROW);
    LAS unsigned* lcnt = (LAS unsigned*)(F.lds + 512);
    const float* g = F.in[layer ? I1_N2G : I0_N2G]; const float* rb_ = F.in[layer ? I1_RB : I0_RB];
    if (F.tid < 64) lcnt[F.tid] = 0u;
    __syncthreads();
    bf16_t* H = WSP(bf16_t, WS_H); unsigned* cnt = (unsigned*)(F.ws + WS_CTL + CW_CNT) + layer * 64;
    int* list = WSP(int, WS_LIST); int* toke = WSP(int, WS_TOKE); int* tokp = WSP(int, WS_TOKP); float* tokg = WSP(float, WS_TOKG);
    const float* modv = WSP(float, WS_MODV) + (size_t)layer * 9 * 6144;
    const bf16_t* WT = WSP(bf16_t, WS_RWT) + (size_t)layer * 2 * 32 * 1024;
    const bf16_t* Yb = layer == 0 ? WSP(bf16_t, R0_U0) : WSP(bf16_t, R1_OB) - (size_t)TC * D;
    const int per = (T - r0 + F.G - 1) / F.G; const int rbeg = r0 + F.bid * per; const int rend = (rbeg + per < T) ? rbeg + per : T;
    const int lane = F.lane, wave = F.wave, r32 = lane & 31, hi2 = lane >> 5;
    float gg[16]; ld16f(g, lane, gg);
    float scv[16], shv[16]; int curm = -1;
    for (int tb = rbeg; tb < rend; tb += 32) {
        f32x4 xr[4][4]; u32x4 xq[4][2]; u32x4 yr[4][2];
#pragma unroll
        for (int q = 0; q < 4; ++q) { int r = tb + 4 * wave + q; r = r < rend ? r : rend - 1; const bf16_t* yp = Yb + (size_t)r * D;
            if (layer == 0) { const float* xp = xrow_in(F, r);
#pragma unroll
                for (int h = 0; h < 2; ++h) { xr[q][2 * h] = *(const f32x4*)(xp + 8 * lane + 512 * h); xr[q][2 * h + 1] = *(const f32x4*)(xp + 8 * lane + 512 * h + 4); } }
            else { const bf16_t* xp = xrow_b(F, r);
#pragma unroll
                for (int h = 0; h < 2; ++h) xq[q][h] = *(const u32x4*)(xp + 8 * lane + 512 * h); }
#pragma unroll
            for (int h = 0; h < 2; ++h) yr[q][h] = *(const u32x4*)(yp + 8 * lane + 512 * h); }
#pragma unroll
        for (int q = 0; q < 4; ++q) { const int tr = 4 * wave + q, r = tb + tr;
            if (r < rend) {
            float v[16];
#pragma unroll
            for (int h = 0; h < 2; ++h) {
#pragma unroll
                for (int k = 0; k < 4; ++k) { const float xa = layer == 0 ? xr[q][2 * h + (k >> 1)][2 * (k & 1)] : __uint_as_float(xq[q][h][k] << 16), xb = layer == 0 ? xr[q][2 * h + (k >> 1)][2 * (k & 1) + 1] : __uint_as_float(xq[q][h][k] & 0xffff0000u);
                    v[8 * h + 2 * k] = xa + __uint_as_float(yr[q][h][k] << 16); v[8 * h + 2 * k + 1] = xb + __uint_as_float(yr[q][h][k] & 0xffff0000u); } }
            if (layer == 0) { if (r < TC) st16f(xrow_res(F, r), lane, v); else st16b(xrow_b(F, r), lane, v); }
            else st16b(xrow_b(F, r), lane, v);
            float ss = 0.f;
#pragma unroll
            for (int i = 0; i < 16; ++i) ss = fmaf(v[i], v[i], ss);
            const float rs = rsqrtf(wsum(ss) * (1.0f / D) + EPS);
            const int m = modrow(r);
            if (m != curm) { const float* mv = modv + (size_t)m * 6144; ld16f(mv + 4096, lane, scv); ld16f(mv + 3072, lane, shv); curm = m; }
#pragma unroll
            for (int i = 0; i < 16; ++i) v[i] = v[i] * rs * gg[i] * (1.0f + scv[i]) + shv[i];
#pragma unroll
            for (int h = 0; h < 2; ++h) { u32x4 whi, wlo;
#pragma unroll
                for (int k = 0; k < 4; ++k) { const unsigned ph = cvt_pk_bf16(v[8 * h + 2 * k], v[8 * h + 2 * k + 1]); whi[k] = ph;
                    wlo[k] = cvt_pk_bf16(v[8 * h + 2 * k] - __uint_as_float(ph << 16), v[8 * h + 2 * k + 1] - __uint_as_float(ph & 0xffff0000u)); }
                *(u32x4*)(H + (size_t)r * D + 8 * lane + 512 * h) = whi;
                *(LAS u32x4*)(HHI + tr * HROW + (8 * lane + 512 * h) * 2) = whi; *(LAS u32x4*)(HLO + tr * HROW + (8 * lane + 512 * h) * 2) = wlo; } } }
        __syncthreads();
        f32x16 acc = {};
        { const LAS char* ah = HHI + r32 * HROW + (wave * 128 + hi2 * 8) * 2; const LAS char* al = HLO + r32 * HROW + (wave * 128 + hi2 * 8) * 2;
          const bf16_t* wh = WT + (size_t)r32 * 1024 + wave * 128 + hi2 * 8; const bf16_t* wlp = wh + 32 * 1024;
#pragma unroll
          for (int sst = 0; sst < 8; ++sst) { const bf16x8 a_h = *(const LAS bf16x8*)(ah + sst * 32), a_l = *(const LAS bf16x8*)(al + sst * 32);
              const bf16x8 b_h = *(const bf16x8*)(wh + sst * 16), b_l = *(const bf16x8*)(wlp + sst * 16);
              acc = __builtin_amdgcn_mfma_f32_32x32x16_bf16(a_h, b_h, acc, 0, 0, 0);
              acc = __builtin_amdgcn_mfma_f32_32x32x16_bf16(a_h, b_l, acc, 0, 0, 0);
              acc = __builtin_amdgcn_mfma_f32_32x32x16_bf16(a_l, b_h, acc, 0, 0, 0); } }
        __syncthreads();
#pragma unroll
        for (int r = 0; r < 16; ++r) { const int row = (r & 3) + 8 * (r >> 2) + 4 * hi2; RED[(wave * 32 + row) * 32 + r32] = acc[r]; }
        __syncthreads();
#pragma unroll 1
        for (int pq = 0; pq < 2; ++pq) { const int tr = 4 * wave + 2 * pq + hi2, r = tb + tr; const int e = r32;
            float lg = rb_[e];
#pragma unroll
            for (int w8 = 0; w8 < 8; ++w8) lg += RED[(w8 * 32 + tr) * 32 + e];
            LAS float* sc_ = SCR + tr * 40;
            sc_[e] = lg;
            asm volatile("s_waitcnt lgkmcnt(0)" ::: "memory");
            int rank = 0;
#pragma unroll
            for (int q8 = 0; q8 < 8; ++q8) { const f32x4 v4 = *(const LAS f32x4*)(sc_ + 4 * q8);
#pragma unroll
                for (int j = 0; j < 4; ++j) rank += (int)((v4[j] > lg) | ((v4[j] == lg) & ((4 * q8 + j) < e))); }
            if (rank < 4) { sc_[32 + rank] = lg; ((LAS int*)sc_)[36 + rank] = e; }
            asm volatile("s_waitcnt lgkmcnt(0)" ::: "memory");
            const f32x4 tvv = *(const LAS f32x4*)(sc_ + 32); const u32x4 tev = *(const LAS u32x4*)(sc_ + 36);
            asm volatile("s_waitcnt lgkmcnt(0)" ::: "memory");
            const float e1 = __expf(tvv[1] - tvv[0]), e2 = __expf(tvv[2] - tvv[0]), e3 = __expf(tvv[3] - tvv[0]); const float inv = 1.0f / (1.0f + e1 + e2 + e3);
            if (r32 < 4 && r < rend) { const int k = r32; const int ek = (int)(k == 0 ? tev[0] : k == 1 ? tev[1] : k == 2 ? tev[2] : tev[3]); const float gk = (k == 0 ? 1.0f : k == 1 ? e1 : k == 2 ? e2 : e3) * inv;
                const unsigned lp = __hip_atomic_fetch_add(lcnt + ek, 1u, __ATOMIC_RELAXED, __HIP_MEMORY_SCOPE_WORKGROUP);
                toke[r * 4 + k] = ek; tokp[r * 4 + k] = (int)lp; tokg[r * 4 + k] = gk; } }
        __syncthreads();
    }
    __syncthreads();
    if (F.tid < 32) { const unsigned c = lcnt[F.tid]; lcnt[32 + F.tid] = c ? __hip_atomic_fetch_add(cnt + F.tid, c, __ATOMIC_RELAXED, __HIP_MEMORY_SCOPE_AGENT) : 0u; }
    __syncthreads();
    for (int i = rbeg * 4 + F.tid; i < rend * 4; i += NTHR) {
        const int ek = __hip_atomic_load(toke + i, __ATOMIC_RELAXED, __HIP_MEMORY_SCOPE_AGENT); const int pos = __hip_atomic_load(tokp + i, __ATOMIC_RELAXED, __HIP_MEMORY_SCOPE_AGENT) + (int)lcnt[32 + ek]; tokp[i] = pos; list[(size_t)ek * T + pos] = i >> 2; }
}
__device__ __forceinline__ int moe_tstart(const Frame& F, int layer, LAS int* tstart) {
    unsigned* cnt = (unsigned*)(F.ws + WS_CTL + CW_CNT) + layer * 64;
    __syncthreads();
    if (F.tid == 0) { int s = 0; for (int e = 0; e < NE; ++e) { const int c = (int)__hip_atomic_load(cnt + e, __ATOMIC_RELAXED, __HIP_MEMORY_SCOPE_AGENT); tstart[e] = s; tstart[40 + e] = c; s += (c + 255) >> 8; } tstart[NE] = s; }
    __syncthreads();
    { LAS int* t2e = (LAS int*)(F.ring + 140000); const int nt = tstart[NE];
      for (int t = F.tid; t < nt; t += NTHR) { int e = 0; for (int j = 1; j < NE; ++j) e += (t >= tstart[j]) ? 1 : 0; t2e[t] = e; } }
    __syncthreads();
    return __builtin_amdgcn_readfirstlane(tstart[NE]);
}
__device__ __forceinline__ void ph_moe1(const Frame& F, int layer) {
    LAS int* tstart = (LAS int*)(F.lds + 64); const int ntile = moe_tstart(F, layer, tstart);
    pg8::MoeOrder<true> S; S.A = (const char*)WSP(bf16_t, WS_H); S.B = (const char*)WSP(bf16_t, WS_WGU); S.sB = (size_t)2048 * 1024 * 2; S.lda = D; S.ldb = D; S.npn = 8; S.nwg = ntile * 8; S.G = F.G; S.c = F.bid;
    S.tstart = tstart; S.cnt = tstart + 40; S.list = WSP(int, WS_LIST); S.t2e = (const LAS int*)(F.ring + 140000);
    pg8::EpiSwiglu E{WSP(bf16_t, WS_ACT), F.in[layer ? I1_BGU : I0_BGU]};
    pg8::gemm_phase<pg8::EpiSwiglu, pg8::MoeOrder<true>>(F.ring, pg8::Gemm{D, D, D}, S, E);
}
__device__ __forceinline__ void ph_moe2(const Frame& F, int layer) {
    LAS int* tstart = (LAS int*)(F.lds + 64); const int ntile = moe_tstart(F, layer, tstart);
    pg8::MoeOrder<false> S; S.A = (const char*)WSP(bf16_t, WS_ACT); S.B = (const char*)WSP(bf16_t, WS_WDN); S.sB = (size_t)1024 * 1024 * 2; S.lda = FF; S.ldb = FF; S.npn = 4; S.nwg = ntile * 4; S.G = F.G; S.c = F.bid;
    S.tstart = tstart; S.cnt = tstart + 40; S.list = nullptr; S.t2e = (const LAS int*)(F.ring + 140000);
    pg8::EpiDown E{WSP(bf16_t, RM_YB), F.in[layer ? I1_BDN : I0_BDN]};
    pg8::gemm_phase<pg8::EpiDown, pg8::MoeOrder<false>>(F.ring, pg8::Gemm{FF, FF, FF}, S, E);
}
__device__ __forceinline__ void moe_combine_row(const Frame& F, int layer, int r, const LAS int* tstart, float (&v)[16]) {
    const int* toke = WSP(int, WS_TOKE); const int* tokp = WSP(int, WS_TOKP); const float* tokg = WSP(float, WS_TOKG); const bf16_t* YB = WSP(bf16_t, RM_YB);
    const float* g2 = WSP(float, WS_MODV) + (size_t)(layer * 9 + modrow(r)) * 6144 + 5120;
    float y[16];
#pragma unroll
    for (int i = 0; i < 16; ++i) y[i] = 0.f;
#pragma unroll
    for (int k = 0; k < 4; ++k) { const int e = toke[r * 4 + k]; const size_t prow = (size_t)tstart[e] * 256 + tokp[r * 4 + k]; const float gk = tokg[r * 4 + k]; float yy[16]; ld16b(YB + prow * D, F.lane, yy);
#pragma unroll
        for (int i = 0; i < 16; ++i) y[i] = fmaf(gk, yy[i], y[i]); }
    float gg[16]; ld16f(g2, F.lane, gg); if (r >= TC) ld16b(xrow_b(F, r), F.lane, v); else ld16f(xrow_res(F, r), F.lane, v);
#pragma unroll
    for (int i = 0; i < 16; ++i) v[i] = fmaf(gg[i], y[i], v[i]);
}
__device__ __forceinline__ void ph_combine_mod1(const Frame& F) {
    LAS int* tstart = (LAS int*)(F.lds + 64); moe_tstart(F, 0, tstart);
    LAS float* wl = (LAS float*)F.ring;
    load_w32(F, wl, F.in[I1_WIN] + 3072, 3104);
    __syncthreads();
    const float* g = F.in[I1_N1G]; bf16_t* H = WSP(bf16_t, WS_H); float* GD = WSP(float, WS_GD);
    const float* modv = WSP(float, WS_MODV) + (size_t)9 * 6144;
    for (int r = F.bid * NWAVE + F.wave; r < T; r += F.G * NWAVE) {
        float v[16]; moe_combine_row(F, 0, r, tstart, v);
        const float* mv = modv + (size_t)modrow(r) * 6144;
        if (r < TC) st16f(xrow_res(F, r), F.lane, v); else st16b(xrow_b(F, r), F.lane, v);
        modulate16(v, g, mv + 1024, mv, F.lane);
        st16b(H + (size_t)r * D, F.lane, v);
        const float gd = row_gemv32(v, wl, F.lane);
        if ((F.lane & 1) == 0) GD[(size_t)r * 32 + (F.lane >> 1)] = gd;
    }
    __syncthreads();
    cvt_moe_weights(F, (LAS float*)F.ring, F.in[I1_WGU], F.in[I1_WDN]);
}
__device__ __forceinline__ void ph_final(const Frame& F) {
    LAS int* tstart = (LAS int*)(F.lds + 64); moe_tstart(F, 1, tstart);
    const float* g = F.in[I_FNG];
    for (int r = TC + F.bid * NWAVE + F.wave; r < T; r += F.G * NWAVE) {
        float v[16]; moe_combine_row(F, 1, r, tstart, v); float ss = 0.f;
#pragma unroll
        for (int i = 0; i < 16; ++i) ss = fmaf(v[i], v[i], ss);
        const float rs = rsqrtf(wsum(ss) * (1.0f / D) + EPS); float gg[16]; ld16f(g, F.lane, gg);
#pragma unroll
        for (int i = 0; i < 16; ++i) v[i] = v[i] * rs * gg[i];
        st16f(F.out + (size_t)(r - TC) * D, F.lane, v);
    }
}

namespace gla3 {
using att::f32x16; using att::s16x4; using att::crow; using att::v_st; using att::v_rd_base; using att::v_rd_off; using att::tr_read;
constexpr int ROWB = 272;
constexpr int P_GD = 0, P_TOT = 4096, P_WG = 8192;
constexpr int O_QD = 0, O_KD = 17408, O_KS = 34816, O_VV = 51200, O_ST = 67584, O_DEC = 102400;
constexpr size_t TILE_B = 64 * 128 * 2, ITEM_B = 2 * TILE_B;
#define GPK(L, H) (bf16x8){L[0], L[1], L[2], L[3], H[0], H[1], H[2], H[3]}
#define CH_ROW0(b, dir, cc) ((cc) < 4 ? ((b) * 256 + ((dir) ? 3 - (cc) : (cc)) * 64) : (TC + (b) * 4096 + ((dir) ? 67 - (cc) : (cc) - 4) * 64))
#define TOK(dir, jj) ((dir) ? 63 - (jj) : (jj))
__device__ __forceinline__ void pre_phase(const Frame& F) {
  LAS char* lds = (LAS char*)F.ring;
  int tid = threadIdx.x; asm volatile("" : "+v"(tid));
  const int wid = __builtin_amdgcn_readfirstlane(tid >> 6), lane = tid & 63;
  LAS float* gds = (LAS float*)(lds + P_GD); LAS float* tot = (LAS float*)(lds + P_TOT); LAS float* wgall = (LAS float*)(lds + P_WG);
  const bf16_t* U1 = WSP(bf16_t, R1_U1); const float* GD = WSP(float, WS_GD);
  char* tiles = (char*)(F.ws + WS_ACT); float* decbuf = (float*)(F.ws + WS_ACT + (size_t)4352 * ITEM_B);
  for (int i = tid; i < 8 * 17 * 128; i += NTHR) { const int tb = i / (17 * 128), rem = i % (17 * 128), r = rem >> 7, d = rem & 127, hd = tb >> 1, dir = tb & 1;
    const float* Wg = dir ? F.in[I1_WGKB] : F.in[I1_WGKF]; const float* Bg = dir ? F.in[I1_BGKB] : F.in[I1_BGKF]; wgall[i] = (r < 16) ? Wg[r * 512 + hd * 128 + d] : Bg[hd * 128 + d]; }
  const int d0 = 2 * lane, tg = wid, gj = tid >> 3, gr = (tid & 7) * 2;
  unsigned qreg[8], kreg[8]; f32x2 gdreg;
#define PLOAD(u) do { const int _cc = (u) % 68, _s = (u) / 68, _dir = _s & 1, _hd = (_s >> 1) & 3, _b = _s >> 3; const int _r0 = CH_ROW0(_b, _dir, _cc); \
    const bf16_t* _uq = U1 + _hd * 128 + d0; \
    _Pragma("unroll") for (int i = 0; i < 8; ++i) { const bf16_t* _p = _uq + (size_t)(_r0 + TOK(_dir, 8 * tg + i)) * U1W; qreg[i] = *(const unsigned*)_p; kreg[i] = *(const unsigned*)(_p + 512); } \
    gdreg = *(const f32x2*)(GD + (size_t)(_r0 + TOK(_dir, gj)) * 32 + _dir * 16 + gr); } while (0)
  int u = F.bid;
  if (u < 4352) PLOAD(u);
  __syncthreads();
  for (; u < 4352; u += F.G) {
    const int sc = u / 68, dir = sc & 1, hd = (sc >> 1) & 3;
    const LAS float* wg = wgall + (hd * 2 + dir) * 17 * 128;
    *(LAS f32x2*)(gds + gj * 16 + gr) = gdreg;
    __syncthreads();
    float cl0[8], cl1[8];
    { float z0[8], z1[8]; const f32x2 bb = *(const LAS f32x2*)(wg + 16 * 128 + d0);
#pragma unroll
      for (int i = 0; i < 8; ++i) { z0[i] = bb[0]; z1[i] = bb[1]; }
#pragma unroll
      for (int r4 = 0; r4 < 4; ++r4) { f32x2 w[4];
#pragma unroll
        for (int q = 0; q < 4; ++q) w[q] = *(const LAS f32x2*)(wg + (4 * r4 + q) * 128 + d0);
#pragma unroll
        for (int i = 0; i < 8; ++i) { const f32x4 g4 = *(const LAS f32x4*)(gds + (8 * tg + i) * 16 + 4 * r4);
#pragma unroll
          for (int q = 0; q < 4; ++q) { z0[i] = fmaf(g4[q], w[q][0], z0[i]); z1[i] = fmaf(g4[q], w[q][1], z1[i]); } } }
      float a0 = 0.f, a1 = 0.f;
#pragma unroll
      for (int i = 0; i < 8; ++i) { const float l0 = fminf(z0[i], 0.f) - __logf(1.0f + __expf(-fabsf(z0[i]))), l1 = fminf(z1[i], 0.f) - __logf(1.0f + __expf(-fabsf(z1[i])));
        a0 += l0 * (1.0f / 16.0f); a1 += l1 * (1.0f / 16.0f); cl0[i] = a0; cl1[i] = a1; }
      *(LAS f32x2*)(tot + tg * 128 + d0) = (f32x2){a0, a1}; }
    __syncthreads();
    { float off0 = 0.f, off1 = 0.f, last0 = 0.f, last1 = 0.f;
#pragma unroll
      for (int g = 0; g < 8; ++g) { const f32x2 tv = *(const LAS f32x2*)(tot + g * 128 + d0); if (g < tg) { off0 += tv[0]; off1 += tv[1]; } last0 += tv[0]; last1 += tv[1]; }
      const float el0 = __expf(last0), el1 = __expf(last1);
      if (tg == 0) *(f32x2*)(decbuf + (size_t)u * 128 + d0) = (f32x2){el0, el1};
      char* it = tiles + (size_t)u * ITEM_B + d0 * 2;
#pragma unroll
      for (int i = 0; i < 8; ++i) { const int jj = 8 * tg + i; const float e0 = __expf(off0 + cl0[i]), e1 = __expf(off1 + cl1[i]); const float r0 = __builtin_amdgcn_rcpf(e0), r1 = __builtin_amdgcn_rcpf(e1);
        const float q0 = __uint_as_float(qreg[i] << 16), q1 = __uint_as_float(qreg[i] & 0xffff0000u), k0 = __uint_as_float(kreg[i] << 16), k1 = __uint_as_float(kreg[i] & 0xffff0000u);
        *(unsigned*)(it + jj * 256) = cvt_pk_bf16(q0 * e0, q1 * e1);
        *(unsigned*)(it + TILE_B + jj * 256) = cvt_pk_bf16(k0 * r0, k1 * r1); } }
    if (u + F.G < 4352) PLOAD(u + F.G);
    __syncthreads();
  }
#undef PLOAD
}
constexpr int SB_QD = 0, SB_KD = 16384, SB_VV = 32768, SB_DEC = 40960, SB_BYTES = 41984, O_ST2 = 3 * SB_BYTES;
constexpr int vc_off(int d0, int ks, int half) { return d0 * 512 + ks * 2048 + half * 1024; }
struct SeqCtx { LAS char* lds; const char* tiles; const char* decb; const bf16_t* Uv; bf16_t* OUT; unsigned sQ[2], sK[2], ldsw; int vk, b, dir, hd, dvs, wid, lane, r32, hi, trb, xq, eb, db, kdo; };
#define DMA16(gptr, ldsoff) __builtin_amdgcn_global_load_lds((const unsigned*)(gptr), (LAS unsigned*)(C.lds + (ldsoff)), 16, 0, 0)
__device__ __forceinline__ void seq_issue(const SeqCtx& C, int cc) {
    const int bo = (cc % 3) * SB_BYTES; const char* t = C.tiles + (size_t)cc * ITEM_B;
    DMA16(t + C.sQ[0], bo + SB_QD + C.ldsw); DMA16(t + C.sQ[1], bo + SB_QD + 8192 + C.ldsw);
    DMA16(t + TILE_B + C.sK[0], bo + SB_KD + C.ldsw); DMA16(t + TILE_B + C.sK[1], bo + SB_KD + 8192 + C.ldsw);
    DMA16(C.Uv + (size_t)(CH_ROW0(C.b, C.dir, cc) + TOK(C.dir, C.vk)) * U1W, bo + SB_VV + C.ldsw);
    if (C.wid == 7) DMA16(C.decb + (size_t)cc * 512 + C.lane * 16, bo + SB_DEC);
}
#undef DMA16
template <int IB> __device__ __forceinline__ void seq_out_loop(const SeqCtx& C) {
  const int r32 = C.r32, hi = C.hi, xq = C.xq;
  for (int cc = 0; cc < 68; ++cc) {
    if (cc >= 6 && cc < 67) asm volatile("s_waitcnt vmcnt(37)" ::: "memory"); else if (cc >= 1 && cc < 67) asm volatile("s_waitcnt vmcnt(5)" ::: "memory"); else asm volatile("s_waitcnt vmcnt(0)" ::: "memory");
    asm volatile("s_waitcnt lgkmcnt(0)" ::: "memory");
    __builtin_amdgcn_s_barrier();
    asm volatile("" ::: "memory");
    if (cc + 2 < 68) seq_issue(C, cc + 2);
    if (cc < 4) continue;
    const LAS char* sb = C.lds + (cc % 3) * SB_BYTES;
    const LAS char* STp = C.lds + O_ST2 + ((cc + 1) & 1) * 17408;
    f32x16 p0 = {}, p1 = {}, o = {};
    const LAS char* QDr = sb + SB_QD + (32 * IB + r32) * 256; const LAS char* KDr = sb + SB_KD + C.kdo;
#pragma unroll
    for (int k = 0; k < 8; ++k) { const int po = (k << 5) ^ xq; const bf16x8 qf = *(const LAS bf16x8*)(QDr + po); const bf16x8 k0f = *(const LAS bf16x8*)(KDr + (k >> 1) * 512 + (k & 1) * 32);
      p0 = __builtin_amdgcn_mfma_f32_32x32x16_bf16(k0f, qf, p0, 0, 0, 0);
      if (IB) { const bf16x8 k1f = *(const LAS bf16x8*)(KDr + 8192 + (k >> 1) * 512 + (k & 1) * 32); p1 = __builtin_amdgcn_mfma_f32_32x32x16_bf16(k1f, qf, p1, 0, 0, 0); } }
#pragma unroll
    for (int r = 0; r < 16; ++r) { const bool kill = crow(r, hi) > r32; if (IB == 0) p0[r] = kill ? 0.f : p0[r]; else p1[r] = kill ? 0.f : p1[r]; }
    bf16x8 pa0, pa1, pa2, pa3;
#define PK4(P, BASE, OUT_) do { unsigned a0 = cvt_pk_bf16(P[BASE + 0], P[BASE + 1]), a1 = cvt_pk_bf16(P[BASE + 2], P[BASE + 3]);   \
    unsigned b0 = cvt_pk_bf16(P[BASE + 4], P[BASE + 5]), b1 = cvt_pk_bf16(P[BASE + 6], P[BASE + 7]);                              \
    auto r0 = __builtin_amdgcn_permlane32_swap(a0, b0, false, false); auto r1 = __builtin_amdgcn_permlane32_swap(a1, b1, false, false); \
    u32x4 w = {r0[0], r1[0], r0[1], r1[1]}; OUT_ = *reinterpret_cast<bf16x8*>(&w); } while (0)
    PK4(p0, 0, pa0); PK4(p0, 8, pa1); if (IB) { PK4(p1, 0, pa2); PK4(p1, 8, pa3); }
#undef PK4
    { const int vb = (int)(uintptr_t)(sb + SB_VV) + C.trb + C.eb * 512;
      const s16x4 l0 = tr_read<vc_off(0, 0, 0)>(vb), h0 = tr_read<vc_off(0, 0, 1)>(vb), l1 = tr_read<vc_off(0, 1, 0)>(vb), h1 = tr_read<vc_off(0, 1, 1)>(vb);
      s16x4 l2, h2, l3, h3;
      if (IB) { l2 = tr_read<vc_off(0, 2, 0)>(vb); h2 = tr_read<vc_off(0, 2, 1)>(vb); l3 = tr_read<vc_off(0, 3, 0)>(vb); h3 = tr_read<vc_off(0, 3, 1)>(vb); }
      asm volatile("s_waitcnt lgkmcnt(0)" ::: "memory"); __builtin_amdgcn_sched_barrier(0);
      o = __builtin_amdgcn_mfma_f32_32x32x16_bf16(pa0, GPK(l0, h0), o, 0, 0, 0);
      o = __builtin_amdgcn_mfma_f32_32x32x16_bf16(pa1, GPK(l1, h1), o, 0, 0, 0);
      if (IB) { o = __builtin_amdgcn_mfma_f32_32x32x16_bf16(pa2, GPK(l2, h2), o, 0, 0, 0);
                o = __builtin_amdgcn_mfma_f32_32x32x16_bf16(pa3, GPK(l3, h3), o, 0, 0, 0); } }
    { const LAS char* STr = STp + (32 * C.eb + r32) * ROWB + hi * 16;
#pragma unroll
      for (int k = 0; k < 8; ++k) { const bf16x8 qf = *(const LAS bf16x8*)(QDr + ((k << 5) ^ xq)); const bf16x8 sf = *(const LAS bf16x8*)(STr + k * 32);
        o = __builtin_amdgcn_mfma_f32_32x32x16_bf16(qf, sf, o, 0, 0, 0); } }
    bf16_t* op = C.OUT + (size_t)(CH_ROW0(C.b, C.dir, cc) - TC) * D + C.hd * 256 + C.dvs * 64 + 32 * C.eb + r32;
#pragma unroll
    for (int r = 0; r < 16; ++r) { const int i = 32 * IB + crow(r, hi); op[(size_t)TOK(C.dir, i) * D] = f2bf(o[r]); }
  }
}
__device__ __forceinline__ void seq_state_loop(const SeqCtx& C) {
  const int r32 = C.r32, hi = C.hi, db = C.db;
  f32x16 S0 = {}, S1 = {};
  for (int cc = 0; cc < 68; ++cc) {
    if (cc >= 1 && cc < 67) { if (C.wid == 7) asm volatile("s_waitcnt vmcnt(6)" ::: "memory"); else asm volatile("s_waitcnt vmcnt(5)" ::: "memory"); } else asm volatile("s_waitcnt vmcnt(0)" ::: "memory");
    asm volatile("s_waitcnt lgkmcnt(0)" ::: "memory");
    __builtin_amdgcn_s_barrier();
    asm volatile("" ::: "memory");
    if (cc + 2 < 68) seq_issue(C, cc + 2);
    const LAS char* sb = C.lds + (cc % 3) * SB_BYTES;
    LAS char* STn = C.lds + O_ST2 + (cc & 1) * 17408;
    const int kb = (int)(uintptr_t)(sb + SB_KD) + C.trb + db * 512, vb = (int)(uintptr_t)(sb + SB_VV) + C.trb;
    { const s16x4 al0 = tr_read<v_rd_off(0, 0, 0)>(kb), ah0 = tr_read<v_rd_off(0, 0, 1)>(kb), al1 = tr_read<v_rd_off(0, 1, 0)>(kb), ah1 = tr_read<v_rd_off(0, 1, 1)>(kb);
      const s16x4 al2 = tr_read<v_rd_off(0, 2, 0)>(kb), ah2 = tr_read<v_rd_off(0, 2, 1)>(kb), al3 = tr_read<v_rd_off(0, 3, 0)>(kb), ah3 = tr_read<v_rd_off(0, 3, 1)>(kb);
      const s16x4 bl0 = tr_read<vc_off(0, 0, 0)>(vb), bh0 = tr_read<vc_off(0, 0, 1)>(vb), bl1 = tr_read<vc_off(0, 1, 0)>(vb), bh1 = tr_read<vc_off(0, 1, 1)>(vb);
      const s16x4 bl2 = tr_read<vc_off(0, 2, 0)>(vb), bh2 = tr_read<vc_off(0, 2, 1)>(vb), bl3 = tr_read<vc_off(0, 3, 0)>(vb), bh3 = tr_read<vc_off(0, 3, 1)>(vb);
      const s16x4 cl0_ = tr_read<vc_off(1, 0, 0)>(vb), ch0 = tr_read<vc_off(1, 0, 1)>(vb), cl1_ = tr_read<vc_off(1, 1, 0)>(vb), ch1 = tr_read<vc_off(1, 1, 1)>(vb);
      const s16x4 cl2 = tr_read<vc_off(1, 2, 0)>(vb), ch2 = tr_read<vc_off(1, 2, 1)>(vb), cl3 = tr_read<vc_off(1, 3, 0)>(vb), ch3 = tr_read<vc_off(1, 3, 1)>(vb);
      asm volatile("s_waitcnt lgkmcnt(0)" ::: "memory"); __builtin_amdgcn_sched_barrier(0);
      S0 = __builtin_amdgcn_mfma_f32_32x32x16_bf16(GPK(al0, ah0), GPK(bl0, bh0), S0, 0, 0, 0); S1 = __builtin_amdgcn_mfma_f32_32x32x16_bf16(GPK(al0, ah0), GPK(cl0_, ch0), S1, 0, 0, 0);
      S0 = __builtin_amdgcn_mfma_f32_32x32x16_bf16(GPK(al1, ah1), GPK(bl1, bh1), S0, 0, 0, 0); S1 = __builtin_amdgcn_mfma_f32_32x32x16_bf16(GPK(al1, ah1), GPK(cl1_, ch1), S1, 0, 0, 0);
      S0 = __builtin_amdgcn_mfma_f32_32x32x16_bf16(GPK(al2, ah2), GPK(bl2, bh2), S0, 0, 0, 0); S1 = __builtin_amdgcn_mfma_f32_32x32x16_bf16(GPK(al2, ah2), GPK(cl2, ch2), S1, 0, 0, 0);
      S0 = __builtin_amdgcn_mfma_f32_32x32x16_bf16(GPK(al3, ah3), GPK(bl3, bh3), S0, 0, 0, 0); S1 = __builtin_amdgcn_mfma_f32_32x32x16_bf16(GPK(al3, ah3), GPK(cl3, ch3), S1, 0, 0, 0); }
#pragma unroll
    for (int g = 0; g < 4; ++g) { const f32x4 dc = *(const LAS f32x4*)(sb + SB_DEC + (32 * db + 8 * g + 4 * hi) * 4);
                                  S0[4 * g] *= dc[0]; S0[4 * g + 1] *= dc[1]; S0[4 * g + 2] *= dc[2]; S0[4 * g + 3] *= dc[3];
                                  S1[4 * g] *= dc[0]; S1[4 * g + 1] *= dc[1]; S1[4 * g + 2] *= dc[2]; S1[4 * g + 3] *= dc[3]; }
#pragma unroll
    for (int g = 0; g < 4; ++g) { u32x2 w0, w1; w0.x = cvt_pk_bf16(S0[4 * g], S0[4 * g + 1]); w0.y = cvt_pk_bf16(S0[4 * g + 2], S0[4 * g + 3]); w1.x = cvt_pk_bf16(S1[4 * g], S1[4 * g + 1]); w1.y = cvt_pk_bf16(S1[4 * g + 2], S1[4 * g + 3]);
      *(LAS u32x2*)(STn + r32 * ROWB + (32 * db + 8 * g + 4 * hi) * 2) = w0; *(LAS u32x2*)(STn + (32 + r32) * ROWB + (32 * db + 8 * g + 4 * hi) * 2) = w1; }
  }
}
__device__ __forceinline__ void seq_unit(const Frame& F, int b, int hd, int dir, int dvs, LAS char* lds) {
  int tid = threadIdx.x; asm volatile("" : "+v"(tid));
  SeqCtx C; C.lds = lds; C.wid = __builtin_amdgcn_readfirstlane(tid >> 6); C.lane = tid & 63; C.r32 = C.lane & 31; C.hi = C.lane >> 5; C.b = b; C.dir = dir; C.hd = hd; C.dvs = dvs;
  const int sc = (b * 4 + hd) * 2 + dir;
  C.OUT = WSP(bf16_t, dir ? R1_OB : R1_OF);
  C.tiles = (const char*)(F.ws + WS_ACT) + (size_t)sc * 68 * ITEM_B; C.decb = (const char*)(F.ws + WS_ACT + (size_t)4352 * ITEM_B) + (size_t)sc * 68 * 512;
  for (int i = tid; i < 2 * 17408 / 4; i += NTHR) ((LAS unsigned*)(lds + O_ST2))[i] = 0u;
  int vcol;
#pragma unroll
  for (int rd = 0; rd < 2; ++rd) { const int o = rd * 8192 + C.wid * 1024 + C.lane * 16;
    { const int row = o >> 8, slot = (o >> 4) & 15; C.sQ[rd] = (unsigned)(row * 256 + ((slot ^ (row & 15)) << 4)); }
    { const int sub = o >> 9, kkhi = sub >> 2, cblk = sub & 3, w = (o & 511) >> 1, kklo = w >> 5, cin = w & 31; const int kk = kkhi * 8 + kklo; const int k = (kk & ~0xC) | ((kk & 4) << 1) | ((kk & 8) >> 1);
      C.sK[rd] = (unsigned)(k * 256 + (cblk * 32 + cin) * 2); } }
  { const int o = C.wid * 1024 + C.lane * 16; const int sub = o >> 9, kkhi = sub >> 1, cblk = sub & 1, w = (o & 511) >> 1, kklo = w >> 5, cin = w & 31; const int kk = kkhi * 8 + kklo;
    C.vk = (kk & ~0xC) | ((kk & 4) << 1) | ((kk & 8) >> 1); vcol = cblk * 32 + cin; }
  C.Uv = WSP(bf16_t, R1_U1) + 1024 + hd * 256 + dvs * 64 + vcol;
  C.ldsw = (unsigned)C.wid * 1024u;
  C.eb = C.wid & 1; C.db = C.wid & 3; C.trb = v_rd_base(C.lane); C.xq = ((C.r32 & 15) ^ C.hi) << 4;
  { const int j = C.r32, kk = (j & ~0xC) | ((j & 4) << 1) | ((j & 8) >> 1); C.kdo = (kk >> 3) * 2048 + (kk & 7) * 64 + C.hi * 16; }
  seq_issue(C, 0); seq_issue(C, 1);
  if (C.wid < 4) { if (C.wid & 2) seq_out_loop<1>(C); else seq_out_loop<0>(C); }
  else seq_state_loop(C);
  asm volatile("s_waitcnt vmcnt(0) lgkmcnt(0)" ::: "memory");
  __builtin_amdgcn_s_barrier();
}
__device__ __forceinline__ void seq_phase(const Frame& F) {
  for (int un = F.bid; un < 256; un += F.G) {
    const int dvs = un & 3, sc = un >> 2, dir = sc & 1, hd = (sc >> 1) & 3, b = sc >> 3;
    __syncthreads();
    seq_unit(F, b, hd, dir, dvs, (LAS char*)F.ring);
  }
}
#undef GPK
#undef CH_ROW0
#undef TOK
}

__device__ __forceinline__ void ph_gla_out(const Frame& F) {
    const bf16_t* OF = WSP(bf16_t, R1_OF); const bf16_t* OB = WSP(bf16_t, R1_OB); const bf16_t* U1 = WSP(bf16_t, R1_U1); bf16_t* MIX = WSP(bf16_t, R1_OF); const float* gn = F.in[I1_GNG];
    for (int rl = F.bid * NWAVE + F.wave; rl < TL; rl += F.G * NWAVE) {
        float o[16], ob[16], go[16]; ld16b(OF + (size_t)rl * D, F.lane, o); ld16b(OB + (size_t)rl * D, F.lane, ob); ld16b(U1 + (size_t)(TC + rl) * U1W + 2048, F.lane, go);
        float s0 = 0.f, s1 = 0.f;
#pragma unroll
        for (int i = 0; i < 8; ++i) { o[i] += ob[i]; o[8 + i] += ob[8 + i]; s0 = fmaf(o[i], o[i], s0); s1 = fmaf(o[8 + i], o[8 + i], s1); }
        for (int k = 16; k >= 1; k >>= 1) { s0 += __shfl_xor(s0, k); s1 += __shfl_xor(s1, k); }
        const float r0 = rsqrtf(s0 * (1.0f / 256.0f) + EPS), r1 = rsqrtf(s1 * (1.0f / 256.0f) + EPS);
        const float* gp = gn + ((8 * F.lane) & 255);
#pragma unroll
        for (int i = 0; i < 8; ++i) { const float gw = gp[i]; o[i] = o[i] * r0 * gw * silu_fast(go[i]); o[8 + i] = o[8 + i] * r1 * gw * silu_fast(go[8 + i]); }
        st16b(MIX + (size_t)rl * D, F.lane, o);
    }
}

constexpr int NPHASE = 20;
__global__ void __launch_bounds__(NTHR, 2) fwd_kernel(Args args) {
    extern __shared__ __attribute__((aligned(16))) unsigned char lds_raw[];
    Frame F; F.in = args.in; F.out = args.out; F.ws = args.ws; F.lds = (LAS unsigned char*)lds_raw; F.ring = F.lds + RING_OFF;
    F.tid = threadIdx.x; F.lane = F.tid & 63; F.wave = __builtin_amdgcn_readfirstlane(F.tid >> 6); F.G = gridDim.x; F.bid = blockIdx.x;
    if (F.tid < 4) ((LAS unsigned*)F.lds)[F.tid] = 0u;
    __syncthreads();
    const int lo = args.ph_lo, hi = args.ph_hi;
    const bool multi = (hi - lo) > 1;
    XcdBarrier bar; bar.bar = (unsigned*)(F.ws + WS_CTL + CW_BAR); bar.x = 0; bar.st = (volatile LAS unsigned*)F.lds;
    if (multi) bar = xcd_barrier_post((unsigned*)(F.ws + WS_CTL + CW_BAR), (volatile LAS unsigned*)F.lds);
#define IN(k) (lo <= (k) && (k) < hi)
#define SEAM(k) do { if (IN((k) + 1)) xcd_barrier(bar); } while (0)
#define REFRESH() do { int t_ = threadIdx.x; asm volatile("" : "+v"(t_)); F.tid = t_; F.lane = t_ & 63; F.wave = __builtin_amdgcn_readfirstlane(t_ >> 6); } while (0)

    if (IN(0)) { REFRESH(); ph_prologue(F); SEAM(0); }
    if (IN(1)) { REFRESH(); ph_mod0(F); SEAM(1); }
    if (IN(2)) { REFRESH();
        pg8::DualOrder S; S.a.init(WSP(bf16_t, WS_H), WSP(bf16_t, WS_WIN0), D, D, T, U0W, F.G, F.bid); S.b.init(WSP(bf16_t, WS_WF), WSP(bf16_t, WS_H), D, D, 512, T, F.G, F.bid);
        pg8::EpiDual0 E{pg8::EpiBf16{WSP(bf16_t, R0_U0), U0W, U0W}, pg8::EpiFourT{WSP(bf16_t, R0_TT), WSP(bf16_t, R0_TTC)}};
        pg8::gemm_phase<pg8::EpiDual0, pg8::DualOrder>(F.ring, pg8::Gemm{D, D, D}, S, E);
        SEAM(2); }
    if (IN(3)) { REFRESH(); ph_rowstats(F); SEAM(3); }
    if (IN(4)) { REFRESH();
        { pg8::DenseOrder S; S.init(WSP(bf16_t, R0_U0), WSP(bf16_t, WS_WQ), U0W, QL, T, QWP, F.G, F.bid);
          pg8::EpiRS E{WSP(bf16_t, R0_Q), WSP(float, WS_RS), QW, QW}; pg8::gemm_phase<pg8::EpiRS, pg8::DenseOrder>(F.ring, pg8::Gemm{QL, U0W, QL}, S, E); }
        { pg8::DenseOrder S; S.init(WSP(bf16_t, R0_U0) + QL, WSP(bf16_t, WS_WKV), U0W, KVL, T, KVW, F.G, F.bid);
          pg8::EpiRS E{WSP(bf16_t, R0_KV), WSP(float, WS_RS) + T, KVW, KVW}; pg8::gemm_phase<pg8::EpiRS, pg8::DenseOrder>(F.ring, pg8::Gemm{KVL, U0W, KVL}, S, E); }
        SEAM(4); }
    if (IN(5)) { REFRESH();
        ph_queue5(F); SEAM(5); }
    if (IN(6)) { REFRESH();
        pg8::DenseOrder S; S.init(WSP(bf16_t, R0_MIX), WSP(bf16_t, WS_WOUT0), D, D, T, D, F.G, F.bid);
        pg8::EpiGateBf16 E{WSP(bf16_t, R0_U0), WSP(float, WS_MODV), 2048, 0, 0};
        pg8::gemm_phase<pg8::EpiGateBf16, pg8::DenseOrder>(F.ring, pg8::Gemm{D, D, D}, S, E); SEAM(6); }
    if (IN(7)) { REFRESH(); ph_router(F, 0, 0); SEAM(7); }
    if (IN(8)) { REFRESH(); ph_moe1(F, 0); SEAM(8); }
    if (IN(9)) { REFRESH(); ph_moe2(F, 0); SEAM(9); }
    if (IN(10)) { REFRESH(); ph_combine_mod1(F); SEAM(10); }
    if (IN(11)) { REFRESH();
        pg8::DenseOrder S; S.init(WSP(bf16_t, WS_H), WSP(bf16_t, WS_WIN1), D, D, T, U1W, F.G, F.bid);
        pg8::EpiBf16 E{WSP(bf16_t, R1_U1), U1W, U1W}; pg8::gemm_phase<pg8::EpiBf16, pg8::DenseOrder>(F.ring, pg8::Gemm{D, D, D}, S, E); SEAM(11); }
    if (IN(12)) { REFRESH(); gla3::pre_phase(F); SEAM(12); }
    if (IN(13)) { REFRESH(); gla3::seq_phase(F); SEAM(13); }
    if (IN(14)) { REFRESH(); ph_gla_out(F); SEAM(14); }
    if (IN(15)) { REFRESH();
        pg8::DenseOrder S; S.init(WSP(bf16_t, R1_OF), WSP(bf16_t, WS_WOUT1), D, D, TL, D, F.G, F.bid);
        pg8::EpiGateBf16 E{WSP(bf16_t, R1_OB), WSP(float, WS_MODV) + 9 * 6144, 2048, TC, TC};
        pg8::gemm_phase<pg8::EpiGateBf16, pg8::DenseOrder>(F.ring, pg8::Gemm{D, D, D}, S, E); SEAM(15); }
    if (IN(16)) { REFRESH(); ph_router(F, 1, TC); SEAM(16); }
    if (IN(17)) { REFRESH(); ph_moe1(F, 1); SEAM(17); }
    if (IN(18)) { REFRESH(); ph_moe2(F, 1); SEAM(18); }
    if (IN(19)) { REFRESH(); ph_final(F); }
#undef IN
#undef SEAM
}

#ifndef ONE_LAUNCH
#define ONE_LAUNCH 1
#endif
extern "C" void kernel_launch(void* const* d_in, const int* in_sizes, int n_in, void* d_out, int out_size, void* d_ws, size_t ws_size, hipStream_t stream) {
    static int grid = 0;
    if (grid == 0) {
        if (n_in != 38 || out_size != TL * D || ws_size < WS_END) { fprintf(stderr, "kernel_launch: unexpected shapes: n_in %d out %d ws %zu (need %zu)\n", n_in, out_size, ws_size, (size_t)WS_END); grid = -1; return; }
        int dev = 0, cus = 0, per_cu = 0;
        if (hipGetDevice(&dev) != hipSuccess || hipDeviceGetAttribute(&cus, hipDeviceAttributeMultiprocessorCount, dev) != hipSuccess) { grid = -1; return; }
        if (hipFuncSetAttribute((const void*)fwd_kernel, hipFuncAttributeMaxDynamicSharedMemorySize, LDS_BYTES) != hipSuccess) { fprintf(stderr, "kernel_launch: hipFuncSetAttribute failed\n"); grid = -1; return; }
        if (hipOccupancyMaxActiveBlocksPerMultiprocessor(&per_cu, (const void*)fwd_kernel, NTHR, LDS_BYTES) != hipSuccess || per_cu < 1) { fprintf(stderr, "kernel_launch: occupancy query says %d\n", per_cu); }
        (void)hipGetLastError();
        grid = cus;
    }
    if (grid < 0) return;
    (void)hipMemsetAsync((char*)d_ws + WS_CTL, 0, CTL_BYTES, stream);
    Args a{};
    for (int i = 0; i < 38; ++i) a.in[i] = (const float*)d_in[i];
    a.out = (float*)d_out; a.ws = (unsigned char*)d_ws;
#if ONE_LAUNCH
    a.ph_lo = 0; a.ph_hi = NPHASE;
    hipLaunchKernelGGL(fwd_kernel, dim3(grid), dim3(NTHR), LDS_BYTES, stream, a);
#else
    for (int p = 0; p < NPHASE; ++p) { a.ph_lo = p; a.ph_hi = p + 1; hipLaunchKernelGGL(fwd_kernel, dim3(grid), dim3(NTHR), LDS_BYTES, stream, a); }
#endif
}
```

```cpp
#include <hip/hip_runtime.h>
#include <stdint.h>
#include <stdio.h>

#define LAS __attribute__((address_space(3)))
typedef unsigned short bf16_t;
typedef short bf16x8 __attribute__((ext_vector_type(8)));
typedef float f32x4 __attribute__((ext_vector_type(4)));
typedef float f32x2 __attribute__((ext_vector_type(2)));
typedef unsigned u32x4 __attribute__((ext_vector_type(4)));
typedef unsigned u32x2 __attribute__((ext_vector_type(2)));

#ifndef NAIVE_ATTN
#define NAIVE_ATTN 0
#endif
#ifndef NAIVE_GLA
#define NAIVE_GLA 0
#endif
constexpr int D = 1024, NB = 8, SEQ = 4096, CTXL = 256;
constexpr int TC = NB * CTXL, TL = NB * SEQ, T = TC + TL;
constexpr int QL = 384, KVL = 256, ROPE = 64, NH = 6, QKD = 192, VD = 128;
constexpr int U0W = 768;
constexpr int QW = NH * QKD  , QWP = 1280, KVW = NH * 256  ;
constexpr int NE = 32, TOPK = 4, FF = 1024;
constexpr int U1W = 3072;
constexpr int NPAD = 147456;
constexpr float EPS = 1e-6f;
constexpr int NTHR = 512, NWAVE = 8;

constexpr size_t al256(size_t x) { return (x + 255) / 256 * 256; }
constexpr size_t XCD_BAR_WORDS_C = 3456;
constexpr size_t CW_BAR = 0;
constexpr size_t CW_Q5 = 15360;
constexpr size_t CW_CNT = 16384;
constexpr size_t CTL_BYTES = 32768;
constexpr size_t WS_CTL = 0;
constexpr size_t WS_MODV = WS_CTL + CTL_BYTES;
constexpr size_t WS_ROPE = WS_MODV + al256(2 * 9 * 6144 * 4);
constexpr size_t WS_RS = WS_ROPE + al256(2 * 64 * 16 * 4);
constexpr size_t WS_XCTX = WS_RS + al256((size_t)2 * T * 4);
constexpr size_t WS_H = WS_XCTX + al256((size_t)TC * D * 4);
constexpr size_t WS_WIN0 = WS_H + al256((size_t)T * D * 2);
constexpr size_t WS_WF = WS_WIN0 + al256((size_t)U0W * D * 2);
constexpr size_t WS_WQ = WS_WF + al256((size_t)512 * D * 2);
constexpr size_t WS_WKV = WS_WQ + al256((size_t)QWP * QL * 2);
constexpr size_t WS_WOUT0 = WS_WKV + al256((size_t)KVW * KVL * 2);
constexpr size_t WS_WIN1 = WS_WOUT0 + al256((size_t)D * D * 2);
constexpr size_t WS_WOUT1 = WS_WIN1 + al256((size_t)U1W * D * 2);
constexpr size_t WS_WGU = WS_WOUT1 + al256((size_t)D * D * 2);
constexpr size_t WS_WDN = WS_WGU + al256((size_t)NE * 2048 * D * 2);
constexpr size_t WS_ACT = WS_WDN + al256((size_t)NE * D * FF * 2);
constexpr size_t WS_LIST = WS_ACT + al256((size_t)NPAD * FF * 2);
constexpr size_t WS_TOKE = WS_LIST + al256((size_t)NE * T * 4);
constexpr size_t WS_TOKP = WS_TOKE + al256((size_t)T * 4 * 4);
constexpr size_t WS_TOKG = WS_TOKP + al256((size_t)T * 4 * 4);
constexpr size_t WS_RWT = WS_TOKG + al256((size_t)T * 4 * 4);
constexpr size_t WS_GD = WS_RWT + al256((size_t)2 * 2 * 32 * 1024 * 2);
constexpr size_t WS_REG = WS_GD + al256((size_t)T * 32 * 4);
constexpr size_t R0_U0 = WS_REG;
constexpr size_t R0_TT = R0_U0 + al256((size_t)T * U0W * 2);
constexpr size_t R0_TTC = R0_TT + al256((size_t)NB * 256 * 8192 * 2);
constexpr size_t R0_Q = R0_TTC + al256((size_t)NB * 256 * 512 * 2);
constexpr size_t R0_KV = R0_Q + al256((size_t)T * QW * 2);
constexpr size_t R0_KR = R0_KV + al256((size_t)T * KVW * 2);
constexpr size_t R0_MIX = R0_KR + al256((size_t)T * ROPE * 2);
constexpr size_t R0_DFT = R0_MIX + al256((size_t)T * D * 2);
constexpr size_t R0_DFTC = R0_DFT + al256((size_t)4096 * 4096 * 2);
constexpr size_t R0_TT2 = R0_DFTC + al256((size_t)256 * 256 * 2);
constexpr size_t R0_TTC2 = R0_TT2 + al256((size_t)NB * 256 * 4096 * 2);
constexpr size_t R0_END = R0_TTC2 + al256((size_t)NB * 256 * 256 * 2);
constexpr size_t R1_U1 = WS_REG;
constexpr size_t R1_OF = R1_U1 + al256((size_t)T * U1W * 2);
constexpr size_t R1_OB = R1_OF + al256((size_t)TL * D * 2);
constexpr size_t R1_XB = R1_OB + al256((size_t)TL * D * 2);
constexpr size_t R1_END = R1_XB + al256((size_t)TL * D * 2);
constexpr size_t RM_YB = WS_REG;
constexpr size_t RM_END = RM_YB + al256((size_t)NPAD * D * 2);
constexpr size_t cmax(size_t a, size_t b) { return a > b ? a : b; }
constexpr size_t WS_END = cmax(cmax(R0_END, R1_END), RM_END);

constexpr int LDS_BYTES = 160 * 1024;
constexpr int LDS_MISC = 1024;
constexpr int RING_OFF = LDS_MISC;

__device__ __forceinline__ float bf2f(bf16_t b) { return __uint_as_float(((unsigned)b) << 16); }
__device__ __forceinline__ bf16_t f2bf(float f) { unsigned u = __float_as_uint(f); u += 0x7FFFu + ((u >> 16) & 1u); return (bf16_t)(u >> 16); }
__device__ __forceinline__ unsigned pk2(float lo, float hi) { return (unsigned)f2bf(lo) | ((unsigned)f2bf(hi) << 16); }
typedef __bf16 bf16v2_t __attribute__((ext_vector_type(2)));
__device__ __forceinline__ unsigned cvt_pk_bf16(float lo, float hi) { const f32x2 v = {lo, hi}; bf16v2_t b = __builtin_convertvector(v, bf16v2_t); return *reinterpret_cast<unsigned*>(&b); }
__device__ __forceinline__ float wsum(float v) { for (int o = 32; o >= 1; o >>= 1) v += __shfl_xor(v, o); return v; }
__device__ __forceinline__ float siluf(float x) { return x / (1.0f + __expf(-x)); }
__device__ __forceinline__ float silu_fast(float x) { return x * __builtin_amdgcn_rcpf(1.0f + __builtin_amdgcn_exp2f(x * -1.4426950408889634f)); }

#define XB_TMO      128
#define XB_XCNT(j)  (256  + 64 * (j))
#define XB_XSUB(j)  (1280 + 64 * (j))
#define XB_XGEN(j)  (2304 + 64 * (j))
#define XB_TOP      3328
#define XB_TOPGEN   3392
#define XCD_BAR_WORDS 3456
#define XB_SPIN_CAP (1u << 20)
__device__ __forceinline__ unsigned xb_ld(unsigned* p)              { return __hip_atomic_load(p, __ATOMIC_RELAXED, __HIP_MEMORY_SCOPE_AGENT); }
__device__ __forceinline__ unsigned xb_add(unsigned* p, unsigned v) { return __hip_atomic_fetch_add(p, v, __ATOMIC_RELAXED, __HIP_MEMORY_SCOPE_AGENT); }
__device__ __forceinline__ unsigned xb_xcc_id() { return (unsigned)__builtin_amdgcn_s_getreg((3 << 11) | 20) & 0xFu; }
#define XB_SPIN(cond, bar) do { unsigned _sp = 0; while (cond) { __builtin_amdgcn_s_sleep(1); \
    if ((++_sp & 255u) == 0u) { if (xb_ld(&(bar)[XB_TMO])) break; if (_sp > XB_SPIN_CAP) { atomicAdd(&(bar)[XB_TMO], 1u); break; } } } } while (0)
struct XcdBarrier { unsigned* bar; unsigned x; volatile LAS unsigned* st; };
__device__ __forceinline__ XcdBarrier xcd_barrier_post(unsigned* bar, volatile LAS unsigned* st) {
    XcdBarrier b; b.bar = bar; b.x = xb_xcc_id(); b.st = st;
    if (threadIdx.x == 0) (void)xb_add(&bar[XB_XCNT(b.x)], 1u);
    return b;
}
__device__ __forceinline__ void xcd_barrier_complete(unsigned* bar, unsigned x, unsigned& nloc, unsigned& nx) {
    const unsigned G = gridDim.x * gridDim.y * gridDim.z;
    unsigned sum, cnt, mine, sp = 0u;
    for (;;) {
        sum = 0u; cnt = 0u; mine = 0u;
#pragma unroll
        for (unsigned j = 0; j < 16; ++j) { const unsigned c = xb_ld(&bar[XB_XCNT(j)]); sum += c; cnt += (c > 0u) ? 1u : 0u; mine = (j == x) ? c : mine; }
        if (sum == G) break;
        __builtin_amdgcn_s_sleep(1);
        if ((++sp & 255u) == 0u) { if (xb_ld(&bar[XB_TMO])) break; if (sp > XB_SPIN_CAP) { atomicAdd(&bar[XB_TMO], 1u); break; } }
    }
    nloc = mine > 0u ? mine : 1u; nx = cnt > 0u ? cnt : 1u;
}
__device__ __forceinline__ void xcd_barrier(const XcdBarrier& b) {
    asm volatile("s_waitcnt vmcnt(0)" ::: "memory");
    __syncthreads();
    if (threadIdx.x == 0) {
        unsigned* bar = b.bar;
        __builtin_amdgcn_s_waitcnt(0);
        unsigned nloc = b.st[0], nx = b.st[1];
        if (nloc == 0u) { xcd_barrier_complete(bar, b.x, nloc, nx); b.st[0] = nloc; b.st[1] = nx; }
        const unsigned old = xb_add(&bar[XB_XSUB(b.x)], 1u);
        const unsigned gen = old / nloc;
        if (old + 1u == (gen + 1u) * nloc) {
            __builtin_amdgcn_fence(__ATOMIC_RELEASE, "agent");
            asm volatile("s_waitcnt vmcnt(0)" ::: "memory");
            const unsigned og = xb_add(&bar[XB_TOP], 1u);
            const unsigned tg = og / nx;
            if (og + 1u == (tg + 1u) * nx) xb_add(&bar[XB_TOPGEN], 1u);
            else XB_SPIN(xb_ld(&bar[XB_TOPGEN]) == tg, bar);
            __builtin_amdgcn_fence(__ATOMIC_ACQUIRE, "agent");
            xb_add(&bar[XB_XGEN(b.x)], 1u);
            asm volatile("s_waitcnt vmcnt(0)" ::: "memory");
        } else {
            XB_SPIN(xb_ld(&bar[XB_XGEN(b.x)]) == gen, bar);
            __builtin_amdgcn_fence(__ATOMIC_ACQUIRE, "agent");
            asm volatile("s_waitcnt vmcnt(0)" ::: "memory");
        }
    }
    __syncthreads();
}

namespace pg8 {
constexpr int BM = 256, BK = 64, HALF = 128, HTB = HALF * BK * 2, STAGE_BYTES = 8 * HTB, NXCD = 8, WGM = 8;
__host__ __device__ __forceinline__ int lds_byte(int r, int c) { const int st = (r >> 4) * 2 + (c >> 5), rr = r & 15, cc = c & 31, ob = rr * 64 + cc * 2; return st * 1024 + (ob ^ (((ob >> 9) & 1) << 5)); }
__host__ __device__ __forceinline__ void stage_rc(int b, int& R, int& C) { const int st = b / 1024, sb = b % 1024, swz = sb ^ (((sb >> 9) & 1) << 5); R = (st >> 1) * 16 + swz / 64; C = (st & 1) * 32 + (swz % 64) / 2; }
__host__ __device__ __forceinline__ int perm32(int rho) { const int n = rho >> 4, i = rho & 15; return 8 * (i >> 2) + 4 * n + (i & 3); }

struct Unit { int pm, pn, e, cnt; const char* A; const char* B; };
struct Gemm { int K, lda, ldb; };

struct DenseOrder {
    const char* A; const char* B; int lda, ldb; int nM, nN, nwg, G, c;
    static constexpr bool GATHER = false;
    __device__ void init(const void* A_, const void* B_, int lda_, int ldb_, int M, int N, int G_, int c_) { A = (const char*)A_; B = (const char*)B_; lda = lda_; ldb = ldb_; nM = M / BM; nN = N / BM; nwg = nM * nN; G = G_; c = c_; }
    __device__ bool next(int i, Unit& u) const {
        const long L = (long)i * G + c; if (L >= nwg) return false;
        int wgid = (int)L; { const int q = nwg / NXCD, r = nwg % NXCD, xcd = wgid % NXCD, off = wgid / NXCD; wgid = (xcd < r ? xcd * (q + 1) : r * (q + 1) + (xcd - r) * q) + off; }
        const int nig = WGM * nN, gid = wgid / nig, fm = gid * WGM, gsz = (nM - fm) < WGM ? (nM - fm) : WGM;
        u.pm = fm + ((wgid % nig) % gsz); u.pn = (wgid % nig) / gsz; u.e = 0; u.cnt = 0;
        u.A = A + (size_t)u.pm * BM * lda * 2; u.B = B + (size_t)u.pn * BM * ldb * 2; return true;
    }
    __device__ __forceinline__ void aoff(const Unit&, const int (&R)[2], const int (&C)[2], unsigned (&off)[2][2]) const {
#pragma unroll
        for (int h = 0; h < 2; ++h)
#pragma unroll
            for (int i = 0; i < 2; ++i) off[h][i] = (unsigned)((h * HALF + R[i]) * lda + C[i]) * 2u;
    }
};
struct BatchOrder {
    const char* A; const char* B; size_t sA, sB; int lda, ldb; int nM, nN, per, nwg, G, c;
    static constexpr bool GATHER = false;
    __device__ void init(const void* A_, const void* B_, size_t sA_, size_t sB_, int lda_, int ldb_, int nb, int M, int N, int G_, int c_) { A = (const char*)A_; B = (const char*)B_; sA = sA_; sB = sB_; lda = lda_; ldb = ldb_; nM = M / BM; nN = N / BM; per = nM * nN; nwg = per * nb; G = G_; c = c_; }
    __device__ bool next(int i, Unit& u) const {
        const long L = (long)i * G + c; if (L >= nwg) return false;
        const int b = (int)L / per, r = (int)L % per; u.pm = r / nN; u.pn = r % nN; u.e = b; u.cnt = 0;
        u.A = A + (size_t)b * sA + (size_t)u.pm * BM * lda * 2; u.B = B + (size_t)b * sB + (size_t)u.pn * BM * ldb * 2; return true;
    }
    __device__ __forceinline__ void aoff(const Unit&, const int (&R)[2], const int (&C)[2], unsigned (&off)[2][2]) const {
#pragma unroll
        for (int h = 0; h < 2; ++h)
#pragma unroll
            for (int i = 0; i < 2; ++i) off[h][i] = (unsigned)((h * HALF + R[i]) * lda + C[i]) * 2u;
    }
};
struct DualOrder {
    DenseOrder a, b;
    static constexpr bool GATHER = false;
    __device__ __forceinline__ void aoff_issue(const Unit&, const int (&)[2], unsigned (&)[2][2]) const {}
    __device__ __forceinline__ void aoff_finish(const int (&)[2], unsigned (&)[2][2], unsigned (&)[2][2]) const {}
    __device__ bool next(int i, Unit& u) const {
        const long L = (long)i * a.G + a.c;
        if (L < a.nwg) { return a.next(i, u); }
        const long Lb = L - a.nwg; if (Lb >= b.nwg) return false;
        DenseOrder t = b; t.c = (int)(Lb % b.G); const bool ok = t.next((int)(Lb / b.G), u); u.e = 1; return ok;
    }
    __device__ __forceinline__ void aoff(const Unit& u, const int (&R)[2], const int (&C)[2], unsigned (&off)[2][2]) const { a.aoff(u, R, C, off); }
};
struct OneUnit {
    Unit u0; int lda;
    static constexpr bool GATHER = false;
    __device__ bool next(int i, Unit& u) const { if (i != 0) return false; u = u0; return true; }
    __device__ __forceinline__ void aoff(const Unit&, const int (&R)[2], const int (&C)[2], unsigned (&off)[2][2]) const {
#pragma unroll
        for (int h = 0; h < 2; ++h)
#pragma unroll
            for (int i = 0; i < 2; ++i) off[h][i] = (unsigned)((h * HALF + R[i]) * lda + C[i]) * 2u;
    }
};
template <bool GATHER_> struct MoeOrder {
    const char* A; const char* B; size_t sB; int lda, ldb; int npn, nwg, G, c;
    const LAS int* tstart; const LAS int* cnt; const int* list;
    const LAS int* t2e;
    __device__ __forceinline__ int ts(int j) const { return __builtin_amdgcn_readfirstlane(tstart[j]); }
    static constexpr bool GATHER = GATHER_;
    __device__ bool next(int i, Unit& u) const {
        const long L = (long)i * G + c; if (L >= nwg) return false;
        int wgid = (int)L; { const int q = nwg / NXCD, r = nwg % NXCD, xcd = wgid % NXCD, off = wgid / NXCD; wgid = (xcd < r ? xcd * (q + 1) : r * (q + 1) + (xcd - r) * q) + off; }
        const int e = __builtin_amdgcn_readfirstlane(t2e[wgid / npn]);
        const int t0 = ts(e), nt = ts(e + 1) - t0, l = wgid - t0 * npn, pn = l / nt, ti = l % nt;
        u.pm = t0 + ti; u.pn = pn; u.e = e; u.cnt = __builtin_amdgcn_readfirstlane(cnt[e]) - ti * BM;
        u.A = GATHER ? A : A + (size_t)u.pm * BM * lda * 2;
        u.B = B + (size_t)e * sB + (size_t)pn * BM * ldb * 2; return true;
    }
    __device__ __forceinline__ void aoff(const Unit& u, const int (&R)[2], const int (&C)[2], unsigned (&off)[2][2]) const {
        if (GATHER) {
            const int ti = u.pm - ts(u.e);
#pragma unroll
            for (int h = 0; h < 2; ++h)
#pragma unroll
                for (int i = 0; i < 2; ++i) { const int r = h * HALF + R[i]; const int tok = (r < u.cnt) ? list[(size_t)u.e * T + ti * BM + r] : 0; off[h][i] = (unsigned)(tok * lda + C[i]) * 2u; }
        } else {
#pragma unroll
            for (int h = 0; h < 2; ++h)
#pragma unroll
                for (int i = 0; i < 2; ++i) off[h][i] = (unsigned)((h * HALF + R[i]) * lda + C[i]) * 2u;
        }
    }
};

template <class Epi, class Sched>
__device__ __forceinline__ void gemm_phase(LAS unsigned char* lds, const Gemm g, const Sched& S, const Epi& E) {
    const int tid = threadIdx.x, wid = __builtin_amdgcn_readfirstlane(tid >> 6), lane = tid & 63, wr = wid >> 2, wc = wid & 3, fr = lane & 15, fq = lane >> 4;
    const int K = g.K, nt = K / BK;
    int Rr[2], Cc[2]; unsigned voffB[2];
#pragma unroll
    for (int i = 0; i < 2; ++i) { int R, C; stage_rc(tid * 16 + i * 8192, R, C); const int Rb = Epi::PERM ? ((R & ~31) + perm32(R & 31)) : R; Rr[i] = R; Cc[i] = C; voffB[i] = (unsigned)(Rb * g.ldb + C) * 2u; }
    const size_t kstep = (size_t)(BK * 2);
    const size_t hstepB = (size_t)HALF * g.ldb * 2;
    const unsigned ldsw = (unsigned)wid * 1024u;
    const int aoff = lds_byte(wr * 64 + fr, fq * 8), boff = lds_byte(wc * 32 + fr, fq * 8);
#define PG8_SA(b, h) (((b) * 2 + (h)) * HTB)
#define PG8_SB(b, h) ((4 + (b) * 2 + (h)) * HTB)
#define PG8_STAGE2(bufoff, gbase, o0, o1) do { \
        __builtin_amdgcn_global_load_lds((const unsigned*)((const char*)(gbase) + (o0)), (LAS unsigned*)(lds + (bufoff) + ldsw), 16, 0, 0); \
        __builtin_amdgcn_global_load_lds((const unsigned*)((const char*)(gbase) + (o1)), (LAS unsigned*)(lds + (bufoff) + ldsw + 8192), 16, 0, 0); } while (0)
#define PG8_STAGEB(bufoff, gbase) PG8_STAGE2(bufoff, gbase, voffB[0], voffB[1])
#define PG8_LDA(dst, b, h) do { _Pragma("unroll") for (int m = 0; m < 4; ++m) _Pragma("unroll") for (int k = 0; k < 2; ++k) dst[m][k] = *(const LAS bf16x8*)(lds + PG8_SA(b, h) + aoff + m * 2048 + k * 1024); } while (0)
#define PG8_LDB(dst, b, h) do { _Pragma("unroll") for (int n = 0; n < 2; ++n) _Pragma("unroll") for (int k = 0; k < 2; ++k) dst[n][k] = *(const LAS bf16x8*)(lds + PG8_SB(b, h) + boff + n * 2048 + k * 1024); } while (0)
#define PG8_MMA(ai, bj, At, Bt) do { __builtin_amdgcn_s_setprio(1); _Pragma("unroll") for (int m = 0; m < 4; ++m) _Pragma("unroll") for (int n = 0; n < 2; ++n) _Pragma("unroll") for (int k = 0; k < 2; ++k) \
        acc[ai][bj][m][n] = __builtin_amdgcn_mfma_f32_16x16x32_bf16(Bt[n][k], At[m][k], acc[ai][bj][m][n], 0, 0, 0); __builtin_amdgcn_s_setprio(0); } while (0)
#define PG8_WAIT_V(n) asm volatile("s_waitcnt vmcnt(" #n ")" ::: "memory")
#define PG8_WAIT_L(n) asm volatile("s_waitcnt lgkmcnt(" #n ")" ::: "memory")
#define PG8_BAR __builtin_amdgcn_s_barrier()
#define PG8_SCHED __builtin_amdgcn_sched_barrier(0)
    Unit cur, nxt; int ui = 0;
    if (!S.next(0, cur)) return;
    f32x4 acc[2][2][4][2];
#pragma unroll
    for (int a = 0; a < 2; ++a)
#pragma unroll
        for (int b = 0; b < 2; ++b)
#pragma unroll
            for (int m = 0; m < 4; ++m)
#pragma unroll
                for (int n = 0; n < 2; ++n) acc[a][b][m][n] = (f32x4){0.f, 0.f, 0.f, 0.f};
    bf16x8 At[4][2], B0[2][2], B1[2][2];
    unsigned oA[2][2], nOA[2][2];
    S.aoff(cur, Rr, Cc, oA);
    const char* cA = cur.A; const char* cB = cur.B;
    PG8_STAGEB(PG8_SB(0, 0), cB); PG8_STAGEB(PG8_SB(0, 1), cB + hstepB); PG8_STAGE2(PG8_SA(0, 0), cA, oA[0][0], oA[0][1]); PG8_STAGE2(PG8_SA(0, 1), cA, oA[1][0], oA[1][1]);
    if (wr == 1) PG8_BAR;
    PG8_WAIT_V(2); PG8_BAR;
    PG8_STAGEB(PG8_SB(1, 0), cB + kstep); PG8_STAGE2(PG8_SA(1, 0), cA + kstep, oA[0][0], oA[0][1]); PG8_STAGEB(PG8_SB(1, 1), cB + hstepB + kstep);
    PG8_WAIT_V(6); PG8_BAR;
    for (;;) {
        const bool has_next = S.next(ui + 1, nxt);
        const char* nA = has_next ? nxt.A : cA; const char* nB = has_next ? nxt.B : cB;
        if (Sched::GATHER) { if (has_next) S.aoff(nxt, Rr, Cc, nOA); else {
#pragma unroll
            for (int h = 0; h < 2; ++h)
#pragma unroll
                for (int i = 0; i < 2; ++i) nOA[h][i] = oA[h][i]; }
            asm volatile("" : "+v"(nOA[0][0]), "+v"(nOA[0][1]), "+v"(nOA[1][0]), "+v"(nOA[1][1])); }
        for (int t = 0; t < nt; t += 2) {
            const bool last = (t == nt - 2);
            const char* a1 = cA + (size_t)(t + 1) * kstep;
            const char* a2 = last ? nA : cA + (size_t)(t + 2) * kstep; const char* b2 = last ? nB : cB + (size_t)(t + 2) * kstep;
            const char* a3 = a2 + kstep; const char* b3 = b2 + kstep;
            unsigned q00 = oA[0][0], q01 = oA[0][1], q10 = oA[1][0], q11 = oA[1][1];
            if (Sched::GATHER) { q00 = last ? nOA[0][0] : q00; q01 = last ? nOA[0][1] : q01; q10 = last ? nOA[1][0] : q10; q11 = last ? nOA[1][1] : q11; }
            PG8_LDB(B0, 0, 0); PG8_LDB(B1, 0, 1); PG8_SCHED; PG8_LDA(At, 0, 0); PG8_STAGE2(PG8_SA(1, 1), a1, oA[1][0], oA[1][1]);
            PG8_WAIT_V(8); PG8_WAIT_L(0); PG8_BAR; PG8_MMA(0, 0, At, B0); PG8_MMA(0, 1, At, B1); PG8_BAR; PG8_SCHED;
            PG8_LDA(At, 0, 1); PG8_STAGEB(PG8_SB(0, 0), b2); PG8_STAGEB(PG8_SB(0, 1), b2 + hstepB); PG8_STAGE2(PG8_SA(0, 0), a2, q00, q01);
            PG8_WAIT_V(8); PG8_WAIT_L(0); PG8_BAR; PG8_MMA(1, 0, At, B0); PG8_MMA(1, 1, At, B1); PG8_BAR; PG8_SCHED;
            PG8_LDB(B0, 1, 0); PG8_LDB(B1, 1, 1); PG8_SCHED; PG8_LDA(At, 1, 0); PG8_STAGE2(PG8_SA(0, 1), a2, q10, q11);
            PG8_WAIT_V(8); PG8_WAIT_L(0); PG8_BAR; PG8_MMA(0, 0, At, B0); PG8_MMA(0, 1, At, B1); PG8_BAR; PG8_SCHED;
            PG8_LDA(At, 1, 1); PG8_STAGEB(PG8_SB(1, 0), b3); PG8_STAGEB(PG8_SB(1, 1), b3 + hstepB); PG8_STAGE2(PG8_SA(1, 0), a3, q00, q01);
            PG8_WAIT_V(8); PG8_WAIT_L(0); PG8_BAR; PG8_MMA(1, 0, At, B0); PG8_MMA(1, 1, At, B1); PG8_BAR; PG8_SCHED;
        }
        if (wr == 0) PG8_BAR;
        E(acc, cur, wr, wc, fr, fq, lds + 3 * HTB + ldsw);
        if (!has_next) break;
#pragma unroll
        for (int a = 0; a < 2; ++a)
#pragma unroll
            for (int b = 0; b < 2; ++b)
#pragma unroll
                for (int m = 0; m < 4; ++m)
#pragma unroll
                    for (int n = 0; n < 2; ++n) acc[a][b][m][n] = (f32x4){0.f, 0.f, 0.f, 0.f};
        cur = nxt; cA = nA; cB = nB; ++ui;
        if (Sched::GATHER) {
#pragma unroll
            for (int h = 0; h < 2; ++h)
#pragma unroll
                for (int i = 0; i < 2; ++i) oA[h][i] = nOA[h][i]; }
        if (wr == 1) PG8_BAR;
    }
    PG8_WAIT_V(0);
    PG8_BAR;
#undef PG8_SA
#undef PG8_SB
#undef PG8_STAGE2
#undef PG8_STAGEB
#undef PG8_LDA
#undef PG8_LDB
#undef PG8_MMA
#undef PG8_WAIT_V
#undef PG8_WAIT_L
#undef PG8_BAR
#undef PG8_SCHED
}

typedef f32x4 Acc[2][2][4][2];

struct XStore {
    LAS unsigned char* w; LAS unsigned char* r; int rr, cc;
    __device__ __forceinline__ XStore(LAS unsigned char* xs, int fr, int fq) {
        const int lane = fq * 16 + fr; rr = lane >> 2; cc = lane & 3;
        w = xs + fr * 64 + ((fq ^ ((fr >> 1) & 3)) * 16); r = xs + rr * 64 + ((cc ^ ((rr >> 1) & 3)) * 16); }
    __device__ __forceinline__ void put(const u32x4& x, const u32x4& y) const { *(LAS u32x4*)w = x; *(LAS u32x4*)(w + 8192) = y; }
    __device__ __forceinline__ void get(u32x4& x, u32x4& y) const { x = *(const LAS u32x4*)r; y = *(const LAS u32x4*)(r + 8192); }
};
struct EpiBf16 {
    static constexpr bool PERM = true;
    bf16_t* O; int ldc; int ncols;
    __device__ __forceinline__ void operator()(const Acc& acc, const Unit& u, int wr, int wc, int fr, int fq, LAS unsigned char* xs) const {
        const XStore X(xs, fr, fq);
        const int colw = u.pn * BM + wc * 32; const bool ok0 = colw < ncols, ok1 = colw + HALF < ncols;
        bf16_t* ob = O + (size_t)(u.pm * BM + wr * 64 + X.rr) * ldc + colw + 8 * X.cc;
#pragma unroll
        for (int ai = 0; ai < 2; ++ai)
#pragma unroll
            for (int m = 0; m < 4; ++m) { u32x4 w[2];
#pragma unroll
                for (int bj = 0; bj < 2; ++bj) { const f32x4 v0 = acc[ai][bj][m][0], v1 = acc[ai][bj][m][1];
                    w[bj].x = cvt_pk_bf16(v0[0], v0[1]); w[bj].y = cvt_pk_bf16(v0[2], v0[3]); w[bj].z = cvt_pk_bf16(v1[0], v1[1]); w[bj].w = cvt_pk_bf16(v1[2], v1[3]); }
                X.put(w[0], w[1]); u32x4 a, b; X.get(a, b);
                bf16_t* rowp = ob + (size_t)(ai * HALF + m * 16) * ldc; if (ok0) *(u32x4*)rowp = a; if (ok1) *(u32x4*)(rowp + HALF) = b; }
    }
};
struct EpiFourT {
    static constexpr bool PERM = true;
    bf16_t* TT; bf16_t* TTC;
    __device__ __forceinline__ void operator()(const Acc& acc, const Unit& u, int wr, int wc, int fr, int fq, LAS unsigned char* xs) const {
        const XStore X(xs, fr, fq);
        const int part = u.pm; const int ch0 = wr * 64 + X.rr; const int tokw = u.pn * BM + wc * 32;
        bf16_t* base[2]; int ldt[2];
#pragma unroll
        for (int bj = 0; bj < 2; ++bj) { const int tok = tokw + bj * HALF;
            if (tok < TC) { const int b = tok >> 8, n = tok & 255; base[bj] = TTC + (size_t)b * 256 * 512 + part * 256 + n + 8 * X.cc; ldt[bj] = 512; }
            else { const int tl = tok - TC, b = tl >> 12, n = tl & 4095; base[bj] = TT + (size_t)b * 256 * 8192 + part * 4096 + n + 8 * X.cc; ldt[bj] = 8192; } }
#pragma unroll
        for (int ai = 0; ai < 2; ++ai)
#pragma unroll
            for (int m = 0; m < 4; ++m) { const int ch = ch0 + ai * HALF + m * 16; u32x4 w[2];
#pragma unroll
                for (int bj = 0; bj < 2; ++bj) { const f32x4 v0 = acc[ai][bj][m][0], v1 = acc[ai][bj][m][1];
                    w[bj].x = cvt_pk_bf16(v0[0], v0[1]); w[bj].y = cvt_pk_bf16(v0[2], v0[3]); w[bj].z = cvt_pk_bf16(v1[0], v1[1]); w[bj].w = cvt_pk_bf16(v1[2], v1[3]); }
                X.put(w[0], w[1]); u32x4 a, b; X.get(a, b);
                *(u32x4*)(base[0] + (size_t)ch * ldt[0]) = a; *(u32x4*)(base[1] + (size_t)ch * ldt[1]) = b; }
    }
};
struct EpiRS {
    static constexpr bool PERM = true;
    bf16_t* O; const float* rs; int ldc, ncols;
    __device__ __forceinline__ void operator()(const Acc& acc, const Unit& u, int wr, int wc, int fr, int fq, LAS unsigned char* xs) const {
        const XStore X(xs, fr, fq);
        const int row0 = u.pm * BM + wr * 64 + fr, colw = u.pn * BM + wc * 32; const bool ok0 = colw < ncols, ok1 = colw + HALF < ncols;
        bf16_t* ob = O + (size_t)(u.pm * BM + wr * 64 + X.rr) * ldc + colw + 8 * X.cc;
#pragma unroll
        for (int ai = 0; ai < 2; ++ai)
#pragma unroll
            for (int m = 0; m < 4; ++m) { const float sc = rs[row0 + ai * HALF + m * 16]; u32x4 w[2];
#pragma unroll
                for (int bj = 0; bj < 2; ++bj) { const f32x4 v0 = acc[ai][bj][m][0] * sc, v1 = acc[ai][bj][m][1] * sc;
                    w[bj].x = cvt_pk_bf16(v0[0], v0[1]); w[bj].y = cvt_pk_bf16(v0[2], v0[3]); w[bj].z = cvt_pk_bf16(v1[0], v1[1]); w[bj].w = cvt_pk_bf16(v1[2], v1[3]); }
                X.put(w[0], w[1]); u32x4 a, b; X.get(a, b);
                bf16_t* rowp = ob + (size_t)(ai * HALF + m * 16) * ldc; if (ok0) *(u32x4*)rowp = a; if (ok1) *(u32x4*)(rowp + HALF) = b; }
    }
};
struct EpiFourOut {
    static constexpr bool PERM = true;
    bf16_t* MIX; int rowbase, rows_per_b;
    __device__ __forceinline__ void operator()(const Acc& acc, const Unit& u, int wr, int wc, int fr, int fq, LAS unsigned char* xs) const {
        const XStore X(xs, fr, fq);
        bf16_t* ob = MIX + (size_t)(rowbase + u.e * rows_per_b + u.pm * BM + wr * 64 + X.rr) * D + 768 + wc * 32 + 8 * X.cc;
#pragma unroll
        for (int ai = 0; ai < 2; ++ai)
#pragma unroll
            for (int m = 0; m < 4; ++m) { u32x4 w[2];
#pragma unroll
                for (int bj = 0; bj < 2; ++bj) { const f32x4 v0 = acc[ai][bj][m][0], v1 = acc[ai][bj][m][1];
                    w[bj].x = cvt_pk_bf16(v0[0], v0[1]); w[bj].y = cvt_pk_bf16(v0[2], v0[3]); w[bj].z = cvt_pk_bf16(v1[0], v1[1]); w[bj].w = cvt_pk_bf16(v1[2], v1[3]); }
                X.put(w[0], w[1]); u32x4 a, b; X.get(a, b);
                bf16_t* rowp = ob + (size_t)(ai * HALF + m * 16) * D; *(u32x4*)rowp = a; *(u32x4*)(rowp + HALF) = b; }
    }
};
struct EpiDual0 {
    static constexpr bool PERM = true;
    EpiBf16 e0; EpiFourT e1;
    __device__ __forceinline__ void operator()(const Acc& acc, const Unit& u, int wr, int wc, int fr, int fq, LAS unsigned char* xs) const { if (u.e == 0) e0(acc, u, wr, wc, fr, fq, xs); else e1(acc, u, wr, wc, fr, fq, xs); }
};
struct EpiResid {
    static constexpr bool PERM = false;
    const float* base_ctx; const float* base_lat; float* out_ctx; float* out_lat; const float* modv; int goff; int rowoff;
    __device__ __forceinline__ void operator()(const Acc& acc, const Unit& u, int wr, int wc, int fr, int fq, LAS unsigned char* xs) const {
        const int rt = rowoff + u.pm * BM;
        const bool isctx = rt < TC; const int mr = isctx ? 8 : ((rt - TC) >> 12);
        const float* base = isctx ? base_ctx + (size_t)rt * D : base_lat + (size_t)(rt - TC) * D;
        float* out = isctx ? out_ctx + (size_t)rt * D : out_lat + (size_t)(rt - TC) * D;
        const float* gv = modv + mr * 6144 + goff;
        const int r0 = wr * 64 + fr, col0 = u.pn * BM + wc * 32 + 4 * fq;
        f32x4 g[2][2];
#pragma unroll
        for (int bj = 0; bj < 2; ++bj)
#pragma unroll
            for (int n = 0; n < 2; ++n) g[bj][n] = *(const f32x4*)(gv + col0 + bj * HALF + n * 16);
#pragma unroll
        for (int ai = 0; ai < 2; ++ai) {
            f32x4 bs[4][2][2];
#pragma unroll
            for (int m = 0; m < 4; ++m) { const size_t off = (size_t)(r0 + ai * HALF + m * 16) * D + col0;
#pragma unroll
                for (int bj = 0; bj < 2; ++bj)
#pragma unroll
                    for (int n = 0; n < 2; ++n) bs[m][bj][n] = *(const f32x4*)(base + off + bj * HALF + n * 16); }
#pragma unroll
            for (int m = 0; m < 4; ++m) { const size_t off = (size_t)(r0 + ai * HALF + m * 16) * D + col0;
#pragma unroll
                for (int bj = 0; bj < 2; ++bj)
#pragma unroll
                    for (int n = 0; n < 2; ++n) *(f32x4*)(out + off + bj * HALF + n * 16) = bs[m][bj][n] + g[bj][n] * acc[ai][bj][m][n]; }
            asm volatile("" ::: "memory"); }
    }
};
struct EpiGateBf16 {
    static constexpr bool PERM = true; static constexpr int NSTORE = 16;
    bf16_t* Y; const float* modv; int goff, rowoff, ybase;
    __device__ __forceinline__ void operator()(const Acc& acc, const Unit& u, int wr, int wc, int fr, int fq, LAS unsigned char* xs) const {
        const XStore X(xs, fr, fq);
        const int rt = rowoff + u.pm * BM; const int mr = rt < TC ? 8 : ((rt - TC) >> 12);
        const float* gv = modv + mr * 6144 + goff; const int col0 = u.pn * BM + wc * 32 + 8 * fq;
        f32x4 g[2][2];
#pragma unroll
        for (int bj = 0; bj < 2; ++bj)
#pragma unroll
            for (int n = 0; n < 2; ++n) g[bj][n] = *(const f32x4*)(gv + col0 + bj * HALF + 4 * n);
        bf16_t* yb = Y + (size_t)(rt - ybase + wr * 64 + X.rr) * D + u.pn * BM + wc * 32 + 8 * X.cc;
#pragma unroll
        for (int ai = 0; ai < 2; ++ai)
#pragma unroll
            for (int m = 0; m < 4; ++m) { u32x4 w[2];
#pragma unroll
                for (int bj = 0; bj < 2; ++bj) { const f32x4 v0 = acc[ai][bj][m][0] * g[bj][0], v1 = acc[ai][bj][m][1] * g[bj][1];
                    w[bj].x = cvt_pk_bf16(v0[0], v0[1]); w[bj].y = cvt_pk_bf16(v0[2], v0[3]); w[bj].z = cvt_pk_bf16(v1[0], v1[1]); w[bj].w = cvt_pk_bf16(v1[2], v1[3]); }
                X.put(w[0], w[1]); u32x4 a, b; X.get(a, b);
                bf16_t* rowp = yb + (size_t)(ai * HALF + m * 16) * D; *(u32x4*)rowp = a; *(u32x4*)(rowp + HALF) = b; }
    }
};
struct EpiSwiglu {
    static constexpr bool PERM = true;
    bf16_t* ACT; const float* bgu;
    __device__ __forceinline__ void operator()(const Acc& acc, const Unit& u, int wr, int wc, int fr, int fq, LAS unsigned char* xs) const {
        const XStore X(xs, fr, fq);
        const int a0 = u.pn * HALF + wc * 32 + 8 * fq;
        const float* bp = bgu + (size_t)u.e * 2048 + 2 * a0;
        float bg[8], bl[8];
#pragma unroll
        for (int q = 0; q < 4; ++q) { const f32x4 t = *(const f32x4*)(bp + 4 * q); bg[2 * q] = t[0]; bl[2 * q] = t[1]; bg[2 * q + 1] = t[2]; bl[2 * q + 1] = t[3]; }
        bf16_t* ab = ACT + (size_t)(u.pm * BM + wr * 64 + X.rr) * FF + u.pn * HALF + wc * 32 + 8 * X.cc;
#pragma unroll
        for (int ai = 0; ai < 2; ++ai)
#pragma unroll
            for (int mp = 0; mp < 2; ++mp) { u32x4 w[2];
#pragma unroll
                for (int mm = 0; mm < 2; ++mm) { const int m = 2 * mp + mm; float o[8];
#pragma unroll
                    for (int j = 0; j < 8; ++j) { float xg = acc[ai][0][m][j >> 2][j & 3] + bg[j], xl = acc[ai][1][m][j >> 2][j & 3] + bl[j];
                        xg = fminf(xg, 7.0f); xl = fminf(fmaxf(xl, -7.0f), 7.0f);
                        o[j] = xg * __builtin_amdgcn_rcpf(1.0f + __builtin_amdgcn_exp2f(xg * (-1.702f * 1.4426950408889634f))) * (xl + 1.0f); }
                    w[mm].x = cvt_pk_bf16(o[0], o[1]); w[mm].y = cvt_pk_bf16(o[2], o[3]); w[mm].z = cvt_pk_bf16(o[4], o[5]); w[mm].w = cvt_pk_bf16(o[6], o[7]); }
                X.put(w[0], w[1]); u32x4 a, b; X.get(a, b);
                bf16_t* rowp = ab + (size_t)(ai * HALF + mp * 32) * FF; *(u32x4*)rowp = a; *(u32x4*)(rowp + (size_t)16 * FF) = b; }
    }
};
struct EpiDown {
    static constexpr bool PERM = true;
    bf16_t* YB; const float* bdn;
    __device__ __forceinline__ void operator()(const Acc& acc, const Unit& u, int wr, int wc, int fr, int fq, LAS unsigned char* xs) const {
        const int col0 = u.pn * BM + wc * 32 + 8 * fq;
        f32x4 bv[2][2];
#pragma unroll
        for (int bj = 0; bj < 2; ++bj)
#pragma unroll
            for (int n = 0; n < 2; ++n) bv[bj][n] = *(const f32x4*)(bdn + (size_t)u.e * D + col0 + bj * HALF + 4 * n);
        const XStore X(xs, fr, fq);
        bf16_t* yb = YB + (size_t)(u.pm * BM + wr * 64 + X.rr) * D + u.pn * BM + wc * 32 + 8 * X.cc;
#pragma unroll
        for (int ai = 0; ai < 2; ++ai)
#pragma unroll
            for (int m = 0; m < 4; ++m) { u32x4 w[2];
#pragma unroll
                for (int bj = 0; bj < 2; ++bj) { const f32x4 v0 = acc[ai][bj][m][0] + bv[bj][0], v1 = acc[ai][bj][m][1] + bv[bj][1];
                    w[bj].x = cvt_pk_bf16(v0[0], v0[1]); w[bj].y = cvt_pk_bf16(v0[2], v0[3]); w[bj].z = cvt_pk_bf16(v1[0], v1[1]); w[bj].w = cvt_pk_bf16(v1[2], v1[3]); }
                X.put(w[0], w[1]); u32x4 a, b; X.get(a, b);
                bf16_t* rowp = yb + (size_t)(ai * HALF + m * 16) * D; *(u32x4*)rowp = a; *(u32x4*)(rowp + HALF) = b; }
    }
};
}

struct Args { const float* in[38]; float* out; unsigned char* ws; int ph_lo, ph_hi; };
enum { I_X = 0, I_C, I_CTX, I_CCTX, I_FNG,
       I0_MODW, I0_MODB, I0_N1G, I0_WIN, I0_QNG, I0_WQUP, I0_KVNG, I0_WKVUP, I0_WOUT, I0_N2G, I0_RW, I0_RB, I0_WGU, I0_BGU, I0_WDN, I0_BDN,
       I1_MODW, I1_MODB, I1_N1G, I1_WIN, I1_WGKF, I1_BGKF, I1_WGKB, I1_BGKB, I1_GNG, I1_WOUT, I1_N2G, I1_RW, I1_RB, I1_WGU, I1_BGU, I1_WDN, I1_BDN };

struct Frame {
    const float* const* in; float* out; unsigned char* ws; LAS unsigned char* lds; LAS unsigned char* ring;
    int tid, lane, wave, G, bid;
};
#define WSP(T_, off) ((T_*)(F.ws + (off)))

__device__ __forceinline__ int gu_row(int n) { const int a = n >> 1, half = n & 1; return 256 * (a >> 7) + 128 * half + (a & 127); }
template <int MODE>
__device__ __forceinline__ void cvt_tile(const Frame& F, LAS bf16_t* tile  , const float* src, int ldsrc, int k0, int n0, bf16_t* dst, int ldd, const float* sk, float mul) {
    const int t = F.tid;
    { const int kl = t >> 3, nc = (t & 7) * 8; const float* p = src + (size_t)(k0 + kl) * ldsrc + n0 + nc;
      const f32x4 a = *(const f32x4*)p, b = *(const f32x4*)(p + 4); const float s = (sk ? sk[k0 + kl] : 1.0f) * mul;
      tile[(nc + 0) * 72 + kl] = f2bf(a[0] * s); tile[(nc + 1) * 72 + kl] = f2bf(a[1] * s); tile[(nc + 2) * 72 + kl] = f2bf(a[2] * s); tile[(nc + 3) * 72 + kl] = f2bf(a[3] * s);
      tile[(nc + 4) * 72 + kl] = f2bf(b[0] * s); tile[(nc + 5) * 72 + kl] = f2bf(b[1] * s); tile[(nc + 6) * 72 + kl] = f2bf(b[2] * s); tile[(nc + 7) * 72 + kl] = f2bf(b[3] * s); }
    __syncthreads();
    { const int nl = t >> 3, kc = (t & 7) * 8; const int n = n0 + nl; const int row = MODE == 1 ? gu_row(n) : n;
      const u32x4 v = *(const LAS u32x4*)(tile + nl * 72 + kc); *(u32x4*)(dst + (size_t)row * ldd + k0 + kc) = v; }
    __syncthreads();
}
template <int MODE>
__device__ __forceinline__ void cvt_blk(const Frame& F, LAS float* tl, const float* src, int ldsrc, int k0, int n0, bf16_t* dst, int ldd) {
    const int t = F.tid, w = t >> 6, l = t & 63;
    f32x4 v[8];
#pragma unroll
    for (int i = 0; i < 8; ++i) v[i] = *(const f32x4*)(src + (size_t)(k0 + w + 8 * i) * ldsrc + n0 + 4 * l);
#pragma unroll
    for (int i = 0; i < 8; ++i) *(LAS f32x4*)(tl + (w + 8 * i) * 260 + 4 * l) = v[i];
    __syncthreads();
    { const int n = t & 255, kh = t >> 8; const int row = MODE == 1 ? gu_row(n0 + n) : n0 + n; bf16_t* dp = dst + (size_t)row * ldd + k0 + kh * 32;
#pragma unroll
      for (int q = 0; q < 4; ++q) { float x[8];
#pragma unroll
          for (int j = 0; j < 8; ++j) x[j] = tl[(kh * 32 + 8 * q + j) * 260 + n];
          u32x4 o; o.x = cvt_pk_bf16(x[0], x[1]); o.y = cvt_pk_bf16(x[2], x[3]); o.z = cvt_pk_bf16(x[4], x[5]); o.w = cvt_pk_bf16(x[6], x[7]);
          *(u32x4*)(dp + 8 * q) = o; } }
    __syncthreads();
}
constexpr int CVT_NGU = NE * 16 * 8, CVT_NDN = NE * 16 * 4, CVT_JOBS = CVT_NGU + CVT_NDN;
__device__ __forceinline__ void cvt_moe_job(const Frame& F, LAS float* tl, const float* wgu, const float* wdn, int j) {
    bf16_t* WGU = WSP(bf16_t, WS_WGU); bf16_t* WDN = WSP(bf16_t, WS_WDN);
    if (j < CVT_NGU) { const int e = j >> 7, r = j & 127, kt = r >> 3, ntl = r & 7; cvt_blk<1>(F, tl, wgu + (size_t)e * 1024 * 2048, 2048, kt * 64, ntl * 256, WGU + (size_t)e * 2048 * 1024, 1024); }
    else { const int jj = j - CVT_NGU, e = jj >> 6, r = jj & 63, kt = r >> 2, ntl = r & 3; cvt_blk<0>(F, tl, wdn + (size_t)e * 1024 * 1024, 1024, kt * 64, ntl * 256, WDN + (size_t)e * 1024 * 1024, 1024); }
}
__device__ __forceinline__ void cvt_moe_weights(const Frame& F, LAS float* tl, const float* wgu, const float* wdn) {
    for (int j = F.bid; j < CVT_JOBS; j += F.G) cvt_moe_job(F, tl, wgu, wdn, j);
}
__device__ __forceinline__ void ph_prologue(const Frame& F) {
    LAS float* sc = (LAS float*)(F.ring);
    LAS float* red = (LAS float*)(F.ring + 36864);
    LAS float* ctab = (LAS float*)(F.ring + 55296);
    LAS float* stab = ctab + 4096;
    LAS bf16_t* tile = (LAS bf16_t*)(F.ring + 88064);
    LAS float* wt = (LAS float*)(F.ring + 97280);
    const int t = F.tid;
    for (int i = t; i < 9 * 1024; i += NTHR) { const int r = i >> 10, k = i & 1023; const float v = (r < 8) ? F.in[I_C][r * 1024 + k] : F.in[I_CCTX][k]; sc[i] = siluf(v); }
    for (int i = t; i < 4096; i += NTHR) { const float x = (float)i * (1.0f / 2048.0f); ctab[i] = cospif(x); stab[i] = sinpif(x); }
    __syncthreads();
    for (int u = F.bid; u < 2 * 96; u += F.G) {
        const int l = u / 96, j0 = (u % 96) * 64; const float* W = l ? F.in[I1_MODW] : F.in[I0_MODW]; const float* Bv = l ? F.in[I1_MODB] : F.in[I0_MODB];
        const int c4 = t & 15, kb = F.wave * 128 + ((t >> 4) & 3) * 32; f32x4 a[9];
#pragma unroll
        for (int r = 0; r < 9; ++r) a[r] = (f32x4){0.f, 0.f, 0.f, 0.f};
#pragma unroll 8
        for (int q = 0; q < 32; ++q) { const f32x4 w = *(const f32x4*)(W + (size_t)(kb + q) * 6144 + j0 + 4 * c4);
#pragma unroll
            for (int r = 0; r < 9; ++r) a[r] += w * sc[r * 1024 + kb + q]; }
#pragma unroll
        for (int r = 0; r < 9; ++r) {
#pragma unroll
            for (int j = 0; j < 4; ++j) { float v = a[r][j]; v += __shfl_xor(v, 16); v += __shfl_xor(v, 32); a[r][j] = v; }
            if ((t & 48) == 0) *(LAS f32x4*)(red + (F.wave * 9 + r) * 64 + 4 * c4) = a[r]; }
        __syncthreads();
        for (int i = t; i < 576; i += NTHR) { const int r = i >> 6, c = i & 63; float s = 0.f;
#pragma unroll
            for (int q = 0; q < 8; ++q) s += red[(q * 9 + r) * 64 + c];
            WSP(float, WS_MODV)[(size_t)(l * 9 + r) * 6144 + j0 + c] = s + Bv[j0 + c]; }
        __syncthreads();
    }
    if (F.bid == (1 % F.G)) { for (int i = t; i < 1024; i += NTHR) { const int pos = i >> 4, j = i & 15; const float inv = powf(10000.0f, -(float)j / 16.0f); const float ang = (float)pos * inv;
        WSP(float, WS_ROPE)[i] = cosf(ang); WSP(float, WS_ROPE)[1024 + i] = sinf(ang); } }
    { bf16_t* DFT = WSP(bf16_t, R0_DFT); bf16_t* DFTC = WSP(bf16_t, R0_DFTC);
      for (int k = F.bid; k < 4096 + 256; k += F.G) {
          if (k < 4096) { for (int jc = t; jc < 512; jc += NTHR) { const int j0 = jc * 8; float v[8];
#pragma unroll
                  for (int q = 0; q < 8; ++q) { const int j = j0 + q; const bool isS = j > 2048; const int idx = (k * (isS ? j - 2048 : j)) & 4095; v[q] = (isS ? stab[idx] : ctab[idx]) * (1.0f / 512.0f); }
                  u32x4 w; w.x = pk2(v[0], v[1]); w.y = pk2(v[2], v[3]); w.z = pk2(v[4], v[5]); w.w = pk2(v[6], v[7]); *(u32x4*)(DFT + (size_t)k * 4096 + j0) = w; } }
          else { const int kk = k - 4096; for (int jc = t; jc < 32; jc += NTHR) { const int j0 = jc * 8; float v[8];
#pragma unroll
                  for (int q = 0; q < 8; ++q) { const int j = j0 + q; const bool isS = j > 128; const int idx = ((kk * (isS ? j - 128 : j)) & 255) * 16; v[q] = (isS ? stab[idx] : ctab[idx]) * (1.0f / 128.0f); }
                  u32x4 w; w.x = pk2(v[0], v[1]); w.y = pk2(v[2], v[3]); w.z = pk2(v[4], v[5]); w.w = pk2(v[6], v[7]); *(u32x4*)(DFTC + (size_t)kk * 256 + j0) = w; } }
      } }
    { bf16_t* WF = WSP(bf16_t, WS_WF); const float* Win = F.in[I0_WIN];
      for (int j = (F.bid + 64) % F.G; j < 64; j += F.G) { const int k0 = (j >> 2) * 64, g = j & 3;
          for (int i = t; i < 4096; i += NTHR) { const int kl = i >> 6, c = i & 63; wt[kl * 65 + c] = Win[(size_t)(k0 + kl) * 960 + 704 + g * 64 + c]; }
          __syncthreads();
          { const int kl = t & 63, mg = t >> 6;
#pragma unroll 1
            for (int mm = 0; mm < 8; ++mm) { const int m = mg * 8 + mm; float ac = 0.f, as = 0.f;
                for (int c = 0; c < 64; ++c) { const int idx = ((m * c) & 63) * 64; const float w = wt[kl * 65 + c]; ac = fmaf(w, ctab[idx], ac); as = fmaf(w, stab[idx], as); }
                WF[(size_t)(g * 64 + m) * 1024 + k0 + kl] = f2bf(ac); WF[(size_t)(256 + g * 64 + m) * 1024 + k0 + kl] = f2bf(-as); } }
          __syncthreads(); } }
    for (int i = F.bid * NTHR + t; i < 2 * 32 * 1024; i += F.G * NTHR) { const int l = i >> 15, e = (i >> 10) & 31, k = i & 1023; const float w = (l ? F.in[I1_RW] : F.in[I0_RW])[k * 32 + e];
        const bf16_t hi = f2bf(w); const bf16_t lo = f2bf(w - bf2f(hi)); bf16_t* base = WSP(bf16_t, WS_RWT) + (size_t)l * 2 * 32 * 1024; base[e * 1024 + k] = hi; base[32 * 1024 + e * 1024 + k] = lo; }
    {
      constexpr int J_WIN0 = 16 * 11, J_WQ = 6 * 18, J_WKV = 4 * 24, J_WO = 16 * 16, J_WIN1 = 16 * 48;
      constexpr int JT = J_WIN0 + J_WQ + J_WKV + 2 * J_WO + J_WIN1;
      for (int j = F.bid; j < JT; j += F.G) { int r = j;
          if (r < J_WIN0) { cvt_tile<0>(F, tile, F.in[I0_WIN], 960, (r / 11) * 64, (r % 11) * 64, WSP(bf16_t, WS_WIN0), 1024, nullptr, 1.0f); continue; } r -= J_WIN0;
          if (r < J_WQ) { cvt_tile<0>(F, tile, F.in[I0_WQUP], 1152, (r / 18) * 64, (r % 18) * 64, WSP(bf16_t, WS_WQ), QL, F.in[I0_QNG], 1.0f); continue; } r -= J_WQ;
          if (r < J_WKV) { cvt_tile<0>(F, tile, F.in[I0_WKVUP], 1536, (r / 24) * 64, (r % 24) * 64, WSP(bf16_t, WS_WKV), KVL, F.in[I0_KVNG], 1.0f); continue; } r -= J_WKV;
          if (r < J_WO) { cvt_tile<0>(F, tile, F.in[I0_WOUT], 1024, (r / 16) * 64, (r % 16) * 64, WSP(bf16_t, WS_WOUT0), 1024, nullptr, 1.0f); continue; } r -= J_WO;
          if (r < J_WO) { cvt_tile<0>(F, tile, F.in[I1_WOUT], 1024, (r / 16) * 64, (r % 16) * 64, WSP(bf16_t, WS_WOUT1), 1024, nullptr, 1.0f); continue; } r -= J_WO;
          { const int n0 = (r % 48) * 64; cvt_tile<0>(F, tile, F.in[I1_WIN], 3104, (r / 48) * 64, n0, WSP(bf16_t, WS_WIN1), 1024, nullptr, n0 < 512 ? 0.08838834764831845f : 1.0f); }
      }
      for (int i = F.bid * NTHR + t; i < (64 * 1024 + 128 * QL) / 8; i += F.G * NTHR) { const u32x4 z = {0u, 0u, 0u, 0u};
          if (i < 64 * 1024 / 8) *(u32x4*)(WSP(bf16_t, WS_WIN0) + (size_t)704 * 1024 + (size_t)i * 8) = z; else *(u32x4*)(WSP(bf16_t, WS_WQ) + (size_t)1152 * QL + (size_t)(i - 64 * 1024 / 8) * 8) = z; }
    }
}

__device__ __forceinline__ const float* xrow_in(const Frame& F, int r) { return r < TC ? F.in[I_CTX] + (size_t)r * D : F.in[I_X] + (size_t)(r - TC) * D; }
__device__ __forceinline__ float* xrow_res(const Frame& F, int r) { return r < TC ? WSP(float, WS_XCTX) + (size_t)r * D : F.out + (size_t)(r - TC) * D; }
__device__ __forceinline__ bf16_t* xrow_b(const Frame& F, int r) { return WSP(bf16_t, R1_XB) + (size_t)(r - TC) * D; }
__device__ __forceinline__ int modrow(int r) { return r < TC ? 8 : ((r - TC) >> 12); }
__device__ __forceinline__ void ld16f(const float* p, int lane, float (&v)[16]) {
#pragma unroll
    for (int h = 0; h < 2; ++h) { const f32x4 a = *(const f32x4*)(p + 8 * lane + 512 * h), b = *(const f32x4*)(p + 8 * lane + 512 * h + 4);
        v[8 * h] = a[0]; v[8 * h + 1] = a[1]; v[8 * h + 2] = a[2]; v[8 * h + 3] = a[3]; v[8 * h + 4] = b[0]; v[8 * h + 5] = b[1]; v[8 * h + 6] = b[2]; v[8 * h + 7] = b[3]; }
}
__device__ __forceinline__ void st16f(float* p, int lane, const float (&v)[16]) {
#pragma unroll
    for (int h = 0; h < 2; ++h) { *(f32x4*)(p + 8 * lane + 512 * h) = (f32x4){v[8 * h], v[8 * h + 1], v[8 * h + 2], v[8 * h + 3]}; *(f32x4*)(p + 8 * lane + 512 * h + 4) = (f32x4){v[8 * h + 4], v[8 * h + 5], v[8 * h + 6], v[8 * h + 7]}; }
}
__device__ __forceinline__ void ld16b(const bf16_t* p, int lane, float (&v)[16]) {
#pragma unroll
    for (int h = 0; h < 2; ++h) { const u32x4 w = *(const u32x4*)(p + 8 * lane + 512 * h);
#pragma unroll
        for (int q = 0; q < 4; ++q) { v[8 * h + 2 * q] = __uint_as_float(w[q] << 16); v[8 * h + 2 * q + 1] = __uint_as_float(w[q] & 0xffff0000u); } }
}
__device__ __forceinline__ void st16b(bf16_t* p, int lane, const float (&v)[16]) {
#pragma unroll
    for (int h = 0; h < 2; ++h) { u32x4 w; w.x = cvt_pk_bf16(v[8 * h], v[8 * h + 1]); w.y = cvt_pk_bf16(v[8 * h + 2], v[8 * h + 3]); w.z = cvt_pk_bf16(v[8 * h + 4], v[8 * h + 5]); w.w = cvt_pk_bf16(v[8 * h + 6], v[8 * h + 7]);
        *(u32x4*)(p + 8 * lane + 512 * h) = w; }
}
__device__ __forceinline__ void modulate16(float (&v)[16], const float* g, const float* scale, const float* shift, int lane) {
    float ss = 0.f;
#pragma unroll
    for (int i = 0; i < 16; ++i) ss = fmaf(v[i], v[i], ss);
    const float rs = rsqrtf(wsum(ss) * (1.0f / D) + EPS);
    float gg[16], sc[16], sh[16]; ld16f(g, lane, gg); ld16f(scale, lane, sc); ld16f(shift, lane, sh);
#pragma unroll
    for (int i = 0; i < 16; ++i) v[i] = v[i] * rs * gg[i] * (1.0f + sc[i]) + sh[i];
}

__device__ __forceinline__ void ph_mod0(const Frame& F) {
    const float* g = F.in[I0_N1G]; bf16_t* H = WSP(bf16_t, WS_H);
    for (int r = F.bid * NWAVE + F.wave; r < T; r += F.G * NWAVE) {
        const float* mv = WSP(float, WS_MODV) + (size_t)modrow(r) * 6144;
        float v[16]; ld16f(xrow_in(F, r), F.lane, v);
        modulate16(v, g, mv + 1024, mv, F.lane);
        st16b(H + (size_t)r * D, F.lane, v);
    }
}
__device__ __forceinline__ void ph_rowstats(const Frame& F) {
    const bf16_t* U0 = WSP(bf16_t, R0_U0); float* rsq = WSP(float, WS_RS); float* rskv = rsq + T; bf16_t* KR = WSP(bf16_t, R0_KR);
    const float* rc = WSP(float, WS_ROPE); const float* rsn = rc + 1024;
    for (int r = F.bid * NWAVE + F.wave; r < T; r += F.G * NWAVE) {
        const bf16_t* u = U0 + (size_t)r * U0W; const int lane = F.lane;
        float a[8], b[8];
        { const u32x4 w = *(const u32x4*)(u + 8 * lane);
#pragma unroll
          for (int q = 0; q < 4; ++q) { a[2 * q] = __uint_as_float(w[q] << 16); a[2 * q + 1] = __uint_as_float(w[q] & 0xffff0000u); } }
        { u32x4 w = {0u, 0u, 0u, 0u}; if (lane < 32) w = *(const u32x4*)(u + 512 + 8 * lane);
#pragma unroll
          for (int q = 0; q < 4; ++q) { b[2 * q] = __uint_as_float(w[q] << 16); b[2 * q + 1] = __uint_as_float(w[q] & 0xffff0000u); } }
        float sa = 0.f, sb = 0.f;
#pragma unroll
        for (int j = 0; j < 8; ++j) { sa = fmaf(a[j], a[j], sa); sb = fmaf(b[j], b[j], sb); }
        const float sq = wsum(lane < 48 ? sa : 0.f), skv = wsum((lane >= 48 ? sa : 0.f) + (lane < 16 ? sb : 0.f));
        float pr[8];
#pragma unroll
        for (int j = 0; j < 8; ++j) pr[j] = __shfl_xor(b[j], 2);
        if (lane >= 16 && lane < 24) { const int jq = lane - 16, quarter = jq >> 1;
            if (r >= TC) { const int n = (r - TC) & 4095; const int pos = (quarter >= 2) ? (n & 63) : (n >> 6); const float* cp = rc + pos * 16 + (jq & 1) * 8; const float* sp = rsn + pos * 16 + (jq & 1) * 8;
#pragma unroll
                for (int j = 0; j < 8; ++j) b[j] = (quarter & 1) ? (b[j] * cp[j] + pr[j] * sp[j]) : (b[j] * cp[j] - pr[j] * sp[j]); }
            u32x4 w; w.x = cvt_pk_bf16(b[0], b[1]); w.y = cvt_pk_bf16(b[2], b[3]); w.z = cvt_pk_bf16(b[4], b[5]); w.w = cvt_pk_bf16(b[6], b[7]);
            *(u32x4*)(KR + (size_t)r * ROPE + 8 * jq) = w; }
        if (lane == 0) { rsq[r] = rsqrtf(sq * (1.0f / QL) + EPS); rskv[r] = rsqrtf(skv * (1.0f / KVL) + EPS); }
    }
    { const bf16_t* TT = WSP(bf16_t, R0_TT); const bf16_t* TTC = WSP(bf16_t, R0_TTC); bf16_t* TT2 = WSP(bf16_t, R0_TT2); bf16_t* TTC2 = WSP(bf16_t, R0_TTC2);
      const int nch_l = NB * 256 * 512, nch_c = NB * 256 * 32;
      for (int i = F.bid * NTHR + F.tid; i < nch_l + nch_c; i += F.G * NTHR) {
          const bool lat = i < nch_l; const int ii = lat ? i : i - nch_l; const int N = lat ? 4096 : 256; const int cpr = N >> 3; const int row = ii / cpr, p0 = (ii % cpr) * 8;
          const bf16_t* src = (lat ? TT : TTC) + (size_t)row * 2 * N; bf16_t* dst = (lat ? TT2 : TTC2) + (size_t)row * N + p0; float v[8];
#pragma unroll
          for (int q = 0; q < 8; ++q) { const int pp = p0 + q; const bool cs = pp <= (N >> 1); const int j = cs ? pp : pp - (N >> 1); const bf16_t* X = cs ? src : src + N;
              const float a = bf2f(X[j]); const float bmir = (j == 0 || j == (N >> 1)) ? 0.f : bf2f(X[N - j]); v[q] = cs ? a + bmir : a - bmir; }
          u32x4 w; w.x = pk2(v[0], v[1]); w.y = pk2(v[2], v[3]); w.z = pk2(v[4], v[5]); w.w = pk2(v[6], v[7]); *(u32x4*)dst = w; }
    }
}

namespace att {
typedef float f32x16 __attribute__((ext_vector_type(16)));
typedef short s16x4 __attribute__((ext_vector_type(4)));
constexpr float SCALE = 0.07216878364870322f, THR = 8.f;
constexpr int SHM_V = 16384, SHM_KN = 64 * 272, SHM_KR = 64 * 144, SHM_QW = 32 * 272;
constexpr int OFF_V = 0, OFF_KN = 2 * SHM_V, OFF_KR = OFF_KN + 2 * SHM_KN, OFF_WS = OFF_KR + 2 * SHM_KR, OFF_QR = OFF_WS + 2048;
#define KNSWZ(row, cb) ((row) * 272 + (cb))
#define KRSWZ(row, cb) ((row) * 144 + (cb))
#define SBAR() __builtin_amdgcn_sched_barrier(0)
__device__ __forceinline__ int crow(int r, int hi) { return (r & 3) + 8 * (r >> 2) + 4 * hi; }
__device__ __forceinline__ void partialSM(f32x16& p0, f32x16& p1, float& m_reg, float& mn, float& alpha) {
  constexpr float C = SCALE * 1.4426950408889634f;
  float pmax = p0[0];
#pragma unroll
  for (int r = 1; r < 16; ++r) pmax = fmaxf(pmax, p0[r]);
#pragma unroll
  for (int r = 0; r < 16; ++r) pmax = fmaxf(pmax, p1[r]);
  { auto rr = __builtin_amdgcn_permlane32_swap(__float_as_uint(pmax), __float_as_uint(pmax), false, false);
    pmax = fmaxf(__uint_as_float(rr[0]), __uint_as_float(rr[1])); }
  if (__builtin_expect(__all(pmax - m_reg <= THR / SCALE), 1)) { mn = m_reg; alpha = 1.f; }
  else { mn = fmaxf(m_reg, pmax); alpha = __builtin_amdgcn_exp2f((m_reg - mn) * C); m_reg = mn; }
  const float mnC = -mn * C;
#pragma unroll
  for (int r = 0; r < 16; ++r) p0[r] = fmaf(p0[r], C, mnC);
#pragma unroll
  for (int r = 0; r < 16; ++r) p1[r] = fmaf(p1[r], C, mnC);
#pragma unroll
  for (int r = 0; r < 16; ++r) p0[r] = __builtin_amdgcn_exp2f(p0[r]);
}
__device__ __forceinline__ void finishSM(f32x16& p0, f32x16& p1, float alpha, float& l_reg, bf16x8& pa0, bf16x8& pa1, bf16x8& pa2, bf16x8& pa3) {
#pragma unroll
  for (int r = 0; r < 16; ++r) p1[r] = __builtin_amdgcn_exp2f(p1[r]);
  float ps = 0;
#pragma unroll
  for (int r = 0; r < 16; ++r) ps += p0[r];
#pragma unroll
  for (int r = 0; r < 16; ++r) ps += p1[r];
  { auto rr = __builtin_amdgcn_permlane32_swap(__float_as_uint(ps), __float_as_uint(ps), false, false);
    ps = __uint_as_float(rr[0]) + __uint_as_float(rr[1]); }
  l_reg = l_reg * alpha + ps;
#define PK4(P, BASE, OUT) do { unsigned a0 = cvt_pk_bf16(P[BASE + 0], P[BASE + 1]), a1 = cvt_pk_bf16(P[BASE + 2], P[BASE + 3]);   \
    unsigned b0 = cvt_pk_bf16(P[BASE + 4], P[BASE + 5]), b1 = cvt_pk_bf16(P[BASE + 6], P[BASE + 7]);                              \
    auto r0 = __builtin_amdgcn_permlane32_swap(a0, b0, false, false); auto r1 = __builtin_amdgcn_permlane32_swap(a1, b1, false, false); \
    u32x4 w = {r0[0], r1[0], r0[1], r1[1]}; OUT = *reinterpret_cast<bf16x8*>(&w); } while (0)
  PK4(p0, 0, pa0); PK4(p0, 8, pa1); PK4(p1, 0, pa2); PK4(p1, 8, pa3);
#undef PK4
}
__device__ __forceinline__ void qkt(f32x16& p0, f32x16& p1, const LAS char* Kn, const LAS char* Kr, const bf16x8 (&qr)[4], const LAS char* Qr, int r32, int hi) {
  p0 = f32x16{}; p1 = f32x16{};
#pragma unroll
  for (int d0 = 0; d0 < 8; ++d0) { const int cb = (d0 * 16 + hi * 8) * 2;
    const bf16x8 b0 = *(const LAS bf16x8*)(Kn + KNSWZ(r32, cb));
    const bf16x8 b1 = *(const LAS bf16x8*)(Kn + KNSWZ(32 + r32, cb));
    bf16x8 qq; if (d0 < 4) qq = qr[d0]; else qq = *(const LAS bf16x8*)(Qr + KNSWZ(r32, ((d0 - 4) * 16 + hi * 8) * 2));
    p0 = __builtin_amdgcn_mfma_f32_32x32x16_bf16(b0, qq, p0, 0, 0, 0);
    p1 = __builtin_amdgcn_mfma_f32_32x32x16_bf16(b1, qq, p1, 0, 0, 0); }
#pragma unroll
  for (int d0 = 0; d0 < 4; ++d0) { const int cb = (d0 * 16 + hi * 8) * 2;
    const bf16x8 b0 = *(const LAS bf16x8*)(Kr + KRSWZ(r32, cb));
    const bf16x8 b1 = *(const LAS bf16x8*)(Kr + KRSWZ(32 + r32, cb));
    const bf16x8 qq = *(const LAS bf16x8*)(Qr + KNSWZ(r32, ((4 + d0) * 16 + hi * 8) * 2));
    p0 = __builtin_amdgcn_mfma_f32_32x32x16_bf16(b0, qq, p0, 0, 0, 0);
    p1 = __builtin_amdgcn_mfma_f32_32x32x16_bf16(b1, qq, p1, 0, 0, 0); }
}
__device__ __forceinline__ int v_st(int k, int c) { const int kk = (k & ~0xC) | ((k & 4) << 1) | ((k & 8) >> 1); return ((kk >> 3) * 4 + (c >> 5)) * 512 + ((kk & 7) * 32 + (c & 31)) * 2; }
__device__ __forceinline__ int v_rd_base(int lane) { return ((lane & 3) << 3) | (((lane >> 2) & 3) << 6) | (((lane >> 4) & 1) << 5) | (((lane >> 5) & 1) << 8); }
constexpr int v_rd_off(int d0, int ks, int half) { return d0 * 512 + ks * 4096 + half * 2048; }
template <int OFF> __device__ __forceinline__ s16x4 tr_read(int vb) {
  s16x4 r; asm volatile("ds_read_b64_tr_b16 %0, %1 offset:%2" : "=&v"(r) : "v"(vb), "i"(OFF) : "memory"); return r;
}
template <int D0> __device__ __forceinline__ void pv_one(f32x16& od, int vb, bf16x8 pa0, bf16x8 pa1, bf16x8 pa2, bf16x8 pa3) {
  const s16x4 l0 = tr_read<v_rd_off(D0, 0, 0)>(vb), h0 = tr_read<v_rd_off(D0, 0, 1)>(vb), l1 = tr_read<v_rd_off(D0, 1, 0)>(vb), h1 = tr_read<v_rd_off(D0, 1, 1)>(vb);
  const s16x4 l2 = tr_read<v_rd_off(D0, 2, 0)>(vb), h2 = tr_read<v_rd_off(D0, 2, 1)>(vb), l3 = tr_read<v_rd_off(D0, 3, 0)>(vb), h3 = tr_read<v_rd_off(D0, 3, 1)>(vb);
  asm volatile("s_waitcnt lgkmcnt(0)" ::: "memory"); SBAR();
#define PK(L, H) (bf16x8){L[0], L[1], L[2], L[3], H[0], H[1], H[2], H[3]}
  od = __builtin_amdgcn_mfma_f32_32x32x16_bf16(pa0, PK(l0, h0), od, 0, 0, 0);
  od = __builtin_amdgcn_mfma_f32_32x32x16_bf16(pa1, PK(l1, h1), od, 0, 0, 0);
  od = __builtin_amdgcn_mfma_f32_32x32x16_bf16(pa2, PK(l2, h2), od, 0, 0, 0);
  od = __builtin_amdgcn_mfma_f32_32x32x16_bf16(pa3, PK(l3, h3), od, 0, 0, 0);
#undef PK
}
__device__ __forceinline__ void pv_d0(f32x16 (&o)[4], int vb, bf16x8 pa0, bf16x8 pa1, bf16x8 pa2, bf16x8 pa3) {
  pv_one<0>(o[0], vb, pa0, pa1, pa2, pa3); pv_one<1>(o[1], vb, pa0, pa1, pa2, pa3); pv_one<2>(o[2], vb, pa0, pa1, pa2, pa3); pv_one<3>(o[3], vb, pa0, pa1, pa2, pa3);
}
__device__ __forceinline__ void attn_unit(const bf16_t* __restrict__ Q, const bf16_t* __restrict__ KV, const bf16_t* __restrict__ KR, bf16_t* __restrict__ MIX,
                                          const float* __restrict__ ropec, const float* __restrict__ ropes, int h, int qrow0, bool lat, int crow0, int lrow0, int NT, LAS char* lds) {
  int tid = threadIdx.x; asm volatile("" : "+v"(tid));
  const int wid = __builtin_amdgcn_readfirstlane(tid >> 6), lane = tid & 63, r32 = lane & 31, hi = lane >> 5;
  LAS char* V_lds = lds + OFF_V; LAS char* KN_lds = lds + OFF_KN; LAS char* KR_lds = lds + OFF_KR;
  LAS float* ws = (LAS float*)(lds + OFF_WS) + wid * 64; LAS float* li_l = ws; LAS float* al_l = ws + 32;
  float m_reg = -1e30f, l_reg = 0; f32x16 o[4] = {}; bf16x8 qr[4];
  LAS char* Qr = lds + OFF_QR + wid * SHM_QW;
  { const int qrow = qrow0 + wid * 32 + r32; const bf16_t* Qw = Q + (size_t)qrow * QW + h * QKD + hi * 8;
#pragma unroll
    for (int d0 = 0; d0 < 4; ++d0) qr[d0] = *(const bf16x8*)(Qw + d0 * 16);
#pragma unroll
    for (int d0 = 4; d0 < 8; ++d0) *(LAS bf16x8*)(Qr + KNSWZ(r32, ((d0 - 4) * 16 + hi * 8) * 2)) = *(const bf16x8*)(Qw + d0 * 16);
    const int n = (qrow - TC) & 4095;
#pragma unroll
    for (int ax = 0; ax < 2; ++ax) {
      const bf16x8 q1 = *(const bf16x8*)(Qw + (8 + 2 * ax) * 16), q2 = *(const bf16x8*)(Qw + (9 + 2 * ax) * 16);
      u32x4 w1 = *reinterpret_cast<const u32x4*>(&q1), w2 = *reinterpret_cast<const u32x4*>(&q2);
      if (lat) { const int pos = ax ? (n & 63) : (n >> 6); const float* cp = ropec + pos * 16 + hi * 8; const float* sp = ropes + pos * 16 + hi * 8;
#pragma unroll
        for (int j = 0; j < 4; ++j) { const float c0 = cp[2 * j], s0 = sp[2 * j], c1 = cp[2 * j + 1], s1 = sp[2 * j + 1];
          const float a0 = bf2f((bf16_t)q1[2 * j]), a1 = bf2f((bf16_t)q1[2 * j + 1]), b0 = bf2f((bf16_t)q2[2 * j]), b1 = bf2f((bf16_t)q2[2 * j + 1]);
          w1[j] = cvt_pk_bf16(a0 * c0 - b0 * s0, a1 * c1 - b1 * s1);
          w2[j] = cvt_pk_bf16(b0 * c0 + a0 * s0, b1 * c1 + a1 * s1); } }
      *(LAS u32x4*)(Qr + KNSWZ(r32, ((4 + 2 * ax) * 16 + hi * 8) * 2)) = w1; *(LAS u32x4*)(Qr + KNSWZ(r32, ((5 + 2 * ax) * 16 + hi * 8) * 2)) = w2; }
  }
  const int sr = tid >> 4, sc = (tid & 15) * 8, vst0 = v_st(sr, sc), vst1 = v_st(32 + sr, sc);
  const int rr = tid >> 3, rc = (tid & 7) * 8;
  const int vb0 = (int)(uintptr_t)V_lds + v_rd_base(lane);
  const bf16_t* KVh = KV + h * 256;
  const int nctx_t = lat ? 4 : NT;
  bf16x8 vs0, vs1, ks0, ks1, krs;
#define TROW(kt) ((kt) < nctx_t ? crow0 + (kt) * 64 : lrow0 + ((kt) - nctx_t) * 64)
#define SLOAD(kt) do { const int _r0 = TROW(kt); const bf16_t* _p0 = KVh + (size_t)(_r0 + sr) * KVW + sc; const bf16_t* _p1 = KVh + (size_t)(_r0 + 32 + sr) * KVW + sc; \
    vs0 = *(const bf16x8*)(_p0 + 128); vs1 = *(const bf16x8*)(_p1 + 128); ks0 = *(const bf16x8*)_p0; ks1 = *(const bf16x8*)_p1; krs = *(const bf16x8*)(KR + (size_t)(_r0 + rr) * ROPE + rc); } while (0)
#define SWRITE(b) do { *(LAS bf16x8*)(V_lds + (b) * SHM_V + vst0) = vs0; *(LAS bf16x8*)(V_lds + (b) * SHM_V + vst1) = vs1; \
    *(LAS bf16x8*)(KN_lds + (b) * SHM_KN + KNSWZ(sr, sc * 2)) = ks0; *(LAS bf16x8*)(KN_lds + (b) * SHM_KN + KNSWZ(32 + sr, sc * 2)) = ks1; \
    *(LAS bf16x8*)(KR_lds + (b) * SHM_KR + KRSWZ(rr, rc * 2)) = krs; } while (0)
#define SWAIT() asm volatile("s_waitcnt vmcnt(0)" ::: "memory")
#define RESC(a) do { if (__any((a) < 1.f)) { if (hi == 0) al_l[r32] = (a); asm volatile("s_waitcnt lgkmcnt(0)" ::: "memory"); \
    _Pragma("unroll") for (int d = 0; d < 4; ++d) _Pragma("unroll") for (int r = 0; r < 16; ++r) o[d][r] *= al_l[crow(r, hi)]; } } while (0)
  f32x16 pA0, pA1, pB0, pB1; float mnA, mnB, alA, alB; bf16x8 pa0, pa1, pa2, pa3;
  SLOAD(0); SWAIT(); SWRITE(0); __syncthreads();
  qkt(pA0, pA1, KN_lds, KR_lds, qr, Qr, r32, hi); partialSM(pA0, pA1, m_reg, mnA, alA);
  SLOAD(1); SWAIT(); SWRITE(1); __syncthreads();
  for (int j = 1; j + 1 < NT; j += 2) {
    SBAR(); qkt(pB0, pB1, KN_lds + SHM_KN, KR_lds + SHM_KR, qr, Qr, r32, hi);
    finishSM(pA0, pA1, alA, l_reg, pa0, pa1, pa2, pa3); SBAR();
    SLOAD(j + 1); SBAR();
    pv_d0(o, vb0, pa0, pa1, pa2, pa3); partialSM(pB0, pB1, m_reg, mnB, alB);
    __syncthreads(); SWAIT(); SWRITE(0);
    RESC(alB); __syncthreads();
    SBAR(); qkt(pA0, pA1, KN_lds, KR_lds, qr, Qr, r32, hi);
    finishSM(pB0, pB1, alB, l_reg, pa0, pa1, pa2, pa3); SBAR();
    SLOAD(j + 2); SBAR();
    pv_d0(o, vb0 + SHM_V, pa0, pa1, pa2, pa3); partialSM(pA0, pA1, m_reg, mnA, alA);
    __syncthreads(); SWAIT(); SWRITE(1);
    RESC(alA); __syncthreads();
  }
  SBAR(); qkt(pB0, pB1, KN_lds + SHM_KN, KR_lds + SHM_KR, qr, Qr, r32, hi);
  finishSM(pA0, pA1, alA, l_reg, pa0, pa1, pa2, pa3); SBAR();
  pv_d0(o, vb0, pa0, pa1, pa2, pa3); partialSM(pB0, pB1, m_reg, mnB, alB);
  __syncthreads(); RESC(alB);
  finishSM(pB0, pB1, alB, l_reg, pa0, pa1, pa2, pa3); SBAR();
  pv_d0(o, vb0 + SHM_V, pa0, pa1, pa2, pa3);
  if (hi == 0) li_l[r32] = l_reg; asm volatile("s_waitcnt lgkmcnt(0)" ::: "memory");
  float rli[16];
#pragma unroll
  for (int r = 0; r < 16; ++r) rli[r] = __builtin_amdgcn_rcpf(li_l[crow(r, hi)]);
  int tid2 = threadIdx.x; asm volatile("" : "+v"(tid2));
  const int r32e = tid2 & 31, hie = (tid2 >> 5) & 1;
#pragma unroll
  for (int r = 0; r < 16; ++r) { const int orow = crow(r, hie);
#pragma unroll
    for (int d0 = 0; d0 < 4; ++d0) *(LAS bf16_t*)(Qr + KNSWZ(orow, (d0 * 32 + r32e) * 2)) = f2bf(o[d0][r] * rli[r]); }
  { const int lane2 = tid2 & 63; bf16_t* Ow = MIX + (size_t)(qrow0 + wid * 32 + (lane2 >> 4)) * D + h * VD + (lane2 & 15) * 8;
#pragma unroll
    for (int i = 0; i < 8; ++i) { const u32x4 w = *(const LAS u32x4*)(Qr + KNSWZ((lane2 >> 4) + 4 * i, (lane2 & 15) * 16)); *(u32x4*)(Ow + (size_t)(4 * i) * D) = w; } }
  __syncthreads();
#undef TROW
#undef SLOAD
#undef SWRITE
#undef SWAIT
#undef RESC
}
}
constexpr int Q5_ATT = 768, Q5_DFT = Q5_ATT + 128, Q5_ATTC = Q5_DFT + 48, Q5_DFTC = Q5_ATTC + 8, Q5_END = Q5_DFTC + CVT_JOBS;
__device__ __forceinline__ void ph_queue5(const Frame& F) {
    unsigned* qhead = (unsigned*)(F.ws + WS_CTL + CW_Q5);
    LAS int* qslot = (LAS int*)(F.lds + 640);
    const bf16_t* Q = WSP(bf16_t, R0_Q); const bf16_t* KV = WSP(bf16_t, R0_KV); const bf16_t* KR = WSP(bf16_t, R0_KR); bf16_t* MIX = WSP(bf16_t, R0_MIX);
    const float* rc = WSP(float, WS_ROPE); const float* rs = rc + 1024;
    for (;;) {
        __syncthreads();
        if (F.tid == 0) qslot[0] = (int)__hip_atomic_fetch_add(qhead, 1u, __ATOMIC_RELAXED, __HIP_MEMORY_SCOPE_AGENT);
        __syncthreads();
        const int it = __builtin_amdgcn_readfirstlane(qslot[0]);
        if (it >= Q5_END) break;
        if (it < Q5_ATT) { const int b = it / 96, rem = it % 96, h = rem / 16, qb = rem % 16;
            att::attn_unit(Q, KV, KR, MIX, rc, rs, h, TC + b * 4096 + qb * 256, true, b * 256, TC + b * 4096, 68, (LAS char*)F.ring); }
        else if (it < Q5_DFT || (it >= Q5_ATTC && it < Q5_DFTC)) {
            const bool lat = it < Q5_DFT; const int i = lat ? it - Q5_ATT : it - Q5_ATTC; const int b = lat ? i >> 4 : i, pm = lat ? i & 15 : 0; const int K = lat ? 4096 : 256;
            pg8::OneUnit S; S.lda = K; S.u0.pm = pm; S.u0.pn = 0; S.u0.e = b; S.u0.cnt = 0;
            S.u0.A = (const char*)(lat ? WSP(bf16_t, R0_DFT) : WSP(bf16_t, R0_DFTC)) + (size_t)pm * 256 * K * 2;
            S.u0.B = (const char*)(lat ? WSP(bf16_t, R0_TT2) : WSP(bf16_t, R0_TTC2)) + (size_t)b * 256 * K * 2;
            pg8::EpiFourOut E{MIX, lat ? TC : 0, lat ? 4096 : 256};
            pg8::gemm_phase<pg8::EpiFourOut, pg8::OneUnit>(F.ring, pg8::Gemm{K, K, K}, S, E); }
        else if (it < Q5_ATTC) { const int uu = it - Q5_DFT, b = uu / 6, h = uu % 6;
            att::attn_unit(Q, KV, KR, MIX, rc, rs, h, b * 256, false, b * 256, 0, 4, (LAS char*)F.ring); }
        else cvt_moe_job(F, (LAS float*)F.ring, F.in[I0_WGU], F.in[I0_WDN], it - Q5_DFTC);
    }
}

__device__ __forceinline__ void load_w32(const Frame& F, LAS float* wl, const float* W, int ldw) {
    for (int i = F.tid; i < 1024 * 8; i += NTHR) { const int r = i >> 3, q = i & 7; const int c = 8 * (r & 63) + 512 * (r >> 9) + ((r >> 6) & 7); const f32x4 v = *(const f32x4*)(W + (size_t)c * ldw + q * 4); *(LAS f32x4*)(wl + r * 36 + q * 4) = v; }
}
__device__ __forceinline__ float row_gemv32(const float (&v)[16], const LAS float* wl, int lane) {
    float p[32];
#pragma unroll
    for (int e = 0; e < 32; ++e) p[e] = 0.f;
#pragma unroll
    for (int i = 0; i < 16; ++i) { const LAS float* wr_ = wl + (lane + 64 * i) * 36;
#pragma unroll
        for (int q = 0; q < 8; ++q) { const f32x4 w = *(const LAS f32x4*)(wr_ + q * 4); p[4 * q] = fmaf(v[i], w[0], p[4 * q]); p[4 * q + 1] = fmaf(v[i], w[1], p[4 * q + 1]); p[4 * q + 2] = fmaf(v[i], w[2], p[4 * q + 2]); p[4 * q + 3] = fmaf(v[i], w[3], p[4 * q + 3]); }
        asm volatile("" ::: "memory"); }
    float a16[16], a8[8], a4[4], a2[2];
    { const bool up = (lane & 32) != 0;
#pragma unroll
      for (int i = 0; i < 16; ++i) { const float send = up ? p[i] : p[i + 16], keep = up ? p[i + 16] : p[i]; a16[i] = keep + __shfl_xor(send, 32); } }
    { const bool up = (lane & 16) != 0;
#pragma unroll
      for (int i = 0; i < 8; ++i) { const float send = up ? a16[i] : a16[i + 8], keep = up ? a16[i + 8] : a16[i]; a8[i] = keep + __shfl_xor(send, 16); } }
    { const bool up = (lane & 8) != 0;
#pragma unroll
      for (int i = 0; i < 4; ++i) { const float send = up ? a8[i] : a8[i + 4], keep = up ? a8[i + 4] : a8[i]; a4[i] = keep + __shfl_xor(send, 8); } }
    { const bool up = (lane & 4) != 0;
#pragma unroll
      for (int i = 0; i < 2; ++i) { const float send = up ? a4[i] : a4[i + 2], keep = up ? a4[i + 2] : a4[i]; a2[i] = keep + __shfl_xor(send, 4); } }
    float a1; { const bool up = (lane & 2) != 0; const float send = up ? a2[0] : a2[1], keep = up ? a2[1] : a2[0]; a1 = keep + __shfl_xor(send, 2); }
    a1 += __shfl_xor(a1, 1);
    return a1;
}
__device__ __forceinline__ void row_gemv32x2(const float (&va)[16], const float (&vb)[16], const LAS float* wl, int lane, float& ya, float& yb) {
    float p[32], q[32];
#pragma unroll
    for (int e = 0; e < 32; ++e) { p[e] = 0.f; q[e] = 0.f; }
#pragma unroll
    for (int i = 0; i < 16; ++i) { const LAS float* wr_ = wl + (lane + 64 * i) * 36;
#pragma unroll
        for (int k = 0; k < 8; ++k) { const f32x4 w = *(const LAS f32x4*)(wr_ + k * 4);
            p[4 * k] = fmaf(va[i], w[0], p[4 * k]); p[4 * k + 1] = fmaf(va[i], w[1], p[4 * k + 1]); p[4 * k + 2] = fmaf(va[i], w[2], p[4 * k + 2]); p[4 * k + 3] = fmaf(va[i], w[3], p[4 * k + 3]);
            q[4 * k] = fmaf(vb[i], w[0], q[4 * k]); q[4 * k + 1] = fmaf(vb[i], w[1], q[4 * k + 1]); q[4 * k + 2] = fmaf(vb[i], w[2], q[4 * k + 2]); q[4 * k + 3] = fmaf(vb[i], w[3], q[4 * k + 3]); }
        asm volatile("" ::: "memory"); }
    float a16[16], b16[16], a8[8], b8[8], a4[4], b4[4], a2[2], b2[2];
    { const bool up = (lane & 32) != 0;
#pragma unroll
      for (int i = 0; i < 16; ++i) { a16[i] = (up ? p[i + 16] : p[i]) + __shfl_xor(up ? p[i] : p[i + 16], 32); b16[i] = (up ? q[i + 16] : q[i]) + __shfl_xor(up ? q[i] : q[i + 16], 32); } }
    { const bool up = (lane & 16) != 0;
#pragma unroll
      for (int i = 0; i < 8; ++i) { a8[i] = (up ? a16[i + 8] : a16[i]) + __shfl_xor(up ? a16[i] : a16[i + 8], 16); b8[i] = (up ? b16[i + 8] : b16[i]) + __shfl_xor(up ? b16[i] : b16[i + 8], 16); } }
    { const bool up = (lane & 8) != 0;
#pragma unroll
      for (int i = 0; i < 4; ++i) { a4[i] = (up ? a8[i + 4] : a8[i]) + __shfl_xor(up ? a8[i] : a8[i + 4], 8); b4[i] = (up ? b8[i + 4] : b8[i]) + __shfl_xor(up ? b8[i] : b8[i + 4], 8); } }
    { const bool up = (lane & 4) != 0;
#pragma unroll
      for (int i = 0; i < 2; ++i) { a2[i] = (up ? a4[i + 2] : a4[i]) + __shfl_xor(up ? a4[i] : a4[i + 2], 4); b2[i] = (up ? b4[i + 2] : b4[i]) + __shfl_xor(up ? b4[i] : b4[i + 2], 4); } }
    { const bool up = (lane & 2) != 0; ya = (up ? a2[1] : a2[0]) + __shfl_xor(up ? a2[0] : a2[1], 2); yb = (up ? b2[1] : b2[0]) + __shfl_xor(up ? b2[0] : b2[1], 2); }
    ya += __shfl_xor(ya, 1); yb += __shfl_xor(yb, 1);
}
__device__ __forceinline__ void ph_router(const Frame& F, int layer, int r0) {
    typedef float f32x16 __attribute__((ext_vector_type(16)));
    constexpr int HROW = 2064;
    LAS char* HHI = (LAS char*)F.ring; LAS char* HLO = HHI + 32 * HROW; LAS float* RED = (LAS float*)F.ring;
    LAS float* SCR = (LAS float*)(F.ring + 2 * 32 * HROW);
    LAS unsigned* lcnt = (LAS unsigned*)(F.lds + 512);
    const float* g = F.in[layer ? I1_N2G : I0_N2G]; const float* rb_ = F.in[layer ? I1_RB : I0_RB];
    if (F.tid < 64) lcnt[F.tid] = 0u;
    __syncthreads();
    bf16_t* H = WSP(bf16_t, WS_H); unsigned* cnt = (unsigned*)(F.ws + WS_CTL + CW_CNT) + layer * 64;
    int* list = WSP(int, WS_LIST); int* toke = WSP(int, WS_TOKE); int* tokp = WSP(int, WS_TOKP); float* tokg = WSP(float, WS_TOKG);
    const float* modv = WSP(float, WS_MODV) + (size_t)layer * 9 * 6144;
    const bf16_t* WT = WSP(bf16_t, WS_RWT) + (size_t)layer * 2 * 32 * 1024;
    const bf16_t* Yb = layer == 0 ? WSP(bf16_t, R0_U0) : WSP(bf16_t, R1_OB) - (size_t)TC * D;
    const int per = (T - r0 + F.G - 1) / F.G; const int rbeg = r0 + F.bid * per; const int rend = (rbeg + per < T) ? rbeg + per : T;
    const int lane = F.lane, wave = F.wave, r32 = lane & 31, hi2 = lane >> 5;
    float gg[16]; ld16f(g, lane, gg);
    float scv[16], shv[16]; int curm = -1;
    for (int tb = rbeg; tb < rend; tb += 32) {
        f32x4 xr[4][4]; u32x4 xq[4][2]; u32x4 yr[4][2];
#pragma unroll
        for (int q = 0; q < 4; ++q) { int r = tb + 4 * wave + q; r = r < rend ? r : rend - 1; const bf16_t* yp = Yb + (size_t)r * D;
            if (layer == 0) { const float* xp = xrow_in(F, r);
#pragma unroll
                for (int h = 0; h < 2; ++h) { xr[q][2 * h] = *(const f32x4*)(xp + 8 * lane + 512 * h); xr[q][2 * h + 1] = *(const f32x4*)(xp + 8 * lane + 512 * h + 4); } }
            else { const bf16_t* xp = xrow_b(F, r);
#pragma unroll
                for (int h = 0; h < 2; ++h) xq[q][h] = *(const u32x4*)(xp + 8 * lane + 512 * h); }
#pragma unroll
            for (int h = 0; h < 2; ++h) yr[q][h] = *(const u32x4*)(yp + 8 * lane + 512 * h); }
#pragma unroll
        for (int q = 0; q < 4; ++q) { const int tr = 4 * wave + q, r = tb + tr;
            if (r < rend) {
            float v[16];
#pragma unroll
            for (int h = 0; h < 2; ++h) {
#pragma unroll
                for (int k = 0; k < 4; ++k) { const float xa = layer == 0 ? xr[q][2 * h + (k >> 1)][2 * (k & 1)] : __uint_as_float(xq[q][h][k] << 16), xb = layer == 0 ? xr[q][2 * h + (k >> 1)][2 * (k & 1) + 1] : __uint_as_float(xq[q][h][k] & 0xffff0000u);
                    v[8 * h + 2 * k] = xa + __uint_as_float(yr[q][h][k] << 16); v[8 * h + 2 * k + 1] = xb + __uint_as_float(yr[q][h][k] & 0xffff0000u); } }
            if (layer == 0) { if (r < TC) st16f(xrow_res(F, r), lane, v); else st16b(xrow_b(F, r), lane, v); }
            else st16b(xrow_b(F, r), lane, v);
            float ss = 0.f;
#pragma unroll
            for (int i = 0; i < 16; ++i) ss = fmaf(v[i], v[i], ss);
            const float rs = rsqrtf(wsum(ss) * (1.0f / D) + EPS);
            const int m = modrow(r);
            if (m != curm) { const float* mv = modv + (size_t)m * 6144; ld16f(mv + 4096, lane, scv); ld16f(mv + 3072, lane, shv); curm = m; }
#pragma unroll
            for (int i = 0; i < 16; ++i) v[i] = v[i] * rs * gg[i] * (1.0f + scv[i]) + shv[i];
#pragma unroll
            for (int h = 0; h < 2; ++h) { u32x4 whi, wlo;
#pragma unroll
                for (int k = 0; k < 4; ++k) { const unsigned ph = cvt_pk_bf16(v[8 * h + 2 * k], v[8 * h + 2 * k + 1]); whi[k] = ph;
                    wlo[k] = cvt_pk_bf16(v[8 * h + 2 * k] - __uint_as_float(ph << 16), v[8 * h + 2 * k + 1] - __uint_as_float(ph & 0xffff0000u)); }
                *(u32x4*)(H + (size_t)r * D + 8 * lane + 512 * h) = whi;
                *(LAS u32x4*)(HHI + tr * HROW + (8 * lane + 512 * h) * 2) = whi; *(LAS u32x4*)(HLO + tr * HROW + (8 * lane + 512 * h) * 2) = wlo; } } }
        __syncthreads();
        f32x16 acc = {};
        { const LAS char* ah = HHI + r32 * HROW + (wave * 128 + hi2 * 8) * 2; const LAS char* al = HLO + r32 * HROW + (wave * 128 + hi2 * 8) * 2;
          const bf16_t* wh = WT + (size_t)r32 * 1024 + wave * 128 + hi2 * 8; const bf16_t* wlp = wh + 32 * 1024;
#pragma unroll
          for (int sst = 0; sst < 8; ++sst) { const bf16x8 a_h = *(const LAS bf16x8*)(ah + sst * 32), a_l = *(const LAS bf16x8*)(al + sst * 32);
              const bf16x8 b_h = *(const bf16x8*)(wh + sst * 16), b_l = *(const bf16x8*)(wlp + sst * 16);
              acc = __builtin_amdgcn_mfma_f32_32x32x16_bf16(a_h, b_h, acc, 0, 0, 0);
              acc = __builtin_amdgcn_mfma_f32_32x32x16_bf16(a_h, b_l, acc, 0, 0, 0);
              acc = __builtin_amdgcn_mfma_f32_32x32x16_bf16(a_l, b_h, acc, 0, 0, 0); } }
        __syncthreads();
#pragma unroll
        for (int r = 0; r < 16; ++r) { const int row = (r & 3) + 8 * (r >> 2) + 4 * hi2; RED[(wave * 32 + row) * 32 + r32] = acc[r]; }
        __syncthreads();
#pragma unroll 1
        for (int pq = 0; pq < 2; ++pq) { const int tr = 4 * wave + 2 * pq + hi2, r = tb + tr; const int e = r32;
            float lg = rb_[e];
#pragma unroll
            for (int w8 = 0; w8 < 8; ++w8) lg += RED[(w8 * 32 + tr) * 32 + e];
            LAS float* sc_ = SCR + tr * 40;
            sc_[e] = lg;
            asm volatile("s_waitcnt lgkmcnt(0)" ::: "memory");
            int rank = 0;
#pragma unroll
            for (int q8 = 0; q8 < 8; ++q8) { const f32x4 v4 = *(const LAS f32x4*)(sc_ + 4 * q8);
#pragma unroll
                for (int j = 0; j < 4; ++j) rank += (int)((v4[j] > lg) | ((v4[j] == lg) & ((4 * q8 + j) < e))); }
            if (rank < 4) { sc_[32 + rank] = lg; ((LAS int*)sc_)[36 + rank] = e; }
            asm volatile("s_waitcnt lgkmcnt(0)" ::: "memory");
            const f32x4 tvv = *(const LAS f32x4*)(sc_ + 32); const u32x4 tev = *(const LAS u32x4*)(sc_ + 36);
            asm volatile("s_waitcnt lgkmcnt(0)" ::: "memory");
            const float e1 = __expf(tvv[1] - tvv[0]), e2 = __expf(tvv[2] - tvv[0]), e3 = __expf(tvv[3] - tvv[0]); const float inv = 1.0f / (1.0f + e1 + e2 + e3);
            if (r32 < 4 && r < rend) { const int k = r32; const int ek = (int)(k == 0 ? tev[0] : k == 1 ? tev[1] : k == 2 ? tev[2] : tev[3]); const float gk = (k == 0 ? 1.0f : k == 1 ? e1 : k == 2 ? e2 : e3) * inv;
                const unsigned lp = __hip_atomic_fetch_add(lcnt + ek, 1u, __ATOMIC_RELAXED, __HIP_MEMORY_SCOPE_WORKGROUP);
                toke[r * 4 + k] = ek; tokp[r * 4 + k] = (int)lp; tokg[r * 4 + k] = gk; } }
        __syncthreads();
    }
    __syncthreads();
    if (F.tid < 32) { const unsigned c = lcnt[F.tid]; lcnt[32 + F.tid] = c ? __hip_atomic_fetch_add(cnt + F.tid, c, __ATOMIC_RELAXED, __HIP_MEMORY_SCOPE_AGENT) : 0u; }
    __syncthreads();
    for (int i = rbeg * 4 + F.tid; i < rend * 4; i += NTHR) {
        const int ek = __hip_atomic_load(toke + i, __ATOMIC_RELAXED, __HIP_MEMORY_SCOPE_AGENT); const int pos = __hip_atomic_load(tokp + i, __ATOMIC_RELAXED, __HIP_MEMORY_SCOPE_AGENT) + (int)lcnt[32 + ek]; tokp[i] = pos; list[(size_t)ek * T + pos] = i >> 2; }
}
__device__ __forceinline__ int moe_tstart(const Frame& F, int layer, LAS int* tstart) {
    unsigned* cnt = (unsigned*)(F.ws + WS_CTL + CW_CNT) + layer * 64;
    __syncthreads();
    if (F.tid == 0) { int s = 0; for (int e = 0; e < NE; ++e) { const int c = (int)__hip_atomic_load(cnt + e, __ATOMIC_RELAXED, __HIP_MEMORY_SCOPE_AGENT); tstart[e] = s; tstart[40 + e] = c; s += (c + 255) >> 8; } tstart[NE] = s; }
    __syncthreads();
    { LAS int* t2e = (LAS int*)(F.ring + 140000); const int nt = tstart[NE];
      for (int t = F.tid; t < nt; t += NTHR) { int e = 0; for (int j = 1; j < NE; ++j) e += (t >= tstart[j]) ? 1 : 0; t2e[t] = e; } }
    __syncthreads();
    return __builtin_amdgcn_readfirstlane(tstart[NE]);
}
__device__ __forceinline__ void ph_moe1(const Frame& F, int layer) {
    LAS int* tstart = (LAS int*)(F.lds + 64); const int ntile = moe_tstart(F, layer, tstart);
    pg8::MoeOrder<true> S; S.A = (const char*)WSP(bf16_t, WS_H); S.B = (const char*)WSP(bf16_t, WS_WGU); S.sB = (size_t)2048 * 1024 * 2; S.lda = D; S.ldb = D; S.npn = 8; S.nwg = ntile * 8; S.G = F.G; S.c = F.bid;
    S.tstart = tstart; S.cnt = tstart + 40; S.list = WSP(int, WS_LIST); S.t2e = (const LAS int*)(F.ring + 140000);
    pg8::EpiSwiglu E{WSP(bf16_t, WS_ACT), F.in[layer ? I1_BGU : I0_BGU]};
    pg8::gemm_phase<pg8::EpiSwiglu, pg8::MoeOrder<true>>(F.ring, pg8::Gemm{D, D, D}, S, E);
}
__device__ __forceinline__ void ph_moe2(const Frame& F, int layer) {
    LAS int* tstart = (LAS int*)(F.lds + 64); const int ntile = moe_tstart(F, layer, tstart);
    pg8::MoeOrder<false> S; S.A = (const char*)WSP(bf16_t, WS_ACT); S.B = (const char*)WSP(bf16_t, WS_WDN); S.sB = (size_t)1024 * 1024 * 2; S.lda = FF; S.ldb = FF; S.npn = 4; S.nwg = ntile * 4; S.G = F.G; S.c = F.bid;
    S.tstart = tstart; S.cnt = tstart + 40; S.list = nullptr; S.t2e = (const LAS int*)(F.ring + 140000);
    pg8::EpiDown E{WSP(bf16_t, RM_YB), F.in[layer ? I1_BDN : I0_BDN]};
    pg8::gemm_phase<pg8::EpiDown, pg8::MoeOrder<false>>(F.ring, pg8::Gemm{FF, FF, FF}, S, E);
}
__device__ __forceinline__ void moe_combine_row(const Frame& F, int layer, int r, const LAS int* tstart, float (&v)[16]) {
    const int* toke = WSP(int, WS_TOKE); const int* tokp = WSP(int, WS_TOKP); const float* tokg = WSP(float, WS_TOKG); const bf16_t* YB = WSP(bf16_t, RM_YB);
    const float* g2 = WSP(float, WS_MODV) + (size_t)(layer * 9 + modrow(r)) * 6144 + 5120;
    float y[16];
#pragma unroll
    for (int i = 0; i < 16; ++i) y[i] = 0.f;
#pragma unroll
    for (int k = 0; k < 4; ++k) { const int e = toke[r * 4 + k]; const size_t prow = (size_t)tstart[e] * 256 + tokp[r * 4 + k]; const float gk = tokg[r * 4 + k]; float yy[16]; ld16b(YB + prow * D, F.lane, yy);
#pragma unroll
        for (int i = 0; i < 16; ++i) y[i] = fmaf(gk, yy[i], y[i]); }
    float gg[16]; ld16f(g2, F.lane, gg); if (r >= TC) ld16b(xrow_b(F, r), F.lane, v); else ld16f(xrow_res(F, r), F.lane, v);
#pragma unroll
    for (int i = 0; i < 16; ++i) v[i] = fmaf(gg[i], y[i], v[i]);
}
__device__ __forceinline__ void ph_combine_mod1(const Frame& F) {
    LAS int* tstart = (LAS int*)(F.lds + 64); moe_tstart(F, 0, tstart);
    LAS float* wl = (LAS float*)F.ring;
    load_w32(F, wl, F.in[I1_WIN] + 3072, 3104);
    __syncthreads();
    const float* g = F.in[I1_N1G]; bf16_t* H = WSP(bf16_t, WS_H); float* GD = WSP(float, WS_GD);
    const float* modv = WSP(float, WS_MODV) + (size_t)9 * 6144;
    for (int r = F.bid * NWAVE + F.wave; r < T; r += F.G * NWAVE) {
        float v[16]; moe_combine_row(F, 0, r, tstart, v);
        const float* mv = modv + (size_t)modrow(r) * 6144;
        if (r < TC) st16f(xrow_res(F, r), F.lane, v); else st16b(xrow_b(F, r), F.lane, v);
        modulate16(v, g, mv + 1024, mv, F.lane);
        st16b(H + (size_t)r * D, F.lane, v);
        const float gd = row_gemv32(v, wl, F.lane);
        if ((F.lane & 1) == 0) GD[(size_t)r * 32 + (F.lane >> 1)] = gd;
    }
    __syncthreads();
    cvt_moe_weights(F, (LAS float*)F.ring, F.in[I1_WGU], F.in[I1_WDN]);
}
__device__ __forceinline__ void ph_final(const Frame& F) {
    LAS int* tstart = (LAS int*)(F.lds + 64); moe_tstart(F, 1, tstart);
    const float* g = F.in[I_FNG];
    for (int r = TC + F.bid * NWAVE + F.wave; r < T; r += F.G * NWAVE) {
        float v[16]; moe_combine_row(F, 1, r, tstart, v); float ss = 0.f;
#pragma unroll
        for (int i = 0; i < 16; ++i) ss = fmaf(v[i], v[i], ss);
        const float rs = rsqrtf(wsum(ss) * (1.0f / D) + EPS); float gg[16]; ld16f(g, F.lane, gg);
#pragma unroll
        for (int i = 0; i < 16; ++i) v[i] = v[i] * rs * gg[i];
        st16f(F.out + (size_t)(r - TC) * D, F.lane, v);
    }
}

namespace gla3 {
using att::f32x16; using att::s16x4; using att::crow; using att::v_st; using att::v_rd_base; using att::v_rd_off; using att::tr_read;
constexpr int ROWB = 272;
constexpr int P_GD = 0, P_TOT = 4096, P_WG = 8192;
constexpr int O_QD = 0, O_KD = 17408, O_KS = 34816, O_VV = 51200, O_ST = 67584, O_DEC = 102400;
constexpr size_t TILE_B = 64 * 128 * 2, ITEM_B = 2 * TILE_B;
#define GPK(L, H) (bf16x8){L[0], L[1], L[2], L[3], H[0], H[1], H[2], H[3]}
#define CH_ROW0(b, dir, cc) ((cc) < 4 ? ((b) * 256 + ((dir) ? 3 - (cc) : (cc)) * 64) : (TC + (b) * 4096 + ((dir) ? 67 - (cc) : (cc) - 4) * 64))
#define TOK(dir, jj) ((dir) ? 63 - (jj) : (jj))
__device__ __forceinline__ void pre_phase(const Frame& F) {
  LAS char* lds = (LAS char*)F.ring;
  int tid = threadIdx.x; asm volatile("" : "+v"(tid));
  const int wid = __builtin_amdgcn_readfirstlane(tid >> 6), lane = tid & 63;
  LAS float* gds = (LAS float*)(lds + P_GD); LAS float* tot = (LAS float*)(lds + P_TOT); LAS float* wgall = (LAS float*)(lds + P_WG);
  const bf16_t* U1 = WSP(bf16_t, R1_U1); const float* GD = WSP(float, WS_GD);
  char* tiles = (char*)(F.ws + WS_ACT); float* decbuf = (float*)(F.ws + WS_ACT + (size_t)4352 * ITEM_B);
  for (int i = tid; i < 8 * 17 * 128; i += NTHR) { const int tb = i / (17 * 128), rem = i % (17 * 128), r = rem >> 7, d = rem & 127, hd = tb >> 1, dir = tb & 1;
    const float* Wg = dir ? F.in[I1_WGKB] : F.in[I1_WGKF]; const float* Bg = dir ? F.in[I1_BGKB] : F.in[I1_BGKF]; wgall[i] = (r < 16) ? Wg[r * 512 + hd * 128 + d] : Bg[hd * 128 + d]; }
  const int d0 = 2 * lane, tg = wid, gj = tid >> 3, gr = (tid & 7) * 2;
  unsigned qreg[8], kreg[8]; f32x2 gdreg;
#define PLOAD(u) do { const int _cc = (u) % 68, _s = (u) / 68, _dir = _s & 1, _hd = (_s >> 1) & 3, _b = _s >> 3; const int _r0 = CH_ROW0(_b, _dir, _cc); \
    const bf16_t* _uq = U1 + _hd * 128 + d0; \
    _Pragma("unroll") for (int i = 0; i < 8; ++i) { const bf16_t* _p = _uq + (size_t)(_r0 + TOK(_dir, 8 * tg + i)) * U1W; qreg[i] = *(const unsigned*)_p; kreg[i] = *(const unsigned*)(_p + 512); } \
    gdreg = *(const f32x2*)(GD + (size_t)(_r0 + TOK(_dir, gj)) * 32 + _dir * 16 + gr); } while (0)
  int u = F.bid;
  if (u < 4352) PLOAD(u);
  __syncthreads();
  for (; u < 4352; u += F.G) {
    const int sc = u / 68, dir = sc & 1, hd = (sc >> 1) & 3;
    const LAS float* wg = wgall + (hd * 2 + dir) * 17 * 128;
    *(LAS f32x2*)(gds + gj * 16 + gr) = gdreg;
    __syncthreads();
    float cl0[8], cl1[8];
    { float z0[8], z1[8]; const f32x2 bb = *(const LAS f32x2*)(wg + 16 * 128 + d0);
#pragma unroll
      for (int i = 0; i < 8; ++i) { z0[i] = bb[0]; z1[i] = bb[1]; }
#pragma unroll
      for (int r4 = 0; r4 < 4; ++r4) { f32x2 w[4];
#pragma unroll
        for (int q = 0; q < 4; ++q) w[q] = *(const LAS f32x2*)(wg + (4 * r4 + q) * 128 + d0);
#pragma unroll
        for (int i = 0; i < 8; ++i) { const f32x4 g4 = *(const LAS f32x4*)(gds + (8 * tg + i) * 16 + 4 * r4);
#pragma unroll
          for (int q = 0; q < 4; ++q) { z0[i] = fmaf(g4[q], w[q][0], z0[i]); z1[i] = fmaf(g4[q], w[q][1], z1[i]); } } }
      float a0 = 0.f, a1 = 0.f;
#pragma unroll
      for (int i = 0; i < 8; ++i) { const float l0 = fminf(z0[i], 0.f) - __logf(1.0f + __expf(-fabsf(z0[i]))), l1 = fminf(z1[i], 0.f) - __logf(1.0f + __expf(-fabsf(z1[i])));
        a0 += l0 * (1.0f / 16.0f); a1 += l1 * (1.0f / 16.0f); cl0[i] = a0; cl1[i] = a1; }
      *(LAS f32x2*)(tot + tg * 128 + d0) = (f32x2){a0, a1}; }
    __syncthreads();
    { float off0 = 0.f, off1 = 0.f, last0 = 0.f, last1 = 0.f;
#pragma unroll
      for (int g = 0; g < 8; ++g) { const f32x2 tv = *(const LAS f32x2*)(tot + g * 128 + d0); if (g < tg) { off0 += tv[0]; off1 += tv[1]; } last0 += tv[0]; last1 += tv[1]; }
      const float el0 = __expf(last0), el1 = __expf(last1);
      if (tg == 0) *(f32x2*)(decbuf + (size_t)u * 128 + d0) = (f32x2){el0, el1};
      char* it = tiles + (size_t)u * ITEM_B + d0 * 2;
#pragma unroll
      for (int i = 0; i < 8; ++i) { const int jj = 8 * tg + i; const float e0 = __expf(off0 + cl0[i]), e1 = __expf(off1 + cl1[i]); const float r0 = __builtin_amdgcn_rcpf(e0), r1 = __builtin_amdgcn_rcpf(e1);
        const float q0 = __uint_as_float(qreg[i] << 16), q1 = __uint_as_float(qreg[i] & 0xffff0000u), k0 = __uint_as_float(kreg[i] << 16), k1 = __uint_as_float(kreg[i] & 0xffff0000u);
        *(unsigned*)(it + jj * 256) = cvt_pk_bf16(q0 * e0, q1 * e1);
        *(unsigned*)(it + TILE_B + jj * 256) = cvt_pk_bf16(k0 * r0, k1 * r1); } }
    if (u + F.G < 4352) PLOAD(u + F.G);
    __syncthreads();
  }
#undef PLOAD
}
constexpr int SB_QD = 0, SB_KD = 16384, SB_VV = 32768, SB_DEC = 40960, SB_BYTES = 41984, O_ST2 = 3 * SB_BYTES;
constexpr int vc_off(int d0, int ks, int half) { return d0 * 512 + ks * 2048 + half * 1024; }
struct SeqCtx { LAS char* lds; const char* tiles; const char* decb; const bf16_t* Uv; bf16_t* OUT; unsigned sQ[2], sK[2], ldsw; int vk, b, dir, hd, dvs, wid, lane, r32, hi, trb, xq, eb, db, kdo; };
#define DMA16(gptr, ldsoff) __builtin_amdgcn_global_load_lds((const unsigned*)(gptr), (LAS unsigned*)(C.lds + (ldsoff)), 16, 0, 0)
__device__ __forceinline__ void seq_issue(const SeqCtx& C, int cc) {
    const int bo = (cc % 3) * SB_BYTES; const char* t = C.tiles + (size_t)cc * ITEM_B;
    DMA16(t + C.sQ[0], bo + SB_QD + C.ldsw); DMA16(t + C.sQ[1], bo + SB_QD + 8192 + C.ldsw);
    DMA16(t + TILE_B + C.sK[0], bo + SB_KD + C.ldsw); DMA16(t + TILE_B + C.sK[1], bo + SB_KD + 8192 + C.ldsw);
    DMA16(C.Uv + (size_t)(CH_ROW0(C.b, C.dir, cc) + TOK(C.dir, C.vk)) * U1W, bo + SB_VV + C.ldsw);
    if (C.wid == 7) DMA16(C.decb + (size_t)cc * 512 + C.lane * 16, bo + SB_DEC);
}
#undef DMA16
template <int IB> __device__ __forceinline__ void seq_out_loop(const SeqCtx& C) {
  const int r32 = C.r32, hi = C.hi, xq = C.xq;
  for (int cc = 0; cc < 68; ++cc) {
    if (cc >= 6 && cc < 67) asm volatile("s_waitcnt vmcnt(37)" ::: "memory"); else if (cc >= 1 && cc < 67) asm volatile("s_waitcnt vmcnt(5)" ::: "memory"); else asm volatile("s_waitcnt vmcnt(0)" ::: "memory");
    asm volatile("s_waitcnt lgkmcnt(0)" ::: "memory");
    __builtin_amdgcn_s_barrier();
    asm volatile("" ::: "memory");
    if (cc + 2 < 68) seq_issue(C, cc + 2);
    if (cc < 4) continue;
    const LAS char* sb = C.lds + (cc % 3) * SB_BYTES;
    const LAS char* STp = C.lds + O_ST2 + ((cc + 1) & 1) * 17408;
    f32x16 p0 = {}, p1 = {}, o = {};
    const LAS char* QDr = sb + SB_QD + (32 * IB + r32) * 256; const LAS char* KDr = sb + SB_KD + C.kdo;
#pragma unroll
    for (int k = 0; k < 8; ++k) { const int po = (k << 5) ^ xq; const bf16x8 qf = *(const LAS bf16x8*)(QDr + po); const bf16x8 k0f = *(const LAS bf16x8*)(KDr + (k >> 1) * 512 + (k & 1) * 32);
      p0 = __builtin_amdgcn_mfma_f32_32x32x16_bf16(k0f, qf, p0, 0, 0, 0);
      if (IB) { const bf16x8 k1f = *(const LAS bf16x8*)(KDr + 8192 + (k >> 1) * 512 + (k & 1) * 32); p1 = __builtin_amdgcn_mfma_f32_32x32x16_bf16(k1f, qf, p1, 0, 0, 0); } }
#pragma unroll
    for (int r = 0; r < 16; ++r) { const bool kill = crow(r, hi) > r32; if (IB == 0) p0[r] = kill ? 0.f : p0[r]; else p1[r] = kill ? 0.f : p1[r]; }
    bf16x8 pa0, pa1, pa2, pa3;
#define PK4(P, BASE, OUT_) do { unsigned a0 = cvt_pk_bf16(P[BASE + 0], P[BASE + 1]), a1 = cvt_pk_bf16(P[BASE + 2], P[BASE + 3]);   \
    unsigned b0 = cvt_pk_bf16(P[BASE + 4], P[BASE + 5]), b1 = cvt_pk_bf16(P[BASE + 6], P[BASE + 7]);                              \
    auto r0 = __builtin_amdgcn_permlane32_swap(a0, b0, false, false); auto r1 = __builtin_amdgcn_permlane32_swap(a1, b1, false, false); \
    u32x4 w = {r0[0], r1[0], r0[1], r1[1]}; OUT_ = *reinterpret_cast<bf16x8*>(&w); } while (0)
    PK4(p0, 0, pa0); PK4(p0, 8, pa1); if (IB) { PK4(p1, 0, pa2); PK4(p1, 8, pa3); }
#undef PK4
    { const int vb = (int)(uintptr_t)(sb + SB_VV) + C.trb + C.eb * 512;
      const s16x4 l0 = tr_read<vc_off(0, 0, 0)>(vb), h0 = tr_read<vc_off(0, 0, 1)>(vb), l1 = tr_read<vc_off(0, 1, 0)>(vb), h1 = tr_read<vc_off(0, 1, 1)>(vb);
      s16x4 l2, h2, l3, h3;
      if (IB) { l2 = tr_read<vc_off(0, 2, 0)>(vb); h2 = tr_read<vc_off(0, 2, 1)>(vb); l3 = tr_read<vc_off(0, 3, 0)>(vb); h3 = tr_read<vc_off(0, 3, 1)>(vb); }
      asm volatile("s_waitcnt lgkmcnt(0)" ::: "memory"); __builtin_amdgcn_sched_barrier(0);
      o = __builtin_amdgcn_mfma_f32_32x32x16_bf16(pa0, GPK(l0, h0), o, 0, 0, 0);
      o = __builtin_amdgcn_mfma_f32_32x32x16_bf16(pa1, GPK(l1, h1), o, 0, 0, 0);
      if (IB) { o = __builtin_amdgcn_mfma_f32_32x32x16_bf16(pa2, GPK(l2, h2), o, 0, 0, 0);
                o = __builtin_amdgcn_mfma_f32_32x32x16_bf16(pa3, GPK(l3, h3), o, 0, 0, 0); } }
    { const LAS char* STr = STp + (32 * C.eb + r32) * ROWB + hi * 16;
#pragma unroll
      for (int k = 0; k < 8; ++k) { const bf16x8 qf = *(const LAS bf16x8*)(QDr + ((k << 5) ^ xq)); const bf16x8 sf = *(const LAS bf16x8*)(STr + k * 32);
        o = __builtin_amdgcn_mfma_f32_32x32x16_bf16(qf, sf, o, 0, 0, 0); } }
    bf16_t* op = C.OUT + (size_t)(CH_ROW0(C.b, C.dir, cc) - TC) * D + C.hd * 256 + C.dvs * 64 + 32 * C.eb + r32;
#pragma unroll
    for (int r = 0; r < 16; ++r) { const int i = 32 * IB + crow(r, hi); op[(size_t)TOK(C.dir, i) * D] = f2bf(o[r]); }
  }
}
__device__ __forceinline__ void seq_state_loop(const SeqCtx& C) {
  const int r32 = C.r32, hi = C.hi, db = C.db;
  f32x16 S0 = {}, S1 = {};
  for (int cc = 0; cc < 68; ++cc) {
    if (cc >= 1 && cc < 67) { if (C.wid == 7) asm volatile("s_waitcnt vmcnt(6)" ::: "memory"); else asm volatile("s_waitcnt vmcnt(5)" ::: "memory"); } else asm volatile("s_waitcnt vmcnt(0)" ::: "memory");
    asm volatile("s_waitcnt lgkmcnt(0)" ::: "memory");
    __builtin_amdgcn_s_barrier();
    asm volatile("" ::: "memory");
    if (cc + 2 < 68) seq_issue(C, cc + 2);
    const LAS char* sb = C.lds + (cc % 3) * SB_BYTES;
    LAS char* STn = C.lds + O_ST2 + (cc & 1) * 17408;
    const int kb = (int)(uintptr_t)(sb + SB_KD) + C.trb + db * 512, vb = (int)(uintptr_t)(sb + SB_VV) + C.trb;
    { const s16x4 al0 = tr_read<v_rd_off(0, 0, 0)>(kb), ah0 = tr_read<v_rd_off(0, 0, 1)>(kb), al1 = tr_read<v_rd_off(0, 1, 0)>(kb), ah1 = tr_read<v_rd_off(0, 1, 1)>(kb);
      const s16x4 al2 = tr_read<v_rd_off(0, 2, 0)>(kb), ah2 = tr_read<v_rd_off(0, 2, 1)>(kb), al3 = tr_read<v_rd_off(0, 3, 0)>(kb), ah3 = tr_read<v_rd_off(0, 3, 1)>(kb);
      const s16x4 bl0 = tr_read<vc_off(0, 0, 0)>(vb), bh0 = tr_read<vc_off(0, 0, 1)>(vb), bl1 = tr_read<vc_off(0, 1, 0)>(vb), bh1 = tr_read<vc_off(0, 1, 1)>(vb);
      const s16x4 bl2 = tr_read<vc_off(0, 2, 0)>(vb), bh2 = tr_read<vc_off(0, 2, 1)>(vb), bl3 = tr_read<vc_off(0, 3, 0)>(vb), bh3 = tr_read<vc_off(0, 3, 1)>(vb);
      const s16x4 cl0_ = tr_read<vc_off(1, 0, 0)>(vb), ch0 = tr_read<vc_off(1, 0, 1)>(vb), cl1_ = tr_read<vc_off(1, 1, 0)>(vb), ch1 = tr_read<vc_off(1, 1, 1)>(vb);
      const s16x4 cl2 = tr_read<vc_off(1, 2, 0)>(vb), ch2 = tr_read<vc_off(1, 2, 1)>(vb), cl3 = tr_read<vc_off(1, 3, 0)>(vb), ch3 = tr_read<vc_off(1, 3, 1)>(vb);
      asm volatile("s_waitcnt lgkmcnt(0)" ::: "memory"); __builtin_amdgcn_sched_barrier(0);
      S0 = __builtin_amdgcn_mfma_f32_32x32x16_bf16(GPK(al0, ah0), GPK(bl0, bh0), S0, 0, 0, 0); S1 = __builtin_amdgcn_mfma_f32_32x32x16_bf16(GPK(al0, ah0), GPK(cl0_, ch0), S1, 0, 0, 0);
      S0 = __builtin_amdgcn_mfma_f32_32x32x16_bf16(GPK(al1, ah1), GPK(bl1, bh1), S0, 0, 0, 0); S1 = __builtin_amdgcn_mfma_f32_32x32x16_bf16(GPK(al1, ah1), GPK(cl1_, ch1), S1, 0, 0, 0);
      S0 = __builtin_amdgcn_mfma_f32_32x32x16_bf16(GPK(al2, ah2), GPK(bl2, bh2), S0, 0, 0, 0); S1 = __builtin_amdgcn_mfma_f32_32x32x16_bf16(GPK(al2, ah2), GPK(cl2, ch2), S1, 0, 0, 0);
      S0 = __builtin_amdgcn_mfma_f32_32x32x16_bf16(GPK(al3, ah3), GPK(bl3, bh3), S0, 0, 0, 0); S1 = __builtin_amdgcn_mfma_f32_32x32x16_bf16(GPK(al3, ah3), GPK(cl3, ch3), S1, 0, 0, 0); }
#pragma unroll
    for (int g = 0; g < 4; ++g) { const f32x4 dc = *(const LAS f32x4*)(sb + SB_DEC + (32 * db + 8 * g + 4 * hi) * 4);
                                  S0[4 * g] *= dc[0]; S0[4 * g + 1] *= dc[1]; S0[4 * g + 2] *= dc[2]; S0[4 * g + 3] *= dc[3];
                                  S1[4 * g] *= dc[0]; S1[4 * g + 1] *= dc[1]; S1[4 * g + 2] *= dc[2]; S1[4 * g + 3] *= dc[3]; }
#pragma unroll
    for (int g = 0; g < 4; ++g) { u32x2 w0, w1; w0.x = cvt_pk_bf16(S0[4 * g], S0[4 * g + 1]); w0.y = cvt_pk_bf16(S0[4 * g + 2], S0[4 * g + 3]); w1.x = cvt_pk_bf16(S1[4 * g], S1[4 * g + 1]); w1.y = cvt_pk_bf16(S1[4 * g + 2], S1[4 * g + 3]);
      *(LAS u32x2*)(STn + r32 * ROWB + (32 * db + 8 * g + 4 * hi) * 2) = w0; *(LAS u32x2*)(STn + (32 + r32) * ROWB + (32 * db + 8 * g + 4 * hi) * 2) = w1; }
  }
}
__device__ __forceinline__ void seq_unit(const Frame& F, int b, int hd, int dir, int dvs, LAS char* lds) {
  int tid = threadIdx.x; asm volatile("" : "+v"(tid));
  SeqCtx C; C.lds = lds; C.wid = __builtin_amdgcn_readfirstlane(tid >> 6); C.lane = tid & 63; C.r32 = C.lane & 31; C.hi = C.lane >> 5; C.b = b; C.dir = dir; C.hd = hd; C.dvs = dvs;
  const int sc = (b * 4 + hd) * 2 + dir;
  C.OUT = WSP(bf16_t, dir ? R1_OB : R1_OF);
  C.tiles = (const char*)(F.ws + WS_ACT) + (size_t)sc * 68 * ITEM_B; C.decb = (const char*)(F.ws + WS_ACT + (size_t)4352 * ITEM_B) + (size_t)sc * 68 * 512;
  for (int i = tid; i < 2 * 17408 / 4; i += NTHR) ((LAS unsigned*)(lds + O_ST2))[i] = 0u;
  int vcol;
#pragma unroll
  for (int rd = 0; rd < 2; ++rd) { const int o = rd * 8192 + C.wid * 1024 + C.lane * 16;
    { const int row = o >> 8, slot = (o >> 4) & 15; C.sQ[rd] = (unsigned)(row * 256 + ((slot ^ (row & 15)) << 4)); }
    { const int sub = o >> 9, kkhi = sub >> 2, cblk = sub & 3, w = (o & 511) >> 1, kklo = w >> 5, cin = w & 31; const int kk = kkhi * 8 + kklo; const int k = (kk & ~0xC) | ((kk & 4) << 1) | ((kk & 8) >> 1);
      C.sK[rd] = (unsigned)(k * 256 + (cblk * 32 + cin) * 2); } }
  { const int o = C.wid * 1024 + C.lane * 16; const int sub = o >> 9, kkhi = sub >> 1, cblk = sub & 1, w = (o & 511) >> 1, kklo = w >> 5, cin = w & 31; const int kk = kkhi * 8 + kklo;
    C.vk = (kk & ~0xC) | ((kk & 4) << 1) | ((kk & 8) >> 1); vcol = cblk * 32 + cin; }
  C.Uv = WSP(bf16_t, R1_U1) + 1024 + hd * 256 + dvs * 64 + vcol;
  C.ldsw = (unsigned)C.wid * 1024u;
  C.eb = C.wid & 1; C.db = C.wid & 3; C.trb = v_rd_base(C.lane); C.xq = ((C.r32 & 15) ^ C.hi) << 4;
  { const int j = C.r32, kk = (j & ~0xC) | ((j & 4) << 1) | ((j & 8) >> 1); C.kdo = (kk >> 3) * 2048 + (kk & 7) * 64 + C.hi * 16; }
  seq_issue(C, 0); seq_issue(C, 1);
  if (C.wid < 4) { if (C.wid & 2) seq_out_loop<1>(C); else seq_out_loop<0>(C); }
  else seq_state_loop(C);
  asm volatile("s_waitcnt vmcnt(0) lgkmcnt(0)" ::: "memory");
  __builtin_amdgcn_s_barrier();
}
__device__ __forceinline__ void seq_phase(const Frame& F) {
  for (int un = F.bid; un < 256; un += F.G) {
    const int dvs = un & 3, sc = un >> 2, dir = sc & 1, hd = (sc >> 1) & 3, b = sc >> 3;
    __syncthreads();
    seq_unit(F, b, hd, dir, dvs, (LAS char*)F.ring);
  }
}
#undef GPK
#undef CH_ROW0
#undef TOK
}

__device__ __forceinline__ void ph_gla_out(const Frame& F) {
    const bf16_t* OF = WSP(bf16_t, R1_OF); const bf16_t* OB = WSP(bf16_t, R1_OB); const bf16_t* U1 = WSP(bf16_t, R1_U1); bf16_t* MIX = WSP(bf16_t, R1_OF); const float* gn = F.in[I1_GNG];
    for (int rl = F.bid * NWAVE + F.wave; rl < TL; rl += F.G * NWAVE) {
        float o[16], ob[16], go[16]; ld16b(OF + (size_t)rl * D, F.lane, o); ld16b(OB + (size_t)rl * D, F.lane, ob); ld16b(U1 + (size_t)(TC + rl) * U1W + 2048, F.lane, go);
        float s0 = 0.f, s1 = 0.f;
#pragma unroll
        for (int i = 0; i < 8; ++i) { o[i] += ob[i]; o[8 + i] += ob[8 + i]; s0 = fmaf(o[i], o[i], s0); s1 = fmaf(o[8 + i], o[8 + i], s1); }
        for (int k = 16; k >= 1; k >>= 1) { s0 += __shfl_xor(s0, k); s1 += __shfl_xor(s1, k); }
        const float r0 = rsqrtf(s0 * (1.0f / 256.0f) + EPS), r1 = rsqrtf(s1 * (1.0f / 256.0f) + EPS);
        const float* gp = gn + ((8 * F.lane) & 255);
#pragma unroll
        for (int i = 0; i < 8; ++i) { const float gw = gp[i]; o[i] = o[i] * r0 * gw * silu_fast(go[i]); o[8 + i] = o[8 + i] * r1 * gw * silu_fast(go[8 + i]); }
        st16b(MIX + (size_t)rl * D, F.lane, o);
    }
}

constexpr int NPHASE = 20;
__global__ void __launch_bounds__(NTHR, 2) fwd_kernel(Args args) {
    extern __shared__ __attribute__((aligned(16))) unsigned char lds_raw[];
    Frame F; F.in = args.in; F.out = args.out; F.ws = args.ws; F.lds = (LAS unsigned char*)lds_raw; F.ring = F.lds + RING_OFF;
    F.tid = threadIdx.x; F.lane = F.tid & 63; F.wave = __builtin_amdgcn_readfirstlane(F.tid >> 6); F.G = gridDim.x; F.bid = blockIdx.x;
    if (F.tid < 4) ((LAS unsigned*)F.lds)[F.tid] = 0u;
    __syncthreads();
    const int lo = args.ph_lo, hi = args.ph_hi;
    const bool multi = (hi - lo) > 1;
    XcdBarrier bar; bar.bar = (unsigned*)(F.ws + WS_CTL + CW_BAR); bar.x = 0; bar.st = (volatile LAS unsigned*)F.lds;
    if (multi) bar = xcd_barrier_post((unsigned*)(F.ws + WS_CTL + CW_BAR), (volatile LAS unsigned*)F.lds);
#define IN(k) (lo <= (k) && (k) < hi)
#define SEAM(k) do { if (IN((k) + 1)) xcd_barrier(bar); } while (0)
#define REFRESH() do { int t_ = threadIdx.x; asm volatile("" : "+v"(t_)); F.tid = t_; F.lane = t_ & 63; F.wave = __builtin_amdgcn_readfirstlane(t_ >> 6); } while (0)

    if (IN(0)) { REFRESH(); ph_prologue(F); SEAM(0); }
    if (IN(1)) { REFRESH(); ph_mod0(F); SEAM(1); }
    if (IN(2)) { REFRESH();
        pg8::DualOrder S; S.a.init(WSP(bf16_t, WS_H), WSP(bf16_t, WS_WIN0), D, D, T, U0W, F.G, F.bid); S.b.init(WSP(bf16_t, WS_WF), WSP(bf16_t, WS_H), D, D, 512, T, F.G, F.bid);
        pg8::EpiDual0 E{pg8::EpiBf16{WSP(bf16_t, R0_U0), U0W, U0W}, pg8::EpiFourT{WSP(bf16_t, R0_TT), WSP(bf16_t, R0_TTC)}};
        pg8::gemm_phase<pg8::EpiDual0, pg8::DualOrder>(F.ring, pg8::Gemm{D, D, D}, S, E);
        SEAM(2); }
    if (IN(3)) { REFRESH(); ph_rowstats(F); SEAM(3); }
    if (IN(4)) { REFRESH();
        { pg8::DenseOrder S; S.init(WSP(bf16_t, R0_U0), WSP(bf16_t, WS_WQ), U0W, QL, T, QWP, F.G, F.bid);
          pg8::EpiRS E{WSP(bf16_t, R0_Q), WSP(float, WS_RS), QW, QW}; pg8::gemm_phase<pg8::EpiRS, pg8::DenseOrder>(F.ring, pg8::Gemm{QL, U0W, QL}, S, E); }
        { pg8::DenseOrder S; S.init(WSP(bf16_t, R0_U0) + QL, WSP(bf16_t, WS_WKV), U0W, KVL, T, KVW, F.G, F.bid);
          pg8::EpiRS E{WSP(bf16_t, R0_KV), WSP(float, WS_RS) + T, KVW, KVW}; pg8::gemm_phase<pg8::EpiRS, pg8::DenseOrder>(F.ring, pg8::Gemm{KVL, U0W, KVL}, S, E); }
        SEAM(4); }
    if (IN(5)) { REFRESH();
        ph_queue5(F); SEAM(5); }
    if (IN(6)) { REFRESH();
        pg8::DenseOrder S; S.init(WSP(bf16_t, R0_MIX), WSP(bf16_t, WS_WOUT0), D, D, T, D, F.G, F.bid);
        pg8::EpiGateBf16 E{WSP(bf16_t, R0_U0), WSP(float, WS_MODV), 2048, 0, 0};
        pg8::gemm_phase<pg8::EpiGateBf16, pg8::DenseOrder>(F.ring, pg8::Gemm{D, D, D}, S, E); SEAM(6); }
    if (IN(7)) { REFRESH(); ph_router(F, 0, 0); SEAM(7); }
    if (IN(8)) { REFRESH(); ph_moe1(F, 0); SEAM(8); }
    if (IN(9)) { REFRESH(); ph_moe2(F, 0); SEAM(9); }
    if (IN(10)) { REFRESH(); ph_combine_mod1(F); SEAM(10); }
    if (IN(11)) { REFRESH();
        pg8::DenseOrder S; S.init(WSP(bf16_t, WS_H), WSP(bf16_t, WS_WIN1), D, D, T, U1W, F.G, F.bid);
        pg8::EpiBf16 E{WSP(bf16_t, R1_U1), U1W, U1W}; pg8::gemm_phase<pg8::EpiBf16, pg8::DenseOrder>(F.ring, pg8::Gemm{D, D, D}, S, E); SEAM(11); }
    if (IN(12)) { REFRESH(); gla3::pre_phase(F); SEAM(12); }
    if (IN(13)) { REFRESH(); gla3::seq_phase(F); SEAM(13); }
    if (IN(14)) { REFRESH(); ph_gla_out(F); SEAM(14); }
    if (IN(15)) { REFRESH();
        pg8::DenseOrder S; S.init(WSP(bf16_t, R1_OF), WSP(bf16_t, WS_WOUT1), D, D, TL, D, F.G, F.bid);
        pg8::EpiGateBf16 E{WSP(bf16_t, R1_OB), WSP(float, WS_MODV) + 9 * 6144, 2048, TC, TC};
        pg8::gemm_phase<pg8::EpiGateBf16, pg8::DenseOrder>(F.ring, pg8::Gemm{D, D, D}, S, E); SEAM(15); }
    if (IN(16)) { REFRESH(); ph_router(F, 1, TC); SEAM(16); }
    if (IN(17)) { REFRESH(); ph_moe1(F, 1); SEAM(17); }
    if (IN(18)) { REFRESH(); ph_moe2(F, 1); SEAM(18); }
    if (IN(19)) { REFRESH(); ph_final(F); }
#undef IN
#undef SEAM
}

#ifndef ONE_LAUNCH
#define ONE_LAUNCH 1
#endif
extern "C" void kernel_launch(void* const* d_in, const int* in_sizes, int n_in, void* d_out, int out_size, void* d_ws, size_t ws_size, hipStream_t stream) {
    static int grid = 0;
    if (grid == 0) {
        if (n_in != 38 || out_size != TL * D || ws_size < WS_END) { fprintf(stderr, "kernel_launch: unexpected shapes: n_in %d out %d ws %zu (need %zu)\n", n_in, out_size, ws_size, (size_t)WS_END); grid = -1; return; }
        int dev = 0, cus = 0, per_cu = 0;
        if (hipGetDevice(&dev) != hipSuccess || hipDeviceGetAttribute(&cus, hipDeviceAttributeMultiprocessorCount, dev) != hipSuccess) { grid = -1; return; }
        if (hipFuncSetAttribute((const void*)fwd_kernel, hipFuncAttributeMaxDynamicSharedMemorySize, LDS_BYTES) != hipSuccess) { fprintf(stderr, "kernel_launch: hipFuncSetAttribute failed\n"); grid = -1; return; }
        if (hipOccupancyMaxActiveBlocksPerMultiprocessor(&per_cu, (const void*)fwd_kernel, NTHR, LDS_BYTES) != hipSuccess || per_cu < 1) { fprintf(stderr, "kernel_launch: occupancy query says %d\n", per_cu); }
        (void)hipGetLastError();
        grid = cus;
    }
    if (grid < 0) return;
    (void)hipMemsetAsync((char*)d_ws + WS_CTL, 0, CTL_BYTES, stream);
    Args a{};
    for (int i = 0; i < 38; ++i) a.in[i] = (const float*)d_in[i];
    a.out = (float*)d_out; a.ws = (unsigned char*)d_ws;
#if ONE_LAUNCH
    a.ph_lo = 0; a.ph_hi = NPHASE;
    hipLaunchKernelGGL(fwd_kernel, dim3(grid), dim3(NTHR), LDS_BYTES, stream, a);
#else
    for (int p = 0; p < NPHASE; ++p) { a.ph_lo = p; a.ph_hi = p + 1; hipLaunchKernelGGL(fwd_kernel, dim3(grid), dim3(NTHR), LDS_BYTES, stream, a); }
#endif
}
```

```cpp
#include <hip/hip_runtime.h>
#include <stdint.h>
#include <stdio.h>

#define LAS __attribute__((address_space(3)))
typedef unsigned short bf16_t;
typedef short bf16x8 __attribute__((ext_vector_type(8)));
typedef float f32x4 __attribute__((ext_vector_type(4)));
typedef float f32x2 __attribute__((ext_vector_type(2)));
typedef unsigned u32x4 __attribute__((ext_vector_type(4)));
typedef unsigned u32x2 __attribute__((ext_vector_type(2)));

#ifndef NAIVE_ATTN
#define NAIVE_ATTN 0
#endif
#ifndef NAIVE_GLA
#define NAIVE_GLA 0
#endif
constexpr int D = 1024, NB = 8, SEQ = 4096, CTXL = 256;
constexpr int TC = NB * CTXL, TL = NB * SEQ, T = TC + TL;
constexpr int QL = 384, KVL = 256, ROPE = 64, NH = 6, QKD = 192, VD = 128;
constexpr int U0W = 768;
constexpr int QW = NH * QKD  , QWP = 1280, KVW = NH * 256  ;
constexpr int NE = 32, TOPK = 4, FF = 1024;
constexpr int U1W = 3072;
constexpr int NPAD = 147456;
constexpr float EPS = 1e-6f;
constexpr int NTHR = 512, NWAVE = 8;

constexpr size_t al256(size_t x) { return (x + 255) / 256 * 256; }
constexpr size_t XCD_BAR_WORDS_C = 3456;
constexpr size_t CW_BAR = 0;
constexpr size_t CW_Q5 = 15360;
constexpr size_t CW_CNT = 16384;
constexpr size_t CTL_BYTES = 32768;
constexpr size_t WS_CTL = 0;
constexpr size_t WS_MODV = WS_CTL + CTL_BYTES;
constexpr size_t WS_ROPE = WS_MODV + al256(2 * 9 * 6144 * 4);
constexpr size_t WS_RS = WS_ROPE + al256(2 * 64 * 16 * 4);
constexpr size_t WS_XCTX = WS_RS + al256((size_t)2 * T * 4);
constexpr size_t WS_H = WS_XCTX + al256((size_t)TC * D * 4);
constexpr size_t WS_WIN0 = WS_H + al256((size_t)T * D * 2);
constexpr size_t WS_WF = WS_WIN0 + al256((size_t)U0W * D * 2);
constexpr size_t WS_WQ = WS_WF + al256((size_t)512 * D * 2);
constexpr size_t WS_WKV = WS_WQ + al256((size_t)QWP * QL * 2);
constexpr size_t WS_WOUT0 = WS_WKV + al256((size_t)KVW * KVL * 2);
constexpr size_t WS_WIN1 = WS_WOUT0 + al256((size_t)D * D * 2);
constexpr size_t WS_WOUT1 = WS_WIN1 + al256((size_t)(U1W + 256) * D * 2);
constexpr size_t WS_WGU = WS_WOUT1 + al256((size_t)D * D * 2);
constexpr size_t WS_WDN = WS_WGU + al256((size_t)NE * 2048 * D * 2);
constexpr size_t WS_ACT = WS_WDN + al256((size_t)NE * D * FF * 2);
constexpr size_t WS_LIST = WS_ACT + al256((size_t)NPAD * FF * 2);
constexpr size_t WS_TOKE = WS_LIST + al256((size_t)NE * T * 4);
constexpr size_t WS_TOKP = WS_TOKE + al256((size_t)T * 4 * 4);
constexpr size_t WS_TOKG = WS_TOKP + al256((size_t)T * 4 * 4);
constexpr size_t WS_RWT = WS_TOKG + al256((size_t)T * 4 * 4);
constexpr size_t WS_GD = WS_RWT + al256((size_t)2 * 2 * 32 * 1024 * 2);
constexpr size_t WS_REG = WS_GD + al256((size_t)T * 32 * 4);
constexpr size_t R0_U0 = WS_REG;
constexpr size_t R0_TT = R0_U0 + al256((size_t)T * U0W * 2);
constexpr size_t R0_TTC = R0_TT + al256((size_t)NB * 256 * 8192 * 2);
constexpr size_t R0_Q = R0_TTC + al256((size_t)NB * 256 * 512 * 2);
constexpr size_t R0_KV = R0_Q + al256((size_t)T * QW * 2);
constexpr size_t R0_KR = R0_KV + al256((size_t)T * KVW * 2);
constexpr size_t R0_MIX = R0_KR + al256((size_t)T * ROPE * 2);
constexpr size_t R0_DFT = R0_MIX + al256((size_t)T * D * 2);
constexpr size_t R0_DFTC = R0_DFT + al256((size_t)4096 * 4096 * 2);
constexpr size_t R0_TT2 = R0_DFTC + al256((size_t)256 * 256 * 2);
constexpr size_t R0_TTC2 = R0_TT2 + al256((size_t)NB * 256 * 4096 * 2);
constexpr size_t R0_END = R0_TTC2 + al256((size_t)NB * 256 * 256 * 2);
constexpr size_t R1_U1 = WS_REG;
constexpr size_t R1_OF = R1_U1 + al256((size_t)T * U1W * 2);
constexpr size_t R1_OB = R1_OF + al256((size_t)TL * D * 2);
constexpr size_t R1_XB = R1_OB + al256((size_t)TL * D * 2);
constexpr size_t R1_END = R1_XB + al256((size_t)TL * D * 2);
constexpr size_t RM_YB = WS_REG;
constexpr size_t RM_END = RM_YB + al256((size_t)NPAD * D * 2);
constexpr size_t cmax(size_t a, size_t b) { return a > b ? a : b; }
constexpr size_t WS_END = cmax(cmax(R0_END, R1_END), RM_END);

constexpr int LDS_BYTES = 160 * 1024;
constexpr int LDS_MISC = 1024;
constexpr int RING_OFF = LDS_MISC;

__device__ __forceinline__ float bf2f(bf16_t b) { return __uint_as_float(((unsigned)b) << 16); }
__device__ __forceinline__ bf16_t f2bf(float f) { unsigned u = __float_as_uint(f); u += 0x7FFFu + ((u >> 16) & 1u); return (bf16_t)(u >> 16); }
__device__ __forceinline__ unsigned pk2(float lo, float hi) { return (unsigned)f2bf(lo) | ((unsigned)f2bf(hi) << 16); }
typedef __bf16 bf16v2_t __attribute__((ext_vector_type(2)));
__device__ __forceinline__ unsigned cvt_pk_bf16(float lo, float hi) { const f32x2 v = {lo, hi}; bf16v2_t b = __builtin_convertvector(v, bf16v2_t); return *reinterpret_cast<unsigned*>(&b); }
__device__ __forceinline__ float wsum(float v) { for (int o = 32; o >= 1; o >>= 1) v += __shfl_xor(v, o); return v; }
__device__ __forceinline__ float siluf(float x) { return x / (1.0f + __expf(-x)); }
__device__ __forceinline__ float silu_fast(float x) { return x * __builtin_amdgcn_rcpf(1.0f + __builtin_amdgcn_exp2f(x * -1.4426950408889634f)); }

#define XB_TMO      128
#define XB_XCNT(j)  (256  + 64 * (j))
#define XB_XSUB(j)  (1280 + 64 * (j))
#define XB_XGEN(j)  (2304 + 64 * (j))
#define XB_TOP      3328
#define XB_TOPGEN   3392
#define XCD_BAR_WORDS 3456
#define XB_SPIN_CAP (1u << 20)
__device__ __forceinline__ unsigned xb_ld(unsigned* p)              { return __hip_atomic_load(p, __ATOMIC_RELAXED, __HIP_MEMORY_SCOPE_AGENT); }
__device__ __forceinline__ unsigned xb_add(unsigned* p, unsigned v) { return __hip_atomic_fetch_add(p, v, __ATOMIC_RELAXED, __HIP_MEMORY_SCOPE_AGENT); }
__device__ __forceinline__ unsigned xb_xcc_id() { return (unsigned)__builtin_amdgcn_s_getreg((3 << 11) | 20) & 0xFu; }
#define XB_SPIN(cond, bar) do { unsigned _sp = 0; while (cond) { __builtin_amdgcn_s_sleep(1); \
    if ((++_sp & 255u) == 0u) { if (xb_ld(&(bar)[XB_TMO])) break; if (_sp > XB_SPIN_CAP) { atomicAdd(&(bar)[XB_TMO], 1u); break; } } } } while (0)
struct XcdBarrier { unsigned* bar; unsigned x; volatile LAS unsigned* st; };
__device__ __forceinline__ XcdBarrier xcd_barrier_post(unsigned* bar, volatile LAS unsigned* st) {
    XcdBarrier b; b.bar = bar; b.x = xb_xcc_id(); b.st = st;
    if (threadIdx.x == 0) (void)xb_add(&bar[XB_XCNT(b.x)], 1u);
    return b;
}
__device__ __forceinline__ void xcd_barrier_complete(unsigned* bar, unsigned x, unsigned& nloc, unsigned& nx) {
    const unsigned G = gridDim.x * gridDim.y * gridDim.z;
    unsigned sum, cnt, mine, sp = 0u;
    for (;;) {
        sum = 0u; cnt = 0u; mine = 0u;
#pragma unroll
        for (unsigned j = 0; j < 16; ++j) { const unsigned c = xb_ld(&bar[XB_XCNT(j)]); sum += c; cnt += (c > 0u) ? 1u : 0u; mine = (j == x) ? c : mine; }
        if (sum == G) break;
        __builtin_amdgcn_s_sleep(1);
        if ((++sp & 255u) == 0u) { if (xb_ld(&bar[XB_TMO])) break; if (sp > XB_SPIN_CAP) { atomicAdd(&bar[XB_TMO], 1u); break; } }
    }
    nloc = mine > 0u ? mine : 1u; nx = cnt > 0u ? cnt : 1u;
}
__device__ __forceinline__ void xcd_barrier(const XcdBarrier& b) {
    asm volatile("s_waitcnt vmcnt(0)" ::: "memory");
    __syncthreads();
    if (threadIdx.x == 0) {
        unsigned* bar = b.bar;
        __builtin_amdgcn_s_waitcnt(0);
        unsigned nloc = b.st[0], nx = b.st[1];
        if (nloc == 0u) { xcd_barrier_complete(bar, b.x, nloc, nx); b.st[0] = nloc; b.st[1] = nx; }
        const unsigned old = xb_add(&bar[XB_XSUB(b.x)], 1u);
        const unsigned gen = old / nloc;
        if (old + 1u == (gen + 1u) * nloc) {
            __builtin_amdgcn_fence(__ATOMIC_RELEASE, "agent");
            asm volatile("s_waitcnt vmcnt(0)" ::: "memory");
            const unsigned og = xb_add(&bar[XB_TOP], 1u);
            const unsigned tg = og / nx;
            if (og + 1u == (tg + 1u) * nx) xb_add(&bar[XB_TOPGEN], 1u);
            else XB_SPIN(xb_ld(&bar[XB_TOPGEN]) == tg, bar);
            __builtin_amdgcn_fence(__ATOMIC_ACQUIRE, "agent");
            xb_add(&bar[XB_XGEN(b.x)], 1u);
            asm volatile("s_waitcnt vmcnt(0)" ::: "memory");
        } else {
            XB_SPIN(xb_ld(&bar[XB_XGEN(b.x)]) == gen, bar);
            __builtin_amdgcn_fence(__ATOMIC_ACQUIRE, "agent");
            asm volatile("s_waitcnt vmcnt(0)" ::: "memory");
        }
    }
    __syncthreads();
}

namespace pg8 {
constexpr int BM = 256, BK = 64, HALF = 128, HTB = HALF * BK * 2, STAGE_BYTES = 8 * HTB, NXCD = 8, WGM = 8;
__host__ __device__ __forceinline__ int lds_byte(int r, int c) { const int st = (r >> 4) * 2 + (c >> 5), rr = r & 15, cc = c & 31, ob = rr * 64 + cc * 2; return st * 1024 + (ob ^ (((ob >> 9) & 1) << 5)); }
__host__ __device__ __forceinline__ void stage_rc(int b, int& R, int& C) { const int st = b / 1024, sb = b % 1024, swz = sb ^ (((sb >> 9) & 1) << 5); R = (st >> 1) * 16 + swz / 64; C = (st & 1) * 32 + (swz % 64) / 2; }
__host__ __device__ __forceinline__ int perm32(int rho) { const int n = rho >> 4, i = rho & 15; return 8 * (i >> 2) + 4 * n + (i & 3); }

struct Unit { int pm, pn, e, cnt; const char* A; const char* B; };
struct Gemm { int K, lda, ldb; };

struct DenseOrder {
    const char* A; const char* B; int lda, ldb; int nM, nN, nwg, G, c;
    static constexpr bool GATHER = false;
    __device__ void init(const void* A_, const void* B_, int lda_, int ldb_, int M, int N, int G_, int c_) { A = (const char*)A_; B = (const char*)B_; lda = lda_; ldb = ldb_; nM = M / BM; nN = N / BM; nwg = nM * nN; G = G_; c = c_; }
    __device__ bool next(int i, Unit& u) const {
        const long L = (long)i * G + c; if (L >= nwg) return false;
        int wgid = (int)L; { const int q = nwg / NXCD, r = nwg % NXCD, xcd = wgid % NXCD, off = wgid / NXCD; wgid = (xcd < r ? xcd * (q + 1) : r * (q + 1) + (xcd - r) * q) + off; }
        const int nig = WGM * nN, gid = wgid / nig, fm = gid * WGM, gsz = (nM - fm) < WGM ? (nM - fm) : WGM;
        u.pm = fm + ((wgid % nig) % gsz); u.pn = (wgid % nig) / gsz; u.e = 0; u.cnt = 0;
        u.A = A + (size_t)u.pm * BM * lda * 2; u.B = B + (size_t)u.pn * BM * ldb * 2; return true;
    }
    __device__ __forceinline__ void aoff(const Unit&, const int (&R)[2], const int (&C)[2], unsigned (&off)[2][2]) const {
#pragma unroll
        for (int h = 0; h < 2; ++h)
#pragma unroll
            for (int i = 0; i < 2; ++i) off[h][i] = (unsigned)((h * HALF + R[i]) * lda + C[i]) * 2u;
    }
};
struct BatchOrder {
    const char* A; const char* B; size_t sA, sB; int lda, ldb; int nM, nN, per, nwg, G, c;
    static constexpr bool GATHER = false;
    __device__ void init(const void* A_, const void* B_, size_t sA_, size_t sB_, int lda_, int ldb_, int nb, int M, int N, int G_, int c_) { A = (const char*)A_; B = (const char*)B_; sA = sA_; sB = sB_; lda = lda_; ldb = ldb_; nM = M / BM; nN = N / BM; per = nM * nN; nwg = per * nb; G = G_; c = c_; }
    __device__ bool next(int i, Unit& u) const {
        const long L = (long)i * G + c; if (L >= nwg) return false;
        const int b = (int)L / per, r = (int)L % per; u.pm = r / nN; u.pn = r % nN; u.e = b; u.cnt = 0;
        u.A = A + (size_t)b * sA + (size_t)u.pm * BM * lda * 2; u.B = B + (size_t)b * sB + (size_t)u.pn * BM * ldb * 2; return true;
    }
    __device__ __forceinline__ void aoff(const Unit&, const int (&R)[2], const int (&C)[2], unsigned (&off)[2][2]) const {
#pragma unroll
        for (int h = 0; h < 2; ++h)
#pragma unroll
            for (int i = 0; i < 2; ++i) off[h][i] = (unsigned)((h * HALF + R[i]) * lda + C[i]) * 2u;
    }
};
struct DualOrder {
    DenseOrder a, b;
    static constexpr bool GATHER = false;
    __device__ __forceinline__ void aoff_issue(const Unit&, const int (&)[2], unsigned (&)[2][2]) const {}
    __device__ __forceinline__ void aoff_finish(const int (&)[2], unsigned (&)[2][2], unsigned (&)[2][2]) const {}
    __device__ bool next(int i, Unit& u) const {
        const long L = (long)i * a.G + a.c;
        if (L < a.nwg) { return a.next(i, u); }
        const long Lb = L - a.nwg; if (Lb >= b.nwg) return false;
        DenseOrder t = b; t.c = (int)(Lb % b.G); const bool ok = t.next((int)(Lb / b.G), u); u.e = 1; return ok;
    }
    __device__ __forceinline__ void aoff(const Unit& u, const int (&R)[2], const int (&C)[2], unsigned (&off)[2][2]) const { a.aoff(u, R, C, off); }
};
struct OneUnit {
    Unit u0; int lda;
    static constexpr bool GATHER = false;
    __device__ bool next(int i, Unit& u) const { if (i != 0) return false; u = u0; return true; }
    __device__ __forceinline__ void aoff(const Unit&, const int (&R)[2], const int (&C)[2], unsigned (&off)[2][2]) const {
#pragma unroll
        for (int h = 0; h < 2; ++h)
#pragma unroll
            for (int i = 0; i < 2; ++i) off[h][i] = (unsigned)((h * HALF + R[i]) * lda + C[i]) * 2u;
    }
};
template <bool GATHER_> struct MoeOrder {
    const char* A; const char* B; size_t sB; int lda, ldb; int npn, nwg, G, c;
    const LAS int* tstart; const LAS int* cnt; const int* list;
    const LAS int* t2e;
    __device__ __forceinline__ int ts(int j) const { return __builtin_amdgcn_readfirstlane(tstart[j]); }
    static constexpr bool GATHER = GATHER_;
    __device__ bool next(int i, Unit& u) const {
        const long L = (long)i * G + c; if (L >= nwg) return false;
        int wgid = (int)L; { const int q = nwg / NXCD, r = nwg % NXCD, xcd = wgid % NXCD, off = wgid / NXCD; wgid = (xcd < r ? xcd * (q + 1) : r * (q + 1) + (xcd - r) * q) + off; }
        if (!GATHER) wgid = nwg - 1 - wgid;
        const int e = __builtin_amdgcn_readfirstlane(t2e[wgid / npn]);
        const int t0 = ts(e), nt = ts(e + 1) - t0, l = wgid - t0 * npn, pn = l / nt, ti = l % nt;
        u.pm = t0 + ti; u.pn = pn; u.e = e; u.cnt = __builtin_amdgcn_readfirstlane(cnt[e]) - ti * BM;
        u.A = GATHER ? A : A + (size_t)u.pm * BM * lda * 2;
        u.B = B + (size_t)e * sB + (size_t)pn * BM * ldb * 2; return true;
    }
    __device__ __forceinline__ void aoff(const Unit& u, const int (&R)[2], const int (&C)[2], unsigned (&off)[2][2]) const {
        if (GATHER) {
            const int ti = u.pm - ts(u.e);
#pragma unroll
            for (int h = 0; h < 2; ++h)
#pragma unroll
                for (int i = 0; i < 2; ++i) { const int r = h * HALF + R[i]; const int rc = r < u.cnt ? r : u.cnt - 1;
                    const int tok = list[(size_t)u.e * T + ti * BM + rc]; off[h][i] = (unsigned)(tok * lda + C[i]) * 2u; }
        } else {
#pragma unroll
            for (int h = 0; h < 2; ++h)
#pragma unroll
                for (int i = 0; i < 2; ++i) off[h][i] = (unsigned)((h * HALF + R[i]) * lda + C[i]) * 2u;
        }
    }
};

template <class Epi, class Sched>
__device__ __forceinline__ void gemm_phase(LAS unsigned char* lds, const Gemm g, const Sched& S, const Epi& E) {
    const int tid = threadIdx.x, wid = __builtin_amdgcn_readfirstlane(tid >> 6), lane = tid & 63, wr = wid >> 2, wc = wid & 3, fr = lane & 15, fq = lane >> 4;
    const int K = g.K, nt = K / BK;
    int Rr[2], Cc[2]; unsigned voffB[2];
#pragma unroll
    for (int i = 0; i < 2; ++i) { int R, C; stage_rc(tid * 16 + i * 8192, R, C); const int Rb = Epi::PERM ? ((R & ~31) + perm32(R & 31)) : R; Rr[i] = R; Cc[i] = C; voffB[i] = (unsigned)(Rb * g.ldb + C) * 2u; }
    const size_t kstep = (size_t)(BK * 2);
    const size_t hstepB = (size_t)HALF * g.ldb * 2;
    const unsigned ldsw = (unsigned)wid * 1024u;
    const int aoff = lds_byte(wr * 64 + fr, fq * 8), boff = lds_byte(wc * 32 + fr, fq * 8);
#define PG8_SA(b, h) (((b) * 2 + (h)) * HTB)
#define PG8_SB(b, h) ((4 + (b) * 2 + (h)) * HTB)
#define PG8_STAGE2(bufoff, gbase, o0, o1) do { \
        __builtin_amdgcn_global_load_lds((const unsigned*)((const char*)(gbase) + (o0)), (LAS unsigned*)(lds + (bufoff) + ldsw), 16, 0, 0); \
        __builtin_amdgcn_global_load_lds((const unsigned*)((const char*)(gbase) + (o1)), (LAS unsigned*)(lds + (bufoff) + ldsw + 8192), 16, 0, 0); } while (0)
#define PG8_STAGEB(bufoff, gbase) PG8_STAGE2(bufoff, gbase, voffB[0], voffB[1])
#define PG8_LDA(dst, b, h) do { _Pragma("unroll") for (int m = 0; m < 4; ++m) _Pragma("unroll") for (int k = 0; k < 2; ++k) dst[m][k] = *(const LAS bf16x8*)(lds + PG8_SA(b, h) + aoff + m * 2048 + k * 1024); } while (0)
#define PG8_LDB(dst, b, h) do { _Pragma("unroll") for (int n = 0; n < 2; ++n) _Pragma("unroll") for (int k = 0; k < 2; ++k) dst[n][k] = *(const LAS bf16x8*)(lds + PG8_SB(b, h) + boff + n * 2048 + k * 1024); } while (0)
#define PG8_MMA(ai, bj, At, Bt) do { __builtin_amdgcn_s_setprio(1); _Pragma("unroll") for (int m = 0; m < 4; ++m) _Pragma("unroll") for (int n = 0; n < 2; ++n) _Pragma("unroll") for (int k = 0; k < 2; ++k) \
        acc[ai][bj][m][n] = __builtin_amdgcn_mfma_f32_16x16x32_bf16(Bt[n][k], At[m][k], acc[ai][bj][m][n], 0, 0, 0); __builtin_amdgcn_s_setprio(0); } while (0)
#define PG8_WAIT_V(n) asm volatile("s_waitcnt vmcnt(" #n ")" ::: "memory")
#define PG8_WAIT_L(n) asm volatile("s_waitcnt lgkmcnt(" #n ")" ::: "memory")
#define PG8_BAR __builtin_amdgcn_s_barrier()
#define PG8_SCHED __builtin_amdgcn_sched_barrier(0)
    Unit cur, nxt; int ui = 0;
    if (!S.next(0, cur)) return;
    f32x4 acc[2][2][4][2];
#pragma unroll
    for (int a = 0; a < 2; ++a)
#pragma unroll
        for (int b = 0; b < 2; ++b)
#pragma unroll
            for (int m = 0; m < 4; ++m)
#pragma unroll
                for (int n = 0; n < 2; ++n) acc[a][b][m][n] = (f32x4){0.f, 0.f, 0.f, 0.f};
    bf16x8 At[4][2], B0[2][2], B1[2][2];
    unsigned oA[2][2], nOA[2][2];
    S.aoff(cur, Rr, Cc, oA);
    const char* cA = cur.A; const char* cB = cur.B;
    PG8_STAGEB(PG8_SB(0, 0), cB); PG8_STAGEB(PG8_SB(0, 1), cB + hstepB); PG8_STAGE2(PG8_SA(0, 0), cA, oA[0][0], oA[0][1]); PG8_STAGE2(PG8_SA(0, 1), cA, oA[1][0], oA[1][1]);
    if (wr == 1) PG8_BAR;
    PG8_WAIT_V(2); PG8_BAR;
    PG8_STAGEB(PG8_SB(1, 0), cB + kstep); PG8_STAGE2(PG8_SA(1, 0), cA + kstep, oA[0][0], oA[0][1]); PG8_STAGEB(PG8_SB(1, 1), cB + hstepB + kstep);
    PG8_WAIT_V(6); PG8_BAR;
    for (;;) {
        const bool has_next = S.next(ui + 1, nxt);
        const char* nA = has_next ? nxt.A : cA; const char* nB = has_next ? nxt.B : cB;
        if (Sched::GATHER) { if (has_next) S.aoff(nxt, Rr, Cc, nOA); else {
#pragma unroll
            for (int h = 0; h < 2; ++h)
#pragma unroll
                for (int i = 0; i < 2; ++i) nOA[h][i] = oA[h][i]; }
            asm volatile("" : "+v"(nOA[0][0]), "+v"(nOA[0][1]), "+v"(nOA[1][0]), "+v"(nOA[1][1])); }
        for (int t = 0; t < nt; t += 2) {
            const bool last = (t == nt - 2);
            const char* a1 = cA + (size_t)(t + 1) * kstep;
            const char* a2 = last ? nA : cA + (size_t)(t + 2) * kstep; const char* b2 = last ? nB : cB + (size_t)(t + 2) * kstep;
            const char* a3 = a2 + kstep; const char* b3 = b2 + kstep;
            unsigned q00 = oA[0][0], q01 = oA[0][1], q10 = oA[1][0], q11 = oA[1][1];
            if (Sched::GATHER) { q00 = last ? nOA[0][0] : q00; q01 = last ? nOA[0][1] : q01; q10 = last ? nOA[1][0] : q10; q11 = last ? nOA[1][1] : q11; }
            PG8_LDB(B0, 0, 0); PG8_LDB(B1, 0, 1); PG8_SCHED; PG8_LDA(At, 0, 0); PG8_STAGE2(PG8_SA(1, 1), a1, oA[1][0], oA[1][1]);
            PG8_WAIT_V(8); PG8_WAIT_L(0); PG8_BAR; PG8_MMA(0, 0, At, B0); PG8_MMA(0, 1, At, B1); PG8_BAR; PG8_SCHED;
            PG8_LDA(At, 0, 1); PG8_STAGEB(PG8_SB(0, 0), b2); PG8_STAGEB(PG8_SB(0, 1), b2 + hstepB); PG8_STAGE2(PG8_SA(0, 0), a2, q00, q01);
            PG8_WAIT_V(8); PG8_WAIT_L(0); PG8_BAR; PG8_MMA(1, 0, At, B0); PG8_MMA(1, 1, At, B1); PG8_BAR; PG8_SCHED;
            PG8_LDB(B0, 1, 0); PG8_LDB(B1, 1, 1); PG8_SCHED; PG8_LDA(At, 1, 0); PG8_STAGE2(PG8_SA(0, 1), a2, q10, q11);
            PG8_WAIT_V(8); PG8_WAIT_L(0); PG8_BAR; PG8_MMA(0, 0, At, B0); PG8_MMA(0, 1, At, B1); PG8_BAR; PG8_SCHED;
            PG8_LDA(At, 1, 1); PG8_STAGEB(PG8_SB(1, 0), b3); PG8_STAGEB(PG8_SB(1, 1), b3 + hstepB); PG8_STAGE2(PG8_SA(1, 0), a3, q00, q01);
            PG8_WAIT_V(8); PG8_WAIT_L(0); PG8_BAR; PG8_MMA(1, 0, At, B0); PG8_MMA(1, 1, At, B1); PG8_BAR; PG8_SCHED;
        }
        if (wr == 0) PG8_BAR;
        E(acc, cur, wr, wc, fr, fq, lds + 3 * HTB + ldsw);
        if (!has_next) break;
#pragma unroll
        for (int a = 0; a < 2; ++a)
#pragma unroll
            for (int b = 0; b < 2; ++b)
#pragma unroll
                for (int m = 0; m < 4; ++m)
#pragma unroll
                    for (int n = 0; n < 2; ++n) acc[a][b][m][n] = (f32x4){0.f, 0.f, 0.f, 0.f};
        cur = nxt; cA = nA; cB = nB; ++ui;
        if (Sched::GATHER) {
#pragma unroll
            for (int h = 0; h < 2; ++h)
#pragma unroll
                for (int i = 0; i < 2; ++i) oA[h][i] = nOA[h][i]; }
        if (wr == 1) PG8_BAR;
    }
    PG8_WAIT_V(0);
    PG8_BAR;
#undef PG8_SA
#undef PG8_SB
#undef PG8_STAGE2
#undef PG8_STAGEB
#undef PG8_LDA
#undef PG8_LDB
#undef PG8_MMA
#undef PG8_WAIT_V
#undef PG8_WAIT_L
#undef PG8_BAR
#undef PG8_SCHED
}

typedef f32x4 Acc[2][2][4][2];

struct XStore {
    LAS unsigned char* w; LAS unsigned char* r; int rr, cc;
    __device__ __forceinline__ XStore(LAS unsigned char* xs, int fr, int fq) {
        const int lane = fq * 16 + fr; rr = lane >> 2; cc = lane & 3;
        w = xs + fr * 64 + ((fq ^ ((fr >> 1) & 3)) * 16); r = xs + rr * 64 + ((cc ^ ((rr >> 1) & 3)) * 16); }
    __device__ __forceinline__ void put(const u32x4& x, const u32x4& y) const { *(LAS u32x4*)w = x; *(LAS u32x4*)(w + 8192) = y; }
    __device__ __forceinline__ void get(u32x4& x, u32x4& y) const { x = *(const LAS u32x4*)r; y = *(const LAS u32x4*)(r + 8192); }
};
struct EpiBf16 {
    static constexpr bool PERM = true;
    bf16_t* O; int ldc; int ncols;
    __device__ __forceinline__ void operator()(const Acc& acc, const Unit& u, int wr, int wc, int fr, int fq, LAS unsigned char* xs) const {
        const XStore X(xs, fr, fq);
        const int colw = u.pn * BM + wc * 32; const bool ok0 = colw < ncols, ok1 = colw + HALF < ncols;
        bf16_t* ob = O + (size_t)(u.pm * BM + wr * 64 + X.rr) * ldc + colw + 8 * X.cc;
#pragma unroll
        for (int ai = 0; ai < 2; ++ai)
#pragma unroll
            for (int m = 0; m < 4; ++m) { u32x4 w[2];
#pragma unroll
                for (int bj = 0; bj < 2; ++bj) { const f32x4 v0 = acc[ai][bj][m][0], v1 = acc[ai][bj][m][1];
                    w[bj].x = cvt_pk_bf16(v0[0], v0[1]); w[bj].y = cvt_pk_bf16(v0[2], v0[3]); w[bj].z = cvt_pk_bf16(v1[0], v1[1]); w[bj].w = cvt_pk_bf16(v1[2], v1[3]); }
                X.put(w[0], w[1]); u32x4 a, b; X.get(a, b);
                bf16_t* rowp = ob + (size_t)(ai * HALF + m * 16) * ldc; if (ok0) *(u32x4*)rowp = a; if (ok1) *(u32x4*)(rowp + HALF) = b; }
    }
};
struct EpiFourT {
    static constexpr bool PERM = true;
    bf16_t* TT; bf16_t* TTC;
    __device__ __forceinline__ void operator()(const Acc& acc, const Unit& u, int wr, int wc, int fr, int fq, LAS unsigned char* xs) const {
        const XStore X(xs, fr, fq);
        const int part = u.pm; const int ch0 = wr * 64 + X.rr; const int tokw = u.pn * BM + wc * 32;
        bf16_t* base[2]; int ldt[2];
#pragma unroll
        for (int bj = 0; bj < 2; ++bj) { const int tok = tokw + bj * HALF;
            if (tok < TC) { const int b = tok >> 8, n = tok & 255; base[bj] = TTC + (size_t)b * 256 * 512 + part * 256 + n + 8 * X.cc; ldt[bj] = 512; }
            else { const int tl = tok - TC, b = tl >> 12, n = tl & 4095; base[bj] = TT + (size_t)b * 256 * 8192 + part * 4096 + n + 8 * X.cc; ldt[bj] = 8192; } }
#pragma unroll
        for (int ai = 0; ai < 2; ++ai)
#pragma unroll
            for (int m = 0; m < 4; ++m) { const int ch = ch0 + ai * HALF + m * 16; u32x4 w[2];
#pragma unroll
                for (int bj = 0; bj < 2; ++bj) { const f32x4 v0 = acc[ai][bj][m][0], v1 = acc[ai][bj][m][1];
                    w[bj].x = cvt_pk_bf16(v0[0], v0[1]); w[bj].y = cvt_pk_bf16(v0[2], v0[3]); w[bj].z = cvt_pk_bf16(v1[0], v1[1]); w[bj].w = cvt_pk_bf16(v1[2], v1[3]); }
                X.put(w[0], w[1]); u32x4 a, b; X.get(a, b);
                *(u32x4*)(base[0] + (size_t)ch * ldt[0]) = a; *(u32x4*)(base[1] + (size_t)ch * ldt[1]) = b; }
    }
};
struct EpiRS {
    static constexpr bool PERM = true;
    bf16_t* O; const float* rs; int ldc, ncols;
    __device__ __forceinline__ void operator()(const Acc& acc, const Unit& u, int wr, int wc, int fr, int fq, LAS unsigned char* xs) const {
        const XStore X(xs, fr, fq);
        const int row0 = u.pm * BM + wr * 64 + fr, colw = u.pn * BM + wc * 32; const bool ok0 = colw < ncols, ok1 = colw + HALF < ncols;
        bf16_t* ob = O + (size_t)(u.pm * BM + wr * 64 + X.rr) * ldc + colw + 8 * X.cc;
        float scv[2][4];
#pragma unroll
        for (int ai = 0; ai < 2; ++ai)
#pragma unroll
            for (int m = 0; m < 4; ++m) scv[ai][m] = rs[row0 + ai * HALF + m * 16];
#pragma unroll
        for (int ai = 0; ai < 2; ++ai)
#pragma unroll
            for (int m = 0; m < 4; ++m) { const float sc = scv[ai][m]; u32x4 w[2];
#pragma unroll
                for (int bj = 0; bj < 2; ++bj) { const f32x4 v0 = acc[ai][bj][m][0] * sc, v1 = acc[ai][bj][m][1] * sc;
                    w[bj].x = cvt_pk_bf16(v0[0], v0[1]); w[bj].y = cvt_pk_bf16(v0[2], v0[3]); w[bj].z = cvt_pk_bf16(v1[0], v1[1]); w[bj].w = cvt_pk_bf16(v1[2], v1[3]); }
                X.put(w[0], w[1]); u32x4 a, b; X.get(a, b);
                bf16_t* rowp = ob + (size_t)(ai * HALF + m * 16) * ldc; if (ok0) *(u32x4*)rowp = a; if (ok1) *(u32x4*)(rowp + HALF) = b; }
    }
};
struct EpiFourOut {
    static constexpr bool PERM = true;
    bf16_t* MIX; int rowbase, rows_per_b;
    __device__ __forceinline__ void operator()(const Acc& acc, const Unit& u, int wr, int wc, int fr, int fq, LAS unsigned char* xs) const {
        const XStore X(xs, fr, fq);
        bf16_t* ob = MIX + (size_t)(rowbase + u.e * rows_per_b + u.pm * BM + wr * 64 + X.rr) * D + 768 + wc * 32 + 8 * X.cc;
#pragma unroll
        for (int ai = 0; ai < 2; ++ai)
#pragma unroll
            for (int m = 0; m < 4; ++m) { u32x4 w[2];
#pragma unroll
                for (int bj = 0; bj < 2; ++bj) { const f32x4 v0 = acc[ai][bj][m][0], v1 = acc[ai][bj][m][1];
                    w[bj].x = cvt_pk_bf16(v0[0], v0[1]); w[bj].y = cvt_pk_bf16(v0[2], v0[3]); w[bj].z = cvt_pk_bf16(v1[0], v1[1]); w[bj].w = cvt_pk_bf16(v1[2], v1[3]); }
                X.put(w[0], w[1]); u32x4 a, b; X.get(a, b);
                bf16_t* rowp = ob + (size_t)(ai * HALF + m * 16) * D; *(u32x4*)rowp = a; *(u32x4*)(rowp + HALF) = b; }
    }
};
struct EpiU1 {
    static constexpr bool PERM = true;
    EpiBf16 e0; float* GD;
    __device__ __forceinline__ void operator()(const Acc& acc, const Unit& u, int wr, int wc, int fr, int fq, LAS unsigned char* xs) const {
        if (u.pn < 12) { e0(acc, u, wr, wc, fr, fq, xs); return; }
        if (wc < 2) { float* gp = GD + (size_t)(u.pm * BM + wr * 64 + fr) * 32 + 16 * wc + 4 * fq;
#pragma unroll
            for (int ai = 0; ai < 2; ++ai)
#pragma unroll
                for (int m = 0; m < 4; ++m) *(f32x4*)(gp + (size_t)(ai * HALF + m * 16) * 32) = acc[ai][0][m][0] + acc[ai][0][m][1]; }
    }
};
struct EpiDual0 {
    static constexpr bool PERM = true;
    EpiBf16 e0; EpiFourT e1;
    __device__ __forceinline__ void operator()(const Acc& acc, const Unit& u, int wr, int wc, int fr, int fq, LAS unsigned char* xs) const { if (u.e == 0) e0(acc, u, wr, wc, fr, fq, xs); else e1(acc, u, wr, wc, fr, fq, xs); }
};
struct EpiResid {
    static constexpr bool PERM = false;
    const float* base_ctx; const float* base_lat; float* out_ctx; float* out_lat; const float* modv; int goff; int rowoff;
    __device__ __forceinline__ void operator()(const Acc& acc, const Unit& u, int wr, int wc, int fr, int fq, LAS unsigned char* xs) const {
        const int rt = rowoff + u.pm * BM;
        const bool isctx = rt < TC; const int mr = isctx ? 8 : ((rt - TC) >> 12);
        const float* base = isctx ? base_ctx + (size_t)rt * D : base_lat + (size_t)(rt - TC) * D;
        float* out = isctx ? out_ctx + (size_t)rt * D : out_lat + (size_t)(rt - TC) * D;
        const float* gv = modv + mr * 6144 + goff;
        const int r0 = wr * 64 + fr, col0 = u.pn * BM + wc * 32 + 4 * fq;
        f32x4 g[2][2];
#pragma unroll
        for (int bj = 0; bj < 2; ++bj)
#pragma unroll
            for (int n = 0; n < 2; ++n) g[bj][n] = *(const f32x4*)(gv + col0 + bj * HALF + n * 16);
#pragma unroll
        for (int ai = 0; ai < 2; ++ai) {
            f32x4 bs[4][2][2];
#pragma unroll
            for (int m = 0; m < 4; ++m) { const size_t off = (size_t)(r0 + ai * HALF + m * 16) * D + col0;
#pragma unroll
                for (int bj = 0; bj < 2; ++bj)
#pragma unroll
                    for (int n = 0; n < 2; ++n) bs[m][bj][n] = *(const f32x4*)(base + off + bj * HALF + n * 16); }
#pragma unroll
            for (int m = 0; m < 4; ++m) { const size_t off = (size_t)(r0 + ai * HALF + m * 16) * D + col0;
#pragma unroll
                for (int bj = 0; bj < 2; ++bj)
#pragma unroll
                    for (int n = 0; n < 2; ++n) *(f32x4*)(out + off + bj * HALF + n * 16) = bs[m][bj][n] + g[bj][n] * acc[ai][bj][m][n]; }
            asm volatile("" ::: "memory"); }
    }
};
struct EpiGateBf16 {
    static constexpr bool PERM = true; static constexpr int NSTORE = 16;
    bf16_t* Y; const float* modv; int goff, rowoff, ybase;
    __device__ __forceinline__ void operator()(const Acc& acc, const Unit& u, int wr, int wc, int fr, int fq, LAS unsigned char* xs) const {
        const XStore X(xs, fr, fq);
        const int rt = rowoff + u.pm * BM; const int mr = rt < TC ? 8 : ((rt - TC) >> 12);
        const float* gv = modv + mr * 6144 + goff; const int col0 = u.pn * BM + wc * 32 + 8 * fq;
        f32x4 g[2][2];
#pragma unroll
        for (int bj = 0; bj < 2; ++bj)
#pragma unroll
            for (int n = 0; n < 2; ++n) g[bj][n] = *(const f32x4*)(gv + col0 + bj * HALF + 4 * n);
        bf16_t* yb = Y + (size_t)(rt - ybase + wr * 64 + X.rr) * D + u.pn * BM + wc * 32 + 8 * X.cc;
#pragma unroll
        for (int ai = 0; ai < 2; ++ai)
#pragma unroll
            for (int m = 0; m < 4; ++m) { u32x4 w[2];
#pragma unroll
                for (int bj = 0; bj < 2; ++bj) { const f32x4 v0 = acc[ai][bj][m][0] * g[bj][0], v1 = acc[ai][bj][m][1] * g[bj][1];
                    w[bj].x = cvt_pk_bf16(v0[0], v0[1]); w[bj].y = cvt_pk_bf16(v0[2], v0[3]); w[bj].z = cvt_pk_bf16(v1[0], v1[1]); w[bj].w = cvt_pk_bf16(v1[2], v1[3]); }
                X.put(w[0], w[1]); u32x4 a, b; X.get(a, b);
                bf16_t* rowp = yb + (size_t)(ai * HALF + m * 16) * D; *(u32x4*)rowp = a; *(u32x4*)(rowp + HALF) = b; }
    }
};
struct EpiSwiglu {
    static constexpr bool PERM = true;
    bf16_t* ACT; const float* bgu;
    __device__ __forceinline__ void operator()(const Acc& acc, const Unit& u, int wr, int wc, int fr, int fq, LAS unsigned char* xs) const {
        const XStore X(xs, fr, fq);
        const int a0 = u.pn * HALF + wc * 32 + 8 * fq;
        const float* bp = bgu + (size_t)u.e * 2048 + 2 * a0;
        float bg[8], bl[8];
#pragma unroll
        for (int q = 0; q < 4; ++q) { const f32x4 t = *(const f32x4*)(bp + 4 * q); bg[2 * q] = t[0]; bl[2 * q] = t[1]; bg[2 * q + 1] = t[2]; bl[2 * q + 1] = t[3]; }
        bf16_t* ab = ACT + (size_t)(u.pm * BM + wr * 64 + X.rr) * FF + u.pn * HALF + wc * 32 + 8 * X.cc;
#pragma unroll
        for (int ai = 0; ai < 2; ++ai)
#pragma unroll
            for (int mp = 0; mp < 2; ++mp) { u32x4 w[2];
#pragma unroll
                for (int mm = 0; mm < 2; ++mm) { const int m = 2 * mp + mm; float o[8];
#pragma unroll
                    for (int j = 0; j < 8; ++j) { float xg = acc[ai][0][m][j >> 2][j & 3] + bg[j], xl = acc[ai][1][m][j >> 2][j & 3] + bl[j];
                        xg = fminf(xg, 7.0f); xl = fminf(fmaxf(xl, -7.0f), 7.0f);
                        o[j] = xg * __builtin_amdgcn_rcpf(1.0f + __builtin_amdgcn_exp2f(xg * (-1.702f * 1.4426950408889634f))) * (xl + 1.0f); }
                    w[mm].x = cvt_pk_bf16(o[0], o[1]); w[mm].y = cvt_pk_bf16(o[2], o[3]); w[mm].z = cvt_pk_bf16(o[4], o[5]); w[mm].w = cvt_pk_bf16(o[6], o[7]); }
                X.put(w[0], w[1]); u32x4 a, b; X.get(a, b);
                bf16_t* rowp = ab + (size_t)(ai * HALF + mp * 32) * FF; *(u32x4*)rowp = a; *(u32x4*)(rowp + (size_t)16 * FF) = b; }
    }
};
struct EpiDown {
    static constexpr bool PERM = true;
    bf16_t* YB; const float* bdn;
    __device__ __forceinline__ void operator()(const Acc& acc, const Unit& u, int wr, int wc, int fr, int fq, LAS unsigned char* xs) const {
        const int col0 = u.pn * BM + wc * 32 + 8 * fq;
        f32x4 bv[2][2];
#pragma unroll
        for (int bj = 0; bj < 2; ++bj)
#pragma unroll
            for (int n = 0; n < 2; ++n) bv[bj][n] = *(const f32x4*)(bdn + (size_t)u.e * D + col0 + bj * HALF + 4 * n);
        const XStore X(xs, fr, fq);
        bf16_t* yb = YB + (size_t)(u.pm * BM + wr * 64 + X.rr) * D + u.pn * BM + wc * 32 + 8 * X.cc;
#pragma unroll
        for (int ai = 0; ai < 2; ++ai)
#pragma unroll
            for (int m = 0; m < 4; ++m) { u32x4 w[2];
#pragma unroll
                for (int bj = 0; bj < 2; ++bj) { const f32x4 v0 = acc[ai][bj][m][0] + bv[bj][0], v1 = acc[ai][bj][m][1] + bv[bj][1];
                    w[bj].x = cvt_pk_bf16(v0[0], v0[1]); w[bj].y = cvt_pk_bf16(v0[2], v0[3]); w[bj].z = cvt_pk_bf16(v1[0], v1[1]); w[bj].w = cvt_pk_bf16(v1[2], v1[3]); }
                X.put(w[0], w[1]); u32x4 a, b; X.get(a, b);
                bf16_t* rowp = yb + (size_t)(ai * HALF + m * 16) * D; *(u32x4*)rowp = a; *(u32x4*)(rowp + HALF) = b; }
    }
};
}

struct Args { const float* in[38]; float* out; unsigned char* ws; int ph_lo, ph_hi; };
enum { I_X = 0, I_C, I_CTX, I_CCTX, I_FNG,
       I0_MODW, I0_MODB, I0_N1G, I0_WIN, I0_QNG, I0_WQUP, I0_KVNG, I0_WKVUP, I0_WOUT, I0_N2G, I0_RW, I0_RB, I0_WGU, I0_BGU, I0_WDN, I0_BDN,
       I1_MODW, I1_MODB, I1_N1G, I1_WIN, I1_WGKF, I1_BGKF, I1_WGKB, I1_BGKB, I1_GNG, I1_WOUT, I1_N2G, I1_RW, I1_RB, I1_WGU, I1_BGU, I1_WDN, I1_BDN };

struct Frame {
    const float* const* in; float* out; unsigned char* ws; LAS unsigned char* lds; LAS unsigned char* ring;
    int tid, lane, wave, G, bid;
};
#define WSP(T_, off) ((T_*)(F.ws + (off)))

__device__ __forceinline__ int gu_row(int n) { const int a = n >> 1, half = n & 1; return 256 * (a >> 7) + 128 * half + (a & 127); }
template <int MODE>
__device__ __forceinline__ void cvt_tile(const Frame& F, LAS bf16_t* tile  , const float* src, int ldsrc, int k0, int n0, bf16_t* dst, int ldd, const float* sk, float mul) {
    const int t = F.tid;
    { const int kl = t >> 3, nc = (t & 7) * 8; const float* p = src + (size_t)(k0 + kl) * ldsrc + n0 + nc;
      const f32x4 a = *(const f32x4*)p, b = *(const f32x4*)(p + 4); const float s = (sk ? sk[k0 + kl] : 1.0f) * mul;
      tile[(nc + 0) * 72 + kl] = f2bf(a[0] * s); tile[(nc + 1) * 72 + kl] = f2bf(a[1] * s); tile[(nc + 2) * 72 + kl] = f2bf(a[2] * s); tile[(nc + 3) * 72 + kl] = f2bf(a[3] * s);
      tile[(nc + 4) * 72 + kl] = f2bf(b[0] * s); tile[(nc + 5) * 72 + kl] = f2bf(b[1] * s); tile[(nc + 6) * 72 + kl] = f2bf(b[2] * s); tile[(nc + 7) * 72 + kl] = f2bf(b[3] * s); }
    __syncthreads();
    { const int nl = t >> 3, kc = (t & 7) * 8; const int n = n0 + nl; const int row = MODE == 1 ? gu_row(n) : n;
      const u32x4 v = *(const LAS u32x4*)(tile + nl * 72 + kc); *(u32x4*)(dst + (size_t)row * ldd + k0 + kc) = v; }
    __syncthreads();
}
template <int MODE>
__device__ __forceinline__ void cvt_blk(const Frame& F, LAS float* tl, const float* src, int ldsrc, int k0, int n0, bf16_t* dst, int ldd) {
    const int t = F.tid, w = t >> 6, l = t & 63;
    f32x4 v[8];
#pragma unroll
    for (int i = 0; i < 8; ++i) v[i] = *(const f32x4*)(src + (size_t)(k0 + w + 8 * i) * ldsrc + n0 + 4 * l);
#pragma unroll
    for (int i = 0; i < 8; ++i) *(LAS f32x4*)(tl + (w + 8 * i) * 260 + 4 * l) = v[i];
    __syncthreads();
    { const int n = t & 255, kh = t >> 8; const int row = MODE == 1 ? gu_row(n0 + n) : n0 + n; bf16_t* dp = dst + (size_t)row * ldd + k0 + kh * 32;
#pragma unroll
      for (int q = 0; q < 4; ++q) { float x[8];
#pragma unroll
          for (int j = 0; j < 8; ++j) x[j] = tl[(kh * 32 + 8 * q + j) * 260 + n];
          u32x4 o; o.x = cvt_pk_bf16(x[0], x[1]); o.y = cvt_pk_bf16(x[2], x[3]); o.z = cvt_pk_bf16(x[4], x[5]); o.w = cvt_pk_bf16(x[6], x[7]);
          *(u32x4*)(dp + 8 * q) = o; } }
    __syncthreads();
}
constexpr int CVT_NGU = NE * 16 * 8, CVT_NDN = NE * 16 * 4, CVT_JOBS = CVT_NGU + CVT_NDN;
__device__ __forceinline__ void cvt_moe_job(const Frame& F, LAS float* tl, const float* wgu, const float* wdn, int j) {
    bf16_t* WGU = WSP(bf16_t, WS_WGU); bf16_t* WDN = WSP(bf16_t, WS_WDN);
    if (j < CVT_NGU) { const int e = j >> 7, r = j & 127, kt = r >> 3, ntl = r & 7; cvt_blk<1>(F, tl, wgu + (size_t)e * 1024 * 2048, 2048, kt * 64, ntl * 256, WGU + (size_t)e * 2048 * 1024, 1024); }
    else { const int jj = j - CVT_NGU, e = jj >> 6, r = jj & 63, kt = r >> 2, ntl = r & 3; cvt_blk<0>(F, tl, wdn + (size_t)e * 1024 * 1024, 1024, kt * 64, ntl * 256, WDN + (size_t)e * 1024 * 1024, 1024); }
}
__device__ __forceinline__ void cvt_moe_weights(const Frame& F, LAS float* tl, const float* wgu, const float* wdn) {
    for (int j = F.bid; j < CVT_JOBS; j += F.G) cvt_moe_job(F, tl, wgu, wdn, j);
}
__device__ __forceinline__ void ph_prologue(const Frame& F) {
    LAS float* sc = (LAS float*)(F.ring);
    LAS float* red = (LAS float*)(F.ring + 36864);
    LAS float* ctab = (LAS float*)(F.ring + 55296);
    LAS float* stab = ctab + 4096;
    LAS bf16_t* tile = (LAS bf16_t*)(F.ring + 88064);
    LAS float* wt = (LAS float*)(F.ring + 97280);
    const int t = F.tid;
    for (int i = t; i < 9 * 1024; i += NTHR) { const int r = i >> 10, k = i & 1023; const float v = (r < 8) ? F.in[I_C][r * 1024 + k] : F.in[I_CCTX][k]; sc[i] = siluf(v); }
    for (int i = t; i < 4096; i += NTHR) { const float x = (float)i * (1.0f / 2048.0f); ctab[i] = cospif(x); stab[i] = sinpif(x); }
    __syncthreads();
    for (int u = F.bid; u < 2 * 96; u += F.G) {
        const int l = u / 96, j0 = (u % 96) * 64; const float* W = l ? F.in[I1_MODW] : F.in[I0_MODW]; const float* Bv = l ? F.in[I1_MODB] : F.in[I0_MODB];
        const int c4 = t & 15, kb = F.wave * 128 + ((t >> 4) & 3) * 32; f32x4 a[9];
#pragma unroll
        for (int r = 0; r < 9; ++r) a[r] = (f32x4){0.f, 0.f, 0.f, 0.f};
#pragma unroll 8
        for (int q = 0; q < 32; ++q) { const f32x4 w = *(const f32x4*)(W + (size_t)(kb + q) * 6144 + j0 + 4 * c4);
#pragma unroll
            for (int r = 0; r < 9; ++r) a[r] += w * sc[r * 1024 + kb + q]; }
#pragma unroll
        for (int r = 0; r < 9; ++r) {
#pragma unroll
            for (int j = 0; j < 4; ++j) { float v = a[r][j]; v += __shfl_xor(v, 16); v += __shfl_xor(v, 32); a[r][j] = v; }
            if ((t & 48) == 0) *(LAS f32x4*)(red + (F.wave * 9 + r) * 64 + 4 * c4) = a[r]; }
        __syncthreads();
        for (int i = t; i < 576; i += NTHR) { const int r = i >> 6, c = i & 63; float s = 0.f;
#pragma unroll
            for (int q = 0; q < 8; ++q) s += red[(q * 9 + r) * 64 + c];
            WSP(float, WS_MODV)[(size_t)(l * 9 + r) * 6144 + j0 + c] = s + Bv[j0 + c]; }
        __syncthreads();
    }
    if (F.bid == (1 % F.G)) { for (int i = t; i < 1024; i += NTHR) { const int pos = i >> 4, j = i & 15; const float inv = powf(10000.0f, -(float)j / 16.0f); const float ang = (float)pos * inv;
        WSP(float, WS_ROPE)[i] = cosf(ang); WSP(float, WS_ROPE)[1024 + i] = sinf(ang); } }
    { bf16_t* DFT = WSP(bf16_t, R0_DFT); bf16_t* DFTC = WSP(bf16_t, R0_DFTC);
      for (int k = F.bid; k < 4096 + 256; k += F.G) {
          if (k < 4096) { for (int jc = t; jc < 512; jc += NTHR) { const int j0 = jc * 8; float v[8];
#pragma unroll
                  for (int q = 0; q < 8; ++q) { const int j = j0 + q; const bool isS = j > 2048; const int idx = (k * (isS ? j - 2048 : j)) & 4095; v[q] = (isS ? stab[idx] : ctab[idx]) * (1.0f / 512.0f); }
                  u32x4 w; w.x = pk2(v[0], v[1]); w.y = pk2(v[2], v[3]); w.z = pk2(v[4], v[5]); w.w = pk2(v[6], v[7]); *(u32x4*)(DFT + (size_t)k * 4096 + j0) = w; } }
          else { const int kk = k - 4096; for (int jc = t; jc < 32; jc += NTHR) { const int j0 = jc * 8; float v[8];
#pragma unroll
                  for (int q = 0; q < 8; ++q) { const int j = j0 + q; const bool isS = j > 128; const int idx = ((kk * (isS ? j - 128 : j)) & 255) * 16; v[q] = (isS ? stab[idx] : ctab[idx]) * (1.0f / 128.0f); }
                  u32x4 w; w.x = pk2(v[0], v[1]); w.y = pk2(v[2], v[3]); w.z = pk2(v[4], v[5]); w.w = pk2(v[6], v[7]); *(u32x4*)(DFTC + (size_t)kk * 256 + j0) = w; } }
      } }
    { bf16_t* WF = WSP(bf16_t, WS_WF); const float* Win = F.in[I0_WIN];
      for (int j = (F.bid + 64) % F.G; j < 64; j += F.G) { const int k0 = (j >> 2) * 64, g = j & 3;
          for (int i = t; i < 4096; i += NTHR) { const int kl = i >> 6, c = i & 63; wt[kl * 65 + c] = Win[(size_t)(k0 + kl) * 960 + 704 + g * 64 + c]; }
          __syncthreads();
          { const int kl = t & 63, mg = t >> 6;
#pragma unroll 1
            for (int mm = 0; mm < 8; ++mm) { const int m = mg * 8 + mm; float ac = 0.f, as = 0.f;
                for (int c = 0; c < 64; ++c) { const int idx = ((m * c) & 63) * 64; const float w = wt[kl * 65 + c]; ac = fmaf(w, ctab[idx], ac); as = fmaf(w, stab[idx], as); }
                WF[(size_t)(g * 64 + m) * 1024 + k0 + kl] = f2bf(ac); WF[(size_t)(256 + g * 64 + m) * 1024 + k0 + kl] = f2bf(-as); } }
          __syncthreads(); } }
    for (int i = F.bid * NTHR + t; i < 2 * 32 * 1024; i += F.G * NTHR) { const int l = i >> 15, e = (i >> 10) & 31, k = i & 1023; const float w = (l ? F.in[I1_RW] : F.in[I0_RW])[k * 32 + e];
        const bf16_t hi = f2bf(w); const bf16_t lo = f2bf(w - bf2f(hi)); bf16_t* base = WSP(bf16_t, WS_RWT) + (size_t)l * 2 * 32 * 1024; base[e * 1024 + k] = hi; base[32 * 1024 + e * 1024 + k] = lo; }
    for (int i = F.bid * NTHR + t; i < 256 * 1024; i += F.G * NTHR) { const int c = i >> 10, k = i & 1023; bf16_t o = 0;
        if (c < 64) { const int j = (c >> 3) * 4 + (c & 3); const float w = F.in[I1_WIN][(size_t)k * 3104 + 3072 + j]; const bf16_t hi = f2bf(w); o = (c & 4) ? f2bf(w - bf2f(hi)) : hi; }
        WSP(bf16_t, WS_WIN1)[(size_t)(3072 + c) * 1024 + k] = o; }
    {
      constexpr int J_WIN0 = 16 * 11, J_WQ = 6 * 18, J_WKV = 4 * 24, J_WO = 16 * 16, J_WIN1 = 16 * 48;
      constexpr int JT = J_WIN0 + J_WQ + J_WKV + 2 * J_WO + J_WIN1;
      for (int j = F.bid; j < JT; j += F.G) { int r = j;
          if (r < J_WIN0) { cvt_tile<0>(F, tile, F.in[I0_WIN], 960, (r / 11) * 64, (r % 11) * 64, WSP(bf16_t, WS_WIN0), 1024, nullptr, 1.0f); continue; } r -= J_WIN0;
          if (r < J_WQ) { cvt_tile<0>(F, tile, F.in[I0_WQUP], 1152, (r / 18) * 64, (r % 18) * 64, WSP(bf16_t, WS_WQ), QL, F.in[I0_QNG], 1.0f); continue; } r -= J_WQ;
          if (r < J_WKV) { cvt_tile<0>(F, tile, F.in[I0_WKVUP], 1536, (r / 24) * 64, (r % 24) * 64, WSP(bf16_t, WS_WKV), KVL, F.in[I0_KVNG], 1.0f); continue; } r -= J_WKV;
          if (r < J_WO) { cvt_tile<0>(F, tile, F.in[I0_WOUT], 1024, (r / 16) * 64, (r % 16) * 64, WSP(bf16_t, WS_WOUT0), 1024, nullptr, 1.0f); continue; } r -= J_WO;
          if (r < J_WO) { cvt_tile<0>(F, tile, F.in[I1_WOUT], 1024, (r / 16) * 64, (r % 16) * 64, WSP(bf16_t, WS_WOUT1), 1024, nullptr, 1.0f); continue; } r -= J_WO;
          { const int n0 = (r % 48) * 64; cvt_tile<0>(F, tile, F.in[I1_WIN], 3104, (r / 48) * 64, n0, WSP(bf16_t, WS_WIN1), 1024, nullptr, n0 < 512 ? 0.08838834764831845f : 1.0f); }
      }
      for (int i = F.bid * NTHR + t; i < (64 * 1024 + 128 * QL) / 8; i += F.G * NTHR) { const u32x4 z = {0u, 0u, 0u, 0u};
          if (i < 64 * 1024 / 8) *(u32x4*)(WSP(bf16_t, WS_WIN0) + (size_t)704 * 1024 + (size_t)i * 8) = z; else *(u32x4*)(WSP(bf16_t, WS_WQ) + (size_t)1152 * QL + (size_t)(i - 64 * 1024 / 8) * 8) = z; }
    }
}

__device__ __forceinline__ const float* xrow_in(const Frame& F, int r) { return r < TC ? F.in[I_CTX] + (size_t)r * D : F.in[I_X] + (size_t)(r - TC) * D; }
__device__ __forceinline__ float* xrow_res(const Frame& F, int r) { return r < TC ? WSP(float, WS_XCTX) + (size_t)r * D : F.out + (size_t)(r - TC) * D; }
__device__ __forceinline__ bf16_t* xrow_b(const Frame& F, int r) { return WSP(bf16_t, R1_XB) + (size_t)(r - TC) * D; }
__device__ __forceinline__ int modrow(int r) { return r < TC ? 8 : ((r - TC) >> 12); }
__device__ __forceinline__ void ld16f(const float* p, int lane, float (&v)[16]) {
#pragma unroll
    for (int h = 0; h < 2; ++h) { const f32x4 a = *(const f32x4*)(p + 8 * lane + 512 * h), b = *(const f32x4*)(p + 8 * lane + 512 * h + 4);
        v[8 * h] = a[0]; v[8 * h + 1] = a[1]; v[8 * h + 2] = a[2]; v[8 * h + 3] = a[3]; v[8 * h + 4] = b[0]; v[8 * h + 5] = b[1]; v[8 * h + 6] = b[2]; v[8 * h + 7] = b[3]; }
}
__device__ __forceinline__ void st16f(float* p, int lane, const float (&v)[16]) {
#pragma unroll
    for (int h = 0; h < 2; ++h) { *(f32x4*)(p + 8 * lane + 512 * h) = (f32x4){v[8 * h], v[8 * h + 1], v[8 * h + 2], v[8 * h + 3]}; *(f32x4*)(p + 8 * lane + 512 * h + 4) = (f32x4){v[8 * h + 4], v[8 * h + 5], v[8 * h + 6], v[8 * h + 7]}; }
}
__device__ __forceinline__ void ld16b(const bf16_t* p, int lane, float (&v)[16]) {
#pragma unroll
    for (int h = 0; h < 2; ++h) { const u32x4 w = *(const u32x4*)(p + 8 * lane + 512 * h);
#pragma unroll
        for (int q = 0; q < 4; ++q) { v[8 * h + 2 * q] = __uint_as_float(w[q] << 16); v[8 * h + 2 * q + 1] = __uint_as_float(w[q] & 0xffff0000u); } }
}
__device__ __forceinline__ void st16b(bf16_t* p, int lane, const float (&v)[16]) {
#pragma unroll
    for (int h = 0; h < 2; ++h) { u32x4 w; w.x = cvt_pk_bf16(v[8 * h], v[8 * h + 1]); w.y = cvt_pk_bf16(v[8 * h + 2], v[8 * h + 3]); w.z = cvt_pk_bf16(v[8 * h + 4], v[8 * h + 5]); w.w = cvt_pk_bf16(v[8 * h + 6], v[8 * h + 7]);
        *(u32x4*)(p + 8 * lane + 512 * h) = w; }
}
__device__ __forceinline__ void modulate16(float (&v)[16], const float* g, const float* scale, const float* shift, int lane) {
    float ss = 0.f;
#pragma unroll
    for (int i = 0; i < 16; ++i) ss = fmaf(v[i], v[i], ss);
    const float rs = rsqrtf(wsum(ss) * (1.0f / D) + EPS);
    float gg[16], sc[16], sh[16]; ld16f(g, lane, gg); ld16f(scale, lane, sc); ld16f(shift, lane, sh);
#pragma unroll
    for (int i = 0; i < 16; ++i) v[i] = v[i] * rs * gg[i] * (1.0f + sc[i]) + sh[i];
}

__device__ __forceinline__ void ph_mod0(const Frame& F) {
    const float* g = F.in[I0_N1G]; bf16_t* H = WSP(bf16_t, WS_H);
    for (int r = F.bid * NWAVE + F.wave; r < T; r += F.G * NWAVE) {
        const float* mv = WSP(float, WS_MODV) + (size_t)modrow(r) * 6144;
        float v[16]; ld16f(xrow_in(F, r), F.lane, v);
        modulate16(v, g, mv + 1024, mv, F.lane);
        st16b(H + (size_t)r * D, F.lane, v);
    }
}
__device__ __forceinline__ void ph_rowstats(const Frame& F) {
    const bf16_t* U0 = WSP(bf16_t, R0_U0); float* rsq = WSP(float, WS_RS); float* rskv = rsq + T; bf16_t* KR = WSP(bf16_t, R0_KR);
    const float* rc = WSP(float, WS_ROPE); const float* rsn = rc + 1024;
    const int lane = F.lane;
    for (int rb = (F.bid * NWAVE + F.wave) * 4; rb < T; rb += F.G * NWAVE * 4) {
        u32x4 wa[4], wb[4];
#pragma unroll
        for (int q4 = 0; q4 < 4; ++q4) { const int r = rb + q4 < T ? rb + q4 : T - 1; const bf16_t* u = U0 + (size_t)r * U0W;
            wa[q4] = *(const u32x4*)(u + 8 * lane); wb[q4] = (u32x4){0u, 0u, 0u, 0u}; if (lane < 32) wb[q4] = *(const u32x4*)(u + 512 + 8 * lane); }
#pragma unroll
        for (int q4 = 0; q4 < 4; ++q4) { const int r = rb + q4; if (r >= T) break;
        float a[8], b[8];
#pragma unroll
        for (int q = 0; q < 4; ++q) { a[2 * q] = __uint_as_float(wa[q4][q] << 16); a[2 * q + 1] = __uint_as_float(wa[q4][q] & 0xffff0000u); b[2 * q] = __uint_as_float(wb[q4][q] << 16); b[2 * q + 1] = __uint_as_float(wb[q4][q] & 0xffff0000u); }
        float sa = 0.f, sb = 0.f;
#pragma unroll
        for (int j = 0; j < 8; ++j) { sa = fmaf(a[j], a[j], sa); sb = fmaf(b[j], b[j], sb); }
        const float sq = wsum(lane < 48 ? sa : 0.f), skv = wsum((lane >= 48 ? sa : 0.f) + (lane < 16 ? sb : 0.f));
        float pr[8];
#pragma unroll
        for (int j = 0; j < 8; ++j) pr[j] = __shfl_xor(b[j], 2);
        if (lane >= 16 && lane < 24) { const int jq = lane - 16, quarter = jq >> 1;
            if (r >= TC) { const int n = (r - TC) & 4095; const int pos = (quarter >= 2) ? (n & 63) : (n >> 6); const float* cp = rc + pos * 16 + (jq & 1) * 8; const float* sp = rsn + pos * 16 + (jq & 1) * 8;
#pragma unroll
                for (int j = 0; j < 8; ++j) b[j] = (quarter & 1) ? (b[j] * cp[j] + pr[j] * sp[j]) : (b[j] * cp[j] - pr[j] * sp[j]); }
            u32x4 w; w.x = cvt_pk_bf16(b[0], b[1]); w.y = cvt_pk_bf16(b[2], b[3]); w.z = cvt_pk_bf16(b[4], b[5]); w.w = cvt_pk_bf16(b[6], b[7]);
            *(u32x4*)(KR + (size_t)r * ROPE + 8 * jq) = w; }
        if (lane == 0) { rsq[r] = rsqrtf(sq * (1.0f / QL) + EPS); rskv[r] = rsqrtf(skv * (1.0f / KVL) + EPS); } }
    }
    { const bf16_t* TT = WSP(bf16_t, R0_TT); const bf16_t* TTC = WSP(bf16_t, R0_TTC); bf16_t* TT2 = WSP(bf16_t, R0_TT2); bf16_t* TTC2 = WSP(bf16_t, R0_TTC2);
      const int nch_l = NB * 256 * 512, nch_c = NB * 256 * 32;
      for (int i = F.bid * NTHR + F.tid; i < nch_l + nch_c; i += F.G * NTHR) {
          const bool lat = i < nch_l; const int ii = lat ? i : i - nch_l; const int N = lat ? 4096 : 256; const int cpr = N >> 3; const int row = ii / cpr, p0 = (ii % cpr) * 8;
          const bf16_t* src = (lat ? TT : TTC) + (size_t)row * 2 * N; bf16_t* dst = (lat ? TT2 : TTC2) + (size_t)row * N + p0; float v[8];
          if (p0 == (N >> 1)) {
#pragma unroll
              for (int q = 0; q < 8; ++q) { const int pp = p0 + q; const bool cs = pp <= (N >> 1); const int j = cs ? pp : pp - (N >> 1); const bf16_t* X = cs ? src : src + N;
                  const float a = bf2f(X[j]); const float bmir = (j == 0 || j == (N >> 1)) ? 0.f : bf2f(X[N - j]); v[q] = cs ? a + bmir : a - bmir; }
          } else {
              const bool cs = p0 < (N >> 1); const int j0 = cs ? p0 : p0 - (N >> 1); const bf16_t* X = cs ? src : src + N;
              const u32x4 fa = *(const u32x4*)(X + j0), m1 = *(const u32x4*)(X + N - j0 - 8), m2 = *(const u32x4*)(X + N - j0);
              float a[8], mr[8];
#pragma unroll
              for (int q = 0; q < 4; ++q) { a[2 * q] = __uint_as_float(fa[q] << 16); a[2 * q + 1] = __uint_as_float(fa[q] & 0xffff0000u); }
              mr[0] = (j0 == 0) ? 0.f : __uint_as_float(m2[0] << 16);
#pragma unroll
              for (int q = 1; q < 8; ++q) { const int e = 8 - q; mr[q] = (e & 1) ? __uint_as_float(m1[e >> 1] & 0xffff0000u) : __uint_as_float(m1[e >> 1] << 16); }
#pragma unroll
              for (int q = 0; q < 8; ++q) v[q] = cs ? a[q] + mr[q] : a[q] - mr[q];
          }
          u32x4 w; w.x = pk2(v[0], v[1]); w.y = pk2(v[2], v[3]); w.z = pk2(v[4], v[5]); w.w = pk2(v[6], v[7]); *(u32x4*)dst = w; }
    }
}

namespace att {
typedef float f32x16 __attribute__((ext_vector_type(16)));
typedef short s16x4 __attribute__((ext_vector_type(4)));
constexpr float SCALE = 0.07216878364870322f, THR = 8.f;
constexpr int SHM_V = 16384, SHM_KN = 64 * 272, SHM_KR = 64 * 144, SHM_QW = 32 * 272;
constexpr int OFF_V = 0, OFF_KN = 2 * SHM_V, OFF_KR = OFF_KN + 2 * SHM_KN, OFF_WS = OFF_KR + 2 * SHM_KR, OFF_QR = OFF_WS + 2048;
#define KNSWZ(row, cb) ((row) * 272 + (cb))
#define KRSWZ(row, cb) ((row) * 144 + (cb))
#define SBAR() __builtin_amdgcn_sched_barrier(0)
__device__ __forceinline__ int crow(int r, int hi) { return (r & 3) + 8 * (r >> 2) + 4 * hi; }
__device__ __forceinline__ void partialSM(f32x16& p0, f32x16& p1, float& m_reg, float& mn, float& alpha) {
  constexpr float C = SCALE * 1.4426950408889634f;
  float pmax = p0[0];
#pragma unroll
  for (int r = 1; r < 16; ++r) pmax = fmaxf(pmax, p0[r]);
#pragma unroll
  for (int r = 0; r < 16; ++r) pmax = fmaxf(pmax, p1[r]);
  { auto rr = __builtin_amdgcn_permlane32_swap(__float_as_uint(pmax), __float_as_uint(pmax), false, false);
    pmax = fmaxf(__uint_as_float(rr[0]), __uint_as_float(rr[1])); }
  if (__builtin_expect(__all(pmax - m_reg <= THR / SCALE), 1)) { mn = m_reg; alpha = 1.f; }
  else { mn = fmaxf(m_reg, pmax); alpha = __builtin_amdgcn_exp2f((m_reg - mn) * C); m_reg = mn; }
  const float mnC = -mn * C;
#pragma unroll
  for (int r = 0; r < 16; ++r) p0[r] = fmaf(p0[r], C, mnC);
#pragma unroll
  for (int r = 0; r < 16; ++r) p1[r] = fmaf(p1[r], C, mnC);
#pragma unroll
  for (int r = 0; r < 16; ++r) p0[r] = __builtin_amdgcn_exp2f(p0[r]);
}
__device__ __forceinline__ void finishSM(f32x16& p0, f32x16& p1, float alpha, float& l_reg, bf16x8& pa0, bf16x8& pa1, bf16x8& pa2, bf16x8& pa3) {
#pragma unroll
  for (int r = 0; r < 16; ++r) p1[r] = __builtin_amdgcn_exp2f(p1[r]);
  float ps = 0;
#pragma unroll
  for (int r = 0; r < 16; ++r) ps += p0[r];
#pragma unroll
  for (int r = 0; r < 16; ++r) ps += p1[r];
  { auto rr = __builtin_amdgcn_permlane32_swap(__float_as_uint(ps), __float_as_uint(ps), false, false);
    ps = __uint_as_float(rr[0]) + __uint_as_float(rr[1]); }
  l_reg = l_reg * alpha + ps;
#define PK4(P, BASE, OUT) do { unsigned a0 = cvt_pk_bf16(P[BASE + 0], P[BASE + 1]), a1 = cvt_pk_bf16(P[BASE + 2], P[BASE + 3]);   \
    unsigned b0 = cvt_pk_bf16(P[BASE + 4], P[BASE + 5]), b1 = cvt_pk_bf16(P[BASE + 6], P[BASE + 7]);                              \
    auto r0 = __builtin_amdgcn_permlane32_swap(a0, b0, false, false); auto r1 = __builtin_amdgcn_permlane32_swap(a1, b1, false, false); \
    u32x4 w = {r0[0], r1[0], r0[1], r1[1]}; OUT = *reinterpret_cast<bf16x8*>(&w); } while (0)
  PK4(p0, 0, pa0); PK4(p0, 8, pa1); PK4(p1, 0, pa2); PK4(p1, 8, pa3);
#undef PK4
}
__device__ __forceinline__ void qkt(f32x16& p0, f32x16& p1, const LAS char* Kn, const LAS char* Kr, const bf16x8 (&qr)[4], const LAS char* Qr, int r32, int hi) {
  p0 = f32x16{}; p1 = f32x16{};
#pragma unroll
  for (int d0 = 0; d0 < 8; ++d0) { const int cb = (d0 * 16 + hi * 8) * 2;
    const bf16x8 b0 = *(const LAS bf16x8*)(Kn + KNSWZ(r32, cb));
    const bf16x8 b1 = *(const LAS bf16x8*)(Kn + KNSWZ(32 + r32, cb));
    bf16x8 qq; if (d0 < 4) qq = qr[d0]; else qq = *(const LAS bf16x8*)(Qr + KNSWZ(r32, ((d0 - 4) * 16 + hi * 8) * 2));
    p0 = __builtin_amdgcn_mfma_f32_32x32x16_bf16(b0, qq, p0, 0, 0, 0);
    p1 = __builtin_amdgcn_mfma_f32_32x32x16_bf16(b1, qq, p1, 0, 0, 0); }
#pragma unroll
  for (int d0 = 0; d0 < 4; ++d0) { const int cb = (d0 * 16 + hi * 8) * 2;
    const bf16x8 b0 = *(const LAS bf16x8*)(Kr + KRSWZ(r32, cb));
    const bf16x8 b1 = *(const LAS bf16x8*)(Kr + KRSWZ(32 + r32, cb));
    const bf16x8 qq = *(const LAS bf16x8*)(Qr + KNSWZ(r32, ((4 + d0) * 16 + hi * 8) * 2));
    p0 = __builtin_amdgcn_mfma_f32_32x32x16_bf16(b0, qq, p0, 0, 0, 0);
    p1 = __builtin_amdgcn_mfma_f32_32x32x16_bf16(b1, qq, p1, 0, 0, 0); }
}
__device__ __forceinline__ int v_st(int k, int c) { const int kk = (k & ~0xC) | ((k & 4) << 1) | ((k & 8) >> 1); return ((kk >> 3) * 4 + (c >> 5)) * 512 + ((kk & 7) * 32 + (c & 31)) * 2; }
__device__ __forceinline__ int v_rd_base(int lane) { return ((lane & 3) << 3) | (((lane >> 2) & 3) << 6) | (((lane >> 4) & 1) << 5) | (((lane >> 5) & 1) << 8); }
constexpr int v_rd_off(int d0, int ks, int half) { return d0 * 512 + ks * 4096 + half * 2048; }
template <int OFF> __device__ __forceinline__ s16x4 tr_read(int vb) {
  s16x4 r; asm volatile("ds_read_b64_tr_b16 %0, %1 offset:%2" : "=&v"(r) : "v"(vb), "i"(OFF) : "memory"); return r;
}
template <int D0> __device__ __forceinline__ void pv_one(f32x16& od, int vb, bf16x8 pa0, bf16x8 pa1, bf16x8 pa2, bf16x8 pa3) {
  const s16x4 l0 = tr_read<v_rd_off(D0, 0, 0)>(vb), h0 = tr_read<v_rd_off(D0, 0, 1)>(vb), l1 = tr_read<v_rd_off(D0, 1, 0)>(vb), h1 = tr_read<v_rd_off(D0, 1, 1)>(vb);
  const s16x4 l2 = tr_read<v_rd_off(D0, 2, 0)>(vb), h2 = tr_read<v_rd_off(D0, 2, 1)>(vb), l3 = tr_read<v_rd_off(D0, 3, 0)>(vb), h3 = tr_read<v_rd_off(D0, 3, 1)>(vb);
  asm volatile("s_waitcnt lgkmcnt(0)" ::: "memory"); SBAR();
#define PK(L, H) (bf16x8){L[0], L[1], L[2], L[3], H[0], H[1], H[2], H[3]}
  od = __builtin_amdgcn_mfma_f32_32x32x16_bf16(pa0, PK(l0, h0), od, 0, 0, 0);
  od = __builtin_amdgcn_mfma_f32_32x32x16_bf16(pa1, PK(l1, h1), od, 0, 0, 0);
  od = __builtin_amdgcn_mfma_f32_32x32x16_bf16(pa2, PK(l2, h2), od, 0, 0, 0);
  od = __builtin_amdgcn_mfma_f32_32x32x16_bf16(pa3, PK(l3, h3), od, 0, 0, 0);
#undef PK
}
__device__ __forceinline__ void pv_d0(f32x16 (&o)[4], int vb, bf16x8 pa0, bf16x8 pa1, bf16x8 pa2, bf16x8 pa3) {
  pv_one<0>(o[0], vb, pa0, pa1, pa2, pa3); pv_one<1>(o[1], vb, pa0, pa1, pa2, pa3); pv_one<2>(o[2], vb, pa0, pa1, pa2, pa3); pv_one<3>(o[3], vb, pa0, pa1, pa2, pa3);
}
__device__ __forceinline__ void attn_unit(const bf16_t* __restrict__ Q, const bf16_t* __restrict__ KV, const bf16_t* __restrict__ KR, bf16_t* __restrict__ MIX,
                                          const float* __restrict__ ropec, const float* __restrict__ ropes, int h, int qrow0, bool lat, int crow0, int lrow0, int NT, LAS char* lds) {
  int tid = threadIdx.x; asm volatile("" : "+v"(tid));
  const int wid = __builtin_amdgcn_readfirstlane(tid >> 6), lane = tid & 63, r32 = lane & 31, hi = lane >> 5;
  LAS char* V_lds = lds + OFF_V; LAS char* KN_lds = lds + OFF_KN; LAS char* KR_lds = lds + OFF_KR;
  LAS float* ws = (LAS float*)(lds + OFF_WS) + wid * 64; LAS float* li_l = ws; LAS float* al_l = ws + 32;
  float m_reg = -1e30f, l_reg = 0; f32x16 o[4] = {}; bf16x8 qr[4];
  LAS char* Qr = lds + OFF_QR + wid * SHM_QW;
  { const int qrow = qrow0 + wid * 32 + r32; const bf16_t* Qw = Q + (size_t)qrow * QW + h * QKD + hi * 8;
#pragma unroll
    for (int d0 = 0; d0 < 4; ++d0) qr[d0] = *(const bf16x8*)(Qw + d0 * 16);
#pragma unroll
    for (int d0 = 4; d0 < 8; ++d0) *(LAS bf16x8*)(Qr + KNSWZ(r32, ((d0 - 4) * 16 + hi * 8) * 2)) = *(const bf16x8*)(Qw + d0 * 16);
    const int n = (qrow - TC) & 4095;
#pragma unroll
    for (int ax = 0; ax < 2; ++ax) {
      const bf16x8 q1 = *(const bf16x8*)(Qw + (8 + 2 * ax) * 16), q2 = *(const bf16x8*)(Qw + (9 + 2 * ax) * 16);
      u32x4 w1 = *reinterpret_cast<const u32x4*>(&q1), w2 = *reinterpret_cast<const u32x4*>(&q2);
      if (lat) { const int pos = ax ? (n & 63) : (n >> 6); const float* cp = ropec + pos * 16 + hi * 8; const float* sp = ropes + pos * 16 + hi * 8;
#pragma unroll
        for (int j = 0; j < 4; ++j) { const float c0 = cp[2 * j], s0 = sp[2 * j], c1 = cp[2 * j + 1], s1 = sp[2 * j + 1];
          const float a0 = bf2f((bf16_t)q1[2 * j]), a1 = bf2f((bf16_t)q1[2 * j + 1]), b0 = bf2f((bf16_t)q2[2 * j]), b1 = bf2f((bf16_t)q2[2 * j + 1]);
          w1[j] = cvt_pk_bf16(a0 * c0 - b0 * s0, a1 * c1 - b1 * s1);
          w2[j] = cvt_pk_bf16(b0 * c0 + a0 * s0, b1 * c1 + a1 * s1); } }
      *(LAS u32x4*)(Qr + KNSWZ(r32, ((4 + 2 * ax) * 16 + hi * 8) * 2)) = w1; *(LAS u32x4*)(Qr + KNSWZ(r32, ((5 + 2 * ax) * 16 + hi * 8) * 2)) = w2; }
  }
  const int sr = tid >> 4, sc = (tid & 15) * 8, vst0 = v_st(sr, sc), vst1 = v_st(32 + sr, sc);
  const int rr = tid >> 3, rc = (tid & 7) * 8;
  const int vb0 = (int)(uintptr_t)V_lds + v_rd_base(lane);
  const bf16_t* KVh = KV + h * 256;
  const int nctx_t = lat ? 4 : NT;
  bf16x8 vs0, vs1, ks0, ks1, krs;
#define TROW(kt) ((kt) < nctx_t ? crow0 + (kt) * 64 : lrow0 + ((kt) - nctx_t) * 64)
#define SLOAD(kt) do { const int _r0 = TROW(kt); const bf16_t* _p0 = KVh + (size_t)(_r0 + sr) * KVW + sc; const bf16_t* _p1 = KVh + (size_t)(_r0 + 32 + sr) * KVW + sc; \
    vs0 = *(const bf16x8*)(_p0 + 128); vs1 = *(const bf16x8*)(_p1 + 128); ks0 = *(const bf16x8*)_p0; ks1 = *(const bf16x8*)_p1; krs = *(const bf16x8*)(KR + (size_t)(_r0 + rr) * ROPE + rc); } while (0)
#define SWRITE(b) do { *(LAS bf16x8*)(V_lds + (b) * SHM_V + vst0) = vs0; *(LAS bf16x8*)(V_lds + (b) * SHM_V + vst1) = vs1; \
    *(LAS bf16x8*)(KN_lds + (b) * SHM_KN + KNSWZ(sr, sc * 2)) = ks0; *(LAS bf16x8*)(KN_lds + (b) * SHM_KN + KNSWZ(32 + sr, sc * 2)) = ks1; \
    *(LAS bf16x8*)(KR_lds + (b) * SHM_KR + KRSWZ(rr, rc * 2)) = krs; } while (0)
#define SWAIT() asm volatile("s_waitcnt vmcnt(0)" ::: "memory")
#define RESC(a) do { if (__any((a) < 1.f)) { if (hi == 0) al_l[r32] = (a); asm volatile("s_waitcnt lgkmcnt(0)" ::: "memory"); \
    _Pragma("unroll") for (int d = 0; d < 4; ++d) _Pragma("unroll") for (int r = 0; r < 16; ++r) o[d][r] *= al_l[crow(r, hi)]; } } while (0)
  f32x16 pA0, pA1, pB0, pB1; float mnA, mnB, alA, alB; bf16x8 pa0, pa1, pa2, pa3;
  SLOAD(0); SWAIT(); SWRITE(0); __syncthreads();
  qkt(pA0, pA1, KN_lds, KR_lds, qr, Qr, r32, hi); partialSM(pA0, pA1, m_reg, mnA, alA);
  SLOAD(1); SWAIT(); SWRITE(1); __syncthreads();
  for (int j = 1; j + 1 < NT; j += 2) {
    SBAR(); qkt(pB0, pB1, KN_lds + SHM_KN, KR_lds + SHM_KR, qr, Qr, r32, hi);
    finishSM(pA0, pA1, alA, l_reg, pa0, pa1, pa2, pa3); SBAR();
    SLOAD(j + 1); SBAR();
    pv_d0(o, vb0, pa0, pa1, pa2, pa3); partialSM(pB0, pB1, m_reg, mnB, alB);
    __syncthreads(); SWAIT(); SWRITE(0);
    RESC(alB); __syncthreads();
    SBAR(); qkt(pA0, pA1, KN_lds, KR_lds, qr, Qr, r32, hi);
    finishSM(pB0, pB1, alB, l_reg, pa0, pa1, pa2, pa3); SBAR();
    SLOAD(j + 2); SBAR();
    pv_d0(o, vb0 + SHM_V, pa0, pa1, pa2, pa3); partialSM(pA0, pA1, m_reg, mnA, alA);
    __syncthreads(); SWAIT(); SWRITE(1);
    RESC(alA); __syncthreads();
  }
  SBAR(); qkt(pB0, pB1, KN_lds + SHM_KN, KR_lds + SHM_KR, qr, Qr, r32, hi);
  finishSM(pA0, pA1, alA, l_reg, pa0, pa1, pa2, pa3); SBAR();
  pv_d0(o, vb0, pa0, pa1, pa2, pa3); partialSM(pB0, pB1, m_reg, mnB, alB);
  __syncthreads(); RESC(alB);
  finishSM(pB0, pB1, alB, l_reg, pa0, pa1, pa2, pa3); SBAR();
  pv_d0(o, vb0 + SHM_V, pa0, pa1, pa2, pa3);
  if (hi == 0) li_l[r32] = l_reg; asm volatile("s_waitcnt lgkmcnt(0)" ::: "memory");
  float rli[16];
#pragma unroll
  for (int r = 0; r < 16; ++r) rli[r] = __builtin_amdgcn_rcpf(li_l[crow(r, hi)]);
  int tid2 = threadIdx.x; asm volatile("" : "+v"(tid2));
  const int r32e = tid2 & 31, hie = (tid2 >> 5) & 1;
#pragma unroll
  for (int r = 0; r < 16; ++r) { const int orow = crow(r, hie);
#pragma unroll
    for (int d0 = 0; d0 < 4; ++d0) *(LAS bf16_t*)(Qr + KNSWZ(orow, (d0 * 32 + r32e) * 2)) = f2bf(o[d0][r] * rli[r]); }
  { const int lane2 = tid2 & 63; bf16_t* Ow = MIX + (size_t)(qrow0 + wid * 32 + (lane2 >> 4)) * D + h * VD + (lane2 & 15) * 8;
#pragma unroll
    for (int i = 0; i < 8; ++i) { const u32x4 w = *(const LAS u32x4*)(Qr + KNSWZ((lane2 >> 4) + 4 * i, (lane2 & 15) * 16)); *(u32x4*)(Ow + (size_t)(4 * i) * D) = w; } }
  __syncthreads();
#undef TROW
#undef SLOAD
#undef SWRITE
#undef SWAIT
#undef RESC
}
}
constexpr int Q5_ATT = 768, Q5_DFT = Q5_ATT + 128, Q5_ATTC = Q5_DFT + 48, Q5_DFTC = Q5_ATTC + 8, Q5_END = Q5_DFTC + CVT_JOBS;
__device__ __forceinline__ void ph_queue5(const Frame& F) {
    unsigned* qhead = (unsigned*)(F.ws + WS_CTL + CW_Q5);
    LAS int* qslot = (LAS int*)(F.lds + 640);
    const bf16_t* Q = WSP(bf16_t, R0_Q); const bf16_t* KV = WSP(bf16_t, R0_KV); const bf16_t* KR = WSP(bf16_t, R0_KR); bf16_t* MIX = WSP(bf16_t, R0_MIX);
    const float* rc = WSP(float, WS_ROPE); const float* rs = rc + 1024;
    const bool deal = (F.G == 256);
    if (deal) { const int xcd = F.bid & 7, kk = F.bid >> 3;
        for (int r = 0; r < 3; ++r) { const int pr = xcd + 8 * (2 * r + (kk >> 4)), qb = kk & 15, b = pr / 6, h = pr % 6;
            att::attn_unit(Q, KV, KR, MIX, rc, rs, h, TC + b * 4096 + qb * 256, true, b * 256, TC + b * 4096, 68, (LAS char*)F.ring); } }
    for (;;) {
        __syncthreads();
        if (F.tid == 0) qslot[0] = (int)__hip_atomic_fetch_add(qhead, 1u, __ATOMIC_RELAXED, __HIP_MEMORY_SCOPE_AGENT);
        __syncthreads();
        const int it = __builtin_amdgcn_readfirstlane(qslot[0]) + (deal ? Q5_ATT : 0);
        if (it >= Q5_END) break;
        if (it < Q5_ATT) { const int b = it / 96, rem = it % 96, h = rem / 16, qb = rem % 16;
            att::attn_unit(Q, KV, KR, MIX, rc, rs, h, TC + b * 4096 + qb * 256, true, b * 256, TC + b * 4096, 68, (LAS char*)F.ring); }
        else if (it < Q5_DFT || (it >= Q5_ATTC && it < Q5_DFTC)) {
            const bool lat = it < Q5_DFT; const int i = lat ? it - Q5_ATT : it - Q5_ATTC; const int b = lat ? i >> 4 : i, pm = lat ? i & 15 : 0; const int K = lat ? 4096 : 256;
            pg8::OneUnit S; S.lda = K; S.u0.pm = pm; S.u0.pn = 0; S.u0.e = b; S.u0.cnt = 0;
            S.u0.A = (const char*)(lat ? WSP(bf16_t, R0_DFT) : WSP(bf16_t, R0_DFTC)) + (size_t)pm * 256 * K * 2;
            S.u0.B = (const char*)(lat ? WSP(bf16_t, R0_TT2) : WSP(bf16_t, R0_TTC2)) + (size_t)b * 256 * K * 2;
            pg8::EpiFourOut E{MIX, lat ? TC : 0, lat ? 4096 : 256};
            pg8::gemm_phase<pg8::EpiFourOut, pg8::OneUnit>(F.ring, pg8::Gemm{K, K, K}, S, E); }
        else if (it < Q5_ATTC) { const int uu = it - Q5_DFT, b = uu / 6, h = uu % 6;
            att::attn_unit(Q, KV, KR, MIX, rc, rs, h, b * 256, false, b * 256, 0, 4, (LAS char*)F.ring); }
        else cvt_moe_job(F, (LAS float*)F.ring, F.in[I0_WGU], F.in[I0_WDN], it - Q5_DFTC);
    }
}

__device__ __forceinline__ void load_w32(const Frame& F, LAS float* wl, const float* W, int ldw) {
    for (int i = F.tid; i < 1024 * 8; i += NTHR) { const int r = i >> 3, q = i & 7; const int c = 8 * (r & 63) + 512 * (r >> 9) + ((r >> 6) & 7); const f32x4 v = *(const f32x4*)(W + (size_t)c * ldw + q * 4); *(LAS f32x4*)(wl + r * 36 + q * 4) = v; }
}
__device__ __forceinline__ float row_gemv32(const float (&v)[16], const LAS float* wl, int lane) {
    float p[32];
#pragma unroll
    for (int e = 0; e < 32; ++e) p[e] = 0.f;
#pragma unroll
    for (int i = 0; i < 16; ++i) { const LAS float* wr_ = wl + (lane + 64 * i) * 36;
#pragma unroll
        for (int q = 0; q < 8; ++q) { const f32x4 w = *(const LAS f32x4*)(wr_ + q * 4); p[4 * q] = fmaf(v[i], w[0], p[4 * q]); p[4 * q + 1] = fmaf(v[i], w[1], p[4 * q + 1]); p[4 * q + 2] = fmaf(v[i], w[2], p[4 * q + 2]); p[4 * q + 3] = fmaf(v[i], w[3], p[4 * q + 3]); }
        asm volatile("" ::: "memory"); }
    float a16[16], a8[8], a4[4], a2[2];
    { const bool up = (lane & 32) != 0;
#pragma unroll
      for (int i = 0; i < 16; ++i) { const float send = up ? p[i] : p[i + 16], keep = up ? p[i + 16] : p[i]; a16[i] = keep + __shfl_xor(send, 32); } }
    { const bool up = (lane & 16) != 0;
#pragma unroll
      for (int i = 0; i < 8; ++i) { const float send = up ? a16[i] : a16[i + 8], keep = up ? a16[i + 8] : a16[i]; a8[i] = keep + __shfl_xor(send, 16); } }
    { const bool up = (lane & 8) != 0;
#pragma unroll
      for (int i = 0; i < 4; ++i) { const float send = up ? a8[i] : a8[i + 4], keep = up ? a8[i + 4] : a8[i]; a4[i] = keep + __shfl_xor(send, 8); } }
    { const bool up = (lane & 4) != 0;
#pragma unroll
      for (int i = 0; i < 2; ++i) { const float send = up ? a4[i] : a4[i + 2], keep = up ? a4[i + 2] : a4[i]; a2[i] = keep + __shfl_xor(send, 4); } }
    float a1; { const bool up = (lane & 2) != 0; const float send = up ? a2[0] : a2[1], keep = up ? a2[1] : a2[0]; a1 = keep + __shfl_xor(send, 2); }
    a1 += __shfl_xor(a1, 1);
    return a1;
}
__device__ __forceinline__ void row_gemv32x2(const float (&va)[16], const float (&vb)[16], const LAS float* wl, int lane, float& ya, float& yb) {
    float p[32], q[32];
#pragma unroll
    for (int e = 0; e < 32; ++e) { p[e] = 0.f; q[e] = 0.f; }
#pragma unroll
    for (int i = 0; i < 16; ++i) { const LAS float* wr_ = wl + (lane + 64 * i) * 36;
#pragma unroll
        for (int k = 0; k < 8; ++k) { const f32x4 w = *(const LAS f32x4*)(wr_ + k * 4);
            p[4 * k] = fmaf(va[i], w[0], p[4 * k]); p[4 * k + 1] = fmaf(va[i], w[1], p[4 * k + 1]); p[4 * k + 2] = fmaf(va[i], w[2], p[4 * k + 2]); p[4 * k + 3] = fmaf(va[i], w[3], p[4 * k + 3]);
            q[4 * k] = fmaf(vb[i], w[0], q[4 * k]); q[4 * k + 1] = fmaf(vb[i], w[1], q[4 * k + 1]); q[4 * k + 2] = fmaf(vb[i], w[2], q[4 * k + 2]); q[4 * k + 3] = fmaf(vb[i], w[3], q[4 * k + 3]); }
        asm volatile("" ::: "memory"); }
    float a16[16], b16[16], a8[8], b8[8], a4[4], b4[4], a2[2], b2[2];
    { const bool up = (lane & 32) != 0;
#pragma unroll
      for (int i = 0; i < 16; ++i) { a16[i] = (up ? p[i + 16] : p[i]) + __shfl_xor(up ? p[i] : p[i + 16], 32); b16[i] = (up ? q[i + 16] : q[i]) + __shfl_xor(up ? q[i] : q[i + 16], 32); } }
    { const bool up = (lane & 16) != 0;
#pragma unroll
      for (int i = 0; i < 8; ++i) { a8[i] = (up ? a16[i + 8] : a16[i]) + __shfl_xor(up ? a16[i] : a16[i + 8], 16); b8[i] = (up ? b16[i + 8] : b16[i]) + __shfl_xor(up ? b16[i] : b16[i + 8], 16); } }
    { const bool up = (lane & 8) != 0;
#pragma unroll
      for (int i = 0; i < 4; ++i) { a4[i] = (up ? a8[i + 4] : a8[i]) + __shfl_xor(up ? a8[i] : a8[i + 4], 8); b4[i] = (up ? b8[i + 4] : b8[i]) + __shfl_xor(up ? b8[i] : b8[i + 4], 8); } }
    { const bool up = (lane & 4) != 0;
#pragma unroll
      for (int i = 0; i < 2; ++i) { a2[i] = (up ? a4[i + 2] : a4[i]) + __shfl_xor(up ? a4[i] : a4[i + 2], 4); b2[i] = (up ? b4[i + 2] : b4[i]) + __shfl_xor(up ? b4[i] : b4[i + 2], 4); } }
    { const bool up = (lane & 2) != 0; ya = (up ? a2[1] : a2[0]) + __shfl_xor(up ? a2[0] : a2[1], 2); yb = (up ? b2[1] : b2[0]) + __shfl_xor(up ? b2[0] : b2[1], 2); }
    ya += __shfl_xor(ya, 1); yb += __shfl_xor(yb, 1);
}
__device__ __forceinline__ void ph_router(const Frame& F, int layer, int r0) {
    typedef float f32x16 __attribute__((ext_vector_type(16)));
    constexpr int HROW = 2064;
    LAS char* HHI = (LAS char*)F.ring; LAS char* HLO = HHI + 32 * HROW; LAS float* RED = (LAS float*)F.ring;
    LAS float* SCR = (LAS float*)(F.ring + 2 * 32 * HROW);
    LAS unsigned* lcnt = (LAS unsigned*)(F.lds + 512);
    const float* g = F.in[layer ? I1_N2G : I0_N2G]; const float* rb_ = F.in[layer ? I1_RB : I0_RB];
    if (F.tid < 64) lcnt[F.tid] = 0u;
    __syncthreads();
    bf16_t* H = WSP(bf16_t, WS_H); unsigned* cnt = (unsigned*)(F.ws + WS_CTL + CW_CNT) + layer * 64;
    int* list = WSP(int, WS_LIST); int* toke = WSP(int, WS_TOKE); int* tokp = WSP(int, WS_TOKP); float* tokg = WSP(float, WS_TOKG);
    const float* modv = WSP(float, WS_MODV) + (size_t)layer * 9 * 6144;
    const bf16_t* WT = WSP(bf16_t, WS_RWT) + (size_t)layer * 2 * 32 * 1024;
    const bf16_t* Yb = layer == 0 ? WSP(bf16_t, R0_U0) : WSP(bf16_t, R1_OB) - (size_t)TC * D;
    const int per = (T - r0 + F.G - 1) / F.G; const int rbeg = r0 + F.bid * per; const int rend = (rbeg + per < T) ? rbeg + per : T;
    const int lane = F.lane, wave = F.wave, r32 = lane & 31, hi2 = lane >> 5;
    float gg[16]; ld16f(g, lane, gg);
    float scv[16], shv[16]; int curm = -1;
    bf16x8 bwh[8], bwl[8];
    { const bf16_t* wh = WT + (size_t)r32 * 1024 + wave * 128 + hi2 * 8; const bf16_t* wlp = wh + 32 * 1024;
#pragma unroll
      for (int sst = 0; sst < 8; ++sst) { bwh[sst] = *(const bf16x8*)(wh + sst * 16); bwl[sst] = *(const bf16x8*)(wlp + sst * 16); } }
    for (int tb = rbeg; tb < rend; tb += 32) {
        f32x4 xr[4][4]; u32x4 xq[4][2]; u32x4 yr[4][2];
#pragma unroll
        for (int q = 0; q < 4; ++q) { int r = tb + 4 * wave + q; r = r < rend ? r : rend - 1; const bf16_t* yp = Yb + (size_t)r * D;
            if (layer == 0) { const float* xp = xrow_in(F, r);
#pragma unroll
                for (int h = 0; h < 2; ++h) { xr[q][2 * h] = *(const f32x4*)(xp + 8 * lane + 512 * h); xr[q][2 * h + 1] = *(const f32x4*)(xp + 8 * lane + 512 * h + 4); } }
            else { const bf16_t* xp = xrow_b(F, r);
#pragma unroll
                for (int h = 0; h < 2; ++h) xq[q][h] = *(const u32x4*)(xp + 8 * lane + 512 * h); }
#pragma unroll
            for (int h = 0; h < 2; ++h) yr[q][h] = *(const u32x4*)(yp + 8 * lane + 512 * h); }
#pragma unroll
        for (int q = 0; q < 4; ++q) { const int tr = 4 * wave + q, r = tb + tr;
            if (r < rend) {
            float v[16];
#pragma unroll
            for (int h = 0; h < 2; ++h) {
#pragma unroll
                for (int k = 0; k < 4; ++k) { const float xa = layer == 0 ? xr[q][2 * h + (k >> 1)][2 * (k & 1)] : __uint_as_float(xq[q][h][k] << 16), xb = layer == 0 ? xr[q][2 * h + (k >> 1)][2 * (k & 1) + 1] : __uint_as_float(xq[q][h][k] & 0xffff0000u);
                    v[8 * h + 2 * k] = xa + __uint_as_float(yr[q][h][k] << 16); v[8 * h + 2 * k + 1] = xb + __uint_as_float(yr[q][h][k] & 0xffff0000u); } }
            if (layer == 0) { if (r < TC) st16f(xrow_res(F, r), lane, v); else st16b(xrow_b(F, r), lane, v); }
            else st16b(xrow_b(F, r), lane, v);
            float ss = 0.f;
#pragma unroll
            for (int i = 0; i < 16; ++i) ss = fmaf(v[i], v[i], ss);
            const float rs = rsqrtf(wsum(ss) * (1.0f / D) + EPS);
            const int m = modrow(r);
            if (m != curm) { const float* mv = modv + (size_t)m * 6144; ld16f(mv + 4096, lane, scv); ld16f(mv + 3072, lane, shv); curm = m; }
#pragma unroll
            for (int i = 0; i < 16; ++i) v[i] = v[i] * rs * gg[i] * (1.0f + scv[i]) + shv[i];
#pragma unroll
            for (int h = 0; h < 2; ++h) { u32x4 whi, wlo;
#pragma unroll
                for (int k = 0; k < 4; ++k) { const unsigned ph = cvt_pk_bf16(v[8 * h + 2 * k], v[8 * h + 2 * k + 1]); whi[k] = ph;
                    wlo[k] = cvt_pk_bf16(v[8 * h + 2 * k] - __uint_as_float(ph << 16), v[8 * h + 2 * k + 1] - __uint_as_float(ph & 0xffff0000u)); }
                *(u32x4*)(H + (size_t)r * D + 8 * lane + 512 * h) = whi;
                *(LAS u32x4*)(HHI + tr * HROW + (8 * lane + 512 * h) * 2) = whi; *(LAS u32x4*)(HLO + tr * HROW + (8 * lane + 512 * h) * 2) = wlo; } } }
        __syncthreads();
        f32x16 acc = {};
        { const LAS char* ah = HHI + r32 * HROW + (wave * 128 + hi2 * 8) * 2; const LAS char* al = HLO + r32 * HROW + (wave * 128 + hi2 * 8) * 2;
#pragma unroll
          for (int sst = 0; sst < 8; ++sst) { const bf16x8 a_h = *(const LAS bf16x8*)(ah + sst * 32), a_l = *(const LAS bf16x8*)(al + sst * 32);
              const bf16x8 b_h = bwh[sst], b_l = bwl[sst];
              acc = __builtin_amdgcn_mfma_f32_32x32x16_bf16(a_h, b_h, acc, 0, 0, 0);
              acc = __builtin_amdgcn_mfma_f32_32x32x16_bf16(a_h, b_l, acc, 0, 0, 0);
              acc = __builtin_amdgcn_mfma_f32_32x32x16_bf16(a_l, b_h, acc, 0, 0, 0); } }
        __syncthreads();
#pragma unroll
        for (int r = 0; r < 16; ++r) { const int row = (r & 3) + 8 * (r >> 2) + 4 * hi2; RED[(wave * 32 + row) * 32 + r32] = acc[r]; }
        __syncthreads();
#pragma unroll 1
        for (int pq = 0; pq < 2; ++pq) { const int tr = 4 * wave + 2 * pq + hi2, r = tb + tr; const int e = r32;
            float lg = rb_[e];
#pragma unroll
            for (int w8 = 0; w8 < 8; ++w8) lg += RED[(w8 * 32 + tr) * 32 + e];
            LAS float* sc_ = SCR + tr * 40;
            sc_[e] = lg;
            asm volatile("s_waitcnt lgkmcnt(0)" ::: "memory");
            int rank = 0;
#pragma unroll
            for (int q8 = 0; q8 < 8; ++q8) { const f32x4 v4 = *(const LAS f32x4*)(sc_ + 4 * q8);
#pragma unroll
                for (int j = 0; j < 4; ++j) rank += (int)((v4[j] > lg) | ((v4[j] == lg) & ((4 * q8 + j) < e))); }
            if (rank < 4) { sc_[32 + rank] = lg; ((LAS int*)sc_)[36 + rank] = e; }
            asm volatile("s_waitcnt lgkmcnt(0)" ::: "memory");
            const f32x4 tvv = *(const LAS f32x4*)(sc_ + 32); const u32x4 tev = *(const LAS u32x4*)(sc_ + 36);
            asm volatile("s_waitcnt lgkmcnt(0)" ::: "memory");
            const float e1 = __expf(tvv[1] - tvv[0]), e2 = __expf(tvv[2] - tvv[0]), e3 = __expf(tvv[3] - tvv[0]); const float inv = 1.0f / (1.0f + e1 + e2 + e3);
            if (r32 < 4 && r < rend) { const int k = r32; const int ek = (int)(k == 0 ? tev[0] : k == 1 ? tev[1] : k == 2 ? tev[2] : tev[3]); const float gk = (k == 0 ? 1.0f : k == 1 ? e1 : k == 2 ? e2 : e3) * inv;
                const unsigned lp = __hip_atomic_fetch_add(lcnt + ek, 1u, __ATOMIC_RELAXED, __HIP_MEMORY_SCOPE_WORKGROUP);
                toke[r * 4 + k] = ek; tokp[r * 4 + k] = (int)lp; tokg[r * 4 + k] = gk; } }
        __syncthreads();
    }
    __syncthreads();
    if (F.tid < 32) { const unsigned c = lcnt[F.tid]; lcnt[32 + F.tid] = c ? __hip_atomic_fetch_add(cnt + F.tid, c, __ATOMIC_RELAXED, __HIP_MEMORY_SCOPE_AGENT) : 0u; }
    __syncthreads();
    for (int i = rbeg * 4 + F.tid; i < rend * 4; i += NTHR) {
        const int ek = __hip_atomic_load(toke + i, __ATOMIC_RELAXED, __HIP_MEMORY_SCOPE_AGENT); const int pos = __hip_atomic_load(tokp + i, __ATOMIC_RELAXED, __HIP_MEMORY_SCOPE_AGENT) + (int)lcnt[32 + ek]; tokp[i] = pos; list[(size_t)ek * T + pos] = i >> 2; }
}
__device__ __forceinline__ int moe_tstart(const Frame& F, int layer, LAS int* tstart) {
    unsigned* cnt = (unsigned*)(F.ws + WS_CTL + CW_CNT) + layer * 64;
    __syncthreads();
    if (F.tid < 64) {
        const int e = F.tid & 31; const int c = (int)__hip_atomic_load(cnt + e, __ATOMIC_RELAXED, __HIP_MEMORY_SCOPE_AGENT); const int nt = (c + 255) >> 8; int incl = nt;
#pragma unroll
        for (int o = 1; o < 32; o <<= 1) { const int up = __shfl_up(incl, o, 32); if (e >= o) incl += up; }
        if (F.tid < NE) { tstart[e] = incl - nt; tstart[40 + e] = c; if (e == NE - 1) tstart[NE] = incl; } }
    __syncthreads();
    { LAS int* t2e = (LAS int*)(F.ring + 140000); const int nt = tstart[NE];
      for (int t = F.tid; t < nt; t += NTHR) { int e = 0; for (int j = 1; j < NE; ++j) e += (t >= tstart[j]) ? 1 : 0; t2e[t] = e; } }
    __syncthreads();
    return __builtin_amdgcn_readfirstlane(tstart[NE]);
}
__device__ __forceinline__ void ph_moe1(const Frame& F, int layer) {
    LAS int* tstart = (LAS int*)(F.lds + 64); const int ntile = moe_tstart(F, layer, tstart);
    pg8::MoeOrder<true> S; S.A = (const char*)WSP(bf16_t, WS_H); S.B = (const char*)WSP(bf16_t, WS_WGU); S.sB = (size_t)2048 * 1024 * 2; S.lda = D; S.ldb = D; S.npn = 8; S.nwg = ntile * 8; S.G = F.G; S.c = F.bid;
    S.tstart = tstart; S.cnt = tstart + 40; S.list = WSP(int, WS_LIST); S.t2e = (const LAS int*)(F.ring + 140000);
    pg8::EpiSwiglu E{WSP(bf16_t, WS_ACT), F.in[layer ? I1_BGU : I0_BGU]};
    pg8::gemm_phase<pg8::EpiSwiglu, pg8::MoeOrder<true>>(F.ring, pg8::Gemm{D, D, D}, S, E);
}
__device__ __forceinline__ void ph_moe2(const Frame& F, int layer) {
    LAS int* tstart = (LAS int*)(F.lds + 64); const int ntile = moe_tstart(F, layer, tstart);
    pg8::MoeOrder<false> S; S.A = (const char*)WSP(bf16_t, WS_ACT); S.B = (const char*)WSP(bf16_t, WS_WDN); S.sB = (size_t)1024 * 1024 * 2; S.lda = FF; S.ldb = FF; S.npn = 4; S.nwg = ntile * 4; S.G = F.G; S.c = F.bid;
    S.tstart = tstart; S.cnt = tstart + 40; S.list = nullptr; S.t2e = (const LAS int*)(F.ring + 140000);
    pg8::EpiDown E{WSP(bf16_t, RM_YB), F.in[layer ? I1_BDN : I0_BDN]};
    pg8::gemm_phase<pg8::EpiDown, pg8::MoeOrder<false>>(F.ring, pg8::Gemm{FF, FF, FF}, S, E);
}
__device__ __forceinline__ void moe_combine_row(const Frame& F, int layer, int r, const LAS int* tstart, float (&v)[16]) {
    const int* toke = WSP(int, WS_TOKE); const int* tokp = WSP(int, WS_TOKP); const float* tokg = WSP(float, WS_TOKG); const bf16_t* YB = WSP(bf16_t, RM_YB);
    const float* g2 = WSP(float, WS_MODV) + (size_t)(layer * 9 + modrow(r)) * 6144 + 5120;
    float y[16];
#pragma unroll
    for (int i = 0; i < 16; ++i) y[i] = 0.f;
#pragma unroll
    for (int k = 0; k < 4; ++k) { const int e = toke[r * 4 + k]; const size_t prow = (size_t)tstart[e] * 256 + tokp[r * 4 + k]; const float gk = tokg[r * 4 + k]; float yy[16]; ld16b(YB + prow * D, F.lane, yy);
#pragma unroll
        for (int i = 0; i < 16; ++i) y[i] = fmaf(gk, yy[i], y[i]); }
    float gg[16]; ld16f(g2, F.lane, gg); if (r >= TC) ld16b(xrow_b(F, r), F.lane, v); else ld16f(xrow_res(F, r), F.lane, v);
#pragma unroll
    for (int i = 0; i < 16; ++i) v[i] = fmaf(gg[i], y[i], v[i]);
}
__device__ __forceinline__ void ph_combine_mod1(const Frame& F) {
    LAS int* tstart = (LAS int*)(F.lds + 64); moe_tstart(F, 0, tstart);
    const float* g = F.in[I1_N1G]; bf16_t* H = WSP(bf16_t, WS_H);
    const float* modv = WSP(float, WS_MODV) + (size_t)9 * 6144;
    for (int r = F.bid * NWAVE + F.wave; r < T; r += F.G * NWAVE) {
        float v[16]; moe_combine_row(F, 0, r, tstart, v);
        const float* mv = modv + (size_t)modrow(r) * 6144;
        if (r < TC) st16f(xrow_res(F, r), F.lane, v); else st16b(xrow_b(F, r), F.lane, v);
        modulate16(v, g, mv + 1024, mv, F.lane);
        st16b(H + (size_t)r * D, F.lane, v);
    }
    __syncthreads();
    cvt_moe_weights(F, (LAS float*)F.ring, F.in[I1_WGU], F.in[I1_WDN]);
}
__device__ __forceinline__ void ph_final(const Frame& F) {
    LAS int* tstart = (LAS int*)(F.lds + 64); moe_tstart(F, 1, tstart);
    const float* g = F.in[I_FNG];
    for (int r = TC + F.bid * NWAVE + F.wave; r < T; r += F.G * NWAVE) {
        float v[16]; moe_combine_row(F, 1, r, tstart, v); float ss = 0.f;
#pragma unroll
        for (int i = 0; i < 16; ++i) ss = fmaf(v[i], v[i], ss);
        const float rs = rsqrtf(wsum(ss) * (1.0f / D) + EPS); float gg[16]; ld16f(g, F.lane, gg);
#pragma unroll
        for (int i = 0; i < 16; ++i) v[i] = v[i] * rs * gg[i];
        st16f(F.out + (size_t)(r - TC) * D, F.lane, v);
    }
}

namespace gla3 {
using att::f32x16; using att::s16x4; using att::crow; using att::v_st; using att::v_rd_base; using att::v_rd_off; using att::tr_read;
constexpr int ROWB = 272;
constexpr int P_GD = 0, P_TOT = 4096, P_WG = 8192;
constexpr int O_QD = 0, O_KD = 17408, O_KS = 34816, O_VV = 51200, O_ST = 67584, O_DEC = 102400;
constexpr size_t TILE_B = 64 * 128 * 2, ITEM_B = 2 * TILE_B;
#define GPK(L, H) (bf16x8){L[0], L[1], L[2], L[3], H[0], H[1], H[2], H[3]}
#define CH_ROW0(b, dir, cc) ((cc) < 4 ? ((b) * 256 + ((dir) ? 3 - (cc) : (cc)) * 64) : (TC + (b) * 4096 + ((dir) ? 67 - (cc) : (cc) - 4) * 64))
#define TOK(dir, jj) ((dir) ? 63 - (jj) : (jj))
__device__ __forceinline__ void pre_phase(const Frame& F) {
  LAS char* lds = (LAS char*)F.ring;
  int tid = threadIdx.x; asm volatile("" : "+v"(tid));
  const int wid = __builtin_amdgcn_readfirstlane(tid >> 6), lane = tid & 63;
  LAS float* gds = (LAS float*)(lds + P_GD); LAS float* tot = (LAS float*)(lds + P_TOT); LAS float* wgall = (LAS float*)(lds + P_WG);
  const bf16_t* U1 = WSP(bf16_t, R1_U1); const float* GD = WSP(float, WS_GD);
  char* tiles = (char*)(F.ws + WS_ACT); float* decbuf = (float*)(F.ws + WS_ACT + (size_t)4352 * ITEM_B);
  for (int i = tid; i < 8 * 17 * 128; i += NTHR) { const int tb = i / (17 * 128), rem = i % (17 * 128), r = rem >> 7, d = rem & 127, hd = tb >> 1, dir = tb & 1;
    const float* Wg = dir ? F.in[I1_WGKB] : F.in[I1_WGKF]; const float* Bg = dir ? F.in[I1_BGKB] : F.in[I1_BGKF]; wgall[i] = ((r < 16) ? Wg[r * 512 + hd * 128 + d] : Bg[hd * 128 + d]) * 1.4426950408889634f; }
  const int d0 = 2 * lane, tg = wid, gj = tid >> 3, gr = (tid & 7) * 2;
  unsigned qreg[8], kreg[8]; f32x2 gdreg;
#define PRE_BAR() do { asm volatile("s_waitcnt lgkmcnt(0)" ::: "memory"); __builtin_amdgcn_s_barrier(); asm volatile("" ::: "memory"); } while (0)
#define PLOAD(u) do { const int _cc = (u) % 68, _s = (u) / 68, _dir = _s & 1, _hd = (_s >> 1) & 3, _b = _s >> 3; const int _r0 = CH_ROW0(_b, _dir, _cc); \
    const bf16_t* _uq = U1 + _hd * 128 + d0; \
    gdreg = *(const f32x2*)(GD + (size_t)(_r0 + TOK(_dir, gj)) * 32 + _dir * 16 + gr); asm volatile("" ::: "memory"); \
    _Pragma("unroll") for (int i = 0; i < 8; ++i) { const bf16_t* _p = _uq + (size_t)(_r0 + TOK(_dir, 8 * tg + i)) * U1W; qreg[i] = *(const unsigned*)_p; kreg[i] = *(const unsigned*)(_p + 512); } } while (0)
  int u = F.bid;
  if (u < 4352) PLOAD(u);
  __syncthreads();
  for (; u < 4352; u += F.G) {
    const int sc = u / 68, dir = sc & 1, hd = (sc >> 1) & 3;
    const LAS float* wg = wgall + (hd * 2 + dir) * 17 * 128;
    *(LAS f32x2*)(gds + gj * 16 + gr) = gdreg;
    PRE_BAR();
    float cl0[8], cl1[8];
    { float z0[8], z1[8]; const f32x2 bb = *(const LAS f32x2*)(wg + 16 * 128 + d0);
#pragma unroll
      for (int i = 0; i < 8; ++i) { z0[i] = bb[0]; z1[i] = bb[1]; }
#pragma unroll
      for (int r4 = 0; r4 < 4; ++r4) { f32x2 w[4];
#pragma unroll
        for (int q = 0; q < 4; ++q) w[q] = *(const LAS f32x2*)(wg + (4 * r4 + q) * 128 + d0);
#pragma unroll
        for (int i = 0; i < 8; ++i) { const f32x4 g4 = *(const LAS f32x4*)(gds + (8 * tg + i) * 16 + 4 * r4);
#pragma unroll
          for (int q = 0; q < 4; ++q) { z0[i] = fmaf(g4[q], w[q][0], z0[i]); z1[i] = fmaf(g4[q], w[q][1], z1[i]); } } }
      float a0 = 0.f, a1 = 0.f;
#pragma unroll
      for (int i = 0; i < 8; ++i) { const float l0 = fminf(z0[i], 0.f) - __builtin_amdgcn_logf(1.0f + __builtin_amdgcn_exp2f(-fabsf(z0[i]))), l1 = fminf(z1[i], 0.f) - __builtin_amdgcn_logf(1.0f + __builtin_amdgcn_exp2f(-fabsf(z1[i])));
        a0 += l0 * (1.0f / 16.0f); a1 += l1 * (1.0f / 16.0f); cl0[i] = a0; cl1[i] = a1; }
      *(LAS f32x2*)(tot + tg * 128 + d0) = (f32x2){a0, a1}; }
    PRE_BAR();
    { float off0 = 0.f, off1 = 0.f, last0 = 0.f, last1 = 0.f;
#pragma unroll
      for (int g = 0; g < 8; ++g) { const f32x2 tv = *(const LAS f32x2*)(tot + g * 128 + d0); if (g < tg) { off0 += tv[0]; off1 += tv[1]; } last0 += tv[0]; last1 += tv[1]; }
      const float el0 = __builtin_amdgcn_exp2f(last0), el1 = __builtin_amdgcn_exp2f(last1);
      if (tg == 0) *(f32x2*)(decbuf + (size_t)u * 128 + d0) = (f32x2){el0, el1};
      char* it = tiles + (size_t)u * ITEM_B + d0 * 2;
#pragma unroll
      for (int i = 0; i < 8; ++i) { const int jj = 8 * tg + i; const float e0 = __builtin_amdgcn_exp2f(off0 + cl0[i]), e1 = __builtin_amdgcn_exp2f(off1 + cl1[i]); const float r0 = __builtin_amdgcn_exp2f(-(off0 + cl0[i])), r1 = __builtin_amdgcn_exp2f(-(off1 + cl1[i]));
        const float q0 = __uint_as_float(qreg[i] << 16), q1 = __uint_as_float(qreg[i] & 0xffff0000u), k0 = __uint_as_float(kreg[i] << 16), k1 = __uint_as_float(kreg[i] & 0xffff0000u);
        *(unsigned*)(it + jj * 256) = cvt_pk_bf16(q0 * e0, q1 * e1);
        *(unsigned*)(it + TILE_B + jj * 256) = cvt_pk_bf16(k0 * r0, k1 * r1); } }
    if (u + F.G < 4352) PLOAD(u + F.G);
    PRE_BAR();
  }
#undef PLOAD
#undef PRE_BAR
}
constexpr int SB_QD = 0, SB_KD = 16384, SB_VV = 32768, SB_DEC = 40960, SB_BYTES = 41984, O_ST2 = 3 * SB_BYTES;
constexpr int vc_off(int d0, int ks, int half) { return d0 * 512 + ks * 2048 + half * 1024; }
struct SeqCtx { LAS char* lds; const char* tiles; const char* decb; const char* Uvb; bf16_t* OUT; unsigned soff[7]; int pdst[7], ptyp[7]; int b, dir, hd, dvs, wid, lane, r32, hi, trb, xq, eb, db, kdo; };
#define DMA16(gptr, ldsoff) __builtin_amdgcn_global_load_lds((const unsigned*)(gptr), (LAS unsigned*)(C.lds + (ldsoff)), 16, 0, 0)
__device__ __forceinline__ void seq_issue(const SeqCtx& C, int cc) {
    const int bo = (cc % 3) * SB_BYTES; const char* t = C.tiles + (size_t)cc * ITEM_B; const char* vb = C.Uvb + (size_t)CH_ROW0(C.b, C.dir, cc) * U1W * 2; const char* db = C.decb + (size_t)cc * 512;
#pragma unroll
    for (int i = 0; i < 7; ++i) { const int ty = C.ptyp[i]; const char* base = ty == 0 ? t : (ty == 1 ? vb : db); DMA16(base + C.soff[i], bo + C.pdst[i]); }
}
#undef DMA16
template <int IB> __device__ __forceinline__ void seq_out_loop(const SeqCtx& C) {
  const int r32 = C.r32, hi = C.hi, xq = C.xq;
  for (int cc = 0; cc < 68; ++cc) {
    if (IB == 0) { if (cc >= 6 && cc < 67) asm volatile("s_waitcnt vmcnt(39)" ::: "memory"); else if (cc >= 1 && cc < 67) asm volatile("s_waitcnt vmcnt(7)" ::: "memory"); else asm volatile("s_waitcnt vmcnt(0)" ::: "memory"); }
    else asm volatile("s_waitcnt vmcnt(32)" ::: "memory");
    asm volatile("s_waitcnt lgkmcnt(0)" ::: "memory");
    __builtin_amdgcn_s_barrier();
    asm volatile("" ::: "memory");
    if (IB == 0 && cc + 2 < 68) seq_issue(C, cc + 2);
    if (cc < 4) continue;
    const LAS char* sb = C.lds + (cc % 3) * SB_BYTES;
    const LAS char* STp = C.lds + O_ST2 + ((cc + 1) & 1) * 17408;
    f32x16 p0 = {}, p1 = {}, o = {};
    const LAS char* QDr = sb + SB_QD + (32 * IB + r32) * 256; const LAS char* KDr = sb + SB_KD + C.kdo;
    bf16x8 qfr[8];
#pragma unroll
    for (int k = 0; k < 8; ++k) qfr[k] = *(const LAS bf16x8*)(QDr + ((k << 5) ^ xq));
#pragma unroll
    for (int k = 0; k < 8; ++k) { const bf16x8 qf = qfr[k]; const bf16x8 k0f = *(const LAS bf16x8*)(KDr + (k >> 1) * 512 + (k & 1) * 32);
      p0 = __builtin_amdgcn_mfma_f32_32x32x16_bf16(k0f, qf, p0, 0, 0, 0);
      if (IB) { const bf16x8 k1f = *(const LAS bf16x8*)(KDr + 8192 + (k >> 1) * 512 + (k & 1) * 32); p1 = __builtin_amdgcn_mfma_f32_32x32x16_bf16(k1f, qf, p1, 0, 0, 0); } }
#pragma unroll
    for (int r = 0; r < 16; ++r) { const bool kill = crow(r, hi) > r32; if (IB == 0) p0[r] = kill ? 0.f : p0[r]; else p1[r] = kill ? 0.f : p1[r]; }
    bf16x8 pa0, pa1, pa2, pa3;
#define PK4(P, BASE, OUT_) do { unsigned a0 = cvt_pk_bf16(P[BASE + 0], P[BASE + 1]), a1 = cvt_pk_bf16(P[BASE + 2], P[BASE + 3]);   \
    unsigned b0 = cvt_pk_bf16(P[BASE + 4], P[BASE + 5]), b1 = cvt_pk_bf16(P[BASE + 6], P[BASE + 7]);                              \
    auto r0 = __builtin_amdgcn_permlane32_swap(a0, b0, false, false); auto r1 = __builtin_amdgcn_permlane32_swap(a1, b1, false, false); \
    u32x4 w = {r0[0], r1[0], r0[1], r1[1]}; OUT_ = *reinterpret_cast<bf16x8*>(&w); } while (0)
    PK4(p0, 0, pa0); PK4(p0, 8, pa1); if (IB) { PK4(p1, 0, pa2); PK4(p1, 8, pa3); }
#undef PK4
    { const int vb = (int)(uintptr_t)(sb + SB_VV) + C.trb + C.eb * 512;
      const s16x4 l0 = tr_read<vc_off(0, 0, 0)>(vb), h0 = tr_read<vc_off(0, 0, 1)>(vb), l1 = tr_read<vc_off(0, 1, 0)>(vb), h1 = tr_read<vc_off(0, 1, 1)>(vb);
      s16x4 l2, h2, l3, h3;
      if (IB) { l2 = tr_read<vc_off(0, 2, 0)>(vb); h2 = tr_read<vc_off(0, 2, 1)>(vb); l3 = tr_read<vc_off(0, 3, 0)>(vb); h3 = tr_read<vc_off(0, 3, 1)>(vb); }
      asm volatile("s_waitcnt lgkmcnt(0)" ::: "memory"); __builtin_amdgcn_sched_barrier(0);
      o = __builtin_amdgcn_mfma_f32_32x32x16_bf16(pa0, GPK(l0, h0), o, 0, 0, 0);
      o = __builtin_amdgcn_mfma_f32_32x32x16_bf16(pa1, GPK(l1, h1), o, 0, 0, 0);
      if (IB) { o = __builtin_amdgcn_mfma_f32_32x32x16_bf16(pa2, GPK(l2, h2), o, 0, 0, 0);
                o = __builtin_amdgcn_mfma_f32_32x32x16_bf16(pa3, GPK(l3, h3), o, 0, 0, 0); } }
    { const LAS char* STr = STp + (32 * C.eb + r32) * ROWB + hi * 16;
#pragma unroll
      for (int k = 0; k < 8; ++k) { const bf16x8 qf = qfr[k]; const bf16x8 sf = *(const LAS bf16x8*)(STr + k * 32);
        o = __builtin_amdgcn_mfma_f32_32x32x16_bf16(qf, sf, o, 0, 0, 0); } }
    bf16_t* op = C.OUT + (size_t)(CH_ROW0(C.b, C.dir, cc) - TC) * D + C.hd * 256 + C.dvs * 64 + 32 * C.eb + r32;
#pragma unroll
    for (int r = 0; r < 16; ++r) { const int i = 32 * IB + crow(r, hi); op[(size_t)TOK(C.dir, i) * D] = f2bf(o[r]); }
  }
}
__device__ __forceinline__ void seq_state_loop(const SeqCtx& C) {
  const int r32 = C.r32, hi = C.hi, db = C.db;
  f32x16 S0 = {}, S1 = {};
  for (int cc = 0; cc < 68; ++cc) {
    if (cc >= 1 && cc < 67) asm volatile("s_waitcnt vmcnt(7)" ::: "memory"); else asm volatile("s_waitcnt vmcnt(0)" ::: "memory");
    asm volatile("s_waitcnt lgkmcnt(0)" ::: "memory");
    __builtin_amdgcn_s_barrier();
    asm volatile("" ::: "memory");
    if (cc + 2 < 68) seq_issue(C, cc + 2);
    const LAS char* sb = C.lds + (cc % 3) * SB_BYTES;
    LAS char* STn = C.lds + O_ST2 + (cc & 1) * 17408;
    const int kb = (int)(uintptr_t)(sb + SB_KD) + C.trb + db * 512, vb = (int)(uintptr_t)(sb + SB_VV) + C.trb;
    { const s16x4 al0 = tr_read<v_rd_off(0, 0, 0)>(kb), ah0 = tr_read<v_rd_off(0, 0, 1)>(kb), al1 = tr_read<v_rd_off(0, 1, 0)>(kb), ah1 = tr_read<v_rd_off(0, 1, 1)>(kb);
      const s16x4 al2 = tr_read<v_rd_off(0, 2, 0)>(kb), ah2 = tr_read<v_rd_off(0, 2, 1)>(kb), al3 = tr_read<v_rd_off(0, 3, 0)>(kb), ah3 = tr_read<v_rd_off(0, 3, 1)>(kb);
      const s16x4 bl0 = tr_read<vc_off(0, 0, 0)>(vb), bh0 = tr_read<vc_off(0, 0, 1)>(vb), bl1 = tr_read<vc_off(0, 1, 0)>(vb), bh1 = tr_read<vc_off(0, 1, 1)>(vb);
      const s16x4 bl2 = tr_read<vc_off(0, 2, 0)>(vb), bh2 = tr_read<vc_off(0, 2, 1)>(vb), bl3 = tr_read<vc_off(0, 3, 0)>(vb), bh3 = tr_read<vc_off(0, 3, 1)>(vb);
      const s16x4 cl0_ = tr_read<vc_off(1, 0, 0)>(vb), ch0 = tr_read<vc_off(1, 0, 1)>(vb), cl1_ = tr_read<vc_off(1, 1, 0)>(vb), ch1 = tr_read<vc_off(1, 1, 1)>(vb);
      const s16x4 cl2 = tr_read<vc_off(1, 2, 0)>(vb), ch2 = tr_read<vc_off(1, 2, 1)>(vb), cl3 = tr_read<vc_off(1, 3, 0)>(vb), ch3 = tr_read<vc_off(1, 3, 1)>(vb);
      asm volatile("s_waitcnt lgkmcnt(0)" ::: "memory"); __builtin_amdgcn_sched_barrier(0);
      S0 = __builtin_amdgcn_mfma_f32_32x32x16_bf16(GPK(al0, ah0), GPK(bl0, bh0), S0, 0, 0, 0); S1 = __builtin_amdgcn_mfma_f32_32x32x16_bf16(GPK(al0, ah0), GPK(cl0_, ch0), S1, 0, 0, 0);
      S0 = __builtin_amdgcn_mfma_f32_32x32x16_bf16(GPK(al1, ah1), GPK(bl1, bh1), S0, 0, 0, 0); S1 = __builtin_amdgcn_mfma_f32_32x32x16_bf16(GPK(al1, ah1), GPK(cl1_, ch1), S1, 0, 0, 0);
      S0 = __builtin_amdgcn_mfma_f32_32x32x16_bf16(GPK(al2, ah2), GPK(bl2, bh2), S0, 0, 0, 0); S1 = __builtin_amdgcn_mfma_f32_32x32x16_bf16(GPK(al2, ah2), GPK(cl2, ch2), S1, 0, 0, 0);
      S0 = __builtin_amdgcn_mfma_f32_32x32x16_bf16(GPK(al3, ah3), GPK(bl3, bh3), S0, 0, 0, 0); S1 = __builtin_amdgcn_mfma_f32_32x32x16_bf16(GPK(al3, ah3), GPK(cl3, ch3), S1, 0, 0, 0); }
#pragma unroll
    for (int g = 0; g < 4; ++g) { const f32x4 dc = *(const LAS f32x4*)(sb + SB_DEC + (32 * db + 8 * g + 4 * hi) * 4);
                                  S0[4 * g] *= dc[0]; S0[4 * g + 1] *= dc[1]; S0[4 * g + 2] *= dc[2]; S0[4 * g + 3] *= dc[3];
                                  S1[4 * g] *= dc[0]; S1[4 * g + 1] *= dc[1]; S1[4 * g + 2] *= dc[2]; S1[4 * g + 3] *= dc[3]; }
#pragma unroll
    for (int g = 0; g < 4; ++g) { u32x2 w0, w1; w0.x = cvt_pk_bf16(S0[4 * g], S0[4 * g + 1]); w0.y = cvt_pk_bf16(S0[4 * g + 2], S0[4 * g + 3]); w1.x = cvt_pk_bf16(S1[4 * g], S1[4 * g + 1]); w1.y = cvt_pk_bf16(S1[4 * g + 2], S1[4 * g + 3]);
      *(LAS u32x2*)(STn + r32 * ROWB + (32 * db + 8 * g + 4 * hi) * 2) = w0; *(LAS u32x2*)(STn + (32 + r32) * ROWB + (32 * db + 8 * g + 4 * hi) * 2) = w1; }
  }
}
__device__ __forceinline__ void seq_unit(const Frame& F, int b, int hd, int dir, int dvs, LAS char* lds) {
  int tid = threadIdx.x; asm volatile("" : "+v"(tid));
  SeqCtx C; C.lds = lds; C.wid = __builtin_amdgcn_readfirstlane(tid >> 6); C.lane = tid & 63; C.r32 = C.lane & 31; C.hi = C.lane >> 5; C.b = b; C.dir = dir; C.hd = hd; C.dvs = dvs;
  const int sc = (b * 4 + hd) * 2 + dir;
  C.OUT = WSP(bf16_t, dir ? R1_OB : R1_OF);
  C.tiles = (const char*)(F.ws + WS_ACT) + (size_t)sc * 68 * ITEM_B; C.decb = (const char*)(F.ws + WS_ACT + (size_t)4352 * ITEM_B) + (size_t)sc * 68 * 512;
  for (int i = tid; i < 2 * 17408 / 4; i += NTHR) ((LAS unsigned*)(lds + O_ST2))[i] = 0u;
  { const int j = C.wid < 2 ? C.wid : C.wid - 2;
#pragma unroll
    for (int i = 0; i < 7; ++i) { int g = j + 6 * i; g = g > 40 ? 40 : g; unsigned so; int pd, ty;
      if (g < 16) { const int o = g * 1024 + C.lane * 16; const int row = o >> 8, slot = (o >> 4) & 15; so = (unsigned)(row * 256 + ((slot ^ (row & 15)) << 4)); pd = SB_QD + g * 1024; ty = 0; }
      else if (g < 32) { const int o = (g - 16) * 1024 + C.lane * 16; const int sub = o >> 9, kkhi = sub >> 2, cblk = sub & 3, w = (o & 511) >> 1, kklo = w >> 5, cin = w & 31; const int kk = kkhi * 8 + kklo; const int k = (kk & ~0xC) | ((kk & 4) << 1) | ((kk & 8) >> 1);
        so = (unsigned)(TILE_B + k * 256 + (cblk * 32 + cin) * 2); pd = SB_KD + (g - 16) * 1024; ty = 0; }
      else if (g < 40) { const int o = (g - 32) * 1024 + C.lane * 16; const int sub = o >> 9, kkhi = sub >> 1, cblk = sub & 1, w = (o & 511) >> 1, kklo = w >> 5, cin = w & 31; const int kk = kkhi * 8 + kklo; const int vk = (kk & ~0xC) | ((kk & 4) << 1) | ((kk & 8) >> 1);
        so = (unsigned)((TOK(dir, vk) * U1W + cblk * 32 + cin) * 2); pd = SB_VV + (g - 32) * 1024; ty = 1; }
      else { so = (unsigned)(C.lane * 16); pd = SB_DEC; ty = 2; }
      C.soff[i] = so; C.pdst[i] = __builtin_amdgcn_readfirstlane(pd); C.ptyp[i] = __builtin_amdgcn_readfirstlane(ty); } }
  C.Uvb = (const char*)(WSP(bf16_t, R1_U1) + 1024 + hd * 256 + dvs * 64);
  C.eb = C.wid & 1; C.db = C.wid & 3; C.trb = v_rd_base(C.lane); C.xq = ((C.r32 & 15) ^ C.hi) << 4;
  { const int j = C.r32, kk = (j & ~0xC) | ((j & 4) << 1) | ((j & 8) >> 1); C.kdo = (kk >> 3) * 2048 + (kk & 7) * 64 + C.hi * 16; }
  if ((C.wid & 6) != 2) { seq_issue(C, 0); seq_issue(C, 1); }
  if (C.wid < 4) { if (C.wid & 2) seq_out_loop<1>(C); else seq_out_loop<0>(C); }
  else seq_state_loop(C);
  asm volatile("s_waitcnt vmcnt(0) lgkmcnt(0)" ::: "memory");
  __builtin_amdgcn_s_barrier();
}
__device__ __forceinline__ void seq_phase(const Frame& F) {
  for (int un = F.bid; un < 256; un += F.G) {
    const int xcd = un & 7, kk = un >> 3; const int dvs = kk & 3, sc = (kk >> 2) * 8 + xcd, dir = sc & 1, hd = (sc >> 1) & 3, b = sc >> 3;
    __syncthreads();
    seq_unit(F, b, hd, dir, dvs, (LAS char*)F.ring);
  }
}
#undef GPK
#undef CH_ROW0
#undef TOK
}

__device__ __forceinline__ void ph_gla_out(const Frame& F) {
    const bf16_t* OF = WSP(bf16_t, R1_OF); const bf16_t* OB = WSP(bf16_t, R1_OB); const bf16_t* U1 = WSP(bf16_t, R1_U1); bf16_t* MIX = WSP(bf16_t, R1_OF); const float* gn = F.in[I1_GNG];
    for (int rl = F.bid * NWAVE + F.wave; rl < TL; rl += F.G * NWAVE) {
        float o[16], ob[16], go[16]; ld16b(OF + (size_t)rl * D, F.lane, o); ld16b(OB + (size_t)rl * D, F.lane, ob); ld16b(U1 + (size_t)(TC + rl) * U1W + 2048, F.lane, go);
        float s0 = 0.f, s1 = 0.f;
#pragma unroll
        for (int i = 0; i < 8; ++i) { o[i] += ob[i]; o[8 + i] += ob[8 + i]; s0 = fmaf(o[i], o[i], s0); s1 = fmaf(o[8 + i], o[8 + i], s1); }
        for (int k = 16; k >= 1; k >>= 1) { s0 += __shfl_xor(s0, k); s1 += __shfl_xor(s1, k); }
        const float r0 = rsqrtf(s0 * (1.0f / 256.0f) + EPS), r1 = rsqrtf(s1 * (1.0f / 256.0f) + EPS);
        const float* gp = gn + ((8 * F.lane) & 255);
#pragma unroll
        for (int i = 0; i < 8; ++i) { const float gw = gp[i]; o[i] = o[i] * r0 * gw * silu_fast(go[i]); o[8 + i] = o[8 + i] * r1 * gw * silu_fast(go[8 + i]); }
        st16b(MIX + (size_t)rl * D, F.lane, o);
    }
}

constexpr int NPHASE = 20;
__global__ void __launch_bounds__(NTHR, 2) fwd_kernel(Args args) {
    extern __shared__ __attribute__((aligned(16))) unsigned char lds_raw[];
    Frame F; F.in = args.in; F.out = args.out; F.ws = args.ws; F.lds = (LAS unsigned char*)lds_raw; F.ring = F.lds + RING_OFF;
    F.tid = threadIdx.x; F.lane = F.tid & 63; F.wave = __builtin_amdgcn_readfirstlane(F.tid >> 6); F.G = gridDim.x; F.bid = blockIdx.x;
    if (F.tid < 4) ((LAS unsigned*)F.lds)[F.tid] = 0u;
    __syncthreads();
    const int lo = args.ph_lo, hi = args.ph_hi;
    const bool multi = (hi - lo) > 1;
    XcdBarrier bar; bar.bar = (unsigned*)(F.ws + WS_CTL + CW_BAR); bar.x = 0; bar.st = (volatile LAS unsigned*)F.lds;
    if (multi) bar = xcd_barrier_post((unsigned*)(F.ws + WS_CTL + CW_BAR), (volatile LAS unsigned*)F.lds);
#define IN(k) (lo <= (k) && (k) < hi)
#define SEAM(k) do { if (IN((k) + 1)) xcd_barrier(bar); } while (0)
#define REFRESH() do { int t_ = threadIdx.x; asm volatile("" : "+v"(t_)); F.tid = t_; F.lane = t_ & 63; F.wave = __builtin_amdgcn_readfirstlane(t_ >> 6); } while (0)

    if (IN(0)) { REFRESH(); ph_prologue(F); SEAM(0); }
    if (IN(1)) { REFRESH(); ph_mod0(F); SEAM(1); }
    if (IN(2)) { REFRESH();
        pg8::DualOrder S; S.a.init(WSP(bf16_t, WS_H), WSP(bf16_t, WS_WIN0), D, D, T, U0W, F.G, F.bid); S.b.init(WSP(bf16_t, WS_WF), WSP(bf16_t, WS_H), D, D, 512, T, F.G, F.bid);
        pg8::EpiDual0 E{pg8::EpiBf16{WSP(bf16_t, R0_U0), U0W, U0W}, pg8::EpiFourT{WSP(bf16_t, R0_TT), WSP(bf16_t, R0_TTC)}};
        pg8::gemm_phase<pg8::EpiDual0, pg8::DualOrder>(F.ring, pg8::Gemm{D, D, D}, S, E);
        SEAM(2); }
    if (IN(3)) { REFRESH(); ph_rowstats(F); SEAM(3); }
    if (IN(4)) { REFRESH();
        { pg8::DenseOrder S; S.init(WSP(bf16_t, R0_U0), WSP(bf16_t, WS_WQ), U0W, QL, T, QWP, F.G, F.bid);
          pg8::EpiRS E{WSP(bf16_t, R0_Q), WSP(float, WS_RS), QW, QW}; pg8::gemm_phase<pg8::EpiRS, pg8::DenseOrder>(F.ring, pg8::Gemm{QL, U0W, QL}, S, E); }
        { pg8::DenseOrder S; S.init(WSP(bf16_t, R0_U0) + QL, WSP(bf16_t, WS_WKV), U0W, KVL, T, KVW, F.G, (F.bid + F.G - (680 % F.G)) % F.G);
          pg8::EpiRS E{WSP(bf16_t, R0_KV), WSP(float, WS_RS) + T, KVW, KVW}; pg8::gemm_phase<pg8::EpiRS, pg8::DenseOrder>(F.ring, pg8::Gemm{KVL, U0W, KVL}, S, E); }
        SEAM(4); }
    if (IN(5)) { REFRESH();
        ph_queue5(F); SEAM(5); }
    if (IN(6)) { REFRESH();
        pg8::DenseOrder S; S.init(WSP(bf16_t, R0_MIX), WSP(bf16_t, WS_WOUT0), D, D, T, D, F.G, F.bid);
        pg8::EpiGateBf16 E{WSP(bf16_t, R0_U0), WSP(float, WS_MODV), 2048, 0, 0};
        pg8::gemm_phase<pg8::EpiGateBf16, pg8::DenseOrder>(F.ring, pg8::Gemm{D, D, D}, S, E); SEAM(6); }
    if (IN(7)) { REFRESH(); ph_router(F, 0, 0); SEAM(7); }
    if (IN(8)) { REFRESH(); ph_moe1(F, 0); SEAM(8); }
    if (IN(9)) { REFRESH(); ph_moe2(F, 0); SEAM(9); }
    if (IN(10)) { REFRESH(); ph_combine_mod1(F); SEAM(10); }
    if (IN(11)) { REFRESH();
        pg8::DenseOrder S; S.init(WSP(bf16_t, WS_H), WSP(bf16_t, WS_WIN1), D, D, T, U1W + 256, F.G, F.bid);
        pg8::EpiU1 E{pg8::EpiBf16{WSP(bf16_t, R1_U1), U1W, U1W}, WSP(float, WS_GD)}; pg8::gemm_phase<pg8::EpiU1, pg8::DenseOrder>(F.ring, pg8::Gemm{D, D, D}, S, E); SEAM(11); }
    if (IN(12)) { REFRESH(); gla3::pre_phase(F); SEAM(12); }
    if (IN(13)) { REFRESH(); gla3::seq_phase(F); SEAM(13); }
    if (IN(14)) { REFRESH(); ph_gla_out(F); SEAM(14); }
    if (IN(15)) { REFRESH();
        pg8::DenseOrder S; S.init(WSP(bf16_t, R1_OF), WSP(bf16_t, WS_WOUT1), D, D, TL, D, F.G, F.bid);
        pg8::EpiGateBf16 E{WSP(bf16_t, R1_OB), WSP(float, WS_MODV) + 9 * 6144, 2048, TC, TC};
        pg8::gemm_phase<pg8::EpiGateBf16, pg8::DenseOrder>(F.ring, pg8::Gemm{D, D, D}, S, E); SEAM(15); }
    if (IN(16)) { REFRESH(); ph_router(F, 1, TC); SEAM(16); }
    if (IN(17)) { REFRESH(); ph_moe1(F, 1); SEAM(17); }
    if (IN(18)) { REFRESH(); ph_moe2(F, 1); SEAM(18); }
    if (IN(19)) { REFRESH(); ph_final(F); }
#undef IN
#undef SEAM
}

#ifndef ONE_LAUNCH
#define ONE_LAUNCH 1
#endif
extern "C" void kernel_launch(void* const* d_in, const int* in_sizes, int n_in, void* d_out, int out_size, void* d_ws, size_t ws_size, hipStream_t stream) {
    static int grid = 0;
    if (grid == 0) {
        if (n_in != 38 || out_size != TL * D || ws_size < WS_END) { fprintf(stderr, "kernel_launch: unexpected shapes: n_in %d out %d ws %zu (need %zu)\n", n_in, out_size, ws_size, (size_t)WS_END); grid = -1; return; }
        int dev = 0, cus = 0, per_cu = 0;
        if (hipGetDevice(&dev) != hipSuccess || hipDeviceGetAttribute(&cus, hipDeviceAttributeMultiprocessorCount, dev) != hipSuccess) { grid = -1; return; }
        if (hipFuncSetAttribute((const void*)fwd_kernel, hipFuncAttributeMaxDynamicSharedMemorySize, LDS_BYTES) != hipSuccess) { fprintf(stderr, "kernel_launch: hipFuncSetAttribute failed\n"); grid = -1; return; }
        if (hipOccupancyMaxActiveBlocksPerMultiprocessor(&per_cu, (const void*)fwd_kernel, NTHR, LDS_BYTES) != hipSuccess || per_cu < 1) { fprintf(stderr, "kernel_launch: occupancy query says %d\n", per_cu); }
        (void)hipGetLastError();
        grid = cus;
    }
    if (grid < 0) return;
    (void)hipMemsetAsync((char*)d_ws + WS_CTL, 0, CTL_BYTES, stream);
    Args a{};
    for (int i = 0; i < 38; ++i) a.in[i] = (const float*)d_in[i];
    a.out = (float*)d_out; a.ws = (unsigned char*)d_ws;
#if ONE_LAUNCH
    a.ph_lo = 0; a.ph_hi = NPHASE;
    hipLaunchKernelGGL(fwd_kernel, dim3(grid), dim3(NTHR), LDS_BYTES, stream, a);
#else
    for (int p = 0; p < NPHASE; ++p) { a.ph_lo = p; a.ph_hi = p + 1; hipLaunchKernelGGL(fwd_kernel, dim3(grid), dim3(NTHR), LDS_BYTES, stream, a); }
#endif
}
```
